# Optimizing an MI355X kernel written in HIP

```python
import numpy as np
import jax
import jax.numpy as jnp
from jax import lax

D_MODEL = 1024
BATCH = 8
SEQ = 2048
DEPTH = 4

N_EVEN = (DEPTH + 1) // 2
N_ODD = DEPTH // 2
ALPHA = (2 * DEPTH) ** 0.25
BETA = (8 * DEPTH) ** -0.25
LN_EPS = 1e-5
CONV_DIM = D_MODEL // 2
CONV_WIDTH = 3
SSM_D_INNER = D_MODEL
SSM_HEAD_DIM = 64
SSM_HEADS = SSM_D_INNER // SSM_HEAD_DIM
SSM_GROUPS = 4
SSM_STATE = 64
SSM_CONV = 4
SSM_CONV_DIM = SSM_D_INNER + 2 * SSM_GROUPS * SSM_STATE
SSD_CHUNK = 128
MLSTM_HEADS = 4
MLSTM_HEAD_DIM = D_MODEL // 8
MLSTM_W = MLSTM_HEADS * MLSTM_HEAD_DIM
MLSTM_CHUNK = 64
FOX_HEADS = 8
FOX_HEAD_DIM = D_MODEL // 16
FOX_W = FOX_HEADS * FOX_HEAD_DIM
Q_BLOCK = 128
AB_SIZES = (CONV_DIM, CONV_DIM, CONV_DIM, SSM_D_INNER, SSM_CONV_DIM, SSM_HEADS)
AB_IN = sum(AB_SIZES)
AB_MIX = CONV_DIM + SSM_D_INNER
CD_SIZES = (MLSTM_W, MLSTM_W, MLSTM_W, MLSTM_HEADS, MLSTM_HEADS, MLSTM_W,
            FOX_W, FOX_W, FOX_W, FOX_HEADS)
CD_IN = sum(CD_SIZES)
CD_MIX = MLSTM_W + FOX_W
MOE_GROUPS = 4
EXPERTS_PER_GROUP = 8
N_EXPERTS = MOE_GROUPS * EXPERTS_PER_GROUP
TOP_K = 2
D_EXPERT = D_MODEL // 2
MOE_BLOCK = 128

kernel_name = 'hybrid_conv_ssd_mlstm_fox_hiermoe_deepnorm'


def split_cols(a, sizes):
    cuts = [int(c) for c in np.cumsum(sizes)[:-1]]
    return jnp.split(a, cuts, axis=-1)


def layer_norm(x, g, b):
    xf = x.astype(jnp.float32)
    mu = jnp.mean(xf, axis=-1, keepdims=True)
    var = jnp.mean(jnp.square(xf - mu), axis=-1, keepdims=True)
    return ((xf - mu) * lax.rsqrt(var + LN_EPS) * g + b).astype(x.dtype)


def gated_rms_norm(y, z, w):
    u = y.astype(jnp.float32) * jax.nn.silu(z.astype(jnp.float32))
    return (u * lax.rsqrt(jnp.mean(u * u, axis=-1, keepdims=True) + LN_EPS) * w).astype(z.dtype)


def causal_dwconv(x, w):
    k_width, ch = w.shape
    return lax.conv_general_dilated(
        x, w[:, None, :].astype(x.dtype), window_strides=(1,),
        padding=[(k_width - 1, 0)], dimension_numbers=('NWC', 'WIO', 'NWC'),
        feature_group_count=ch)


def ssd_chunked(xs, dt, a_neg, b_mat, c_mat):
    bsz, s_len, n_heads, p_dim = xs.shape
    n_groups, n_state = b_mat.shape[2], b_mat.shape[3]
    r = n_heads // n_groups
    l_c = SSD_CHUNK
    nc = s_len // l_c
    f32 = jnp.float32
    xdt = (xs.astype(f32) * dt[..., None]).reshape(bsz, nc, l_c, n_groups, r, p_dim)
    a = jnp.transpose((dt * a_neg).reshape(bsz, nc, l_c, n_groups, r), (0, 1, 3, 4, 2))
    a_cs = jnp.cumsum(a, axis=-1)
    bc = b_mat.astype(f32).reshape(bsz, nc, l_c, n_groups, n_state)
    cc = c_mat.astype(f32).reshape(bsz, nc, l_c, n_groups, n_state)
    causal = jnp.tril(jnp.ones((l_c, l_c), bool))
    seg = jnp.exp(jnp.where(causal, a_cs[..., :, None] - a_cs[..., None, :], -jnp.inf))
    cb = jnp.einsum('bclgn,bcsgn->bcgls', cc, bc)
    y_diag = jnp.einsum('bcgls,bcgrls,bcsgrp->bclgrp', cb, seg, xdt)
    decay_to_end = jnp.exp(a_cs[..., -1:] - a_cs)
    chunk_states = jnp.einsum('bclgn,bcgrl,bclgrp->bcgrpn', bc, decay_to_end, xdt)
    chunk_decay = jnp.exp(a_cs[..., -1])

    def step(h, inp):
        s_c, d_c = inp
        return h * d_c[..., None, None] + s_c, h

    h0 = jnp.zeros((bsz, n_groups, r, p_dim, n_state), f32)
    _, h_prev = lax.scan(step, h0, (jnp.moveaxis(chunk_states, 1, 0), jnp.moveaxis(chunk_decay, 1, 0)))
    h_prev = jnp.moveaxis(h_prev, 0, 1)
    y_off = jnp.einsum('bclgn,bcgrpn,bcgrl->bclgrp', cc, h_prev, jnp.exp(a_cs))
    return (y_diag + y_off).reshape(bsz, s_len, n_heads, p_dim)


def mlstm_chunkwise(q, k, v, i_pre, f_pre):
    bsz, s_len, n_heads, dk = q.shape
    dv = v.shape[-1]
    l_c = MLSTM_CHUNK
    nc = s_len // l_c
    f32 = jnp.float32

    def to_chunks(a):
        a = a.astype(f32).reshape((bsz, nc, l_c) + a.shape[2:])
        return jnp.moveaxis(a, (1, 3), (0, 2))

    qc, kc, vc = to_chunks(q), to_chunks(k) * (dk ** -0.5), to_chunks(v)
    ic = to_chunks(i_pre)
    fc = to_chunks(jax.nn.log_sigmoid(f_pre.astype(f32)))
    causal = jnp.tril(jnp.ones((l_c, l_c), bool))

    def step(carry, inp):
        c_mat, n_vec, m_prev = carry
        q_b, k_b, v_b, i_b, f_b = inp
        b_cum = jnp.cumsum(f_b, axis=-1)
        d_mat = jnp.where(causal, b_cum[..., :, None] - b_cum[..., None, :] + i_b[..., None, :], -jnp.inf)
        inter = b_cum + m_prev[..., None]
        m_t = jnp.maximum(jnp.max(d_mat, axis=-1), inter)
        w_qk = jnp.einsum('bhld,bhsd->bhls', q_b, k_b) * jnp.exp(d_mat - m_t[..., None])
        s_inter = jnp.exp(inter - m_t)
        num = jnp.einsum('bhls,bhsv->bhlv', w_qk, v_b) + s_inter[..., None] * jnp.einsum('bhld,bhdv->bhlv', q_b, c_mat)
        den = jnp.sum(w_qk, axis=-1) + s_inter * jnp.einsum('bhld,bhd->bhl', q_b, n_vec)
        h = num / jnp.maximum(jnp.abs(den), jnp.exp(-m_t))[..., None]
        b_last = b_cum[..., -1]
        g_log = b_last[..., None] - b_cum + i_b
        m_new = jnp.maximum(b_last + m_prev, jnp.max(g_log, axis=-1))
        w_k = jnp.exp(g_log - m_new[..., None])
        decay = jnp.exp(b_last + m_prev - m_new)
        c_new = decay[..., None, None] * c_mat + jnp.einsum('bhs,bhsd,bhsv->bhdv', w_k, k_b, v_b)
        n_new = decay[..., None] * n_vec + jnp.einsum('bhs,bhsd->bhd', w_k, k_b)
        return (c_new, n_new, m_new), h

    init = (jnp.zeros((bsz, n_heads, dk, dv), f32), jnp.zeros((bsz, n_heads, dk), f32),
            jnp.zeros((bsz, n_heads), f32))
    _, h = lax.scan(step, init, (qc, kc, vc, ic, fc))
    return jnp.transpose(h, (1, 0, 3, 2, 4)).reshape(bsz, s_len, n_heads, dv)


def forgetting_attention(q, k, v, f_pre):
    bsz, s_len, n_heads, d = q.shape
    scale = d ** -0.5
    cum = jnp.transpose(jnp.cumsum(jax.nn.log_sigmoid(f_pre.astype(jnp.float32)), axis=1), (0, 2, 1))
    qh, kh, vh = (jnp.transpose(a, (0, 2, 1, 3)) for a in (q, k, v))
    outs = []
    for blk in range(s_len // Q_BLOCK):
        q0, q1 = blk * Q_BLOCK, (blk + 1) * Q_BLOCK
        logits = (jnp.einsum('bhqd,bhkd->bhqk', qh[:, :, q0:q1], kh[:, :, :q1]).astype(jnp.float32) * scale
                  + cum[:, :, q0:q1, None] - cum[:, :, None, :q1])
        mask = jnp.arange(q0, q1)[:, None] >= jnp.arange(q1)[None, :]
        p = jax.nn.softmax(jnp.where(mask, logits, -jnp.inf), axis=-1)
        outs.append(jnp.einsum('bhqk,bhkd->bhqd', p.astype(vh.dtype), vh[:, :, :q1]))
    return jnp.transpose(jnp.concatenate(outs, axis=2), (0, 2, 1, 3))


def conv_ssd_mixer(x, w_in, conv_a, conv_ssm_w, conv_ssm_b, dt_bias, a_log, d_skip, norm_w, w_out):
    bsz, s_len, _ = x.shape
    proj = jnp.dot(x, w_in)
    b_gate, c_gate, x_a, z, xbc, dt_raw = split_cols(proj, AB_SIZES)
    y_a = b_gate * causal_dwconv(c_gate * x_a, conv_a)
    xbc = jax.nn.silu(causal_dwconv(xbc, conv_ssm_w) + conv_ssm_b)
    xs, b_mat, c_mat = split_cols(xbc, (SSM_D_INNER, SSM_GROUPS * SSM_STATE, SSM_GROUPS * SSM_STATE))
    xs = xs.reshape(bsz, s_len, SSM_HEADS, SSM_HEAD_DIM)
    b_mat = b_mat.reshape(bsz, s_len, SSM_GROUPS, SSM_STATE)
    c_mat = c_mat.reshape(bsz, s_len, SSM_GROUPS, SSM_STATE)
    dt = jax.nn.softplus(dt_raw.astype(jnp.float32) + dt_bias)
    a_neg = -jnp.exp(a_log.astype(jnp.float32))
    y = ssd_chunked(xs, dt, a_neg, b_mat, c_mat) + d_skip[:, None] * xs.astype(jnp.float32)
    y_b = gated_rms_norm(y.reshape(bsz, s_len, SSM_D_INNER), z, norm_w)
    return jnp.dot(jnp.concatenate([y_a, y_b.astype(y_a.dtype)], axis=-1), w_out)


def mlstm_fox_mixer(x, w_in, i_bias, f_bias, hnorm_w, fox_f_bias, w_out):
    bsz, s_len, _ = x.shape
    proj = jnp.dot(x, w_in)
    q, k, v, i_pre, f_pre, o_pre, fq, fk, fv, ff = split_cols(proj, CD_SIZES)
    mh = lambda a: a.reshape(bsz, s_len, MLSTM_HEADS, MLSTM_HEAD_DIM)
    h = mlstm_chunkwise(mh(q), mh(k), mh(v), i_pre.astype(jnp.float32) + i_bias,
                        f_pre.astype(jnp.float32) + f_bias)
    mu = jnp.mean(h, axis=-1, keepdims=True)
    var = jnp.mean(jnp.square(h - mu), axis=-1, keepdims=True)
    h = (h - mu) * lax.rsqrt(var + LN_EPS) * hnorm_w.reshape(MLSTM_HEADS, MLSTM_HEAD_DIM)
    y_c = (jax.nn.sigmoid(o_pre.astype(jnp.float32)) * h.reshape(bsz, s_len, MLSTM_W)).astype(x.dtype)
    fh = lambda a: a.reshape(bsz, s_len, FOX_HEADS, FOX_HEAD_DIM)
    y_d = forgetting_attention(fh(fq), fh(fk), fh(fv), ff.astype(jnp.float32) + fox_f_bias)
    y_d = y_d.reshape(bsz, s_len, FOX_W).astype(x.dtype)
    return jnp.dot(jnp.concatenate([y_c, y_d], axis=-1), w_out)


def grouped_expert_ffn(xt, expert_id, w_gate, w_up, w_down):
    n_rows = expert_id.shape[0]
    d = xt.shape[1]
    n_exp = w_gate.shape[0]
    n_blocks = -(-n_rows // MOE_BLOCK) + n_exp
    order = jnp.argsort(expert_id)
    sorted_e = expert_id[order]
    counts = jnp.bincount(expert_id, length=n_exp)
    padded = (counts + MOE_BLOCK - 1) // MOE_BLOCK * MOE_BLOCK
    pad_end = jnp.cumsum(padded)
    pad_start = pad_end - padded
    start = jnp.cumsum(counts) - counts
    dest = pad_start[sorted_e] + jnp.arange(n_rows) - start[sorted_e]
    buf = jnp.zeros((n_blocks * MOE_BLOCK, d), xt.dtype).at[dest].set(xt[order // TOP_K])
    block_expert = jnp.minimum(
        jnp.searchsorted(pad_end, jnp.arange(n_blocks) * MOE_BLOCK, side='right'), n_exp - 1)

    def expert_block(args):
        xb, e = args
        hidden = jax.nn.silu(jnp.dot(xb, w_gate[e])) * jnp.dot(xb, w_up[e])
        return jnp.dot(hidden, w_down[e])

    out = lax.map(expert_block, (buf.reshape(n_blocks, MOE_BLOCK, d), block_expert))
    out_sorted = out.reshape(-1, d)[dest]
    return jnp.zeros((n_rows, d), out.dtype).at[order].set(out_sorted)


def hierarchical_moe(x, rg_w, rg_b, re_w, re_b, w_gate, w_up, w_down):
    bsz, s_len, d = x.shape
    xt = x.reshape(-1, d)
    n_tok = xt.shape[0]
    g_logits = jnp.dot(xt, rg_w).astype(jnp.float32) + rg_b
    g_prob = jax.nn.softmax(g_logits, axis=-1)
    g_idx = jnp.argmax(g_logits, axis=-1)
    p_group = jnp.max(g_prob, axis=-1, keepdims=True)
    e_logits_all = jnp.einsum('td,gde->tge', xt, re_w).astype(jnp.float32) + re_b
    e_logits = jnp.einsum('tge,tg->te', e_logits_all, jax.nn.one_hot(g_idx, MOE_GROUPS, dtype=jnp.float32))
    top_vals, top_loc = lax.top_k(e_logits, TOP_K)
    gate = p_group * jax.nn.softmax(top_vals, axis=-1)
    expert_id = (g_idx[:, None] * EXPERTS_PER_GROUP + top_loc).reshape(-1).astype(jnp.int32)
    rows = grouped_expert_ffn(xt, expert_id, w_gate, w_up, w_down)
    y = jnp.einsum('tkd,tk->td', rows.reshape(n_tok, TOP_K, d), gate.astype(rows.dtype))
    return y.reshape(bsz, s_len, d)


def setup_inputs(seed: int = 0) -> dict:
    key = jax.random.key(seed)
    ks = iter(jax.random.split(key, 48))
    f32 = jnp.float32

    def nrm(shape, scale):
        return jax.random.normal(next(ks), shape, f32) * scale

    dt0 = jnp.exp(jax.random.uniform(next(ks), (N_EVEN, SSM_HEADS), f32)
                  * (np.log(0.1) - np.log(0.001)) + np.log(0.001))
    return {
        'x': nrm((BATCH, SEQ, D_MODEL), 1.0),
        'ab_w_in': nrm((N_EVEN, D_MODEL, AB_IN), D_MODEL ** -0.5),
        'ab_conv_a': nrm((N_EVEN, CONV_WIDTH, CONV_DIM), CONV_WIDTH ** -0.5),
        'ab_conv_ssm_w': nrm((N_EVEN, SSM_CONV, SSM_CONV_DIM), SSM_CONV ** -0.5),
        'ab_conv_ssm_b': nrm((N_EVEN, SSM_CONV_DIM), 0.02),
        'ab_dt_bias': dt0 + jnp.log(-jnp.expm1(-dt0)),
        'ab_a_log': jnp.log(jax.random.uniform(next(ks), (N_EVEN, SSM_HEADS), f32, 1.0, 16.0)),
        'ab_d_skip': 1.0 + nrm((N_EVEN, SSM_HEADS), 0.1),
        'ab_norm_w': 1.0 + nrm((N_EVEN, SSM_D_INNER), 0.02),
        'ab_w_out': nrm((N_EVEN, AB_MIX, D_MODEL), AB_MIX ** -0.5 * BETA),
        'cd_w_in': nrm((N_ODD, D_MODEL, CD_IN), D_MODEL ** -0.5),
        'cd_i_bias': nrm((N_ODD, MLSTM_HEADS), 0.5),
        'cd_f_bias': 3.0 + nrm((N_ODD, MLSTM_HEADS), 0.5),
        'cd_hnorm_w': 1.0 + nrm((N_ODD, MLSTM_W), 0.02),
        'cd_fox_f_bias': 3.0 + nrm((N_ODD, FOX_HEADS), 0.5),
        'cd_w_out': nrm((N_ODD, CD_MIX, D_MODEL), CD_MIX ** -0.5 * BETA),
        'ln1_g': 1.0 + nrm((DEPTH, D_MODEL), 0.02),
        'ln1_b': nrm((DEPTH, D_MODEL), 0.02),
        'ln2_g': 1.0 + nrm((DEPTH, D_MODEL), 0.02),
        'ln2_b': nrm((DEPTH, D_MODEL), 0.02),
        'moe_rg_w': nrm((DEPTH, D_MODEL, MOE_GROUPS), D_MODEL ** -0.5),
        'moe_rg_b': nrm((DEPTH, MOE_GROUPS), 0.01),
        'moe_re_w': nrm((DEPTH, MOE_GROUPS, D_MODEL, EXPERTS_PER_GROUP), D_MODEL ** -0.5),
        'moe_re_b': nrm((DEPTH, MOE_GROUPS, EXPERTS_PER_GROUP), 0.01),
        'moe_w_gate': nrm((DEPTH, N_EXPERTS, D_MODEL, D_EXPERT), D_MODEL ** -0.5),
        'moe_w_up': nrm((DEPTH, N_EXPERTS, D_MODEL, D_EXPERT), D_MODEL ** -0.5),
        'moe_w_down': nrm((DEPTH, N_EXPERTS, D_EXPERT, D_MODEL), D_EXPERT ** -0.5 * BETA),
    }


def reference(x, ab_w_in, ab_conv_a, ab_conv_ssm_w, ab_conv_ssm_b, ab_dt_bias, ab_a_log, ab_d_skip,
              ab_norm_w, ab_w_out, cd_w_in, cd_i_bias, cd_f_bias, cd_hnorm_w, cd_fox_f_bias, cd_w_out,
              ln1_g, ln1_b, ln2_g, ln2_b, moe_rg_w, moe_rg_b, moe_re_w, moe_re_b,
              moe_w_gate, moe_w_up, moe_w_down):
    h = x
    for layer in range(DEPTH):
        j = layer // 2
        if layer % 2 == 0:
            mix = conv_ssd_mixer(h, ab_w_in[j], ab_conv_a[j], ab_conv_ssm_w[j], ab_conv_ssm_b[j],
                                 ab_dt_bias[j], ab_a_log[j], ab_d_skip[j], ab_norm_w[j], ab_w_out[j])
        else:
            mix = mlstm_fox_mixer(h, cd_w_in[j], cd_i_bias[j], cd_f_bias[j], cd_hnorm_w[j],
                                  cd_fox_f_bias[j], cd_w_out[j])
        h = layer_norm(ALPHA * h + mix, ln1_g[layer], ln1_b[layer])
        ffn = hierarchical_moe(h, moe_rg_w[layer], moe_rg_b[layer], moe_re_w[layer], moe_re_b[layer],
                               moe_w_gate[layer], moe_w_up[layer], moe_w_down[layer])
        h = layer_norm(ALPHA * h + ffn, ln2_g[layer], ln2_b[layer])
    return h
```

```cpp
#include <hip/hip_runtime.h>
#include <cstdio>
#include <cstdint>
__device__ __forceinline__ float silu_f(float x) { return x / (1.0f + __expf(-x)); }
namespace pg8 {
#define PG8_LAS __attribute__((address_space(3)))
typedef unsigned short bf16_t;
typedef short bf16x8 __attribute__((ext_vector_type(8)));
typedef float f32x4 __attribute__((ext_vector_type(4)));
typedef unsigned u32x4 __attribute__((ext_vector_type(4)));
constexpr int BM = 256, BK = 64, HALF = 128, HTB = HALF * BK * 2  , STAGE_BYTES = 8 * HTB, NXCD = 8, WGM = 8;

__host__ __device__ __forceinline__ int lds_byte(int r, int c) { const int st = (r >> 4) * 2 + (c >> 5), rr = r & 15, cc = c & 31, ob = rr * 64 + cc * 2; return st * 1024 + (ob ^ (((ob >> 9) & 1) << 5)); }
__host__ __device__ __forceinline__ void stage_rc(int b, int& R, int& C) { const int st = b / 1024, sb = b % 1024, swz = sb ^ (((sb >> 9) & 1) << 5); R = (st >> 1) * 16 + swz / 64; C = (st & 1) * 32 + (swz % 64) / 2; }
__host__ __device__ __forceinline__ int perm32(int rho) { const int n = rho >> 4, i = rho & 15; return 8 * (i >> 2) + 4 * n + (i & 3); }

struct Unit { int pm, pn, be; };
struct Gemm { const bf16_t* A; const bf16_t* Bt; int M, N, K; size_t bstride; };

struct StaticOrder {
    int nM, nN, nwg, G, c;
    __host__ __device__ void init(int M, int N, int G_, int c_) { nM = M / BM; nN = N / BM; nwg = nM * nN; G = G_; c = c_; }
    __host__ __device__ bool next(int i, Unit& u) const {
        const long L = (long)i * G + c; if (L >= nwg) return false;
        int wgid = (int)L; { const int q = nwg / NXCD, r = nwg % NXCD, xcd = wgid % NXCD, off = wgid / NXCD; wgid = (xcd < r ? xcd * (q + 1) : r * (q + 1) + (xcd - r) * q) + off; }
        const int nig = WGM * nN, gid = wgid / nig, fm = gid * WGM, gsz = (nM - fm) < WGM ? (nM - fm) : WGM;
        u.pm = fm + ((wgid % nig) % gsz); u.pn = (wgid % nig) / gsz; u.be = 0; return true;
    }
    __device__ __forceinline__ void a_ready(const Unit&) const {}
    __device__ __forceinline__ void done(const Unit&) const {}
};

__device__ __forceinline__ unsigned cvt_pk_bf16(float lo, float hi) { unsigned r; asm volatile("v_cvt_pk_bf16_f32 %0, %1, %2" : "=v"(r) : "v"(lo), "v"(hi)); return r; }
struct EpiStoreBf16 {
    static constexpr bool PERM = true, AFTER_DRAIN = false;
    bf16_t* O; int ldc;
    __device__ __forceinline__ void operator()(const f32x4 (&acc)[2][2][4][2], const Unit& u, int wr, int wc, int fr, int fq) const {
        const int row0 = u.pm * BM + wr * 64 + fr, col0 = u.pn * BM + wc * 32 + 8 * fq;
#pragma unroll
        for (int ai = 0; ai < 2; ++ai)
#pragma unroll
            for (int m = 0; m < 4; ++m) { bf16_t* rowp = O + (size_t)(row0 + ai * HALF + m * 16) * ldc + col0;
#pragma unroll
                for (int bj = 0; bj < 2; ++bj) { const f32x4 v0 = acc[ai][bj][m][0], v1 = acc[ai][bj][m][1];
                    u32x4 w; w.x = cvt_pk_bf16(v0[0], v0[1]); w.y = cvt_pk_bf16(v0[2], v0[3]); w.z = cvt_pk_bf16(v1[0], v1[1]); w.w = cvt_pk_bf16(v1[2], v1[3]);
                    *(u32x4*)(rowp + bj * HALF) = w; } }
    }
};
struct EpiStoreF32 {
    static constexpr bool PERM = false, AFTER_DRAIN = false;
    float* C; int ldc;
    __device__ __forceinline__ void operator()(const f32x4 (&acc)[2][2][4][2], const Unit& u, int wr, int wc, int fr, int fq) const {
        const int row0 = u.pm * BM + wr * 64 + fr, col0 = u.pn * BM + wc * 32 + 4 * fq;
#pragma unroll
        for (int ai = 0; ai < 2; ++ai)
#pragma unroll
            for (int m = 0; m < 4; ++m) { float* rowp = C + (size_t)(row0 + ai * HALF + m * 16) * ldc + col0;
#pragma unroll
                for (int bj = 0; bj < 2; ++bj)
#pragma unroll
                    for (int n = 0; n < 2; ++n) *(f32x4*)(rowp + bj * HALF + n * 16) = acc[ai][bj][m][n]; }
    }
};
struct EpiSwiglu {
    static constexpr bool PERM = true, AFTER_DRAIN = false;
    bf16_t* O; int ldc;
    __device__ __forceinline__ void operator()(const f32x4 (&acc)[2][2][4][2], const Unit& u, int wr, int wc, int fr, int fq) const {
        const int row0 = u.pm * BM + wr * 64 + fr, col0 = u.pn * HALF + wc * 32 + 8 * fq;
#pragma unroll
        for (int ai = 0; ai < 2; ++ai)
#pragma unroll
            for (int m = 0; m < 4; ++m) { bf16_t* rowp = O + (size_t)(row0 + ai * HALF + m * 16) * ldc + col0;
                const f32x4 g0 = acc[ai][0][m][0], g1 = acc[ai][0][m][1], u0 = acc[ai][1][m][0], u1 = acc[ai][1][m][1];
                float h[8];
#pragma unroll
                for (int i = 0; i < 4; ++i) { h[i] = silu_f(g0[i]) * u0[i]; h[4 + i] = silu_f(g1[i]) * u1[i]; }
                u32x4 w; w.x = cvt_pk_bf16(h[0], h[1]); w.y = cvt_pk_bf16(h[2], h[3]); w.z = cvt_pk_bf16(h[4], h[5]); w.w = cvt_pk_bf16(h[6], h[7]);
                *(u32x4*)rowp = w; }
    }
};
struct MoeOrder : StaticOrder {
    const int* tab;
    __device__ __forceinline__ void initm(const int* tab_, int nN_, int G_, int c_) { tab = tab_; nM = tab_[0]; nN = nN_; nwg = nM * nN; G = G_; c = c_; }
    __device__ __forceinline__ bool next(int i, Unit& u) const { if (!StaticOrder::next(i, u)) return false; u.be = tab[1 + u.pm]; return true; }
};
template <class Epi, class Sched, bool ALIGN_EPI = false, bool SP2 = false>
__device__ __forceinline__ void gemm_phase(PG8_LAS unsigned char* lds, const Gemm g, const Sched& S, const Epi& E) {
    const int tid = threadIdx.x, wid = __builtin_amdgcn_readfirstlane(tid >> 6), lane = tid & 63, wr = wid >> 2, wc = wid & 3, fr = lane & 15, fq = lane >> 4;
    const int K = g.K, nt = K / BK;
    unsigned voffA[2], voffB[2];
#pragma unroll
    for (int i = 0; i < 2; ++i) { int R, C; stage_rc(tid * 16 + i * 8192, R, C); const int Rb = Epi::PERM ? ((R & ~31) + perm32(R & 31)) : R;
        voffA[i] = (unsigned)(R * K + C) * 2u; voffB[i] = (unsigned)(Rb * K + C) * 2u; }
    const size_t kstep = (size_t)(BK * 2);
    const size_t hstep = (size_t)HALF * K * 2;
    const size_t tstep = 2 * hstep;
    const unsigned ldsw = (unsigned)wid * 1024u;
    const int aoff = lds_byte(wr * 64 + fr, fq * 8), boff = lds_byte(wc * 32 + fr, fq * 8);
#define PG8_SA(b, h) (((b) * 2 + (h)) * HTB)
#define PG8_SB(b, h) ((4 + (b) * 2 + (h)) * HTB)
#define PG8_STAGE(bufoff, gbase, voff) do { _Pragma("unroll") for (int _i = 0; _i < 2; ++_i) \
        __builtin_amdgcn_global_load_lds((const unsigned*)((const char*)(gbase) + (voff)[_i]), (PG8_LAS unsigned*)(lds + (bufoff) + ldsw + _i * 8192), 16, 0, 0); } while (0)
#define PG8_LDA(dst, b, h) do { _Pragma("unroll") for (int m = 0; m < 4; ++m) _Pragma("unroll") for (int k = 0; k < 2; ++k) dst[m][k] = *(const PG8_LAS bf16x8*)(lds + PG8_SA(b, h) + aoff + m * 2048 + k * 1024); } while (0)
#define PG8_LDB(dst, b, h) do { _Pragma("unroll") for (int n = 0; n < 2; ++n) _Pragma("unroll") for (int k = 0; k < 2; ++k) dst[n][k] = *(const PG8_LAS bf16x8*)(lds + PG8_SB(b, h) + boff + n * 2048 + k * 1024); } while (0)
#define PG8_MMA(ai, bj, At, Bt) do { __builtin_amdgcn_s_setprio(1); _Pragma("unroll") for (int m = 0; m < 4; ++m) _Pragma("unroll") for (int n = 0; n < 2; ++n) _Pragma("unroll") for (int k = 0; k < 2; ++k) \
        acc[ai][bj][m][n] = __builtin_amdgcn_mfma_f32_16x16x32_bf16(Bt[n][k], At[m][k], acc[ai][bj][m][n], 0, 0, 0); __builtin_amdgcn_s_setprio(0); } while (0)
#define PG8_WAIT_V(n) asm volatile("s_waitcnt vmcnt(" #n ")" ::: "memory")
#define PG8_WAIT_L(n) asm volatile("s_waitcnt lgkmcnt(" #n ")" ::: "memory")
#define PG8_BAR __builtin_amdgcn_s_barrier()
#define PG8_SCHED __builtin_amdgcn_sched_barrier(0)
    Unit cur, nxt; int ui = 0;
    if (!S.next(0, cur)) return;
    f32x4 acc[2][2][4][2];
#pragma unroll
    for (int a = 0; a < 2; ++a)
#pragma unroll
        for (int b = 0; b < 2; ++b)
#pragma unroll
            for (int m = 0; m < 4; ++m)
#pragma unroll
                for (int n = 0; n < 2; ++n) acc[a][b][m][n] = (f32x4){0.f, 0.f, 0.f, 0.f};
    bf16x8 At[4][2], B0[2][2], B1[2][2];
    const char* cA = (const char*)g.A + (size_t)cur.pm * tstep; const char* cB = (const char*)g.Bt + (size_t)cur.be * g.bstride + (size_t)cur.pn * tstep;
    S.a_ready(cur);
    if constexpr (SP2) {
        PG8_STAGE(PG8_SB(0, 0), cB, voffB); PG8_STAGE(PG8_SB(0, 1), cB + hstep, voffB); PG8_STAGE(PG8_SA(0, 0), cA, voffA); PG8_STAGE(PG8_SA(0, 1), cA + hstep, voffA);
        if (wr == 1) PG8_BAR;
        PG8_WAIT_V(2); PG8_BAR;
        PG8_STAGE(PG8_SB(1, 0), cB + kstep, voffB); PG8_STAGE(PG8_SA(1, 0), cA + kstep, voffA); PG8_STAGE(PG8_SB(1, 1), cB + hstep + kstep, voffB);
        PG8_WAIT_V(6); PG8_BAR;
    } else {
        PG8_STAGE(PG8_SB(0, 0), cB, voffB); PG8_STAGE(PG8_SA(0, 0), cA, voffA); PG8_STAGE(PG8_SB(0, 1), cB + hstep, voffB); PG8_STAGE(PG8_SA(0, 1), cA + hstep, voffA);
        if (wr == 1) PG8_BAR;
        PG8_WAIT_V(4); PG8_BAR;
        PG8_STAGE(PG8_SB(1, 0), cB + kstep, voffB); PG8_STAGE(PG8_SA(1, 0), cA + kstep, voffA); PG8_STAGE(PG8_SB(1, 1), cB + hstep + kstep, voffB);
        PG8_WAIT_V(6); PG8_BAR;
    }
    for (;;) {
        const bool has_next = S.next(ui + 1, nxt);
        const char* nA = has_next ? (const char*)g.A + (size_t)nxt.pm * tstep : cA; const char* nB = has_next ? (const char*)g.Bt + (size_t)nxt.be * g.bstride + (size_t)nxt.pn * tstep : cB;
        for (int t = 0; t < nt; t += 2) {
            const bool last = (t == nt - 2);
            const char* a1 = cA + (size_t)(t + 1) * kstep;
            const char* a2 = last ? nA : cA + (size_t)(t + 2) * kstep; const char* b2 = last ? nB : cB + (size_t)(t + 2) * kstep;
            const char* a3 = a2 + kstep; const char* b3 = b2 + kstep;
            if (last && has_next) S.a_ready(nxt);
            if constexpr (SP2) {
            PG8_LDB(B0, 0, 0); PG8_LDB(B1, 0, 1); PG8_SCHED; PG8_LDA(At, 0, 0); PG8_STAGE(PG8_SA(1, 1), a1 + hstep, voffA);
            PG8_WAIT_V(8); PG8_WAIT_L(0); PG8_BAR; PG8_MMA(0, 0, At, B0); PG8_MMA(0, 1, At, B1); PG8_BAR; PG8_SCHED;
            PG8_LDA(At, 0, 1); PG8_STAGE(PG8_SB(0, 0), b2, voffB); PG8_STAGE(PG8_SB(0, 1), b2 + hstep, voffB); PG8_STAGE(PG8_SA(0, 0), a2, voffA);
            PG8_WAIT_V(8); PG8_WAIT_L(0); PG8_BAR; PG8_MMA(1, 0, At, B0); PG8_MMA(1, 1, At, B1); PG8_BAR; PG8_SCHED;
            PG8_LDB(B0, 1, 0); PG8_LDB(B1, 1, 1); PG8_SCHED; PG8_LDA(At, 1, 0); PG8_STAGE(PG8_SA(0, 1), a2 + hstep, voffA);
            PG8_WAIT_V(8); PG8_WAIT_L(0); PG8_BAR; PG8_MMA(0, 0, At, B0); PG8_MMA(0, 1, At, B1); PG8_BAR; PG8_SCHED;
            PG8_LDA(At, 1, 1); PG8_STAGE(PG8_SB(1, 0), b3, voffB); PG8_STAGE(PG8_SB(1, 1), b3 + hstep, voffB); PG8_STAGE(PG8_SA(1, 0), a3, voffA);
            PG8_WAIT_V(8); PG8_WAIT_L(0); PG8_BAR; PG8_MMA(1, 0, At, B0); PG8_MMA(1, 1, At, B1); PG8_BAR; PG8_SCHED;
            } else {
            PG8_LDB(B0, 0, 0); PG8_SCHED; PG8_LDA(At, 0, 0); PG8_STAGE(PG8_SA(1, 1), a1 + hstep, voffA);
            PG8_WAIT_L(8); PG8_BAR; PG8_WAIT_L(0); PG8_MMA(0, 0, At, B0); PG8_BAR; PG8_SCHED;
            PG8_LDB(B1, 0, 1); PG8_STAGE(PG8_SB(0, 0), b2, voffB);
            PG8_BAR; PG8_WAIT_L(0); PG8_MMA(0, 1, At, B1); PG8_BAR;
            PG8_LDA(At, 0, 1); PG8_STAGE(PG8_SA(0, 0), a2, voffA);
            PG8_BAR; PG8_WAIT_L(0); PG8_MMA(1, 0, At, B0); PG8_BAR; PG8_SCHED;
            PG8_STAGE(PG8_SB(0, 1), b2 + hstep, voffB);
            PG8_WAIT_V(6); PG8_BAR; PG8_MMA(1, 1, At, B1); PG8_BAR;
            PG8_LDB(B0, 1, 0); PG8_SCHED; PG8_LDA(At, 1, 0); PG8_STAGE(PG8_SA(0, 1), a2 + hstep, voffA);
            PG8_WAIT_L(8); PG8_BAR; PG8_WAIT_L(0); PG8_MMA(0, 0, At, B0); PG8_BAR; PG8_SCHED;
            PG8_LDB(B1, 1, 1); PG8_STAGE(PG8_SB(1, 0), b3, voffB);
            PG8_BAR; PG8_WAIT_L(0); PG8_MMA(0, 1, At, B1); PG8_BAR;
            PG8_LDA(At, 1, 1); PG8_STAGE(PG8_SA(1, 0), a3, voffA);
            PG8_BAR; PG8_WAIT_L(0); PG8_MMA(1, 0, At, B0); PG8_BAR; PG8_SCHED;
            PG8_STAGE(PG8_SB(1, 1), b3 + hstep, voffB);
            PG8_WAIT_V(6); PG8_BAR; PG8_MMA(1, 1, At, B1); PG8_BAR;
            }
        }
        if constexpr (ALIGN_EPI) { if (wr == 0) PG8_BAR; }
        if constexpr (!Epi::AFTER_DRAIN) { E(acc, cur, wr, wc, fr, fq); S.done(cur); }
        if (!has_next) break;
#pragma unroll
        for (int a = 0; a < 2; ++a)
#pragma unroll
            for (int b = 0; b < 2; ++b)
#pragma unroll
                for (int m = 0; m < 4; ++m)
#pragma unroll
                    for (int n = 0; n < 2; ++n) acc[a][b][m][n] = (f32x4){0.f, 0.f, 0.f, 0.f};
        cur = nxt; cA = nA; cB = nB; ++ui;
        if constexpr (ALIGN_EPI) { if (wr == 1) PG8_BAR; }
    }
    PG8_WAIT_V(0);
    if constexpr (!ALIGN_EPI) { if (wr == 0) PG8_BAR; }
    PG8_BAR;
    if constexpr (Epi::AFTER_DRAIN) { E.fused(acc, cur, wr, wc, fr, fq, lds, wid, lane); S.done(cur); }
#undef PG8_SA
#undef PG8_SB
#undef PG8_STAGE
#undef PG8_LDA
#undef PG8_LDB
#undef PG8_MMA
#undef PG8_WAIT_V
#undef PG8_WAIT_L
#undef PG8_BAR
#undef PG8_SCHED
}
}
constexpr int NWAVES = 8;
constexpr int T = 16384, D = 1024, SEQ = 2048, NBATCH = 8, DEPTH = 4;
constexpr float ALPHA = 1.6817928305074290f;
constexpr float LN_EPS = 1e-5f;
constexpr int AB_IN = 4112, CD_IN = 3600, NPE = 4096, NPO = 3584;
constexpr float LOG2E = 1.4426950408889634f;
constexpr float FOX_C2 = 0.125f * LOG2E;
constexpr float MLSTM_KSCALE = 0.08838834764831845f;
constexpr int RPAD = 40960;
constexpr int NPH_LAYER = 12, NPHASES = 1 + DEPTH * NPH_LAYER;
#ifndef MK_ONE_LAUNCH
#define MK_ONE_LAUNCH 0
#endif

constexpr size_t MiB = 1u << 20, KiB = 1u << 10;
constexpr size_t WS_CTL = 0, CTL_ZERO_BYTES = 1 * MiB;
constexpr size_t WS_BCNT = 1 * MiB, WS_PANEL = WS_BCNT + 64 * KiB, WS_ROUTE = WS_BCNT + 128 * KiB, WS_GATE = WS_BCNT + 384 * KiB, WS_POS = WS_BCNT + 512 * KiB,
                 WS_DEC = WS_BCNT + 640 * KiB, WS_MLOC = WS_BCNT + 704 * KiB, WS_BLAST = WS_BCNT + 712 * KiB, WS_MPREV = WS_BCNT + 720 * KiB,
                 WS_FOXC = 2 * MiB, WS_NLOC = 2 * MiB + 512 * KiB, WS_SG = 3 * MiB;
constexpr size_t WS_WINE = 4 * MiB, WS_WINO = 20 * MiB, WS_WOUTE = 34 * MiB, WS_WOUTO = 40 * MiB, WS_WGU = 44 * MiB, WS_WD = 300 * MiB;
constexpr size_t WS_HF = 428 * MiB, WS_HB = 492 * MiB, WS_H1F = 524 * MiB, WS_H1B = 588 * MiB;
constexpr size_t WS_R1 = 620 * MiB;
constexpr size_t WS_R2 = 748 * MiB;
constexpr size_t WS_R3 = 812 * MiB;
constexpr size_t WS_R4 = 860 * MiB;
constexpr size_t WS_MIX = 892 * MiB, WS_END = 940 * MiB;
constexpr int CW_BAR = 4096;

constexpr int RING_BYTES = 131072, SMALL_OFF = RING_BYTES, SMALL_BYTES = 8192, MISC_OFF = SMALL_OFF + SMALL_BYTES, LDS_BYTES = 147456;

#define GAS __attribute__((address_space(1)))
#define LAS __attribute__((address_space(3)))
typedef unsigned short bf16;
typedef unsigned v4u __attribute__((ext_vector_type(4)));
typedef unsigned v2u __attribute__((ext_vector_type(2)));
typedef float f32x4 __attribute__((ext_vector_type(4)));
typedef float f32x2 __attribute__((ext_vector_type(2)));
typedef int i32x4 __attribute__((ext_vector_type(4)));
typedef int i32x2 __attribute__((ext_vector_type(2)));
#define LDS_WAIT() asm volatile("s_waitcnt lgkmcnt(0)" ::: "memory")
__device__ __forceinline__ unsigned f2bf(float f) { unsigned u = __builtin_bit_cast(unsigned, f); return (u + 0x7fffu + ((u >> 16) & 1u)) >> 16; }
__device__ __forceinline__ unsigned pk2(float lo, float hi) { return f2bf(lo) | (f2bf(hi) << 16); }
__device__ __forceinline__ float bflo(unsigned w) { return __builtin_bit_cast(float, w << 16); }
__device__ __forceinline__ float bfhi(unsigned w) { return __builtin_bit_cast(float, w & 0xffff0000u); }
__device__ __forceinline__ float bf2f(bf16 b) { return __builtin_bit_cast(float, (unsigned)b << 16); }
__device__ __forceinline__ float wave_sum(float v) {
#pragma unroll
    for (int o = 1; o < 64; o <<= 1) v += __shfl_xor(v, o);
    return v;
}
__device__ __forceinline__ float wave_max(float v) {
#pragma unroll
    for (int o = 1; o < 64; o <<= 1) v = fmaxf(v, __shfl_xor(v, o));
    return v;
}
__device__ __forceinline__ float wave_scan_sum(float v, int lane) {
#pragma unroll
    for (int o = 1; o < 64; o <<= 1) { const float t = __shfl_up(v, o); if (lane >= o) v += t; }
    return v;
}
__device__ __forceinline__ float wave_scan_max(float v, int lane) {
#pragma unroll
    for (int o = 1; o < 64; o <<= 1) { const float t = __shfl_up(v, o); if (lane >= o) v = fmaxf(v, t); }
    return v;
}
__device__ __forceinline__ float softplus_f(float x) { return x > 20.f ? x : log1pf(expf(x)); }
__device__ __forceinline__ float logsigmoid_f(float x) { return fminf(x, 0.f) - log1pf(expf(-fabsf(x))); }
__device__ __forceinline__ float sigmoid_f(float x) { return 1.0f / (1.0f + expf(-x)); }
#define XB_TMO      128
#define XB_XCNT(j)  (256  + 64 * (j))
#define XB_XSUB(j)  (1280 + 64 * (j))
#define XB_XGEN(j)  (2304 + 64 * (j))
#define XB_TOP      3328
#define XB_TOPGEN   3392
#define XCD_BAR_WORDS 3456
#define XB_SPIN_CAP (1u << 18)

__device__ __forceinline__ unsigned xb_ld(unsigned* p)              { return __hip_atomic_load(p, __ATOMIC_RELAXED, __HIP_MEMORY_SCOPE_AGENT); }
__device__ __forceinline__ unsigned xb_add(unsigned* p, unsigned v) { return __hip_atomic_fetch_add(p, v, __ATOMIC_RELAXED, __HIP_MEMORY_SCOPE_AGENT); }
__device__ __forceinline__ unsigned xb_xcc_id() { return (unsigned)__builtin_amdgcn_s_getreg((3 << 11) | 20) & 0xFu; }
#define XB_SPIN(cond, bar) do { unsigned _sp = 0; while (cond) { __builtin_amdgcn_s_sleep(1); \
    if ((++_sp & 255u) == 0u) { if (xb_ld(&(bar)[XB_TMO])) break; if (_sp > XB_SPIN_CAP) { atomicAdd(&(bar)[XB_TMO], 1u); break; } } } } while (0)

struct XcdBarrier {
    unsigned* bar; unsigned x;
    volatile LAS unsigned* st;
};

__device__ __forceinline__ XcdBarrier xcd_barrier_post(unsigned* bar, volatile LAS unsigned* st) {
    XcdBarrier b; b.bar = bar; b.x = xb_xcc_id(); b.st = st;
    if (threadIdx.x == 0) (void)xb_add(&bar[XB_XCNT(b.x)], 1u);
    return b;
}
__device__ __forceinline__ void xcd_barrier_complete(unsigned* bar, unsigned x, unsigned& nloc, unsigned& nx) {
    const unsigned G = gridDim.x * gridDim.y * gridDim.z;
    unsigned sum, cnt, mine, sp = 0u;
    for (;;) {
        sum = 0u; cnt = 0u; mine = 0u;
#pragma unroll
        for (unsigned j = 0; j < 16; ++j) { const unsigned c = xb_ld(&bar[XB_XCNT(j)]); sum += c; cnt += (c > 0u) ? 1u : 0u; mine = (j == x) ? c : mine; }
        if (sum == G) break;
        __builtin_amdgcn_s_sleep(1);
        if ((++sp & 255u) == 0u) { if (xb_ld(&bar[XB_TMO])) break; if (sp > XB_SPIN_CAP) { atomicAdd(&bar[XB_TMO], 1u); break; } }
    }
    nloc = mine > 0u ? mine : 1u; nx = cnt > 0u ? cnt : 1u;
}

__device__ __forceinline__ void xcd_barrier(const XcdBarrier& b) {
    asm volatile("s_waitcnt vmcnt(0)" ::: "memory");
    __syncthreads();
    if (threadIdx.x == 0) {
        unsigned* bar = b.bar;
        __builtin_amdgcn_s_waitcnt(0);
        unsigned nloc = b.st[0], nx = b.st[1];
        if (nloc == 0u) { xcd_barrier_complete(bar, b.x, nloc, nx); b.st[0] = nloc; b.st[1] = nx; }
        const unsigned old = xb_add(&bar[XB_XSUB(b.x)], 1u);
        const unsigned gen = old / nloc;
        if (old + 1u == (gen + 1u) * nloc) {
            __builtin_amdgcn_fence(__ATOMIC_RELEASE, "agent");
            asm volatile("s_waitcnt vmcnt(0)" ::: "memory");
            const unsigned og = xb_add(&bar[XB_TOP], 1u);
            const unsigned tg = og / nx;
            if (og + 1u == (tg + 1u) * nx) xb_add(&bar[XB_TOPGEN], 1u);
            else XB_SPIN(xb_ld(&bar[XB_TOPGEN]) == tg, bar);
            __builtin_amdgcn_fence(__ATOMIC_ACQUIRE, "agent");
            xb_add(&bar[XB_XGEN(b.x)], 1u);
            asm volatile("s_waitcnt vmcnt(0)" ::: "memory");
        } else {
            XB_SPIN(xb_ld(&bar[XB_XGEN(b.x)]) == gen, bar);
            __builtin_amdgcn_fence(__ATOMIC_ACQUIRE, "agent");
            asm volatile("s_waitcnt vmcnt(0)" ::: "memory");
        }
    }
    __syncthreads();
}
struct Frame {
    LAS unsigned char* lds;
    volatile LAS unsigned* MISC;
    unsigned* ctl;
    int tid, lane, wave, vcu, G, gw, NGW;
    float* out; unsigned char* ws;
};
typedef const float* const cfpc_t; typedef __attribute__((address_space(4))) cfpc_t* kargp_t;
__device__ __forceinline__ kargp_t kin() { kargp_t p = (kargp_t)__builtin_amdgcn_kernarg_segment_ptr(); asm volatile("" : "+s"(p)); return p; }
#define KIN(i) (kin()[i])
enum { I_X = 0, I_ABWIN, I_CONVA, I_CONVW, I_CONVB, I_DTB, I_ALOG, I_DSKIP, I_NORMW, I_ABWOUT, I_CDWIN, I_IB, I_FB, I_HNW, I_FOXB, I_CDWOUT, I_LN1G, I_LN1B, I_LN2G, I_LN2B,
       I_RGW, I_RGB, I_REW, I_REB, I_WG, I_WU, I_WDN };

__device__ __forceinline__ void row_load(const float* row, int lane, f32x4 (&v)[4]) {
#pragma unroll
    for (int j = 0; j < 4; ++j) v[j] = ((const f32x4*)row)[lane + 64 * j];
}
__device__ __forceinline__ void row_store_f32(float* row, int lane, const f32x4 (&v)[4]) {
#pragma unroll
    for (int j = 0; j < 4; ++j) ((f32x4*)row)[lane + 64 * j] = v[j];
}
__device__ __forceinline__ void row_store_bf16(bf16* row, int lane, const f32x4 (&v)[4]) {
#pragma unroll
    for (int j = 0; j < 4; ++j) { v2u w; w.x = pk2(v[j][0], v[j][1]); w.y = pk2(v[j][2], v[j][3]); ((v2u*)row)[lane + 64 * j] = w; }
}
__device__ __forceinline__ void row_load_bf16(const bf16* row, int lane, f32x4 (&v)[4]) {
#pragma unroll
    for (int j = 0; j < 4; ++j) { const v2u w = ((const v2u*)row)[lane + 64 * j]; v[j] = (f32x4){bflo(w.x), bfhi(w.x), bflo(w.y), bfhi(w.y)}; }
}
__device__ __forceinline__ void row_layernorm(f32x4 (&v)[4], const float* g, const float* b, int lane) {
    float s = 0.f;
#pragma unroll
    for (int j = 0; j < 4; ++j) s += (v[j][0] + v[j][1]) + (v[j][2] + v[j][3]);
    const float mean = wave_sum(s) * (1.f / D); float s2 = 0.f;
#pragma unroll
    for (int j = 0; j < 4; ++j) { v[j] = v[j] - mean; s2 += (v[j][0] * v[j][0] + v[j][1] * v[j][1]) + (v[j][2] * v[j][2] + v[j][3] * v[j][3]); }
    const float rstd = 1.0f / sqrtf(wave_sum(s2) * (1.f / D) + LN_EPS);
#pragma unroll
    for (int j = 0; j < 4; ++j) { const f32x4 gg = ((const f32x4*)g)[lane + 64 * j], bb = ((const f32x4*)b)[lane + 64 * j]; v[j] = v[j] * rstd * gg + bb; }
}
__device__ __forceinline__ void row_proj16(const f32x4 (&v)[4], const float* W, int ldw, int c0a, int c0b, float* sg, int lane) {
    float a[16];
#pragma unroll
    for (int c = 0; c < 16; ++c) a[c] = 0.f;
#pragma unroll
    for (int j = 0; j < 4; ++j)
#pragma unroll
        for (int i = 0; i < 4; ++i) { const float x = v[j][i]; const float* wr = W + (size_t)(256 * j + 4 * lane + i) * ldw;
            const f32x4 w0 = *(const f32x4*)(wr + c0a), w1 = *(const f32x4*)(wr + c0a + 4), w2 = *(const f32x4*)(wr + c0b), w3 = *(const f32x4*)(wr + c0b + 4);
#pragma unroll
            for (int c = 0; c < 4; ++c) { a[c] += x * w0[c]; a[4 + c] += x * w1[c]; a[8 + c] += x * w2[c]; a[12 + c] += x * w3[c]; } }
    float r = 0.f;
#pragma unroll
    for (int c = 0; c < 16; ++c) { const float s = wave_sum(a[c]); r = (lane == c) ? s : r; }
    if (lane < 16) sg[lane] = r;
}
__device__ __forceinline__ void row_gate_proj(Frame& F, const f32x4 (&v)[4], int layer, int m) {
    float* sg = (float*)(F.ws + WS_SG) + (size_t)m * 16; const int j = layer >> 1;
    if ((layer & 1) == 0) row_proj16(v, KIN(I_ABWIN) + (size_t)j * D * AB_IN, AB_IN, 4096, 4104, sg, F.lane);
    else                  row_proj16(v, KIN(I_CDWIN) + (size_t)j * D * CD_IN, CD_IN, 1536, 3592, sg, F.lane);
}

__device__ __forceinline__ void transpose_tile(const float* W, int ldw, int k0, int n0, bf16* WT, int ldt, int drow0, float scale, const float* kscale, LAS float* scr, int lane) {
#pragma unroll 8
    for (int i = 0; i < 32; ++i) { const int kk = 2 * i + (lane >> 5); float v = W[(size_t)(k0 + kk) * ldw + n0 + (lane & 31)] * scale; if (kscale) v *= kscale[kk]; scr[kk * 33 + (lane & 31)] = v; }
    LDS_WAIT(); asm volatile("" ::: "memory");
    const int c = lane & 7;
#pragma unroll
    for (int j = 0; j < 4; ++j) { const int n = (lane >> 3) + 8 * j; const LAS float* s = scr + (8 * c) * 33 + n;
        v4u o; o.x = pk2(s[0 * 33], s[1 * 33]); o.y = pk2(s[2 * 33], s[3 * 33]); o.z = pk2(s[4 * 33], s[5 * 33]); o.w = pk2(s[6 * 33], s[7 * 33]);
        *(v4u*)(WT + (size_t)(drow0 + n) * ldt + k0 + 8 * c) = o; }
    LDS_WAIT(); asm volatile("" ::: "memory");
}
__device__ __forceinline__ void p_prologue(Frame& F) {
    LAS float* scr = (LAS float*)(F.lds + F.wave * 16384);
    bf16* WinE = (bf16*)(F.ws + WS_WINE); bf16* WinO = (bf16*)(F.ws + WS_WINO); bf16* WoutE = (bf16*)(F.ws + WS_WOUTE); bf16* WoutO = (bf16*)(F.ws + WS_WOUTO);
    bf16* Wgu = (bf16*)(F.ws + WS_WGU); bf16* Wd = (bf16*)(F.ws + WS_WD);
    constexpr int N_WINE = 2 * 2048, N_WINO = 2 * 1792, N_WOE = 2 * 768, N_WOO = 2 * 512, N_GU = 128 * 512, N_D = 128 * 256;
    constexpr int NITEMS = N_WINE + N_WINO + N_WOE + N_WOO + N_GU + N_D;
    for (int it = F.gw; it < NITEMS; it += F.NGW) {
        int r = it;
        if (r < N_WINE) { const int j = r / 2048, q = r % 2048, kb = q / 128, nb = q % 128;
            transpose_tile(KIN(I_ABWIN) + (size_t)j * D * AB_IN, AB_IN, 64 * kb, 32 * nb, WinE + (size_t)j * NPE * D, D, 32 * nb, 1.f, nullptr, scr, F.lane); continue; } r -= N_WINE;
        if (r < N_WINO) { const int j = r / 1792, q = r % 1792, seg = q / 256, q2 = q % 256, kb = q2 / 16, nb = q2 % 16;
            const int scol = (seg < 3 ? 512 * seg : 1544 + 512 * (seg - 3)) + 32 * nb; const float sc = seg == 1 ? MLSTM_KSCALE : (seg == 4 ? FOX_C2 : 1.f);
            transpose_tile(KIN(I_CDWIN) + (size_t)j * D * CD_IN, CD_IN, 64 * kb, scol, WinO + (size_t)j * NPO * D, D, 512 * seg + 32 * nb, sc, nullptr, scr, F.lane); continue; } r -= N_WINO;
        if (r < N_WOE) { const int j = r / 768, q = r % 768, kb = q / 32, nb = q % 32;
            const float* ks = kb >= 8 ? KIN(I_NORMW) + (size_t)j * 1024 + (64 * kb - 512) : nullptr;
            transpose_tile(KIN(I_ABWOUT) + (size_t)j * 1536 * D, D, 64 * kb, 32 * nb, WoutE + (size_t)j * D * 1536, 1536, 32 * nb, 1.f, ks, scr, F.lane); continue; } r -= N_WOE;
        if (r < N_WOO) { const int j = r / 512, q = r % 512, kb = q / 32, nb = q % 32;
            transpose_tile(KIN(I_CDWOUT) + (size_t)j * D * D, D, 64 * kb, 32 * nb, WoutO + (size_t)j * D * D, D, 32 * nb, 1.f, nullptr, scr, F.lane); continue; } r -= N_WOO;
        if (r < N_GU) { const int le = r / 512, q = r % 512, half = q / 256, q2 = q % 256, kb = q2 / 16, nb = q2 % 16, n0 = 32 * nb;
            const float* src = (half ? KIN(I_WU) : KIN(I_WG)) + (size_t)le * D * 512;
            transpose_tile(src, 512, 64 * kb, n0, Wgu + (size_t)le * D * D, D, 256 * (n0 / 128) + 128 * half + (n0 % 128), 1.f, nullptr, scr, F.lane); continue; } r -= N_GU;
        { const int le = r / 256, q = r % 256, kb = q / 32, nb = q % 32;
            transpose_tile(KIN(I_WDN) + (size_t)le * 512 * D, D, 64 * kb, 32 * nb, Wd + (size_t)le * D * 512, 512, 32 * nb, 1.f, nullptr, scr, F.lane); }
    }
    bf16* HB = (bf16*)(F.ws + WS_HB);
    for (int m = F.gw; m < T; m += F.NGW) { f32x4 v[4]; row_load(KIN(I_X) + (size_t)m * D, F.lane, v); row_store_bf16(HB + (size_t)m * D, F.lane, v); row_gate_proj(F, v, 0, m); }
}
__device__ __forceinline__ void e0_conv(Frame& F, int j) {
    const bf16* P = (const bf16*)(F.ws + WS_R1); bf16* XBC = (bf16*)(F.ws + WS_R3); bf16* MIX = (bf16*)(F.ws + WS_MIX);
    const float* cw = KIN(I_CONVW) + (size_t)j * 4 * 1536; const float* cb = KIN(I_CONVB) + (size_t)j * 1536; const float* ca = KIN(I_CONVA) + (size_t)j * 3 * 512;
    for (int it = F.gw; it < (T / 8) * 16; it += F.NGW) {
        const int tt = it >> 4, cg = it & 15, t0 = tt * 8, s0 = t0 & (SEQ - 1);
        if (cg < 12) {
            const int c = cg * 128 + 2 * F.lane;
            float w0[4], w1[4];
#pragma unroll
            for (int k = 0; k < 4; ++k) { w0[k] = cw[k * 1536 + c]; w1[k] = cw[k * 1536 + c + 1]; }
            const float b0 = cb[c], b1 = cb[c + 1];
            float xa[11], xb[11];
#pragma unroll
            for (int r = 0; r < 11; ++r) { unsigned w = 0u; if (s0 - 3 + r >= 0) w = *(const unsigned*)(P + (size_t)(t0 - 3 + r) * NPE + 2560 + c); xa[r] = bflo(w); xb[r] = bfhi(w); }
#pragma unroll
            for (int o = 0; o < 8; ++o) { float a0 = b0, a1 = b1;
#pragma unroll
                for (int k = 0; k < 4; ++k) { a0 += w0[k] * xa[o + k]; a1 += w1[k] * xb[o + k]; }
                *(unsigned*)(XBC + (size_t)(t0 + o) * 1536 + c) = pk2(silu_f(a0), silu_f(a1)); }
        } else {
            const int c = (cg - 12) * 128 + 2 * F.lane;
            float w0[3], w1[3];
#pragma unroll
            for (int k = 0; k < 3; ++k) { w0[k] = ca[k * 512 + c]; w1[k] = ca[k * 512 + c + 1]; }
            float ua[10], ub[10];
#pragma unroll
            for (int r = 0; r < 10; ++r) { float a = 0.f, b = 0.f;
                if (s0 - 2 + r >= 0) { const bf16* pr = P + (size_t)(t0 - 2 + r) * NPE; const unsigned cgw = *(const unsigned*)(pr + 512 + c), xw = *(const unsigned*)(pr + 1024 + c); a = bflo(cgw) * bflo(xw); b = bfhi(cgw) * bfhi(xw); }
                ua[r] = a; ub[r] = b; }
#pragma unroll
            for (int o = 0; o < 8; ++o) { float a0 = 0.f, a1 = 0.f;
#pragma unroll
                for (int k = 0; k < 3; ++k) { a0 += w0[k] * ua[o + k]; a1 += w1[k] * ub[o + k]; }
                const unsigned bg = *(const unsigned*)(P + (size_t)(t0 + o) * NPE + c);
                *(unsigned*)(MIX + (size_t)(t0 + o) * 1536 + c) = pk2(bflo(bg) * a0, bfhi(bg) * a1); }
        }
    }
}
__device__ __forceinline__ void ssd_gates(Frame& F, int j, int t0, int h, LAS float* dtl, LAS float* acs) {
    if (F.wave == 0) {
        const float* SG = (const float*)(F.ws + WS_SG); const float dtb = KIN(I_DTB)[j * 16 + h], aneg = -expf(KIN(I_ALOG)[j * 16 + h]);
        const float d0 = softplus_f(SG[(size_t)(t0 + 2 * F.lane) * 16 + h] + dtb), d1 = softplus_f(SG[(size_t)(t0 + 2 * F.lane + 1) * 16 + h] + dtb);
        const float a0 = d0 * aneg, a1 = d1 * aneg; const float inc = wave_scan_sum(a0 + a1, F.lane);
        dtl[2 * F.lane] = d0; dtl[2 * F.lane + 1] = d1; acs[2 * F.lane] = inc - a1; acs[2 * F.lane + 1] = inc;
    }
}
__device__ __forceinline__ void e1_states(Frame& F, int j) {
    const bf16* XBC = (const bf16*)(F.ws + WS_R3); float* ST = (float*)(F.ws + WS_R4); float* DEC = (float*)(F.ws + WS_DEC);
    LAS float* xw = (LAS float*)F.lds; LAS float* Bm = (LAS float*)(F.lds + 32768); LAS float* dtl = (LAS float*)(F.lds + SMALL_OFF); LAS float* acs = dtl + 128;
    for (int u = F.vcu; u < 2048; u += F.G) {
        const int b = u >> 8, c = (u >> 4) & 15, h = u & 15, g = h >> 2, t0 = b * SEQ + c * 128;
        __syncthreads();
        ssd_gates(F, j, t0, h, dtl, acs);
        __syncthreads();
        for (int i = F.tid; i < 128 * 32; i += 512) { const int l = i >> 5, pp = (i & 31) * 2; const float wgt = expf(acs[127] - acs[l]) * dtl[l];
            const unsigned xv = *(const unsigned*)(XBC + (size_t)(t0 + l) * 1536 + h * 64 + pp), bv = *(const unsigned*)(XBC + (size_t)(t0 + l) * 1536 + 1024 + g * 64 + pp);
            xw[l * 64 + pp] = bflo(xv) * wgt; xw[l * 64 + pp + 1] = bfhi(xv) * wgt; Bm[l * 64 + pp] = bflo(bv); Bm[l * 64 + pp + 1] = bfhi(bv); }
        __syncthreads();
        const int n = F.lane, p0 = 8 * F.wave; float acc[8];
#pragma unroll
        for (int i = 0; i < 8; ++i) acc[i] = 0.f;
#pragma unroll 2
        for (int l = 0; l < 128; ++l) { const float bm = Bm[l * 64 + n]; const f32x4 x0 = *(const LAS f32x4*)(xw + l * 64 + p0), x1 = *(const LAS f32x4*)(xw + l * 64 + p0 + 4);
#pragma unroll
            for (int i = 0; i < 4; ++i) { acc[i] += x0[i] * bm; acc[4 + i] += x1[i] * bm; } }
        float* dst = ST + (size_t)u * 4096;
#pragma unroll
        for (int i = 0; i < 8; ++i) dst[(p0 + i) * 64 + n] = acc[i];
        if (F.tid == 0) DEC[u] = expf(acs[127]);
    }
}
__device__ __forceinline__ void e2_scan(Frame& F) {
    float* ST = (float*)(F.ws + WS_R4); const float* DEC = (const float*)(F.ws + WS_DEC);
    for (int e = F.vcu * 512 + F.tid; e < NBATCH * 16 * 4096; e += F.G * 512) {
        const int b = e >> 16, h = (e >> 12) & 15, pn = e & 4095; float run = 0.f;
        for (int c = 0; c < 16; ++c) { const int u = (b * 16 + c) * 16 + h; const size_t idx = (size_t)u * 4096 + pn; const float s = ST[idx]; ST[idx] = run; run = run * DEC[u] + s; }
    }
}
__device__ __forceinline__ void e3_output(Frame& F, int j) {
    const bf16* XBC = (const bf16*)(F.ws + WS_R3); const float* ST = (const float*)(F.ws + WS_R4); float* Y = (float*)(F.ws + WS_R2);
    LAS float* R0 = (LAS float*)F.lds;
    LAS float* R1 = (LAS float*)(F.lds + 32768);
    LAS float* R2 = (LAS float*)(F.lds + 65536);
    LAS float* dtl = (LAS float*)(F.lds + SMALL_OFF); LAS float* acs = dtl + 128;
    for (int u = F.vcu; u < 2048; u += F.G) {
        const int b = u >> 8, c = (u >> 4) & 15, h = u & 15, g = h >> 2, t0 = b * SEQ + c * 128;
        __syncthreads();
        ssd_gates(F, j, t0, h, dtl, acs);
        for (int i = F.tid; i < 128 * 32; i += 512) { const int l = i >> 5, nn = (i & 31) * 2;
            const unsigned bv = *(const unsigned*)(XBC + (size_t)(t0 + l) * 1536 + 1024 + g * 64 + nn), cv = *(const unsigned*)(XBC + (size_t)(t0 + l) * 1536 + 1280 + g * 64 + nn);
            R0[l * 64 + nn] = bflo(cv); R0[l * 64 + nn + 1] = bfhi(cv); R1[nn * 128 + l] = bflo(bv); R1[(nn + 1) * 128 + l] = bfhi(bv); }
        { const float* hp = ST + (size_t)u * 4096; for (int i = F.tid; i < 4096; i += 512) { const int p = i >> 6, n = i & 63; R2[n * 64 + p] = hp[i]; } }
        __syncthreads();
        const int p = F.lane, l0 = 16 * F.wave; float acc[16];
#pragma unroll
        for (int i = 0; i < 16; ++i) acc[i] = 0.f;
#pragma unroll 1
        for (int n0 = 0; n0 < 64; n0 += 4) { float hp[4];
#pragma unroll
            for (int i = 0; i < 4; ++i) hp[i] = R2[(n0 + i) * 64 + p];
#pragma unroll
            for (int li = 0; li < 16; ++li) { const f32x4 c4 = *(const LAS f32x4*)(R0 + (l0 + li) * 64 + n0); acc[li] += (c4[0] * hp[0] + c4[1] * hp[1]) + (c4[2] * hp[2] + c4[3] * hp[3]); } }
#pragma unroll
        for (int li = 0; li < 16; ++li) acc[li] *= expf(acs[l0 + li]);
        __syncthreads();
#pragma unroll 1
        for (int half = 0; half < 2; ++half) { const int s = F.tid & 127, lg = 32 * (F.tid >> 7) + 16 * half; float gacc[16];
#pragma unroll
            for (int i = 0; i < 16; ++i) gacc[i] = 0.f;
#pragma unroll 1
            for (int n0 = 0; n0 < 64; n0 += 4) { float bb[4];
#pragma unroll
                for (int i = 0; i < 4; ++i) bb[i] = R1[(n0 + i) * 128 + s];
#pragma unroll
                for (int li = 0; li < 16; ++li) { const f32x4 c4 = *(const LAS f32x4*)(R0 + (lg + li) * 64 + n0); gacc[li] += (c4[0] * bb[0] + c4[1] * bb[1]) + (c4[2] * bb[2] + c4[3] * bb[3]); } }
            const float as = acs[s];
#pragma unroll
            for (int li = 0; li < 16; ++li) { const int l = lg + li; R2[l * 128 + s] = (s <= l) ? gacc[li] * expf(acs[l] - as) : 0.f; } }
        __syncthreads();
        for (int i = F.tid; i < 128 * 32; i += 512) { const int l = i >> 5, pp = (i & 31) * 2; const unsigned xv = *(const unsigned*)(XBC + (size_t)(t0 + l) * 1536 + h * 64 + pp);
            R0[l * 64 + pp] = bflo(xv); R0[l * 64 + pp + 1] = bfhi(xv); }
        __syncthreads();
#pragma unroll 1
        for (int s0 = 0; s0 < l0 + 16; s0 += 4) { float xv[4];
#pragma unroll
            for (int i = 0; i < 4; ++i) xv[i] = R0[(s0 + i) * 64 + p] * dtl[s0 + i];
#pragma unroll
            for (int li = 0; li < 16; ++li) { const f32x4 g4 = *(const LAS f32x4*)(R2 + (l0 + li) * 128 + s0); acc[li] += (g4[0] * xv[0] + g4[1] * xv[1]) + (g4[2] * xv[2] + g4[3] * xv[3]); } }
        const float dsk = KIN(I_DSKIP)[j * 16 + h];
#pragma unroll
        for (int li = 0; li < 16; ++li) Y[(size_t)(t0 + l0 + li) * D + h * 64 + p] = acc[li] + dsk * R0[(l0 + li) * 64 + p];
    }
}
__device__ __forceinline__ void e4_gnorm(Frame& F) {
    const float* Y = (const float*)(F.ws + WS_R2); const bf16* P = (const bf16*)(F.ws + WS_R1); bf16* MIX = (bf16*)(F.ws + WS_MIX);
    for (int m = F.gw; m < T; m += F.NGW) { f32x4 y[4], z[4]; row_load(Y + (size_t)m * D, F.lane, y); row_load_bf16(P + (size_t)m * NPE + 1536, F.lane, z); float ss = 0.f;
#pragma unroll
        for (int jj = 0; jj < 4; ++jj)
#pragma unroll
            for (int i = 0; i < 4; ++i) { const float uu = y[jj][i] * silu_f(z[jj][i]); y[jj][i] = uu; ss += uu * uu; }
        const float rstd = 1.0f / sqrtf(wave_sum(ss) * (1.f / D) + LN_EPS);
#pragma unroll
        for (int jj = 0; jj < 4; ++jj) y[jj] = y[jj] * rstd;
        row_store_bf16(MIX + (size_t)m * 1536 + 512, F.lane, y); }
}
__device__ __forceinline__ void o_foxscan(Frame& F, int j) {
    const float* SG = (const float*)(F.ws + WS_SG); float* FOXC = (float*)(F.ws + WS_FOXC);
    for (int bh = F.gw; bh < 64; bh += F.NGW) { const int b = bh >> 3, h = bh & 7; const float bias = KIN(I_FOXB)[j * 8 + h];
        float v[32], run = 0.f;
#pragma unroll
        for (int i = 0; i < 32; ++i) { run += logsigmoid_f(SG[(size_t)(b * SEQ + 32 * F.lane + i) * 16 + 8 + h] + bias); v[i] = run; }
        const float off = wave_scan_sum(run, F.lane) - run;
#pragma unroll
        for (int i = 0; i < 32; ++i) FOXC[(size_t)bh * SEQ + 32 * F.lane + i] = (v[i] + off) * LOG2E; }
}
__device__ __forceinline__ void mlstm_gates(Frame& F, int j, int t0, int h, float& bcum, float& ib) {
    const float* SG = (const float*)(F.ws + WS_SG);
    ib = SG[(size_t)(t0 + F.lane) * 16 + h] + KIN(I_IB)[j * 4 + h];
    bcum = wave_scan_sum(logsigmoid_f(SG[(size_t)(t0 + F.lane) * 16 + 4 + h] + KIN(I_FB)[j * 4 + h]), F.lane);
}
__device__ __forceinline__ void o1_local(Frame& F, int j) {
    const bf16* P = (const bf16*)(F.ws + WS_R1); float* KLOC = (float*)(F.ws + WS_R2); float* NLOC = (float*)(F.ws + WS_NLOC); float* MLOC = (float*)(F.ws + WS_MLOC); float* BLAST = (float*)(F.ws + WS_BLAST);
    LAS float* kw = (LAS float*)F.lds; LAS float* Vs = (LAS float*)(F.lds + 32768); LAS float* wk = (LAS float*)(F.lds + SMALL_OFF);
    for (int u = F.vcu; u < 1024; u += F.G) {
        const int b = u >> 7, h = (u >> 5) & 3, c = u & 31, t0 = b * SEQ + c * 64;
        __syncthreads();
        if (F.wave == 0) { float bcum, ib; mlstm_gates(F, j, t0, h, bcum, ib); const float blast = __shfl(bcum, 63); const float gl = blast - bcum + ib; const float ml = wave_max(gl);
            wk[F.lane] = expf(gl - ml); if (F.lane == 0) { MLOC[u] = ml; BLAST[u] = blast; } }
        __syncthreads();
        for (int i = F.tid; i < 64 * 64; i += 512) { const int s = i >> 6, dd = (i & 63) * 2; const float w = wk[s];
            const unsigned kv = *(const unsigned*)(P + (size_t)(t0 + s) * NPO + 512 + h * 128 + dd), vv = *(const unsigned*)(P + (size_t)(t0 + s) * NPO + 1024 + h * 128 + dd);
            kw[s * 128 + dd] = bflo(kv) * w; kw[s * 128 + dd + 1] = bfhi(kv) * w; Vs[s * 128 + dd] = bflo(vv); Vs[s * 128 + dd + 1] = bfhi(vv); }
        __syncthreads();
        const int v = F.tid & 127, d0 = 32 * (F.tid >> 7); float acc[32];
#pragma unroll
        for (int i = 0; i < 32; ++i) acc[i] = 0.f;
#pragma unroll 1
        for (int s = 0; s < 64; ++s) { const float vv = Vs[s * 128 + v];
#pragma unroll
            for (int di = 0; di < 32; di += 4) { const f32x4 k4 = *(const LAS f32x4*)(kw + s * 128 + d0 + di);
#pragma unroll
                for (int i = 0; i < 4; ++i) acc[di + i] += k4[i] * vv; } }
        float* dst = KLOC + (size_t)u * 16384;
#pragma unroll
        for (int i = 0; i < 32; ++i) dst[(d0 + i) * 128 + v] = acc[i];
        if (F.tid < 128) { float a = 0.f; for (int s = 0; s < 64; ++s) a += kw[s * 128 + F.tid]; NLOC[(size_t)u * 128 + F.tid] = a; }
    }
}
__device__ __forceinline__ void o2_scan(Frame& F) {
    float* KLOC = (float*)(F.ws + WS_R2); float* NLOC = (float*)(F.ws + WS_NLOC); const float* MLOC = (const float*)(F.ws + WS_MLOC); const float* BLAST = (const float*)(F.ws + WS_BLAST); float* MPREV = (float*)(F.ws + WS_MPREV);
    constexpr int PER = 16384 + 128;
    for (int e = F.vcu * 512 + F.tid; e < 32 * PER; e += F.G * 512) {
        const int bh = e / PER, r = e % PER; float run = 0.f, m = 0.f;
        for (int c = 0; c < 32; ++c) { const int u = bh * 32 + c; float* p = r < 16384 ? KLOC + (size_t)u * 16384 + r : NLOC + (size_t)u * 128 + (r - 16384);
            const float loc = *p; *p = run; if (r == 0) MPREV[u] = m;
            const float bl = BLAST[u], ml = MLOC[u], mn = fmaxf(bl + m, ml);
            run = expf(bl + m - mn) * run + expf(ml - mn) * loc; m = mn; }
    }
}
__device__ __forceinline__ void o3_output(Frame& F, int j) {
    const bf16* P = (const bf16*)(F.ws + WS_R1); const float* CPREV = (const float*)(F.ws + WS_R2); const float* NPREV = (const float*)(F.ws + WS_NLOC); const float* MPREV = (const float*)(F.ws + WS_MPREV); bf16* MIX = (bf16*)(F.ws + WS_MIX);
    LAS float* qT = (LAS float*)F.lds;
    LAS float* kT = (LAS float*)(F.lds + 32768);
    LAS float* Vs = (LAS float*)(F.lds + 65536);
    LAS float* WT = (LAS float*)(F.lds + 98304);
    LAS float* sm = (LAS float*)(F.lds + SMALL_OFF);
    for (int u = F.vcu; u < 1024; u += F.G) {
        const int b = u >> 7, h = (u >> 5) & 3, c = u & 31, t0 = b * SEQ + c * 64;
        __syncthreads();
        if (F.wave == 0) { float bcum, ib; mlstm_gates(F, j, t0, h, bcum, ib); const float mprev = MPREV[u];
            const float pm = wave_scan_max(ib - bcum, F.lane); const float inter = bcum + mprev; const float mt = fmaxf(bcum + pm, inter);
            sm[F.lane] = bcum; sm[64 + F.lane] = ib; sm[128 + F.lane] = mt; sm[192 + F.lane] = expf(inter - mt); }
        for (int i = F.tid; i < 64 * 64; i += 512) { const int s = i >> 6, dd = (i & 63) * 2; const bf16* pr = P + (size_t)(t0 + s) * NPO + h * 128 + dd;
            const unsigned qv = *(const unsigned*)pr, kv = *(const unsigned*)(pr + 512), vv = *(const unsigned*)(pr + 1024);
            qT[dd * 64 + s] = bflo(qv); qT[(dd + 1) * 64 + s] = bfhi(qv); kT[dd * 64 + s] = bflo(kv); kT[(dd + 1) * 64 + s] = bfhi(kv); Vs[s * 128 + dd] = bflo(vv); Vs[s * 128 + dd + 1] = bfhi(vv); }
        __syncthreads();
        { const int s = F.lane, l0 = 8 * F.wave; float acc[8];
#pragma unroll
            for (int i = 0; i < 8; ++i) acc[i] = 0.f;
#pragma unroll 2
            for (int d = 0; d < 128; ++d) { const float kk = kT[d * 64 + s]; const f32x4 q0 = *(const LAS f32x4*)(qT + d * 64 + l0), q1 = *(const LAS f32x4*)(qT + d * 64 + l0 + 4);
#pragma unroll
                for (int i = 0; i < 4; ++i) { acc[i] += q0[i] * kk; acc[4 + i] += q1[i] * kk; } }
            const float gs = sm[64 + s] - sm[s];
#pragma unroll
            for (int i = 0; i < 8; ++i) { const int l = l0 + i; const float w = (s <= l) ? acc[i] * expf(sm[l] + gs - sm[128 + l]) : 0.f; WT[s * 64 + l] = w; const float dsum = wave_sum(w); if (F.lane == 0) sm[256 + l] = dsum; } }
        __syncthreads();
        if (F.tid < 64) { const int l = F.tid; float qn = 0.f; const float* np = NPREV + (size_t)u * 128; for (int d = 0; d < 128; ++d) qn += qT[d * 64 + l] * np[d]; sm[256 + l] += sm[192 + l] * qn; }
        const int v = F.tid & 127, l0 = 16 * (F.tid >> 7); float acc[16];
#pragma unroll
        for (int i = 0; i < 16; ++i) acc[i] = 0.f;
        { const float* cp = CPREV + (size_t)u * 16384;
#pragma unroll 2
            for (int d = 0; d < 128; ++d) { const float cc = cp[d * 128 + v];
#pragma unroll
                for (int li = 0; li < 16; li += 4) { const f32x4 q4 = *(const LAS f32x4*)(qT + d * 64 + l0 + li);
#pragma unroll
                    for (int i = 0; i < 4; ++i) acc[li + i] += q4[i] * cc; } } }
#pragma unroll
        for (int i = 0; i < 16; ++i) acc[i] *= sm[192 + l0 + i];
#pragma unroll 2
        for (int s = 0; s < 64; ++s) { const float vv = Vs[s * 128 + v];
#pragma unroll
            for (int li = 0; li < 16; li += 4) { const f32x4 w4 = *(const LAS f32x4*)(WT + s * 64 + l0 + li);
#pragma unroll
                for (int i = 0; i < 4; ++i) acc[li + i] += w4[i] * vv; } }
        __syncthreads();
        LAS float* hb = kT;
#pragma unroll
        for (int i = 0; i < 16; ++i) { const int l = l0 + i; const float hv = acc[i] / fmaxf(fabsf(sm[256 + l]), expf(-sm[128 + l])); acc[i] = hv; hb[l * 128 + v] = hv; }
        __syncthreads();
        { const int lb = 8 * F.wave;
#pragma unroll
            for (int i = 0; i < 8; ++i) { const int l = lb + i; const float a = hb[l * 128 + F.lane], bq = hb[l * 128 + 64 + F.lane]; const float mu = wave_sum(a + bq) * (1.f / 128.f);
                const float da = a - mu, db = bq - mu; const float var = wave_sum(da * da + db * db) * (1.f / 128.f); if (F.lane == 0) { sm[320 + l] = mu; sm[384 + l] = 1.0f / sqrtf(var + LN_EPS); } } }
        __syncthreads();
        const float hw = KIN(I_HNW)[j * 512 + h * 128 + v];
#pragma unroll
        for (int i = 0; i < 16; ++i) { const int l = l0 + i; const float og = sigmoid_f(bf2f(P[(size_t)(t0 + l) * NPO + 1536 + h * 128 + v]));
            MIX[(size_t)(t0 + l) * D + h * 128 + v] = (bf16)f2bf(og * (acc[i] - sm[320 + l]) * sm[384 + l] * hw); }
    }
}
__device__ __forceinline__ void o4_fox(Frame& F) {
    const bf16* P = (const bf16*)(F.ws + WS_R1); const float* FOXC = (const float*)(F.ws + WS_FOXC); bf16* MIX = (bf16*)(F.ws + WS_MIX);
    LAS float* QT = (LAS float*)F.lds;
    LAS float* KT = (LAS float*)(F.lds + 16384);
    LAS float* Vs = (LAS float*)(F.lds + 32768);
    LAS float* PT = (LAS float*)(F.lds + 49152) + F.wave * 512;
    LAS float* cq = (LAS float*)(F.lds + SMALL_OFF); LAS float* ck = cq + 64;
    for (int it = F.vcu; it < 2048; it += F.G) {
        const int qt = 31 - (it >> 6), bh = it & 63, b = bh >> 3, h = bh & 7, tq0 = b * SEQ + qt * 64;
        __syncthreads();
        for (int i = F.tid; i < 64 * 32; i += 512) { const int q = i >> 5, dd = (i & 31) * 2; const unsigned w = *(const unsigned*)(P + (size_t)(tq0 + q) * NPO + 2048 + h * 64 + dd); QT[dd * 64 + q] = bflo(w); QT[(dd + 1) * 64 + q] = bfhi(w); }
        if (F.tid < 64) cq[F.tid] = FOXC[(size_t)bh * SEQ + qt * 64 + F.tid];
        const int q0 = 8 * F.wave; float mrun[8], lrun[8], o[8];
#pragma unroll
        for (int i = 0; i < 8; ++i) { mrun[i] = -INFINITY; lrun[i] = 0.f; o[i] = 0.f; }
#pragma unroll 1
        for (int kt = 0; kt <= qt; ++kt) { const int tk0 = b * SEQ + kt * 64;
            __syncthreads();
            for (int i = F.tid; i < 64 * 32; i += 512) { const int k = i >> 5, dd = (i & 31) * 2; const bf16* pr = P + (size_t)(tk0 + k) * NPO + h * 64 + dd; const unsigned kw = *(const unsigned*)(pr + 2560), vw = *(const unsigned*)(pr + 3072);
                KT[dd * 64 + k] = bflo(kw); KT[(dd + 1) * 64 + k] = bfhi(kw); Vs[k * 64 + dd] = bflo(vw); Vs[k * 64 + dd + 1] = bfhi(vw); }
            if (F.tid < 64) ck[F.tid] = FOXC[(size_t)bh * SEQ + kt * 64 + F.tid];
            __syncthreads();
            float s[8];
#pragma unroll
            for (int i = 0; i < 8; ++i) s[i] = 0.f;
#pragma unroll 2
            for (int d = 0; d < 64; ++d) { const float kk = KT[d * 64 + F.lane]; const f32x4 qa = *(const LAS f32x4*)(QT + d * 64 + q0), qb = *(const LAS f32x4*)(QT + d * 64 + q0 + 4);
#pragma unroll
                for (int i = 0; i < 4; ++i) { s[i] += qa[i] * kk; s[4 + i] += qb[i] * kk; } }
            const float ckv = ck[F.lane];
#pragma unroll
            for (int i = 0; i < 8; ++i) { float sv = s[i] + cq[q0 + i] - ckv; if (kt == qt && F.lane > q0 + i) sv = -INFINITY;
                const float mn = fmaxf(mrun[i], wave_max(sv)); const float p = exp2f(sv - mn), al = exp2f(mrun[i] - mn);
                lrun[i] = lrun[i] * al + wave_sum(p); o[i] *= al; mrun[i] = mn; PT[F.lane * 8 + i] = p; }
            LDS_WAIT(); asm volatile("" ::: "memory");
#pragma unroll 2
            for (int k = 0; k < 64; ++k) { const float vv = Vs[k * 64 + F.lane]; const f32x4 pa = *(const LAS f32x4*)(PT + k * 8), pb = *(const LAS f32x4*)(PT + k * 8 + 4);
#pragma unroll
                for (int i = 0; i < 4; ++i) { o[i] += pa[i] * vv; o[4 + i] += pb[i] * vv; } }
        }
#pragma unroll
        for (int i = 0; i < 8; ++i) MIX[(size_t)(tq0 + q0 + i) * D + 512 + h * 64 + F.lane] = (bf16)f2bf(o[i] / lrun[i]);
    }
}
__device__ __forceinline__ void p_ln1_route(Frame& F, int layer, const float* hin) {
    const float* OUTP = (const float*)(F.ws + WS_R1); float* H1F = (float*)(F.ws + WS_H1F); bf16* H1B = (bf16*)(F.ws + WS_H1B);
    i32x4* ROUTE = (i32x4*)(F.ws + WS_ROUTE); f32x2* GATE = (f32x2*)(F.ws + WS_GATE); int* BCNT = (int*)(F.ws + WS_BCNT);
    LAS int* cnt = (LAS int*)(F.lds + SMALL_OFF);
    const float* g1 = KIN(I_LN1G) + (size_t)layer * D; const float* b1 = KIN(I_LN1B) + (size_t)layer * D;
    const float* rgw = KIN(I_RGW) + (size_t)layer * D * 4; const float* rgb = KIN(I_RGB) + layer * 4; const float* rew = KIN(I_REW) + (size_t)layer * 4 * D * 8; const float* reb = KIN(I_REB) + layer * 32;
    __syncthreads();
    if (F.tid < 32) cnt[F.tid] = 0;
    __syncthreads();
    for (int m = F.gw; m < T; m += F.NGW) {
        f32x4 v[4], a[4]; row_load(hin + (size_t)m * D, F.lane, v); row_load(OUTP + (size_t)m * D, F.lane, a);
#pragma unroll
        for (int jj = 0; jj < 4; ++jj) v[jj] = v[jj] * ALPHA + a[jj];
        row_layernorm(v, g1, b1, F.lane);
        row_store_f32(H1F + (size_t)m * D, F.lane, v); row_store_bf16(H1B + (size_t)m * D, F.lane, v);
        float gl[4] = {0.f, 0.f, 0.f, 0.f};
#pragma unroll
        for (int jj = 0; jj < 4; ++jj)
#pragma unroll
            for (int i = 0; i < 4; ++i) { const f32x4 w = *(const f32x4*)(rgw + (size_t)(256 * jj + 4 * F.lane + i) * 4);
#pragma unroll
                for (int c = 0; c < 4; ++c) gl[c] += v[jj][i] * w[c]; }
#pragma unroll
        for (int c = 0; c < 4; ++c) gl[c] = wave_sum(gl[c]) + rgb[c];
        int gi = 0; float gm = gl[0];
#pragma unroll
        for (int c = 1; c < 4; ++c) if (gl[c] > gm) { gm = gl[c]; gi = c; }
        float se = 0.f;
#pragma unroll
        for (int c = 0; c < 4; ++c) se += expf(gl[c] - gm);
        const float pg = 1.0f / se;
        const float* rw = rew + (size_t)gi * D * 8; float el[8];
#pragma unroll
        for (int c = 0; c < 8; ++c) el[c] = 0.f;
#pragma unroll
        for (int jj = 0; jj < 4; ++jj)
#pragma unroll
            for (int i = 0; i < 4; ++i) { const float* wr = rw + (size_t)(256 * jj + 4 * F.lane + i) * 8; const f32x4 w0 = *(const f32x4*)wr, w1 = *(const f32x4*)(wr + 4);
#pragma unroll
                for (int c = 0; c < 4; ++c) { el[c] += v[jj][i] * w0[c]; el[4 + c] += v[jj][i] * w1[c]; } }
#pragma unroll
        for (int c = 0; c < 8; ++c) el[c] = wave_sum(el[c]) + reb[gi * 8 + c];
        int i0 = 0; float v0 = el[0];
#pragma unroll
        for (int c = 1; c < 8; ++c) if (el[c] > v0) { v0 = el[c]; i0 = c; }
        int i1 = -1; float v1 = -INFINITY;
#pragma unroll
        for (int c = 0; c < 8; ++c) if (c != i0 && el[c] > v1) { v1 = el[c]; i1 = c; }
        if (i1 < 0) i1 = (i0 + 1) & 7;
        const float ee = expf(v1 - v0), g0 = pg / (1.0f + ee), g1v = pg * ee / (1.0f + ee);
        if (F.lane == 0) { const int e0 = gi * 8 + i0, e1 = gi * 8 + i1;
            const int r0 = __hip_atomic_fetch_add(cnt + e0, 1, __ATOMIC_RELAXED, __HIP_MEMORY_SCOPE_WORKGROUP), r1 = __hip_atomic_fetch_add(cnt + e1, 1, __ATOMIC_RELAXED, __HIP_MEMORY_SCOPE_WORKGROUP);
            ROUTE[m] = (i32x4){e0, r0, e1, r1}; GATE[m] = (f32x2){g0, g1v}; }
    }
    __syncthreads();
    if (F.tid < 32) BCNT[F.vcu * 32 + F.tid] = cnt[F.tid];
}
__device__ __forceinline__ void p_scatter(Frame& F) {
    const int* BCNT = (const int*)(F.ws + WS_BCNT); int* PANEL = (int*)(F.ws + WS_PANEL); const i32x4* ROUTE = (const i32x4*)(F.ws + WS_ROUTE); i32x2* POS = (i32x2*)(F.ws + WS_POS);
    const bf16* H1B = (const bf16*)(F.ws + WS_H1B); bf16* XS = (bf16*)(F.ws + WS_R1);
    LAS int* pa = (LAS int*)(F.lds + SMALL_OFF); LAS int* pb = pa + 512; LAS int* tot = pa + 1024; LAS int* bef = pa + 1056; LAS int* base = pa + 1088;
    __syncthreads();
    { const int e = F.tid & 31, part = F.tid >> 5; int sa = 0, sb = 0;
        for (int b = part; b < F.G; b += 16) { const int c = BCNT[b * 32 + e]; sa += c; if (b < F.vcu) sb += c; }
        pa[part * 32 + e] = sa; pb[part * 32 + e] = sb; }
    __syncthreads();
    if (F.tid < 32) { int sa = 0, sb = 0; for (int p = 0; p < 16; ++p) { sa += pa[p * 32 + F.tid]; sb += pb[p * 32 + F.tid]; } tot[F.tid] = sa; bef[F.tid] = sb; }
    __syncthreads();
    if (F.tid == 0) { int off = 0, np = 0;
        for (int e = 0; e < 32; ++e) { const int npan = (tot[e] + 255) >> 8; base[e] = off + bef[e];
            if (F.vcu == 0) for (int p = 0; p < npan; ++p) PANEL[1 + np + p] = e;
            np += npan; off += npan * 256; }
        if (F.vcu == 0) PANEL[0] = np; }
    __syncthreads();
    for (int m = F.gw; m < T; m += F.NGW) { const i32x4 r = ROUTE[m]; const int p0 = base[r.x] + r.y, p1 = base[r.z] + r.w;
        if (F.lane == 0) POS[m] = (i32x2){p0, p1};
        const v4u* src = (const v4u*)(H1B + (size_t)m * D); v4u* d0 = (v4u*)(XS + (size_t)p0 * D); v4u* d1 = (v4u*)(XS + (size_t)p1 * D);
#pragma unroll
        for (int jj = 0; jj < 2; ++jj) { const v4u w = src[F.lane + 64 * jj]; d0[F.lane + 64 * jj] = w; d1[F.lane + 64 * jj] = w; } }
}
__device__ __forceinline__ void p_combine(Frame& F, int layer) {
    const float* H1F = (const float*)(F.ws + WS_H1F); const bf16* EOUT = (const bf16*)(F.ws + WS_R1); const i32x2* POS = (const i32x2*)(F.ws + WS_POS); const f32x2* GATE = (const f32x2*)(F.ws + WS_GATE);
    float* HF = (float*)(F.ws + WS_HF); bf16* HB = (bf16*)(F.ws + WS_HB);
    const float* g2 = KIN(I_LN2G) + (size_t)layer * D; const float* b2 = KIN(I_LN2B) + (size_t)layer * D;
    for (int m = F.gw; m < T; m += F.NGW) { const i32x2 ps = POS[m]; const f32x2 gt = GATE[m];
        f32x4 v[4], ea[4], eb[4]; row_load(H1F + (size_t)m * D, F.lane, v); row_load_bf16(EOUT + (size_t)ps.x * D, F.lane, ea); row_load_bf16(EOUT + (size_t)ps.y * D, F.lane, eb);
#pragma unroll
        for (int jj = 0; jj < 4; ++jj) v[jj] = v[jj] * ALPHA + (ea[jj] * gt.x + eb[jj] * gt.y);
        row_layernorm(v, g2, b2, F.lane);
        if (layer == DEPTH - 1) row_store_f32(F.out + (size_t)m * D, F.lane, v);
        else { row_store_f32(HF + (size_t)m * D, F.lane, v); row_store_bf16(HB + (size_t)m * D, F.lane, v); row_gate_proj(F, v, layer + 1, m); } }
}
#ifndef PHASE_MASK
#define PHASE_MASK 0x1fff
#endif
#define PH_EN(k) (((PHASE_MASK) >> (k)) & 1)
#define IN(k) (lo <= (k) && (k) < hi)
#define SEAM(k) do { if ((k) + 1 < hi) xcd_barrier(bar); } while (0)
template <int LAYER> __device__ __forceinline__ void layer_body(Frame& F, const int lo, const int hi, const XcdBarrier& bar) {
        constexpr int layer = LAYER, pb = 1 + LAYER * NPH_LAYER, j = LAYER >> 1; constexpr bool odd = (LAYER & 1) != 0;
        bf16* HB = (bf16*)(F.ws + WS_HB); bf16* MIX = (bf16*)(F.ws + WS_MIX);
        const float* hin = layer == 0 ? KIN(I_X) : (const float*)(F.ws + WS_HF);
        if constexpr (PH_EN(0)) if (IN(pb + 0)) {
            const int N = odd ? NPO : NPE; const bf16* Bt = odd ? (const bf16*)(F.ws + WS_WINO) + (size_t)j * NPO * D : (const bf16*)(F.ws + WS_WINE) + (size_t)j * NPE * D;
            pg8::Gemm g{HB, Bt, T, N, D, 0}; pg8::StaticOrder S; S.init(T, N, F.G, (int)blockIdx.x);
            pg8::EpiStoreBf16 E{(bf16*)(F.ws + WS_R1), N};
            pg8::gemm_phase<pg8::EpiStoreBf16, pg8::StaticOrder, true, true>(F.lds, g, S, E);
            SEAM(pb + 0); }
        if constexpr (!odd) {
            if constexpr (PH_EN(1)) if (IN(pb + 1)) { e0_conv(F, j); SEAM(pb + 1); }
            if constexpr (PH_EN(2)) if (IN(pb + 2)) { e1_states(F, j); SEAM(pb + 2); }
            if constexpr (PH_EN(3)) if (IN(pb + 3)) { e2_scan(F); SEAM(pb + 3); }
            if constexpr (PH_EN(4)) if (IN(pb + 4)) { e3_output(F, j); SEAM(pb + 4); }
            if constexpr (PH_EN(5)) if (IN(pb + 5)) { e4_gnorm(F); SEAM(pb + 5); }
        } else {
            if constexpr (PH_EN(1)) if (IN(pb + 1)) { o_foxscan(F, j); o1_local(F, j); SEAM(pb + 1); }
            if constexpr (PH_EN(2)) if (IN(pb + 2)) { o2_scan(F); SEAM(pb + 2); }
            if constexpr (PH_EN(3)) if (IN(pb + 3)) { o3_output(F, j); SEAM(pb + 3); }
            if constexpr (PH_EN(4)) if (IN(pb + 4)) { o4_fox(F); SEAM(pb + 4); }
            if constexpr (PH_EN(5)) if (IN(pb + 5)) { SEAM(pb + 5); }
        }
        if constexpr (PH_EN(6)) if (IN(pb + 6)) {
            const int K = odd ? D : 1536; const bf16* Bt = odd ? (const bf16*)(F.ws + WS_WOUTO) + (size_t)j * D * D : (const bf16*)(F.ws + WS_WOUTE) + (size_t)j * D * 1536;
            pg8::Gemm g{MIX, Bt, T, D, K, 0}; pg8::StaticOrder S; S.init(T, D, F.G, (int)blockIdx.x);
            pg8::EpiStoreF32 E{(float*)(F.ws + WS_R1), D};
            pg8::gemm_phase<pg8::EpiStoreF32, pg8::StaticOrder, false, true>(F.lds, g, S, E);
            SEAM(pb + 6); }
        if constexpr (PH_EN(7)) if (IN(pb + 7)) { p_ln1_route(F, layer, hin); SEAM(pb + 7); }
        if constexpr (PH_EN(8)) if (IN(pb + 8)) { p_scatter(F); SEAM(pb + 8); }
        if constexpr (PH_EN(9)) if (IN(pb + 9)) {
            pg8::Gemm g{(const bf16*)(F.ws + WS_R1), (const bf16*)(F.ws + WS_WGU) + (size_t)layer * 32 * D * D, RPAD, D, D, (size_t)D * D * 2};
            pg8::MoeOrder S; S.initm((const int*)(F.ws + WS_PANEL), 4, F.G, (int)blockIdx.x);
            pg8::EpiSwiglu E{(bf16*)(F.ws + WS_R3), 512};
            pg8::gemm_phase<pg8::EpiSwiglu, pg8::MoeOrder, true, true>(F.lds, g, S, E);
            SEAM(pb + 9); }
        if constexpr (PH_EN(10)) if (IN(pb + 10)) {
            pg8::Gemm g{(const bf16*)(F.ws + WS_R3), (const bf16*)(F.ws + WS_WD) + (size_t)layer * 32 * D * 512, RPAD, D, 512, (size_t)D * 512 * 2};
            pg8::MoeOrder S; S.initm((const int*)(F.ws + WS_PANEL), 4, F.G, (int)blockIdx.x);
            pg8::EpiStoreBf16 E{(bf16*)(F.ws + WS_R1), D};
            pg8::gemm_phase<pg8::EpiStoreBf16, pg8::MoeOrder, true, true>(F.lds, g, S, E);
            SEAM(pb + 10); }
        if constexpr (PH_EN(11)) if (IN(pb + 11)) { p_combine(F, layer); SEAM(pb + 11); }
}
struct Args { const float* in[27]; float* out; unsigned char* ws; int ph_lo, ph_hi; };
__global__ void __launch_bounds__(NWAVES * 64, 2) fwd_kernel(Args args) {
    extern __shared__ __attribute__((aligned(16))) unsigned char lds[];
    Frame F;
    F.lds = (LAS unsigned char*)lds;
    F.MISC = (volatile LAS unsigned*)(F.lds + MISC_OFF);
    F.tid = threadIdx.x; F.lane = F.tid & 63; F.wave = __builtin_amdgcn_readfirstlane(F.tid >> 6);
    F.G = gridDim.x; { const int bx = blockIdx.x; F.vcu = (F.G % 8 == 0) ? (bx % 8) * (F.G / 8) + bx / 8 : bx; }
    F.gw = F.vcu * NWAVES + F.wave; F.NGW = F.G * NWAVES;
    F.out = args.out; F.ws = args.ws; F.ctl = (unsigned*)(args.ws + WS_CTL);
    const int lo = args.ph_lo, hi = args.ph_hi;
    for (int u = F.tid; u < (LDS_BYTES - MISC_OFF) / 4; u += NWAVES * 64) ((LAS unsigned*)(F.lds + MISC_OFF))[u] = 0u;
    __syncthreads();
    XcdBarrier bar; bar.bar = F.ctl + CW_BAR; bar.x = 0; bar.st = nullptr;
    if (hi - lo > 1) bar = xcd_barrier_post(F.ctl + CW_BAR, F.MISC + 8);
    if constexpr (PH_EN(12)) if (IN(0)) { p_prologue(F); SEAM(0); }
    layer_body<0>(F, lo, hi, bar); layer_body<1>(F, lo, hi, bar); layer_body<2>(F, lo, hi, bar); layer_body<3>(F, lo, hi, bar);
#undef IN
#undef SEAM
}

extern "C" void kernel_launch(void* const* d_in, const int* in_sizes, int n_in, void* d_out, int out_size, void* d_ws, size_t ws_size, hipStream_t stream) {
    static int grid = 0;
    if (grid == 0) {
        if (n_in != 27 || in_sizes[0] != T * D || out_size != T * D || ws_size < WS_END) { fprintf(stderr, "kernel_launch: unexpected shapes (n_in %d, in0 %d, out %d, ws %zu); nothing launched\n", n_in, n_in > 0 ? in_sizes[0] : -1, out_size, ws_size); grid = -1; return; }
        int dev = 0, cus = 0, per_cu = 0;
        if (hipGetDevice(&dev) != hipSuccess || hipDeviceGetAttribute(&cus, hipDeviceAttributeMultiprocessorCount, dev) != hipSuccess) { grid = -1; return; }
        if (hipFuncSetAttribute((const void*)fwd_kernel, hipFuncAttributeMaxDynamicSharedMemorySize, LDS_BYTES) != hipSuccess) { fprintf(stderr, "kernel_launch: hipFuncSetAttribute failed\n"); grid = -1; return; }
        if (hipOccupancyMaxActiveBlocksPerMultiprocessor(&per_cu, (const void*)fwd_kernel, NWAVES * 64, LDS_BYTES) != hipSuccess || per_cu < 1) fprintf(stderr, "kernel_launch: note: occupancy query reports %d workgroups per CU\n", per_cu);
        (void)hipGetLastError();
        grid = cus;
    }
    if (grid < 0) return;
    if (hipMemsetAsync((char*)d_ws + WS_CTL, 0, CTL_ZERO_BYTES, stream) != hipSuccess) return;
    Args a{};
    for (int i = 0; i < 27; ++i) a.in[i] = (const float*)d_in[i];
    a.out = (float*)d_out; a.ws = (unsigned char*)d_ws;
#if MK_ONE_LAUNCH
    a.ph_lo = 0; a.ph_hi = NPHASES;
    hipLaunchKernelGGL(fwd_kernel, dim3(grid), dim3(NWAVES * 64), LDS_BYTES, stream, a);
#else
    for (int ph = 0; ph < NPHASES; ++ph) {
        if (ph > 0 && (((ph - 1) / NPH_LAYER) & 1) && ((ph - 1) % NPH_LAYER) == 5) continue;
        a.ph_lo = ph; a.ph_hi = ph + 1;
        hipLaunchKernelGGL(fwd_kernel, dim3(grid), dim3(NWAVES * 64), LDS_BYTES, stream, a);
    }
#endif
}
```

```cpp
#include <hip/hip_runtime.h>
#include <cstdio>
#include <cstdint>
__device__ __forceinline__ float silu_f(float x) { return x / (1.0f + __expf(-x)); }
namespace pg8 {
#define PG8_LAS __attribute__((address_space(3)))
typedef unsigned short bf16_t;
typedef short bf16x8 __attribute__((ext_vector_type(8)));
typedef float f32x4 __attribute__((ext_vector_type(4)));
typedef unsigned u32x4 __attribute__((ext_vector_type(4)));
constexpr int BM = 256, BK = 64, HALF = 128, HTB = HALF * BK * 2  , STAGE_BYTES = 8 * HTB, NXCD = 8, WGM = 8;

__host__ __device__ __forceinline__ int lds_byte(int r, int c) { const int st = (r >> 4) * 2 + (c >> 5), rr = r & 15, cc = c & 31, ob = rr * 64 + cc * 2; return st * 1024 + (ob ^ (((ob >> 9) & 1) << 5)); }
__host__ __device__ __forceinline__ void stage_rc(int b, int& R, int& C) { const int st = b / 1024, sb = b % 1024, swz = sb ^ (((sb >> 9) & 1) << 5); R = (st >> 1) * 16 + swz / 64; C = (st & 1) * 32 + (swz % 64) / 2; }
__host__ __device__ __forceinline__ int perm32(int rho) { const int n = rho >> 4, i = rho & 15; return 8 * (i >> 2) + 4 * n + (i & 3); }

struct Unit { int pm, pn, be; };
struct Gemm { const bf16_t* A; const bf16_t* Bt; int M, N, K; size_t bstride; };

struct StaticOrder {
    int nM, nN, nwg, G, c;
    __host__ __device__ void init(int M, int N, int G_, int c_) { nM = M / BM; nN = N / BM; nwg = nM * nN; G = G_; c = c_; }
    __host__ __device__ bool next(int i, Unit& u) const {
        const long L = (long)i * G + c; if (L >= nwg) return false;
        int wgid = (int)L; { const int q = nwg / NXCD, r = nwg % NXCD, xcd = wgid % NXCD, off = wgid / NXCD; wgid = (xcd < r ? xcd * (q + 1) : r * (q + 1) + (xcd - r) * q) + off; }
        const int nig = WGM * nN, gid = wgid / nig, fm = gid * WGM, gsz = (nM - fm) < WGM ? (nM - fm) : WGM;
        u.pm = fm + ((wgid % nig) % gsz); u.pn = (wgid % nig) / gsz; u.be = 0; return true;
    }
    __device__ __forceinline__ void a_ready(const Unit&) const {}
    __device__ __forceinline__ void done(const Unit&) const {}
};

__device__ __forceinline__ unsigned cvt_pk_bf16(float lo, float hi) { unsigned r; asm volatile("v_cvt_pk_bf16_f32 %0, %1, %2" : "=v"(r) : "v"(lo), "v"(hi)); return r; }
struct EpiStoreBf16 {
    static constexpr bool PERM = true, AFTER_DRAIN = false;
    bf16_t* O; int ldc;
    __device__ __forceinline__ void operator()(const f32x4 (&acc)[2][2][4][2], const Unit& u, int wr, int wc, int fr, int fq) const {
        const int row0 = u.pm * BM + wr * 64 + fr, col0 = u.pn * BM + wc * 32 + 8 * fq;
#pragma unroll
        for (int ai = 0; ai < 2; ++ai)
#pragma unroll
            for (int m = 0; m < 4; ++m) { bf16_t* rowp = O + (size_t)(row0 + ai * HALF + m * 16) * ldc + col0;
#pragma unroll
                for (int bj = 0; bj < 2; ++bj) { const f32x4 v0 = acc[ai][bj][m][0], v1 = acc[ai][bj][m][1];
                    u32x4 w; w.x = cvt_pk_bf16(v0[0], v0[1]); w.y = cvt_pk_bf16(v0[2], v0[3]); w.z = cvt_pk_bf16(v1[0], v1[1]); w.w = cvt_pk_bf16(v1[2], v1[3]);
                    *(u32x4*)(rowp + bj * HALF) = w; } }
    }
};
struct EpiStoreF32 {
    static constexpr bool PERM = false, AFTER_DRAIN = false;
    float* C; int ldc;
    __device__ __forceinline__ void operator()(const f32x4 (&acc)[2][2][4][2], const Unit& u, int wr, int wc, int fr, int fq) const {
        const int row0 = u.pm * BM + wr * 64 + fr, col0 = u.pn * BM + wc * 32 + 4 * fq;
#pragma unroll
        for (int ai = 0; ai < 2; ++ai)
#pragma unroll
            for (int m = 0; m < 4; ++m) { float* rowp = C + (size_t)(row0 + ai * HALF + m * 16) * ldc + col0;
#pragma unroll
                for (int bj = 0; bj < 2; ++bj)
#pragma unroll
                    for (int n = 0; n < 2; ++n) *(f32x4*)(rowp + bj * HALF + n * 16) = acc[ai][bj][m][n]; }
    }
};
struct EpiSwiglu {
    static constexpr bool PERM = true, AFTER_DRAIN = false;
    bf16_t* O; int ldc;
    __device__ __forceinline__ void operator()(const f32x4 (&acc)[2][2][4][2], const Unit& u, int wr, int wc, int fr, int fq) const {
        const int row0 = u.pm * BM + wr * 64 + fr, col0 = u.pn * HALF + wc * 32 + 8 * fq;
#pragma unroll
        for (int ai = 0; ai < 2; ++ai)
#pragma unroll
            for (int m = 0; m < 4; ++m) { bf16_t* rowp = O + (size_t)(row0 + ai * HALF + m * 16) * ldc + col0;
                const f32x4 g0 = acc[ai][0][m][0], g1 = acc[ai][0][m][1], u0 = acc[ai][1][m][0], u1 = acc[ai][1][m][1];
                float h[8];
#pragma unroll
                for (int i = 0; i < 4; ++i) { h[i] = silu_f(g0[i]) * u0[i]; h[4 + i] = silu_f(g1[i]) * u1[i]; }
                u32x4 w; w.x = cvt_pk_bf16(h[0], h[1]); w.y = cvt_pk_bf16(h[2], h[3]); w.z = cvt_pk_bf16(h[4], h[5]); w.w = cvt_pk_bf16(h[6], h[7]);
                *(u32x4*)rowp = w; }
    }
};
struct MoeOrder : StaticOrder {
    const int* tab;
    __device__ __forceinline__ void initm(const int* tab_, int nN_, int G_, int c_) { tab = tab_; nM = tab_[0]; nN = nN_; nwg = nM * nN; G = G_; c = c_; }
    __device__ __forceinline__ bool next(int i, Unit& u) const { if (!StaticOrder::next(i, u)) return false; u.be = tab[1 + u.pm]; return true; }
};
template <class Epi, class Sched, bool ALIGN_EPI = false, bool SP2 = false>
__device__ __forceinline__ void gemm_phase(PG8_LAS unsigned char* lds, const Gemm g, const Sched& S, const Epi& E) {
    const int tid = threadIdx.x, wid = __builtin_amdgcn_readfirstlane(tid >> 6), lane = tid & 63, wr = wid >> 2, wc = wid & 3, fr = lane & 15, fq = lane >> 4;
    const int K = g.K, nt = K / BK;
    unsigned voffA[2], voffB[2];
#pragma unroll
    for (int i = 0; i < 2; ++i) { int R, C; stage_rc(tid * 16 + i * 8192, R, C); const int Rb = Epi::PERM ? ((R & ~31) + perm32(R & 31)) : R;
        voffA[i] = (unsigned)(R * K + C) * 2u; voffB[i] = (unsigned)(Rb * K + C) * 2u; }
    const size_t kstep = (size_t)(BK * 2);
    const size_t hstep = (size_t)HALF * K * 2;
    const size_t tstep = 2 * hstep;
    const unsigned ldsw = (unsigned)wid * 1024u;
    const int aoff = lds_byte(wr * 64 + fr, fq * 8), boff = lds_byte(wc * 32 + fr, fq * 8);
#define PG8_SA(b, h) (((b) * 2 + (h)) * HTB)
#define PG8_SB(b, h) ((4 + (b) * 2 + (h)) * HTB)
#define PG8_STAGE(bufoff, gbase, voff) do { _Pragma("unroll") for (int _i = 0; _i < 2; ++_i) \
        __builtin_amdgcn_global_load_lds((const unsigned*)((const char*)(gbase) + (voff)[_i]), (PG8_LAS unsigned*)(lds + (bufoff) + ldsw + _i * 8192), 16, 0, 0); } while (0)
#define PG8_LDA(dst, b, h) do { _Pragma("unroll") for (int m = 0; m < 4; ++m) _Pragma("unroll") for (int k = 0; k < 2; ++k) dst[m][k] = *(const PG8_LAS bf16x8*)(lds + PG8_SA(b, h) + aoff + m * 2048 + k * 1024); } while (0)
#define PG8_LDB(dst, b, h) do { _Pragma("unroll") for (int n = 0; n < 2; ++n) _Pragma("unroll") for (int k = 0; k < 2; ++k) dst[n][k] = *(const PG8_LAS bf16x8*)(lds + PG8_SB(b, h) + boff + n * 2048 + k * 1024); } while (0)
#define PG8_MMA(ai, bj, At, Bt) do { __builtin_amdgcn_s_setprio(1); _Pragma("unroll") for (int m = 0; m < 4; ++m) _Pragma("unroll") for (int n = 0; n < 2; ++n) _Pragma("unroll") for (int k = 0; k < 2; ++k) \
        acc[ai][bj][m][n] = __builtin_amdgcn_mfma_f32_16x16x32_bf16(Bt[n][k], At[m][k], acc[ai][bj][m][n], 0, 0, 0); __builtin_amdgcn_s_setprio(0); } while (0)
#define PG8_WAIT_V(n) asm volatile("s_waitcnt vmcnt(" #n ")" ::: "memory")
#define PG8_WAIT_L(n) asm volatile("s_waitcnt lgkmcnt(" #n ")" ::: "memory")
#define PG8_BAR __builtin_amdgcn_s_barrier()
#define PG8_SCHED __builtin_amdgcn_sched_barrier(0)
    Unit cur, nxt; int ui = 0;
    if (!S.next(0, cur)) return;
    f32x4 acc[2][2][4][2];
#pragma unroll
    for (int a = 0; a < 2; ++a)
#pragma unroll
        for (int b = 0; b < 2; ++b)
#pragma unroll
            for (int m = 0; m < 4; ++m)
#pragma unroll
                for (int n = 0; n < 2; ++n) acc[a][b][m][n] = (f32x4){0.f, 0.f, 0.f, 0.f};
    bf16x8 At[4][2], B0[2][2], B1[2][2];
    const char* cA = (const char*)g.A + (size_t)cur.pm * tstep; const char* cB = (const char*)g.Bt + (size_t)cur.be * g.bstride + (size_t)cur.pn * tstep;
    S.a_ready(cur);
    if constexpr (SP2) {
        PG8_STAGE(PG8_SB(0, 0), cB, voffB); PG8_STAGE(PG8_SB(0, 1), cB + hstep, voffB); PG8_STAGE(PG8_SA(0, 0), cA, voffA); PG8_STAGE(PG8_SA(0, 1), cA + hstep, voffA);
        if (wr == 1) PG8_BAR;
        PG8_WAIT_V(2); PG8_BAR;
        PG8_STAGE(PG8_SB(1, 0), cB + kstep, voffB); PG8_STAGE(PG8_SA(1, 0), cA + kstep, voffA); PG8_STAGE(PG8_SB(1, 1), cB + hstep + kstep, voffB);
        PG8_WAIT_V(6); PG8_BAR;
    } else {
        PG8_STAGE(PG8_SB(0, 0), cB, voffB); PG8_STAGE(PG8_SA(0, 0), cA, voffA); PG8_STAGE(PG8_SB(0, 1), cB + hstep, voffB); PG8_STAGE(PG8_SA(0, 1), cA + hstep, voffA);
        if (wr == 1) PG8_BAR;
        PG8_WAIT_V(4); PG8_BAR;
        PG8_STAGE(PG8_SB(1, 0), cB + kstep, voffB); PG8_STAGE(PG8_SA(1, 0), cA + kstep, voffA); PG8_STAGE(PG8_SB(1, 1), cB + hstep + kstep, voffB);
        PG8_WAIT_V(6); PG8_BAR;
    }
    for (;;) {
        const bool has_next = S.next(ui + 1, nxt);
        const char* nA = has_next ? (const char*)g.A + (size_t)nxt.pm * tstep : cA; const char* nB = has_next ? (const char*)g.Bt + (size_t)nxt.be * g.bstride + (size_t)nxt.pn * tstep : cB;
        for (int t = 0; t < nt; t += 2) {
            const bool last = (t == nt - 2);
            const char* a1 = cA + (size_t)(t + 1) * kstep;
            const char* a2 = last ? nA : cA + (size_t)(t + 2) * kstep; const char* b2 = last ? nB : cB + (size_t)(t + 2) * kstep;
            const char* a3 = a2 + kstep; const char* b3 = b2 + kstep;
            if (last && has_next) S.a_ready(nxt);
            if constexpr (SP2) {
            PG8_LDB(B0, 0, 0); PG8_LDB(B1, 0, 1); PG8_SCHED; PG8_LDA(At, 0, 0); PG8_STAGE(PG8_SA(1, 1), a1 + hstep, voffA);
            PG8_WAIT_V(8); PG8_WAIT_L(0); PG8_BAR; PG8_MMA(0, 0, At, B0); PG8_MMA(0, 1, At, B1); PG8_BAR; PG8_SCHED;
            PG8_LDA(At, 0, 1); PG8_STAGE(PG8_SB(0, 0), b2, voffB); PG8_STAGE(PG8_SB(0, 1), b2 + hstep, voffB); PG8_STAGE(PG8_SA(0, 0), a2, voffA);
            PG8_WAIT_V(8); PG8_WAIT_L(0); PG8_BAR; PG8_MMA(1, 0, At, B0); PG8_MMA(1, 1, At, B1); PG8_BAR; PG8_SCHED;
            PG8_LDB(B0, 1, 0); PG8_LDB(B1, 1, 1); PG8_SCHED; PG8_LDA(At, 1, 0); PG8_STAGE(PG8_SA(0, 1), a2 + hstep, voffA);
            PG8_WAIT_V(8); PG8_WAIT_L(0); PG8_BAR; PG8_MMA(0, 0, At, B0); PG8_MMA(0, 1, At, B1); PG8_BAR; PG8_SCHED;
            PG8_LDA(At, 1, 1); PG8_STAGE(PG8_SB(1, 0), b3, voffB); PG8_STAGE(PG8_SB(1, 1), b3 + hstep, voffB); PG8_STAGE(PG8_SA(1, 0), a3, voffA);
            PG8_WAIT_V(8); PG8_WAIT_L(0); PG8_BAR; PG8_MMA(1, 0, At, B0); PG8_MMA(1, 1, At, B1); PG8_BAR; PG8_SCHED;
            } else {
            PG8_LDB(B0, 0, 0); PG8_SCHED; PG8_LDA(At, 0, 0); PG8_STAGE(PG8_SA(1, 1), a1 + hstep, voffA);
            PG8_WAIT_L(8); PG8_BAR; PG8_WAIT_L(0); PG8_MMA(0, 0, At, B0); PG8_BAR; PG8_SCHED;
            PG8_LDB(B1, 0, 1); PG8_STAGE(PG8_SB(0, 0), b2, voffB);
            PG8_BAR; PG8_WAIT_L(0); PG8_MMA(0, 1, At, B1); PG8_BAR;
            PG8_LDA(At, 0, 1); PG8_STAGE(PG8_SA(0, 0), a2, voffA);
            PG8_BAR; PG8_WAIT_L(0); PG8_MMA(1, 0, At, B0); PG8_BAR; PG8_SCHED;
            PG8_STAGE(PG8_SB(0, 1), b2 + hstep, voffB);
            PG8_WAIT_V(6); PG8_BAR; PG8_MMA(1, 1, At, B1); PG8_BAR;
            PG8_LDB(B0, 1, 0); PG8_SCHED; PG8_LDA(At, 1, 0); PG8_STAGE(PG8_SA(0, 1), a2 + hstep, voffA);
            PG8_WAIT_L(8); PG8_BAR; PG8_WAIT_L(0); PG8_MMA(0, 0, At, B0); PG8_BAR; PG8_SCHED;
            PG8_LDB(B1, 1, 1); PG8_STAGE(PG8_SB(1, 0), b3, voffB);
            PG8_BAR; PG8_WAIT_L(0); PG8_MMA(0, 1, At, B1); PG8_BAR;
            PG8_LDA(At, 1, 1); PG8_STAGE(PG8_SA(1, 0), a3, voffA);
            PG8_BAR; PG8_WAIT_L(0); PG8_MMA(1, 0, At, B0); PG8_BAR; PG8_SCHED;
            PG8_STAGE(PG8_SB(1, 1), b3 + hstep, voffB);
            PG8_WAIT_V(6); PG8_BAR; PG8_MMA(1, 1, At, B1); PG8_BAR;
            }
        }
        if constexpr (ALIGN_EPI) { if (wr == 0) PG8_BAR; }
        if constexpr (!Epi::AFTER_DRAIN) { E(acc, cur, wr, wc, fr, fq); S.done(cur); }
        if (!has_next) break;
#pragma unroll
        for (int a = 0; a < 2; ++a)
#pragma unroll
            for (int b = 0; b < 2; ++b)
#pragma unroll
                for (int m = 0; m < 4; ++m)
#pragma unroll
                    for (int n = 0; n < 2; ++n) acc[a][b][m][n] = (f32x4){0.f, 0.f, 0.f, 0.f};
        cur = nxt; cA = nA; cB = nB; ++ui;
        if constexpr (ALIGN_EPI) { if (wr == 1) PG8_BAR; }
    }
    PG8_WAIT_V(0);
    if constexpr (!ALIGN_EPI) { if (wr == 0) PG8_BAR; }
    PG8_BAR;
    if constexpr (Epi::AFTER_DRAIN) { E.fused(acc, cur, wr, wc, fr, fq, lds, wid, lane); S.done(cur); }
#undef PG8_SA
#undef PG8_SB
#undef PG8_STAGE
#undef PG8_LDA
#undef PG8_LDB
#undef PG8_MMA
#undef PG8_WAIT_V
#undef PG8_WAIT_L
#undef PG8_BAR
#undef PG8_SCHED
}
}
constexpr int NWAVES = 8;
constexpr int T = 16384, D = 1024, SEQ = 2048, NBATCH = 8, DEPTH = 4;
constexpr float ALPHA = 1.6817928305074290f;
constexpr float LN_EPS = 1e-5f;
constexpr int AB_IN = 4112, CD_IN = 3600, NPE = 4096, NPO = 3584;
constexpr float LOG2E = 1.4426950408889634f;
constexpr float FOX_C2 = 0.125f * LOG2E;
constexpr float MLSTM_KSCALE = 0.08838834764831845f;
constexpr int RPAD = 40960;
constexpr int NPH_LAYER = 12, NPHASES = 1 + DEPTH * NPH_LAYER;
#ifndef MK_ONE_LAUNCH
#define MK_ONE_LAUNCH 1
#endif

constexpr size_t MiB = 1u << 20, KiB = 1u << 10;
constexpr size_t WS_CTL = 0, CTL_ZERO_BYTES = 1 * MiB;
constexpr size_t WS_BCNT = 1 * MiB, WS_PANEL = WS_BCNT + 64 * KiB, WS_ROUTE = WS_BCNT + 128 * KiB, WS_GATE = WS_BCNT + 384 * KiB, WS_POS = WS_BCNT + 512 * KiB,
                 WS_DEC = WS_BCNT + 640 * KiB, WS_MLOC = WS_BCNT + 704 * KiB, WS_BLAST = WS_BCNT + 712 * KiB, WS_MPREV = WS_BCNT + 720 * KiB,
                 WS_FOXC = 2 * MiB, WS_NLOC = 2 * MiB + 512 * KiB, WS_SG = 3 * MiB;
constexpr size_t WS_WINE = 4 * MiB, WS_WINO = 20 * MiB, WS_WOUTE = 34 * MiB, WS_WOUTO = 40 * MiB, WS_WGU = 44 * MiB, WS_WD = 300 * MiB;
constexpr size_t WS_HF = 428 * MiB, WS_HB = 492 * MiB, WS_H1F = 524 * MiB, WS_H1B = 588 * MiB;
constexpr size_t WS_R1 = 620 * MiB;
constexpr size_t WS_R2 = 748 * MiB;
constexpr size_t WS_R3 = 812 * MiB;
constexpr size_t WS_R4 = 860 * MiB;
constexpr size_t WS_MIX = 892 * MiB, WS_END = 940 * MiB;
constexpr int CW_BAR = 4096;

constexpr int RING_BYTES = 131072, SMALL_OFF = RING_BYTES, SMALL_BYTES = 8192, MISC_OFF = SMALL_OFF + SMALL_BYTES, LDS_BYTES = 147456;

#define GAS __attribute__((address_space(1)))
#define LAS __attribute__((address_space(3)))
typedef unsigned short bf16;
typedef unsigned v4u __attribute__((ext_vector_type(4)));
typedef unsigned v2u __attribute__((ext_vector_type(2)));
typedef float f32x4 __attribute__((ext_vector_type(4)));
typedef float f32x2 __attribute__((ext_vector_type(2)));
typedef int i32x4 __attribute__((ext_vector_type(4)));
typedef int i32x2 __attribute__((ext_vector_type(2)));
#define LDS_WAIT() asm volatile("s_waitcnt lgkmcnt(0)" ::: "memory")
__device__ __forceinline__ unsigned f2bf(float f) { unsigned u = __builtin_bit_cast(unsigned, f); return (u + 0x7fffu + ((u >> 16) & 1u)) >> 16; }
__device__ __forceinline__ unsigned pk2(float lo, float hi) { return f2bf(lo) | (f2bf(hi) << 16); }
__device__ __forceinline__ float bflo(unsigned w) { return __builtin_bit_cast(float, w << 16); }
__device__ __forceinline__ float bfhi(unsigned w) { return __builtin_bit_cast(float, w & 0xffff0000u); }
__device__ __forceinline__ float bf2f(bf16 b) { return __builtin_bit_cast(float, (unsigned)b << 16); }
__device__ __forceinline__ float wave_sum(float v) {
#pragma unroll
    for (int o = 1; o < 64; o <<= 1) v += __shfl_xor(v, o);
    return v;
}
__device__ __forceinline__ float wave_max(float v) {
#pragma unroll
    for (int o = 1; o < 64; o <<= 1) v = fmaxf(v, __shfl_xor(v, o));
    return v;
}
__device__ __forceinline__ float wave_scan_sum(float v, int lane) {
#pragma unroll
    for (int o = 1; o < 64; o <<= 1) { const float t = __shfl_up(v, o); if (lane >= o) v += t; }
    return v;
}
__device__ __forceinline__ float wave_scan_max(float v, int lane) {
#pragma unroll
    for (int o = 1; o < 64; o <<= 1) { const float t = __shfl_up(v, o); if (lane >= o) v = fmaxf(v, t); }
    return v;
}
__device__ __forceinline__ float softplus_f(float x) { return x > 20.f ? x : log1pf(expf(x)); }
__device__ __forceinline__ float logsigmoid_f(float x) { return fminf(x, 0.f) - log1pf(expf(-fabsf(x))); }
__device__ __forceinline__ float sigmoid_f(float x) { return 1.0f / (1.0f + expf(-x)); }
#define XB_TMO      128
#define XB_XCNT(j)  (256  + 64 * (j))
#define XB_XSUB(j)  (1280 + 64 * (j))
#define XB_XGEN(j)  (2304 + 64 * (j))
#define XB_TOP      3328
#define XB_TOPGEN   3392
#define XCD_BAR_WORDS 3456
#define XB_SPIN_CAP (1u << 18)

__device__ __forceinline__ unsigned xb_ld(unsigned* p)              { return __hip_atomic_load(p, __ATOMIC_RELAXED, __HIP_MEMORY_SCOPE_AGENT); }
__device__ __forceinline__ unsigned xb_add(unsigned* p, unsigned v) { return __hip_atomic_fetch_add(p, v, __ATOMIC_RELAXED, __HIP_MEMORY_SCOPE_AGENT); }
__device__ __forceinline__ unsigned xb_xcc_id() { return (unsigned)__builtin_amdgcn_s_getreg((3 << 11) | 20) & 0xFu; }
#define XB_SPIN(cond, bar) do { unsigned _sp = 0; while (cond) { __builtin_amdgcn_s_sleep(1); \
    if ((++_sp & 255u) == 0u) { if (xb_ld(&(bar)[XB_TMO])) break; if (_sp > XB_SPIN_CAP) { atomicAdd(&(bar)[XB_TMO], 1u); break; } } } } while (0)

struct XcdBarrier {
    unsigned* bar; unsigned x;
    volatile LAS unsigned* st;
};

__device__ __forceinline__ XcdBarrier xcd_barrier_post(unsigned* bar, volatile LAS unsigned* st) {
    XcdBarrier b; b.bar = bar; b.x = xb_xcc_id(); b.st = st;
    if (threadIdx.x == 0) (void)xb_add(&bar[XB_XCNT(b.x)], 1u);
    return b;
}
__device__ __forceinline__ void xcd_barrier_complete(unsigned* bar, unsigned x, unsigned& nloc, unsigned& nx) {
    const unsigned G = gridDim.x * gridDim.y * gridDim.z;
    unsigned sum, cnt, mine, sp = 0u;
    for (;;) {
        sum = 0u; cnt = 0u; mine = 0u;
#pragma unroll
        for (unsigned j = 0; j < 16; ++j) { const unsigned c = xb_ld(&bar[XB_XCNT(j)]); sum += c; cnt += (c > 0u) ? 1u : 0u; mine = (j == x) ? c : mine; }
        if (sum == G) break;
        __builtin_amdgcn_s_sleep(1);
        if ((++sp & 255u) == 0u) { if (xb_ld(&bar[XB_TMO])) break; if (sp > XB_SPIN_CAP) { atomicAdd(&bar[XB_TMO], 1u); break; } }
    }
    nloc = mine > 0u ? mine : 1u; nx = cnt > 0u ? cnt : 1u;
}

__device__ __forceinline__ void xcd_barrier(const XcdBarrier& b) {
    asm volatile("s_waitcnt vmcnt(0)" ::: "memory");
    __syncthreads();
    if (threadIdx.x == 0) {
        unsigned* bar = b.bar;
        __builtin_amdgcn_s_waitcnt(0);
        unsigned nloc = b.st[0], nx = b.st[1];
        if (nloc == 0u) { xcd_barrier_complete(bar, b.x, nloc, nx); b.st[0] = nloc; b.st[1] = nx; }
        const unsigned old = xb_add(&bar[XB_XSUB(b.x)], 1u);
        const unsigned gen = old / nloc;
        if (old + 1u == (gen + 1u) * nloc) {
            __builtin_amdgcn_fence(__ATOMIC_RELEASE, "agent");
            asm volatile("s_waitcnt vmcnt(0)" ::: "memory");
            const unsigned og = xb_add(&bar[XB_TOP], 1u);
            const unsigned tg = og / nx;
            if (og + 1u == (tg + 1u) * nx) xb_add(&bar[XB_TOPGEN], 1u);
            else XB_SPIN(xb_ld(&bar[XB_TOPGEN]) == tg, bar);
            __builtin_amdgcn_fence(__ATOMIC_ACQUIRE, "agent");
            xb_add(&bar[XB_XGEN(b.x)], 1u);
            asm volatile("s_waitcnt vmcnt(0)" ::: "memory");
        } else {
            XB_SPIN(xb_ld(&bar[XB_XGEN(b.x)]) == gen, bar);
            __builtin_amdgcn_fence(__ATOMIC_ACQUIRE, "agent");
            asm volatile("s_waitcnt vmcnt(0)" ::: "memory");
        }
    }
    __syncthreads();
}
struct Frame {
    LAS unsigned char* lds;
    volatile LAS unsigned* MISC;
    unsigned* ctl;
    int tid, lane, wave, vcu, G, gw, NGW;
    float* out; unsigned char* ws;
};
typedef const float* const cfpc_t; typedef __attribute__((address_space(4))) cfpc_t* kargp_t;
__device__ __forceinline__ kargp_t kin() { kargp_t p = (kargp_t)__builtin_amdgcn_kernarg_segment_ptr(); asm volatile("" : "+s"(p)); return p; }
#define KIN(i) (kin()[i])
enum { I_X = 0, I_ABWIN, I_CONVA, I_CONVW, I_CONVB, I_DTB, I_ALOG, I_DSKIP, I_NORMW, I_ABWOUT, I_CDWIN, I_IB, I_FB, I_HNW, I_FOXB, I_CDWOUT, I_LN1G, I_LN1B, I_LN2G, I_LN2B,
       I_RGW, I_RGB, I_REW, I_REB, I_WG, I_WU, I_WDN };

__device__ __forceinline__ void row_load(const float* row, int lane, f32x4 (&v)[4]) {
#pragma unroll
    for (int j = 0; j < 4; ++j) v[j] = ((const f32x4*)row)[lane + 64 * j];
}
__device__ __forceinline__ void row_store_f32(float* row, int lane, const f32x4 (&v)[4]) {
#pragma unroll
    for (int j = 0; j < 4; ++j) ((f32x4*)row)[lane + 64 * j] = v[j];
}
__device__ __forceinline__ void row_store_bf16(bf16* row, int lane, const f32x4 (&v)[4]) {
#pragma unroll
    for (int j = 0; j < 4; ++j) { v2u w; w.x = pk2(v[j][0], v[j][1]); w.y = pk2(v[j][2], v[j][3]); ((v2u*)row)[lane + 64 * j] = w; }
}
__device__ __forceinline__ void row_load_bf16(const bf16* row, int lane, f32x4 (&v)[4]) {
#pragma unroll
    for (int j = 0; j < 4; ++j) { const v2u w = ((const v2u*)row)[lane + 64 * j]; v[j] = (f32x4){bflo(w.x), bfhi(w.x), bflo(w.y), bfhi(w.y)}; }
}
__device__ __forceinline__ void row_layernorm(f32x4 (&v)[4], const float* g, const float* b, int lane) {
    float s = 0.f;
#pragma unroll
    for (int j = 0; j < 4; ++j) s += (v[j][0] + v[j][1]) + (v[j][2] + v[j][3]);
    const float mean = wave_sum(s) * (1.f / D); float s2 = 0.f;
#pragma unroll
    for (int j = 0; j < 4; ++j) { v[j] = v[j] - mean; s2 += (v[j][0] * v[j][0] + v[j][1] * v[j][1]) + (v[j][2] * v[j][2] + v[j][3] * v[j][3]); }
    const float rstd = 1.0f / sqrtf(wave_sum(s2) * (1.f / D) + LN_EPS);
#pragma unroll
    for (int j = 0; j < 4; ++j) { const f32x4 gg = ((const f32x4*)g)[lane + 64 * j], bb = ((const f32x4*)b)[lane + 64 * j]; v[j] = v[j] * rstd * gg + bb; }
}
__device__ __forceinline__ void row_proj16(const f32x4 (&v)[4], const float* W, int ldw, int c0a, int c0b, float* sg, int lane) {
    float a[16];
#pragma unroll
    for (int c = 0; c < 16; ++c) a[c] = 0.f;
#pragma unroll
    for (int j = 0; j < 4; ++j)
#pragma unroll
        for (int i = 0; i < 4; ++i) { const float x = v[j][i]; const float* wr = W + (size_t)(256 * j + 4 * lane + i) * ldw;
            const f32x4 w0 = *(const f32x4*)(wr + c0a), w1 = *(const f32x4*)(wr + c0a + 4), w2 = *(const f32x4*)(wr + c0b), w3 = *(const f32x4*)(wr + c0b + 4);
#pragma unroll
            for (int c = 0; c < 4; ++c) { a[c] += x * w0[c]; a[4 + c] += x * w1[c]; a[8 + c] += x * w2[c]; a[12 + c] += x * w3[c]; } }
    float r = 0.f;
#pragma unroll
    for (int c = 0; c < 16; ++c) { const float s = wave_sum(a[c]); r = (lane == c) ? s : r; }
    if (lane < 16) sg[lane] = r;
}
__device__ __forceinline__ void row_gate_proj(Frame& F, const f32x4 (&v)[4], int layer, int m) {
    float* sg = (float*)(F.ws + WS_SG) + (size_t)m * 16; const int j = layer >> 1;
    if ((layer & 1) == 0) row_proj16(v, KIN(I_ABWIN) + (size_t)j * D * AB_IN, AB_IN, 4096, 4104, sg, F.lane);
    else                  row_proj16(v, KIN(I_CDWIN) + (size_t)j * D * CD_IN, CD_IN, 1536, 3592, sg, F.lane);
}

__device__ __forceinline__ void transpose_tile(const float* W, int ldw, int k0, int n0, bf16* WT, int ldt, int drow0, float scale, const float* kscale, LAS float* scr, int lane) {
#pragma unroll 8
    for (int i = 0; i < 32; ++i) { const int kk = 2 * i + (lane >> 5); float v = W[(size_t)(k0 + kk) * ldw + n0 + (lane & 31)] * scale; if (kscale) v *= kscale[kk]; scr[kk * 33 + (lane & 31)] = v; }
    LDS_WAIT(); asm volatile("" ::: "memory");
    const int c = lane & 7;
#pragma unroll
    for (int j = 0; j < 4; ++j) { const int n = (lane >> 3) + 8 * j; const LAS float* s = scr + (8 * c) * 33 + n;
        v4u o; o.x = pk2(s[0 * 33], s[1 * 33]); o.y = pk2(s[2 * 33], s[3 * 33]); o.z = pk2(s[4 * 33], s[5 * 33]); o.w = pk2(s[6 * 33], s[7 * 33]);
        *(v4u*)(WT + (size_t)(drow0 + n) * ldt + k0 + 8 * c) = o; }
    LDS_WAIT(); asm volatile("" ::: "memory");
}
__device__ __forceinline__ void p_prologue(Frame& F) {
    LAS float* scr = (LAS float*)(F.lds + F.wave * 16384);
    bf16* WinE = (bf16*)(F.ws + WS_WINE); bf16* WinO = (bf16*)(F.ws + WS_WINO); bf16* WoutE = (bf16*)(F.ws + WS_WOUTE); bf16* WoutO = (bf16*)(F.ws + WS_WOUTO);
    bf16* Wgu = (bf16*)(F.ws + WS_WGU); bf16* Wd = (bf16*)(F.ws + WS_WD);
    constexpr int N_WINE = 2 * 2048, N_WINO = 2 * 1792, N_WOE = 2 * 768, N_WOO = 2 * 512, N_GU = 128 * 512, N_D = 128 * 256;
    constexpr int NITEMS = N_WINE + N_WINO + N_WOE + N_WOO + N_GU + N_D;
    for (int it = F.gw; it < NITEMS; it += F.NGW) {
        int r = it;
        if (r < N_WINE) { const int j = r / 2048, q = r % 2048, kb = q / 128, nb = q % 128;
            transpose_tile(KIN(I_ABWIN) + (size_t)j * D * AB_IN, AB_IN, 64 * kb, 32 * nb, WinE + (size_t)j * NPE * D, D, 32 * nb, 1.f, nullptr, scr, F.lane); continue; } r -= N_WINE;
        if (r < N_WINO) { const int j = r / 1792, q = r % 1792, seg = q / 256, q2 = q % 256, kb = q2 / 16, nb = q2 % 16;
            const int scol = (seg < 3 ? 512 * seg : 1544 + 512 * (seg - 3)) + 32 * nb; const float sc = seg == 1 ? MLSTM_KSCALE : (seg == 4 ? FOX_C2 : 1.f);
            transpose_tile(KIN(I_CDWIN) + (size_t)j * D * CD_IN, CD_IN, 64 * kb, scol, WinO + (size_t)j * NPO * D, D, 512 * seg + 32 * nb, sc, nullptr, scr, F.lane); continue; } r -= N_WINO;
        if (r < N_WOE) { const int j = r / 768, q = r % 768, kb = q / 32, nb = q % 32;
            const float* ks = kb >= 8 ? KIN(I_NORMW) + (size_t)j * 1024 + (64 * kb - 512) : nullptr;
            transpose_tile(KIN(I_ABWOUT) + (size_t)j * 1536 * D, D, 64 * kb, 32 * nb, WoutE + (size_t)j * D * 1536, 1536, 32 * nb, 1.f, ks, scr, F.lane); continue; } r -= N_WOE;
        if (r < N_WOO) { const int j = r / 512, q = r % 512, kb = q / 32, nb = q % 32;
            transpose_tile(KIN(I_CDWOUT) + (size_t)j * D * D, D, 64 * kb, 32 * nb, WoutO + (size_t)j * D * D, D, 32 * nb, 1.f, nullptr, scr, F.lane); continue; } r -= N_WOO;
        if (r < N_GU) { const int le = r / 512, q = r % 512, half = q / 256, q2 = q % 256, kb = q2 / 16, nb = q2 % 16, n0 = 32 * nb;
            const float* src = (half ? KIN(I_WU) : KIN(I_WG)) + (size_t)le * D * 512;
            transpose_tile(src, 512, 64 * kb, n0, Wgu + (size_t)le * D * D, D, 256 * (n0 / 128) + 128 * half + (n0 % 128), 1.f, nullptr, scr, F.lane); continue; } r -= N_GU;
        { const int le = r / 256, q = r % 256, kb = q / 32, nb = q % 32;
            transpose_tile(KIN(I_WDN) + (size_t)le * 512 * D, D, 64 * kb, 32 * nb, Wd + (size_t)le * D * 512, 512, 32 * nb, 1.f, nullptr, scr, F.lane); }
    }
    bf16* HB = (bf16*)(F.ws + WS_HB);
    for (int m = F.gw; m < T; m += F.NGW) { f32x4 v[4]; row_load(KIN(I_X) + (size_t)m * D, F.lane, v); row_store_bf16(HB + (size_t)m * D, F.lane, v); row_gate_proj(F, v, 0, m); }
}
__device__ __forceinline__ void e0_conv(Frame& F, int j) {
    const bf16* P = (const bf16*)(F.ws + WS_R1); bf16* XBC = (bf16*)(F.ws + WS_R3); bf16* MIX = (bf16*)(F.ws + WS_MIX);
    const float* cw = KIN(I_CONVW) + (size_t)j * 4 * 1536; const float* cb = KIN(I_CONVB) + (size_t)j * 1536; const float* ca = KIN(I_CONVA) + (size_t)j * 3 * 512;
    for (int it = F.gw; it < (T / 8) * 16; it += F.NGW) {
        const int tt = it >> 4, cg = it & 15, t0 = tt * 8, s0 = t0 & (SEQ - 1);
        if (cg < 12) {
            const int c = cg * 128 + 2 * F.lane;
            float w0[4], w1[4];
#pragma unroll
            for (int k = 0; k < 4; ++k) { w0[k] = cw[k * 1536 + c]; w1[k] = cw[k * 1536 + c + 1]; }
            const float b0 = cb[c], b1 = cb[c + 1];
            float xa[11], xb[11];
#pragma unroll
            for (int r = 0; r < 11; ++r) { unsigned w = 0u; if (s0 - 3 + r >= 0) w = *(const unsigned*)(P + (size_t)(t0 - 3 + r) * NPE + 2560 + c); xa[r] = bflo(w); xb[r] = bfhi(w); }
#pragma unroll
            for (int o = 0; o < 8; ++o) { float a0 = b0, a1 = b1;
#pragma unroll
                for (int k = 0; k < 4; ++k) { a0 += w0[k] * xa[o + k]; a1 += w1[k] * xb[o + k]; }
                *(unsigned*)(XBC + (size_t)(t0 + o) * 1536 + c) = pk2(silu_f(a0), silu_f(a1)); }
        } else {
            const int c = (cg - 12) * 128 + 2 * F.lane;
            float w0[3], w1[3];
#pragma unroll
            for (int k = 0; k < 3; ++k) { w0[k] = ca[k * 512 + c]; w1[k] = ca[k * 512 + c + 1]; }
            float ua[10], ub[10];
#pragma unroll
            for (int r = 0; r < 10; ++r) { float a = 0.f, b = 0.f;
                if (s0 - 2 + r >= 0) { const bf16* pr = P + (size_t)(t0 - 2 + r) * NPE; const unsigned cgw = *(const unsigned*)(pr + 512 + c), xw = *(const unsigned*)(pr + 1024 + c); a = bflo(cgw) * bflo(xw); b = bfhi(cgw) * bfhi(xw); }
                ua[r] = a; ub[r] = b; }
#pragma unroll
            for (int o = 0; o < 8; ++o) { float a0 = 0.f, a1 = 0.f;
#pragma unroll
                for (int k = 0; k < 3; ++k) { a0 += w0[k] * ua[o + k]; a1 += w1[k] * ub[o + k]; }
                const unsigned bg = *(const unsigned*)(P + (size_t)(t0 + o) * NPE + c);
                *(unsigned*)(MIX + (size_t)(t0 + o) * 1536 + c) = pk2(bflo(bg) * a0, bfhi(bg) * a1); }
        }
    }
}
__device__ __forceinline__ void ssd_gates(Frame& F, int j, int t0, int h, LAS float* dtl, LAS float* acs) {
    if (F.wave == 0) {
        const float* SG = (const float*)(F.ws + WS_SG); const float dtb = KIN(I_DTB)[j * 16 + h], aneg = -expf(KIN(I_ALOG)[j * 16 + h]);
        const float d0 = softplus_f(SG[(size_t)(t0 + 2 * F.lane) * 16 + h] + dtb), d1 = softplus_f(SG[(size_t)(t0 + 2 * F.lane + 1) * 16 + h] + dtb);
        const float a0 = d0 * aneg, a1 = d1 * aneg; const float inc = wave_scan_sum(a0 + a1, F.lane);
        dtl[2 * F.lane] = d0; dtl[2 * F.lane + 1] = d1; acs[2 * F.lane] = inc - a1; acs[2 * F.lane + 1] = inc;
    }
}
__device__ __forceinline__ void e1_states(Frame& F, int j) {
    const bf16* XBC = (const bf16*)(F.ws + WS_R3); float* ST = (float*)(F.ws + WS_R4); float* DEC = (float*)(F.ws + WS_DEC);
    LAS float* xw = (LAS float*)F.lds; LAS float* Bm = (LAS float*)(F.lds + 32768); LAS float* dtl = (LAS float*)(F.lds + SMALL_OFF); LAS float* acs = dtl + 128;
    for (int u = F.vcu; u < 2048; u += F.G) {
        const int b = u >> 8, c = (u >> 4) & 15, h = u & 15, g = h >> 2, t0 = b * SEQ + c * 128;
        __syncthreads();
        ssd_gates(F, j, t0, h, dtl, acs);
        __syncthreads();
        for (int i = F.tid; i < 128 * 32; i += 512) { const int l = i >> 5, pp = (i & 31) * 2; const float wgt = expf(acs[127] - acs[l]) * dtl[l];
            const unsigned xv = *(const unsigned*)(XBC + (size_t)(t0 + l) * 1536 + h * 64 + pp), bv = *(const unsigned*)(XBC + (size_t)(t0 + l) * 1536 + 1024 + g * 64 + pp);
            xw[l * 64 + pp] = bflo(xv) * wgt; xw[l * 64 + pp + 1] = bfhi(xv) * wgt; Bm[l * 64 + pp] = bflo(bv); Bm[l * 64 + pp + 1] = bfhi(bv); }
        __syncthreads();
        const int n = F.lane, p0 = 8 * F.wave; float acc[8];
#pragma unroll
        for (int i = 0; i < 8; ++i) acc[i] = 0.f;
#pragma unroll 2
        for (int l = 0; l < 128; ++l) { const float bm = Bm[l * 64 + n]; const f32x4 x0 = *(const LAS f32x4*)(xw + l * 64 + p0), x1 = *(const LAS f32x4*)(xw + l * 64 + p0 + 4);
#pragma unroll
            for (int i = 0; i < 4; ++i) { acc[i] += x0[i] * bm; acc[4 + i] += x1[i] * bm; } }
        float* dst = ST + (size_t)u * 4096;
#pragma unroll
        for (int i = 0; i < 8; ++i) dst[(p0 + i) * 64 + n] = acc[i];
        if (F.tid == 0) DEC[u] = expf(acs[127]);
    }
}
__device__ __forceinline__ void e2_scan(Frame& F) {
    float* ST = (float*)(F.ws + WS_R4); const float* DEC = (const float*)(F.ws + WS_DEC);
    for (int e = F.vcu * 512 + F.tid; e < NBATCH * 16 * 4096; e += F.G * 512) {
        const int b = e >> 16, h = (e >> 12) & 15, pn = e & 4095; float run = 0.f;
        for (int c = 0; c < 16; ++c) { const int u = (b * 16 + c) * 16 + h; const size_t idx = (size_t)u * 4096 + pn; const float s = ST[idx]; ST[idx] = run; run = run * DEC[u] + s; }
    }
}
__device__ __forceinline__ void e3_output(Frame& F, int j) {
    const bf16* XBC = (const bf16*)(F.ws + WS_R3); const float* ST = (const float*)(F.ws + WS_R4); float* Y = (float*)(F.ws + WS_R2);
    LAS float* R0 = (LAS float*)F.lds;
    LAS float* R1 = (LAS float*)(F.lds + 32768);
    LAS float* R2 = (LAS float*)(F.lds + 65536);
    LAS float* dtl = (LAS float*)(F.lds + SMALL_OFF); LAS float* acs = dtl + 128;
    for (int u = F.vcu; u < 2048; u += F.G) {
        const int b = u >> 8, c = (u >> 4) & 15, h = u & 15, g = h >> 2, t0 = b * SEQ + c * 128;
        __syncthreads();
        ssd_gates(F, j, t0, h, dtl, acs);
        for (int i = F.tid; i < 128 * 32; i += 512) { const int l = i >> 5, nn = (i & 31) * 2;
            const unsigned bv = *(const unsigned*)(XBC + (size_t)(t0 + l) * 1536 + 1024 + g * 64 + nn), cv = *(const unsigned*)(XBC + (size_t)(t0 + l) * 1536 + 1280 + g * 64 + nn);
            R0[l * 64 + nn] = bflo(cv); R0[l * 64 + nn + 1] = bfhi(cv); R1[nn * 128 + l] = bflo(bv); R1[(nn + 1) * 128 + l] = bfhi(bv); }
        { const float* hp = ST + (size_t)u * 4096; for (int i = F.tid; i < 4096; i += 512) { const int p = i >> 6, n = i & 63; R2[n * 64 + p] = hp[i]; } }
        __syncthreads();
        const int p = F.lane, l0 = 16 * F.wave; float acc[16];
#pragma unroll
        for (int i = 0; i < 16; ++i) acc[i] = 0.f;
#pragma unroll 1
        for (int n0 = 0; n0 < 64; n0 += 4) { float hp[4];
#pragma unroll
            for (int i = 0; i < 4; ++i) hp[i] = R2[(n0 + i) * 64 + p];
#pragma unroll
            for (int li = 0; li < 16; ++li) { const f32x4 c4 = *(const LAS f32x4*)(R0 + (l0 + li) * 64 + n0); acc[li] += (c4[0] * hp[0] + c4[1] * hp[1]) + (c4[2] * hp[2] + c4[3] * hp[3]); } }
#pragma unroll
        for (int li = 0; li < 16; ++li) acc[li] *= expf(acs[l0 + li]);
        __syncthreads();
#pragma unroll 1
        for (int half = 0; half < 2; ++half) { const int s = F.tid & 127, lg = 32 * (F.tid >> 7) + 16 * half; float gacc[16];
#pragma unroll
            for (int i = 0; i < 16; ++i) gacc[i] = 0.f;
#pragma unroll 1
            for (int n0 = 0; n0 < 64; n0 += 4) { float bb[4];
#pragma unroll
                for (int i = 0; i < 4; ++i) bb[i] = R1[(n0 + i) * 128 + s];
#pragma unroll
                for (int li = 0; li < 16; ++li) { const f32x4 c4 = *(const LAS f32x4*)(R0 + (lg + li) * 64 + n0); gacc[li] += (c4[0] * bb[0] + c4[1] * bb[1]) + (c4[2] * bb[2] + c4[3] * bb[3]); } }
            const float as = acs[s];
#pragma unroll
            for (int li = 0; li < 16; ++li) { const int l = lg + li; R2[l * 128 + s] = (s <= l) ? gacc[li] * expf(acs[l] - as) : 0.f; } }
        __syncthreads();
        for (int i = F.tid; i < 128 * 32; i += 512) { const int l = i >> 5, pp = (i & 31) * 2; const unsigned xv = *(const unsigned*)(XBC + (size_t)(t0 + l) * 1536 + h * 64 + pp);
            R0[l * 64 + pp] = bflo(xv); R0[l * 64 + pp + 1] = bfhi(xv); }
        __syncthreads();
#pragma unroll 1
        for (int s0 = 0; s0 < l0 + 16; s0 += 4) { float xv[4];
#pragma unroll
            for (int i = 0; i < 4; ++i) xv[i] = R0[(s0 + i) * 64 + p] * dtl[s0 + i];
#pragma unroll
            for (int li = 0; li < 16; ++li) { const f32x4 g4 = *(const LAS f32x4*)(R2 + (l0 + li) * 128 + s0); acc[li] += (g4[0] * xv[0] + g4[1] * xv[1]) + (g4[2] * xv[2] + g4[3] * xv[3]); } }
        const float dsk = KIN(I_DSKIP)[j * 16 + h];
#pragma unroll
        for (int li = 0; li < 16; ++li) Y[(size_t)(t0 + l0 + li) * D + h * 64 + p] = acc[li] + dsk * R0[(l0 + li) * 64 + p];
    }
}
__device__ __forceinline__ void e4_gnorm(Frame& F) {
    const float* Y = (const float*)(F.ws + WS_R2); const bf16* P = (const bf16*)(F.ws + WS_R1); bf16* MIX = (bf16*)(F.ws + WS_MIX);
    for (int m = F.gw; m < T; m += F.NGW) { f32x4 y[4], z[4]; row_load(Y + (size_t)m * D, F.lane, y); row_load_bf16(P + (size_t)m * NPE + 1536, F.lane, z); float ss = 0.f;
#pragma unroll
        for (int jj = 0; jj < 4; ++jj)
#pragma unroll
            for (int i = 0; i < 4; ++i) { const float uu = y[jj][i] * silu_f(z[jj][i]); y[jj][i] = uu; ss += uu * uu; }
        const float rstd = 1.0f / sqrtf(wave_sum(ss) * (1.f / D) + LN_EPS);
#pragma unroll
        for (int jj = 0; jj < 4; ++jj) y[jj] = y[jj] * rstd;
        row_store_bf16(MIX + (size_t)m * 1536 + 512, F.lane, y); }
}
__device__ __forceinline__ void o_foxscan(Frame& F, int j) {
    const float* SG = (const float*)(F.ws + WS_SG); float* FOXC = (float*)(F.ws + WS_FOXC);
    for (int bh = F.gw; bh < 64; bh += F.NGW) { const int b = bh >> 3, h = bh & 7; const float bias = KIN(I_FOXB)[j * 8 + h];
        float v[32], run = 0.f;
#pragma unroll
        for (int i = 0; i < 32; ++i) { run += logsigmoid_f(SG[(size_t)(b * SEQ + 32 * F.lane + i) * 16 + 8 + h] + bias); v[i] = run; }
        const float off = wave_scan_sum(run, F.lane) - run;
#pragma unroll
        for (int i = 0; i < 32; ++i) FOXC[(size_t)bh * SEQ + 32 * F.lane + i] = (v[i] + off) * LOG2E; }
}
__device__ __forceinline__ void mlstm_gates(Frame& F, int j, int t0, int h, float& bcum, float& ib) {
    const float* SG = (const float*)(F.ws + WS_SG);
    ib = SG[(size_t)(t0 + F.lane) * 16 + h] + KIN(I_IB)[j * 4 + h];
    bcum = wave_scan_sum(logsigmoid_f(SG[(size_t)(t0 + F.lane) * 16 + 4 + h] + KIN(I_FB)[j * 4 + h]), F.lane);
}
__device__ __forceinline__ void o1_local(Frame& F, int j) {
    const bf16* P = (const bf16*)(F.ws + WS_R1); float* KLOC = (float*)(F.ws + WS_R2); float* NLOC = (float*)(F.ws + WS_NLOC); float* MLOC = (float*)(F.ws + WS_MLOC); float* BLAST = (float*)(F.ws + WS_BLAST);
    LAS float* kw = (LAS float*)F.lds; LAS float* Vs = (LAS float*)(F.lds + 32768); LAS float* wk = (LAS float*)(F.lds + SMALL_OFF);
    for (int u = F.vcu; u < 1024; u += F.G) {
        const int b = u >> 7, h = (u >> 5) & 3, c = u & 31, t0 = b * SEQ + c * 64;
        __syncthreads();
        if (F.wave == 0) { float bcum, ib; mlstm_gates(F, j, t0, h, bcum, ib); const float blast = __shfl(bcum, 63); const float gl = blast - bcum + ib; const float ml = wave_max(gl);
            wk[F.lane] = expf(gl - ml); if (F.lane == 0) { MLOC[u] = ml; BLAST[u] = blast; } }
        __syncthreads();
        for (int i = F.tid; i < 64 * 64; i += 512) { const int s = i >> 6, dd = (i & 63) * 2; const float w = wk[s];
            const unsigned kv = *(const unsigned*)(P + (size_t)(t0 + s) * NPO + 512 + h * 128 + dd), vv = *(const unsigned*)(P + (size_t)(t0 + s) * NPO + 1024 + h * 128 + dd);
            kw[s * 128 + dd] = bflo(kv) * w; kw[s * 128 + dd + 1] = bfhi(kv) * w; Vs[s * 128 + dd] = bflo(vv); Vs[s * 128 + dd + 1] = bfhi(vv); }
        __syncthreads();
        const int v = F.tid & 127, d0 = 32 * (F.tid >> 7); float acc[32];
#pragma unroll
        for (int i = 0; i < 32; ++i) acc[i] = 0.f;
#pragma unroll 1
        for (int s = 0; s < 64; ++s) { const float vv = Vs[s * 128 + v];
#pragma unroll
            for (int di = 0; di < 32; di += 4) { const f32x4 k4 = *(const LAS f32x4*)(kw + s * 128 + d0 + di);
#pragma unroll
                for (int i = 0; i < 4; ++i) acc[di + i] += k4[i] * vv; } }
        float* dst = KLOC + (size_t)u * 16384;
#pragma unroll
        for (int i = 0; i < 32; ++i) dst[(d0 + i) * 128 + v] = acc[i];
        if (F.tid < 128) { float a = 0.f; for (int s = 0; s < 64; ++s) a += kw[s * 128 + F.tid]; NLOC[(size_t)u * 128 + F.tid] = a; }
    }
}
__device__ __forceinline__ void o2_scan(Frame& F) {
    float* KLOC = (float*)(F.ws + WS_R2); float* NLOC = (float*)(F.ws + WS_NLOC); const float* MLOC = (const float*)(F.ws + WS_MLOC); const float* BLAST = (const float*)(F.ws + WS_BLAST); float* MPREV = (float*)(F.ws + WS_MPREV);
    constexpr int PER = 16384 + 128;
    for (int e = F.vcu * 512 + F.tid; e < 32 * PER; e += F.G * 512) {
        const int bh = e / PER, r = e % PER; float run = 0.f, m = 0.f;
        for (int c = 0; c < 32; ++c) { const int u = bh * 32 + c; float* p = r < 16384 ? KLOC + (size_t)u * 16384 + r : NLOC + (size_t)u * 128 + (r - 16384);
            const float loc = *p; *p = run; if (r == 0) MPREV[u] = m;
            const float bl = BLAST[u], ml = MLOC[u], mn = fmaxf(bl + m, ml);
            run = expf(bl + m - mn) * run + expf(ml - mn) * loc; m = mn; }
    }
}
__device__ __forceinline__ void o3_output(Frame& F, int j) {
    const bf16* P = (const bf16*)(F.ws + WS_R1); const float* CPREV = (const float*)(F.ws + WS_R2); const float* NPREV = (const float*)(F.ws + WS_NLOC); const float* MPREV = (const float*)(F.ws + WS_MPREV); bf16* MIX = (bf16*)(F.ws + WS_MIX);
    LAS float* qT = (LAS float*)F.lds;
    LAS float* kT = (LAS float*)(F.lds + 32768);
    LAS float* Vs = (LAS float*)(F.lds + 65536);
    LAS float* WT = (LAS float*)(F.lds + 98304);
    LAS float* sm = (LAS float*)(F.lds + SMALL_OFF);
    for (int u = F.vcu; u < 1024; u += F.G) {
        const int b = u >> 7, h = (u >> 5) & 3, c = u & 31, t0 = b * SEQ + c * 64;
        __syncthreads();
        if (F.wave == 0) { float bcum, ib; mlstm_gates(F, j, t0, h, bcum, ib); const float mprev = MPREV[u];
            const float pm = wave_scan_max(ib - bcum, F.lane); const float inter = bcum + mprev; const float mt = fmaxf(bcum + pm, inter);
            sm[F.lane] = bcum; sm[64 + F.lane] = ib; sm[128 + F.lane] = mt; sm[192 + F.lane] = expf(inter - mt); }
        for (int i = F.tid; i < 64 * 64; i += 512) { const int s = i >> 6, dd = (i & 63) * 2; const bf16* pr = P + (size_t)(t0 + s) * NPO + h * 128 + dd;
            const unsigned qv = *(const unsigned*)pr, kv = *(const unsigned*)(pr + 512), vv = *(const unsigned*)(pr + 1024);
            qT[dd * 64 + s] = bflo(qv); qT[(dd + 1) * 64 + s] = bfhi(qv); kT[dd * 64 + s] = bflo(kv); kT[(dd + 1) * 64 + s] = bfhi(kv); Vs[s * 128 + dd] = bflo(vv); Vs[s * 128 + dd + 1] = bfhi(vv); }
        __syncthreads();
        { const int s = F.lane, l0 = 8 * F.wave; float acc[8];
#pragma unroll
            for (int i = 0; i < 8; ++i) acc[i] = 0.f;
#pragma unroll 2
            for (int d = 0; d < 128; ++d) { const float kk = kT[d * 64 + s]; const f32x4 q0 = *(const LAS f32x4*)(qT + d * 64 + l0), q1 = *(const LAS f32x4*)(qT + d * 64 + l0 + 4);
#pragma unroll
                for (int i = 0; i < 4; ++i) { acc[i] += q0[i] * kk; acc[4 + i] += q1[i] * kk; } }
            const float gs = sm[64 + s] - sm[s];
#pragma unroll
            for (int i = 0; i < 8; ++i) { const int l = l0 + i; const float w = (s <= l) ? acc[i] * expf(sm[l] + gs - sm[128 + l]) : 0.f; WT[s * 64 + l] = w; const float dsum = wave_sum(w); if (F.lane == 0) sm[256 + l] = dsum; } }
        __syncthreads();
        if (F.tid < 64) { const int l = F.tid; float qn = 0.f; const float* np = NPREV + (size_t)u * 128; for (int d = 0; d < 128; ++d) qn += qT[d * 64 + l] * np[d]; sm[256 + l] += sm[192 + l] * qn; }
        const int v = F.tid & 127, l0 = 16 * (F.tid >> 7); float acc[16];
#pragma unroll
        for (int i = 0; i < 16; ++i) acc[i] = 0.f;
        { const float* cp = CPREV + (size_t)u * 16384;
#pragma unroll 2
            for (int d = 0; d < 128; ++d) { const float cc = cp[d * 128 + v];
#pragma unroll
                for (int li = 0; li < 16; li += 4) { const f32x4 q4 = *(const LAS f32x4*)(qT + d * 64 + l0 + li);
#pragma unroll
                    for (int i = 0; i < 4; ++i) acc[li + i] += q4[i] * cc; } } }
#pragma unroll
        for (int i = 0; i < 16; ++i) acc[i] *= sm[192 + l0 + i];
#pragma unroll 2
        for (int s = 0; s < 64; ++s) { const float vv = Vs[s * 128 + v];
#pragma unroll
            for (int li = 0; li < 16; li += 4) { const f32x4 w4 = *(const LAS f32x4*)(WT + s * 64 + l0 + li);
#pragma unroll
                for (int i = 0; i < 4; ++i) acc[li + i] += w4[i] * vv; } }
        __syncthreads();
        LAS float* hb = kT;
#pragma unroll
        for (int i = 0; i < 16; ++i) { const int l = l0 + i; const float hv = acc[i] / fmaxf(fabsf(sm[256 + l]), expf(-sm[128 + l])); acc[i] = hv; hb[l * 128 + v] = hv; }
        __syncthreads();
        { const int lb = 8 * F.wave;
#pragma unroll
            for (int i = 0; i < 8; ++i) { const int l = lb + i; const float a = hb[l * 128 + F.lane], bq = hb[l * 128 + 64 + F.lane]; const float mu = wave_sum(a + bq) * (1.f / 128.f);
                const float da = a - mu, db = bq - mu; const float var = wave_sum(da * da + db * db) * (1.f / 128.f); if (F.lane == 0) { sm[320 + l] = mu; sm[384 + l] = 1.0f / sqrtf(var + LN_EPS); } } }
        __syncthreads();
        const float hw = KIN(I_HNW)[j * 512 + h * 128 + v];
#pragma unroll
        for (int i = 0; i < 16; ++i) { const int l = l0 + i; const float og = sigmoid_f(bf2f(P[(size_t)(t0 + l) * NPO + 1536 + h * 128 + v]));
            MIX[(size_t)(t0 + l) * D + h * 128 + v] = (bf16)f2bf(og * (acc[i] - sm[320 + l]) * sm[384 + l] * hw); }
    }
}
__device__ __forceinline__ void o4_fox(Frame& F) {
    const bf16* P = (const bf16*)(F.ws + WS_R1); const float* FOXC = (const float*)(F.ws + WS_FOXC); bf16* MIX = (bf16*)(F.ws + WS_MIX);
    LAS float* QT = (LAS float*)F.lds;
    LAS float* KT = (LAS float*)(F.lds + 16384);
    LAS float* Vs = (LAS float*)(F.lds + 32768);
    LAS float* PT = (LAS float*)(F.lds + 49152) + F.wave * 512;
    LAS float* cq = (LAS float*)(F.lds + SMALL_OFF); LAS float* ck = cq + 64;
    for (int it = F.vcu; it < 2048; it += F.G) {
        const int qt = 31 - (it >> 6), bh = it & 63, b = bh >> 3, h = bh & 7, tq0 = b * SEQ + qt * 64;
        __syncthreads();
        for (int i = F.tid; i < 64 * 32; i += 512) { const int q = i >> 5, dd = (i & 31) * 2; const unsigned w = *(const unsigned*)(P + (size_t)(tq0 + q) * NPO + 2048 + h * 64 + dd); QT[dd * 64 + q] = bflo(w); QT[(dd + 1) * 64 + q] = bfhi(w); }
        if (F.tid < 64) cq[F.tid] = FOXC[(size_t)bh * SEQ + qt * 64 + F.tid];
        const int q0 = 8 * F.wave; float mrun[8], lrun[8], o[8];
#pragma unroll
        for (int i = 0; i < 8; ++i) { mrun[i] = -INFINITY; lrun[i] = 0.f; o[i] = 0.f; }
#pragma unroll 1
        for (int kt = 0; kt <= qt; ++kt) { const int tk0 = b * SEQ + kt * 64;
            __syncthreads();
            for (int i = F.tid; i < 64 * 32; i += 512) { const int k = i >> 5, dd = (i & 31) * 2; const bf16* pr = P + (size_t)(tk0 + k) * NPO + h * 64 + dd; const unsigned kw = *(const unsigned*)(pr + 2560), vw = *(const unsigned*)(pr + 3072);
                KT[dd * 64 + k] = bflo(kw); KT[(dd + 1) * 64 + k] = bfhi(kw); Vs[k * 64 + dd] = bflo(vw); Vs[k * 64 + dd + 1] = bfhi(vw); }
            if (F.tid < 64) ck[F.tid] = FOXC[(size_t)bh * SEQ + kt * 64 + F.tid];
            __syncthreads();
            float s[8];
#pragma unroll
            for (int i = 0; i < 8; ++i) s[i] = 0.f;
#pragma unroll 2
            for (int d = 0; d < 64; ++d) { const float kk = KT[d * 64 + F.lane]; const f32x4 qa = *(const LAS f32x4*)(QT + d * 64 + q0), qb = *(const LAS f32x4*)(QT + d * 64 + q0 + 4);
#pragma unroll
                for (int i = 0; i < 4; ++i) { s[i] += qa[i] * kk; s[4 + i] += qb[i] * kk; } }
            const float ckv = ck[F.lane];
#pragma unroll
            for (int i = 0; i < 8; ++i) { float sv = s[i] + cq[q0 + i] - ckv; if (kt == qt && F.lane > q0 + i) sv = -INFINITY;
                const float mn = fmaxf(mrun[i], wave_max(sv)); const float p = exp2f(sv - mn), al = exp2f(mrun[i] - mn);
                lrun[i] = lrun[i] * al + wave_sum(p); o[i] *= al; mrun[i] = mn; PT[F.lane * 8 + i] = p; }
            LDS_WAIT(); asm volatile("" ::: "memory");
#pragma unroll 2
            for (int k = 0; k < 64; ++k) { const float vv = Vs[k * 64 + F.lane]; const f32x4 pa = *(const LAS f32x4*)(PT + k * 8), pb = *(const LAS f32x4*)(PT + k * 8 + 4);
#pragma unroll
                for (int i = 0; i < 4; ++i) { o[i] += pa[i] * vv; o[4 + i] += pb[i] * vv; } }
        }
#pragma unroll
        for (int i = 0; i < 8; ++i) MIX[(size_t)(tq0 + q0 + i) * D + 512 + h * 64 + F.lane] = (bf16)f2bf(o[i] / lrun[i]);
    }
}
__device__ __forceinline__ void p_ln1_route(Frame& F, int layer, const float* hin) {
    const float* OUTP = (const float*)(F.ws + WS_R1); float* H1F = (float*)(F.ws + WS_H1F); bf16* H1B = (bf16*)(F.ws + WS_H1B);
    i32x4* ROUTE = (i32x4*)(F.ws + WS_ROUTE); f32x2* GATE = (f32x2*)(F.ws + WS_GATE); int* BCNT = (int*)(F.ws + WS_BCNT);
    LAS int* cnt = (LAS int*)(F.lds + SMALL_OFF);
    const float* g1 = KIN(I_LN1G) + (size_t)layer * D; const float* b1 = KIN(I_LN1B) + (size_t)layer * D;
    const float* rgw = KIN(I_RGW) + (size_t)layer * D * 4; const float* rgb = KIN(I_RGB) + layer * 4; const float* rew = KIN(I_REW) + (size_t)layer * 4 * D * 8; const float* reb = KIN(I_REB) + layer * 32;
    __syncthreads();
    if (F.tid < 32) cnt[F.tid] = 0;
    __syncthreads();
    for (int m = F.gw; m < T; m += F.NGW) {
        f32x4 v[4], a[4]; row_load(hin + (size_t)m * D, F.lane, v); row_load(OUTP + (size_t)m * D, F.lane, a);
#pragma unroll
        for (int jj = 0; jj < 4; ++jj) v[jj] = v[jj] * ALPHA + a[jj];
        row_layernorm(v, g1, b1, F.lane);
        row_store_f32(H1F + (size_t)m * D, F.lane, v); row_store_bf16(H1B + (size_t)m * D, F.lane, v);
        float gl[4] = {0.f, 0.f, 0.f, 0.f};
#pragma unroll
        for (int jj = 0; jj < 4; ++jj)
#pragma unroll
            for (int i = 0; i < 4; ++i) { const f32x4 w = *(const f32x4*)(rgw + (size_t)(256 * jj + 4 * F.lane + i) * 4);
#pragma unroll
                for (int c = 0; c < 4; ++c) gl[c] += v[jj][i] * w[c]; }
#pragma unroll
        for (int c = 0; c < 4; ++c) gl[c] = wave_sum(gl[c]) + rgb[c];
        int gi = 0; float gm = gl[0];
#pragma unroll
        for (int c = 1; c < 4; ++c) if (gl[c] > gm) { gm = gl[c]; gi = c; }
        float se = 0.f;
#pragma unroll
        for (int c = 0; c < 4; ++c) se += expf(gl[c] - gm);
        const float pg = 1.0f / se;
        const float* rw = rew + (size_t)gi * D * 8; float el[8];
#pragma unroll
        for (int c = 0; c < 8; ++c) el[c] = 0.f;
#pragma unroll
        for (int jj = 0; jj < 4; ++jj)
#pragma unroll
            for (int i = 0; i < 4; ++i) { const float* wr = rw + (size_t)(256 * jj + 4 * F.lane + i) * 8; const f32x4 w0 = *(const f32x4*)wr, w1 = *(const f32x4*)(wr + 4);
#pragma unroll
                for (int c = 0; c < 4; ++c) { el[c] += v[jj][i] * w0[c]; el[4 + c] += v[jj][i] * w1[c]; } }
#pragma unroll
        for (int c = 0; c < 8; ++c) el[c] = wave_sum(el[c]) + reb[gi * 8 + c];
        int i0 = 0; float v0 = el[0];
#pragma unroll
        for (int c = 1; c < 8; ++c) if (el[c] > v0) { v0 = el[c]; i0 = c; }
        int i1 = -1; float v1 = -INFINITY;
#pragma unroll
        for (int c = 0; c < 8; ++c) if (c != i0 && el[c] > v1) { v1 = el[c]; i1 = c; }
        if (i1 < 0) i1 = (i0 + 1) & 7;
        const float ee = expf(v1 - v0), g0 = pg / (1.0f + ee), g1v = pg * ee / (1.0f + ee);
        if (F.lane == 0) { const int e0 = gi * 8 + i0, e1 = gi * 8 + i1;
            const int r0 = __hip_atomic_fetch_add(cnt + e0, 1, __ATOMIC_RELAXED, __HIP_MEMORY_SCOPE_WORKGROUP), r1 = __hip_atomic_fetch_add(cnt + e1, 1, __ATOMIC_RELAXED, __HIP_MEMORY_SCOPE_WORKGROUP);
            ROUTE[m] = (i32x4){e0, r0, e1, r1}; GATE[m] = (f32x2){g0, g1v}; }
    }
    __syncthreads();
    if (F.tid < 32) BCNT[F.vcu * 32 + F.tid] = cnt[F.tid];
}
__device__ __forceinline__ void p_scatter(Frame& F) {
    const int* BCNT = (const int*)(F.ws + WS_BCNT); int* PANEL = (int*)(F.ws + WS_PANEL); const i32x4* ROUTE = (const i32x4*)(F.ws + WS_ROUTE); i32x2* POS = (i32x2*)(F.ws + WS_POS);
    const bf16* H1B = (const bf16*)(F.ws + WS_H1B); bf16* XS = (bf16*)(F.ws + WS_R1);
    LAS int* pa = (LAS int*)(F.lds + SMALL_OFF); LAS int* pb = pa + 512; LAS int* tot = pa + 1024; LAS int* bef = pa + 1056; LAS int* base = pa + 1088;
    __syncthreads();
    { const int e = F.tid & 31, part = F.tid >> 5; int sa = 0, sb = 0;
        for (int b = part; b < F.G; b += 16) { const int c = BCNT[b * 32 + e]; sa += c; if (b < F.vcu) sb += c; }
        pa[part * 32 + e] = sa; pb[part * 32 + e] = sb; }
    __syncthreads();
    if (F.tid < 32) { int sa = 0, sb = 0; for (int p = 0; p < 16; ++p) { sa += pa[p * 32 + F.tid]; sb += pb[p * 32 + F.tid]; } tot[F.tid] = sa; bef[F.tid] = sb; }
    __syncthreads();
    if (F.tid == 0) { int off = 0, np = 0;
        for (int e = 0; e < 32; ++e) { const int npan = (tot[e] + 255) >> 8; base[e] = off + bef[e];
            if (F.vcu == 0) for (int p = 0; p < npan; ++p) PANEL[1 + np + p] = e;
            np += npan; off += npan * 256; }
        if (F.vcu == 0) PANEL[0] = np; }
    __syncthreads();
    for (int m = F.gw; m < T; m += F.NGW) { const i32x4 r = ROUTE[m]; const int p0 = base[r.x] + r.y, p1 = base[r.z] + r.w;
        if (F.lane == 0) POS[m] = (i32x2){p0, p1};
        const v4u* src = (const v4u*)(H1B + (size_t)m * D); v4u* d0 = (v4u*)(XS + (size_t)p0 * D); v4u* d1 = (v4u*)(XS + (size_t)p1 * D);
#pragma unroll
        for (int jj = 0; jj < 2; ++jj) { const v4u w = src[F.lane + 64 * jj]; d0[F.lane + 64 * jj] = w; d1[F.lane + 64 * jj] = w; } }
}
__device__ __forceinline__ void p_combine(Frame& F, int layer) {
    const float* H1F = (const float*)(F.ws + WS_H1F); const bf16* EOUT = (const bf16*)(F.ws + WS_R1); const i32x2* POS = (const i32x2*)(F.ws + WS_POS); const f32x2* GATE = (const f32x2*)(F.ws + WS_GATE);
    float* HF = (float*)(F.ws + WS_HF); bf16* HB = (bf16*)(F.ws + WS_HB);
    const float* g2 = KIN(I_LN2G) + (size_t)layer * D; const float* b2 = KIN(I_LN2B) + (size_t)layer * D;
    for (int m = F.gw; m < T; m += F.NGW) { const i32x2 ps = POS[m]; const f32x2 gt = GATE[m];
        f32x4 v[4], ea[4], eb[4]; row_load(H1F + (size_t)m * D, F.lane, v); row_load_bf16(EOUT + (size_t)ps.x * D, F.lane, ea); row_load_bf16(EOUT + (size_t)ps.y * D, F.lane, eb);
#pragma unroll
        for (int jj = 0; jj < 4; ++jj) v[jj] = v[jj] * ALPHA + (ea[jj] * gt.x + eb[jj] * gt.y);
        row_layernorm(v, g2, b2, F.lane);
        if (layer == DEPTH - 1) row_store_f32(F.out + (size_t)m * D, F.lane, v);
        else { row_store_f32(HF + (size_t)m * D, F.lane, v); row_store_bf16(HB + (size_t)m * D, F.lane, v); row_gate_proj(F, v, layer + 1, m); } }
}
#ifndef PHASE_MASK
#define PHASE_MASK 0x1fff
#endif
#define PH_EN(k) (((PHASE_MASK) >> (k)) & 1)
#define IN(k) (lo <= (k) && (k) < hi)
#define SEAM(k) do { if ((k) + 1 < hi) xcd_barrier(bar); } while (0)
template <int LAYER> __device__ __forceinline__ void layer_body(Frame& F, const int lo, const int hi, const XcdBarrier& bar) {
        constexpr int layer = LAYER, pb = 1 + LAYER * NPH_LAYER, j = LAYER >> 1; constexpr bool odd = (LAYER & 1) != 0;
        bf16* HB = (bf16*)(F.ws + WS_HB); bf16* MIX = (bf16*)(F.ws + WS_MIX);
        const float* hin = layer == 0 ? KIN(I_X) : (const float*)(F.ws + WS_HF);
        if constexpr (PH_EN(0)) if (IN(pb + 0)) {
            const int N = odd ? NPO : NPE; const bf16* Bt = odd ? (const bf16*)(F.ws + WS_WINO) + (size_t)j * NPO * D : (const bf16*)(F.ws + WS_WINE) + (size_t)j * NPE * D;
            pg8::Gemm g{HB, Bt, T, N, D, 0}; pg8::StaticOrder S; S.init(T, N, F.G, (int)blockIdx.x);
            pg8::EpiStoreBf16 E{(bf16*)(F.ws + WS_R1), N};
            pg8::gemm_phase<pg8::EpiStoreBf16, pg8::StaticOrder, true, true>(F.lds, g, S, E);
            SEAM(pb + 0); }
        if constexpr (!odd) {
            if constexpr (PH_EN(1)) if (IN(pb + 1)) { e0_conv(F, j); SEAM(pb + 1); }
            if constexpr (PH_EN(2)) if (IN(pb + 2)) { e1_states(F, j); SEAM(pb + 2); }
            if constexpr (PH_EN(3)) if (IN(pb + 3)) { e2_scan(F); SEAM(pb + 3); }
            if constexpr (PH_EN(4)) if (IN(pb + 4)) { e3_output(F, j); SEAM(pb + 4); }
            if constexpr (PH_EN(5)) if (IN(pb + 5)) { e4_gnorm(F); SEAM(pb + 5); }
        } else {
            if constexpr (PH_EN(1)) if (IN(pb + 1)) { o_foxscan(F, j); o1_local(F, j); SEAM(pb + 1); }
            if constexpr (PH_EN(2)) if (IN(pb + 2)) { o2_scan(F); SEAM(pb + 2); }
            if constexpr (PH_EN(3)) if (IN(pb + 3)) { o3_output(F, j); SEAM(pb + 3); }
            if constexpr (PH_EN(4)) if (IN(pb + 4)) { o4_fox(F); SEAM(pb + 4); }
            if constexpr (PH_EN(5)) if (IN(pb + 5)) { SEAM(pb + 5); }
        }
        if constexpr (PH_EN(6)) if (IN(pb + 6)) {
            const int K = odd ? D : 1536; const bf16* Bt = odd ? (const bf16*)(F.ws + WS_WOUTO) + (size_t)j * D * D : (const bf16*)(F.ws + WS_WOUTE) + (size_t)j * D * 1536;
            pg8::Gemm g{MIX, Bt, T, D, K, 0}; pg8::StaticOrder S; S.init(T, D, F.G, (int)blockIdx.x);
            pg8::EpiStoreF32 E{(float*)(F.ws + WS_R1), D};
            pg8::gemm_phase<pg8::EpiStoreF32, pg8::StaticOrder, false, true>(F.lds, g, S, E);
            SEAM(pb + 6); }
        if constexpr (PH_EN(7)) if (IN(pb + 7)) { p_ln1_route(F, layer, hin); SEAM(pb + 7); }
        if constexpr (PH_EN(8)) if (IN(pb + 8)) { p_scatter(F); SEAM(pb + 8); }
        if constexpr (PH_EN(9)) if (IN(pb + 9)) {
            pg8::Gemm g{(const bf16*)(F.ws + WS_R1), (const bf16*)(F.ws + WS_WGU) + (size_t)layer * 32 * D * D, RPAD, D, D, (size_t)D * D * 2};
            pg8::MoeOrder S; S.initm((const int*)(F.ws + WS_PANEL), 4, F.G, (int)blockIdx.x);
            pg8::EpiSwiglu E{(bf16*)(F.ws + WS_R3), 512};
            pg8::gemm_phase<pg8::EpiSwiglu, pg8::MoeOrder, true, true>(F.lds, g, S, E);
            SEAM(pb + 9); }
        if constexpr (PH_EN(10)) if (IN(pb + 10)) {
            pg8::Gemm g{(const bf16*)(F.ws + WS_R3), (const bf16*)(F.ws + WS_WD) + (size_t)layer * 32 * D * 512, RPAD, D, 512, (size_t)D * 512 * 2};
            pg8::MoeOrder S; S.initm((const int*)(F.ws + WS_PANEL), 4, F.G, (int)blockIdx.x);
            pg8::EpiStoreBf16 E{(bf16*)(F.ws + WS_R1), D};
            pg8::gemm_phase<pg8::EpiStoreBf16, pg8::MoeOrder, true, true>(F.lds, g, S, E);
            SEAM(pb + 10); }
        if constexpr (PH_EN(11)) if (IN(pb + 11)) { p_combine(F, layer); SEAM(pb + 11); }
}
struct Args { const float* in[27]; float* out; unsigned char* ws; int ph_lo, ph_hi; };
__global__ void __launch_bounds__(NWAVES * 64, 2) fwd_kernel(Args args) {
    extern __shared__ __attribute__((aligned(16))) unsigned char lds[];
    Frame F;
    F.lds = (LAS unsigned char*)lds;
    F.MISC = (volatile LAS unsigned*)(F.lds + MISC_OFF);
    F.tid = threadIdx.x; F.lane = F.tid & 63; F.wave = __builtin_amdgcn_readfirstlane(F.tid >> 6);
    F.G = gridDim.x; { const int bx = blockIdx.x; F.vcu = (F.G % 8 == 0) ? (bx % 8) * (F.G / 8) + bx / 8 : bx; }
    F.gw = F.vcu * NWAVES + F.wave; F.NGW = F.G * NWAVES;
    F.out = args.out; F.ws = args.ws; F.ctl = (unsigned*)(args.ws + WS_CTL);
    const int lo = args.ph_lo, hi = args.ph_hi;
    for (int u = F.tid; u < (LDS_BYTES - MISC_OFF) / 4; u += NWAVES * 64) ((LAS unsigned*)(F.lds + MISC_OFF))[u] = 0u;
    __syncthreads();
    XcdBarrier bar; bar.bar = F.ctl + CW_BAR; bar.x = 0; bar.st = nullptr;
    if (hi - lo > 1) bar = xcd_barrier_post(F.ctl + CW_BAR, F.MISC + 8);
    if constexpr (PH_EN(12)) if (IN(0)) { p_prologue(F); SEAM(0); }
    layer_body<0>(F, lo, hi, bar); layer_body<1>(F, lo, hi, bar); layer_body<2>(F, lo, hi, bar); layer_body<3>(F, lo, hi, bar);
#undef IN
#undef SEAM
}

extern "C" void kernel_launch(void* const* d_in, const int* in_sizes, int n_in, void* d_out, int out_size, void* d_ws, size_t ws_size, hipStream_t stream) {
    static int grid = 0;
    if (grid == 0) {
        if (n_in != 27 || in_sizes[0] != T * D || out_size != T * D || ws_size < WS_END) { fprintf(stderr, "kernel_launch: unexpected shapes (n_in %d, in0 %d, out %d, ws %zu); nothing launched\n", n_in, n_in > 0 ? in_sizes[0] : -1, out_size, ws_size); grid = -1; return; }
        int dev = 0, cus = 0, per_cu = 0;
        if (hipGetDevice(&dev) != hipSuccess || hipDeviceGetAttribute(&cus, hipDeviceAttributeMultiprocessorCount, dev) != hipSuccess) { grid = -1; return; }
        if (hipFuncSetAttribute((const void*)fwd_kernel, hipFuncAttributeMaxDynamicSharedMemorySize, LDS_BYTES) != hipSuccess) { fprintf(stderr, "kernel_launch: hipFuncSetAttribute failed\n"); grid = -1; return; }
        if (hipOccupancyMaxActiveBlocksPerMultiprocessor(&per_cu, (const void*)fwd_kernel, NWAVES * 64, LDS_BYTES) != hipSuccess || per_cu < 1) fprintf(stderr, "kernel_launch: note: occupancy query reports %d workgroups per CU\n", per_cu);
        (void)hipGetLastError();
        grid = cus;
    }
    if (grid < 0) return;
    if (hipMemsetAsync((char*)d_ws + WS_CTL, 0, CTL_ZERO_BYTES, stream) != hipSuccess) return;
    Args a{};
    for (int i = 0; i < 27; ++i) a.in[i] = (const float*)d_in[i];
    a.out = (float*)d_out; a.ws = (unsigned char*)d_ws;
#if MK_ONE_LAUNCH
    a.ph_lo = 0; a.ph_hi = NPHASES;
    hipLaunchKernelGGL(fwd_kernel, dim3(grid), dim3(NWAVES * 64), LDS_BYTES, stream, a);
#else
    for (int ph = 0; ph < NPHASES; ++ph) {
        if (ph > 0 && (((ph - 1) / NPH_LAYER) & 1) && ((ph - 1) % NPH_LAYER) == 5) continue;
        a.ph_lo = ph; a.ph_hi = ph + 1;
        hipLaunchKernelGGL(fwd_kernel, dim3(grid), dim3(NWAVES * 64), LDS_BYTES, stream, a);
    }
#endif
}
```

```cpp
#include <hip/hip_runtime.h>
#include <cstdio>
#include <cstdint>
__device__ __forceinline__ float silu_f(float x) { return x / (1.0f + __expf(-x)); }
namespace pg8 {
#define PG8_LAS __attribute__((address_space(3)))
typedef unsigned short bf16_t;
typedef short bf16x8 __attribute__((ext_vector_type(8)));
typedef float f32x4 __attribute__((ext_vector_type(4)));
typedef unsigned u32x4 __attribute__((ext_vector_type(4)));
constexpr int BM = 256, BK = 64, HALF = 128, HTB = HALF * BK * 2  , STAGE_BYTES = 8 * HTB, NXCD = 8, WGM = 8;

__host__ __device__ __forceinline__ int lds_byte(int r, int c) { const int st = (r >> 4) * 2 + (c >> 5), rr = r & 15, cc = c & 31, ob = rr * 64 + cc * 2; return st * 1024 + (ob ^ (((ob >> 9) & 1) << 5)); }
__host__ __device__ __forceinline__ void stage_rc(int b, int& R, int& C) { const int st = b / 1024, sb = b % 1024, swz = sb ^ (((sb >> 9) & 1) << 5); R = (st >> 1) * 16 + swz / 64; C = (st & 1) * 32 + (swz % 64) / 2; }
__host__ __device__ __forceinline__ int perm32(int rho) { const int n = rho >> 4, i = rho & 15; return 8 * (i >> 2) + 4 * n + (i & 3); }

struct Unit { int pm, pn, be; };
struct Gemm { const bf16_t* A; const bf16_t* Bt; int M, N, K; size_t bstride; };

struct StaticOrder {
    int nM, nN, nwg, G, c;
    __host__ __device__ void init(int M, int N, int G_, int c_) { nM = M / BM; nN = N / BM; nwg = nM * nN; G = G_; c = c_; }
    __host__ __device__ bool next(int i, Unit& u) const {
        const long L = (long)i * G + c; if (L >= nwg) return false;
        int wgid = (int)L; { const int q = nwg / NXCD, r = nwg % NXCD, xcd = wgid % NXCD, off = wgid / NXCD; wgid = (xcd < r ? xcd * (q + 1) : r * (q + 1) + (xcd - r) * q) + off; }
        const int nig = WGM * nN, gid = wgid / nig, fm = gid * WGM, gsz = (nM - fm) < WGM ? (nM - fm) : WGM;
        u.pm = fm + ((wgid % nig) % gsz); u.pn = (wgid % nig) / gsz; u.be = 0; return true;
    }
    __device__ __forceinline__ void a_ready(const Unit&) const {}
    __device__ __forceinline__ void done(const Unit&) const {}
};

__device__ __forceinline__ unsigned cvt_pk_bf16(float lo, float hi) { unsigned r; asm volatile("v_cvt_pk_bf16_f32 %0, %1, %2" : "=v"(r) : "v"(lo), "v"(hi)); return r; }
struct EpiStoreBf16 {
    static constexpr bool PERM = true, AFTER_DRAIN = false;
    bf16_t* O; int ldc;
    __device__ __forceinline__ void operator()(const f32x4 (&acc)[2][2][4][2], const Unit& u, int wr, int wc, int fr, int fq) const {
        const int row0 = u.pm * BM + wr * 64 + fr, col0 = u.pn * BM + wc * 32 + 8 * fq;
#pragma unroll
        for (int ai = 0; ai < 2; ++ai)
#pragma unroll
            for (int m = 0; m < 4; ++m) { bf16_t* rowp = O + (size_t)(row0 + ai * HALF + m * 16) * ldc + col0;
#pragma unroll
                for (int bj = 0; bj < 2; ++bj) { const f32x4 v0 = acc[ai][bj][m][0], v1 = acc[ai][bj][m][1];
                    u32x4 w; w.x = cvt_pk_bf16(v0[0], v0[1]); w.y = cvt_pk_bf16(v0[2], v0[3]); w.z = cvt_pk_bf16(v1[0], v1[1]); w.w = cvt_pk_bf16(v1[2], v1[3]);
                    *(u32x4*)(rowp + bj * HALF) = w; } }
    }
};
struct EpiStoreF32 {
    static constexpr bool PERM = false, AFTER_DRAIN = false;
    float* C; int ldc;
    __device__ __forceinline__ void operator()(const f32x4 (&acc)[2][2][4][2], const Unit& u, int wr, int wc, int fr, int fq) const {
        const int row0 = u.pm * BM + wr * 64 + fr, col0 = u.pn * BM + wc * 32 + 4 * fq;
#pragma unroll
        for (int ai = 0; ai < 2; ++ai)
#pragma unroll
            for (int m = 0; m < 4; ++m) { float* rowp = C + (size_t)(row0 + ai * HALF + m * 16) * ldc + col0;
#pragma unroll
                for (int bj = 0; bj < 2; ++bj)
#pragma unroll
                    for (int n = 0; n < 2; ++n) *(f32x4*)(rowp + bj * HALF + n * 16) = acc[ai][bj][m][n]; }
    }
};
struct EpiSwiglu {
    static constexpr bool PERM = true, AFTER_DRAIN = false;
    bf16_t* O; int ldc;
    __device__ __forceinline__ void operator()(const f32x4 (&acc)[2][2][4][2], const Unit& u, int wr, int wc, int fr, int fq) const {
        const int row0 = u.pm * BM + wr * 64 + fr, col0 = u.pn * HALF + wc * 32 + 8 * fq;
#pragma unroll
        for (int ai = 0; ai < 2; ++ai)
#pragma unroll
            for (int m = 0; m < 4; ++m) { bf16_t* rowp = O + (size_t)(row0 + ai * HALF + m * 16) * ldc + col0;
                const f32x4 g0 = acc[ai][0][m][0], g1 = acc[ai][0][m][1], u0 = acc[ai][1][m][0], u1 = acc[ai][1][m][1];
                float h[8];
#pragma unroll
                for (int i = 0; i < 4; ++i) { h[i] = silu_f(g0[i]) * u0[i]; h[4 + i] = silu_f(g1[i]) * u1[i]; }
                u32x4 w; w.x = cvt_pk_bf16(h[0], h[1]); w.y = cvt_pk_bf16(h[2], h[3]); w.z = cvt_pk_bf16(h[4], h[5]); w.w = cvt_pk_bf16(h[6], h[7]);
                *(u32x4*)rowp = w; }
    }
};
struct MoeOrder : StaticOrder {
    const int* tab;
    __device__ __forceinline__ void initm(const int* tab_, int nN_, int G_, int c_) { tab = tab_; nM = tab_[0]; nN = nN_; nwg = nM * nN; G = G_; c = c_; }
    __device__ __forceinline__ bool next(int i, Unit& u) const { if (!StaticOrder::next(i, u)) return false; u.be = tab[1 + u.pm]; return true; }
};
template <class Epi, class Sched, bool ALIGN_EPI = false, bool SP2 = false>
__device__ __forceinline__ void gemm_phase(PG8_LAS unsigned char* lds, const Gemm g, const Sched& S, const Epi& E) {
    const int tid = threadIdx.x, wid = __builtin_amdgcn_readfirstlane(tid >> 6), lane = tid & 63, wr = wid >> 2, wc = wid & 3, fr = lane & 15, fq = lane >> 4;
    const int K = g.K, nt = K / BK;
    unsigned voffA[2], voffB[2];
#pragma unroll
    for (int i = 0; i < 2; ++i) { int R, C; stage_rc(tid * 16 + i * 8192, R, C); const int Rb = Epi::PERM ? ((R & ~31) + perm32(R & 31)) : R;
        voffA[i] = (unsigned)(R * K + C) * 2u; voffB[i] = (unsigned)(Rb * K + C) * 2u; }
    const size_t kstep = (size_t)(BK * 2);
    const size_t hstep = (size_t)HALF * K * 2;
    const size_t tstep = 2 * hstep;
    const unsigned ldsw = (unsigned)wid * 1024u;
    const int aoff = lds_byte(wr * 64 + fr, fq * 8), boff = lds_byte(wc * 32 + fr, fq * 8);
#define PG8_SA(b, h) (((b) * 2 + (h)) * HTB)
#define PG8_SB(b, h) ((4 + (b) * 2 + (h)) * HTB)
#define PG8_STAGE(bufoff, gbase, voff) do { _Pragma("unroll") for (int _i = 0; _i < 2; ++_i) \
        __builtin_amdgcn_global_load_lds((const unsigned*)((const char*)(gbase) + (voff)[_i]), (PG8_LAS unsigned*)(lds + (bufoff) + ldsw + _i * 8192), 16, 0, 0); } while (0)
#define PG8_LDA(dst, b, h) do { _Pragma("unroll") for (int m = 0; m < 4; ++m) _Pragma("unroll") for (int k = 0; k < 2; ++k) dst[m][k] = *(const PG8_LAS bf16x8*)(lds + PG8_SA(b, h) + aoff + m * 2048 + k * 1024); } while (0)
#define PG8_LDB(dst, b, h) do { _Pragma("unroll") for (int n = 0; n < 2; ++n) _Pragma("unroll") for (int k = 0; k < 2; ++k) dst[n][k] = *(const PG8_LAS bf16x8*)(lds + PG8_SB(b, h) + boff + n * 2048 + k * 1024); } while (0)
#define PG8_MMA(ai, bj, At, Bt) do { __builtin_amdgcn_s_setprio(1); _Pragma("unroll") for (int m = 0; m < 4; ++m) _Pragma("unroll") for (int n = 0; n < 2; ++n) _Pragma("unroll") for (int k = 0; k < 2; ++k) \
        acc[ai][bj][m][n] = __builtin_amdgcn_mfma_f32_16x16x32_bf16(Bt[n][k], At[m][k], acc[ai][bj][m][n], 0, 0, 0); __builtin_amdgcn_s_setprio(0); } while (0)
#define PG8_WAIT_V(n) asm volatile("s_waitcnt vmcnt(" #n ")" ::: "memory")
#define PG8_WAIT_L(n) asm volatile("s_waitcnt lgkmcnt(" #n ")" ::: "memory")
#define PG8_BAR __builtin_amdgcn_s_barrier()
#define PG8_SCHED __builtin_amdgcn_sched_barrier(0)
    Unit cur, nxt; int ui = 0;
    if (!S.next(0, cur)) return;
    f32x4 acc[2][2][4][2];
#pragma unroll
    for (int a = 0; a < 2; ++a)
#pragma unroll
        for (int b = 0; b < 2; ++b)
#pragma unroll
            for (int m = 0; m < 4; ++m)
#pragma unroll
                for (int n = 0; n < 2; ++n) acc[a][b][m][n] = (f32x4){0.f, 0.f, 0.f, 0.f};
    bf16x8 At[4][2], B0[2][2], B1[2][2];
    const char* cA = (const char*)g.A + (size_t)cur.pm * tstep; const char* cB = (const char*)g.Bt + (size_t)cur.be * g.bstride + (size_t)cur.pn * tstep;
    S.a_ready(cur);
    if constexpr (SP2) {
        PG8_STAGE(PG8_SB(0, 0), cB, voffB); PG8_STAGE(PG8_SB(0, 1), cB + hstep, voffB); PG8_STAGE(PG8_SA(0, 0), cA, voffA); PG8_STAGE(PG8_SA(0, 1), cA + hstep, voffA);
        if (wr == 1) PG8_BAR;
        PG8_WAIT_V(2); PG8_BAR;
        PG8_STAGE(PG8_SB(1, 0), cB + kstep, voffB); PG8_STAGE(PG8_SA(1, 0), cA + kstep, voffA); PG8_STAGE(PG8_SB(1, 1), cB + hstep + kstep, voffB);
        PG8_WAIT_V(6); PG8_BAR;
    } else {
        PG8_STAGE(PG8_SB(0, 0), cB, voffB); PG8_STAGE(PG8_SA(0, 0), cA, voffA); PG8_STAGE(PG8_SB(0, 1), cB + hstep, voffB); PG8_STAGE(PG8_SA(0, 1), cA + hstep, voffA);
        if (wr == 1) PG8_BAR;
        PG8_WAIT_V(4); PG8_BAR;
        PG8_STAGE(PG8_SB(1, 0), cB + kstep, voffB); PG8_STAGE(PG8_SA(1, 0), cA + kstep, voffA); PG8_STAGE(PG8_SB(1, 1), cB + hstep + kstep, voffB);
        PG8_WAIT_V(6); PG8_BAR;
    }
    for (;;) {
        const bool has_next = S.next(ui + 1, nxt);
        const char* nA = has_next ? (const char*)g.A + (size_t)nxt.pm * tstep : cA; const char* nB = has_next ? (const char*)g.Bt + (size_t)nxt.be * g.bstride + (size_t)nxt.pn * tstep : cB;
        for (int t = 0; t < nt; t += 2) {
            const bool last = (t == nt - 2);
            const char* a1 = cA + (size_t)(t + 1) * kstep;
            const char* a2 = last ? nA : cA + (size_t)(t + 2) * kstep; const char* b2 = last ? nB : cB + (size_t)(t + 2) * kstep;
            const char* a3 = a2 + kstep; const char* b3 = b2 + kstep;
            if (last && has_next) S.a_ready(nxt);
            if constexpr (SP2) {
            PG8_LDB(B0, 0, 0); PG8_LDB(B1, 0, 1); PG8_SCHED; PG8_LDA(At, 0, 0); PG8_STAGE(PG8_SA(1, 1), a1 + hstep, voffA);
            PG8_WAIT_V(8); PG8_WAIT_L(0); PG8_BAR; PG8_MMA(0, 0, At, B0); PG8_MMA(0, 1, At, B1); PG8_BAR; PG8_SCHED;
            PG8_LDA(At, 0, 1); PG8_STAGE(PG8_SB(0, 0), b2, voffB); PG8_STAGE(PG8_SB(0, 1), b2 + hstep, voffB); PG8_STAGE(PG8_SA(0, 0), a2, voffA);
            PG8_WAIT_V(8); PG8_WAIT_L(0); PG8_BAR; PG8_MMA(1, 0, At, B0); PG8_MMA(1, 1, At, B1); PG8_BAR; PG8_SCHED;
            PG8_LDB(B0, 1, 0); PG8_LDB(B1, 1, 1); PG8_SCHED; PG8_LDA(At, 1, 0); PG8_STAGE(PG8_SA(0, 1), a2 + hstep, voffA);
            PG8_WAIT_V(8); PG8_WAIT_L(0); PG8_BAR; PG8_MMA(0, 0, At, B0); PG8_MMA(0, 1, At, B1); PG8_BAR; PG8_SCHED;
            PG8_LDA(At, 1, 1); PG8_STAGE(PG8_SB(1, 0), b3, voffB); PG8_STAGE(PG8_SB(1, 1), b3 + hstep, voffB); PG8_STAGE(PG8_SA(1, 0), a3, voffA);
            PG8_WAIT_V(8); PG8_WAIT_L(0); PG8_BAR; PG8_MMA(1, 0, At, B0); PG8_MMA(1, 1, At, B1); PG8_BAR; PG8_SCHED;
            } else {
            PG8_LDB(B0, 0, 0); PG8_SCHED; PG8_LDA(At, 0, 0); PG8_STAGE(PG8_SA(1, 1), a1 + hstep, voffA);
            PG8_WAIT_L(8); PG8_BAR; PG8_WAIT_L(0); PG8_MMA(0, 0, At, B0); PG8_BAR; PG8_SCHED;
            PG8_LDB(B1, 0, 1); PG8_STAGE(PG8_SB(0, 0), b2, voffB);
            PG8_BAR; PG8_WAIT_L(0); PG8_MMA(0, 1, At, B1); PG8_BAR;
            PG8_LDA(At, 0, 1); PG8_STAGE(PG8_SA(0, 0), a2, voffA);
            PG8_BAR; PG8_WAIT_L(0); PG8_MMA(1, 0, At, B0); PG8_BAR; PG8_SCHED;
            PG8_STAGE(PG8_SB(0, 1), b2 + hstep, voffB);
            PG8_WAIT_V(6); PG8_BAR; PG8_MMA(1, 1, At, B1); PG8_BAR;
            PG8_LDB(B0, 1, 0); PG8_SCHED; PG8_LDA(At, 1, 0); PG8_STAGE(PG8_SA(0, 1), a2 + hstep, voffA);
            PG8_WAIT_L(8); PG8_BAR; PG8_WAIT_L(0); PG8_MMA(0, 0, At, B0); PG8_BAR; PG8_SCHED;
            PG8_LDB(B1, 1, 1); PG8_STAGE(PG8_SB(1, 0), b3, voffB);
            PG8_BAR; PG8_WAIT_L(0); PG8_MMA(0, 1, At, B1); PG8_BAR;
            PG8_LDA(At, 1, 1); PG8_STAGE(PG8_SA(1, 0), a3, voffA);
            PG8_BAR; PG8_WAIT_L(0); PG8_MMA(1, 0, At, B0); PG8_BAR; PG8_SCHED;
            PG8_STAGE(PG8_SB(1, 1), b3 + hstep, voffB);
            PG8_WAIT_V(6); PG8_BAR; PG8_MMA(1, 1, At, B1); PG8_BAR;
            }
        }
        if constexpr (ALIGN_EPI) { if (wr == 0) PG8_BAR; }
        if constexpr (!Epi::AFTER_DRAIN) { E(acc, cur, wr, wc, fr, fq); S.done(cur); }
        if (!has_next) break;
#pragma unroll
        for (int a = 0; a < 2; ++a)
#pragma unroll
            for (int b = 0; b < 2; ++b)
#pragma unroll
                for (int m = 0; m < 4; ++m)
#pragma unroll
                    for (int n = 0; n < 2; ++n) acc[a][b][m][n] = (f32x4){0.f, 0.f, 0.f, 0.f};
        cur = nxt; cA = nA; cB = nB; ++ui;
        if constexpr (ALIGN_EPI) { if (wr == 1) PG8_BAR; }
    }
    PG8_WAIT_V(0);
    if constexpr (!ALIGN_EPI) { if (wr == 0) PG8_BAR; }
    PG8_BAR;
    if constexpr (Epi::AFTER_DRAIN) { E.fused(acc, cur, wr, wc, fr, fq, lds, wid, lane); S.done(cur); }
#undef PG8_SA
#undef PG8_SB
#undef PG8_STAGE
#undef PG8_LDA
#undef PG8_LDB
#undef PG8_MMA
#undef PG8_WAIT_V
#undef PG8_WAIT_L
#undef PG8_BAR
#undef PG8_SCHED
}
}
#ifndef FOX_NAIVE
#define FOX_NAIVE 0
#endif
#include <hip/hip_bf16.h>
#include <cmath>
namespace attn_body {
using bf16=__hip_bfloat16;
using bf16x8=__attribute__((ext_vector_type(8)))short;
using s16x4=__attribute__((ext_vector_type(4)))short;
using f32x16=__attribute__((ext_vector_type(16)))float;
using u32x4=__attribute__((ext_vector_type(4)))unsigned;
constexpr int BATCH=8,NHEAD=8,SEQ=2048,D=64,PQ=3584,PO=1024;
constexpr int NW=8,QBLK=32,QB=QBLK*NW,KVBLK=64,NQB=SEQ/QB;
constexpr int ATTN_UNIT_ROWS=QB;
__device__ __forceinline__ int crow(int r,int hi){return (r&3)+8*(r>>2)+4*hi;}
#define SBAR() __builtin_amdgcn_sched_barrier(0)
__device__ __forceinline__ void cmask(f32x16&p0,f32x16&p1,int jb,int qrel,int hi){
  const float NEG=-INFINITY; int kb=64*jb+4*hi;
  #pragma unroll
  for(int r=0;r<16;++r){int kv=kb+(r&3)+8*(r>>2); if(kv>qrel)p0[r]=NEG; if(kv+32>qrel)p1[r]=NEG;}
}

constexpr int NSLOT=3, SLOTB=8192;
constexpr int LDS_K=0, LDS_V=NSLOT*SLOTB, LDS_WS=2*NSLOT*SLOTB, LDS_OST=LDS_WS+NW*64*4, LDS_CK=LDS_OST+NW*4096, LDS_BYTES=LDS_CK+SEQ*4;
constexpr float C2=0.125f*1.4426950408889634f;
__device__ __forceinline__ void glds16(const void*gsrc,unsigned lds_dst){unsigned keep;
  asm volatile("s_mov_b32 %0, m0\n\ts_mov_b32 m0, %2\n\ts_nop 0\n\tglobal_load_lds_dwordx4 %1, off\n\ts_mov_b32 m0, %0":"=&s"(keep):"v"(gsrc),"s"(lds_dst):"memory");}
__device__ __forceinline__ float max3f(float a,float b,float c){float r;asm("v_max3_f32 %0, %1, %2, %3":"=v"(r):"v"(a),"v"(b),"v"(c));return r;}
__device__ __forceinline__ float max2f(float a,float b){float r;asm("v_max_f32_e32 %0, %1, %2":"=v"(r):"v"(a),"v"(b));return r;}
__device__ __forceinline__ float fadd_s(float a,float b){float r;asm("v_add_f32_e32 %0, %1, %2":"=v"(r):"v"(a),"v"(b));return r;}
__device__ __forceinline__ float fsub_s(float a,float b){float r;asm("v_sub_f32_e32 %0, %1, %2":"=v"(r):"v"(a),"v"(b));return r;}
typedef float f32x4_t __attribute__((ext_vector_type(4))); typedef float f32x2_t __attribute__((ext_vector_type(2))); typedef __bf16 bf16x2_t __attribute__((ext_vector_type(2)));
__device__ __forceinline__ unsigned cvtpk_s(float lo,float hi){f32x2_t v={lo,hi};bf16x2_t b=__builtin_convertvector(v,bf16x2_t);return __builtin_bit_cast(unsigned,b);}
#define WAIT_BAR(N) asm volatile("s_waitcnt vmcnt(" #N ") lgkmcnt(0)\n\ts_barrier":::"memory")

__device__ __forceinline__ void qkt(f32x16&p0,f32x16&p1,const char*Kslot,const bf16x8*qr,int r32,int hi){
  const char*kb=Kslot+hi*1024+r32*16;
  #pragma unroll
  for(int d0=0;d0<4;++d0){
    const bf16x8 b0=*reinterpret_cast<const bf16x8*>(kb+d0*2048);
    const bf16x8 b1=*reinterpret_cast<const bf16x8*>(kb+d0*2048+512);
    {p0=__builtin_amdgcn_mfma_f32_32x32x16_bf16(b0,qr[d0],p0,0,0,0);p1=__builtin_amdgcn_mfma_f32_32x32x16_bf16(b1,qr[d0],p1,0,0,0);}}
}
typedef __attribute__((address_space(3))) const char* lds_cptr;
typedef short v4i16_t __attribute__((ext_vector_type(4)));
__device__ __forceinline__ void kload8(bf16x8*kf,lds_cptr kp){
  kf[0]=*(const __attribute__((address_space(3))) bf16x8*)(kp);      kf[1]=*(const __attribute__((address_space(3))) bf16x8*)(kp+512);
  kf[2]=*(const __attribute__((address_space(3))) bf16x8*)(kp+2048); kf[3]=*(const __attribute__((address_space(3))) bf16x8*)(kp+2560);
  kf[4]=*(const __attribute__((address_space(3))) bf16x8*)(kp+4096); kf[5]=*(const __attribute__((address_space(3))) bf16x8*)(kp+4608);
  kf[6]=*(const __attribute__((address_space(3))) bf16x8*)(kp+6144); kf[7]=*(const __attribute__((address_space(3))) bf16x8*)(kp+6656);
}
__device__ __forceinline__ void kload2(bf16x8*kf,lds_cptr kp,int j){ kf[2*j]=*(const __attribute__((address_space(3))) bf16x8*)(kp+j*2048); kf[2*j+1]=*(const __attribute__((address_space(3))) bf16x8*)(kp+j*2048+512); }
__device__ __forceinline__ s16x4 vtr(lds_cptr p){ return __builtin_bit_cast(s16x4,__builtin_amdgcn_ds_read_tr16_b64_v4i16((__attribute__((address_space(3))) v4i16_t*)p)); }
__device__ __forceinline__ float rowmax(const f32x16&p0,const f32x16&p1){
  float a=max3f(p0[0],p0[1],p1[0]),b=max3f(p0[2],p0[3],p1[1]);a=max3f(a,p1[2],p1[3]);
  #pragma unroll
  for(int r=4;r<16;r+=4){a=max3f(a,p0[r],p0[r+1]);b=max3f(b,p0[r+2],p0[r+3]);a=max3f(a,p1[r],p1[r+1]);b=max3f(b,p1[r+2],p1[r+3]);}
  const float m=max2f(a,b);
  auto rr=__builtin_amdgcn_permlane32_swap(__float_as_uint(m),__float_as_uint(m),false,false);
  return max2f(__uint_as_float(rr[0]),__uint_as_float(rr[1]));
}
__device__ __forceinline__ void pv(f32x16*o,int vb,bf16x8 pa0,bf16x8 pa1,bf16x8 pa2,bf16x8 pa3){
  #pragma unroll
  for(int d0=0;d0<2;++d0){s16x4 lo[4],hi[4];
    #pragma unroll
    for(int ks=0;ks<4;++ks){
      asm volatile("ds_read_b64_tr_b16 %0,%1 offset:%c2":"=&v"(lo[ks]):"v"(vb),"i"(d0*4096+ks*1024):"memory");
      asm volatile("ds_read_b64_tr_b16 %0,%1 offset:%c2":"=&v"(hi[ks]):"v"(vb),"i"(d0*4096+ks*1024+512):"memory");}
    asm volatile("s_waitcnt lgkmcnt(0)":::"memory");SBAR();
    #define PK(k) (bf16x8){lo[k][0],lo[k][1],lo[k][2],lo[k][3],hi[k][0],hi[k][1],hi[k][2],hi[k][3]}
    o[d0]=__builtin_amdgcn_mfma_f32_32x32x16_bf16(pa0,PK(0),o[d0],0,0,0);
    o[d0]=__builtin_amdgcn_mfma_f32_32x32x16_bf16(pa1,PK(1),o[d0],0,0,0);
    o[d0]=__builtin_amdgcn_mfma_f32_32x32x16_bf16(pa2,PK(2),o[d0],0,0,0);
    o[d0]=__builtin_amdgcn_mfma_f32_32x32x16_bf16(pa3,PK(3),o[d0],0,0,0);
    #undef PK
  }
}

#ifndef ATTN_STORE16
#define ATTN_STORE16(p,v) (*(u32x4*)(p)=(v))
#endif
template<int THRL> __device__ __forceinline__ void attn_unit(int b,int h,int qb,const bf16*Q,const bf16*K,const bf16*V,bf16*O,const float*cum,char*shm){
  const int tid=threadIdx.x,lane=tid&63,r32=lane&31,hi=lane>>5; const int wid=__builtin_amdgcn_readfirstlane(tid>>6);
  const long rowbase=(long)b*SEQ; const int q0=qb*QB;
  const bf16*Qw=Q+(rowbase+q0+wid*QBLK)*PQ+h*D;
  const bf16*Kh=K+rowbase*PQ+h*D,*Vh=V+rowbase*PQ+h*D;
  const lds_cptr shm3_=(lds_cptr)shm;
  const unsigned lds0=(unsigned)(uintptr_t)shm;
  float*wsf=(float*)(shm+LDS_WS)+wid*64;
  const bf16*ksrc=Kh+(long)lane*PQ+wid*8;
  const bf16*vsrc=Vh+(long)(16*(wid&3)+(lane>>2))*PQ+(wid>>2)*32+(lane&3)*8;
  const unsigned kdst=lds0+LDS_K+wid*1024, vdst=lds0+LDS_V+wid*1024;
  #define DMA_K(t,slot) glds16(ksrc+(long)(t)*KVBLK*PQ,(unsigned)__builtin_amdgcn_readfirstlane(kdst+(slot)))
  #define DMA_V(t,slot) glds16(vsrc+(long)(t)*KVBLK*PQ,(unsigned)__builtin_amdgcn_readfirstlane(vdst+(slot)))
  const int vb0=(int)(lds0+LDS_V)+((lane>>4)&1)*32+(lane&3)*8+(4*hi+((lane&15)>>2))*64;
  const char*Kbase=shm+LDS_K; bf16x8 kf[8];
  const lds_cptr shm3=(lds_cptr)shm; const lds_cptr kp0=shm3+LDS_K+hi*1024+r32*16; const lds_cptr vp0=shm3+LDS_V+((lane>>4)&1)*32+(lane&3)*8+(4*hi+((lane&15)>>2))*64;
  const int NT=(q0+QB)/KVBLK;
  float cqm;
  { float*cks=(float*)(shm+LDS_CK); for(int i=tid;i<q0+QB;i+=NW*64)cks[i]=cum[i]; cqm=cum[q0+wid*QBLK+r32]; asm volatile("s_waitcnt vmcnt(0)":"+v"(cqm)::"memory"); }
  const __attribute__((address_space(3))) float*ckl=(const __attribute__((address_space(3))) float*)(shm3_+LDS_CK)+4*hi;
  #define BIASFILL(C0_,C1_,t_) do{ const __attribute__((address_space(3))) float*cp_=ckl+64*(t_); \
    _Pragma("unroll") for(int a_=0;a_<4;++a_){ const f32x4_t u_=*(const __attribute__((address_space(3))) f32x4_t*)(cp_+8*a_), w_=*(const __attribute__((address_space(3))) f32x4_t*)(cp_+32+8*a_); \
      _Pragma("unroll") for(int i_=0;i_<4;++i_){ C0_[4*a_+i_]=cqm-u_[i_]; C1_[4*a_+i_]=cqm-w_[i_]; } } }while(0)
  DMA_K(0,0);DMA_V(0,0);DMA_K(1,SLOTB);
  bf16x8 qr[4];
  #pragma unroll
  for(int d0=0;d0<4;++d0)qr[d0]=*reinterpret_cast<const bf16x8*>(&Qw[(long)r32*PQ+d0*16+hi*8]);
  float l_reg=0.f;f32x16 o[2];o[0]=f32x16{};o[1]=f32x16{};
  const int qrel=wid*QBLK+r32;
  #define CMASK(P0,P1,t) do{int jb_=(t)-(NT-4); if(jb_>=0)cmask(P0,P1,jb_,qrel,hi);}while(0)
  bool resc=false;
  #define START(P0,P1) do{ const float rm=rowmax(P0,P1); resc=false; \
    { const float dl=rm; cqm=fsub_s(cqm,dl); \
      _Pragma("unroll") for(int r=0;r<16;++r){P0[r]=fsub_s(P0[r],dl);P1[r]=fsub_s(P1[r],dl);} \
      } \
    _Pragma("unroll") for(int r=0;r<16;++r)P0[r]=__builtin_amdgcn_exp2f(P0[r]); }while(0)
  #define RESC() do{ if(resc){ asm volatile("s_waitcnt lgkmcnt(0)":::"memory"); \
      _Pragma("unroll") for(int d_=0;d_<2;++d_) _Pragma("unroll") for(int r=0;r<16;++r)o[d_][r]*=wsf[crow(r,hi)]; } }while(0)
  f32x16 pA0,pA1,pB0,pB1;
  int sl_prev=0,sl_cur=0,sl_next=SLOTB;
  #define ROT() do{sl_prev=sl_cur;sl_cur=sl_next;sl_next=(sl_next==(NSLOT-1)*SLOTB)?0:sl_next+SLOTB;}while(0)
  DMA_K(2,2*SLOTB);
  WAIT_BAR(3);
  BIASFILL(pA0,pA1,0); qkt(pA0,pA1,Kbase,qr,r32,hi);asm volatile("s_nop 15\n\ts_nop 7":"+v"(pA0),"+v"(pA1));CMASK(pA0,pA1,0);
  START(pA0,pA1);
  _Pragma("unroll") for(int r=0;r<16;++r)pA1[r]=__builtin_amdgcn_exp2f(pA1[r]);
  WAIT_BAR(0);
  DMA_K(3,0);DMA_V(1,SLOTB);
  ROT();
  kload8(kf,kp0+sl_cur);
  WAIT_BAR(2);
  s16x4 vlo[8],vhi[8]; u32x4 pw0,pw1,pw2,pw3;
  #define PKW(P,B) cvtpk_s(P[B],P[B+1])
  #define PAF(k) __builtin_bit_cast(bf16x8,pw##k)
  #define VFR(i) (bf16x8){vlo[i][0],vlo[i][1],vlo[i][2],vlo[i][3],vhi[i][0],vhi[i][1],vhi[i][2],vhi[i][3]}
  #define PIN(x) asm volatile("":"+v"(x))
  #define MX3(a,b,c) __builtin_fmaxf(__builtin_fmaxf((a),(b)),(c))
  #define GAPA(MF,A0,A1,A2,A3,W0,W1,PW) do{ MF; sacc+=A0; sacc+=A1; sacc+=A2; sacc+=A3; PIN(sacc); W0; W1; PIN(PW); SBAR(); }while(0)
  #define EX(v) __builtin_amdgcn_exp2f(v)
  #define GAPB(MF,X,B) do{ MF; X[B]=EX(X[B]); X[B+1]=EX(X[B+1]); X[B+2]=EX(X[B+2]); X[B+3]=EX(X[B+3]); PIN(X); SBAR(); }while(0)
  #define VRD(i) do{ vlo[i]=vtr(vp_+(((i)>>2)*4096+((i)&3)*1024)); vhi[i]=vtr(vp_+(((i)>>2)*4096+((i)&3)*1024+512)); }while(0)
  #define KRD(G,j) do{ if(G){ kload2(kf,kp0+sl_next,j); SBAR(); } }while(0)
  #define STEP(C0,C1,P0,P1,t,GK,GV,GL) do{ BIASFILL(C0,C1,t); SBAR(); \
    const lds_cptr vp_=vp0+sl_prev; \
    VRD(0); SBAR(); float sacc=(P0[0]+P0[1]); \
    GAPA(C0=__builtin_amdgcn_mfma_f32_32x32x16_bf16(kf[0],qr[0],C0,0,0,0), P0[2],P0[3],P0[4],P0[5],     pw0[0]=PKW(P0,0), pw0[1]=PKW(P0,2), pw0); \
    VRD(4); SBAR(); GAPA(C1=__builtin_amdgcn_mfma_f32_32x32x16_bf16(kf[1],qr[0],C1,0,0,0), P0[6],P0[7],P0[8],P0[9],     pw0[2]=PKW(P0,4), pw0[3]=PKW(P0,6), pw0); \
    VRD(1); SBAR(); GAPA(C0=__builtin_amdgcn_mfma_f32_32x32x16_bf16(kf[2],qr[1],C0,0,0,0),   P0[10],P0[11],P0[12],P0[13], pw1[0]=PKW(P0,8), pw1[1]=PKW(P0,10), pw1); \
    VRD(5); SBAR(); GAPA(C1=__builtin_amdgcn_mfma_f32_32x32x16_bf16(kf[3],qr[1],C1,0,0,0),   P0[14],P0[15],P1[0],P1[1],   pw1[2]=PKW(P0,12),pw1[3]=PKW(P0,14), pw1); \
    VRD(2); SBAR(); GAPA(C0=__builtin_amdgcn_mfma_f32_32x32x16_bf16(kf[4],qr[2],C0,0,0,0),   P1[2],P1[3],P1[4],P1[5],     pw2[0]=PKW(P1,0), pw2[1]=PKW(P1,2), pw2); \
    VRD(6); SBAR(); GAPA(C1=__builtin_amdgcn_mfma_f32_32x32x16_bf16(kf[5],qr[2],C1,0,0,0),   P1[6],P1[7],P1[8],P1[9],     pw2[2]=PKW(P1,4), pw2[3]=PKW(P1,6), pw2); \
    VRD(3); SBAR(); GAPA(C0=__builtin_amdgcn_mfma_f32_32x32x16_bf16(kf[6],qr[3],C0,0,0,0),   P1[10],P1[11],P1[12],P1[13], pw3[0]=PKW(P1,8), pw3[1]=PKW(P1,10), pw3); \
    VRD(7); SBAR(); GAPA(C1=__builtin_amdgcn_mfma_f32_32x32x16_bf16(kf[7],qr[3],C1,0,0,0),   P1[14],P1[15],0.f,0.f,       pw3[2]=PKW(P1,12),pw3[3]=PKW(P1,14), pw3); \
    l_reg+=sacc; \
    if(GK){DMA_K((t)+3,sl_cur);} if(GV){DMA_V((t)+1,sl_next);} \
    CMASK(C0,C1,t); \
    { float a=MX3(C0[0],C0[1],C1[0]),b=MX3(C0[2],C0[3],C1[1]); a=MX3(a,C1[2],C1[3]); \
      _Pragma("unroll") for(int r=4;r<16;r+=4){a=MX3(a,C0[r],C0[r+1]);b=MX3(b,C0[r+2],C0[r+3]);a=MX3(a,C1[r],C1[r+1]);b=MX3(b,C1[r+2],C1[r+3]);} \
      float rm=__builtin_fmaxf(a,b); { auto rr=__builtin_amdgcn_permlane32_swap(__float_as_uint(rm),__float_as_uint(rm),false,false); rm=__builtin_fmaxf(__uint_as_float(rr[0]),__uint_as_float(rr[1])); } \
      resc=false; \
      if(__builtin_expect(__any(rm>(float)THRL),0)){ const float dl=__builtin_fmaxf(rm,0.f); cqm-=dl; \
        _Pragma("unroll") for(int r=0;r<16;++r){C0[r]-=dl;C1[r]-=dl;} \
        const float f=__builtin_amdgcn_exp2f(-dl); l_reg*=f; if(hi==0)wsf[r32]=f; resc=true; } } \
    SBAR(); \
    GAPB(o[0]=__builtin_amdgcn_mfma_f32_32x32x16_bf16(PAF(0),VFR(0),o[0],0,0,0), C0,0); \
    GAPB(o[1]=__builtin_amdgcn_mfma_f32_32x32x16_bf16(PAF(0),VFR(4),o[1],0,0,0), C0,4); \
    KRD(GL,0); GAPB(o[0]=__builtin_amdgcn_mfma_f32_32x32x16_bf16(PAF(1),VFR(1),o[0],0,0,0), C0,8); \
    KRD(GL,1); GAPB(o[1]=__builtin_amdgcn_mfma_f32_32x32x16_bf16(PAF(1),VFR(5),o[1],0,0,0), C0,12); \
    KRD(GL,2); GAPB(o[0]=__builtin_amdgcn_mfma_f32_32x32x16_bf16(PAF(2),VFR(2),o[0],0,0,0), C1,0); \
    KRD(GL,3); GAPB(o[1]=__builtin_amdgcn_mfma_f32_32x32x16_bf16(PAF(2),VFR(6),o[1],0,0,0), C1,4); \
    GAPB(o[0]=__builtin_amdgcn_mfma_f32_32x32x16_bf16(PAF(3),VFR(3),o[0],0,0,0), C1,8); \
    GAPB(o[1]=__builtin_amdgcn_mfma_f32_32x32x16_bf16(PAF(3),VFR(7),o[1],0,0,0), C1,12); \
    }while(0)
  int t=1;
  #undef CMASK
  #define CMASK(P0,P1,t) do{}while(0)
  for(;t+5<NT;t+=2){
    STEP(pB0,pB1,pA0,pA1,t,true,true,true);     WAIT_BAR(2); RESC(); ROT();
    STEP(pA0,pA1,pB0,pB1,t+1,true,true,true);   WAIT_BAR(2); RESC(); ROT();
  }
  #undef CMASK
  #define CMASK(P0,P1,t) do{int jb_=(t)-(NT-4); if(jb_>=0)cmask(P0,P1,jb_,qrel,hi);}while(0)
  #define ENDW(tt) do{ if((tt)+3<NT){WAIT_BAR(2);} else if((tt)+2<NT){WAIT_BAR(1);} else {WAIT_BAR(0);} }while(0)
  for(;t+1<NT;t+=2){
    STEP(pB0,pB1,pA0,pA1,t,(t+3<NT),(t+1<NT),(t+1<NT));       ENDW(t);   RESC(); ROT();
    STEP(pA0,pA1,pB0,pB1,t+1,(t+4<NT),(t+2<NT),(t+2<NT));     ENDW(t+1); RESC(); ROT();
  }
  STEP(pB0,pB1,pA0,pA1,NT-1,false,false,false); RESC();
  { float sacc=pB0[0]+pB0[1]; _Pragma("unroll") for(int r=2;r<16;++r)sacc+=pB0[r]; _Pragma("unroll") for(int r=0;r<16;++r)sacc+=pB1[r]; l_reg+=sacc;
    pw0=(u32x4){PKW(pB0,0),PKW(pB0,2),PKW(pB0,4),PKW(pB0,6)};pw1=(u32x4){PKW(pB0,8),PKW(pB0,10),PKW(pB0,12),PKW(pB0,14)};pw2=(u32x4){PKW(pB1,0),PKW(pB1,2),PKW(pB1,4),PKW(pB1,6)};pw3=(u32x4){PKW(pB1,8),PKW(pB1,10),PKW(pB1,12),PKW(pB1,14)};
    SBAR(); pv(o,vb0+sl_cur,PAF(0),PAF(1),PAF(2),PAF(3)); }
  #undef PKW
  #undef PAF
  #undef VFR
  #undef PIN
  #undef MX3
  #undef GAPA
  #undef GAPB
  #undef EX
  #undef VRD
  #undef KRD
  #undef STEP
  #undef ENDW
  {auto rr=__builtin_amdgcn_permlane32_swap(__float_as_uint(l_reg),__float_as_uint(l_reg),false,false);l_reg=__uint_as_float(rr[0])+__uint_as_float(rr[1]);}
  if(hi==0)wsf[32+r32]=l_reg;asm volatile("s_waitcnt lgkmcnt(0)":::"memory");
  float rli[16];
  #pragma unroll
  for(int r=0;r<16;++r)rli[r]=__builtin_amdgcn_rcpf(wsf[32+crow(r,hi)]);
  bf16*Ow=O+(rowbase+q0+wid*QBLK)*PO+h*D;
  { bf16*stg=(bf16*)(shm+LDS_OST)+wid*2048;
    #pragma unroll
    for(int r=0;r<16;++r){const int orow=crow(r,hi);
      #pragma unroll
      for(int d0=0;d0<2;++d0)stg[orow*64+d0*32+r32]=__float2bfloat16(o[d0][r]*rli[r]);}
    asm volatile("s_waitcnt lgkmcnt(0)":::"memory");
    #pragma unroll
    for(int i=0;i<4;++i){const int row=i*8+(lane>>3),ch=lane&7; const u32x4 v=*(const u32x4*)(stg+row*64+ch*8); ATTN_STORE16(Ow+(long)row*PO+ch*8,v);} }
  asm volatile("s_waitcnt lgkmcnt(0)\n\ts_barrier":::"memory");
  #undef DMA_K
  #undef BIASFILL
  #undef DMA_V
  #undef CMASK
  #undef START
  #undef RESC
  #undef ROT
}
constexpr int ATTN_LDS_BYTES=LDS_BYTES;
struct AttnTensors { const bf16* Q; const bf16* K; const bf16* V; bf16* O; const float* cum; };
struct AttnUnit { int bh; int qb; };
struct StaticOrder {
  int vcu, G;
  __device__ __forceinline__ explicit StaticOrder(int grid,int v):vcu(v),G(grid){}
  __device__ __forceinline__ bool next(int i,AttnUnit&u)const{ const int pr=vcu+(i>>1)*G; if(pr>=256)return false; const int s=pr&3; u.bh=pr>>2; u.qb=(i&1)?7-s:s; return true; }
  __device__ __forceinline__ void a_ready(const AttnUnit&)const{}
  __device__ __forceinline__ void done(const AttnUnit&)const{}
};
template<class Sched,int THRL=8> __device__ __forceinline__ void attn_phase(char*lds,const AttnTensors&T,const Sched&S){
  AttnUnit u;
  for(int i=0;S.next(i,u);++i){ S.a_ready(u); attn_unit<THRL>(u.bh/NHEAD,u.bh%NHEAD,u.qb,T.Q,T.K,T.V,T.O,T.cum+(long)u.bh*SEQ,lds); S.done(u); }
}
#undef SBAR
#undef WAIT_BAR
}
constexpr int NWAVES = 8;
constexpr int T = 16384, D = 1024, SEQ = 2048, NBATCH = 8, DEPTH = 4;
constexpr float ALPHA = 1.6817928305074290f;
constexpr float LN_EPS = 1e-5f;
constexpr int AB_IN = 4112, CD_IN = 3600, NPE = 4096, NPO = 3584;
constexpr float LOG2E = 1.4426950408889634f;
constexpr float FOX_C2 = 0.125f * LOG2E;
constexpr float MLSTM_KSCALE = 0.08838834764831845f;
constexpr int RPAD = 40960;
constexpr int NPH_LAYER = 12, NPHASES = 1 + DEPTH * NPH_LAYER;
#ifndef MK_ONE_LAUNCH
#define MK_ONE_LAUNCH 1
#endif

constexpr size_t MiB = 1u << 20, KiB = 1u << 10;
constexpr size_t WS_CTL = 0, CTL_ZERO_BYTES = 1 * MiB;
constexpr size_t WS_BCNT = 1 * MiB, WS_PANEL = WS_BCNT + 64 * KiB, WS_ROUTE = WS_BCNT + 128 * KiB, WS_GATE = WS_BCNT + 384 * KiB, WS_POS = WS_BCNT + 512 * KiB,
                 WS_DEC = WS_BCNT + 640 * KiB, WS_MLOC = WS_BCNT + 704 * KiB, WS_BLAST = WS_BCNT + 712 * KiB, WS_MPREV = WS_BCNT + 720 * KiB,
                 WS_FOXC = 2 * MiB, WS_NLOC = 2 * MiB + 512 * KiB, WS_SG = 3 * MiB;
constexpr size_t WS_WINE = 4 * MiB, WS_WINO = 20 * MiB, WS_WOUTE = 34 * MiB, WS_WOUTO = 40 * MiB, WS_WGU = 44 * MiB, WS_WD = 300 * MiB;
constexpr size_t WS_HF = 428 * MiB, WS_HB = 492 * MiB, WS_H1F = 524 * MiB, WS_H1B = 588 * MiB;
constexpr size_t WS_R1 = 620 * MiB;
constexpr size_t WS_R2 = 748 * MiB;
constexpr size_t WS_R3 = 812 * MiB;
constexpr size_t WS_R4 = 860 * MiB;
constexpr size_t WS_MIX = 892 * MiB, WS_END = 940 * MiB;
constexpr int CW_BAR = 4096;

constexpr int RING_BYTES = 131072, SMALL_OFF = RING_BYTES, SMALL_BYTES = 8192, MISC_OFF = SMALL_OFF + SMALL_BYTES, LDS_BYTES = 147456;

#define GAS __attribute__((address_space(1)))
#define LAS __attribute__((address_space(3)))
typedef unsigned short bf16;
typedef unsigned v4u __attribute__((ext_vector_type(4)));
typedef unsigned v2u __attribute__((ext_vector_type(2)));
typedef float f32x4 __attribute__((ext_vector_type(4)));
typedef float f32x2 __attribute__((ext_vector_type(2)));
typedef int i32x4 __attribute__((ext_vector_type(4)));
typedef int i32x2 __attribute__((ext_vector_type(2)));
#define LDS_WAIT() asm volatile("s_waitcnt lgkmcnt(0)" ::: "memory")
__device__ __forceinline__ unsigned f2bf(float f) { unsigned u = __builtin_bit_cast(unsigned, f); return (u + 0x7fffu + ((u >> 16) & 1u)) >> 16; }
__device__ __forceinline__ unsigned pk2(float lo, float hi) { return f2bf(lo) | (f2bf(hi) << 16); }
__device__ __forceinline__ float bflo(unsigned w) { return __builtin_bit_cast(float, w << 16); }
__device__ __forceinline__ float bfhi(unsigned w) { return __builtin_bit_cast(float, w & 0xffff0000u); }
__device__ __forceinline__ float bf2f(bf16 b) { return __builtin_bit_cast(float, (unsigned)b << 16); }
__device__ __forceinline__ float wave_sum(float v) {
#pragma unroll
    for (int o = 1; o < 64; o <<= 1) v += __shfl_xor(v, o);
    return v;
}
__device__ __forceinline__ float wave_max(float v) {
#pragma unroll
    for (int o = 1; o < 64; o <<= 1) v = fmaxf(v, __shfl_xor(v, o));
    return v;
}
__device__ __forceinline__ float wave_scan_sum(float v, int lane) {
#pragma unroll
    for (int o = 1; o < 64; o <<= 1) { const float t = __shfl_up(v, o); if (lane >= o) v += t; }
    return v;
}
__device__ __forceinline__ float wave_scan_max(float v, int lane) {
#pragma unroll
    for (int o = 1; o < 64; o <<= 1) { const float t = __shfl_up(v, o); if (lane >= o) v = fmaxf(v, t); }
    return v;
}
__device__ __forceinline__ float softplus_f(float x) { return x > 20.f ? x : log1pf(expf(x)); }
__device__ __forceinline__ float logsigmoid_f(float x) { return fminf(x, 0.f) - log1pf(expf(-fabsf(x))); }
__device__ __forceinline__ float sigmoid_f(float x) { return 1.0f / (1.0f + expf(-x)); }
#define XB_TMO      128
#define XB_XCNT(j)  (256  + 64 * (j))
#define XB_XSUB(j)  (1280 + 64 * (j))
#define XB_XGEN(j)  (2304 + 64 * (j))
#define XB_TOP      3328
#define XB_TOPGEN   3392
#define XCD_BAR_WORDS 3456
#define XB_SPIN_CAP (1u << 18)

__device__ __forceinline__ unsigned xb_ld(unsigned* p)              { return __hip_atomic_load(p, __ATOMIC_RELAXED, __HIP_MEMORY_SCOPE_AGENT); }
__device__ __forceinline__ unsigned xb_add(unsigned* p, unsigned v) { return __hip_atomic_fetch_add(p, v, __ATOMIC_RELAXED, __HIP_MEMORY_SCOPE_AGENT); }
__device__ __forceinline__ unsigned xb_xcc_id() { return (unsigned)__builtin_amdgcn_s_getreg((3 << 11) | 20) & 0xFu; }
#define XB_SPIN(cond, bar) do { unsigned _sp = 0; while (cond) { __builtin_amdgcn_s_sleep(1); \
    if ((++_sp & 255u) == 0u) { if (xb_ld(&(bar)[XB_TMO])) break; if (_sp > XB_SPIN_CAP) { atomicAdd(&(bar)[XB_TMO], 1u); break; } } } } while (0)

struct XcdBarrier {
    unsigned* bar; unsigned x;
    volatile LAS unsigned* st;
};

__device__ __forceinline__ XcdBarrier xcd_barrier_post(unsigned* bar, volatile LAS unsigned* st) {
    XcdBarrier b; b.bar = bar; b.x = xb_xcc_id(); b.st = st;
    if (threadIdx.x == 0) (void)xb_add(&bar[XB_XCNT(b.x)], 1u);
    return b;
}
__device__ __forceinline__ void xcd_barrier_complete(unsigned* bar, unsigned x, unsigned& nloc, unsigned& nx) {
    const unsigned G = gridDim.x * gridDim.y * gridDim.z;
    unsigned sum, cnt, mine, sp = 0u;
    for (;;) {
        sum = 0u; cnt = 0u; mine = 0u;
#pragma unroll
        for (unsigned j = 0; j < 16; ++j) { const unsigned c = xb_ld(&bar[XB_XCNT(j)]); sum += c; cnt += (c > 0u) ? 1u : 0u; mine = (j == x) ? c : mine; }
        if (sum == G) break;
        __builtin_amdgcn_s_sleep(1);
        if ((++sp & 255u) == 0u) { if (xb_ld(&bar[XB_TMO])) break; if (sp > XB_SPIN_CAP) { atomicAdd(&bar[XB_TMO], 1u); break; } }
    }
    nloc = mine > 0u ? mine : 1u; nx = cnt > 0u ? cnt : 1u;
}

__device__ __forceinline__ void xcd_barrier(const XcdBarrier& b) {
    asm volatile("s_waitcnt vmcnt(0)" ::: "memory");
    __syncthreads();
    if (threadIdx.x == 0) {
        unsigned* bar = b.bar;
        __builtin_amdgcn_s_waitcnt(0);
        unsigned nloc = b.st[0], nx = b.st[1];
        if (nloc == 0u) { xcd_barrier_complete(bar, b.x, nloc, nx); b.st[0] = nloc; b.st[1] = nx; }
        const unsigned old = xb_add(&bar[XB_XSUB(b.x)], 1u);
        const unsigned gen = old / nloc;
        if (old + 1u == (gen + 1u) * nloc) {
            __builtin_amdgcn_fence(__ATOMIC_RELEASE, "agent");
            asm volatile("s_waitcnt vmcnt(0)" ::: "memory");
            const unsigned og = xb_add(&bar[XB_TOP], 1u);
            const unsigned tg = og / nx;
            if (og + 1u == (tg + 1u) * nx) xb_add(&bar[XB_TOPGEN], 1u);
            else XB_SPIN(xb_ld(&bar[XB_TOPGEN]) == tg, bar);
            __builtin_amdgcn_fence(__ATOMIC_ACQUIRE, "agent");
            xb_add(&bar[XB_XGEN(b.x)], 1u);
            asm volatile("s_waitcnt vmcnt(0)" ::: "memory");
        } else {
            XB_SPIN(xb_ld(&bar[XB_XGEN(b.x)]) == gen, bar);
            __builtin_amdgcn_fence(__ATOMIC_ACQUIRE, "agent");
            asm volatile("s_waitcnt vmcnt(0)" ::: "memory");
        }
    }
    __syncthreads();
}
struct Frame {
    LAS unsigned char* lds;
    volatile LAS unsigned* MISC;
    unsigned* ctl;
    int tid, lane, wave, vcu, G, gw, NGW;
    float* out; unsigned char* ws;
};
typedef const float* const cfpc_t; typedef __attribute__((address_space(4))) cfpc_t* kargp_t;
__device__ __forceinline__ kargp_t kin() { kargp_t p = (kargp_t)__builtin_amdgcn_kernarg_segment_ptr(); asm volatile("" : "+s"(p)); return p; }
#define KIN(i) (kin()[i])
enum { I_X = 0, I_ABWIN, I_CONVA, I_CONVW, I_CONVB, I_DTB, I_ALOG, I_DSKIP, I_NORMW, I_ABWOUT, I_CDWIN, I_IB, I_FB, I_HNW, I_FOXB, I_CDWOUT, I_LN1G, I_LN1B, I_LN2G, I_LN2B,
       I_RGW, I_RGB, I_REW, I_REB, I_WG, I_WU, I_WDN };

__device__ __forceinline__ void row_load(const float* row, int lane, f32x4 (&v)[4]) {
#pragma unroll
    for (int j = 0; j < 4; ++j) v[j] = ((const f32x4*)row)[lane + 64 * j];
}
__device__ __forceinline__ void row_store_f32(float* row, int lane, const f32x4 (&v)[4]) {
#pragma unroll
    for (int j = 0; j < 4; ++j) ((f32x4*)row)[lane + 64 * j] = v[j];
}
__device__ __forceinline__ void row_store_bf16(bf16* row, int lane, const f32x4 (&v)[4]) {
#pragma unroll
    for (int j = 0; j < 4; ++j) { v2u w; w.x = pk2(v[j][0], v[j][1]); w.y = pk2(v[j][2], v[j][3]); ((v2u*)row)[lane + 64 * j] = w; }
}
__device__ __forceinline__ void row_load_bf16(const bf16* row, int lane, f32x4 (&v)[4]) {
#pragma unroll
    for (int j = 0; j < 4; ++j) { const v2u w = ((const v2u*)row)[lane + 64 * j]; v[j] = (f32x4){bflo(w.x), bfhi(w.x), bflo(w.y), bfhi(w.y)}; }
}
__device__ __forceinline__ void row_layernorm(f32x4 (&v)[4], const float* g, const float* b, int lane) {
    float s = 0.f;
#pragma unroll
    for (int j = 0; j < 4; ++j) s += (v[j][0] + v[j][1]) + (v[j][2] + v[j][3]);
    const float mean = wave_sum(s) * (1.f / D); float s2 = 0.f;
#pragma unroll
    for (int j = 0; j < 4; ++j) { v[j] = v[j] - mean; s2 += (v[j][0] * v[j][0] + v[j][1] * v[j][1]) + (v[j][2] * v[j][2] + v[j][3] * v[j][3]); }
    const float rstd = 1.0f / sqrtf(wave_sum(s2) * (1.f / D) + LN_EPS);
#pragma unroll
    for (int j = 0; j < 4; ++j) { const f32x4 gg = ((const f32x4*)g)[lane + 64 * j], bb = ((const f32x4*)b)[lane + 64 * j]; v[j] = v[j] * rstd * gg + bb; }
}
__device__ __forceinline__ void row_proj16(const f32x4 (&v)[4], const float* W, int ldw, int c0a, int c0b, float* sg, int lane) {
    float a[16];
#pragma unroll
    for (int c = 0; c < 16; ++c) a[c] = 0.f;
#pragma unroll
    for (int j = 0; j < 4; ++j)
#pragma unroll
        for (int i = 0; i < 4; ++i) { const float x = v[j][i]; const float* wr = W + (size_t)(256 * j + 4 * lane + i) * ldw;
            const f32x4 w0 = *(const f32x4*)(wr + c0a), w1 = *(const f32x4*)(wr + c0a + 4), w2 = *(const f32x4*)(wr + c0b), w3 = *(const f32x4*)(wr + c0b + 4);
#pragma unroll
            for (int c = 0; c < 4; ++c) { a[c] += x * w0[c]; a[4 + c] += x * w1[c]; a[8 + c] += x * w2[c]; a[12 + c] += x * w3[c]; } }
    float r = 0.f;
#pragma unroll
    for (int c = 0; c < 16; ++c) { const float s = wave_sum(a[c]); r = (lane == c) ? s : r; }
    if (lane < 16) sg[lane] = r;
}
__device__ __forceinline__ void row_gate_proj(Frame& F, const f32x4 (&v)[4], int layer, int m) {
    float* sg = (float*)(F.ws + WS_SG) + (size_t)m * 16; const int j = layer >> 1;
    if ((layer & 1) == 0) row_proj16(v, KIN(I_ABWIN) + (size_t)j * D * AB_IN, AB_IN, 4096, 4104, sg, F.lane);
    else                  row_proj16(v, KIN(I_CDWIN) + (size_t)j * D * CD_IN, CD_IN, 1536, 3592, sg, F.lane);
}

__device__ __forceinline__ void transpose_tile(const float* W, int ldw, int k0, int n0, bf16* WT, int ldt, int drow0, float scale, const float* kscale, LAS float* scr, int lane) {
#pragma unroll 8
    for (int i = 0; i < 32; ++i) { const int kk = 2 * i + (lane >> 5); float v = W[(size_t)(k0 + kk) * ldw + n0 + (lane & 31)] * scale; if (kscale) v *= kscale[kk]; scr[kk * 33 + (lane & 31)] = v; }
    LDS_WAIT(); asm volatile("" ::: "memory");
    const int c = lane & 7;
#pragma unroll
    for (int j = 0; j < 4; ++j) { const int n = (lane >> 3) + 8 * j; const LAS float* s = scr + (8 * c) * 33 + n;
        v4u o; o.x = pk2(s[0 * 33], s[1 * 33]); o.y = pk2(s[2 * 33], s[3 * 33]); o.z = pk2(s[4 * 33], s[5 * 33]); o.w = pk2(s[6 * 33], s[7 * 33]);
        *(v4u*)(WT + (size_t)(drow0 + n) * ldt + k0 + 8 * c) = o; }
    LDS_WAIT(); asm volatile("" ::: "memory");
}
__device__ __forceinline__ void p_prologue(Frame& F) {
    LAS float* scr = (LAS float*)(F.lds + F.wave * 16384);
    bf16* WinE = (bf16*)(F.ws + WS_WINE); bf16* WinO = (bf16*)(F.ws + WS_WINO); bf16* WoutE = (bf16*)(F.ws + WS_WOUTE); bf16* WoutO = (bf16*)(F.ws + WS_WOUTO);
    bf16* Wgu = (bf16*)(F.ws + WS_WGU); bf16* Wd = (bf16*)(F.ws + WS_WD);
    constexpr int N_WINE = 2 * 2048, N_WINO = 2 * 1792, N_WOE = 2 * 768, N_WOO = 2 * 512, N_GU = 128 * 512, N_D = 128 * 256;
    constexpr int NITEMS = N_WINE + N_WINO + N_WOE + N_WOO + N_GU + N_D;
    for (int it = F.gw; it < NITEMS; it += F.NGW) {
        int r = it;
        if (r < N_WINE) { const int j = r / 2048, q = r % 2048, kb = q / 128, nb = q % 128;
            transpose_tile(KIN(I_ABWIN) + (size_t)j * D * AB_IN, AB_IN, 64 * kb, 32 * nb, WinE + (size_t)j * NPE * D, D, 32 * nb, 1.f, nullptr, scr, F.lane); continue; } r -= N_WINE;
        if (r < N_WINO) { const int j = r / 1792, q = r % 1792, seg = q / 256, q2 = q % 256, kb = q2 / 16, nb = q2 % 16;
            const int scol = (seg < 3 ? 512 * seg : 1544 + 512 * (seg - 3)) + 32 * nb; const float sc = seg == 1 ? MLSTM_KSCALE : (seg == 4 ? FOX_C2 : 1.f);
            transpose_tile(KIN(I_CDWIN) + (size_t)j * D * CD_IN, CD_IN, 64 * kb, scol, WinO + (size_t)j * NPO * D, D, 512 * seg + 32 * nb, sc, nullptr, scr, F.lane); continue; } r -= N_WINO;
        if (r < N_WOE) { const int j = r / 768, q = r % 768, kb = q / 32, nb = q % 32;
            const float* ks = kb >= 8 ? KIN(I_NORMW) + (size_t)j * 1024 + (64 * kb - 512) : nullptr;
            transpose_tile(KIN(I_ABWOUT) + (size_t)j * 1536 * D, D, 64 * kb, 32 * nb, WoutE + (size_t)j * D * 1536, 1536, 32 * nb, 1.f, ks, scr, F.lane); continue; } r -= N_WOE;
        if (r < N_WOO) { const int j = r / 512, q = r % 512, kb = q / 32, nb = q % 32;
            transpose_tile(KIN(I_CDWOUT) + (size_t)j * D * D, D, 64 * kb, 32 * nb, WoutO + (size_t)j * D * D, D, 32 * nb, 1.f, nullptr, scr, F.lane); continue; } r -= N_WOO;
        if (r < N_GU) { const int le = r / 512, q = r % 512, half = q / 256, q2 = q % 256, kb = q2 / 16, nb = q2 % 16, n0 = 32 * nb;
            const float* src = (half ? KIN(I_WU) : KIN(I_WG)) + (size_t)le * D * 512;
            transpose_tile(src, 512, 64 * kb, n0, Wgu + (size_t)le * D * D, D, 256 * (n0 / 128) + 128 * half + (n0 % 128), 1.f, nullptr, scr, F.lane); continue; } r -= N_GU;
        { const int le = r / 256, q = r % 256, kb = q / 32, nb = q % 32;
            transpose_tile(KIN(I_WDN) + (size_t)le * 512 * D, D, 64 * kb, 32 * nb, Wd + (size_t)le * D * 512, 512, 32 * nb, 1.f, nullptr, scr, F.lane); }
    }
    bf16* HB = (bf16*)(F.ws + WS_HB);
    for (int m = F.gw; m < T; m += F.NGW) { f32x4 v[4]; row_load(KIN(I_X) + (size_t)m * D, F.lane, v); row_store_bf16(HB + (size_t)m * D, F.lane, v); row_gate_proj(F, v, 0, m); }
}
__device__ __forceinline__ void e0_conv(Frame& F, int j) {
    const bf16* P = (const bf16*)(F.ws + WS_R1); bf16* XBC = (bf16*)(F.ws + WS_R3); bf16* MIX = (bf16*)(F.ws + WS_MIX);
    const float* cw = KIN(I_CONVW) + (size_t)j * 4 * 1536; const float* cb = KIN(I_CONVB) + (size_t)j * 1536; const float* ca = KIN(I_CONVA) + (size_t)j * 3 * 512;
    for (int it = F.gw; it < (T / 8) * 16; it += F.NGW) {
        const int tt = it >> 4, cg = it & 15, t0 = tt * 8, s0 = t0 & (SEQ - 1);
        if (cg < 12) {
            const int c = cg * 128 + 2 * F.lane;
            float w0[4], w1[4];
#pragma unroll
            for (int k = 0; k < 4; ++k) { w0[k] = cw[k * 1536 + c]; w1[k] = cw[k * 1536 + c + 1]; }
            const float b0 = cb[c], b1 = cb[c + 1];
            float xa[11], xb[11];
#pragma unroll
            for (int r = 0; r < 11; ++r) { unsigned w = 0u; if (s0 - 3 + r >= 0) w = *(const unsigned*)(P + (size_t)(t0 - 3 + r) * NPE + 2560 + c); xa[r] = bflo(w); xb[r] = bfhi(w); }
#pragma unroll
            for (int o = 0; o < 8; ++o) { float a0 = b0, a1 = b1;
#pragma unroll
                for (int k = 0; k < 4; ++k) { a0 += w0[k] * xa[o + k]; a1 += w1[k] * xb[o + k]; }
                *(unsigned*)(XBC + (size_t)(t0 + o) * 1536 + c) = pk2(silu_f(a0), silu_f(a1)); }
        } else {
            const int c = (cg - 12) * 128 + 2 * F.lane;
            float w0[3], w1[3];
#pragma unroll
            for (int k = 0; k < 3; ++k) { w0[k] = ca[k * 512 + c]; w1[k] = ca[k * 512 + c + 1]; }
            float ua[10], ub[10];
#pragma unroll
            for (int r = 0; r < 10; ++r) { float a = 0.f, b = 0.f;
                if (s0 - 2 + r >= 0) { const bf16* pr = P + (size_t)(t0 - 2 + r) * NPE; const unsigned cgw = *(const unsigned*)(pr + 512 + c), xw = *(const unsigned*)(pr + 1024 + c); a = bflo(cgw) * bflo(xw); b = bfhi(cgw) * bfhi(xw); }
                ua[r] = a; ub[r] = b; }
#pragma unroll
            for (int o = 0; o < 8; ++o) { float a0 = 0.f, a1 = 0.f;
#pragma unroll
                for (int k = 0; k < 3; ++k) { a0 += w0[k] * ua[o + k]; a1 += w1[k] * ub[o + k]; }
                const unsigned bg = *(const unsigned*)(P + (size_t)(t0 + o) * NPE + c);
                *(unsigned*)(MIX + (size_t)(t0 + o) * 1536 + c) = pk2(bflo(bg) * a0, bfhi(bg) * a1); }
        }
    }
}
__device__ __forceinline__ void ssd_gates(Frame& F, int j, int t0, int h, LAS float* dtl, LAS float* acs) {
    if (F.wave == 0) {
        const float* SG = (const float*)(F.ws + WS_SG); const float dtb = KIN(I_DTB)[j * 16 + h], aneg = -expf(KIN(I_ALOG)[j * 16 + h]);
        const float d0 = softplus_f(SG[(size_t)(t0 + 2 * F.lane) * 16 + h] + dtb), d1 = softplus_f(SG[(size_t)(t0 + 2 * F.lane + 1) * 16 + h] + dtb);
        const float a0 = d0 * aneg, a1 = d1 * aneg; const float inc = wave_scan_sum(a0 + a1, F.lane);
        dtl[2 * F.lane] = d0; dtl[2 * F.lane + 1] = d1; acs[2 * F.lane] = inc - a1; acs[2 * F.lane + 1] = inc;
    }
}
__device__ __forceinline__ void e1_states(Frame& F, int j) {
    const bf16* XBC = (const bf16*)(F.ws + WS_R3); float* ST = (float*)(F.ws + WS_R4); float* DEC = (float*)(F.ws + WS_DEC);
    LAS float* xw = (LAS float*)F.lds; LAS float* Bm = (LAS float*)(F.lds + 32768); LAS float* dtl = (LAS float*)(F.lds + SMALL_OFF); LAS float* acs = dtl + 128;
    for (int u = F.vcu; u < 2048; u += F.G) {
        const int b = u >> 8, c = (u >> 4) & 15, h = u & 15, g = h >> 2, t0 = b * SEQ + c * 128;
        __syncthreads();
        ssd_gates(F, j, t0, h, dtl, acs);
        __syncthreads();
        for (int i = F.tid; i < 128 * 32; i += 512) { const int l = i >> 5, pp = (i & 31) * 2; const float wgt = expf(acs[127] - acs[l]) * dtl[l];
            const unsigned xv = *(const unsigned*)(XBC + (size_t)(t0 + l) * 1536 + h * 64 + pp), bv = *(const unsigned*)(XBC + (size_t)(t0 + l) * 1536 + 1024 + g * 64 + pp);
            xw[l * 64 + pp] = bflo(xv) * wgt; xw[l * 64 + pp + 1] = bfhi(xv) * wgt; Bm[l * 64 + pp] = bflo(bv); Bm[l * 64 + pp + 1] = bfhi(bv); }
        __syncthreads();
        const int n = F.lane, p0 = 8 * F.wave; float acc[8];
#pragma unroll
        for (int i = 0; i < 8; ++i) acc[i] = 0.f;
#pragma unroll 2
        for (int l = 0; l < 128; ++l) { const float bm = Bm[l * 64 + n]; const f32x4 x0 = *(const LAS f32x4*)(xw + l * 64 + p0), x1 = *(const LAS f32x4*)(xw + l * 64 + p0 + 4);
#pragma unroll
            for (int i = 0; i < 4; ++i) { acc[i] += x0[i] * bm; acc[4 + i] += x1[i] * bm; } }
        float* dst = ST + (size_t)u * 4096;
#pragma unroll
        for (int i = 0; i < 8; ++i) dst[(p0 + i) * 64 + n] = acc[i];
        if (F.tid == 0) DEC[u] = expf(acs[127]);
    }
}
__device__ __forceinline__ void e2_scan(Frame& F) {
    float* ST = (float*)(F.ws + WS_R4); const float* DEC = (const float*)(F.ws + WS_DEC);
    for (int e = F.vcu * 512 + F.tid; e < NBATCH * 16 * 4096; e += F.G * 512) {
        const int b = e >> 16, h = (e >> 12) & 15, pn = e & 4095; float run = 0.f;
        for (int c = 0; c < 16; ++c) { const int u = (b * 16 + c) * 16 + h; const size_t idx = (size_t)u * 4096 + pn; const float s = ST[idx]; ST[idx] = run; run = run * DEC[u] + s; }
    }
}
__device__ __forceinline__ void e3_output(Frame& F, int j) {
    const bf16* XBC = (const bf16*)(F.ws + WS_R3); const float* ST = (const float*)(F.ws + WS_R4); float* Y = (float*)(F.ws + WS_R2);
    LAS float* R0 = (LAS float*)F.lds;
    LAS float* R1 = (LAS float*)(F.lds + 32768);
    LAS float* R2 = (LAS float*)(F.lds + 65536);
    LAS float* dtl = (LAS float*)(F.lds + SMALL_OFF); LAS float* acs = dtl + 128;
    for (int u = F.vcu; u < 2048; u += F.G) {
        const int b = u >> 8, c = (u >> 4) & 15, h = u & 15, g = h >> 2, t0 = b * SEQ + c * 128;
        __syncthreads();
        ssd_gates(F, j, t0, h, dtl, acs);
        for (int i = F.tid; i < 128 * 32; i += 512) { const int l = i >> 5, nn = (i & 31) * 2;
            const unsigned bv = *(const unsigned*)(XBC + (size_t)(t0 + l) * 1536 + 1024 + g * 64 + nn), cv = *(const unsigned*)(XBC + (size_t)(t0 + l) * 1536 + 1280 + g * 64 + nn);
            R0[l * 64 + nn] = bflo(cv); R0[l * 64 + nn + 1] = bfhi(cv); R1[nn * 128 + l] = bflo(bv); R1[(nn + 1) * 128 + l] = bfhi(bv); }
        { const float* hp = ST + (size_t)u * 4096; for (int i = F.tid; i < 4096; i += 512) { const int p = i >> 6, n = i & 63; R2[n * 64 + p] = hp[i]; } }
        __syncthreads();
        const int p = F.lane, l0 = 16 * F.wave; float acc[16];
#pragma unroll
        for (int i = 0; i < 16; ++i) acc[i] = 0.f;
#pragma unroll 1
        for (int n0 = 0; n0 < 64; n0 += 4) { float hp[4];
#pragma unroll
            for (int i = 0; i < 4; ++i) hp[i] = R2[(n0 + i) * 64 + p];
#pragma unroll
            for (int li = 0; li < 16; ++li) { const f32x4 c4 = *(const LAS f32x4*)(R0 + (l0 + li) * 64 + n0); acc[li] += (c4[0] * hp[0] + c4[1] * hp[1]) + (c4[2] * hp[2] + c4[3] * hp[3]); } }
#pragma unroll
        for (int li = 0; li < 16; ++li) acc[li] *= expf(acs[l0 + li]);
        __syncthreads();
#pragma unroll 1
        for (int half = 0; half < 2; ++half) { const int s = F.tid & 127, lg = 32 * (F.tid >> 7) + 16 * half; float gacc[16];
#pragma unroll
            for (int i = 0; i < 16; ++i) gacc[i] = 0.f;
#pragma unroll 1
            for (int n0 = 0; n0 < 64; n0 += 4) { float bb[4];
#pragma unroll
                for (int i = 0; i < 4; ++i) bb[i] = R1[(n0 + i) * 128 + s];
#pragma unroll
                for (int li = 0; li < 16; ++li) { const f32x4 c4 = *(const LAS f32x4*)(R0 + (lg + li) * 64 + n0); gacc[li] += (c4[0] * bb[0] + c4[1] * bb[1]) + (c4[2] * bb[2] + c4[3] * bb[3]); } }
            const float as = acs[s];
#pragma unroll
            for (int li = 0; li < 16; ++li) { const int l = lg + li; R2[l * 128 + s] = (s <= l) ? gacc[li] * expf(acs[l] - as) : 0.f; } }
        __syncthreads();
        for (int i = F.tid; i < 128 * 32; i += 512) { const int l = i >> 5, pp = (i & 31) * 2; const unsigned xv = *(const unsigned*)(XBC + (size_t)(t0 + l) * 1536 + h * 64 + pp);
            R0[l * 64 + pp] = bflo(xv); R0[l * 64 + pp + 1] = bfhi(xv); }
        __syncthreads();
#pragma unroll 1
        for (int s0 = 0; s0 < l0 + 16; s0 += 4) { float xv[4];
#pragma unroll
            for (int i = 0; i < 4; ++i) xv[i] = R0[(s0 + i) * 64 + p] * dtl[s0 + i];
#pragma unroll
            for (int li = 0; li < 16; ++li) { const f32x4 g4 = *(const LAS f32x4*)(R2 + (l0 + li) * 128 + s0); acc[li] += (g4[0] * xv[0] + g4[1] * xv[1]) + (g4[2] * xv[2] + g4[3] * xv[3]); } }
        const float dsk = KIN(I_DSKIP)[j * 16 + h];
#pragma unroll
        for (int li = 0; li < 16; ++li) Y[(size_t)(t0 + l0 + li) * D + h * 64 + p] = acc[li] + dsk * R0[(l0 + li) * 64 + p];
    }
}
__device__ __forceinline__ void e4_gnorm(Frame& F) {
    const float* Y = (const float*)(F.ws + WS_R2); const bf16* P = (const bf16*)(F.ws + WS_R1); bf16* MIX = (bf16*)(F.ws + WS_MIX);
    for (int m = F.gw; m < T; m += F.NGW) { f32x4 y[4], z[4]; row_load(Y + (size_t)m * D, F.lane, y); row_load_bf16(P + (size_t)m * NPE + 1536, F.lane, z); float ss = 0.f;
#pragma unroll
        for (int jj = 0; jj < 4; ++jj)
#pragma unroll
            for (int i = 0; i < 4; ++i) { const float uu = y[jj][i] * silu_f(z[jj][i]); y[jj][i] = uu; ss += uu * uu; }
        const float rstd = 1.0f / sqrtf(wave_sum(ss) * (1.f / D) + LN_EPS);
#pragma unroll
        for (int jj = 0; jj < 4; ++jj) y[jj] = y[jj] * rstd;
        row_store_bf16(MIX + (size_t)m * 1536 + 512, F.lane, y); }
}
__device__ __forceinline__ void o_foxscan(Frame& F, int j) {
    const float* SG = (const float*)(F.ws + WS_SG); float* FOXC = (float*)(F.ws + WS_FOXC);
    for (int bh = F.gw; bh < 64; bh += F.NGW) { const int b = bh >> 3, h = bh & 7; const float bias = KIN(I_FOXB)[j * 8 + h];
        float v[32], run = 0.f;
#pragma unroll
        for (int i = 0; i < 32; ++i) { run += logsigmoid_f(SG[(size_t)(b * SEQ + 32 * F.lane + i) * 16 + 8 + h] + bias); v[i] = run; }
        const float off = wave_scan_sum(run, F.lane) - run;
#pragma unroll
        for (int i = 0; i < 32; ++i) FOXC[(size_t)bh * SEQ + 32 * F.lane + i] = (v[i] + off) * LOG2E; }
}
__device__ __forceinline__ void mlstm_gates(Frame& F, int j, int t0, int h, float& bcum, float& ib) {
    const float* SG = (const float*)(F.ws + WS_SG);
    ib = SG[(size_t)(t0 + F.lane) * 16 + h] + KIN(I_IB)[j * 4 + h];
    bcum = wave_scan_sum(logsigmoid_f(SG[(size_t)(t0 + F.lane) * 16 + 4 + h] + KIN(I_FB)[j * 4 + h]), F.lane);
}
__device__ __forceinline__ void o1_local(Frame& F, int j) {
    const bf16* P = (const bf16*)(F.ws + WS_R1); float* KLOC = (float*)(F.ws + WS_R2); float* NLOC = (float*)(F.ws + WS_NLOC); float* MLOC = (float*)(F.ws + WS_MLOC); float* BLAST = (float*)(F.ws + WS_BLAST);
    LAS float* kw = (LAS float*)F.lds; LAS float* Vs = (LAS float*)(F.lds + 32768); LAS float* wk = (LAS float*)(F.lds + SMALL_OFF);
    for (int u = F.vcu; u < 1024; u += F.G) {
        const int b = u >> 7, h = (u >> 5) & 3, c = u & 31, t0 = b * SEQ + c * 64;
        __syncthreads();
        if (F.wave == 0) { float bcum, ib; mlstm_gates(F, j, t0, h, bcum, ib); const float blast = __shfl(bcum, 63); const float gl = blast - bcum + ib; const float ml = wave_max(gl);
            wk[F.lane] = expf(gl - ml); if (F.lane == 0) { MLOC[u] = ml; BLAST[u] = blast; } }
        __syncthreads();
        for (int i = F.tid; i < 64 * 64; i += 512) { const int s = i >> 6, dd = (i & 63) * 2; const float w = wk[s];
            const unsigned kv = *(const unsigned*)(P + (size_t)(t0 + s) * NPO + 512 + h * 128 + dd), vv = *(const unsigned*)(P + (size_t)(t0 + s) * NPO + 1024 + h * 128 + dd);
            kw[s * 128 + dd] = bflo(kv) * w; kw[s * 128 + dd + 1] = bfhi(kv) * w; Vs[s * 128 + dd] = bflo(vv); Vs[s * 128 + dd + 1] = bfhi(vv); }
        __syncthreads();
        const int v = F.tid & 127, d0 = 32 * (F.tid >> 7); float acc[32];
#pragma unroll
        for (int i = 0; i < 32; ++i) acc[i] = 0.f;
#pragma unroll 1
        for (int s = 0; s < 64; ++s) { const float vv = Vs[s * 128 + v];
#pragma unroll
            for (int di = 0; di < 32; di += 4) { const f32x4 k4 = *(const LAS f32x4*)(kw + s * 128 + d0 + di);
#pragma unroll
                for (int i = 0; i < 4; ++i) acc[di + i] += k4[i] * vv; } }
        float* dst = KLOC + (size_t)u * 16384;
#pragma unroll
        for (int i = 0; i < 32; ++i) dst[(d0 + i) * 128 + v] = acc[i];
        if (F.tid < 128) { float a = 0.f; for (int s = 0; s < 64; ++s) a += kw[s * 128 + F.tid]; NLOC[(size_t)u * 128 + F.tid] = a; }
    }
}
__device__ __forceinline__ void o2_scan(Frame& F) {
    float* KLOC = (float*)(F.ws + WS_R2); float* NLOC = (float*)(F.ws + WS_NLOC); const float* MLOC = (const float*)(F.ws + WS_MLOC); const float* BLAST = (const float*)(F.ws + WS_BLAST); float* MPREV = (float*)(F.ws + WS_MPREV);
    constexpr int PER = 16384 + 128;
    for (int e = F.vcu * 512 + F.tid; e < 32 * PER; e += F.G * 512) {
        const int bh = e / PER, r = e % PER; float run = 0.f, m = 0.f;
        for (int c = 0; c < 32; ++c) { const int u = bh * 32 + c; float* p = r < 16384 ? KLOC + (size_t)u * 16384 + r : NLOC + (size_t)u * 128 + (r - 16384);
            const float loc = *p; *p = run; if (r == 0) MPREV[u] = m;
            const float bl = BLAST[u], ml = MLOC[u], mn = fmaxf(bl + m, ml);
            run = expf(bl + m - mn) * run + expf(ml - mn) * loc; m = mn; }
    }
}
__device__ __forceinline__ void o3_output(Frame& F, int j) {
    const bf16* P = (const bf16*)(F.ws + WS_R1); const float* CPREV = (const float*)(F.ws + WS_R2); const float* NPREV = (const float*)(F.ws + WS_NLOC); const float* MPREV = (const float*)(F.ws + WS_MPREV); bf16* MIX = (bf16*)(F.ws + WS_MIX);
    LAS float* qT = (LAS float*)F.lds;
    LAS float* kT = (LAS float*)(F.lds + 32768);
    LAS float* Vs = (LAS float*)(F.lds + 65536);
    LAS float* WT = (LAS float*)(F.lds + 98304);
    LAS float* sm = (LAS float*)(F.lds + SMALL_OFF);
    for (int u = F.vcu; u < 1024; u += F.G) {
        const int b = u >> 7, h = (u >> 5) & 3, c = u & 31, t0 = b * SEQ + c * 64;
        __syncthreads();
        if (F.wave == 0) { float bcum, ib; mlstm_gates(F, j, t0, h, bcum, ib); const float mprev = MPREV[u];
            const float pm = wave_scan_max(ib - bcum, F.lane); const float inter = bcum + mprev; const float mt = fmaxf(bcum + pm, inter);
            sm[F.lane] = bcum; sm[64 + F.lane] = ib; sm[128 + F.lane] = mt; sm[192 + F.lane] = expf(inter - mt); }
        for (int i = F.tid; i < 64 * 64; i += 512) { const int s = i >> 6, dd = (i & 63) * 2; const bf16* pr = P + (size_t)(t0 + s) * NPO + h * 128 + dd;
            const unsigned qv = *(const unsigned*)pr, kv = *(const unsigned*)(pr + 512), vv = *(const unsigned*)(pr + 1024);
            qT[dd * 64 + s] = bflo(qv); qT[(dd + 1) * 64 + s] = bfhi(qv); kT[dd * 64 + s] = bflo(kv); kT[(dd + 1) * 64 + s] = bfhi(kv); Vs[s * 128 + dd] = bflo(vv); Vs[s * 128 + dd + 1] = bfhi(vv); }
        __syncthreads();
        { const int s = F.lane, l0 = 8 * F.wave; float acc[8];
#pragma unroll
            for (int i = 0; i < 8; ++i) acc[i] = 0.f;
#pragma unroll 2
            for (int d = 0; d < 128; ++d) { const float kk = kT[d * 64 + s]; const f32x4 q0 = *(const LAS f32x4*)(qT + d * 64 + l0), q1 = *(const LAS f32x4*)(qT + d * 64 + l0 + 4);
#pragma unroll
                for (int i = 0; i < 4; ++i) { acc[i] += q0[i] * kk; acc[4 + i] += q1[i] * kk; } }
            const float gs = sm[64 + s] - sm[s];
#pragma unroll
            for (int i = 0; i < 8; ++i) { const int l = l0 + i; const float w = (s <= l) ? acc[i] * expf(sm[l] + gs - sm[128 + l]) : 0.f; WT[s * 64 + l] = w; const float dsum = wave_sum(w); if (F.lane == 0) sm[256 + l] = dsum; } }
        __syncthreads();
        if (F.tid < 64) { const int l = F.tid; float qn = 0.f; const float* np = NPREV + (size_t)u * 128; for (int d = 0; d < 128; ++d) qn += qT[d * 64 + l] * np[d]; sm[256 + l] += sm[192 + l] * qn; }
        const int v = F.tid & 127, l0 = 16 * (F.tid >> 7); float acc[16];
#pragma unroll
        for (int i = 0; i < 16; ++i) acc[i] = 0.f;
        { const float* cp = CPREV + (size_t)u * 16384;
#pragma unroll 2
            for (int d = 0; d < 128; ++d) { const float cc = cp[d * 128 + v];
#pragma unroll
                for (int li = 0; li < 16; li += 4) { const f32x4 q4 = *(const LAS f32x4*)(qT + d * 64 + l0 + li);
#pragma unroll
                    for (int i = 0; i < 4; ++i) acc[li + i] += q4[i] * cc; } } }
#pragma unroll
        for (int i = 0; i < 16; ++i) acc[i] *= sm[192 + l0 + i];
#pragma unroll 2
        for (int s = 0; s < 64; ++s) { const float vv = Vs[s * 128 + v];
#pragma unroll
            for (int li = 0; li < 16; li += 4) { const f32x4 w4 = *(const LAS f32x4*)(WT + s * 64 + l0 + li);
#pragma unroll
                for (int i = 0; i < 4; ++i) acc[li + i] += w4[i] * vv; } }
        __syncthreads();
        LAS float* hb = kT;
#pragma unroll
        for (int i = 0; i < 16; ++i) { const int l = l0 + i; const float hv = acc[i] / fmaxf(fabsf(sm[256 + l]), expf(-sm[128 + l])); acc[i] = hv; hb[l * 128 + v] = hv; }
        __syncthreads();
        { const int lb = 8 * F.wave;
#pragma unroll
            for (int i = 0; i < 8; ++i) { const int l = lb + i; const float a = hb[l * 128 + F.lane], bq = hb[l * 128 + 64 + F.lane]; const float mu = wave_sum(a + bq) * (1.f / 128.f);
                const float da = a - mu, db = bq - mu; const float var = wave_sum(da * da + db * db) * (1.f / 128.f); if (F.lane == 0) { sm[320 + l] = mu; sm[384 + l] = 1.0f / sqrtf(var + LN_EPS); } } }
        __syncthreads();
        const float hw = KIN(I_HNW)[j * 512 + h * 128 + v];
#pragma unroll
        for (int i = 0; i < 16; ++i) { const int l = l0 + i; const float og = sigmoid_f(bf2f(P[(size_t)(t0 + l) * NPO + 1536 + h * 128 + v]));
            MIX[(size_t)(t0 + l) * D + h * 128 + v] = (bf16)f2bf(og * (acc[i] - sm[320 + l]) * sm[384 + l] * hw); }
    }
}
__device__ __forceinline__ void o4_fox(Frame& F) {
    const bf16* P = (const bf16*)(F.ws + WS_R1); const float* FOXC = (const float*)(F.ws + WS_FOXC); bf16* MIX = (bf16*)(F.ws + WS_MIX);
    LAS float* QT = (LAS float*)F.lds;
    LAS float* KT = (LAS float*)(F.lds + 16384);
    LAS float* Vs = (LAS float*)(F.lds + 32768);
    LAS float* PT = (LAS float*)(F.lds + 49152) + F.wave * 512;
    LAS float* cq = (LAS float*)(F.lds + SMALL_OFF); LAS float* ck = cq + 64;
    for (int it = F.vcu; it < 2048; it += F.G) {
        const int qt = 31 - (it >> 6), bh = it & 63, b = bh >> 3, h = bh & 7, tq0 = b * SEQ + qt * 64;
        __syncthreads();
        for (int i = F.tid; i < 64 * 32; i += 512) { const int q = i >> 5, dd = (i & 31) * 2; const unsigned w = *(const unsigned*)(P + (size_t)(tq0 + q) * NPO + 2048 + h * 64 + dd); QT[dd * 64 + q] = bflo(w); QT[(dd + 1) * 64 + q] = bfhi(w); }
        if (F.tid < 64) cq[F.tid] = FOXC[(size_t)bh * SEQ + qt * 64 + F.tid];
        const int q0 = 8 * F.wave; float mrun[8], lrun[8], o[8];
#pragma unroll
        for (int i = 0; i < 8; ++i) { mrun[i] = -INFINITY; lrun[i] = 0.f; o[i] = 0.f; }
#pragma unroll 1
        for (int kt = 0; kt <= qt; ++kt) { const int tk0 = b * SEQ + kt * 64;
            __syncthreads();
            for (int i = F.tid; i < 64 * 32; i += 512) { const int k = i >> 5, dd = (i & 31) * 2; const bf16* pr = P + (size_t)(tk0 + k) * NPO + h * 64 + dd; const unsigned kw = *(const unsigned*)(pr + 2560), vw = *(const unsigned*)(pr + 3072);
                KT[dd * 64 + k] = bflo(kw); KT[(dd + 1) * 64 + k] = bfhi(kw); Vs[k * 64 + dd] = bflo(vw); Vs[k * 64 + dd + 1] = bfhi(vw); }
            if (F.tid < 64) ck[F.tid] = FOXC[(size_t)bh * SEQ + kt * 64 + F.tid];
            __syncthreads();
            float s[8];
#pragma unroll
            for (int i = 0; i < 8; ++i) s[i] = 0.f;
#pragma unroll 2
            for (int d = 0; d < 64; ++d) { const float kk = KT[d * 64 + F.lane]; const f32x4 qa = *(const LAS f32x4*)(QT + d * 64 + q0), qb = *(const LAS f32x4*)(QT + d * 64 + q0 + 4);
#pragma unroll
                for (int i = 0; i < 4; ++i) { s[i] += qa[i] * kk; s[4 + i] += qb[i] * kk; } }
            const float ckv = ck[F.lane];
#pragma unroll
            for (int i = 0; i < 8; ++i) { float sv = s[i] + cq[q0 + i] - ckv; if (kt == qt && F.lane > q0 + i) sv = -INFINITY;
                const float mn = fmaxf(mrun[i], wave_max(sv)); const float p = exp2f(sv - mn), al = exp2f(mrun[i] - mn);
                lrun[i] = lrun[i] * al + wave_sum(p); o[i] *= al; mrun[i] = mn; PT[F.lane * 8 + i] = p; }
            LDS_WAIT(); asm volatile("" ::: "memory");
#pragma unroll 2
            for (int k = 0; k < 64; ++k) { const float vv = Vs[k * 64 + F.lane]; const f32x4 pa = *(const LAS f32x4*)(PT + k * 8), pb = *(const LAS f32x4*)(PT + k * 8 + 4);
#pragma unroll
                for (int i = 0; i < 4; ++i) { o[i] += pa[i] * vv; o[4 + i] += pb[i] * vv; } }
        }
#pragma unroll
        for (int i = 0; i < 8; ++i) MIX[(size_t)(tq0 + q0 + i) * D + 512 + h * 64 + F.lane] = (bf16)f2bf(o[i] / lrun[i]);
    }
}
__device__ __forceinline__ void p_ln1_route(Frame& F, int layer, const float* hin) {
    const float* OUTP = (const float*)(F.ws + WS_R1); float* H1F = (float*)(F.ws + WS_H1F); bf16* H1B = (bf16*)(F.ws + WS_H1B);
    i32x4* ROUTE = (i32x4*)(F.ws + WS_ROUTE); f32x2* GATE = (f32x2*)(F.ws + WS_GATE); int* BCNT = (int*)(F.ws + WS_BCNT);
    LAS int* cnt = (LAS int*)(F.lds + SMALL_OFF);
    const float* g1 = KIN(I_LN1G) + (size_t)layer * D; const float* b1 = KIN(I_LN1B) + (size_t)layer * D;
    const float* rgw = KIN(I_RGW) + (size_t)layer * D * 4; const float* rgb = KIN(I_RGB) + layer * 4; const float* rew = KIN(I_REW) + (size_t)layer * 4 * D * 8; const float* reb = KIN(I_REB) + layer * 32;
    __syncthreads();
    if (F.tid < 32) cnt[F.tid] = 0;
    __syncthreads();
    for (int m = F.gw; m < T; m += F.NGW) {
        f32x4 v[4], a[4]; row_load(hin + (size_t)m * D, F.lane, v); row_load(OUTP + (size_t)m * D, F.lane, a);
#pragma unroll
        for (int jj = 0; jj < 4; ++jj) v[jj] = v[jj] * ALPHA + a[jj];
        row_layernorm(v, g1, b1, F.lane);
        row_store_f32(H1F + (size_t)m * D, F.lane, v); row_store_bf16(H1B + (size_t)m * D, F.lane, v);
        float gl[4] = {0.f, 0.f, 0.f, 0.f};
#pragma unroll
        for (int jj = 0; jj < 4; ++jj)
#pragma unroll
            for (int i = 0; i < 4; ++i) { const f32x4 w = *(const f32x4*)(rgw + (size_t)(256 * jj + 4 * F.lane + i) * 4);
#pragma unroll
                for (int c = 0; c < 4; ++c) gl[c] += v[jj][i] * w[c]; }
#pragma unroll
        for (int c = 0; c < 4; ++c) gl[c] = wave_sum(gl[c]) + rgb[c];
        int gi = 0; float gm = gl[0];
#pragma unroll
        for (int c = 1; c < 4; ++c) if (gl[c] > gm) { gm = gl[c]; gi = c; }
        float se = 0.f;
#pragma unroll
        for (int c = 0; c < 4; ++c) se += expf(gl[c] - gm);
        const float pg = 1.0f / se;
        const float* rw = rew + (size_t)gi * D * 8; float el[8];
#pragma unroll
        for (int c = 0; c < 8; ++c) el[c] = 0.f;
#pragma unroll
        for (int jj = 0; jj < 4; ++jj)
#pragma unroll
            for (int i = 0; i < 4; ++i) { const float* wr = rw + (size_t)(256 * jj + 4 * F.lane + i) * 8; const f32x4 w0 = *(const f32x4*)wr, w1 = *(const f32x4*)(wr + 4);
#pragma unroll
                for (int c = 0; c < 4; ++c) { el[c] += v[jj][i] * w0[c]; el[4 + c] += v[jj][i] * w1[c]; } }
#pragma unroll
        for (int c = 0; c < 8; ++c) el[c] = wave_sum(el[c]) + reb[gi * 8 + c];
        int i0 = 0; float v0 = el[0];
#pragma unroll
        for (int c = 1; c < 8; ++c) if (el[c] > v0) { v0 = el[c]; i0 = c; }
        int i1 = -1; float v1 = -INFINITY;
#pragma unroll
        for (int c = 0; c < 8; ++c) if (c != i0 && el[c] > v1) { v1 = el[c]; i1 = c; }
        if (i1 < 0) i1 = (i0 + 1) & 7;
        const float ee = expf(v1 - v0), g0 = pg / (1.0f + ee), g1v = pg * ee / (1.0f + ee);
        if (F.lane == 0) { const int e0 = gi * 8 + i0, e1 = gi * 8 + i1;
            const int r0 = __hip_atomic_fetch_add(cnt + e0, 1, __ATOMIC_RELAXED, __HIP_MEMORY_SCOPE_WORKGROUP), r1 = __hip_atomic_fetch_add(cnt + e1, 1, __ATOMIC_RELAXED, __HIP_MEMORY_SCOPE_WORKGROUP);
            ROUTE[m] = (i32x4){e0, r0, e1, r1}; GATE[m] = (f32x2){g0, g1v}; }
    }
    __syncthreads();
    if (F.tid < 32) BCNT[F.vcu * 32 + F.tid] = cnt[F.tid];
}
__device__ __forceinline__ void p_scatter(Frame& F) {
    const int* BCNT = (const int*)(F.ws + WS_BCNT); int* PANEL = (int*)(F.ws + WS_PANEL); const i32x4* ROUTE = (const i32x4*)(F.ws + WS_ROUTE); i32x2* POS = (i32x2*)(F.ws + WS_POS);
    const bf16* H1B = (const bf16*)(F.ws + WS_H1B); bf16* XS = (bf16*)(F.ws + WS_R1);
    LAS int* pa = (LAS int*)(F.lds + SMALL_OFF); LAS int* pb = pa + 512; LAS int* tot = pa + 1024; LAS int* bef = pa + 1056; LAS int* base = pa + 1088;
    __syncthreads();
    { const int e = F.tid & 31, part = F.tid >> 5; int sa = 0, sb = 0;
        for (int b = part; b < F.G; b += 16) { const int c = BCNT[b * 32 + e]; sa += c; if (b < F.vcu) sb += c; }
        pa[part * 32 + e] = sa; pb[part * 32 + e] = sb; }
    __syncthreads();
    if (F.tid < 32) { int sa = 0, sb = 0; for (int p = 0; p < 16; ++p) { sa += pa[p * 32 + F.tid]; sb += pb[p * 32 + F.tid]; } tot[F.tid] = sa; bef[F.tid] = sb; }
    __syncthreads();
    if (F.tid == 0) { int off = 0, np = 0;
        for (int e = 0; e < 32; ++e) { const int npan = (tot[e] + 255) >> 8; base[e] = off + bef[e];
            if (F.vcu == 0) for (int p = 0; p < npan; ++p) PANEL[1 + np + p] = e;
            np += npan; off += npan * 256; }
        if (F.vcu == 0) PANEL[0] = np; }
    __syncthreads();
    for (int m = F.gw; m < T; m += F.NGW) { const i32x4 r = ROUTE[m]; const int p0 = base[r.x] + r.y, p1 = base[r.z] + r.w;
        if (F.lane == 0) POS[m] = (i32x2){p0, p1};
        const v4u* src = (const v4u*)(H1B + (size_t)m * D); v4u* d0 = (v4u*)(XS + (size_t)p0 * D); v4u* d1 = (v4u*)(XS + (size_t)p1 * D);
#pragma unroll
        for (int jj = 0; jj < 2; ++jj) { const v4u w = src[F.lane + 64 * jj]; d0[F.lane + 64 * jj] = w; d1[F.lane + 64 * jj] = w; } }
}
__device__ __forceinline__ void p_combine(Frame& F, int layer) {
    const float* H1F = (const float*)(F.ws + WS_H1F); const bf16* EOUT = (const bf16*)(F.ws + WS_R1); const i32x2* POS = (const i32x2*)(F.ws + WS_POS); const f32x2* GATE = (const f32x2*)(F.ws + WS_GATE);
    float* HF = (float*)(F.ws + WS_HF); bf16* HB = (bf16*)(F.ws + WS_HB);
    const float* g2 = KIN(I_LN2G) + (size_t)layer * D; const float* b2 = KIN(I_LN2B) + (size_t)layer * D;
    for (int m = F.gw; m < T; m += F.NGW) { const i32x2 ps = POS[m]; const f32x2 gt = GATE[m];
        f32x4 v[4], ea[4], eb[4]; row_load(H1F + (size_t)m * D, F.lane, v); row_load_bf16(EOUT + (size_t)ps.x * D, F.lane, ea); row_load_bf16(EOUT + (size_t)ps.y * D, F.lane, eb);
#pragma unroll
        for (int jj = 0; jj < 4; ++jj) v[jj] = v[jj] * ALPHA + (ea[jj] * gt.x + eb[jj] * gt.y);
        row_layernorm(v, g2, b2, F.lane);
        if (layer == DEPTH - 1) row_store_f32(F.out + (size_t)m * D, F.lane, v);
        else { row_store_f32(HF + (size_t)m * D, F.lane, v); row_store_bf16(HB + (size_t)m * D, F.lane, v); row_gate_proj(F, v, layer + 1, m); } }
}
#ifndef PHASE_MASK
#define PHASE_MASK 0x1fff
#endif
#define PH_EN(k) (((PHASE_MASK) >> (k)) & 1)
#define IN(k) (lo <= (k) && (k) < hi)
#define SEAM(k) do { if ((k) + 1 < hi) xcd_barrier(bar); } while (0)
template <int LAYER> __device__ __forceinline__ void layer_body(Frame& F, const int lo, const int hi, const XcdBarrier& bar) {
        constexpr int layer = LAYER, pb = 1 + LAYER * NPH_LAYER, j = LAYER >> 1; constexpr bool odd = (LAYER & 1) != 0;
        bf16* HB = (bf16*)(F.ws + WS_HB); bf16* MIX = (bf16*)(F.ws + WS_MIX);
        const float* hin = layer == 0 ? KIN(I_X) : (const float*)(F.ws + WS_HF);
        if constexpr (PH_EN(0)) if (IN(pb + 0)) {
            const int N = odd ? NPO : NPE; const bf16* Bt = odd ? (const bf16*)(F.ws + WS_WINO) + (size_t)j * NPO * D : (const bf16*)(F.ws + WS_WINE) + (size_t)j * NPE * D;
            pg8::Gemm g{HB, Bt, T, N, D, 0}; pg8::StaticOrder S; S.init(T, N, F.G, (int)blockIdx.x);
            pg8::EpiStoreBf16 E{(bf16*)(F.ws + WS_R1), N};
            pg8::gemm_phase<pg8::EpiStoreBf16, pg8::StaticOrder, true, true>(F.lds, g, S, E);
            SEAM(pb + 0); }
        if constexpr (!odd) {
            if constexpr (PH_EN(1)) if (IN(pb + 1)) { e0_conv(F, j); SEAM(pb + 1); }
            if constexpr (PH_EN(2)) if (IN(pb + 2)) { e1_states(F, j); SEAM(pb + 2); }
            if constexpr (PH_EN(3)) if (IN(pb + 3)) { e2_scan(F); SEAM(pb + 3); }
            if constexpr (PH_EN(4)) if (IN(pb + 4)) { e3_output(F, j); SEAM(pb + 4); }
            if constexpr (PH_EN(5)) if (IN(pb + 5)) { e4_gnorm(F); SEAM(pb + 5); }
        } else {
            if constexpr (PH_EN(1)) if (IN(pb + 1)) { o_foxscan(F, j); o1_local(F, j); SEAM(pb + 1); }
            if constexpr (PH_EN(2)) if (IN(pb + 2)) { o2_scan(F); SEAM(pb + 2); }
            if constexpr (PH_EN(3)) if (IN(pb + 3)) { o3_output(F, j); SEAM(pb + 3); }
            if constexpr (PH_EN(4)) if (IN(pb + 4)) {
#if FOX_NAIVE
                o4_fox(F);
#else
                const attn_body::bf16* PR = (const attn_body::bf16*)(F.ws + WS_R1);
                const attn_body::AttnTensors AT{PR + 2048, PR + 2560, PR + 3072, (attn_body::bf16*)(F.ws + WS_MIX) + 512, (const float*)(F.ws + WS_FOXC)};
                const attn_body::StaticOrder S((int)F.G, F.vcu);
                attn_body::attn_phase<attn_body::StaticOrder>((char*)F.lds, AT, S);
#endif
                SEAM(pb + 4); }
            if constexpr (PH_EN(5)) if (IN(pb + 5)) { SEAM(pb + 5); }
        }
        if constexpr (PH_EN(6)) if (IN(pb + 6)) {
            const int K = odd ? D : 1536; const bf16* Bt = odd ? (const bf16*)(F.ws + WS_WOUTO) + (size_t)j * D * D : (const bf16*)(F.ws + WS_WOUTE) + (size_t)j * D * 1536;
            pg8::Gemm g{MIX, Bt, T, D, K, 0}; pg8::StaticOrder S; S.init(T, D, F.G, (int)blockIdx.x);
            pg8::EpiStoreF32 E{(float*)(F.ws + WS_R1), D};
            pg8::gemm_phase<pg8::EpiStoreF32, pg8::StaticOrder, false, true>(F.lds, g, S, E);
            SEAM(pb + 6); }
        if constexpr (PH_EN(7)) if (IN(pb + 7)) { p_ln1_route(F, layer, hin); SEAM(pb + 7); }
        if constexpr (PH_EN(8)) if (IN(pb + 8)) { p_scatter(F); SEAM(pb + 8); }
        if constexpr (PH_EN(9)) if (IN(pb + 9)) {
            pg8::Gemm g{(const bf16*)(F.ws + WS_R1), (const bf16*)(F.ws + WS_WGU) + (size_t)layer * 32 * D * D, RPAD, D, D, (size_t)D * D * 2};
            pg8::MoeOrder S; S.initm((const int*)(F.ws + WS_PANEL), 4, F.G, (int)blockIdx.x);
            pg8::EpiSwiglu E{(bf16*)(F.ws + WS_R3), 512};
            pg8::gemm_phase<pg8::EpiSwiglu, pg8::MoeOrder, true, true>(F.lds, g, S, E);
            SEAM(pb + 9); }
        if constexpr (PH_EN(10)) if (IN(pb + 10)) {
            pg8::Gemm g{(const bf16*)(F.ws + WS_R3), (const bf16*)(F.ws + WS_WD) + (size_t)layer * 32 * D * 512, RPAD, D, 512, (size_t)D * 512 * 2};
            pg8::MoeOrder S; S.initm((const int*)(F.ws + WS_PANEL), 4, F.G, (int)blockIdx.x);
            pg8::EpiStoreBf16 E{(bf16*)(F.ws + WS_R1), D};
            pg8::gemm_phase<pg8::EpiStoreBf16, pg8::MoeOrder, true, true>(F.lds, g, S, E);
            SEAM(pb + 10); }
        if constexpr (PH_EN(11)) if (IN(pb + 11)) { p_combine(F, layer); SEAM(pb + 11); }
}
struct Args { const float* in[27]; float* out; unsigned char* ws; int ph_lo, ph_hi; };
__global__ void __launch_bounds__(NWAVES * 64, 2) fwd_kernel(Args args) {
    extern __shared__ __attribute__((aligned(16))) unsigned char lds[];
    Frame F;
    F.lds = (LAS unsigned char*)lds;
    F.MISC = (volatile LAS unsigned*)(F.lds + MISC_OFF);
    F.tid = threadIdx.x; F.lane = F.tid & 63; F.wave = __builtin_amdgcn_readfirstlane(F.tid >> 6);
    F.G = gridDim.x; { const int bx = blockIdx.x; F.vcu = (F.G % 8 == 0) ? (bx % 8) * (F.G / 8) + bx / 8 : bx; }
    F.gw = F.vcu * NWAVES + F.wave; F.NGW = F.G * NWAVES;
    F.out = args.out; F.ws = args.ws; F.ctl = (unsigned*)(args.ws + WS_CTL);
    const int lo = args.ph_lo, hi = args.ph_hi;
    for (int u = F.tid; u < (LDS_BYTES - MISC_OFF) / 4; u += NWAVES * 64) ((LAS unsigned*)(F.lds + MISC_OFF))[u] = 0u;
    __syncthreads();
    XcdBarrier bar; bar.bar = F.ctl + CW_BAR; bar.x = 0; bar.st = nullptr;
    if (hi - lo > 1) bar = xcd_barrier_post(F.ctl + CW_BAR, F.MISC + 8);
    if constexpr (PH_EN(12)) if (IN(0)) { p_prologue(F); SEAM(0); }
    layer_body<0>(F, lo, hi, bar); layer_body<1>(F, lo, hi, bar); layer_body<2>(F, lo, hi, bar); layer_body<3>(F, lo, hi, bar);
#undef IN
#undef SEAM
}

extern "C" void kernel_launch(void* const* d_in, const int* in_sizes, int n_in, void* d_out, int out_size, void* d_ws, size_t ws_size, hipStream_t stream) {
    static int grid = 0;
    if (grid == 0) {
        if (n_in != 27 || in_sizes[0] != T * D || out_size != T * D || ws_size < WS_END) { fprintf(stderr, "kernel_launch: unexpected shapes (n_in %d, in0 %d, out %d, ws %zu); nothing launched\n", n_in, n_in > 0 ? in_sizes[0] : -1, out_size, ws_size); grid = -1; return; }
        int dev = 0, cus = 0, per_cu = 0;
        if (hipGetDevice(&dev) != hipSuccess || hipDeviceGetAttribute(&cus, hipDeviceAttributeMultiprocessorCount, dev) != hipSuccess) { grid = -1; return; }
        if (hipFuncSetAttribute((const void*)fwd_kernel, hipFuncAttributeMaxDynamicSharedMemorySize, LDS_BYTES) != hipSuccess) { fprintf(stderr, "kernel_launch: hipFuncSetAttribute failed\n"); grid = -1; return; }
        if (hipOccupancyMaxActiveBlocksPerMultiprocessor(&per_cu, (const void*)fwd_kernel, NWAVES * 64, LDS_BYTES) != hipSuccess || per_cu < 1) fprintf(stderr, "kernel_launch: note: occupancy query reports %d workgroups per CU\n", per_cu);
        (void)hipGetLastError();
        grid = cus;
    }
    if (grid < 0) return;
    if (hipMemsetAsync((char*)d_ws + WS_CTL, 0, CTL_ZERO_BYTES, stream) != hipSuccess) return;
    Args a{};
    for (int i = 0; i < 27; ++i) a.in[i] = (const float*)d_in[i];
    a.out = (float*)d_out; a.ws = (unsigned char*)d_ws;
#if MK_ONE_LAUNCH
    a.ph_lo = 0; a.ph_hi = NPHASES;
    hipLaunchKernelGGL(fwd_kernel, dim3(grid), dim3(NWAVES * 64), LDS_BYTES, stream, a);
#else
    for (int ph = 0; ph < NPHASES; ++ph) {
        if (ph > 0 && (((ph - 1) / NPH_LAYER) & 1) && ((ph - 1) % NPH_LAYER) == 5) continue;
        a.ph_lo = ph; a.ph_hi = ph + 1;
        hipLaunchKernelGGL(fwd_kernel, dim3(grid), dim3(NWAVES * 64), LDS_BYTES, stream, a);
    }
#endif
}
```

```cpp
#include <hip/hip_runtime.h>
#include <cstdio>
#include <cstdint>
__device__ __forceinline__ float silu_f(float x) { return x / (1.0f + __expf(-x)); }
namespace pg8 {
#define PG8_LAS __attribute__((address_space(3)))
typedef unsigned short bf16_t;
typedef short bf16x8 __attribute__((ext_vector_type(8)));
typedef float f32x4 __attribute__((ext_vector_type(4)));
typedef unsigned u32x4 __attribute__((ext_vector_type(4)));
constexpr int BM = 256, BK = 64, HALF = 128, HTB = HALF * BK * 2  , STAGE_BYTES = 8 * HTB, NXCD = 8, WGM = 8;

__host__ __device__ __forceinline__ int lds_byte(int r, int c) { const int st = (r >> 4) * 2 + (c >> 5), rr = r & 15, cc = c & 31, ob = rr * 64 + cc * 2; return st * 1024 + (ob ^ (((ob >> 9) & 1) << 5)); }
__host__ __device__ __forceinline__ void stage_rc(int b, int& R, int& C) { const int st = b / 1024, sb = b % 1024, swz = sb ^ (((sb >> 9) & 1) << 5); R = (st >> 1) * 16 + swz / 64; C = (st & 1) * 32 + (swz % 64) / 2; }
__host__ __device__ __forceinline__ int perm32(int rho) { const int n = rho >> 4, i = rho & 15; return 8 * (i >> 2) + 4 * n + (i & 3); }

struct Unit { int pm, pn, be; };
struct Gemm { const bf16_t* A; const bf16_t* Bt; int M, N, K; size_t bstride; };

struct StaticOrder {
    int nM, nN, nwg, G, c;
    __host__ __device__ void init(int M, int N, int G_, int c_) { nM = M / BM; nN = N / BM; nwg = nM * nN; G = G_; c = c_; }
    __host__ __device__ bool next(int i, Unit& u) const {
        const long L = (long)i * G + c; if (L >= nwg) return false;
        int wgid = (int)L; { const int q = nwg / NXCD, r = nwg % NXCD, xcd = wgid % NXCD, off = wgid / NXCD; wgid = (xcd < r ? xcd * (q + 1) : r * (q + 1) + (xcd - r) * q) + off; }
        const int nig = WGM * nN, gid = wgid / nig, fm = gid * WGM, gsz = (nM - fm) < WGM ? (nM - fm) : WGM;
        u.pm = fm + ((wgid % nig) % gsz); u.pn = (wgid % nig) / gsz; u.be = 0; return true;
    }
    __device__ __forceinline__ void a_ready(const Unit&) const {}
    __device__ __forceinline__ void done(const Unit&) const {}
};

__device__ __forceinline__ unsigned cvt_pk_bf16(float lo, float hi) { unsigned r; asm volatile("v_cvt_pk_bf16_f32 %0, %1, %2" : "=v"(r) : "v"(lo), "v"(hi)); return r; }
struct EpiStoreBf16 {
    static constexpr bool PERM = true, AFTER_DRAIN = false;
    bf16_t* O; int ldc;
    __device__ __forceinline__ void operator()(const f32x4 (&acc)[2][2][4][2], const Unit& u, int wr, int wc, int fr, int fq) const {
        const int row0 = u.pm * BM + wr * 64 + fr, col0 = u.pn * BM + wc * 32 + 8 * fq;
#pragma unroll
        for (int ai = 0; ai < 2; ++ai)
#pragma unroll
            for (int m = 0; m < 4; ++m) { bf16_t* rowp = O + (size_t)(row0 + ai * HALF + m * 16) * ldc + col0;
#pragma unroll
                for (int bj = 0; bj < 2; ++bj) { const f32x4 v0 = acc[ai][bj][m][0], v1 = acc[ai][bj][m][1];
                    u32x4 w; w.x = cvt_pk_bf16(v0[0], v0[1]); w.y = cvt_pk_bf16(v0[2], v0[3]); w.z = cvt_pk_bf16(v1[0], v1[1]); w.w = cvt_pk_bf16(v1[2], v1[3]);
                    *(u32x4*)(rowp + bj * HALF) = w; } }
    }
};
struct EpiStoreF32 {
    static constexpr bool PERM = false, AFTER_DRAIN = false;
    float* C; int ldc;
    __device__ __forceinline__ void operator()(const f32x4 (&acc)[2][2][4][2], const Unit& u, int wr, int wc, int fr, int fq) const {
        const int row0 = u.pm * BM + wr * 64 + fr, col0 = u.pn * BM + wc * 32 + 4 * fq;
#pragma unroll
        for (int ai = 0; ai < 2; ++ai)
#pragma unroll
            for (int m = 0; m < 4; ++m) { float* rowp = C + (size_t)(row0 + ai * HALF + m * 16) * ldc + col0;
#pragma unroll
                for (int bj = 0; bj < 2; ++bj)
#pragma unroll
                    for (int n = 0; n < 2; ++n) *(f32x4*)(rowp + bj * HALF + n * 16) = acc[ai][bj][m][n]; }
    }
};
struct EpiSwiglu {
    static constexpr bool PERM = true, AFTER_DRAIN = false;
    bf16_t* O; int ldc;
    __device__ __forceinline__ void operator()(const f32x4 (&acc)[2][2][4][2], const Unit& u, int wr, int wc, int fr, int fq) const {
        const int row0 = u.pm * BM + wr * 64 + fr, col0 = u.pn * HALF + wc * 32 + 8 * fq;
#pragma unroll
        for (int ai = 0; ai < 2; ++ai)
#pragma unroll
            for (int m = 0; m < 4; ++m) { bf16_t* rowp = O + (size_t)(row0 + ai * HALF + m * 16) * ldc + col0;
                const f32x4 g0 = acc[ai][0][m][0], g1 = acc[ai][0][m][1], u0 = acc[ai][1][m][0], u1 = acc[ai][1][m][1];
                float h[8];
#pragma unroll
                for (int i = 0; i < 4; ++i) { h[i] = silu_f(g0[i]) * u0[i]; h[4 + i] = silu_f(g1[i]) * u1[i]; }
                u32x4 w; w.x = cvt_pk_bf16(h[0], h[1]); w.y = cvt_pk_bf16(h[2], h[3]); w.z = cvt_pk_bf16(h[4], h[5]); w.w = cvt_pk_bf16(h[6], h[7]);
                *(u32x4*)rowp = w; }
    }
};
struct MoeOrder : StaticOrder {
    const int* tab;
    __device__ __forceinline__ void initm(const int* tab_, int nN_, int G_, int c_) { tab = tab_; nM = tab_[0]; nN = nN_; nwg = nM * nN; G = G_; c = c_; }
    __device__ __forceinline__ bool next(int i, Unit& u) const { if (!StaticOrder::next(i, u)) return false; u.be = tab[1 + u.pm]; return true; }
};
template <class Epi, class Sched, bool ALIGN_EPI = false, bool SP2 = false>
__device__ __forceinline__ void gemm_phase(PG8_LAS unsigned char* lds, const Gemm g, const Sched& S, const Epi& E) {
    const int tid = threadIdx.x, wid = __builtin_amdgcn_readfirstlane(tid >> 6), lane = tid & 63, wr = wid >> 2, wc = wid & 3, fr = lane & 15, fq = lane >> 4;
    const int K = g.K, nt = K / BK;
    unsigned voffA[2], voffB[2];
#pragma unroll
    for (int i = 0; i < 2; ++i) { int R, C; stage_rc(tid * 16 + i * 8192, R, C); const int Rb = Epi::PERM ? ((R & ~31) + perm32(R & 31)) : R;
        voffA[i] = (unsigned)(R * K + C) * 2u; voffB[i] = (unsigned)(Rb * K + C) * 2u; }
    const size_t kstep = (size_t)(BK * 2);
    const size_t hstep = (size_t)HALF * K * 2;
    const size_t tstep = 2 * hstep;
    const unsigned ldsw = (unsigned)wid * 1024u;
    const int aoff = lds_byte(wr * 64 + fr, fq * 8), boff = lds_byte(wc * 32 + fr, fq * 8);
#define PG8_SA(b, h) (((b) * 2 + (h)) * HTB)
#define PG8_SB(b, h) ((4 + (b) * 2 + (h)) * HTB)
#define PG8_STAGE(bufoff, gbase, voff) do { _Pragma("unroll") for (int _i = 0; _i < 2; ++_i) \
        __builtin_amdgcn_global_load_lds((const unsigned*)((const char*)(gbase) + (voff)[_i]), (PG8_LAS unsigned*)(lds + (bufoff) + ldsw + _i * 8192), 16, 0, 0); } while (0)
#define PG8_LDA(dst, b, h) do { _Pragma("unroll") for (int m = 0; m < 4; ++m) _Pragma("unroll") for (int k = 0; k < 2; ++k) dst[m][k] = *(const PG8_LAS bf16x8*)(lds + PG8_SA(b, h) + aoff + m * 2048 + k * 1024); } while (0)
#define PG8_LDB(dst, b, h) do { _Pragma("unroll") for (int n = 0; n < 2; ++n) _Pragma("unroll") for (int k = 0; k < 2; ++k) dst[n][k] = *(const PG8_LAS bf16x8*)(lds + PG8_SB(b, h) + boff + n * 2048 + k * 1024); } while (0)
#define PG8_MMA(ai, bj, At, Bt) do { __builtin_amdgcn_s_setprio(1); _Pragma("unroll") for (int m = 0; m < 4; ++m) _Pragma("unroll") for (int n = 0; n < 2; ++n) _Pragma("unroll") for (int k = 0; k < 2; ++k) \
        acc[ai][bj][m][n] = __builtin_amdgcn_mfma_f32_16x16x32_bf16(Bt[n][k], At[m][k], acc[ai][bj][m][n], 0, 0, 0); __builtin_amdgcn_s_setprio(0); } while (0)
#define PG8_WAIT_V(n) asm volatile("s_waitcnt vmcnt(" #n ")" ::: "memory")
#define PG8_WAIT_L(n) asm volatile("s_waitcnt lgkmcnt(" #n ")" ::: "memory")
#define PG8_BAR __builtin_amdgcn_s_barrier()
#define PG8_SCHED __builtin_amdgcn_sched_barrier(0)
    Unit cur, nxt; int ui = 0;
    if (!S.next(0, cur)) return;
    f32x4 acc[2][2][4][2];
#pragma unroll
    for (int a = 0; a < 2; ++a)
#pragma unroll
        for (int b = 0; b < 2; ++b)
#pragma unroll
            for (int m = 0; m < 4; ++m)
#pragma unroll
                for (int n = 0; n < 2; ++n) acc[a][b][m][n] = (f32x4){0.f, 0.f, 0.f, 0.f};
    bf16x8 At[4][2], B0[2][2], B1[2][2];
    const char* cA = (const char*)g.A + (size_t)cur.pm * tstep; const char* cB = (const char*)g.Bt + (size_t)cur.be * g.bstride + (size_t)cur.pn * tstep;
    S.a_ready(cur);
    if constexpr (SP2) {
        PG8_STAGE(PG8_SB(0, 0), cB, voffB); PG8_STAGE(PG8_SB(0, 1), cB + hstep, voffB); PG8_STAGE(PG8_SA(0, 0), cA, voffA); PG8_STAGE(PG8_SA(0, 1), cA + hstep, voffA);
        if (wr == 1) PG8_BAR;
        PG8_WAIT_V(2); PG8_BAR;
        PG8_STAGE(PG8_SB(1, 0), cB + kstep, voffB); PG8_STAGE(PG8_SA(1, 0), cA + kstep, voffA); PG8_STAGE(PG8_SB(1, 1), cB + hstep + kstep, voffB);
        PG8_WAIT_V(6); PG8_BAR;
    } else {
        PG8_STAGE(PG8_SB(0, 0), cB, voffB); PG8_STAGE(PG8_SA(0, 0), cA, voffA); PG8_STAGE(PG8_SB(0, 1), cB + hstep, voffB); PG8_STAGE(PG8_SA(0, 1), cA + hstep, voffA);
        if (wr == 1) PG8_BAR;
        PG8_WAIT_V(4); PG8_BAR;
        PG8_STAGE(PG8_SB(1, 0), cB + kstep, voffB); PG8_STAGE(PG8_SA(1, 0), cA + kstep, voffA); PG8_STAGE(PG8_SB(1, 1), cB + hstep + kstep, voffB);
        PG8_WAIT_V(6); PG8_BAR;
    }
    for (;;) {
        const bool has_next = S.next(ui + 1, nxt);
        const char* nA = has_next ? (const char*)g.A + (size_t)nxt.pm * tstep : cA; const char* nB = has_next ? (const char*)g.Bt + (size_t)nxt.be * g.bstride + (size_t)nxt.pn * tstep : cB;
        for (int t = 0; t < nt; t += 2) {
            const bool last = (t == nt - 2);
            const char* a1 = cA + (size_t)(t + 1) * kstep;
            const char* a2 = last ? nA : cA + (size_t)(t + 2) * kstep; const char* b2 = last ? nB : cB + (size_t)(t + 2) * kstep;
            const char* a3 = a2 + kstep; const char* b3 = b2 + kstep;
            if (last && has_next) S.a_ready(nxt);
            if constexpr (SP2) {
            PG8_LDB(B0, 0, 0); PG8_LDB(B1, 0, 1); PG8_SCHED; PG8_LDA(At, 0, 0); PG8_STAGE(PG8_SA(1, 1), a1 + hstep, voffA);
            PG8_WAIT_V(8); PG8_WAIT_L(0); PG8_BAR; PG8_MMA(0, 0, At, B0); PG8_MMA(0, 1, At, B1); PG8_BAR; PG8_SCHED;
            PG8_LDA(At, 0, 1); PG8_STAGE(PG8_SB(0, 0), b2, voffB); PG8_STAGE(PG8_SB(0, 1), b2 + hstep, voffB); PG8_STAGE(PG8_SA(0, 0), a2, voffA);
            PG8_WAIT_V(8); PG8_WAIT_L(0); PG8_BAR; PG8_MMA(1, 0, At, B0); PG8_MMA(1, 1, At, B1); PG8_BAR; PG8_SCHED;
            PG8_LDB(B0, 1, 0); PG8_LDB(B1, 1, 1); PG8_SCHED; PG8_LDA(At, 1, 0); PG8_STAGE(PG8_SA(0, 1), a2 + hstep, voffA);
            PG8_WAIT_V(8); PG8_WAIT_L(0); PG8_BAR; PG8_MMA(0, 0, At, B0); PG8_MMA(0, 1, At, B1); PG8_BAR; PG8_SCHED;
            PG8_LDA(At, 1, 1); PG8_STAGE(PG8_SB(1, 0), b3, voffB); PG8_STAGE(PG8_SB(1, 1), b3 + hstep, voffB); PG8_STAGE(PG8_SA(1, 0), a3, voffA);
            PG8_WAIT_V(8); PG8_WAIT_L(0); PG8_BAR; PG8_MMA(1, 0, At, B0); PG8_MMA(1, 1, At, B1); PG8_BAR; PG8_SCHED;
            } else {
            PG8_LDB(B0, 0, 0); PG8_SCHED; PG8_LDA(At, 0, 0); PG8_STAGE(PG8_SA(1, 1), a1 + hstep, voffA);
            PG8_WAIT_L(8); PG8_BAR; PG8_WAIT_L(0); PG8_MMA(0, 0, At, B0); PG8_BAR; PG8_SCHED;
            PG8_LDB(B1, 0, 1); PG8_STAGE(PG8_SB(0, 0), b2, voffB);
            PG8_BAR; PG8_WAIT_L(0); PG8_MMA(0, 1, At, B1); PG8_BAR;
            PG8_LDA(At, 0, 1); PG8_STAGE(PG8_SA(0, 0), a2, voffA);
            PG8_BAR; PG8_WAIT_L(0); PG8_MMA(1, 0, At, B0); PG8_BAR; PG8_SCHED;
            PG8_STAGE(PG8_SB(0, 1), b2 + hstep, voffB);
            PG8_WAIT_V(6); PG8_BAR; PG8_MMA(1, 1, At, B1); PG8_BAR;
            PG8_LDB(B0, 1, 0); PG8_SCHED; PG8_LDA(At, 1, 0); PG8_STAGE(PG8_SA(0, 1), a2 + hstep, voffA);
            PG8_WAIT_L(8); PG8_BAR; PG8_WAIT_L(0); PG8_MMA(0, 0, At, B0); PG8_BAR; PG8_SCHED;
            PG8_LDB(B1, 1, 1); PG8_STAGE(PG8_SB(1, 0), b3, voffB);
            PG8_BAR; PG8_WAIT_L(0); PG8_MMA(0, 1, At, B1); PG8_BAR;
            PG8_LDA(At, 1, 1); PG8_STAGE(PG8_SA(1, 0), a3, voffA);
            PG8_BAR; PG8_WAIT_L(0); PG8_MMA(1, 0, At, B0); PG8_BAR; PG8_SCHED;
            PG8_STAGE(PG8_SB(1, 1), b3 + hstep, voffB);
            PG8_WAIT_V(6); PG8_BAR; PG8_MMA(1, 1, At, B1); PG8_BAR;
            }
        }
        if constexpr (ALIGN_EPI) { if (wr == 0) PG8_BAR; }
        if constexpr (!Epi::AFTER_DRAIN) { E(acc, cur, wr, wc, fr, fq); S.done(cur); }
        if (!has_next) break;
#pragma unroll
        for (int a = 0; a < 2; ++a)
#pragma unroll
            for (int b = 0; b < 2; ++b)
#pragma unroll
                for (int m = 0; m < 4; ++m)
#pragma unroll
                    for (int n = 0; n < 2; ++n) acc[a][b][m][n] = (f32x4){0.f, 0.f, 0.f, 0.f};
        cur = nxt; cA = nA; cB = nB; ++ui;
        if constexpr (ALIGN_EPI) { if (wr == 1) PG8_BAR; }
    }
    PG8_WAIT_V(0);
    if constexpr (!ALIGN_EPI) { if (wr == 0) PG8_BAR; }
    PG8_BAR;
    if constexpr (Epi::AFTER_DRAIN) { E.fused(acc, cur, wr, wc, fr, fq, lds, wid, lane); S.done(cur); }
#undef PG8_SA
#undef PG8_SB
#undef PG8_STAGE
#undef PG8_LDA
#undef PG8_LDB
#undef PG8_MMA
#undef PG8_WAIT_V
#undef PG8_WAIT_L
#undef PG8_BAR
#undef PG8_SCHED
}
}
#ifndef SSD_NAIVE
#define SSD_NAIVE 0
#endif
#ifndef MLSTM_NAIVE
#define MLSTM_NAIVE 0
#endif
#ifndef FOX_NAIVE
#define FOX_NAIVE 0
#endif
#include <hip/hip_bf16.h>
#include <cmath>
namespace attn_body {
using bf16=__hip_bfloat16;
using bf16x8=__attribute__((ext_vector_type(8)))short;
using s16x4=__attribute__((ext_vector_type(4)))short;
using f32x16=__attribute__((ext_vector_type(16)))float;
using u32x4=__attribute__((ext_vector_type(4)))unsigned;
constexpr int BATCH=8,NHEAD=8,SEQ=2048,D=64,PQ=3584,PO=1024;
constexpr int NW=8,QBLK=32,QB=QBLK*NW,KVBLK=64,NQB=SEQ/QB;
constexpr int ATTN_UNIT_ROWS=QB;
__device__ __forceinline__ int crow(int r,int hi){return (r&3)+8*(r>>2)+4*hi;}
#define SBAR() __builtin_amdgcn_sched_barrier(0)
__device__ __forceinline__ void cmask(f32x16&p0,f32x16&p1,int jb,int qrel,int hi){
  const float NEG=-INFINITY; int kb=64*jb+4*hi;
  #pragma unroll
  for(int r=0;r<16;++r){int kv=kb+(r&3)+8*(r>>2); if(kv>qrel)p0[r]=NEG; if(kv+32>qrel)p1[r]=NEG;}
}

constexpr int NSLOT=3, SLOTB=8192;
constexpr int LDS_K=0, LDS_V=NSLOT*SLOTB, LDS_WS=2*NSLOT*SLOTB, LDS_OST=LDS_WS+NW*64*4, LDS_CK=LDS_OST+NW*4096, LDS_BYTES=LDS_CK+SEQ*4;
constexpr float C2=0.125f*1.4426950408889634f;
__device__ __forceinline__ void glds16(const void*gsrc,unsigned lds_dst){unsigned keep;
  asm volatile("s_mov_b32 %0, m0\n\ts_mov_b32 m0, %2\n\ts_nop 0\n\tglobal_load_lds_dwordx4 %1, off\n\ts_mov_b32 m0, %0":"=&s"(keep):"v"(gsrc),"s"(lds_dst):"memory");}
__device__ __forceinline__ float max3f(float a,float b,float c){float r;asm("v_max3_f32 %0, %1, %2, %3":"=v"(r):"v"(a),"v"(b),"v"(c));return r;}
__device__ __forceinline__ float max2f(float a,float b){float r;asm("v_max_f32_e32 %0, %1, %2":"=v"(r):"v"(a),"v"(b));return r;}
__device__ __forceinline__ float fadd_s(float a,float b){float r;asm("v_add_f32_e32 %0, %1, %2":"=v"(r):"v"(a),"v"(b));return r;}
__device__ __forceinline__ float fsub_s(float a,float b){float r;asm("v_sub_f32_e32 %0, %1, %2":"=v"(r):"v"(a),"v"(b));return r;}
typedef float f32x4_t __attribute__((ext_vector_type(4))); typedef float f32x2_t __attribute__((ext_vector_type(2))); typedef __bf16 bf16x2_t __attribute__((ext_vector_type(2)));
__device__ __forceinline__ unsigned cvtpk_s(float lo,float hi){f32x2_t v={lo,hi};bf16x2_t b=__builtin_convertvector(v,bf16x2_t);return __builtin_bit_cast(unsigned,b);}
#define WAIT_BAR(N) asm volatile("s_waitcnt vmcnt(" #N ") lgkmcnt(0)\n\ts_barrier":::"memory")

__device__ __forceinline__ void qkt(f32x16&p0,f32x16&p1,const char*Kslot,const bf16x8*qr,int r32,int hi){
  const char*kb=Kslot+hi*1024+r32*16;
  #pragma unroll
  for(int d0=0;d0<4;++d0){
    const bf16x8 b0=*reinterpret_cast<const bf16x8*>(kb+d0*2048);
    const bf16x8 b1=*reinterpret_cast<const bf16x8*>(kb+d0*2048+512);
    {p0=__builtin_amdgcn_mfma_f32_32x32x16_bf16(b0,qr[d0],p0,0,0,0);p1=__builtin_amdgcn_mfma_f32_32x32x16_bf16(b1,qr[d0],p1,0,0,0);}}
}
typedef __attribute__((address_space(3))) const char* lds_cptr;
typedef short v4i16_t __attribute__((ext_vector_type(4)));
__device__ __forceinline__ void kload8(bf16x8*kf,lds_cptr kp){
  kf[0]=*(const __attribute__((address_space(3))) bf16x8*)(kp);      kf[1]=*(const __attribute__((address_space(3))) bf16x8*)(kp+512);
  kf[2]=*(const __attribute__((address_space(3))) bf16x8*)(kp+2048); kf[3]=*(const __attribute__((address_space(3))) bf16x8*)(kp+2560);
  kf[4]=*(const __attribute__((address_space(3))) bf16x8*)(kp+4096); kf[5]=*(const __attribute__((address_space(3))) bf16x8*)(kp+4608);
  kf[6]=*(const __attribute__((address_space(3))) bf16x8*)(kp+6144); kf[7]=*(const __attribute__((address_space(3))) bf16x8*)(kp+6656);
}
__device__ __forceinline__ void kload2(bf16x8*kf,lds_cptr kp,int j){ kf[2*j]=*(const __attribute__((address_space(3))) bf16x8*)(kp+j*2048); kf[2*j+1]=*(const __attribute__((address_space(3))) bf16x8*)(kp+j*2048+512); }
__device__ __forceinline__ s16x4 vtr(lds_cptr p){ return __builtin_bit_cast(s16x4,__builtin_amdgcn_ds_read_tr16_b64_v4i16((__attribute__((address_space(3))) v4i16_t*)p)); }
__device__ __forceinline__ float rowmax(const f32x16&p0,const f32x16&p1){
  float a=max3f(p0[0],p0[1],p1[0]),b=max3f(p0[2],p0[3],p1[1]);a=max3f(a,p1[2],p1[3]);
  #pragma unroll
  for(int r=4;r<16;r+=4){a=max3f(a,p0[r],p0[r+1]);b=max3f(b,p0[r+2],p0[r+3]);a=max3f(a,p1[r],p1[r+1]);b=max3f(b,p1[r+2],p1[r+3]);}
  const float m=max2f(a,b);
  auto rr=__builtin_amdgcn_permlane32_swap(__float_as_uint(m),__float_as_uint(m),false,false);
  return max2f(__uint_as_float(rr[0]),__uint_as_float(rr[1]));
}
__device__ __forceinline__ void pv(f32x16*o,int vb,bf16x8 pa0,bf16x8 pa1,bf16x8 pa2,bf16x8 pa3){
  #pragma unroll
  for(int d0=0;d0<2;++d0){s16x4 lo[4],hi[4];
    #pragma unroll
    for(int ks=0;ks<4;++ks){
      asm volatile("ds_read_b64_tr_b16 %0,%1 offset:%c2":"=&v"(lo[ks]):"v"(vb),"i"(d0*4096+ks*1024):"memory");
      asm volatile("ds_read_b64_tr_b16 %0,%1 offset:%c2":"=&v"(hi[ks]):"v"(vb),"i"(d0*4096+ks*1024+512):"memory");}
    asm volatile("s_waitcnt lgkmcnt(0)":::"memory");SBAR();
    #define PK(k) (bf16x8){lo[k][0],lo[k][1],lo[k][2],lo[k][3],hi[k][0],hi[k][1],hi[k][2],hi[k][3]}
    o[d0]=__builtin_amdgcn_mfma_f32_32x32x16_bf16(pa0,PK(0),o[d0],0,0,0);
    o[d0]=__builtin_amdgcn_mfma_f32_32x32x16_bf16(pa1,PK(1),o[d0],0,0,0);
    o[d0]=__builtin_amdgcn_mfma_f32_32x32x16_bf16(pa2,PK(2),o[d0],0,0,0);
    o[d0]=__builtin_amdgcn_mfma_f32_32x32x16_bf16(pa3,PK(3),o[d0],0,0,0);
    #undef PK
  }
}

#ifndef ATTN_STORE16
#define ATTN_STORE16(p,v) (*(u32x4*)(p)=(v))
#endif
template<int THRL> __device__ __forceinline__ void attn_unit(int b,int h,int qb,const bf16*Q,const bf16*K,const bf16*V,bf16*O,const float*cum,char*shm){
  const int tid=threadIdx.x,lane=tid&63,r32=lane&31,hi=lane>>5; const int wid=__builtin_amdgcn_readfirstlane(tid>>6);
  const long rowbase=(long)b*SEQ; const int q0=qb*QB;
  const bf16*Qw=Q+(rowbase+q0+wid*QBLK)*PQ+h*D;
  const bf16*Kh=K+rowbase*PQ+h*D,*Vh=V+rowbase*PQ+h*D;
  const lds_cptr shm3_=(lds_cptr)shm;
  const unsigned lds0=(unsigned)(uintptr_t)shm;
  float*wsf=(float*)(shm+LDS_WS)+wid*64;
  const bf16*ksrc=Kh+(long)lane*PQ+wid*8;
  const bf16*vsrc=Vh+(long)(16*(wid&3)+(lane>>2))*PQ+(wid>>2)*32+(lane&3)*8;
  const unsigned kdst=lds0+LDS_K+wid*1024, vdst=lds0+LDS_V+wid*1024;
  #define DMA_K(t,slot) glds16(ksrc+(long)(t)*KVBLK*PQ,(unsigned)__builtin_amdgcn_readfirstlane(kdst+(slot)))
  #define DMA_V(t,slot) glds16(vsrc+(long)(t)*KVBLK*PQ,(unsigned)__builtin_amdgcn_readfirstlane(vdst+(slot)))
  const int vb0=(int)(lds0+LDS_V)+((lane>>4)&1)*32+(lane&3)*8+(4*hi+((lane&15)>>2))*64;
  const char*Kbase=shm+LDS_K; bf16x8 kf[8];
  const lds_cptr shm3=(lds_cptr)shm; const lds_cptr kp0=shm3+LDS_K+hi*1024+r32*16; const lds_cptr vp0=shm3+LDS_V+((lane>>4)&1)*32+(lane&3)*8+(4*hi+((lane&15)>>2))*64;
  const int NT=(q0+QB)/KVBLK;
  float cqm;
  { float*cks=(float*)(shm+LDS_CK); for(int i=tid;i<q0+QB;i+=NW*64)cks[i]=cum[i]; cqm=cum[q0+wid*QBLK+r32]; asm volatile("s_waitcnt vmcnt(0)":"+v"(cqm)::"memory"); }
  const __attribute__((address_space(3))) float*ckl=(const __attribute__((address_space(3))) float*)(shm3_+LDS_CK)+4*hi;
  #define BIASFILL(C0_,C1_,t_) do{ const __attribute__((address_space(3))) float*cp_=ckl+64*(t_); \
    _Pragma("unroll") for(int a_=0;a_<4;++a_){ const f32x4_t u_=*(const __attribute__((address_space(3))) f32x4_t*)(cp_+8*a_), w_=*(const __attribute__((address_space(3))) f32x4_t*)(cp_+32+8*a_); \
      _Pragma("unroll") for(int i_=0;i_<4;++i_){ C0_[4*a_+i_]=cqm-u_[i_]; C1_[4*a_+i_]=cqm-w_[i_]; } } }while(0)
  DMA_K(0,0);DMA_V(0,0);DMA_K(1,SLOTB);
  bf16x8 qr[4];
  #pragma unroll
  for(int d0=0;d0<4;++d0)qr[d0]=*reinterpret_cast<const bf16x8*>(&Qw[(long)r32*PQ+d0*16+hi*8]);
  float l_reg=0.f;f32x16 o[2];o[0]=f32x16{};o[1]=f32x16{};
  const int qrel=wid*QBLK+r32;
  #define CMASK(P0,P1,t) do{int jb_=(t)-(NT-4); if(jb_>=0)cmask(P0,P1,jb_,qrel,hi);}while(0)
  bool resc=false;
  #define START(P0,P1) do{ const float rm=rowmax(P0,P1); resc=false; \
    { const float dl=rm; cqm=fsub_s(cqm,dl); \
      _Pragma("unroll") for(int r=0;r<16;++r){P0[r]=fsub_s(P0[r],dl);P1[r]=fsub_s(P1[r],dl);} \
      } \
    _Pragma("unroll") for(int r=0;r<16;++r)P0[r]=__builtin_amdgcn_exp2f(P0[r]); }while(0)
  #define RESC() do{ if(resc){ asm volatile("s_waitcnt lgkmcnt(0)":::"memory"); \
      _Pragma("unroll") for(int d_=0;d_<2;++d_) _Pragma("unroll") for(int r=0;r<16;++r)o[d_][r]*=wsf[crow(r,hi)]; } }while(0)
  f32x16 pA0,pA1,pB0,pB1;
  int sl_prev=0,sl_cur=0,sl_next=SLOTB;
  #define ROT() do{sl_prev=sl_cur;sl_cur=sl_next;sl_next=(sl_next==(NSLOT-1)*SLOTB)?0:sl_next+SLOTB;}while(0)
  DMA_K(2,2*SLOTB);
  WAIT_BAR(3);
  BIASFILL(pA0,pA1,0); qkt(pA0,pA1,Kbase,qr,r32,hi);asm volatile("s_nop 15\n\ts_nop 7":"+v"(pA0),"+v"(pA1));CMASK(pA0,pA1,0);
  START(pA0,pA1);
  _Pragma("unroll") for(int r=0;r<16;++r)pA1[r]=__builtin_amdgcn_exp2f(pA1[r]);
  WAIT_BAR(0);
  DMA_K(3,0);DMA_V(1,SLOTB);
  ROT();
  kload8(kf,kp0+sl_cur);
  WAIT_BAR(2);
  s16x4 vlo[8],vhi[8]; u32x4 pw0,pw1,pw2,pw3;
  #define PKW(P,B) cvtpk_s(P[B],P[B+1])
  #define PAF(k) __builtin_bit_cast(bf16x8,pw##k)
  #define VFR(i) (bf16x8){vlo[i][0],vlo[i][1],vlo[i][2],vlo[i][3],vhi[i][0],vhi[i][1],vhi[i][2],vhi[i][3]}
  #define PIN(x) asm volatile("":"+v"(x))
  #define MX3(a,b,c) __builtin_fmaxf(__builtin_fmaxf((a),(b)),(c))
  #define GAPA(MF,A0,A1,A2,A3,W0,W1,PW) do{ MF; sacc+=A0; sacc+=A1; sacc+=A2; sacc+=A3; PIN(sacc); W0; W1; PIN(PW); SBAR(); }while(0)
  #define EX(v) __builtin_amdgcn_exp2f(v)
  #define GAPB(MF,X,B) do{ MF; X[B]=EX(X[B]); X[B+1]=EX(X[B+1]); X[B+2]=EX(X[B+2]); X[B+3]=EX(X[B+3]); PIN(X); SBAR(); }while(0)
  #define VRD(i) do{ vlo[i]=vtr(vp_+(((i)>>2)*4096+((i)&3)*1024)); vhi[i]=vtr(vp_+(((i)>>2)*4096+((i)&3)*1024+512)); }while(0)
  #define KRD(G,j) do{ if(G){ kload2(kf,kp0+sl_next,j); SBAR(); } }while(0)
  #define STEP(C0,C1,P0,P1,t,GK,GV,GL) do{ BIASFILL(C0,C1,t); SBAR(); \
    const lds_cptr vp_=vp0+sl_prev; \
    VRD(0); SBAR(); float sacc=(P0[0]+P0[1]); \
    GAPA(C0=__builtin_amdgcn_mfma_f32_32x32x16_bf16(kf[0],qr[0],C0,0,0,0), P0[2],P0[3],P0[4],P0[5],     pw0[0]=PKW(P0,0), pw0[1]=PKW(P0,2), pw0); \
    VRD(4); SBAR(); GAPA(C1=__builtin_amdgcn_mfma_f32_32x32x16_bf16(kf[1],qr[0],C1,0,0,0), P0[6],P0[7],P0[8],P0[9],     pw0[2]=PKW(P0,4), pw0[3]=PKW(P0,6), pw0); \
    VRD(1); SBAR(); GAPA(C0=__builtin_amdgcn_mfma_f32_32x32x16_bf16(kf[2],qr[1],C0,0,0,0),   P0[10],P0[11],P0[12],P0[13], pw1[0]=PKW(P0,8), pw1[1]=PKW(P0,10), pw1); \
    VRD(5); SBAR(); GAPA(C1=__builtin_amdgcn_mfma_f32_32x32x16_bf16(kf[3],qr[1],C1,0,0,0),   P0[14],P0[15],P1[0],P1[1],   pw1[2]=PKW(P0,12),pw1[3]=PKW(P0,14), pw1); \
    VRD(2); SBAR(); GAPA(C0=__builtin_amdgcn_mfma_f32_32x32x16_bf16(kf[4],qr[2],C0,0,0,0),   P1[2],P1[3],P1[4],P1[5],     pw2[0]=PKW(P1,0), pw2[1]=PKW(P1,2), pw2); \
    VRD(6); SBAR(); GAPA(C1=__builtin_amdgcn_mfma_f32_32x32x16_bf16(kf[5],qr[2],C1,0,0,0),   P1[6],P1[7],P1[8],P1[9],     pw2[2]=PKW(P1,4), pw2[3]=PKW(P1,6), pw2); \
    VRD(3); SBAR(); GAPA(C0=__builtin_amdgcn_mfma_f32_32x32x16_bf16(kf[6],qr[3],C0,0,0,0),   P1[10],P1[11],P1[12],P1[13], pw3[0]=PKW(P1,8), pw3[1]=PKW(P1,10), pw3); \
    VRD(7); SBAR(); GAPA(C1=__builtin_amdgcn_mfma_f32_32x32x16_bf16(kf[7],qr[3],C1,0,0,0),   P1[14],P1[15],0.f,0.f,       pw3[2]=PKW(P1,12),pw3[3]=PKW(P1,14), pw3); \
    l_reg+=sacc; \
    if(GK){DMA_K((t)+3,sl_cur);} if(GV){DMA_V((t)+1,sl_next);} \
    CMASK(C0,C1,t); \
    { float a=MX3(C0[0],C0[1],C1[0]),b=MX3(C0[2],C0[3],C1[1]); a=MX3(a,C1[2],C1[3]); \
      _Pragma("unroll") for(int r=4;r<16;r+=4){a=MX3(a,C0[r],C0[r+1]);b=MX3(b,C0[r+2],C0[r+3]);a=MX3(a,C1[r],C1[r+1]);b=MX3(b,C1[r+2],C1[r+3]);} \
      float rm=__builtin_fmaxf(a,b); { auto rr=__builtin_amdgcn_permlane32_swap(__float_as_uint(rm),__float_as_uint(rm),false,false); rm=__builtin_fmaxf(__uint_as_float(rr[0]),__uint_as_float(rr[1])); } \
      resc=false; \
      if(__builtin_expect(__any(rm>(float)THRL),0)){ const float dl=__builtin_fmaxf(rm,0.f); cqm-=dl; \
        _Pragma("unroll") for(int r=0;r<16;++r){C0[r]-=dl;C1[r]-=dl;} \
        const float f=__builtin_amdgcn_exp2f(-dl); l_reg*=f; if(hi==0)wsf[r32]=f; resc=true; } } \
    SBAR(); \
    GAPB(o[0]=__builtin_amdgcn_mfma_f32_32x32x16_bf16(PAF(0),VFR(0),o[0],0,0,0), C0,0); \
    GAPB(o[1]=__builtin_amdgcn_mfma_f32_32x32x16_bf16(PAF(0),VFR(4),o[1],0,0,0), C0,4); \
    KRD(GL,0); GAPB(o[0]=__builtin_amdgcn_mfma_f32_32x32x16_bf16(PAF(1),VFR(1),o[0],0,0,0), C0,8); \
    KRD(GL,1); GAPB(o[1]=__builtin_amdgcn_mfma_f32_32x32x16_bf16(PAF(1),VFR(5),o[1],0,0,0), C0,12); \
    KRD(GL,2); GAPB(o[0]=__builtin_amdgcn_mfma_f32_32x32x16_bf16(PAF(2),VFR(2),o[0],0,0,0), C1,0); \
    KRD(GL,3); GAPB(o[1]=__builtin_amdgcn_mfma_f32_32x32x16_bf16(PAF(2),VFR(6),o[1],0,0,0), C1,4); \
    GAPB(o[0]=__builtin_amdgcn_mfma_f32_32x32x16_bf16(PAF(3),VFR(3),o[0],0,0,0), C1,8); \
    GAPB(o[1]=__builtin_amdgcn_mfma_f32_32x32x16_bf16(PAF(3),VFR(7),o[1],0,0,0), C1,12); \
    }while(0)
  int t=1;
  #undef CMASK
  #define CMASK(P0,P1,t) do{}while(0)
  for(;t+5<NT;t+=2){
    STEP(pB0,pB1,pA0,pA1,t,true,true,true);     WAIT_BAR(2); RESC(); ROT();
    STEP(pA0,pA1,pB0,pB1,t+1,true,true,true);   WAIT_BAR(2); RESC(); ROT();
  }
  #undef CMASK
  #define CMASK(P0,P1,t) do{int jb_=(t)-(NT-4); if(jb_>=0)cmask(P0,P1,jb_,qrel,hi);}while(0)
  #define ENDW(tt) do{ if((tt)+3<NT){WAIT_BAR(2);} else if((tt)+2<NT){WAIT_BAR(1);} else {WAIT_BAR(0);} }while(0)
  for(;t+1<NT;t+=2){
    STEP(pB0,pB1,pA0,pA1,t,(t+3<NT),(t+1<NT),(t+1<NT));       ENDW(t);   RESC(); ROT();
    STEP(pA0,pA1,pB0,pB1,t+1,(t+4<NT),(t+2<NT),(t+2<NT));     ENDW(t+1); RESC(); ROT();
  }
  STEP(pB0,pB1,pA0,pA1,NT-1,false,false,false); RESC();
  { float sacc=pB0[0]+pB0[1]; _Pragma("unroll") for(int r=2;r<16;++r)sacc+=pB0[r]; _Pragma("unroll") for(int r=0;r<16;++r)sacc+=pB1[r]; l_reg+=sacc;
    pw0=(u32x4){PKW(pB0,0),PKW(pB0,2),PKW(pB0,4),PKW(pB0,6)};pw1=(u32x4){PKW(pB0,8),PKW(pB0,10),PKW(pB0,12),PKW(pB0,14)};pw2=(u32x4){PKW(pB1,0),PKW(pB1,2),PKW(pB1,4),PKW(pB1,6)};pw3=(u32x4){PKW(pB1,8),PKW(pB1,10),PKW(pB1,12),PKW(pB1,14)};
    SBAR(); pv(o,vb0+sl_cur,PAF(0),PAF(1),PAF(2),PAF(3)); }
  #undef PKW
  #undef PAF
  #undef VFR
  #undef PIN
  #undef MX3
  #undef GAPA
  #undef GAPB
  #undef EX
  #undef VRD
  #undef KRD
  #undef STEP
  #undef ENDW
  {auto rr=__builtin_amdgcn_permlane32_swap(__float_as_uint(l_reg),__float_as_uint(l_reg),false,false);l_reg=__uint_as_float(rr[0])+__uint_as_float(rr[1]);}
  if(hi==0)wsf[32+r32]=l_reg;asm volatile("s_waitcnt lgkmcnt(0)":::"memory");
  float rli[16];
  #pragma unroll
  for(int r=0;r<16;++r)rli[r]=__builtin_amdgcn_rcpf(wsf[32+crow(r,hi)]);
  bf16*Ow=O+(rowbase+q0+wid*QBLK)*PO+h*D;
  { bf16*stg=(bf16*)(shm+LDS_OST)+wid*2048;
    #pragma unroll
    for(int r=0;r<16;++r){const int orow=crow(r,hi);
      #pragma unroll
      for(int d0=0;d0<2;++d0)stg[orow*64+d0*32+r32]=__float2bfloat16(o[d0][r]*rli[r]);}
    asm volatile("s_waitcnt lgkmcnt(0)":::"memory");
    #pragma unroll
    for(int i=0;i<4;++i){const int row=i*8+(lane>>3),ch=lane&7; const u32x4 v=*(const u32x4*)(stg+row*64+ch*8); ATTN_STORE16(Ow+(long)row*PO+ch*8,v);} }
  asm volatile("s_waitcnt lgkmcnt(0)\n\ts_barrier":::"memory");
  #undef DMA_K
  #undef BIASFILL
  #undef DMA_V
  #undef CMASK
  #undef START
  #undef RESC
  #undef ROT
}
constexpr int ATTN_LDS_BYTES=LDS_BYTES;
struct AttnTensors { const bf16* Q; const bf16* K; const bf16* V; bf16* O; const float* cum; };
struct AttnUnit { int bh; int qb; };
struct StaticOrder {
  int vcu, G;
  __device__ __forceinline__ explicit StaticOrder(int grid,int v):vcu(v),G(grid){}
  __device__ __forceinline__ bool next(int i,AttnUnit&u)const{ const int pr=vcu+(i>>1)*G; if(pr>=256)return false; const int s=pr&3; u.bh=pr>>2; u.qb=(i&1)?7-s:s; return true; }
  __device__ __forceinline__ void a_ready(const AttnUnit&)const{}
  __device__ __forceinline__ void done(const AttnUnit&)const{}
};
template<class Sched,int THRL=8> __device__ __forceinline__ void attn_phase(char*lds,const AttnTensors&T,const Sched&S){
  AttnUnit u;
  for(int i=0;S.next(i,u);++i){ S.a_ready(u); attn_unit<THRL>(u.bh/NHEAD,u.bh%NHEAD,u.qb,T.Q,T.K,T.V,T.O,T.cum+(long)u.bh*SEQ,lds); S.done(u); }
}
#undef SBAR
#undef WAIT_BAR
}
constexpr int NWAVES = 8;
constexpr int T = 16384, D = 1024, SEQ = 2048, NBATCH = 8, DEPTH = 4;
constexpr float ALPHA = 1.6817928305074290f;
constexpr float LN_EPS = 1e-5f;
constexpr int AB_IN = 4112, CD_IN = 3600, NPE = 4096, NPO = 3584;
constexpr float LOG2E = 1.4426950408889634f;
constexpr float FOX_C2 = 0.125f * LOG2E;
constexpr float MLSTM_KSCALE = 0.08838834764831845f;
constexpr int RPAD = 40960;
constexpr int NPH_LAYER = 12, NPHASES = 1 + DEPTH * NPH_LAYER;
#ifndef MK_ONE_LAUNCH
#define MK_ONE_LAUNCH 1
#endif

constexpr size_t MiB = 1u << 20, KiB = 1u << 10;
constexpr size_t WS_CTL = 0, CTL_ZERO_BYTES = 1 * MiB;
constexpr size_t WS_BCNT = 1 * MiB, WS_PANEL = WS_BCNT + 64 * KiB, WS_ROUTE = WS_BCNT + 128 * KiB, WS_GATE = WS_BCNT + 384 * KiB, WS_POS = WS_BCNT + 512 * KiB,
                 WS_DEC = WS_BCNT + 640 * KiB, WS_MLOC = WS_BCNT + 704 * KiB, WS_BLAST = WS_BCNT + 712 * KiB, WS_MPREV = WS_BCNT + 720 * KiB,
                 WS_FOXC = 2 * MiB, WS_NLOC = 2 * MiB + 512 * KiB, WS_SG = 3 * MiB;
constexpr size_t WS_WINE = 4 * MiB, WS_WINO = 20 * MiB, WS_WOUTE = 34 * MiB, WS_WOUTO = 40 * MiB, WS_WGU = 44 * MiB, WS_WD = 300 * MiB;
constexpr size_t WS_HF = 428 * MiB, WS_HB = 492 * MiB, WS_H1F = 524 * MiB, WS_H1B = 588 * MiB;
constexpr size_t WS_R1 = 620 * MiB;
constexpr size_t WS_R2 = 748 * MiB;
constexpr size_t WS_R3 = 812 * MiB;
constexpr size_t WS_R4 = 860 * MiB;
constexpr size_t WS_MIX = 892 * MiB, WS_END = 940 * MiB;
constexpr int CW_BAR = 4096;

constexpr int RING_BYTES = 131072, SMALL_OFF = RING_BYTES, SMALL_BYTES = 8192, MISC_OFF = SMALL_OFF + SMALL_BYTES, LDS_BYTES = 147456;

#define GAS __attribute__((address_space(1)))
#define LAS __attribute__((address_space(3)))
typedef unsigned short bf16;
typedef unsigned v4u __attribute__((ext_vector_type(4)));
typedef unsigned v2u __attribute__((ext_vector_type(2)));
typedef float f32x4 __attribute__((ext_vector_type(4)));
typedef float f32x2 __attribute__((ext_vector_type(2)));
typedef int i32x4 __attribute__((ext_vector_type(4)));
typedef int i32x2 __attribute__((ext_vector_type(2)));
#define LDS_WAIT() asm volatile("s_waitcnt lgkmcnt(0)" ::: "memory")
__device__ __forceinline__ unsigned f2bf(float f) { unsigned u = __builtin_bit_cast(unsigned, f); return (u + 0x7fffu + ((u >> 16) & 1u)) >> 16; }
__device__ __forceinline__ unsigned pk2(float lo, float hi) { return f2bf(lo) | (f2bf(hi) << 16); }
__device__ __forceinline__ float bflo(unsigned w) { return __builtin_bit_cast(float, w << 16); }
__device__ __forceinline__ float bfhi(unsigned w) { return __builtin_bit_cast(float, w & 0xffff0000u); }
__device__ __forceinline__ float bf2f(bf16 b) { return __builtin_bit_cast(float, (unsigned)b << 16); }
__device__ __forceinline__ float wave_sum(float v) {
#pragma unroll
    for (int o = 1; o < 64; o <<= 1) v += __shfl_xor(v, o);
    return v;
}
__device__ __forceinline__ float wave_max(float v) {
#pragma unroll
    for (int o = 1; o < 64; o <<= 1) v = fmaxf(v, __shfl_xor(v, o));
    return v;
}
__device__ __forceinline__ float wave_scan_sum(float v, int lane) {
#pragma unroll
    for (int o = 1; o < 64; o <<= 1) { const float t = __shfl_up(v, o); if (lane >= o) v += t; }
    return v;
}
__device__ __forceinline__ float wave_scan_max(float v, int lane) {
#pragma unroll
    for (int o = 1; o < 64; o <<= 1) { const float t = __shfl_up(v, o); if (lane >= o) v = fmaxf(v, t); }
    return v;
}
__device__ __forceinline__ float softplus_f(float x) { return x > 20.f ? x : log1pf(expf(x)); }
__device__ __forceinline__ float logsigmoid_f(float x) { return fminf(x, 0.f) - log1pf(expf(-fabsf(x))); }
__device__ __forceinline__ float sigmoid_f(float x) { return 1.0f / (1.0f + expf(-x)); }
#define XB_TMO      128
#define XB_XCNT(j)  (256  + 64 * (j))
#define XB_XSUB(j)  (1280 + 64 * (j))
#define XB_XGEN(j)  (2304 + 64 * (j))
#define XB_TOP      3328
#define XB_TOPGEN   3392
#define XCD_BAR_WORDS 3456
#define XB_SPIN_CAP (1u << 18)

__device__ __forceinline__ unsigned xb_ld(unsigned* p)              { return __hip_atomic_load(p, __ATOMIC_RELAXED, __HIP_MEMORY_SCOPE_AGENT); }
__device__ __forceinline__ unsigned xb_add(unsigned* p, unsigned v) { return __hip_atomic_fetch_add(p, v, __ATOMIC_RELAXED, __HIP_MEMORY_SCOPE_AGENT); }
__device__ __forceinline__ unsigned xb_xcc_id() { return (unsigned)__builtin_amdgcn_s_getreg((3 << 11) | 20) & 0xFu; }
#define XB_SPIN(cond, bar) do { unsigned _sp = 0; while (cond) { __builtin_amdgcn_s_sleep(1); \
    if ((++_sp & 255u) == 0u) { if (xb_ld(&(bar)[XB_TMO])) break; if (_sp > XB_SPIN_CAP) { atomicAdd(&(bar)[XB_TMO], 1u); break; } } } } while (0)

struct XcdBarrier {
    unsigned* bar; unsigned x;
    volatile LAS unsigned* st;
};

__device__ __forceinline__ XcdBarrier xcd_barrier_post(unsigned* bar, volatile LAS unsigned* st) {
    XcdBarrier b; b.bar = bar; b.x = xb_xcc_id(); b.st = st;
    if (threadIdx.x == 0) (void)xb_add(&bar[XB_XCNT(b.x)], 1u);
    return b;
}
__device__ __forceinline__ void xcd_barrier_complete(unsigned* bar, unsigned x, unsigned& nloc, unsigned& nx) {
    const unsigned G = gridDim.x * gridDim.y * gridDim.z;
    unsigned sum, cnt, mine, sp = 0u;
    for (;;) {
        sum = 0u; cnt = 0u; mine = 0u;
#pragma unroll
        for (unsigned j = 0; j < 16; ++j) { const unsigned c = xb_ld(&bar[XB_XCNT(j)]); sum += c; cnt += (c > 0u) ? 1u : 0u; mine = (j == x) ? c : mine; }
        if (sum == G) break;
        __builtin_amdgcn_s_sleep(1);
        if ((++sp & 255u) == 0u) { if (xb_ld(&bar[XB_TMO])) break; if (sp > XB_SPIN_CAP) { atomicAdd(&bar[XB_TMO], 1u); break; } }
    }
    nloc = mine > 0u ? mine : 1u; nx = cnt > 0u ? cnt : 1u;
}

__device__ __forceinline__ void xcd_barrier(const XcdBarrier& b) {
    asm volatile("s_waitcnt vmcnt(0)" ::: "memory");
    __syncthreads();
    if (threadIdx.x == 0) {
        unsigned* bar = b.bar;
        __builtin_amdgcn_s_waitcnt(0);
        unsigned nloc = b.st[0], nx = b.st[1];
        if (nloc == 0u) { xcd_barrier_complete(bar, b.x, nloc, nx); b.st[0] = nloc; b.st[1] = nx; }
        const unsigned old = xb_add(&bar[XB_XSUB(b.x)], 1u);
        const unsigned gen = old / nloc;
        if (old + 1u == (gen + 1u) * nloc) {
            __builtin_amdgcn_fence(__ATOMIC_RELEASE, "agent");
            asm volatile("s_waitcnt vmcnt(0)" ::: "memory");
            const unsigned og = xb_add(&bar[XB_TOP], 1u);
            const unsigned tg = og / nx;
            if (og + 1u == (tg + 1u) * nx) xb_add(&bar[XB_TOPGEN], 1u);
            else XB_SPIN(xb_ld(&bar[XB_TOPGEN]) == tg, bar);
            __builtin_amdgcn_fence(__ATOMIC_ACQUIRE, "agent");
            xb_add(&bar[XB_XGEN(b.x)], 1u);
            asm volatile("s_waitcnt vmcnt(0)" ::: "memory");
        } else {
            XB_SPIN(xb_ld(&bar[XB_XGEN(b.x)]) == gen, bar);
            __builtin_amdgcn_fence(__ATOMIC_ACQUIRE, "agent");
            asm volatile("s_waitcnt vmcnt(0)" ::: "memory");
        }
    }
    __syncthreads();
}
struct Frame {
    LAS unsigned char* lds;
    volatile LAS unsigned* MISC;
    unsigned* ctl;
    int tid, lane, wave, vcu, G, gw, NGW;
    float* out; unsigned char* ws;
};
typedef const float* const cfpc_t; typedef __attribute__((address_space(4))) cfpc_t* kargp_t;
__device__ __forceinline__ kargp_t kin() { kargp_t p = (kargp_t)__builtin_amdgcn_kernarg_segment_ptr(); asm volatile("" : "+s"(p)); return p; }
#define KIN(i) (kin()[i])
enum { I_X = 0, I_ABWIN, I_CONVA, I_CONVW, I_CONVB, I_DTB, I_ALOG, I_DSKIP, I_NORMW, I_ABWOUT, I_CDWIN, I_IB, I_FB, I_HNW, I_FOXB, I_CDWOUT, I_LN1G, I_LN1B, I_LN2G, I_LN2B,
       I_RGW, I_RGB, I_REW, I_REB, I_WG, I_WU, I_WDN };

__device__ __forceinline__ void row_load(const float* row, int lane, f32x4 (&v)[4]) {
#pragma unroll
    for (int j = 0; j < 4; ++j) v[j] = ((const f32x4*)row)[lane + 64 * j];
}
__device__ __forceinline__ void row_store_f32(float* row, int lane, const f32x4 (&v)[4]) {
#pragma unroll
    for (int j = 0; j < 4; ++j) ((f32x4*)row)[lane + 64 * j] = v[j];
}
__device__ __forceinline__ void row_store_bf16(bf16* row, int lane, const f32x4 (&v)[4]) {
#pragma unroll
    for (int j = 0; j < 4; ++j) { v2u w; w.x = pk2(v[j][0], v[j][1]); w.y = pk2(v[j][2], v[j][3]); ((v2u*)row)[lane + 64 * j] = w; }
}
__device__ __forceinline__ void row_load_bf16(const bf16* row, int lane, f32x4 (&v)[4]) {
#pragma unroll
    for (int j = 0; j < 4; ++j) { const v2u w = ((const v2u*)row)[lane + 64 * j]; v[j] = (f32x4){bflo(w.x), bfhi(w.x), bflo(w.y), bfhi(w.y)}; }
}
__device__ __forceinline__ void row_layernorm(f32x4 (&v)[4], const float* g, const float* b, int lane) {
    float s = 0.f;
#pragma unroll
    for (int j = 0; j < 4; ++j) s += (v[j][0] + v[j][1]) + (v[j][2] + v[j][3]);
    const float mean = wave_sum(s) * (1.f / D); float s2 = 0.f;
#pragma unroll
    for (int j = 0; j < 4; ++j) { v[j] = v[j] - mean; s2 += (v[j][0] * v[j][0] + v[j][1] * v[j][1]) + (v[j][2] * v[j][2] + v[j][3] * v[j][3]); }
    const float rstd = 1.0f / sqrtf(wave_sum(s2) * (1.f / D) + LN_EPS);
#pragma unroll
    for (int j = 0; j < 4; ++j) { const f32x4 gg = ((const f32x4*)g)[lane + 64 * j], bb = ((const f32x4*)b)[lane + 64 * j]; v[j] = v[j] * rstd * gg + bb; }
}
__device__ __forceinline__ void row_proj16(const f32x4 (&v)[4], const float* W, int ldw, int c0a, int c0b, float* sg, int lane) {
    float a[16];
#pragma unroll
    for (int c = 0; c < 16; ++c) a[c] = 0.f;
#pragma unroll
    for (int j = 0; j < 4; ++j)
#pragma unroll
        for (int i = 0; i < 4; ++i) { const float x = v[j][i]; const float* wr = W + (size_t)(256 * j + 4 * lane + i) * ldw;
            const f32x4 w0 = *(const f32x4*)(wr + c0a), w1 = *(const f32x4*)(wr + c0a + 4), w2 = *(const f32x4*)(wr + c0b), w3 = *(const f32x4*)(wr + c0b + 4);
#pragma unroll
            for (int c = 0; c < 4; ++c) { a[c] += x * w0[c]; a[4 + c] += x * w1[c]; a[8 + c] += x * w2[c]; a[12 + c] += x * w3[c]; } }
    float r = 0.f;
#pragma unroll
    for (int c = 0; c < 16; ++c) { const float s = wave_sum(a[c]); r = (lane == c) ? s : r; }
    if (lane < 16) sg[lane] = r;
}
__device__ __forceinline__ void row_gate_proj(Frame& F, const f32x4 (&v)[4], int layer, int m) {
    float* sg = (float*)(F.ws + WS_SG) + (size_t)m * 16; const int j = layer >> 1;
    if ((layer & 1) == 0) row_proj16(v, KIN(I_ABWIN) + (size_t)j * D * AB_IN, AB_IN, 4096, 4104, sg, F.lane);
    else                  row_proj16(v, KIN(I_CDWIN) + (size_t)j * D * CD_IN, CD_IN, 1536, 3592, sg, F.lane);
}

__device__ __forceinline__ void transpose_tile(const float* W, int ldw, int k0, int n0, bf16* WT, int ldt, int drow0, float scale, const float* kscale, LAS float* scr, int lane) {
#pragma unroll 8
    for (int i = 0; i < 32; ++i) { const int kk = 2 * i + (lane >> 5); float v = W[(size_t)(k0 + kk) * ldw + n0 + (lane & 31)] * scale; if (kscale) v *= kscale[kk]; scr[kk * 33 + (lane & 31)] = v; }
    LDS_WAIT(); asm volatile("" ::: "memory");
    const int c = lane & 7;
#pragma unroll
    for (int j = 0; j < 4; ++j) { const int n = (lane >> 3) + 8 * j; const LAS float* s = scr + (8 * c) * 33 + n;
        v4u o; o.x = pk2(s[0 * 33], s[1 * 33]); o.y = pk2(s[2 * 33], s[3 * 33]); o.z = pk2(s[4 * 33], s[5 * 33]); o.w = pk2(s[6 * 33], s[7 * 33]);
        *(v4u*)(WT + (size_t)(drow0 + n) * ldt + k0 + 8 * c) = o; }
    LDS_WAIT(); asm volatile("" ::: "memory");
}
__device__ __forceinline__ void p_prologue(Frame& F) {
    LAS float* scr = (LAS float*)(F.lds + F.wave * 16384);
    bf16* WinE = (bf16*)(F.ws + WS_WINE); bf16* WinO = (bf16*)(F.ws + WS_WINO); bf16* WoutE = (bf16*)(F.ws + WS_WOUTE); bf16* WoutO = (bf16*)(F.ws + WS_WOUTO);
    bf16* Wgu = (bf16*)(F.ws + WS_WGU); bf16* Wd = (bf16*)(F.ws + WS_WD);
    constexpr int N_WINE = 2 * 2048, N_WINO = 2 * 1792, N_WOE = 2 * 768, N_WOO = 2 * 512, N_GU = 128 * 512, N_D = 128 * 256;
    constexpr int NITEMS = N_WINE + N_WINO + N_WOE + N_WOO + N_GU + N_D;
    for (int it = F.gw; it < NITEMS; it += F.NGW) {
        int r = it;
        if (r < N_WINE) { const int j = r / 2048, q = r % 2048, kb = q / 128, nb = q % 128;
            transpose_tile(KIN(I_ABWIN) + (size_t)j * D * AB_IN, AB_IN, 64 * kb, 32 * nb, WinE + (size_t)j * NPE * D, D, 32 * nb, 1.f, nullptr, scr, F.lane); continue; } r -= N_WINE;
        if (r < N_WINO) { const int j = r / 1792, q = r % 1792, seg = q / 256, q2 = q % 256, kb = q2 / 16, nb = q2 % 16;
            const int scol = (seg < 3 ? 512 * seg : 1544 + 512 * (seg - 3)) + 32 * nb; const float sc = seg == 1 ? MLSTM_KSCALE : (seg == 4 ? FOX_C2 : 1.f);
            transpose_tile(KIN(I_CDWIN) + (size_t)j * D * CD_IN, CD_IN, 64 * kb, scol, WinO + (size_t)j * NPO * D, D, 512 * seg + 32 * nb, sc, nullptr, scr, F.lane); continue; } r -= N_WINO;
        if (r < N_WOE) { const int j = r / 768, q = r % 768, kb = q / 32, nb = q % 32;
            const float* ks = kb >= 8 ? KIN(I_NORMW) + (size_t)j * 1024 + (64 * kb - 512) : nullptr;
            transpose_tile(KIN(I_ABWOUT) + (size_t)j * 1536 * D, D, 64 * kb, 32 * nb, WoutE + (size_t)j * D * 1536, 1536, 32 * nb, 1.f, ks, scr, F.lane); continue; } r -= N_WOE;
        if (r < N_WOO) { const int j = r / 512, q = r % 512, kb = q / 32, nb = q % 32;
            transpose_tile(KIN(I_CDWOUT) + (size_t)j * D * D, D, 64 * kb, 32 * nb, WoutO + (size_t)j * D * D, D, 32 * nb, 1.f, nullptr, scr, F.lane); continue; } r -= N_WOO;
        if (r < N_GU) { const int le = r / 512, q = r % 512, half = q / 256, q2 = q % 256, kb = q2 / 16, nb = q2 % 16, n0 = 32 * nb;
            const float* src = (half ? KIN(I_WU) : KIN(I_WG)) + (size_t)le * D * 512;
            transpose_tile(src, 512, 64 * kb, n0, Wgu + (size_t)le * D * D, D, 256 * (n0 / 128) + 128 * half + (n0 % 128), 1.f, nullptr, scr, F.lane); continue; } r -= N_GU;
        { const int le = r / 256, q = r % 256, kb = q / 32, nb = q % 32;
            transpose_tile(KIN(I_WDN) + (size_t)le * 512 * D, D, 64 * kb, 32 * nb, Wd + (size_t)le * D * 512, 512, 32 * nb, 1.f, nullptr, scr, F.lane); }
    }
    bf16* HB = (bf16*)(F.ws + WS_HB);
    for (int m = F.gw; m < T; m += F.NGW) { f32x4 v[4]; row_load(KIN(I_X) + (size_t)m * D, F.lane, v); row_store_bf16(HB + (size_t)m * D, F.lane, v); row_gate_proj(F, v, 0, m); }
}
__device__ __forceinline__ void e0_conv(Frame& F, int j) {
    const bf16* P = (const bf16*)(F.ws + WS_R1); bf16* XBC = (bf16*)(F.ws + WS_R3); bf16* MIX = (bf16*)(F.ws + WS_MIX);
    const float* cw = KIN(I_CONVW) + (size_t)j * 4 * 1536; const float* cb = KIN(I_CONVB) + (size_t)j * 1536; const float* ca = KIN(I_CONVA) + (size_t)j * 3 * 512;
    for (int it = F.gw; it < (T / 8) * 16; it += F.NGW) {
        const int tt = it >> 4, cg = it & 15, t0 = tt * 8, s0 = t0 & (SEQ - 1);
        if (cg < 12) {
            const int c = cg * 128 + 2 * F.lane;
            float w0[4], w1[4];
#pragma unroll
            for (int k = 0; k < 4; ++k) { w0[k] = cw[k * 1536 + c]; w1[k] = cw[k * 1536 + c + 1]; }
            const float b0 = cb[c], b1 = cb[c + 1];
            float xa[11], xb[11];
#pragma unroll
            for (int r = 0; r < 11; ++r) { unsigned w = 0u; if (s0 - 3 + r >= 0) w = *(const unsigned*)(P + (size_t)(t0 - 3 + r) * NPE + 2560 + c); xa[r] = bflo(w); xb[r] = bfhi(w); }
#pragma unroll
            for (int o = 0; o < 8; ++o) { float a0 = b0, a1 = b1;
#pragma unroll
                for (int k = 0; k < 4; ++k) { a0 += w0[k] * xa[o + k]; a1 += w1[k] * xb[o + k]; }
                *(unsigned*)(XBC + (size_t)(t0 + o) * 1536 + c) = pk2(silu_f(a0), silu_f(a1)); }
        } else {
            const int c = (cg - 12) * 128 + 2 * F.lane;
            float w0[3], w1[3];
#pragma unroll
            for (int k = 0; k < 3; ++k) { w0[k] = ca[k * 512 + c]; w1[k] = ca[k * 512 + c + 1]; }
            float ua[10], ub[10];
#pragma unroll
            for (int r = 0; r < 10; ++r) { float a = 0.f, b = 0.f;
                if (s0 - 2 + r >= 0) { const bf16* pr = P + (size_t)(t0 - 2 + r) * NPE; const unsigned cgw = *(const unsigned*)(pr + 512 + c), xw = *(const unsigned*)(pr + 1024 + c); a = bflo(cgw) * bflo(xw); b = bfhi(cgw) * bfhi(xw); }
                ua[r] = a; ub[r] = b; }
#pragma unroll
            for (int o = 0; o < 8; ++o) { float a0 = 0.f, a1 = 0.f;
#pragma unroll
                for (int k = 0; k < 3; ++k) { a0 += w0[k] * ua[o + k]; a1 += w1[k] * ub[o + k]; }
                const unsigned bg = *(const unsigned*)(P + (size_t)(t0 + o) * NPE + c);
                *(unsigned*)(MIX + (size_t)(t0 + o) * 1536 + c) = pk2(bflo(bg) * a0, bfhi(bg) * a1); }
        }
    }
}
__device__ __forceinline__ void ssd_gates(Frame& F, int j, int t0, int h, LAS float* dtl, LAS float* acs) {
    if (F.wave == 0) {
        const float* SG = (const float*)(F.ws + WS_SG); const float dtb = KIN(I_DTB)[j * 16 + h], aneg = -expf(KIN(I_ALOG)[j * 16 + h]);
        const float d0 = softplus_f(SG[(size_t)(t0 + 2 * F.lane) * 16 + h] + dtb), d1 = softplus_f(SG[(size_t)(t0 + 2 * F.lane + 1) * 16 + h] + dtb);
        const float a0 = d0 * aneg, a1 = d1 * aneg; const float inc = wave_scan_sum(a0 + a1, F.lane);
        dtl[2 * F.lane] = d0; dtl[2 * F.lane + 1] = d1; acs[2 * F.lane] = inc - a1; acs[2 * F.lane + 1] = inc;
    }
}
__device__ __forceinline__ void e1_states(Frame& F, int j) {
    const bf16* XBC = (const bf16*)(F.ws + WS_R3); float* ST = (float*)(F.ws + WS_R4); float* DEC = (float*)(F.ws + WS_DEC);
    LAS float* xw = (LAS float*)F.lds; LAS float* Bm = (LAS float*)(F.lds + 32768); LAS float* dtl = (LAS float*)(F.lds + SMALL_OFF); LAS float* acs = dtl + 128;
    for (int u = F.vcu; u < 2048; u += F.G) {
        const int b = u >> 8, c = (u >> 4) & 15, h = u & 15, g = h >> 2, t0 = b * SEQ + c * 128;
        __syncthreads();
        ssd_gates(F, j, t0, h, dtl, acs);
        __syncthreads();
        for (int i = F.tid; i < 128 * 32; i += 512) { const int l = i >> 5, pp = (i & 31) * 2; const float wgt = expf(acs[127] - acs[l]) * dtl[l];
            const unsigned xv = *(const unsigned*)(XBC + (size_t)(t0 + l) * 1536 + h * 64 + pp), bv = *(const unsigned*)(XBC + (size_t)(t0 + l) * 1536 + 1024 + g * 64 + pp);
            xw[l * 64 + pp] = bflo(xv) * wgt; xw[l * 64 + pp + 1] = bfhi(xv) * wgt; Bm[l * 64 + pp] = bflo(bv); Bm[l * 64 + pp + 1] = bfhi(bv); }
        __syncthreads();
        const int n = F.lane, p0 = 8 * F.wave; float acc[8];
#pragma unroll
        for (int i = 0; i < 8; ++i) acc[i] = 0.f;
#pragma unroll 2
        for (int l = 0; l < 128; ++l) { const float bm = Bm[l * 64 + n]; const f32x4 x0 = *(const LAS f32x4*)(xw + l * 64 + p0), x1 = *(const LAS f32x4*)(xw + l * 64 + p0 + 4);
#pragma unroll
            for (int i = 0; i < 4; ++i) { acc[i] += x0[i] * bm; acc[4 + i] += x1[i] * bm; } }
        float* dst = ST + (size_t)u * 4096;
#pragma unroll
        for (int i = 0; i < 8; ++i) dst[(p0 + i) * 64 + n] = acc[i];
        if (F.tid == 0) DEC[u] = expf(acs[127]);
    }
}
__device__ __forceinline__ void e2_scan(Frame& F) {
    float* ST = (float*)(F.ws + WS_R4); const float* DEC = (const float*)(F.ws + WS_DEC);
    for (int e = F.vcu * 512 + F.tid; e < NBATCH * 16 * 4096; e += F.G * 512) {
        const int b = e >> 16, h = (e >> 12) & 15, pn = e & 4095; float run = 0.f;
        for (int c = 0; c < 16; ++c) { const int u = (b * 16 + c) * 16 + h; const size_t idx = (size_t)u * 4096 + pn; const float s = ST[idx]; ST[idx] = run; run = run * DEC[u] + s; }
    }
}
__device__ __forceinline__ void e3_output(Frame& F, int j) {
    const bf16* XBC = (const bf16*)(F.ws + WS_R3); const float* ST = (const float*)(F.ws + WS_R4); float* Y = (float*)(F.ws + WS_R2);
    LAS float* R0 = (LAS float*)F.lds;
    LAS float* R1 = (LAS float*)(F.lds + 32768);
    LAS float* R2 = (LAS float*)(F.lds + 65536);
    LAS float* dtl = (LAS float*)(F.lds + SMALL_OFF); LAS float* acs = dtl + 128;
    for (int u = F.vcu; u < 2048; u += F.G) {
        const int b = u >> 8, c = (u >> 4) & 15, h = u & 15, g = h >> 2, t0 = b * SEQ + c * 128;
        __syncthreads();
        ssd_gates(F, j, t0, h, dtl, acs);
        for (int i = F.tid; i < 128 * 32; i += 512) { const int l = i >> 5, nn = (i & 31) * 2;
            const unsigned bv = *(const unsigned*)(XBC + (size_t)(t0 + l) * 1536 + 1024 + g * 64 + nn), cv = *(const unsigned*)(XBC + (size_t)(t0 + l) * 1536 + 1280 + g * 64 + nn);
            R0[l * 64 + nn] = bflo(cv); R0[l * 64 + nn + 1] = bfhi(cv); R1[nn * 128 + l] = bflo(bv); R1[(nn + 1) * 128 + l] = bfhi(bv); }
        { const float* hp = ST + (size_t)u * 4096; for (int i = F.tid; i < 4096; i += 512) { const int p = i >> 6, n = i & 63; R2[n * 64 + p] = hp[i]; } }
        __syncthreads();
        const int p = F.lane, l0 = 16 * F.wave; float acc[16];
#pragma unroll
        for (int i = 0; i < 16; ++i) acc[i] = 0.f;
#pragma unroll 1
        for (int n0 = 0; n0 < 64; n0 += 4) { float hp[4];
#pragma unroll
            for (int i = 0; i < 4; ++i) hp[i] = R2[(n0 + i) * 64 + p];
#pragma unroll
            for (int li = 0; li < 16; ++li) { const f32x4 c4 = *(const LAS f32x4*)(R0 + (l0 + li) * 64 + n0); acc[li] += (c4[0] * hp[0] + c4[1] * hp[1]) + (c4[2] * hp[2] + c4[3] * hp[3]); } }
#pragma unroll
        for (int li = 0; li < 16; ++li) acc[li] *= expf(acs[l0 + li]);
        __syncthreads();
#pragma unroll 1
        for (int half = 0; half < 2; ++half) { const int s = F.tid & 127, lg = 32 * (F.tid >> 7) + 16 * half; float gacc[16];
#pragma unroll
            for (int i = 0; i < 16; ++i) gacc[i] = 0.f;
#pragma unroll 1
            for (int n0 = 0; n0 < 64; n0 += 4) { float bb[4];
#pragma unroll
                for (int i = 0; i < 4; ++i) bb[i] = R1[(n0 + i) * 128 + s];
#pragma unroll
                for (int li = 0; li < 16; ++li) { const f32x4 c4 = *(const LAS f32x4*)(R0 + (lg + li) * 64 + n0); gacc[li] += (c4[0] * bb[0] + c4[1] * bb[1]) + (c4[2] * bb[2] + c4[3] * bb[3]); } }
            const float as = acs[s];
#pragma unroll
            for (int li = 0; li < 16; ++li) { const int l = lg + li; R2[l * 128 + s] = (s <= l) ? gacc[li] * expf(acs[l] - as) : 0.f; } }
        __syncthreads();
        for (int i = F.tid; i < 128 * 32; i += 512) { const int l = i >> 5, pp = (i & 31) * 2; const unsigned xv = *(const unsigned*)(XBC + (size_t)(t0 + l) * 1536 + h * 64 + pp);
            R0[l * 64 + pp] = bflo(xv); R0[l * 64 + pp + 1] = bfhi(xv); }
        __syncthreads();
#pragma unroll 1
        for (int s0 = 0; s0 < l0 + 16; s0 += 4) { float xv[4];
#pragma unroll
            for (int i = 0; i < 4; ++i) xv[i] = R0[(s0 + i) * 64 + p] * dtl[s0 + i];
#pragma unroll
            for (int li = 0; li < 16; ++li) { const f32x4 g4 = *(const LAS f32x4*)(R2 + (l0 + li) * 128 + s0); acc[li] += (g4[0] * xv[0] + g4[1] * xv[1]) + (g4[2] * xv[2] + g4[3] * xv[3]); } }
        const float dsk = KIN(I_DSKIP)[j * 16 + h];
#pragma unroll
        for (int li = 0; li < 16; ++li) Y[(size_t)(t0 + l0 + li) * D + h * 64 + p] = acc[li] + dsk * R0[(l0 + li) * 64 + p];
    }
}
__device__ __forceinline__ void e4_gnorm(Frame& F) {
    const float* Y = (const float*)(F.ws + WS_R2); const bf16* P = (const bf16*)(F.ws + WS_R1); bf16* MIX = (bf16*)(F.ws + WS_MIX);
    for (int m = F.gw; m < T; m += F.NGW) { f32x4 y[4], z[4]; row_load(Y + (size_t)m * D, F.lane, y); row_load_bf16(P + (size_t)m * NPE + 1536, F.lane, z); float ss = 0.f;
#pragma unroll
        for (int jj = 0; jj < 4; ++jj)
#pragma unroll
            for (int i = 0; i < 4; ++i) { const float uu = y[jj][i] * silu_f(z[jj][i]); y[jj][i] = uu; ss += uu * uu; }
        const float rstd = 1.0f / sqrtf(wave_sum(ss) * (1.f / D) + LN_EPS);
#pragma unroll
        for (int jj = 0; jj < 4; ++jj) y[jj] = y[jj] * rstd;
        row_store_bf16(MIX + (size_t)m * 1536 + 512, F.lane, y); }
}
__device__ __forceinline__ void o_foxscan(Frame& F, int j) {
    const float* SG = (const float*)(F.ws + WS_SG); float* FOXC = (float*)(F.ws + WS_FOXC);
    for (int bh = F.gw; bh < 64; bh += F.NGW) { const int b = bh >> 3, h = bh & 7; const float bias = KIN(I_FOXB)[j * 8 + h];
        float v[32], run = 0.f;
#pragma unroll
        for (int i = 0; i < 32; ++i) { run += logsigmoid_f(SG[(size_t)(b * SEQ + 32 * F.lane + i) * 16 + 8 + h] + bias); v[i] = run; }
        const float off = wave_scan_sum(run, F.lane) - run;
#pragma unroll
        for (int i = 0; i < 32; ++i) FOXC[(size_t)bh * SEQ + 32 * F.lane + i] = (v[i] + off) * LOG2E; }
}
__device__ __forceinline__ void mlstm_gates(Frame& F, int j, int t0, int h, float& bcum, float& ib) {
    const float* SG = (const float*)(F.ws + WS_SG);
    ib = SG[(size_t)(t0 + F.lane) * 16 + h] + KIN(I_IB)[j * 4 + h];
    bcum = wave_scan_sum(logsigmoid_f(SG[(size_t)(t0 + F.lane) * 16 + 4 + h] + KIN(I_FB)[j * 4 + h]), F.lane);
}
__device__ __forceinline__ void o1_local(Frame& F, int j) {
    const bf16* P = (const bf16*)(F.ws + WS_R1); float* KLOC = (float*)(F.ws + WS_R2); float* NLOC = (float*)(F.ws + WS_NLOC); float* MLOC = (float*)(F.ws + WS_MLOC); float* BLAST = (float*)(F.ws + WS_BLAST);
    LAS float* kw = (LAS float*)F.lds; LAS float* Vs = (LAS float*)(F.lds + 32768); LAS float* wk = (LAS float*)(F.lds + SMALL_OFF);
    for (int u = F.vcu; u < 1024; u += F.G) {
        const int b = u >> 7, h = (u >> 5) & 3, c = u & 31, t0 = b * SEQ + c * 64;
        __syncthreads();
        if (F.wave == 0) { float bcum, ib; mlstm_gates(F, j, t0, h, bcum, ib); const float blast = __shfl(bcum, 63); const float gl = blast - bcum + ib; const float ml = wave_max(gl);
            wk[F.lane] = expf(gl - ml); if (F.lane == 0) { MLOC[u] = ml; BLAST[u] = blast; } }
        __syncthreads();
        for (int i = F.tid; i < 64 * 64; i += 512) { const int s = i >> 6, dd = (i & 63) * 2; const float w = wk[s];
            const unsigned kv = *(const unsigned*)(P + (size_t)(t0 + s) * NPO + 512 + h * 128 + dd), vv = *(const unsigned*)(P + (size_t)(t0 + s) * NPO + 1024 + h * 128 + dd);
            kw[s * 128 + dd] = bflo(kv) * w; kw[s * 128 + dd + 1] = bfhi(kv) * w; Vs[s * 128 + dd] = bflo(vv); Vs[s * 128 + dd + 1] = bfhi(vv); }
        __syncthreads();
        const int v = F.tid & 127, d0 = 32 * (F.tid >> 7); float acc[32];
#pragma unroll
        for (int i = 0; i < 32; ++i) acc[i] = 0.f;
#pragma unroll 1
        for (int s = 0; s < 64; ++s) { const float vv = Vs[s * 128 + v];
#pragma unroll
            for (int di = 0; di < 32; di += 4) { const f32x4 k4 = *(const LAS f32x4*)(kw + s * 128 + d0 + di);
#pragma unroll
                for (int i = 0; i < 4; ++i) acc[di + i] += k4[i] * vv; } }
        float* dst = KLOC + (size_t)u * 16384;
#pragma unroll
        for (int i = 0; i < 32; ++i) dst[(d0 + i) * 128 + v] = acc[i];
        if (F.tid < 128) { float a = 0.f; for (int s = 0; s < 64; ++s) a += kw[s * 128 + F.tid]; NLOC[(size_t)u * 128 + F.tid] = a; }
    }
}
__device__ __forceinline__ void o2_scan(Frame& F) {
    float* KLOC = (float*)(F.ws + WS_R2); float* NLOC = (float*)(F.ws + WS_NLOC); const float* MLOC = (const float*)(F.ws + WS_MLOC); const float* BLAST = (const float*)(F.ws + WS_BLAST); float* MPREV = (float*)(F.ws + WS_MPREV);
    constexpr int PER = 16384 + 128;
    for (int e = F.vcu * 512 + F.tid; e < 32 * PER; e += F.G * 512) {
        const int bh = e / PER, r = e % PER; float run = 0.f, m = 0.f;
        for (int c = 0; c < 32; ++c) { const int u = bh * 32 + c; float* p = r < 16384 ? KLOC + (size_t)u * 16384 + r : NLOC + (size_t)u * 128 + (r - 16384);
            const float loc = *p; *p = run; if (r == 0) MPREV[u] = m;
            const float bl = BLAST[u], ml = MLOC[u], mn = fmaxf(bl + m, ml);
            run = expf(bl + m - mn) * run + expf(ml - mn) * loc; m = mn; }
    }
}
__device__ __forceinline__ void o3_output(Frame& F, int j) {
    const bf16* P = (const bf16*)(F.ws + WS_R1); const float* CPREV = (const float*)(F.ws + WS_R2); const float* NPREV = (const float*)(F.ws + WS_NLOC); const float* MPREV = (const float*)(F.ws + WS_MPREV); bf16* MIX = (bf16*)(F.ws + WS_MIX);
    LAS float* qT = (LAS float*)F.lds;
    LAS float* kT = (LAS float*)(F.lds + 32768);
    LAS float* Vs = (LAS float*)(F.lds + 65536);
    LAS float* WT = (LAS float*)(F.lds + 98304);
    LAS float* sm = (LAS float*)(F.lds + SMALL_OFF);
    for (int u = F.vcu; u < 1024; u += F.G) {
        const int b = u >> 7, h = (u >> 5) & 3, c = u & 31, t0 = b * SEQ + c * 64;
        __syncthreads();
        if (F.wave == 0) { float bcum, ib; mlstm_gates(F, j, t0, h, bcum, ib); const float mprev = MPREV[u];
            const float pm = wave_scan_max(ib - bcum, F.lane); const float inter = bcum + mprev; const float mt = fmaxf(bcum + pm, inter);
            sm[F.lane] = bcum; sm[64 + F.lane] = ib; sm[128 + F.lane] = mt; sm[192 + F.lane] = expf(inter - mt); }
        for (int i = F.tid; i < 64 * 64; i += 512) { const int s = i >> 6, dd = (i & 63) * 2; const bf16* pr = P + (size_t)(t0 + s) * NPO + h * 128 + dd;
            const unsigned qv = *(const unsigned*)pr, kv = *(const unsigned*)(pr + 512), vv = *(const unsigned*)(pr + 1024);
            qT[dd * 64 + s] = bflo(qv); qT[(dd + 1) * 64 + s] = bfhi(qv); kT[dd * 64 + s] = bflo(kv); kT[(dd + 1) * 64 + s] = bfhi(kv); Vs[s * 128 + dd] = bflo(vv); Vs[s * 128 + dd + 1] = bfhi(vv); }
        __syncthreads();
        { const int s = F.lane, l0 = 8 * F.wave; float acc[8];
#pragma unroll
            for (int i = 0; i < 8; ++i) acc[i] = 0.f;
#pragma unroll 2
            for (int d = 0; d < 128; ++d) { const float kk = kT[d * 64 + s]; const f32x4 q0 = *(const LAS f32x4*)(qT + d * 64 + l0), q1 = *(const LAS f32x4*)(qT + d * 64 + l0 + 4);
#pragma unroll
                for (int i = 0; i < 4; ++i) { acc[i] += q0[i] * kk; acc[4 + i] += q1[i] * kk; } }
            const float gs = sm[64 + s] - sm[s];
#pragma unroll
            for (int i = 0; i < 8; ++i) { const int l = l0 + i; const float w = (s <= l) ? acc[i] * expf(sm[l] + gs - sm[128 + l]) : 0.f; WT[s * 64 + l] = w; const float dsum = wave_sum(w); if (F.lane == 0) sm[256 + l] = dsum; } }
        __syncthreads();
        if (F.tid < 64) { const int l = F.tid; float qn = 0.f; const float* np = NPREV + (size_t)u * 128; for (int d = 0; d < 128; ++d) qn += qT[d * 64 + l] * np[d]; sm[256 + l] += sm[192 + l] * qn; }
        const int v = F.tid & 127, l0 = 16 * (F.tid >> 7); float acc[16];
#pragma unroll
        for (int i = 0; i < 16; ++i) acc[i] = 0.f;
        { const float* cp = CPREV + (size_t)u * 16384;
#pragma unroll 2
            for (int d = 0; d < 128; ++d) { const float cc = cp[d * 128 + v];
#pragma unroll
                for (int li = 0; li < 16; li += 4) { const f32x4 q4 = *(const LAS f32x4*)(qT + d * 64 + l0 + li);
#pragma unroll
                    for (int i = 0; i < 4; ++i) acc[li + i] += q4[i] * cc; } } }
#pragma unroll
        for (int i = 0; i < 16; ++i) acc[i] *= sm[192 + l0 + i];
#pragma unroll 2
        for (int s = 0; s < 64; ++s) { const float vv = Vs[s * 128 + v];
#pragma unroll
            for (int li = 0; li < 16; li += 4) { const f32x4 w4 = *(const LAS f32x4*)(WT + s * 64 + l0 + li);
#pragma unroll
                for (int i = 0; i < 4; ++i) acc[li + i] += w4[i] * vv; } }
        __syncthreads();
        LAS float* hb = kT;
#pragma unroll
        for (int i = 0; i < 16; ++i) { const int l = l0 + i; const float hv = acc[i] / fmaxf(fabsf(sm[256 + l]), expf(-sm[128 + l])); acc[i] = hv; hb[l * 128 + v] = hv; }
        __syncthreads();
        { const int lb = 8 * F.wave;
#pragma unroll
            for (int i = 0; i < 8; ++i) { const int l = lb + i; const float a = hb[l * 128 + F.lane], bq = hb[l * 128 + 64 + F.lane]; const float mu = wave_sum(a + bq) * (1.f / 128.f);
                const float da = a - mu, db = bq - mu; const float var = wave_sum(da * da + db * db) * (1.f / 128.f); if (F.lane == 0) { sm[320 + l] = mu; sm[384 + l] = 1.0f / sqrtf(var + LN_EPS); } } }
        __syncthreads();
        const float hw = KIN(I_HNW)[j * 512 + h * 128 + v];
#pragma unroll
        for (int i = 0; i < 16; ++i) { const int l = l0 + i; const float og = sigmoid_f(bf2f(P[(size_t)(t0 + l) * NPO + 1536 + h * 128 + v]));
            MIX[(size_t)(t0 + l) * D + h * 128 + v] = (bf16)f2bf(og * (acc[i] - sm[320 + l]) * sm[384 + l] * hw); }
    }
}
__device__ __forceinline__ void o4_fox(Frame& F) {
    const bf16* P = (const bf16*)(F.ws + WS_R1); const float* FOXC = (const float*)(F.ws + WS_FOXC); bf16* MIX = (bf16*)(F.ws + WS_MIX);
    LAS float* QT = (LAS float*)F.lds;
    LAS float* KT = (LAS float*)(F.lds + 16384);
    LAS float* Vs = (LAS float*)(F.lds + 32768);
    LAS float* PT = (LAS float*)(F.lds + 49152) + F.wave * 512;
    LAS float* cq = (LAS float*)(F.lds + SMALL_OFF); LAS float* ck = cq + 64;
    for (int it = F.vcu; it < 2048; it += F.G) {
        const int qt = 31 - (it >> 6), bh = it & 63, b = bh >> 3, h = bh & 7, tq0 = b * SEQ + qt * 64;
        __syncthreads();
        for (int i = F.tid; i < 64 * 32; i += 512) { const int q = i >> 5, dd = (i & 31) * 2; const unsigned w = *(const unsigned*)(P + (size_t)(tq0 + q) * NPO + 2048 + h * 64 + dd); QT[dd * 64 + q] = bflo(w); QT[(dd + 1) * 64 + q] = bfhi(w); }
        if (F.tid < 64) cq[F.tid] = FOXC[(size_t)bh * SEQ + qt * 64 + F.tid];
        const int q0 = 8 * F.wave; float mrun[8], lrun[8], o[8];
#pragma unroll
        for (int i = 0; i < 8; ++i) { mrun[i] = -INFINITY; lrun[i] = 0.f; o[i] = 0.f; }
#pragma unroll 1
        for (int kt = 0; kt <= qt; ++kt) { const int tk0 = b * SEQ + kt * 64;
            __syncthreads();
            for (int i = F.tid; i < 64 * 32; i += 512) { const int k = i >> 5, dd = (i & 31) * 2; const bf16* pr = P + (size_t)(tk0 + k) * NPO + h * 64 + dd; const unsigned kw = *(const unsigned*)(pr + 2560), vw = *(const unsigned*)(pr + 3072);
                KT[dd * 64 + k] = bflo(kw); KT[(dd + 1) * 64 + k] = bfhi(kw); Vs[k * 64 + dd] = bflo(vw); Vs[k * 64 + dd + 1] = bfhi(vw); }
            if (F.tid < 64) ck[F.tid] = FOXC[(size_t)bh * SEQ + kt * 64 + F.tid];
            __syncthreads();
            float s[8];
#pragma unroll
            for (int i = 0; i < 8; ++i) s[i] = 0.f;
#pragma unroll 2
            for (int d = 0; d < 64; ++d) { const float kk = KT[d * 64 + F.lane]; const f32x4 qa = *(const LAS f32x4*)(QT + d * 64 + q0), qb = *(const LAS f32x4*)(QT + d * 64 + q0 + 4);
#pragma unroll
                for (int i = 0; i < 4; ++i) { s[i] += qa[i] * kk; s[4 + i] += qb[i] * kk; } }
            const float ckv = ck[F.lane];
#pragma unroll
            for (int i = 0; i < 8; ++i) { float sv = s[i] + cq[q0 + i] - ckv; if (kt == qt && F.lane > q0 + i) sv = -INFINITY;
                const float mn = fmaxf(mrun[i], wave_max(sv)); const float p = exp2f(sv - mn), al = exp2f(mrun[i] - mn);
                lrun[i] = lrun[i] * al + wave_sum(p); o[i] *= al; mrun[i] = mn; PT[F.lane * 8 + i] = p; }
            LDS_WAIT(); asm volatile("" ::: "memory");
#pragma unroll 2
            for (int k = 0; k < 64; ++k) { const float vv = Vs[k * 64 + F.lane]; const f32x4 pa = *(const LAS f32x4*)(PT + k * 8), pb = *(const LAS f32x4*)(PT + k * 8 + 4);
#pragma unroll
                for (int i = 0; i < 4; ++i) { o[i] += pa[i] * vv; o[4 + i] += pb[i] * vv; } }
        }
#pragma unroll
        for (int i = 0; i < 8; ++i) MIX[(size_t)(tq0 + q0 + i) * D + 512 + h * 64 + F.lane] = (bf16)f2bf(o[i] / lrun[i]);
    }
}
typedef short bf16x8 __attribute__((ext_vector_type(8)));
typedef float f32x16 __attribute__((ext_vector_type(16)));
typedef __bf16 bf16x2_t __attribute__((ext_vector_type(2)));
#define MFMA32(a, b, c) __builtin_amdgcn_mfma_f32_32x32x16_bf16((a), (b), (c), 0, 0, 0)
__device__ __forceinline__ int crow(int r, int h) { return (r & 3) + 8 * (r >> 2) + 4 * h; }
__device__ __forceinline__ unsigned cvtpk(float lo, float hi) { const f32x2 v = {lo, hi}; const bf16x2_t b = __builtin_convertvector(v, bf16x2_t); return __builtin_bit_cast(unsigned, b); }
__device__ __forceinline__ bf16x8 pack8(float a0, float a1, float a2, float a3, float a4, float a5, float a6, float a7) {
    v4u p; p.x = cvtpk(a0, a1); p.y = cvtpk(a2, a3); p.z = cvtpk(a4, a5); p.w = cvtpk(a6, a7); return __builtin_bit_cast(bf16x8, p); }
__device__ __forceinline__ bf16x8 pack_step(const f32x16& x, int s) { return pack8(x[8 * s], x[8 * s + 1], x[8 * s + 2], x[8 * s + 3], x[8 * s + 4], x[8 * s + 5], x[8 * s + 6], x[8 * s + 7]); }
__device__ __forceinline__ bf16x8 ldg8_f32(const float* p) { const f32x4 a = *(const f32x4*)p, b = *(const f32x4*)(p + 4); return pack8(a[0], a[1], a[2], a[3], b[0], b[1], b[2], b[3]); }
__device__ __forceinline__ bf16x8 lds_nat(const LAS bf16* row, int ks, int h) { return *(const LAS bf16x8*)(row + 16 * ks + 8 * h); }
__device__ __forceinline__ bf16x8 lds_krow(const LAS bf16* row, int k0, int h) { const v2u lo = *(const LAS v2u*)(row + k0 + 4 * h), hi = *(const LAS v2u*)(row + k0 + 8 + 4 * h);
    v4u p; p.x = lo.x; p.y = lo.y; p.z = hi.x; p.w = hi.y; return __builtin_bit_cast(bf16x8, p); }
__device__ __forceinline__ f32x16 zero16() { f32x16 z;
#pragma unroll
    for (int i = 0; i < 16; ++i) z[i] = 0.f;
    return z; }

__device__ __forceinline__ void ssd_gates4(Frame& F, int j, int t0, int g, LAS float* DT, LAS float* ACS) {
    if (F.wave < 4) { const int h = 4 * g + F.wave; const float* SG = (const float*)(F.ws + WS_SG); const float dtb = KIN(I_DTB)[j * 16 + h], aneg = -expf(KIN(I_ALOG)[j * 16 + h]);
        const float d0 = softplus_f(SG[(size_t)(t0 + 2 * F.lane) * 16 + h] + dtb), d1 = softplus_f(SG[(size_t)(t0 + 2 * F.lane + 1) * 16 + h] + dtb);
        const float a0 = d0 * aneg, a1 = d1 * aneg; const float inc = wave_scan_sum(a0 + a1, F.lane);
        DT[F.wave * 128 + 2 * F.lane] = d0; DT[F.wave * 128 + 2 * F.lane + 1] = d1; ACS[F.wave * 128 + 2 * F.lane] = inc - a1; ACS[F.wave * 128 + 2 * F.lane + 1] = inc; }
}
__device__ __forceinline__ void ssd_stage_xt(Frame& F, const bf16* XBC, int t0, int g, LAS bf16* XT, const LAS float* WGT) {
    for (int i = F.tid; i < 2048; i += 512) { const int cp = i & 127, s0 = 8 * (i >> 7), hl = cp >> 5; float a[8], bq[8];
#pragma unroll
        for (int k = 0; k < 8; ++k) { const unsigned w = *(const unsigned*)(XBC + (size_t)(t0 + s0 + k) * 1536 + g * 256 + 2 * cp); const float wg = WGT[hl * 128 + s0 + k]; a[k] = bflo(w) * wg; bq[k] = bfhi(w) * wg; }
        *(LAS bf16x8*)(XT + (2 * cp) * 136 + s0) = pack8(a[0], a[1], a[2], a[3], a[4], a[5], a[6], a[7]);
        *(LAS bf16x8*)(XT + (2 * cp + 1) * 136 + s0) = pack8(bq[0], bq[1], bq[2], bq[3], bq[4], bq[5], bq[6], bq[7]); }
}
__device__ __forceinline__ void e1_states_mfma(Frame& F, int j) {
    const bf16* XBC = (const bf16*)(F.ws + WS_R3); float* ST = (float*)(F.ws + WS_R4); float* DEC = (float*)(F.ws + WS_DEC);
    LAS bf16* XT = (LAS bf16*)F.lds; LAS bf16* BT = (LAS bf16*)(F.lds + 69632);
    LAS float* DT = (LAS float*)(F.lds + 98304); LAS float* ACS = DT + 512; LAS float* WGT = DT + 1024;
    for (int u = F.vcu; u < 512; u += F.G) {
        const int b = u >> 6, c = (u >> 2) & 15, g = u & 3, t0 = b * SEQ + c * 128;
        __syncthreads();
        ssd_gates4(F, j, t0, g, DT, ACS);
        { const int np = F.tid & 31, l0 = 8 * (F.tid >> 5); float a[8], bq[8];
#pragma unroll
            for (int k = 0; k < 8; ++k) { const unsigned w = *(const unsigned*)(XBC + (size_t)(t0 + l0 + k) * 1536 + 1024 + g * 64 + 2 * np); a[k] = bflo(w); bq[k] = bfhi(w); }
            *(LAS bf16x8*)(BT + (2 * np) * 136 + l0) = pack8(a[0], a[1], a[2], a[3], a[4], a[5], a[6], a[7]);
            *(LAS bf16x8*)(BT + (2 * np + 1) * 136 + l0) = pack8(bq[0], bq[1], bq[2], bq[3], bq[4], bq[5], bq[6], bq[7]); }
        __syncthreads();
        { const int hl = F.tid >> 7, l = F.tid & 127; WGT[F.tid] = expf(ACS[hl * 128 + 127] - ACS[F.tid]) * DT[F.tid]; if (l == 127) DEC[(b * 16 + c) * 16 + 4 * g + hl] = expf(ACS[F.tid]); }
        __syncthreads();
        ssd_stage_xt(F, XBC, t0, g, XT, WGT);
        __syncthreads();
        const int hl = F.wave >> 1, nt = F.wave & 1, li = F.lane & 31, hh = F.lane >> 5;
        f32x16 acc0 = zero16(), acc1 = zero16();
        const LAS bf16* ar0 = XT + (hl * 64 + li) * 136; const LAS bf16* ar1 = ar0 + 32 * 136; const LAS bf16* br = BT + (32 * nt + li) * 136;
#pragma unroll
        for (int ks = 0; ks < 8; ++ks) { const bf16x8 bf = lds_nat(br, ks, hh); acc0 = MFMA32(lds_nat(ar0, ks, hh), bf, acc0); acc1 = MFMA32(lds_nat(ar1, ks, hh), bf, acc1); }
        float* dst = ST + (size_t)((b * 16 + c) * 16 + 4 * g + hl) * 4096 + 32 * nt + li;
#pragma unroll
        for (int r = 0; r < 16; ++r) { dst[crow(r, hh) * 64] = acc0[r]; dst[(32 + crow(r, hh)) * 64] = acc1[r]; }
    }
}
__device__ __forceinline__ void e3_output_mfma(Frame& F, int j) {
    const bf16* XBC = (const bf16*)(F.ws + WS_R3); const float* ST = (const float*)(F.ws + WS_R4); float* Y = (float*)(F.ws + WS_R2);
    LAS bf16* CR = (LAS bf16*)F.lds; LAS bf16* BR = (LAS bf16*)(F.lds + 18432); LAS bf16* XT = (LAS bf16*)(F.lds + 36864);
    LAS float* DT = (LAS float*)(F.lds + 106496); LAS float* ACS = DT + 512;
    for (int u = F.vcu; u < 512; u += F.G) {
        const int b = u >> 6, c = (u >> 2) & 15, g = u & 3, t0 = b * SEQ + c * 128;
        __syncthreads();
        ssd_gates4(F, j, t0, g, DT, ACS);
        for (int i = F.tid; i < 1024; i += 512) { const int l = i >> 3, ch = i & 7; const bf16* src = XBC + (size_t)(t0 + l) * 1536 + 1024 + g * 64 + 8 * ch;
            *(LAS v4u*)(BR + l * 72 + 8 * ch) = *(const v4u*)src; *(LAS v4u*)(CR + l * 72 + 8 * ch) = *(const v4u*)(src + 256); }
        __syncthreads();
        ssd_stage_xt(F, XBC, t0, g, XT, DT);
        __syncthreads();
        const int hl = F.wave >> 1, half = F.wave & 1, li = F.lane & 31, hh = F.lane >> 5, habs = 4 * g + hl;
        const LAS float* acs = ACS + hl * 128; const LAS float* dtl = DT + hl * 128;
        bf16x8 hp[2][4];
        { const float* hsrc = ST + (size_t)((b * 16 + c) * 16 + habs) * 4096;
#pragma unroll
            for (int pt = 0; pt < 2; ++pt)
#pragma unroll
                for (int ks = 0; ks < 4; ++ks) hp[pt][ks] = ldg8_f32(hsrc + (32 * pt + li) * 64 + 16 * ks + 8 * hh); }
        const float dsk = KIN(I_DSKIP)[j * 16 + habs];
#pragma unroll
        for (int q = 0; q < 2; ++q) { const int lt = half ? 1 + q : 3 * q;
            f32x16 acc[2]; acc[0] = zero16(); acc[1] = zero16();
            const LAS bf16* crl = CR + (32 * lt + li) * 72;
#pragma unroll
            for (int ks = 0; ks < 4; ++ks) { const bf16x8 cf = lds_nat(crl, ks, hh); acc[0] = MFMA32(cf, hp[0][ks], acc[0]); acc[1] = MFMA32(cf, hp[1][ks], acc[1]); }
#pragma unroll
            for (int a4 = 0; a4 < 4; ++a4) { const f32x4 av = *(const LAS f32x4*)(acs + 32 * lt + 8 * a4 + 4 * hh);
#pragma unroll
                for (int i = 0; i < 4; ++i) { const float e = expf(av[i]); acc[0][4 * a4 + i] *= e; acc[1][4 * a4 + i] *= e; } }
            const float acl = acs[32 * lt + li];
            for (int st = 0; st <= lt; ++st) {
                f32x16 gt = zero16(); const LAS bf16* brs = BR + (32 * st + li) * 72;
#pragma unroll
                for (int ks = 0; ks < 4; ++ks) gt = MFMA32(lds_nat(brs, ks, hh), lds_nat(crl, ks, hh), gt);
#pragma unroll
                for (int a4 = 0; a4 < 4; ++a4) { const f32x4 av = *(const LAS f32x4*)(acs + 32 * st + 8 * a4 + 4 * hh);
#pragma unroll
                    for (int i = 0; i < 4; ++i) { const int r = 4 * a4 + i; const float e = expf(acl - av[i]); gt[r] = (st < lt || crow(r, hh) <= li) ? gt[r] * e : 0.f; } }
                const bf16x8 g0 = pack_step(gt, 0), g1 = pack_step(gt, 1);
#pragma unroll
                for (int pt = 0; pt < 2; ++pt) { const LAS bf16* xr = XT + (hl * 64 + 32 * pt + li) * 136 + 32 * st;
                    acc[pt] = MFMA32(g0, lds_krow(xr, 0, hh), acc[pt]); acc[pt] = MFMA32(g1, lds_krow(xr, 16, hh), acc[pt]); } }
#pragma unroll
            for (int pt = 0; pt < 2; ++pt) { const LAS bf16* xr = XT + (hl * 64 + 32 * pt + li) * 136 + 32 * lt; float* yp = Y + (size_t)(t0 + 32 * lt) * D + habs * 64 + 32 * pt + li;
#pragma unroll
                for (int r = 0; r < 16; ++r) { const int l = crow(r, hh); yp[(size_t)l * D] = acc[pt][r] + dsk * bf2f(xr[l]) / dtl[32 * lt + l]; } }
        }
    }
}
__device__ __forceinline__ void mlstm_stage_t(Frame& F, const bf16* P, int t0, int col0, LAS bf16* DST, const LAS float* wk) {
    const int vp = F.tid & 63, s0 = 8 * (F.tid >> 6); float a[8], bq[8];
#pragma unroll
    for (int k = 0; k < 8; ++k) { const unsigned w = *(const unsigned*)(P + (size_t)(t0 + s0 + k) * NPO + col0 + 2 * vp); const float wg = wk ? wk[s0 + k] : 1.f; a[k] = bflo(w) * wg; bq[k] = bfhi(w) * wg; }
    *(LAS bf16x8*)(DST + (2 * vp) * 72 + s0) = pack8(a[0], a[1], a[2], a[3], a[4], a[5], a[6], a[7]);
    *(LAS bf16x8*)(DST + (2 * vp + 1) * 72 + s0) = pack8(bq[0], bq[1], bq[2], bq[3], bq[4], bq[5], bq[6], bq[7]);
}
__device__ __forceinline__ void o1_local_mfma(Frame& F, int j) {
    const bf16* P = (const bf16*)(F.ws + WS_R1); float* KLOC = (float*)(F.ws + WS_R2); float* NLOC = (float*)(F.ws + WS_NLOC); float* MLOC = (float*)(F.ws + WS_MLOC); float* BLAST = (float*)(F.ws + WS_BLAST);
    LAS bf16* VT = (LAS bf16*)F.lds; LAS bf16* KWT = (LAS bf16*)(F.lds + 18432); LAS float* wk = (LAS float*)(F.lds + SMALL_OFF);
    for (int u = F.vcu; u < 1024; u += F.G) {
        const int b = u >> 7, h = (u >> 5) & 3, c = u & 31, t0 = b * SEQ + c * 64;
        __syncthreads();
        if (F.wave == 0) { float bcum, ib; mlstm_gates(F, j, t0, h, bcum, ib); const float blast = __shfl(bcum, 63); const float gl = blast - bcum + ib; const float ml = wave_max(gl);
            wk[F.lane] = expf(gl - ml); if (F.lane == 0) { MLOC[u] = ml; BLAST[u] = blast; } }
        mlstm_stage_t(F, P, t0, 1024 + h * 128, VT, nullptr);
        __syncthreads();
        mlstm_stage_t(F, P, t0, 512 + h * 128, KWT, wk);
        __syncthreads();
        const int vt = F.wave >> 1, dh = F.wave & 1, li = F.lane & 31, hh = F.lane >> 5;
        f32x16 acc0 = zero16(), acc1 = zero16();
        const LAS bf16* ar = VT + (32 * vt + li) * 72; const LAS bf16* b0 = KWT + (64 * dh + li) * 72; const LAS bf16* b1 = b0 + 32 * 72;
#pragma unroll
        for (int ks = 0; ks < 4; ++ks) { const bf16x8 af = lds_nat(ar, ks, hh); acc0 = MFMA32(af, lds_nat(b0, ks, hh), acc0); acc1 = MFMA32(af, lds_nat(b1, ks, hh), acc1); }
        float* dst = KLOC + (size_t)u * 16384 + (size_t)(32 * vt) * 128 + 64 * dh + li;
#pragma unroll
        for (int r = 0; r < 16; ++r) { dst[crow(r, hh) * 128] = acc0[r]; dst[crow(r, hh) * 128 + 32] = acc1[r]; }
        if (F.tid < 128) { float a = 0.f; const LAS bf16* kr = KWT + F.tid * 72;
#pragma unroll
            for (int s8 = 0; s8 < 8; ++s8) { const v4u w = *(const LAS v4u*)(kr + 8 * s8); a += (bflo(w.x) + bfhi(w.x)) + (bflo(w.y) + bfhi(w.y)) + (bflo(w.z) + bfhi(w.z)) + (bflo(w.w) + bfhi(w.w)); }
            NLOC[(size_t)u * 128 + F.tid] = a; }
    }
}
__device__ __forceinline__ void o3_output_mfma(Frame& F, int j) {
    const bf16* P = (const bf16*)(F.ws + WS_R1); const float* CPREV = (const float*)(F.ws + WS_R2); const float* NPREV = (const float*)(F.ws + WS_NLOC); const float* MPREV = (const float*)(F.ws + WS_MPREV); bf16* MIX = (bf16*)(F.ws + WS_MIX);
    LAS bf16* QR = (LAS bf16*)F.lds;
    LAS bf16* KR = (LAS bf16*)(F.lds + 17408);
    LAS bf16* VT = (LAS bf16*)(F.lds + 34816);
    LAS float* OST = (LAS float*)(F.lds + 53248);
    LAS float* sm = (LAS float*)(F.lds + 98304);
    for (int u = F.vcu; u < 1024; u += F.G) {
        const int b = u >> 7, h = (u >> 5) & 3, c = u & 31, t0 = b * SEQ + c * 64;
        __syncthreads();
        if (F.wave == 0) { float bcum, ib; mlstm_gates(F, j, t0, h, bcum, ib); const float mprev = MPREV[u];
            const float pm = wave_scan_max(ib - bcum, F.lane); const float inter = bcum + mprev; const float mt = fmaxf(bcum + pm, inter);
            sm[F.lane] = bcum; sm[64 + F.lane] = ib; sm[128 + F.lane] = mt; sm[192 + F.lane] = expf(inter - mt); }
        for (int i = F.tid; i < 1024; i += 512) { const int l = i >> 4, ch = i & 15; const bf16* src = P + (size_t)(t0 + l) * NPO + h * 128 + 8 * ch;
            *(LAS v4u*)(QR + l * 136 + 8 * ch) = *(const v4u*)src; *(LAS v4u*)(KR + l * 136 + 8 * ch) = *(const v4u*)(src + 512); }
        mlstm_stage_t(F, P, t0, 1024 + h * 128, VT, nullptr);
        __syncthreads();
        if (F.wave == 1) { const int l = F.lane; const float* np = NPREV + (size_t)u * 128; float qn = 0.f;
#pragma unroll 4
            for (int d8 = 0; d8 < 16; ++d8) { const v4u w = *(const LAS v4u*)(QR + l * 136 + 8 * d8); const f32x4 n0 = *(const f32x4*)(np + 8 * d8), n1 = *(const f32x4*)(np + 8 * d8 + 4);
                qn += (bflo(w.x) * n0[0] + bfhi(w.x) * n0[1]) + (bflo(w.y) * n0[2] + bfhi(w.y) * n0[3]) + (bflo(w.z) * n1[0] + bfhi(w.z) * n1[1]) + (bflo(w.w) * n1[2] + bfhi(w.w) * n1[3]); }
            sm[256 + l] = qn; }
        const int lt = F.wave >> 2, vt = F.wave & 3, li = F.lane & 31, hh = F.lane >> 5, l = 32 * lt + li;
        const float bcl = sm[l], mtl = sm[128 + l], sil = sm[192 + l];
        f32x16 acc = zero16();
        const LAS bf16* qrl = QR + l * 136;
        { const float* cp = CPREV + (size_t)u * 16384 + (size_t)(32 * vt + li) * 128;
#pragma unroll
            for (int ks = 0; ks < 8; ++ks) acc = MFMA32(ldg8_f32(cp + 16 * ks + 8 * hh), lds_nat(qrl, ks, hh), acc); }
#pragma unroll
        for (int r = 0; r < 16; ++r) acc[r] *= sil;
        float dsum = 0.f;
        for (int st = 0; st <= lt; ++st) {
            f32x16 wt = zero16(); const LAS bf16* krs = KR + (32 * st + li) * 136;
#pragma unroll
            for (int ks = 0; ks < 8; ++ks) wt = MFMA32(lds_nat(krs, ks, hh), lds_nat(qrl, ks, hh), wt);
#pragma unroll
            for (int a4 = 0; a4 < 4; ++a4) { const f32x4 bs = *(const LAS f32x4*)(sm + 32 * st + 8 * a4 + 4 * hh), is = *(const LAS f32x4*)(sm + 64 + 32 * st + 8 * a4 + 4 * hh);
#pragma unroll
                for (int i = 0; i < 4; ++i) { const int r = 4 * a4 + i; const float e = expf(bcl - bs[i] + is[i] - mtl); const float w = (st < lt || crow(r, hh) <= li) ? wt[r] * e : 0.f; wt[r] = w; dsum += w; } }
            const bf16x8 w0 = pack_step(wt, 0), w1 = pack_step(wt, 1); const LAS bf16* vr = VT + (32 * vt + li) * 72 + 32 * st;
            acc = MFMA32(lds_krow(vr, 0, hh), w0, acc); acc = MFMA32(lds_krow(vr, 16, hh), w1, acc); }
        __syncthreads();
        dsum += __shfl_xor(dsum, 32);
        const float den = dsum + sil * sm[256 + l]; const float rinv = 1.0f / fmaxf(fabsf(den), expf(-mtl));
        float s1 = 0.f, s2 = 0.f;
#pragma unroll
        for (int r = 0; r < 16; ++r) { acc[r] *= rinv; s1 += acc[r]; s2 += acc[r] * acc[r]; }
        s1 += __shfl_xor(s1, 32); s2 += __shfl_xor(s2, 32);
        if (hh == 0) { sm[320 + (vt * 64 + l) * 2] = s1; sm[320 + (vt * 64 + l) * 2 + 1] = s2; }
        __syncthreads();
        { float t1 = 0.f, t2 = 0.f;
#pragma unroll
            for (int q = 0; q < 4; ++q) { t1 += sm[320 + (q * 64 + l) * 2]; t2 += sm[320 + (q * 64 + l) * 2 + 1]; }
            const float mu = t1 * (1.f / 128.f), var = fmaxf(t2 * (1.f / 128.f) - mu * mu, 0.f), rstd = 1.0f / sqrtf(var + LN_EPS);
#pragma unroll
            for (int r = 0; r < 16; ++r) OST[l * 132 + 32 * vt + crow(r, hh)] = (acc[r] - mu) * rstd; }
        __syncthreads();
        for (int i = F.tid; i < 1024; i += 512) { const int ll = i >> 4, ch = i & 15; const LAS float* os = OST + ll * 132 + 8 * ch; const f32x4 o0 = *(const LAS f32x4*)os, o1 = *(const LAS f32x4*)(os + 4);
            const v4u ow = *(const v4u*)(P + (size_t)(t0 + ll) * NPO + 1536 + h * 128 + 8 * ch); const float* hw = KIN(I_HNW) + j * 512 + h * 128 + 8 * ch; const f32x4 h0 = *(const f32x4*)hw, h1 = *(const f32x4*)(hw + 4);
            v4u res; res.x = pk2(o0[0] * h0[0] * sigmoid_f(bflo(ow.x)), o0[1] * h0[1] * sigmoid_f(bfhi(ow.x))); res.y = pk2(o0[2] * h0[2] * sigmoid_f(bflo(ow.y)), o0[3] * h0[3] * sigmoid_f(bfhi(ow.y)));
            res.z = pk2(o1[0] * h1[0] * sigmoid_f(bflo(ow.z)), o1[1] * h1[1] * sigmoid_f(bfhi(ow.z))); res.w = pk2(o1[2] * h1[2] * sigmoid_f(bflo(ow.w)), o1[3] * h1[3] * sigmoid_f(bfhi(ow.w)));
            *(v4u*)(MIX + (size_t)(t0 + ll) * D + h * 128 + 8 * ch) = res; }
    }
}
__device__ __forceinline__ void p_ln1_route(Frame& F, int layer, const float* hin) {
    const float* OUTP = (const float*)(F.ws + WS_R1); float* H1F = (float*)(F.ws + WS_H1F); bf16* H1B = (bf16*)(F.ws + WS_H1B);
    i32x4* ROUTE = (i32x4*)(F.ws + WS_ROUTE); f32x2* GATE = (f32x2*)(F.ws + WS_GATE); int* BCNT = (int*)(F.ws + WS_BCNT);
    LAS int* cnt = (LAS int*)(F.lds + SMALL_OFF);
    const float* g1 = KIN(I_LN1G) + (size_t)layer * D; const float* b1 = KIN(I_LN1B) + (size_t)layer * D;
    const float* rgw = KIN(I_RGW) + (size_t)layer * D * 4; const float* rgb = KIN(I_RGB) + layer * 4; const float* rew = KIN(I_REW) + (size_t)layer * 4 * D * 8; const float* reb = KIN(I_REB) + layer * 32;
    __syncthreads();
    if (F.tid < 32) cnt[F.tid] = 0;
    __syncthreads();
    for (int m = F.gw; m < T; m += F.NGW) {
        f32x4 v[4], a[4]; row_load(hin + (size_t)m * D, F.lane, v); row_load(OUTP + (size_t)m * D, F.lane, a);
#pragma unroll
        for (int jj = 0; jj < 4; ++jj) v[jj] = v[jj] * ALPHA + a[jj];
        row_layernorm(v, g1, b1, F.lane);
        row_store_f32(H1F + (size_t)m * D, F.lane, v); row_store_bf16(H1B + (size_t)m * D, F.lane, v);
        float gl[4] = {0.f, 0.f, 0.f, 0.f};
#pragma unroll
        for (int jj = 0; jj < 4; ++jj)
#pragma unroll
            for (int i = 0; i < 4; ++i) { const f32x4 w = *(const f32x4*)(rgw + (size_t)(256 * jj + 4 * F.lane + i) * 4);
#pragma unroll
                for (int c = 0; c < 4; ++c) gl[c] += v[jj][i] * w[c]; }
#pragma unroll
        for (int c = 0; c < 4; ++c) gl[c] = wave_sum(gl[c]) + rgb[c];
        int gi = 0; float gm = gl[0];
#pragma unroll
        for (int c = 1; c < 4; ++c) if (gl[c] > gm) { gm = gl[c]; gi = c; }
        float se = 0.f;
#pragma unroll
        for (int c = 0; c < 4; ++c) se += expf(gl[c] - gm);
        const float pg = 1.0f / se;
        const float* rw = rew + (size_t)gi * D * 8; float el[8];
#pragma unroll
        for (int c = 0; c < 8; ++c) el[c] = 0.f;
#pragma unroll
        for (int jj = 0; jj < 4; ++jj)
#pragma unroll
            for (int i = 0; i < 4; ++i) { const float* wr = rw + (size_t)(256 * jj + 4 * F.lane + i) * 8; const f32x4 w0 = *(const f32x4*)wr, w1 = *(const f32x4*)(wr + 4);
#pragma unroll
                for (int c = 0; c < 4; ++c) { el[c] += v[jj][i] * w0[c]; el[4 + c] += v[jj][i] * w1[c]; } }
#pragma unroll
        for (int c = 0; c < 8; ++c) el[c] = wave_sum(el[c]) + reb[gi * 8 + c];
        int i0 = 0; float v0 = el[0];
#pragma unroll
        for (int c = 1; c < 8; ++c) if (el[c] > v0) { v0 = el[c]; i0 = c; }
        int i1 = -1; float v1 = -INFINITY;
#pragma unroll
        for (int c = 0; c < 8; ++c) if (c != i0 && el[c] > v1) { v1 = el[c]; i1 = c; }
        if (i1 < 0) i1 = (i0 + 1) & 7;
        const float ee = expf(v1 - v0), g0 = pg / (1.0f + ee), g1v = pg * ee / (1.0f + ee);
        if (F.lane == 0) { const int e0 = gi * 8 + i0, e1 = gi * 8 + i1;
            const int r0 = __hip_atomic_fetch_add(cnt + e0, 1, __ATOMIC_RELAXED, __HIP_MEMORY_SCOPE_WORKGROUP), r1 = __hip_atomic_fetch_add(cnt + e1, 1, __ATOMIC_RELAXED, __HIP_MEMORY_SCOPE_WORKGROUP);
            ROUTE[m] = (i32x4){e0, r0, e1, r1}; GATE[m] = (f32x2){g0, g1v}; }
    }
    __syncthreads();
    if (F.tid < 32) BCNT[F.vcu * 32 + F.tid] = cnt[F.tid];
}
__device__ __forceinline__ void p_scatter(Frame& F) {
    const int* BCNT = (const int*)(F.ws + WS_BCNT); int* PANEL = (int*)(F.ws + WS_PANEL); const i32x4* ROUTE = (const i32x4*)(F.ws + WS_ROUTE); i32x2* POS = (i32x2*)(F.ws + WS_POS);
    const bf16* H1B = (const bf16*)(F.ws + WS_H1B); bf16* XS = (bf16*)(F.ws + WS_R1);
    LAS int* pa = (LAS int*)(F.lds + SMALL_OFF); LAS int* pb = pa + 512; LAS int* tot = pa + 1024; LAS int* bef = pa + 1056; LAS int* base = pa + 1088;
    __syncthreads();
    { const int e = F.tid & 31, part = F.tid >> 5; int sa = 0, sb = 0;
        for (int b = part; b < F.G; b += 16) { const int c = BCNT[b * 32 + e]; sa += c; if (b < F.vcu) sb += c; }
        pa[part * 32 + e] = sa; pb[part * 32 + e] = sb; }
    __syncthreads();
    if (F.tid < 32) { int sa = 0, sb = 0; for (int p = 0; p < 16; ++p) { sa += pa[p * 32 + F.tid]; sb += pb[p * 32 + F.tid]; } tot[F.tid] = sa; bef[F.tid] = sb; }
    __syncthreads();
    if (F.tid == 0) { int off = 0, np = 0;
        for (int e = 0; e < 32; ++e) { const int npan = (tot[e] + 255) >> 8; base[e] = off + bef[e];
            if (F.vcu == 0) for (int p = 0; p < npan; ++p) PANEL[1 + np + p] = e;
            np += npan; off += npan * 256; }
        if (F.vcu == 0) PANEL[0] = np; }
    __syncthreads();
    for (int m = F.gw; m < T; m += F.NGW) { const i32x4 r = ROUTE[m]; const int p0 = base[r.x] + r.y, p1 = base[r.z] + r.w;
        if (F.lane == 0) POS[m] = (i32x2){p0, p1};
        const v4u* src = (const v4u*)(H1B + (size_t)m * D); v4u* d0 = (v4u*)(XS + (size_t)p0 * D); v4u* d1 = (v4u*)(XS + (size_t)p1 * D);
#pragma unroll
        for (int jj = 0; jj < 2; ++jj) { const v4u w = src[F.lane + 64 * jj]; d0[F.lane + 64 * jj] = w; d1[F.lane + 64 * jj] = w; } }
}
__device__ __forceinline__ void p_combine(Frame& F, int layer) {
    const float* H1F = (const float*)(F.ws + WS_H1F); const bf16* EOUT = (const bf16*)(F.ws + WS_R1); const i32x2* POS = (const i32x2*)(F.ws + WS_POS); const f32x2* GATE = (const f32x2*)(F.ws + WS_GATE);
    float* HF = (float*)(F.ws + WS_HF); bf16* HB = (bf16*)(F.ws + WS_HB);
    const float* g2 = KIN(I_LN2G) + (size_t)layer * D; const float* b2 = KIN(I_LN2B) + (size_t)layer * D;
    for (int m = F.gw; m < T; m += F.NGW) { const i32x2 ps = POS[m]; const f32x2 gt = GATE[m];
        f32x4 v[4], ea[4], eb[4]; row_load(H1F + (size_t)m * D, F.lane, v); row_load_bf16(EOUT + (size_t)ps.x * D, F.lane, ea); row_load_bf16(EOUT + (size_t)ps.y * D, F.lane, eb);
#pragma unroll
        for (int jj = 0; jj < 4; ++jj) v[jj] = v[jj] * ALPHA + (ea[jj] * gt.x + eb[jj] * gt.y);
        row_layernorm(v, g2, b2, F.lane);
        if (layer == DEPTH - 1) row_store_f32(F.out + (size_t)m * D, F.lane, v);
        else { row_store_f32(HF + (size_t)m * D, F.lane, v); row_store_bf16(HB + (size_t)m * D, F.lane, v); row_gate_proj(F, v, layer + 1, m); } }
}
#ifndef PHASE_MASK
#define PHASE_MASK 0x1fff
#endif
#define PH_EN(k) (((PHASE_MASK) >> (k)) & 1)
#ifndef PROBE_DUP
#define PROBE_DUP 0
#endif
#define NREP(k) (1 + (((PROBE_DUP) >> (k)) & 1))
#define IN(k) (lo <= (k) && (k) < hi)
#define SEAM(k) do { if ((k) + 1 < hi) xcd_barrier(bar); } while (0)
template <int LAYER> __device__ __forceinline__ void layer_body(Frame& F, const int lo, const int hi, const XcdBarrier& bar) {
        constexpr int layer = LAYER, pb = 1 + LAYER * NPH_LAYER, j = LAYER >> 1; constexpr bool odd = (LAYER & 1) != 0;
        bf16* HB = (bf16*)(F.ws + WS_HB); bf16* MIX = (bf16*)(F.ws + WS_MIX);
        const float* hin = layer == 0 ? KIN(I_X) : (const float*)(F.ws + WS_HF);
        if constexpr (PH_EN(0)) if (IN(pb + 0)) _Pragma("unroll") for (int rep_ = 0; rep_ < NREP(0); ++rep_) { if (rep_) __syncthreads();
            const int N = odd ? NPO : NPE; const bf16* Bt = odd ? (const bf16*)(F.ws + WS_WINO) + (size_t)j * NPO * D : (const bf16*)(F.ws + WS_WINE) + (size_t)j * NPE * D;
            pg8::Gemm g{HB, Bt, T, N, D, 0}; pg8::StaticOrder S; S.init(T, N, F.G, (int)blockIdx.x);
            pg8::EpiStoreBf16 E{(bf16*)(F.ws + WS_R1), N};
            pg8::gemm_phase<pg8::EpiStoreBf16, pg8::StaticOrder, true, true>(F.lds, g, S, E);
            if (rep_ == NREP(0) - 1) SEAM(pb + 0); }
        if constexpr (!odd) {
            if constexpr (PH_EN(1)) if (IN(pb + 1)) _Pragma("unroll") for (int rep_ = 0; rep_ < NREP(1); ++rep_) { if (rep_) __syncthreads(); e0_conv(F, j); if (rep_ == NREP(1) - 1) SEAM(pb + 1); }
            if constexpr (PH_EN(2)) if (IN(pb + 2)) _Pragma("unroll") for (int rep_ = 0; rep_ < NREP(2); ++rep_) { if (rep_) __syncthreads(); if constexpr (SSD_NAIVE) e1_states(F, j); else e1_states_mfma(F, j); if (rep_ == NREP(2) - 1) SEAM(pb + 2); }
            if constexpr (PH_EN(3)) if (IN(pb + 3)) _Pragma("unroll") for (int rep_ = 0; rep_ < NREP(3); ++rep_) { if (rep_) __syncthreads(); e2_scan(F); if (rep_ == NREP(3) - 1) SEAM(pb + 3); }
            if constexpr (PH_EN(4)) if (IN(pb + 4)) _Pragma("unroll") for (int rep_ = 0; rep_ < NREP(4); ++rep_) { if (rep_) __syncthreads(); if constexpr (SSD_NAIVE) e3_output(F, j); else e3_output_mfma(F, j); if (rep_ == NREP(4) - 1) SEAM(pb + 4); }
            if constexpr (PH_EN(5)) if (IN(pb + 5)) _Pragma("unroll") for (int rep_ = 0; rep_ < NREP(5); ++rep_) { if (rep_) __syncthreads(); e4_gnorm(F); if (rep_ == NREP(5) - 1) SEAM(pb + 5); }
        } else {
            if constexpr (PH_EN(1)) if (IN(pb + 1)) _Pragma("unroll") for (int rep_ = 0; rep_ < NREP(1); ++rep_) { if (rep_) __syncthreads(); o_foxscan(F, j); if constexpr (MLSTM_NAIVE) o1_local(F, j); else o1_local_mfma(F, j); if (rep_ == NREP(1) - 1) SEAM(pb + 1); }
            if constexpr (PH_EN(2)) if (IN(pb + 2)) _Pragma("unroll") for (int rep_ = 0; rep_ < NREP(2); ++rep_) { if (rep_) __syncthreads(); o2_scan(F); if (rep_ == NREP(2) - 1) SEAM(pb + 2); }
            if constexpr (PH_EN(3)) if (IN(pb + 3)) _Pragma("unroll") for (int rep_ = 0; rep_ < NREP(3); ++rep_) { if (rep_) __syncthreads(); if constexpr (MLSTM_NAIVE) o3_output(F, j); else o3_output_mfma(F, j); if (rep_ == NREP(3) - 1) SEAM(pb + 3); }
            if constexpr (PH_EN(4)) if (IN(pb + 4)) _Pragma("unroll") for (int rep_ = 0; rep_ < NREP(4); ++rep_) { if (rep_) __syncthreads();
#if FOX_NAIVE
                o4_fox(F);
#else
                const attn_body::bf16* PR = (const attn_body::bf16*)(F.ws + WS_R1);
                const attn_body::AttnTensors AT{PR + 2048, PR + 2560, PR + 3072, (attn_body::bf16*)(F.ws + WS_MIX) + 512, (const float*)(F.ws + WS_FOXC)};
                const attn_body::StaticOrder S((int)F.G, F.vcu);
                attn_body::attn_phase<attn_body::StaticOrder>((char*)F.lds, AT, S);
#endif
                if (rep_ == NREP(4) - 1) SEAM(pb + 4); }
            if constexpr (PH_EN(5)) if (IN(pb + 5)) _Pragma("unroll") for (int rep_ = 0; rep_ < NREP(5); ++rep_) { if (rep_) __syncthreads(); if (rep_ == NREP(5) - 1) SEAM(pb + 5); }
        }
        if constexpr (PH_EN(6)) if (IN(pb + 6)) _Pragma("unroll") for (int rep_ = 0; rep_ < NREP(6); ++rep_) { if (rep_) __syncthreads();
            const int K = odd ? D : 1536; const bf16* Bt = odd ? (const bf16*)(F.ws + WS_WOUTO) + (size_t)j * D * D : (const bf16*)(F.ws + WS_WOUTE) + (size_t)j * D * 1536;
            pg8::Gemm g{MIX, Bt, T, D, K, 0}; pg8::StaticOrder S; S.init(T, D, F.G, (int)blockIdx.x);
            pg8::EpiStoreF32 E{(float*)(F.ws + WS_R1), D};
            pg8::gemm_phase<pg8::EpiStoreF32, pg8::StaticOrder, false, true>(F.lds, g, S, E);
            if (rep_ == NREP(6) - 1) SEAM(pb + 6); }
        if constexpr (PH_EN(7)) if (IN(pb + 7)) _Pragma("unroll") for (int rep_ = 0; rep_ < NREP(7); ++rep_) { if (rep_) __syncthreads(); p_ln1_route(F, layer, hin); if (rep_ == NREP(7) - 1) SEAM(pb + 7); }
        if constexpr (PH_EN(8)) if (IN(pb + 8)) _Pragma("unroll") for (int rep_ = 0; rep_ < NREP(8); ++rep_) { if (rep_) __syncthreads(); p_scatter(F); if (rep_ == NREP(8) - 1) SEAM(pb + 8); }
        if constexpr (PH_EN(9)) if (IN(pb + 9)) _Pragma("unroll") for (int rep_ = 0; rep_ < NREP(9); ++rep_) { if (rep_) __syncthreads();
            pg8::Gemm g{(const bf16*)(F.ws + WS_R1), (const bf16*)(F.ws + WS_WGU) + (size_t)layer * 32 * D * D, RPAD, D, D, (size_t)D * D * 2};
            pg8::MoeOrder S; S.initm((const int*)(F.ws + WS_PANEL), 4, F.G, (int)blockIdx.x);
            pg8::EpiSwiglu E{(bf16*)(F.ws + WS_R3), 512};
            pg8::gemm_phase<pg8::EpiSwiglu, pg8::MoeOrder, true, true>(F.lds, g, S, E);
            if (rep_ == NREP(9) - 1) SEAM(pb + 9); }
        if constexpr (PH_EN(10)) if (IN(pb + 10)) _Pragma("unroll") for (int rep_ = 0; rep_ < NREP(10); ++rep_) { if (rep_) __syncthreads();
            pg8::Gemm g{(const bf16*)(F.ws + WS_R3), (const bf16*)(F.ws + WS_WD) + (size_t)layer * 32 * D * 512, RPAD, D, 512, (size_t)D * 512 * 2};
            pg8::MoeOrder S; S.initm((const int*)(F.ws + WS_PANEL), 4, F.G, (int)blockIdx.x);
            pg8::EpiStoreBf16 E{(bf16*)(F.ws + WS_R1), D};
            pg8::gemm_phase<pg8::EpiStoreBf16, pg8::MoeOrder, true, true>(F.lds, g, S, E);
            if (rep_ == NREP(10) - 1) SEAM(pb + 10); }
        if constexpr (PH_EN(11)) if (IN(pb + 11)) _Pragma("unroll") for (int rep_ = 0; rep_ < NREP(11); ++rep_) { if (rep_) __syncthreads(); p_combine(F, layer); if (rep_ == NREP(11) - 1) SEAM(pb + 11); }
}
struct Args { const float* in[27]; float* out; unsigned char* ws; int ph_lo, ph_hi; };
__global__ void __launch_bounds__(NWAVES * 64, 2) fwd_kernel(Args args) {
    extern __shared__ __attribute__((aligned(16))) unsigned char lds[];
    Frame F;
    F.lds = (LAS unsigned char*)lds;
    F.MISC = (volatile LAS unsigned*)(F.lds + MISC_OFF);
    F.tid = threadIdx.x; F.lane = F.tid & 63; F.wave = __builtin_amdgcn_readfirstlane(F.tid >> 6);
    F.G = gridDim.x; { const int bx = blockIdx.x; F.vcu = (F.G % 8 == 0) ? (bx % 8) * (F.G / 8) + bx / 8 : bx; }
    F.gw = F.vcu * NWAVES + F.wave; F.NGW = F.G * NWAVES;
    F.out = args.out; F.ws = args.ws; F.ctl = (unsigned*)(args.ws + WS_CTL);
    const int lo = args.ph_lo, hi = args.ph_hi;
    for (int u = F.tid; u < (LDS_BYTES - MISC_OFF) / 4; u += NWAVES * 64) ((LAS unsigned*)(F.lds + MISC_OFF))[u] = 0u;
    __syncthreads();
    XcdBarrier bar; bar.bar = F.ctl + CW_BAR; bar.x = 0; bar.st = nullptr;
    if (hi - lo > 1) bar = xcd_barrier_post(F.ctl + CW_BAR, F.MISC + 8);
    if constexpr (PH_EN(12)) if (IN(0)) { p_prologue(F); SEAM(0); }
    layer_body<0>(F, lo, hi, bar); layer_body<1>(F, lo, hi, bar); layer_body<2>(F, lo, hi, bar); layer_body<3>(F, lo, hi, bar);
#undef IN
#undef SEAM
}

extern "C" void kernel_launch(void* const* d_in, const int* in_sizes, int n_in, void* d_out, int out_size, void* d_ws, size_t ws_size, hipStream_t stream) {
    static int grid = 0;
    if (grid == 0) {
        if (n_in != 27 || in_sizes[0] != T * D || out_size != T * D || ws_size < WS_END) { fprintf(stderr, "kernel_launch: unexpected shapes (n_in %d, in0 %d, out %d, ws %zu); nothing launched\n", n_in, n_in > 0 ? in_sizes[0] : -1, out_size, ws_size); grid = -1; return; }
        int dev = 0, cus = 0, per_cu = 0;
        if (hipGetDevice(&dev) != hipSuccess || hipDeviceGetAttribute(&cus, hipDeviceAttributeMultiprocessorCount, dev) != hipSuccess) { grid = -1; return; }
        if (hipFuncSetAttribute((const void*)fwd_kernel, hipFuncAttributeMaxDynamicSharedMemorySize, LDS_BYTES) != hipSuccess) { fprintf(stderr, "kernel_launch: hipFuncSetAttribute failed\n"); grid = -1; return; }
        if (hipOccupancyMaxActiveBlocksPerMultiprocessor(&per_cu, (const void*)fwd_kernel, NWAVES * 64, LDS_BYTES) != hipSuccess || per_cu < 1) fprintf(stderr, "kernel_launch: note: occupancy query reports %d workgroups per CU\n", per_cu);
        (void)hipGetLastError();
        grid = cus;
    }
    if (grid < 0) return;
    if (hipMemsetAsync((char*)d_ws + WS_CTL, 0, CTL_ZERO_BYTES, stream) != hipSuccess) return;
    Args a{};
    for (int i = 0; i < 27; ++i) a.in[i] = (const float*)d_in[i];
    a.out = (float*)d_out; a.ws = (unsigned char*)d_ws;
#if MK_ONE_LAUNCH
    a.ph_lo = 0; a.ph_hi = NPHASES;
    hipLaunchKernelGGL(fwd_kernel, dim3(grid), dim3(NWAVES * 64), LDS_BYTES, stream, a);
#else
    for (int ph = 0; ph < NPHASES; ++ph) {
        if (ph > 0 && (((ph - 1) / NPH_LAYER) & 1) && ((ph - 1) % NPH_LAYER) == 5) continue;
        a.ph_lo = ph; a.ph_hi = ph + 1;
        hipLaunchKernelGGL(fwd_kernel, dim3(grid), dim3(NWAVES * 64), LDS_BYTES, stream, a);
    }
#endif
}
```

```cpp
#include <hip/hip_runtime.h>
#include <cstdio>
#include <cstdint>
__device__ __forceinline__ float silu_f(float x) { return x / (1.0f + __expf(-x)); }
namespace pg8 {
#define PG8_LAS __attribute__((address_space(3)))
typedef unsigned short bf16_t;
typedef short bf16x8 __attribute__((ext_vector_type(8)));
typedef float f32x4 __attribute__((ext_vector_type(4)));
typedef unsigned u32x4 __attribute__((ext_vector_type(4)));
constexpr int BM = 256, BK = 64, HALF = 128, HTB = HALF * BK * 2  , STAGE_BYTES = 8 * HTB, NXCD = 8, WGM = 8;

__host__ __device__ __forceinline__ int lds_byte(int r, int c) { const int st = (r >> 4) * 2 + (c >> 5), rr = r & 15, cc = c & 31, ob = rr * 64 + cc * 2; return st * 1024 + (ob ^ (((ob >> 9) & 1) << 5)); }
__host__ __device__ __forceinline__ void stage_rc(int b, int& R, int& C) { const int st = b / 1024, sb = b % 1024, swz = sb ^ (((sb >> 9) & 1) << 5); R = (st >> 1) * 16 + swz / 64; C = (st & 1) * 32 + (swz % 64) / 2; }
__host__ __device__ __forceinline__ int perm32(int rho) { const int n = rho >> 4, i = rho & 15; return 8 * (i >> 2) + 4 * n + (i & 3); }

struct Unit { int pm, pn, be; };
struct Gemm { const bf16_t* A; const bf16_t* Bt; int M, N, K; size_t bstride; };

struct StaticOrder {
    int nM, nN, nwg, G, c;
    __host__ __device__ void init(int M, int N, int G_, int c_) { nM = M / BM; nN = N / BM; nwg = nM * nN; G = G_; c = c_; }
    __host__ __device__ bool next(int i, Unit& u) const {
        const long L = (long)i * G + c; if (L >= nwg) return false;
        int wgid = (int)L; { const int q = nwg / NXCD, r = nwg % NXCD, xcd = wgid % NXCD, off = wgid / NXCD; wgid = (xcd < r ? xcd * (q + 1) : r * (q + 1) + (xcd - r) * q) + off; }
        const int nig = WGM * nN, gid = wgid / nig, fm = gid * WGM, gsz = (nM - fm) < WGM ? (nM - fm) : WGM;
        u.pm = fm + ((wgid % nig) % gsz); u.pn = (wgid % nig) / gsz; u.be = 0; return true;
    }
    __device__ __forceinline__ void a_ready(const Unit&) const {}
    __device__ __forceinline__ void done(const Unit&) const {}
};

__device__ __forceinline__ unsigned cvt_pk_bf16(float lo, float hi) { unsigned r; asm volatile("v_cvt_pk_bf16_f32 %0, %1, %2" : "=v"(r) : "v"(lo), "v"(hi)); return r; }
struct EpiStoreBf16 {
    static constexpr bool PERM = true, AFTER_DRAIN = false;
    bf16_t* O; int ldc;
    __device__ __forceinline__ void operator()(const f32x4 (&acc)[2][2][4][2], const Unit& u, int wr, int wc, int fr, int fq) const {
        const int row0 = u.pm * BM + wr * 64 + fr, col0 = u.pn * BM + wc * 32 + 8 * fq;
#pragma unroll
        for (int ai = 0; ai < 2; ++ai)
#pragma unroll
            for (int m = 0; m < 4; ++m) { bf16_t* rowp = O + (size_t)(row0 + ai * HALF + m * 16) * ldc + col0;
#pragma unroll
                for (int bj = 0; bj < 2; ++bj) { const f32x4 v0 = acc[ai][bj][m][0], v1 = acc[ai][bj][m][1];
                    u32x4 w; w.x = cvt_pk_bf16(v0[0], v0[1]); w.y = cvt_pk_bf16(v0[2], v0[3]); w.z = cvt_pk_bf16(v1[0], v1[1]); w.w = cvt_pk_bf16(v1[2], v1[3]);
                    *(u32x4*)(rowp + bj * HALF) = w; } }
    }
};
struct EpiStoreF32 {
    static constexpr bool PERM = false, AFTER_DRAIN = false;
    float* C; int ldc;
    __device__ __forceinline__ void operator()(const f32x4 (&acc)[2][2][4][2], const Unit& u, int wr, int wc, int fr, int fq) const {
        const int row0 = u.pm * BM + wr * 64 + fr, col0 = u.pn * BM + wc * 32 + 4 * fq;
#pragma unroll
        for (int ai = 0; ai < 2; ++ai)
#pragma unroll
            for (int m = 0; m < 4; ++m) { float* rowp = C + (size_t)(row0 + ai * HALF + m * 16) * ldc + col0;
#pragma unroll
                for (int bj = 0; bj < 2; ++bj)
#pragma unroll
                    for (int n = 0; n < 2; ++n) *(f32x4*)(rowp + bj * HALF + n * 16) = acc[ai][bj][m][n]; }
    }
};
struct EpiSwiglu {
    static constexpr bool PERM = true, AFTER_DRAIN = false;
    bf16_t* O; int ldc;
    __device__ __forceinline__ void operator()(const f32x4 (&acc)[2][2][4][2], const Unit& u, int wr, int wc, int fr, int fq) const {
        const int row0 = u.pm * BM + wr * 64 + fr, col0 = u.pn * HALF + wc * 32 + 8 * fq;
#pragma unroll
        for (int ai = 0; ai < 2; ++ai)
#pragma unroll
            for (int m = 0; m < 4; ++m) { bf16_t* rowp = O + (size_t)(row0 + ai * HALF + m * 16) * ldc + col0;
                const f32x4 g0 = acc[ai][0][m][0], g1 = acc[ai][0][m][1], u0 = acc[ai][1][m][0], u1 = acc[ai][1][m][1];
                float h[8];
#pragma unroll
                for (int i = 0; i < 4; ++i) { h[i] = silu_f(g0[i]) * u0[i]; h[4 + i] = silu_f(g1[i]) * u1[i]; }
                u32x4 w; w.x = cvt_pk_bf16(h[0], h[1]); w.y = cvt_pk_bf16(h[2], h[3]); w.z = cvt_pk_bf16(h[4], h[5]); w.w = cvt_pk_bf16(h[6], h[7]);
                *(u32x4*)rowp = w; }
    }
};
struct MoeOrder : StaticOrder {
    const int* tab;
    __device__ __forceinline__ void initm(const int* tab_, int nN_, int G_, int c_) { tab = tab_; nM = tab_[0]; nN = nN_; nwg = nM * nN; G = G_; c = c_; }
    __device__ __forceinline__ bool next(int i, Unit& u) const { if (!StaticOrder::next(i, u)) return false; u.be = tab[1 + u.pm]; return true; }
};
template <class Epi, class Sched, bool ALIGN_EPI = false, bool SP2 = false>
__device__ __forceinline__ void gemm_phase(PG8_LAS unsigned char* lds, const Gemm g, const Sched& S, const Epi& E) {
    const int tid = threadIdx.x, wid = __builtin_amdgcn_readfirstlane(tid >> 6), lane = tid & 63, wr = wid >> 2, wc = wid & 3, fr = lane & 15, fq = lane >> 4;
    const int K = g.K, nt = K / BK;
    unsigned voffA[2], voffB[2];
#pragma unroll
    for (int i = 0; i < 2; ++i) { int R, C; stage_rc(tid * 16 + i * 8192, R, C); const int Rb = Epi::PERM ? ((R & ~31) + perm32(R & 31)) : R;
        voffA[i] = (unsigned)(R * K + C) * 2u; voffB[i] = (unsigned)(Rb * K + C) * 2u; }
    const size_t kstep = (size_t)(BK * 2);
    const size_t hstep = (size_t)HALF * K * 2;
    const size_t tstep = 2 * hstep;
    const unsigned ldsw = (unsigned)wid * 1024u;
    const int aoff = lds_byte(wr * 64 + fr, fq * 8), boff = lds_byte(wc * 32 + fr, fq * 8);
#define PG8_SA(b, h) (((b) * 2 + (h)) * HTB)
#define PG8_SB(b, h) ((4 + (b) * 2 + (h)) * HTB)
#define PG8_STAGE(bufoff, gbase, voff) do { _Pragma("unroll") for (int _i = 0; _i < 2; ++_i) \
        __builtin_amdgcn_global_load_lds((const unsigned*)((const char*)(gbase) + (voff)[_i]), (PG8_LAS unsigned*)(lds + (bufoff) + ldsw + _i * 8192), 16, 0, 0); } while (0)
#define PG8_LDA(dst, b, h) do { _Pragma("unroll") for (int m = 0; m < 4; ++m) _Pragma("unroll") for (int k = 0; k < 2; ++k) dst[m][k] = *(const PG8_LAS bf16x8*)(lds + PG8_SA(b, h) + aoff + m * 2048 + k * 1024); } while (0)
#define PG8_LDB(dst, b, h) do { _Pragma("unroll") for (int n = 0; n < 2; ++n) _Pragma("unroll") for (int k = 0; k < 2; ++k) dst[n][k] = *(const PG8_LAS bf16x8*)(lds + PG8_SB(b, h) + boff + n * 2048 + k * 1024); } while (0)
#define PG8_MMA(ai, bj, At, Bt) do { __builtin_amdgcn_s_setprio(1); _Pragma("unroll") for (int m = 0; m < 4; ++m) _Pragma("unroll") for (int n = 0; n < 2; ++n) _Pragma("unroll") for (int k = 0; k < 2; ++k) \
        acc[ai][bj][m][n] = __builtin_amdgcn_mfma_f32_16x16x32_bf16(Bt[n][k], At[m][k], acc[ai][bj][m][n], 0, 0, 0); __builtin_amdgcn_s_setprio(0); } while (0)
#define PG8_WAIT_V(n) asm volatile("s_waitcnt vmcnt(" #n ")" ::: "memory")
#define PG8_WAIT_L(n) asm volatile("s_waitcnt lgkmcnt(" #n ")" ::: "memory")
#define PG8_BAR __builtin_amdgcn_s_barrier()
#define PG8_SCHED __builtin_amdgcn_sched_barrier(0)
    Unit cur, nxt; int ui = 0;
    if (!S.next(0, cur)) return;
    f32x4 acc[2][2][4][2];
#pragma unroll
    for (int a = 0; a < 2; ++a)
#pragma unroll
        for (int b = 0; b < 2; ++b)
#pragma unroll
            for (int m = 0; m < 4; ++m)
#pragma unroll
                for (int n = 0; n < 2; ++n) acc[a][b][m][n] = (f32x4){0.f, 0.f, 0.f, 0.f};
    bf16x8 At[4][2], B0[2][2], B1[2][2];
    const char* cA = (const char*)g.A + (size_t)cur.pm * tstep; const char* cB = (const char*)g.Bt + (size_t)cur.be * g.bstride + (size_t)cur.pn * tstep;
    S.a_ready(cur);
    if constexpr (SP2) {
        PG8_STAGE(PG8_SB(0, 0), cB, voffB); PG8_STAGE(PG8_SB(0, 1), cB + hstep, voffB); PG8_STAGE(PG8_SA(0, 0), cA, voffA); PG8_STAGE(PG8_SA(0, 1), cA + hstep, voffA);
        if (wr == 1) PG8_BAR;
        PG8_WAIT_V(2); PG8_BAR;
        PG8_STAGE(PG8_SB(1, 0), cB + kstep, voffB); PG8_STAGE(PG8_SA(1, 0), cA + kstep, voffA); PG8_STAGE(PG8_SB(1, 1), cB + hstep + kstep, voffB);
        PG8_WAIT_V(6); PG8_BAR;
    } else {
        PG8_STAGE(PG8_SB(0, 0), cB, voffB); PG8_STAGE(PG8_SA(0, 0), cA, voffA); PG8_STAGE(PG8_SB(0, 1), cB + hstep, voffB); PG8_STAGE(PG8_SA(0, 1), cA + hstep, voffA);
        if (wr == 1) PG8_BAR;
        PG8_WAIT_V(4); PG8_BAR;
        PG8_STAGE(PG8_SB(1, 0), cB + kstep, voffB); PG8_STAGE(PG8_SA(1, 0), cA + kstep, voffA); PG8_STAGE(PG8_SB(1, 1), cB + hstep + kstep, voffB);
        PG8_WAIT_V(6); PG8_BAR;
    }
    for (;;) {
        const bool has_next = S.next(ui + 1, nxt);
        const char* nA = has_next ? (const char*)g.A + (size_t)nxt.pm * tstep : cA; const char* nB = has_next ? (const char*)g.Bt + (size_t)nxt.be * g.bstride + (size_t)nxt.pn * tstep : cB;
        for (int t = 0; t < nt; t += 2) {
            const bool last = (t == nt - 2);
            const char* a1 = cA + (size_t)(t + 1) * kstep;
            const char* a2 = last ? nA : cA + (size_t)(t + 2) * kstep; const char* b2 = last ? nB : cB + (size_t)(t + 2) * kstep;
            const char* a3 = a2 + kstep; const char* b3 = b2 + kstep;
            if (last && has_next) S.a_ready(nxt);
            if constexpr (SP2) {
            PG8_LDB(B0, 0, 0); PG8_LDB(B1, 0, 1); PG8_SCHED; PG8_LDA(At, 0, 0); PG8_STAGE(PG8_SA(1, 1), a1 + hstep, voffA);
            PG8_WAIT_V(8); PG8_WAIT_L(0); PG8_BAR; PG8_MMA(0, 0, At, B0); PG8_MMA(0, 1, At, B1); PG8_BAR; PG8_SCHED;
            PG8_LDA(At, 0, 1); PG8_STAGE(PG8_SB(0, 0), b2, voffB); PG8_STAGE(PG8_SB(0, 1), b2 + hstep, voffB); PG8_STAGE(PG8_SA(0, 0), a2, voffA);
            PG8_WAIT_V(8); PG8_WAIT_L(0); PG8_BAR; PG8_MMA(1, 0, At, B0); PG8_MMA(1, 1, At, B1); PG8_BAR; PG8_SCHED;
            PG8_LDB(B0, 1, 0); PG8_LDB(B1, 1, 1); PG8_SCHED; PG8_LDA(At, 1, 0); PG8_STAGE(PG8_SA(0, 1), a2 + hstep, voffA);
            PG8_WAIT_V(8); PG8_WAIT_L(0); PG8_BAR; PG8_MMA(0, 0, At, B0); PG8_MMA(0, 1, At, B1); PG8_BAR; PG8_SCHED;
            PG8_LDA(At, 1, 1); PG8_STAGE(PG8_SB(1, 0), b3, voffB); PG8_STAGE(PG8_SB(1, 1), b3 + hstep, voffB); PG8_STAGE(PG8_SA(1, 0), a3, voffA);
            PG8_WAIT_V(8); PG8_WAIT_L(0); PG8_BAR; PG8_MMA(1, 0, At, B0); PG8_MMA(1, 1, At, B1); PG8_BAR; PG8_SCHED;
            } else {
            PG8_LDB(B0, 0, 0); PG8_SCHED; PG8_LDA(At, 0, 0); PG8_STAGE(PG8_SA(1, 1), a1 + hstep, voffA);
            PG8_WAIT_L(8); PG8_BAR; PG8_WAIT_L(0); PG8_MMA(0, 0, At, B0); PG8_BAR; PG8_SCHED;
            PG8_LDB(B1, 0, 1); PG8_STAGE(PG8_SB(0, 0), b2, voffB);
            PG8_BAR; PG8_WAIT_L(0); PG8_MMA(0, 1, At, B1); PG8_BAR;
            PG8_LDA(At, 0, 1); PG8_STAGE(PG8_SA(0, 0), a2, voffA);
            PG8_BAR; PG8_WAIT_L(0); PG8_MMA(1, 0, At, B0); PG8_BAR; PG8_SCHED;
            PG8_STAGE(PG8_SB(0, 1), b2 + hstep, voffB);
            PG8_WAIT_V(6); PG8_BAR; PG8_MMA(1, 1, At, B1); PG8_BAR;
            PG8_LDB(B0, 1, 0); PG8_SCHED; PG8_LDA(At, 1, 0); PG8_STAGE(PG8_SA(0, 1), a2 + hstep, voffA);
            PG8_WAIT_L(8); PG8_BAR; PG8_WAIT_L(0); PG8_MMA(0, 0, At, B0); PG8_BAR; PG8_SCHED;
            PG8_LDB(B1, 1, 1); PG8_STAGE(PG8_SB(1, 0), b3, voffB);
            PG8_BAR; PG8_WAIT_L(0); PG8_MMA(0, 1, At, B1); PG8_BAR;
            PG8_LDA(At, 1, 1); PG8_STAGE(PG8_SA(1, 0), a3, voffA);
            PG8_BAR; PG8_WAIT_L(0); PG8_MMA(1, 0, At, B0); PG8_BAR; PG8_SCHED;
            PG8_STAGE(PG8_SB(1, 1), b3 + hstep, voffB);
            PG8_WAIT_V(6); PG8_BAR; PG8_MMA(1, 1, At, B1); PG8_BAR;
            }
        }
        if constexpr (ALIGN_EPI) { if (wr == 0) PG8_BAR; }
        if constexpr (!Epi::AFTER_DRAIN) { E(acc, cur, wr, wc, fr, fq); S.done(cur); }
        if (!has_next) break;
#pragma unroll
        for (int a = 0; a < 2; ++a)
#pragma unroll
            for (int b = 0; b < 2; ++b)
#pragma unroll
                for (int m = 0; m < 4; ++m)
#pragma unroll
                    for (int n = 0; n < 2; ++n) acc[a][b][m][n] = (f32x4){0.f, 0.f, 0.f, 0.f};
        cur = nxt; cA = nA; cB = nB; ++ui;
        if constexpr (ALIGN_EPI) { if (wr == 1) PG8_BAR; }
    }
    PG8_WAIT_V(0);
    if constexpr (!ALIGN_EPI) { if (wr == 0) PG8_BAR; }
    PG8_BAR;
    if constexpr (Epi::AFTER_DRAIN) { E.fused(acc, cur, wr, wc, fr, fq, lds, wid, lane); S.done(cur); }
#undef PG8_SA
#undef PG8_SB
#undef PG8_STAGE
#undef PG8_LDA
#undef PG8_LDB
#undef PG8_MMA
#undef PG8_WAIT_V
#undef PG8_WAIT_L
#undef PG8_BAR
#undef PG8_SCHED
}
}
#ifndef SSD_NAIVE
#define SSD_NAIVE 0
#endif
#ifndef MLSTM_NAIVE
#define MLSTM_NAIVE 0
#endif
#ifndef FOX_NAIVE
#define FOX_NAIVE 0
#endif
#include <hip/hip_bf16.h>
#include <cmath>
namespace attn_body {
using bf16=__hip_bfloat16;
using bf16x8=__attribute__((ext_vector_type(8)))short;
using s16x4=__attribute__((ext_vector_type(4)))short;
using f32x16=__attribute__((ext_vector_type(16)))float;
using u32x4=__attribute__((ext_vector_type(4)))unsigned;
constexpr int BATCH=8,NHEAD=8,SEQ=2048,D=64,PQ=3584,PO=1024;
constexpr int NW=8,QBLK=32,QB=QBLK*NW,KVBLK=64,NQB=SEQ/QB;
constexpr int ATTN_UNIT_ROWS=QB;
__device__ __forceinline__ int crow(int r,int hi){return (r&3)+8*(r>>2)+4*hi;}
#define SBAR() __builtin_amdgcn_sched_barrier(0)
__device__ __forceinline__ void cmask(f32x16&p0,f32x16&p1,int jb,int qrel,int hi){
  const float NEG=-INFINITY; int kb=64*jb+4*hi;
  #pragma unroll
  for(int r=0;r<16;++r){int kv=kb+(r&3)+8*(r>>2); if(kv>qrel)p0[r]=NEG; if(kv+32>qrel)p1[r]=NEG;}
}

constexpr int NSLOT=3, SLOTB=8192;
constexpr int LDS_K=0, LDS_V=NSLOT*SLOTB, LDS_WS=2*NSLOT*SLOTB, LDS_OST=LDS_WS+NW*64*4, LDS_CK=LDS_OST+NW*4096, LDS_BYTES=LDS_CK+SEQ*4;
constexpr float C2=0.125f*1.4426950408889634f;
__device__ __forceinline__ void glds16(const void*gsrc,unsigned lds_dst){unsigned keep;
  asm volatile("s_mov_b32 %0, m0\n\ts_mov_b32 m0, %2\n\ts_nop 0\n\tglobal_load_lds_dwordx4 %1, off\n\ts_mov_b32 m0, %0":"=&s"(keep):"v"(gsrc),"s"(lds_dst):"memory");}
__device__ __forceinline__ float max3f(float a,float b,float c){float r;asm("v_max3_f32 %0, %1, %2, %3":"=v"(r):"v"(a),"v"(b),"v"(c));return r;}
__device__ __forceinline__ float max2f(float a,float b){float r;asm("v_max_f32_e32 %0, %1, %2":"=v"(r):"v"(a),"v"(b));return r;}
__device__ __forceinline__ float fadd_s(float a,float b){float r;asm("v_add_f32_e32 %0, %1, %2":"=v"(r):"v"(a),"v"(b));return r;}
__device__ __forceinline__ float fsub_s(float a,float b){float r;asm("v_sub_f32_e32 %0, %1, %2":"=v"(r):"v"(a),"v"(b));return r;}
typedef float f32x4_t __attribute__((ext_vector_type(4))); typedef float f32x2_t __attribute__((ext_vector_type(2))); typedef __bf16 bf16x2_t __attribute__((ext_vector_type(2)));
__device__ __forceinline__ unsigned cvtpk_s(float lo,float hi){f32x2_t v={lo,hi};bf16x2_t b=__builtin_convertvector(v,bf16x2_t);return __builtin_bit_cast(unsigned,b);}
#define WAIT_BAR(N) asm volatile("s_waitcnt vmcnt(" #N ") lgkmcnt(0)\n\ts_barrier":::"memory")

__device__ __forceinline__ void qkt(f32x16&p0,f32x16&p1,const char*Kslot,const bf16x8*qr,int r32,int hi){
  const char*kb=Kslot+hi*1024+r32*16;
  #pragma unroll
  for(int d0=0;d0<4;++d0){
    const bf16x8 b0=*reinterpret_cast<const bf16x8*>(kb+d0*2048);
    const bf16x8 b1=*reinterpret_cast<const bf16x8*>(kb+d0*2048+512);
    {p0=__builtin_amdgcn_mfma_f32_32x32x16_bf16(b0,qr[d0],p0,0,0,0);p1=__builtin_amdgcn_mfma_f32_32x32x16_bf16(b1,qr[d0],p1,0,0,0);}}
}
typedef __attribute__((address_space(3))) const char* lds_cptr;
typedef short v4i16_t __attribute__((ext_vector_type(4)));
__device__ __forceinline__ void kload8(bf16x8*kf,lds_cptr kp){
  kf[0]=*(const __attribute__((address_space(3))) bf16x8*)(kp);      kf[1]=*(const __attribute__((address_space(3))) bf16x8*)(kp+512);
  kf[2]=*(const __attribute__((address_space(3))) bf16x8*)(kp+2048); kf[3]=*(const __attribute__((address_space(3))) bf16x8*)(kp+2560);
  kf[4]=*(const __attribute__((address_space(3))) bf16x8*)(kp+4096); kf[5]=*(const __attribute__((address_space(3))) bf16x8*)(kp+4608);
  kf[6]=*(const __attribute__((address_space(3))) bf16x8*)(kp+6144); kf[7]=*(const __attribute__((address_space(3))) bf16x8*)(kp+6656);
}
__device__ __forceinline__ void kload2(bf16x8*kf,lds_cptr kp,int j){ kf[2*j]=*(const __attribute__((address_space(3))) bf16x8*)(kp+j*2048); kf[2*j+1]=*(const __attribute__((address_space(3))) bf16x8*)(kp+j*2048+512); }
__device__ __forceinline__ s16x4 vtr(lds_cptr p){ return __builtin_bit_cast(s16x4,__builtin_amdgcn_ds_read_tr16_b64_v4i16((__attribute__((address_space(3))) v4i16_t*)p)); }
__device__ __forceinline__ float rowmax(const f32x16&p0,const f32x16&p1){
  float a=max3f(p0[0],p0[1],p1[0]),b=max3f(p0[2],p0[3],p1[1]);a=max3f(a,p1[2],p1[3]);
  #pragma unroll
  for(int r=4;r<16;r+=4){a=max3f(a,p0[r],p0[r+1]);b=max3f(b,p0[r+2],p0[r+3]);a=max3f(a,p1[r],p1[r+1]);b=max3f(b,p1[r+2],p1[r+3]);}
  const float m=max2f(a,b);
  auto rr=__builtin_amdgcn_permlane32_swap(__float_as_uint(m),__float_as_uint(m),false,false);
  return max2f(__uint_as_float(rr[0]),__uint_as_float(rr[1]));
}
__device__ __forceinline__ void pv(f32x16*o,int vb,bf16x8 pa0,bf16x8 pa1,bf16x8 pa2,bf16x8 pa3){
  #pragma unroll
  for(int d0=0;d0<2;++d0){s16x4 lo[4],hi[4];
    #pragma unroll
    for(int ks=0;ks<4;++ks){
      asm volatile("ds_read_b64_tr_b16 %0,%1 offset:%c2":"=&v"(lo[ks]):"v"(vb),"i"(d0*4096+ks*1024):"memory");
      asm volatile("ds_read_b64_tr_b16 %0,%1 offset:%c2":"=&v"(hi[ks]):"v"(vb),"i"(d0*4096+ks*1024+512):"memory");}
    asm volatile("s_waitcnt lgkmcnt(0)":::"memory");SBAR();
    #define PK(k) (bf16x8){lo[k][0],lo[k][1],lo[k][2],lo[k][3],hi[k][0],hi[k][1],hi[k][2],hi[k][3]}
    o[d0]=__builtin_amdgcn_mfma_f32_32x32x16_bf16(pa0,PK(0),o[d0],0,0,0);
    o[d0]=__builtin_amdgcn_mfma_f32_32x32x16_bf16(pa1,PK(1),o[d0],0,0,0);
    o[d0]=__builtin_amdgcn_mfma_f32_32x32x16_bf16(pa2,PK(2),o[d0],0,0,0);
    o[d0]=__builtin_amdgcn_mfma_f32_32x32x16_bf16(pa3,PK(3),o[d0],0,0,0);
    #undef PK
  }
}

#ifndef ATTN_STORE16
#define ATTN_STORE16(p,v) (*(u32x4*)(p)=(v))
#endif
template<int THRL> __device__ __forceinline__ void attn_unit(int b,int h,int qb,const bf16*Q,const bf16*K,const bf16*V,bf16*O,const float*cum,char*shm){
  const int tid=threadIdx.x,lane=tid&63,r32=lane&31,hi=lane>>5; const int wid=__builtin_amdgcn_readfirstlane(tid>>6);
  const long rowbase=(long)b*SEQ; const int q0=qb*QB;
  const bf16*Qw=Q+(rowbase+q0+wid*QBLK)*PQ+h*D;
  const bf16*Kh=K+rowbase*PQ+h*D,*Vh=V+rowbase*PQ+h*D;
  const lds_cptr shm3_=(lds_cptr)shm;
  const unsigned lds0=(unsigned)(uintptr_t)shm;
  float*wsf=(float*)(shm+LDS_WS)+wid*64;
  const bf16*ksrc=Kh+(long)lane*PQ+wid*8;
  const bf16*vsrc=Vh+(long)(16*(wid&3)+(lane>>2))*PQ+(wid>>2)*32+(lane&3)*8;
  const unsigned kdst=lds0+LDS_K+wid*1024, vdst=lds0+LDS_V+wid*1024;
  #define DMA_K(t,slot) glds16(ksrc+(long)(t)*KVBLK*PQ,(unsigned)__builtin_amdgcn_readfirstlane(kdst+(slot)))
  #define DMA_V(t,slot) glds16(vsrc+(long)(t)*KVBLK*PQ,(unsigned)__builtin_amdgcn_readfirstlane(vdst+(slot)))
  const int vb0=(int)(lds0+LDS_V)+((lane>>4)&1)*32+(lane&3)*8+(4*hi+((lane&15)>>2))*64;
  const char*Kbase=shm+LDS_K; bf16x8 kf[8];
  const lds_cptr shm3=(lds_cptr)shm; const lds_cptr kp0=shm3+LDS_K+hi*1024+r32*16; const lds_cptr vp0=shm3+LDS_V+((lane>>4)&1)*32+(lane&3)*8+(4*hi+((lane&15)>>2))*64;
  const int NT=(q0+QB)/KVBLK;
  float cqm;
  { float*cks=(float*)(shm+LDS_CK); for(int i=tid;i<q0+QB;i+=NW*64)cks[i]=cum[i]; cqm=cum[q0+wid*QBLK+r32]; asm volatile("s_waitcnt vmcnt(0)":"+v"(cqm)::"memory"); }
  const __attribute__((address_space(3))) float*ckl=(const __attribute__((address_space(3))) float*)(shm3_+LDS_CK)+4*hi;
  #define BIASFILL(C0_,C1_,t_) do{ const __attribute__((address_space(3))) float*cp_=ckl+64*(t_); \
    _Pragma("unroll") for(int a_=0;a_<4;++a_){ const f32x4_t u_=*(const __attribute__((address_space(3))) f32x4_t*)(cp_+8*a_), w_=*(const __attribute__((address_space(3))) f32x4_t*)(cp_+32+8*a_); \
      _Pragma("unroll") for(int i_=0;i_<4;++i_){ C0_[4*a_+i_]=cqm-u_[i_]; C1_[4*a_+i_]=cqm-w_[i_]; } } }while(0)
  DMA_K(0,0);DMA_V(0,0);DMA_K(1,SLOTB);
  bf16x8 qr[4];
  #pragma unroll
  for(int d0=0;d0<4;++d0)qr[d0]=*reinterpret_cast<const bf16x8*>(&Qw[(long)r32*PQ+d0*16+hi*8]);
  float l_reg=0.f;f32x16 o[2];o[0]=f32x16{};o[1]=f32x16{};
  const int qrel=wid*QBLK+r32;
  #define CMASK(P0,P1,t) do{int jb_=(t)-(NT-4); if(jb_>=0)cmask(P0,P1,jb_,qrel,hi);}while(0)
  bool resc=false;
  #define START(P0,P1) do{ const float rm=rowmax(P0,P1); resc=false; \
    { const float dl=rm; cqm=fsub_s(cqm,dl); \
      _Pragma("unroll") for(int r=0;r<16;++r){P0[r]=fsub_s(P0[r],dl);P1[r]=fsub_s(P1[r],dl);} \
      } \
    _Pragma("unroll") for(int r=0;r<16;++r)P0[r]=__builtin_amdgcn_exp2f(P0[r]); }while(0)
  #define RESC() do{ if(resc){ asm volatile("s_waitcnt lgkmcnt(0)":::"memory"); \
      _Pragma("unroll") for(int d_=0;d_<2;++d_) _Pragma("unroll") for(int r=0;r<16;++r)o[d_][r]*=wsf[crow(r,hi)]; } }while(0)
  f32x16 pA0,pA1,pB0,pB1;
  int sl_prev=0,sl_cur=0,sl_next=SLOTB;
  #define ROT() do{sl_prev=sl_cur;sl_cur=sl_next;sl_next=(sl_next==(NSLOT-1)*SLOTB)?0:sl_next+SLOTB;}while(0)
  DMA_K(2,2*SLOTB);
  WAIT_BAR(3);
  BIASFILL(pA0,pA1,0); qkt(pA0,pA1,Kbase,qr,r32,hi);asm volatile("s_nop 15\n\ts_nop 7":"+v"(pA0),"+v"(pA1));CMASK(pA0,pA1,0);
  START(pA0,pA1);
  _Pragma("unroll") for(int r=0;r<16;++r)pA1[r]=__builtin_amdgcn_exp2f(pA1[r]);
  WAIT_BAR(0);
  DMA_K(3,0);DMA_V(1,SLOTB);
  ROT();
  kload8(kf,kp0+sl_cur);
  WAIT_BAR(2);
  s16x4 vlo[8],vhi[8]; u32x4 pw0,pw1,pw2,pw3;
  #define PKW(P,B) cvtpk_s(P[B],P[B+1])
  #define PAF(k) __builtin_bit_cast(bf16x8,pw##k)
  #define VFR(i) (bf16x8){vlo[i][0],vlo[i][1],vlo[i][2],vlo[i][3],vhi[i][0],vhi[i][1],vhi[i][2],vhi[i][3]}
  #define PIN(x) asm volatile("":"+v"(x))
  #define MX3(a,b,c) __builtin_fmaxf(__builtin_fmaxf((a),(b)),(c))
  #define GAPA(MF,A0,A1,A2,A3,W0,W1,PW) do{ MF; sacc+=A0; sacc+=A1; sacc+=A2; sacc+=A3; PIN(sacc); W0; W1; PIN(PW); SBAR(); }while(0)
  #define EX(v) __builtin_amdgcn_exp2f(v)
  #define GAPB(MF,X,B) do{ MF; X[B]=EX(X[B]); X[B+1]=EX(X[B+1]); X[B+2]=EX(X[B+2]); X[B+3]=EX(X[B+3]); PIN(X); SBAR(); }while(0)
  #define VRD(i) do{ vlo[i]=vtr(vp_+(((i)>>2)*4096+((i)&3)*1024)); vhi[i]=vtr(vp_+(((i)>>2)*4096+((i)&3)*1024+512)); }while(0)
  #define KRD(G,j) do{ if(G){ kload2(kf,kp0+sl_next,j); SBAR(); } }while(0)
  #define STEP(C0,C1,P0,P1,t,GK,GV,GL) do{ BIASFILL(C0,C1,t); SBAR(); \
    const lds_cptr vp_=vp0+sl_prev; \
    VRD(0); SBAR(); float sacc=(P0[0]+P0[1]); \
    GAPA(C0=__builtin_amdgcn_mfma_f32_32x32x16_bf16(kf[0],qr[0],C0,0,0,0), P0[2],P0[3],P0[4],P0[5],     pw0[0]=PKW(P0,0), pw0[1]=PKW(P0,2), pw0); \
    VRD(4); SBAR(); GAPA(C1=__builtin_amdgcn_mfma_f32_32x32x16_bf16(kf[1],qr[0],C1,0,0,0), P0[6],P0[7],P0[8],P0[9],     pw0[2]=PKW(P0,4), pw0[3]=PKW(P0,6), pw0); \
    VRD(1); SBAR(); GAPA(C0=__builtin_amdgcn_mfma_f32_32x32x16_bf16(kf[2],qr[1],C0,0,0,0),   P0[10],P0[11],P0[12],P0[13], pw1[0]=PKW(P0,8), pw1[1]=PKW(P0,10), pw1); \
    VRD(5); SBAR(); GAPA(C1=__builtin_amdgcn_mfma_f32_32x32x16_bf16(kf[3],qr[1],C1,0,0,0),   P0[14],P0[15],P1[0],P1[1],   pw1[2]=PKW(P0,12),pw1[3]=PKW(P0,14), pw1); \
    VRD(2); SBAR(); GAPA(C0=__builtin_amdgcn_mfma_f32_32x32x16_bf16(kf[4],qr[2],C0,0,0,0),   P1[2],P1[3],P1[4],P1[5],     pw2[0]=PKW(P1,0), pw2[1]=PKW(P1,2), pw2); \
    VRD(6); SBAR(); GAPA(C1=__builtin_amdgcn_mfma_f32_32x32x16_bf16(kf[5],qr[2],C1,0,0,0),   P1[6],P1[7],P1[8],P1[9],     pw2[2]=PKW(P1,4), pw2[3]=PKW(P1,6), pw2); \
    VRD(3); SBAR(); GAPA(C0=__builtin_amdgcn_mfma_f32_32x32x16_bf16(kf[6],qr[3],C0,0,0,0),   P1[10],P1[11],P1[12],P1[13], pw3[0]=PKW(P1,8), pw3[1]=PKW(P1,10), pw3); \
    VRD(7); SBAR(); GAPA(C1=__builtin_amdgcn_mfma_f32_32x32x16_bf16(kf[7],qr[3],C1,0,0,0),   P1[14],P1[15],0.f,0.f,       pw3[2]=PKW(P1,12),pw3[3]=PKW(P1,14), pw3); \
    l_reg+=sacc; \
    if(GK){DMA_K((t)+3,sl_cur);} if(GV){DMA_V((t)+1,sl_next);} \
    CMASK(C0,C1,t); \
    { float a=MX3(C0[0],C0[1],C1[0]),b=MX3(C0[2],C0[3],C1[1]); a=MX3(a,C1[2],C1[3]); \
      _Pragma("unroll") for(int r=4;r<16;r+=4){a=MX3(a,C0[r],C0[r+1]);b=MX3(b,C0[r+2],C0[r+3]);a=MX3(a,C1[r],C1[r+1]);b=MX3(b,C1[r+2],C1[r+3]);} \
      float rm=__builtin_fmaxf(a,b); { auto rr=__builtin_amdgcn_permlane32_swap(__float_as_uint(rm),__float_as_uint(rm),false,false); rm=__builtin_fmaxf(__uint_as_float(rr[0]),__uint_as_float(rr[1])); } \
      resc=false; \
      if(__builtin_expect(__any(rm>(float)THRL),0)){ const float dl=__builtin_fmaxf(rm,0.f); cqm-=dl; \
        _Pragma("unroll") for(int r=0;r<16;++r){C0[r]-=dl;C1[r]-=dl;} \
        const float f=__builtin_amdgcn_exp2f(-dl); l_reg*=f; if(hi==0)wsf[r32]=f; resc=true; } } \
    SBAR(); \
    GAPB(o[0]=__builtin_amdgcn_mfma_f32_32x32x16_bf16(PAF(0),VFR(0),o[0],0,0,0), C0,0); \
    GAPB(o[1]=__builtin_amdgcn_mfma_f32_32x32x16_bf16(PAF(0),VFR(4),o[1],0,0,0), C0,4); \
    KRD(GL,0); GAPB(o[0]=__builtin_amdgcn_mfma_f32_32x32x16_bf16(PAF(1),VFR(1),o[0],0,0,0), C0,8); \
    KRD(GL,1); GAPB(o[1]=__builtin_amdgcn_mfma_f32_32x32x16_bf16(PAF(1),VFR(5),o[1],0,0,0), C0,12); \
    KRD(GL,2); GAPB(o[0]=__builtin_amdgcn_mfma_f32_32x32x16_bf16(PAF(2),VFR(2),o[0],0,0,0), C1,0); \
    KRD(GL,3); GAPB(o[1]=__builtin_amdgcn_mfma_f32_32x32x16_bf16(PAF(2),VFR(6),o[1],0,0,0), C1,4); \
    GAPB(o[0]=__builtin_amdgcn_mfma_f32_32x32x16_bf16(PAF(3),VFR(3),o[0],0,0,0), C1,8); \
    GAPB(o[1]=__builtin_amdgcn_mfma_f32_32x32x16_bf16(PAF(3),VFR(7),o[1],0,0,0), C1,12); \
    }while(0)
  int t=1;
  #undef CMASK
  #define CMASK(P0,P1,t) do{}while(0)
  for(;t+5<NT;t+=2){
    STEP(pB0,pB1,pA0,pA1,t,true,true,true);     WAIT_BAR(2); RESC(); ROT();
    STEP(pA0,pA1,pB0,pB1,t+1,true,true,true);   WAIT_BAR(2); RESC(); ROT();
  }
  #undef CMASK
  #define CMASK(P0,P1,t) do{int jb_=(t)-(NT-4); if(jb_>=0)cmask(P0,P1,jb_,qrel,hi);}while(0)
  #define ENDW(tt) do{ if((tt)+3<NT){WAIT_BAR(2);} else if((tt)+2<NT){WAIT_BAR(1);} else {WAIT_BAR(0);} }while(0)
  for(;t+1<NT;t+=2){
    STEP(pB0,pB1,pA0,pA1,t,(t+3<NT),(t+1<NT),(t+1<NT));       ENDW(t);   RESC(); ROT();
    STEP(pA0,pA1,pB0,pB1,t+1,(t+4<NT),(t+2<NT),(t+2<NT));     ENDW(t+1); RESC(); ROT();
  }
  STEP(pB0,pB1,pA0,pA1,NT-1,false,false,false); RESC();
  { float sacc=pB0[0]+pB0[1]; _Pragma("unroll") for(int r=2;r<16;++r)sacc+=pB0[r]; _Pragma("unroll") for(int r=0;r<16;++r)sacc+=pB1[r]; l_reg+=sacc;
    pw0=(u32x4){PKW(pB0,0),PKW(pB0,2),PKW(pB0,4),PKW(pB0,6)};pw1=(u32x4){PKW(pB0,8),PKW(pB0,10),PKW(pB0,12),PKW(pB0,14)};pw2=(u32x4){PKW(pB1,0),PKW(pB1,2),PKW(pB1,4),PKW(pB1,6)};pw3=(u32x4){PKW(pB1,8),PKW(pB1,10),PKW(pB1,12),PKW(pB1,14)};
    SBAR(); pv(o,vb0+sl_cur,PAF(0),PAF(1),PAF(2),PAF(3)); }
  #undef PKW
  #undef PAF
  #undef VFR
  #undef PIN
  #undef MX3
  #undef GAPA
  #undef GAPB
  #undef EX
  #undef VRD
  #undef KRD
  #undef STEP
  #undef ENDW
  {auto rr=__builtin_amdgcn_permlane32_swap(__float_as_uint(l_reg),__float_as_uint(l_reg),false,false);l_reg=__uint_as_float(rr[0])+__uint_as_float(rr[1]);}
  if(hi==0)wsf[32+r32]=l_reg;asm volatile("s_waitcnt lgkmcnt(0)":::"memory");
  float rli[16];
  #pragma unroll
  for(int r=0;r<16;++r)rli[r]=__builtin_amdgcn_rcpf(wsf[32+crow(r,hi)]);
  bf16*Ow=O+(rowbase+q0+wid*QBLK)*PO+h*D;
  { bf16*stg=(bf16*)(shm+LDS_OST)+wid*2048;
    #pragma unroll
    for(int r=0;r<16;++r){const int orow=crow(r,hi);
      #pragma unroll
      for(int d0=0;d0<2;++d0)stg[orow*64+d0*32+r32]=__float2bfloat16(o[d0][r]*rli[r]);}
    asm volatile("s_waitcnt lgkmcnt(0)":::"memory");
    #pragma unroll
    for(int i=0;i<4;++i){const int row=i*8+(lane>>3),ch=lane&7; const u32x4 v=*(const u32x4*)(stg+row*64+ch*8); ATTN_STORE16(Ow+(long)row*PO+ch*8,v);} }
  asm volatile("s_waitcnt lgkmcnt(0)\n\ts_barrier":::"memory");
  #undef DMA_K
  #undef BIASFILL
  #undef DMA_V
  #undef CMASK
  #undef START
  #undef RESC
  #undef ROT
}
constexpr int ATTN_LDS_BYTES=LDS_BYTES;
struct AttnTensors { const bf16* Q; const bf16* K; const bf16* V; bf16* O; const float* cum; };
struct AttnUnit { int bh; int qb; };
struct StaticOrder {
  int vcu, G;
  __device__ __forceinline__ explicit StaticOrder(int grid,int v):vcu(v),G(grid){}
  __device__ __forceinline__ bool next(int i,AttnUnit&u)const{ const int pr=vcu+(i>>1)*G; if(pr>=256)return false; const int s=pr&3; u.bh=pr>>2; u.qb=(i&1)?7-s:s; return true; }
  __device__ __forceinline__ void a_ready(const AttnUnit&)const{}
  __device__ __forceinline__ void done(const AttnUnit&)const{}
};
template<class Sched,int THRL=8> __device__ __forceinline__ void attn_phase(char*lds,const AttnTensors&T,const Sched&S){
  AttnUnit u;
  for(int i=0;S.next(i,u);++i){ S.a_ready(u); attn_unit<THRL>(u.bh/NHEAD,u.bh%NHEAD,u.qb,T.Q,T.K,T.V,T.O,T.cum+(long)u.bh*SEQ,lds); S.done(u); }
}
#undef SBAR
#undef WAIT_BAR
}
constexpr int NWAVES = 8;
constexpr int T = 16384, D = 1024, SEQ = 2048, NBATCH = 8, DEPTH = 4;
constexpr float ALPHA = 1.6817928305074290f;
constexpr float LN_EPS = 1e-5f;
constexpr int AB_IN = 4112, CD_IN = 3600, NPE = 4096, NPO = 3584;
constexpr float LOG2E = 1.4426950408889634f;
constexpr float FOX_C2 = 0.125f * LOG2E;
constexpr float MLSTM_KSCALE = 0.08838834764831845f;
constexpr int RPAD = 40960;
constexpr int NPH_LAYER = 12, NPHASES = 1 + DEPTH * NPH_LAYER;
#ifndef MK_ONE_LAUNCH
#define MK_ONE_LAUNCH 1
#endif

constexpr size_t MiB = 1u << 20, KiB = 1u << 10;
constexpr size_t WS_CTL = 0, CTL_ZERO_BYTES = 1 * MiB;
constexpr size_t WS_BCNT = 1 * MiB, WS_PANEL = WS_BCNT + 64 * KiB, WS_ROUTE = WS_BCNT + 128 * KiB, WS_GATE = WS_BCNT + 384 * KiB, WS_POS = WS_BCNT + 512 * KiB,
                 WS_DEC = WS_BCNT + 640 * KiB, WS_MLOC = WS_BCNT + 704 * KiB, WS_BLAST = WS_BCNT + 712 * KiB, WS_MPREV = WS_BCNT + 720 * KiB,
                 WS_FOXC = 2 * MiB, WS_NLOC = 2 * MiB + 512 * KiB, WS_SG = 3 * MiB;
constexpr size_t WS_WINE = 4 * MiB, WS_WINO = 20 * MiB, WS_WOUTE = 34 * MiB, WS_WOUTO = 40 * MiB, WS_WGU = 44 * MiB, WS_WD = 300 * MiB;
constexpr size_t WS_HF = 428 * MiB, WS_HB = 492 * MiB, WS_H1F = 524 * MiB, WS_H1B = 588 * MiB;
constexpr size_t WS_R1 = 620 * MiB;
constexpr size_t WS_R2 = 748 * MiB;
constexpr size_t WS_R3 = 812 * MiB;
constexpr size_t WS_R4 = 860 * MiB;
constexpr size_t WS_MIX = 892 * MiB, WS_END = 940 * MiB;
constexpr int CW_BAR = 4096;

constexpr int RING_BYTES = 131072, SMALL_OFF = RING_BYTES, SMALL_BYTES = 8192, MISC_OFF = SMALL_OFF + SMALL_BYTES, LDS_BYTES = 147456;

#define GAS __attribute__((address_space(1)))
#define LAS __attribute__((address_space(3)))
typedef unsigned short bf16;
typedef unsigned v4u __attribute__((ext_vector_type(4)));
typedef unsigned v2u __attribute__((ext_vector_type(2)));
typedef float f32x4 __attribute__((ext_vector_type(4)));
typedef float f32x2 __attribute__((ext_vector_type(2)));
typedef int i32x4 __attribute__((ext_vector_type(4)));
typedef int i32x2 __attribute__((ext_vector_type(2)));
#define LDS_WAIT() asm volatile("s_waitcnt lgkmcnt(0)" ::: "memory")
__device__ __forceinline__ unsigned f2bf(float f) { unsigned u = __builtin_bit_cast(unsigned, f); return (u + 0x7fffu + ((u >> 16) & 1u)) >> 16; }
__device__ __forceinline__ unsigned pk2(float lo, float hi) { return f2bf(lo) | (f2bf(hi) << 16); }
__device__ __forceinline__ float bflo(unsigned w) { return __builtin_bit_cast(float, w << 16); }
__device__ __forceinline__ float bfhi(unsigned w) { return __builtin_bit_cast(float, w & 0xffff0000u); }
__device__ __forceinline__ float bf2f(bf16 b) { return __builtin_bit_cast(float, (unsigned)b << 16); }
__device__ __forceinline__ float wave_sum(float v) {
#pragma unroll
    for (int o = 1; o < 64; o <<= 1) v += __shfl_xor(v, o);
    return v;
}
__device__ __forceinline__ float wave_max(float v) {
#pragma unroll
    for (int o = 1; o < 64; o <<= 1) v = fmaxf(v, __shfl_xor(v, o));
    return v;
}
__device__ __forceinline__ float wave_scan_sum(float v, int lane) {
#pragma unroll
    for (int o = 1; o < 64; o <<= 1) { const float t = __shfl_up(v, o); if (lane >= o) v += t; }
    return v;
}
__device__ __forceinline__ float wave_scan_max(float v, int lane) {
#pragma unroll
    for (int o = 1; o < 64; o <<= 1) { const float t = __shfl_up(v, o); if (lane >= o) v = fmaxf(v, t); }
    return v;
}
__device__ __forceinline__ float softplus_f(float x) { return x > 20.f ? x : log1pf(expf(x)); }
__device__ __forceinline__ float logsigmoid_f(float x) { return fminf(x, 0.f) - log1pf(expf(-fabsf(x))); }
__device__ __forceinline__ float sigmoid_f(float x) { return 1.0f / (1.0f + expf(-x)); }
#define XB_TMO      128
#define XB_XCNT(j)  (256  + 64 * (j))
#define XB_XSUB(j)  (1280 + 64 * (j))
#define XB_XGEN(j)  (2304 + 64 * (j))
#define XB_TOP      3328
#define XB_TOPGEN   3392
#define XCD_BAR_WORDS 3456
#define XB_SPIN_CAP (1u << 18)

__device__ __forceinline__ unsigned xb_ld(unsigned* p)              { return __hip_atomic_load(p, __ATOMIC_RELAXED, __HIP_MEMORY_SCOPE_AGENT); }
__device__ __forceinline__ unsigned xb_add(unsigned* p, unsigned v) { return __hip_atomic_fetch_add(p, v, __ATOMIC_RELAXED, __HIP_MEMORY_SCOPE_AGENT); }
__device__ __forceinline__ unsigned xb_xcc_id() { return (unsigned)__builtin_amdgcn_s_getreg((3 << 11) | 20) & 0xFu; }
#define XB_SPIN(cond, bar) do { unsigned _sp = 0; while (cond) { __builtin_amdgcn_s_sleep(1); \
    if ((++_sp & 255u) == 0u) { if (xb_ld(&(bar)[XB_TMO])) break; if (_sp > XB_SPIN_CAP) { atomicAdd(&(bar)[XB_TMO], 1u); break; } } } } while (0)

struct XcdBarrier {
    unsigned* bar; unsigned x;
    volatile LAS unsigned* st;
};

__device__ __forceinline__ XcdBarrier xcd_barrier_post(unsigned* bar, volatile LAS unsigned* st) {
    XcdBarrier b; b.bar = bar; b.x = xb_xcc_id(); b.st = st;
    if (threadIdx.x == 0) (void)xb_add(&bar[XB_XCNT(b.x)], 1u);
    return b;
}
__device__ __forceinline__ void xcd_barrier_complete(unsigned* bar, unsigned x, unsigned& nloc, unsigned& nx) {
    const unsigned G = gridDim.x * gridDim.y * gridDim.z;
    unsigned sum, cnt, mine, sp = 0u;
    for (;;) {
        sum = 0u; cnt = 0u; mine = 0u;
#pragma unroll
        for (unsigned j = 0; j < 16; ++j) { const unsigned c = xb_ld(&bar[XB_XCNT(j)]); sum += c; cnt += (c > 0u) ? 1u : 0u; mine = (j == x) ? c : mine; }
        if (sum == G) break;
        __builtin_amdgcn_s_sleep(1);
        if ((++sp & 255u) == 0u) { if (xb_ld(&bar[XB_TMO])) break; if (sp > XB_SPIN_CAP) { atomicAdd(&bar[XB_TMO], 1u); break; } }
    }
    nloc = mine > 0u ? mine : 1u; nx = cnt > 0u ? cnt : 1u;
}

__device__ __forceinline__ void xcd_barrier(const XcdBarrier& b) {
    asm volatile("s_waitcnt vmcnt(0)" ::: "memory");
    __syncthreads();
    if (threadIdx.x == 0) {
        unsigned* bar = b.bar;
        __builtin_amdgcn_s_waitcnt(0);
        unsigned nloc = b.st[0], nx = b.st[1];
        if (nloc == 0u) { xcd_barrier_complete(bar, b.x, nloc, nx); b.st[0] = nloc; b.st[1] = nx; }
        const unsigned old = xb_add(&bar[XB_XSUB(b.x)], 1u);
        const unsigned gen = old / nloc;
        if (old + 1u == (gen + 1u) * nloc) {
            __builtin_amdgcn_fence(__ATOMIC_RELEASE, "agent");
            asm volatile("s_waitcnt vmcnt(0)" ::: "memory");
            const unsigned og = xb_add(&bar[XB_TOP], 1u);
            const unsigned tg = og / nx;
            if (og + 1u == (tg + 1u) * nx) xb_add(&bar[XB_TOPGEN], 1u);
            else XB_SPIN(xb_ld(&bar[XB_TOPGEN]) == tg, bar);
            __builtin_amdgcn_fence(__ATOMIC_ACQUIRE, "agent");
            xb_add(&bar[XB_XGEN(b.x)], 1u);
            asm volatile("s_waitcnt vmcnt(0)" ::: "memory");
        } else {
            XB_SPIN(xb_ld(&bar[XB_XGEN(b.x)]) == gen, bar);
            __builtin_amdgcn_fence(__ATOMIC_ACQUIRE, "agent");
            asm volatile("s_waitcnt vmcnt(0)" ::: "memory");
        }
    }
    __syncthreads();
}
struct Frame {
    LAS unsigned char* lds;
    volatile LAS unsigned* MISC;
    unsigned* ctl;
    int tid, lane, wave, vcu, G, gw, NGW;
    float* out; unsigned char* ws;
};
typedef const float* const cfpc_t; typedef __attribute__((address_space(4))) cfpc_t* kargp_t;
__device__ __forceinline__ kargp_t kin() { kargp_t p = (kargp_t)__builtin_amdgcn_kernarg_segment_ptr(); asm volatile("" : "+s"(p)); return p; }
#define KIN(i) (kin()[i])
enum { I_X = 0, I_ABWIN, I_CONVA, I_CONVW, I_CONVB, I_DTB, I_ALOG, I_DSKIP, I_NORMW, I_ABWOUT, I_CDWIN, I_IB, I_FB, I_HNW, I_FOXB, I_CDWOUT, I_LN1G, I_LN1B, I_LN2G, I_LN2B,
       I_RGW, I_RGB, I_REW, I_REB, I_WG, I_WU, I_WDN };

__device__ __forceinline__ void row_load(const float* row, int lane, f32x4 (&v)[4]) {
#pragma unroll
    for (int j = 0; j < 4; ++j) v[j] = ((const f32x4*)row)[lane + 64 * j];
}
__device__ __forceinline__ void row_store_f32(float* row, int lane, const f32x4 (&v)[4]) {
#pragma unroll
    for (int j = 0; j < 4; ++j) ((f32x4*)row)[lane + 64 * j] = v[j];
}
__device__ __forceinline__ void row_store_bf16(bf16* row, int lane, const f32x4 (&v)[4]) {
#pragma unroll
    for (int j = 0; j < 4; ++j) { v2u w; w.x = pk2(v[j][0], v[j][1]); w.y = pk2(v[j][2], v[j][3]); ((v2u*)row)[lane + 64 * j] = w; }
}
__device__ __forceinline__ void row_load_bf16(const bf16* row, int lane, f32x4 (&v)[4]) {
#pragma unroll
    for (int j = 0; j < 4; ++j) { const v2u w = ((const v2u*)row)[lane + 64 * j]; v[j] = (f32x4){bflo(w.x), bfhi(w.x), bflo(w.y), bfhi(w.y)}; }
}
__device__ __forceinline__ void row_layernorm(f32x4 (&v)[4], const float* g, const float* b, int lane) {
    float s = 0.f;
#pragma unroll
    for (int j = 0; j < 4; ++j) s += (v[j][0] + v[j][1]) + (v[j][2] + v[j][3]);
    const float mean = wave_sum(s) * (1.f / D); float s2 = 0.f;
#pragma unroll
    for (int j = 0; j < 4; ++j) { v[j] = v[j] - mean; s2 += (v[j][0] * v[j][0] + v[j][1] * v[j][1]) + (v[j][2] * v[j][2] + v[j][3] * v[j][3]); }
    const float rstd = 1.0f / sqrtf(wave_sum(s2) * (1.f / D) + LN_EPS);
#pragma unroll
    for (int j = 0; j < 4; ++j) { const f32x4 gg = ((const f32x4*)g)[lane + 64 * j], bb = ((const f32x4*)b)[lane + 64 * j]; v[j] = v[j] * rstd * gg + bb; }
}
template <int n, int o, int N> struct RedStep {
    static __device__ __forceinline__ void run(float (&a)[N], int lane) { const bool up = (lane & o) != 0;
#pragma unroll
        for (int i = 0; i < n / 2; ++i) { const float keep = up ? a[i + n / 2] : a[i], send = up ? a[i] : a[i + n / 2]; a[i] = keep + __shfl_xor(send, o); }
        RedStep<n / 2, o / 2, N>::run(a, lane); }
};
template <int o, int N> struct RedStep<1, o, N> {
    static __device__ __forceinline__ void run(float (&a)[N], int) { float r = a[0];
#pragma unroll
        for (int oo = o; oo >= 1; oo >>= 1) r += __shfl_xor(r, oo);
        a[0] = r; }
};
template <int N> __device__ __forceinline__ float wave_reduce_multi(float (&a)[N], int lane) { RedStep<N, 32, N>::run(a, lane); return a[0]; }
__device__ __forceinline__ void row_proj16x2(const f32x4 (&v0)[4], const f32x4 (&v1)[4], const float* W, int ldw, int c0a, int c0b, float* sg0, float* sg1, int lane) {
    float a[16], b[16];
#pragma unroll
    for (int c = 0; c < 16; ++c) { a[c] = 0.f; b[c] = 0.f; }
#pragma unroll
    for (int j = 0; j < 4; ++j)
#pragma unroll
        for (int i = 0; i < 4; ++i) { const float x = v0[j][i], y = v1[j][i]; const float* wr = W + (size_t)(256 * j + 4 * lane + i) * ldw;
            const f32x4 w0 = *(const f32x4*)(wr + c0a), w1 = *(const f32x4*)(wr + c0a + 4), w2 = *(const f32x4*)(wr + c0b), w3 = *(const f32x4*)(wr + c0b + 4);
#pragma unroll
            for (int c = 0; c < 4; ++c) { a[c] += x * w0[c]; a[4 + c] += x * w1[c]; a[8 + c] += x * w2[c]; a[12 + c] += x * w3[c]; b[c] += y * w0[c]; b[4 + c] += y * w1[c]; b[8 + c] += y * w2[c]; b[12 + c] += y * w3[c]; } }
    const float r0 = wave_reduce_multi<16>(a, lane), r1 = wave_reduce_multi<16>(b, lane);
    if ((lane & 3) == 0) { sg0[lane >> 2] = r0; if (sg1) sg1[lane >> 2] = r1; }
}
__device__ __forceinline__ void row_gate_proj2(Frame& F, const f32x4 (&v0)[4], const f32x4 (&v1)[4], int layer, int m0, int m1) {
    float* sg0 = (float*)(F.ws + WS_SG) + (size_t)m0 * 16; float* sg1 = m1 >= 0 ? (float*)(F.ws + WS_SG) + (size_t)m1 * 16 : nullptr; const int j = layer >> 1;
    if ((layer & 1) == 0) row_proj16x2(v0, v1, KIN(I_ABWIN) + (size_t)j * D * AB_IN, AB_IN, 4096, 4104, sg0, sg1, F.lane);
    else                  row_proj16x2(v0, v1, KIN(I_CDWIN) + (size_t)j * D * CD_IN, CD_IN, 1536, 3592, sg0, sg1, F.lane);
}

__device__ __forceinline__ void transpose_tile(const float* W, int ldw, int k0, int n0, bf16* WT, int ldt, int drow0, float scale, const float* kscale, LAS float* scr, int lane) {
    const int rs = lane >> 3, c4 = 4 * (lane & 7);
    f32x4 v[8];
#pragma unroll
    for (int i = 0; i < 8; ++i) v[i] = *(const f32x4*)(W + (size_t)(k0 + 8 * i + rs) * ldw + n0 + c4);
#pragma unroll
    for (int i = 0; i < 8; ++i) { const int kk = 8 * i + rs; float sc = scale; if (kscale) sc *= kscale[kk]; LAS float* d = scr + kk * 33 + c4;
        d[0] = v[i][0] * sc; d[1] = v[i][1] * sc; d[2] = v[i][2] * sc; d[3] = v[i][3] * sc; }
    LDS_WAIT(); asm volatile("" ::: "memory");
    const int c = lane & 7;
#pragma unroll
    for (int j = 0; j < 4; ++j) { const int n = (lane >> 3) + 8 * j; const LAS float* s = scr + (8 * c) * 33 + n;
        v4u o; o.x = pk2(s[0 * 33], s[1 * 33]); o.y = pk2(s[2 * 33], s[3 * 33]); o.z = pk2(s[4 * 33], s[5 * 33]); o.w = pk2(s[6 * 33], s[7 * 33]);
        *(v4u*)(WT + (size_t)(drow0 + n) * ldt + k0 + 8 * c) = o; }
    LDS_WAIT(); asm volatile("" ::: "memory");
}
__device__ __forceinline__ void p_prologue(Frame& F) {
    LAS float* scr = (LAS float*)(F.lds + F.wave * 16384);
    bf16* WinE = (bf16*)(F.ws + WS_WINE); bf16* WinO = (bf16*)(F.ws + WS_WINO); bf16* WoutE = (bf16*)(F.ws + WS_WOUTE); bf16* WoutO = (bf16*)(F.ws + WS_WOUTO);
    bf16* Wgu = (bf16*)(F.ws + WS_WGU); bf16* Wd = (bf16*)(F.ws + WS_WD);
    constexpr int N_WINE = 2 * 2048, N_WINO = 2 * 1792, N_WOE = 2 * 768, N_WOO = 2 * 512, N_GU = 128 * 512, N_D = 128 * 256;
    constexpr int NITEMS = N_WINE + N_WINO + N_WOE + N_WOO + N_GU + N_D;
    for (int it = F.gw; it < NITEMS; it += F.NGW) {
        int r = it;
        if (r < N_WINE) { const int j = r / 2048, q = r % 2048, kb = q / 128, nb = q % 128;
            transpose_tile(KIN(I_ABWIN) + (size_t)j * D * AB_IN, AB_IN, 64 * kb, 32 * nb, WinE + (size_t)j * NPE * D, D, 32 * nb, 1.f, nullptr, scr, F.lane); continue; } r -= N_WINE;
        if (r < N_WINO) { const int j = r / 1792, q = r % 1792, seg = q / 256, q2 = q % 256, kb = q2 / 16, nb = q2 % 16;
            const int scol = (seg < 3 ? 512 * seg : 1544 + 512 * (seg - 3)) + 32 * nb; const float sc = seg == 1 ? MLSTM_KSCALE : (seg == 4 ? FOX_C2 : 1.f);
            transpose_tile(KIN(I_CDWIN) + (size_t)j * D * CD_IN, CD_IN, 64 * kb, scol, WinO + (size_t)j * NPO * D, D, 512 * seg + 32 * nb, sc, nullptr, scr, F.lane); continue; } r -= N_WINO;
        if (r < N_WOE) { const int j = r / 768, q = r % 768, kb = q / 32, nb = q % 32;
            const float* ks = kb >= 8 ? KIN(I_NORMW) + (size_t)j * 1024 + (64 * kb - 512) : nullptr;
            transpose_tile(KIN(I_ABWOUT) + (size_t)j * 1536 * D, D, 64 * kb, 32 * nb, WoutE + (size_t)j * D * 1536, 1536, 32 * nb, 1.f, ks, scr, F.lane); continue; } r -= N_WOE;
        if (r < N_WOO) { const int j = r / 512, q = r % 512, kb = q / 32, nb = q % 32;
            transpose_tile(KIN(I_CDWOUT) + (size_t)j * D * D, D, 64 * kb, 32 * nb, WoutO + (size_t)j * D * D, D, 32 * nb, 1.f, nullptr, scr, F.lane); continue; } r -= N_WOO;
        if (r < N_GU) { const int le = r / 512, q = r % 512, half = q / 256, q2 = q % 256, kb = q2 / 16, nb = q2 % 16, n0 = 32 * nb;
            const float* src = (half ? KIN(I_WU) : KIN(I_WG)) + (size_t)le * D * 512;
            transpose_tile(src, 512, 64 * kb, n0, Wgu + (size_t)le * D * D, D, 256 * (n0 / 128) + 128 * half + (n0 % 128), 1.f, nullptr, scr, F.lane); continue; } r -= N_GU;
        { const int le = r / 256, q = r % 256, kb = q / 32, nb = q % 32;
            transpose_tile(KIN(I_WDN) + (size_t)le * 512 * D, D, 64 * kb, 32 * nb, Wd + (size_t)le * D * 512, 512, 32 * nb, 1.f, nullptr, scr, F.lane); }
    }
    bf16* HB = (bf16*)(F.ws + WS_HB);
#pragma unroll 1
    for (int m0 = F.gw; m0 < T; m0 += 2 * F.NGW) { const int m1 = m0 + F.NGW < T ? m0 + F.NGW : -1, m1c = m1 >= 0 ? m1 : m0; f32x4 v0[4], v1[4];
        row_load(KIN(I_X) + (size_t)m0 * D, F.lane, v0); row_load(KIN(I_X) + (size_t)m1c * D, F.lane, v1);
        row_store_bf16(HB + (size_t)m0 * D, F.lane, v0); if (m1 >= 0) row_store_bf16(HB + (size_t)m1 * D, F.lane, v1);
        row_gate_proj2(F, v0, v1, 0, m0, m1); }
}
__device__ __forceinline__ void e0_conv(Frame& F, int j) {
    const bf16* P = (const bf16*)(F.ws + WS_R1); bf16* XBC = (bf16*)(F.ws + WS_R3); bf16* MIX = (bf16*)(F.ws + WS_MIX);
    const float* cw = KIN(I_CONVW) + (size_t)j * 4 * 1536; const float* cb = KIN(I_CONVB) + (size_t)j * 1536; const float* ca = KIN(I_CONVA) + (size_t)j * 3 * 512;
    for (int it = F.gw; it < (T / 8) * 16; it += F.NGW) {
        const int tt = it >> 4, cg = it & 15, t0 = tt * 8, s0 = t0 & (SEQ - 1);
        if (cg < 12) {
            const int c = cg * 128 + 2 * F.lane;
            float w0[4], w1[4];
#pragma unroll
            for (int k = 0; k < 4; ++k) { w0[k] = cw[k * 1536 + c]; w1[k] = cw[k * 1536 + c + 1]; }
            const float b0 = cb[c], b1 = cb[c + 1];
            float xa[11], xb[11];
#pragma unroll
            for (int r = 0; r < 11; ++r) { unsigned w = 0u; if (s0 - 3 + r >= 0) w = *(const unsigned*)(P + (size_t)(t0 - 3 + r) * NPE + 2560 + c); xa[r] = bflo(w); xb[r] = bfhi(w); }
#pragma unroll
            for (int o = 0; o < 8; ++o) { float a0 = b0, a1 = b1;
#pragma unroll
                for (int k = 0; k < 4; ++k) { a0 += w0[k] * xa[o + k]; a1 += w1[k] * xb[o + k]; }
                *(unsigned*)(XBC + (size_t)(t0 + o) * 1536 + c) = pk2(silu_f(a0), silu_f(a1)); }
        } else {
            const int c = (cg - 12) * 128 + 2 * F.lane;
            float w0[3], w1[3];
#pragma unroll
            for (int k = 0; k < 3; ++k) { w0[k] = ca[k * 512 + c]; w1[k] = ca[k * 512 + c + 1]; }
            float ua[10], ub[10];
#pragma unroll
            for (int r = 0; r < 10; ++r) { float a = 0.f, b = 0.f;
                if (s0 - 2 + r >= 0) { const bf16* pr = P + (size_t)(t0 - 2 + r) * NPE; const unsigned cgw = *(const unsigned*)(pr + 512 + c), xw = *(const unsigned*)(pr + 1024 + c); a = bflo(cgw) * bflo(xw); b = bfhi(cgw) * bfhi(xw); }
                ua[r] = a; ub[r] = b; }
#pragma unroll
            for (int o = 0; o < 8; ++o) { float a0 = 0.f, a1 = 0.f;
#pragma unroll
                for (int k = 0; k < 3; ++k) { a0 += w0[k] * ua[o + k]; a1 += w1[k] * ub[o + k]; }
                const unsigned bg = *(const unsigned*)(P + (size_t)(t0 + o) * NPE + c);
                *(unsigned*)(MIX + (size_t)(t0 + o) * 1536 + c) = pk2(bflo(bg) * a0, bfhi(bg) * a1); }
        }
    }
}
__device__ __forceinline__ void ssd_gates(Frame& F, int j, int t0, int h, LAS float* dtl, LAS float* acs) {
    if (F.wave == 0) {
        const float* SG = (const float*)(F.ws + WS_SG); const float dtb = KIN(I_DTB)[j * 16 + h], aneg = -expf(KIN(I_ALOG)[j * 16 + h]);
        const float d0 = softplus_f(SG[(size_t)(t0 + 2 * F.lane) * 16 + h] + dtb), d1 = softplus_f(SG[(size_t)(t0 + 2 * F.lane + 1) * 16 + h] + dtb);
        const float a0 = d0 * aneg, a1 = d1 * aneg; const float inc = wave_scan_sum(a0 + a1, F.lane);
        dtl[2 * F.lane] = d0; dtl[2 * F.lane + 1] = d1; acs[2 * F.lane] = inc - a1; acs[2 * F.lane + 1] = inc;
    }
}
__device__ __forceinline__ void e1_states(Frame& F, int j) {
    const bf16* XBC = (const bf16*)(F.ws + WS_R3); float* ST = (float*)(F.ws + WS_R4); float* DEC = (float*)(F.ws + WS_DEC);
    LAS float* xw = (LAS float*)F.lds; LAS float* Bm = (LAS float*)(F.lds + 32768); LAS float* dtl = (LAS float*)(F.lds + SMALL_OFF); LAS float* acs = dtl + 128;
    for (int u = F.vcu; u < 2048; u += F.G) {
        const int b = u >> 8, c = (u >> 4) & 15, h = u & 15, g = h >> 2, t0 = b * SEQ + c * 128;
        __syncthreads();
        ssd_gates(F, j, t0, h, dtl, acs);
        __syncthreads();
        for (int i = F.tid; i < 128 * 32; i += 512) { const int l = i >> 5, pp = (i & 31) * 2; const float wgt = expf(acs[127] - acs[l]) * dtl[l];
            const unsigned xv = *(const unsigned*)(XBC + (size_t)(t0 + l) * 1536 + h * 64 + pp), bv = *(const unsigned*)(XBC + (size_t)(t0 + l) * 1536 + 1024 + g * 64 + pp);
            xw[l * 64 + pp] = bflo(xv) * wgt; xw[l * 64 + pp + 1] = bfhi(xv) * wgt; Bm[l * 64 + pp] = bflo(bv); Bm[l * 64 + pp + 1] = bfhi(bv); }
        __syncthreads();
        const int n = F.lane, p0 = 8 * F.wave; float acc[8];
#pragma unroll
        for (int i = 0; i < 8; ++i) acc[i] = 0.f;
#pragma unroll 2
        for (int l = 0; l < 128; ++l) { const float bm = Bm[l * 64 + n]; const f32x4 x0 = *(const LAS f32x4*)(xw + l * 64 + p0), x1 = *(const LAS f32x4*)(xw + l * 64 + p0 + 4);
#pragma unroll
            for (int i = 0; i < 4; ++i) { acc[i] += x0[i] * bm; acc[4 + i] += x1[i] * bm; } }
        float* dst = ST + (size_t)u * 4096;
#pragma unroll
        for (int i = 0; i < 8; ++i) dst[(p0 + i) * 64 + n] = acc[i];
        if (F.tid == 0) DEC[u] = expf(acs[127]);
    }
}
__device__ __forceinline__ void e2_scan(Frame& F) {
    float* ST = (float*)(F.ws + WS_R4); const float* DEC = (const float*)(F.ws + WS_DEC);
    for (int e = F.vcu * 512 + F.tid; e < NBATCH * 16 * 4096; e += F.G * 512) {
        const int b = e >> 16, h = (e >> 12) & 15, pn = e & 4095; float run = 0.f;
        for (int c = 0; c < 16; ++c) { const int u = (b * 16 + c) * 16 + h; const size_t idx = (size_t)u * 4096 + pn; const float s = ST[idx]; ST[idx] = run; run = run * DEC[u] + s; }
    }
}
__device__ __forceinline__ void e3_output(Frame& F, int j) {
    const bf16* XBC = (const bf16*)(F.ws + WS_R3); const float* ST = (const float*)(F.ws + WS_R4); float* Y = (float*)(F.ws + WS_R2);
    LAS float* R0 = (LAS float*)F.lds;
    LAS float* R1 = (LAS float*)(F.lds + 32768);
    LAS float* R2 = (LAS float*)(F.lds + 65536);
    LAS float* dtl = (LAS float*)(F.lds + SMALL_OFF); LAS float* acs = dtl + 128;
    for (int u = F.vcu; u < 2048; u += F.G) {
        const int b = u >> 8, c = (u >> 4) & 15, h = u & 15, g = h >> 2, t0 = b * SEQ + c * 128;
        __syncthreads();
        ssd_gates(F, j, t0, h, dtl, acs);
        for (int i = F.tid; i < 128 * 32; i += 512) { const int l = i >> 5, nn = (i & 31) * 2;
            const unsigned bv = *(const unsigned*)(XBC + (size_t)(t0 + l) * 1536 + 1024 + g * 64 + nn), cv = *(const unsigned*)(XBC + (size_t)(t0 + l) * 1536 + 1280 + g * 64 + nn);
            R0[l * 64 + nn] = bflo(cv); R0[l * 64 + nn + 1] = bfhi(cv); R1[nn * 128 + l] = bflo(bv); R1[(nn + 1) * 128 + l] = bfhi(bv); }
        { const float* hp = ST + (size_t)u * 4096; for (int i = F.tid; i < 4096; i += 512) { const int p = i >> 6, n = i & 63; R2[n * 64 + p] = hp[i]; } }
        __syncthreads();
        const int p = F.lane, l0 = 16 * F.wave; float acc[16];
#pragma unroll
        for (int i = 0; i < 16; ++i) acc[i] = 0.f;
#pragma unroll 1
        for (int n0 = 0; n0 < 64; n0 += 4) { float hp[4];
#pragma unroll
            for (int i = 0; i < 4; ++i) hp[i] = R2[(n0 + i) * 64 + p];
#pragma unroll
            for (int li = 0; li < 16; ++li) { const f32x4 c4 = *(const LAS f32x4*)(R0 + (l0 + li) * 64 + n0); acc[li] += (c4[0] * hp[0] + c4[1] * hp[1]) + (c4[2] * hp[2] + c4[3] * hp[3]); } }
#pragma unroll
        for (int li = 0; li < 16; ++li) acc[li] *= expf(acs[l0 + li]);
        __syncthreads();
#pragma unroll 1
        for (int half = 0; half < 2; ++half) { const int s = F.tid & 127, lg = 32 * (F.tid >> 7) + 16 * half; float gacc[16];
#pragma unroll
            for (int i = 0; i < 16; ++i) gacc[i] = 0.f;
#pragma unroll 1
            for (int n0 = 0; n0 < 64; n0 += 4) { float bb[4];
#pragma unroll
                for (int i = 0; i < 4; ++i) bb[i] = R1[(n0 + i) * 128 + s];
#pragma unroll
                for (int li = 0; li < 16; ++li) { const f32x4 c4 = *(const LAS f32x4*)(R0 + (lg + li) * 64 + n0); gacc[li] += (c4[0] * bb[0] + c4[1] * bb[1]) + (c4[2] * bb[2] + c4[3] * bb[3]); } }
            const float as = acs[s];
#pragma unroll
            for (int li = 0; li < 16; ++li) { const int l = lg + li; R2[l * 128 + s] = (s <= l) ? gacc[li] * expf(acs[l] - as) : 0.f; } }
        __syncthreads();
        for (int i = F.tid; i < 128 * 32; i += 512) { const int l = i >> 5, pp = (i & 31) * 2; const unsigned xv = *(const unsigned*)(XBC + (size_t)(t0 + l) * 1536 + h * 64 + pp);
            R0[l * 64 + pp] = bflo(xv); R0[l * 64 + pp + 1] = bfhi(xv); }
        __syncthreads();
#pragma unroll 1
        for (int s0 = 0; s0 < l0 + 16; s0 += 4) { float xv[4];
#pragma unroll
            for (int i = 0; i < 4; ++i) xv[i] = R0[(s0 + i) * 64 + p] * dtl[s0 + i];
#pragma unroll
            for (int li = 0; li < 16; ++li) { const f32x4 g4 = *(const LAS f32x4*)(R2 + (l0 + li) * 128 + s0); acc[li] += (g4[0] * xv[0] + g4[1] * xv[1]) + (g4[2] * xv[2] + g4[3] * xv[3]); } }
        const float dsk = KIN(I_DSKIP)[j * 16 + h];
#pragma unroll
        for (int li = 0; li < 16; ++li) Y[(size_t)(t0 + l0 + li) * D + h * 64 + p] = acc[li] + dsk * R0[(l0 + li) * 64 + p];
    }
}
__device__ __forceinline__ void e4_gnorm(Frame& F) {
    const float* Y = (const float*)(F.ws + WS_R2); const bf16* P = (const bf16*)(F.ws + WS_R1); bf16* MIX = (bf16*)(F.ws + WS_MIX);
    for (int m = F.gw; m < T; m += F.NGW) { f32x4 y[4], z[4]; row_load(Y + (size_t)m * D, F.lane, y); row_load_bf16(P + (size_t)m * NPE + 1536, F.lane, z); float ss = 0.f;
#pragma unroll
        for (int jj = 0; jj < 4; ++jj)
#pragma unroll
            for (int i = 0; i < 4; ++i) { const float uu = y[jj][i] * silu_f(z[jj][i]); y[jj][i] = uu; ss += uu * uu; }
        const float rstd = 1.0f / sqrtf(wave_sum(ss) * (1.f / D) + LN_EPS);
#pragma unroll
        for (int jj = 0; jj < 4; ++jj) y[jj] = y[jj] * rstd;
        row_store_bf16(MIX + (size_t)m * 1536 + 512, F.lane, y); }
}
__device__ __forceinline__ void o_foxscan(Frame& F, int j) {
    const float* SG = (const float*)(F.ws + WS_SG); float* FOXC = (float*)(F.ws + WS_FOXC);
    for (int bh = F.gw; bh < 64; bh += F.NGW) { const int b = bh >> 3, h = bh & 7; const float bias = KIN(I_FOXB)[j * 8 + h];
        float v[32], run = 0.f;
#pragma unroll
        for (int i = 0; i < 32; ++i) { run += logsigmoid_f(SG[(size_t)(b * SEQ + 32 * F.lane + i) * 16 + 8 + h] + bias); v[i] = run; }
        const float off = wave_scan_sum(run, F.lane) - run;
#pragma unroll
        for (int i = 0; i < 32; ++i) FOXC[(size_t)bh * SEQ + 32 * F.lane + i] = (v[i] + off) * LOG2E; }
}
__device__ __forceinline__ void mlstm_gates(Frame& F, int j, int t0, int h, float& bcum, float& ib) {
    const float* SG = (const float*)(F.ws + WS_SG);
    ib = SG[(size_t)(t0 + F.lane) * 16 + h] + KIN(I_IB)[j * 4 + h];
    bcum = wave_scan_sum(logsigmoid_f(SG[(size_t)(t0 + F.lane) * 16 + 4 + h] + KIN(I_FB)[j * 4 + h]), F.lane);
}
__device__ __forceinline__ void o1_local(Frame& F, int j) {
    const bf16* P = (const bf16*)(F.ws + WS_R1); float* KLOC = (float*)(F.ws + WS_R2); float* NLOC = (float*)(F.ws + WS_NLOC); float* MLOC = (float*)(F.ws + WS_MLOC); float* BLAST = (float*)(F.ws + WS_BLAST);
    LAS float* kw = (LAS float*)F.lds; LAS float* Vs = (LAS float*)(F.lds + 32768); LAS float* wk = (LAS float*)(F.lds + SMALL_OFF);
    for (int u = F.vcu; u < 1024; u += F.G) {
        const int b = u >> 7, h = (u >> 5) & 3, c = u & 31, t0 = b * SEQ + c * 64;
        __syncthreads();
        if (F.wave == 0) { float bcum, ib; mlstm_gates(F, j, t0, h, bcum, ib); const float blast = __shfl(bcum, 63); const float gl = blast - bcum + ib; const float ml = wave_max(gl);
            wk[F.lane] = expf(gl - ml); if (F.lane == 0) { MLOC[u] = ml; BLAST[u] = blast; } }
        __syncthreads();
        for (int i = F.tid; i < 64 * 64; i += 512) { const int s = i >> 6, dd = (i & 63) * 2; const float w = wk[s];
            const unsigned kv = *(const unsigned*)(P + (size_t)(t0 + s) * NPO + 512 + h * 128 + dd), vv = *(const unsigned*)(P + (size_t)(t0 + s) * NPO + 1024 + h * 128 + dd);
            kw[s * 128 + dd] = bflo(kv) * w; kw[s * 128 + dd + 1] = bfhi(kv) * w; Vs[s * 128 + dd] = bflo(vv); Vs[s * 128 + dd + 1] = bfhi(vv); }
        __syncthreads();
        const int v = F.tid & 127, d0 = 32 * (F.tid >> 7); float acc[32];
#pragma unroll
        for (int i = 0; i < 32; ++i) acc[i] = 0.f;
#pragma unroll 1
        for (int s = 0; s < 64; ++s) { const float vv = Vs[s * 128 + v];
#pragma unroll
            for (int di = 0; di < 32; di += 4) { const f32x4 k4 = *(const LAS f32x4*)(kw + s * 128 + d0 + di);
#pragma unroll
                for (int i = 0; i < 4; ++i) acc[di + i] += k4[i] * vv; } }
        float* dst = KLOC + (size_t)u * 16384;
#pragma unroll
        for (int i = 0; i < 32; ++i) dst[(d0 + i) * 128 + v] = acc[i];
        if (F.tid < 128) { float a = 0.f; for (int s = 0; s < 64; ++s) a += kw[s * 128 + F.tid]; NLOC[(size_t)u * 128 + F.tid] = a; }
    }
}
__device__ __forceinline__ void o2_scan(Frame& F) {
    float* KLOC = (float*)(F.ws + WS_R2); float* NLOC = (float*)(F.ws + WS_NLOC); const float* MLOC = (const float*)(F.ws + WS_MLOC); const float* BLAST = (const float*)(F.ws + WS_BLAST); float* MPREV = (float*)(F.ws + WS_MPREV);
    constexpr int PER = 16384 + 128;
    for (int e = F.vcu * 512 + F.tid; e < 32 * PER; e += F.G * 512) {
        const int bh = e / PER, r = e % PER; float run = 0.f, m = 0.f;
        for (int c = 0; c < 32; ++c) { const int u = bh * 32 + c; float* p = r < 16384 ? KLOC + (size_t)u * 16384 + r : NLOC + (size_t)u * 128 + (r - 16384);
            const float loc = *p; *p = run; if (r == 0) MPREV[u] = m;
            const float bl = BLAST[u], ml = MLOC[u], mn = fmaxf(bl + m, ml);
            run = expf(bl + m - mn) * run + expf(ml - mn) * loc; m = mn; }
    }
}
__device__ __forceinline__ void o3_output(Frame& F, int j) {
    const bf16* P = (const bf16*)(F.ws + WS_R1); const float* CPREV = (const float*)(F.ws + WS_R2); const float* NPREV = (const float*)(F.ws + WS_NLOC); const float* MPREV = (const float*)(F.ws + WS_MPREV); bf16* MIX = (bf16*)(F.ws + WS_MIX);
    LAS float* qT = (LAS float*)F.lds;
    LAS float* kT = (LAS float*)(F.lds + 32768);
    LAS float* Vs = (LAS float*)(F.lds + 65536);
    LAS float* WT = (LAS float*)(F.lds + 98304);
    LAS float* sm = (LAS float*)(F.lds + SMALL_OFF);
    for (int u = F.vcu; u < 1024; u += F.G) {
        const int b = u >> 7, h = (u >> 5) & 3, c = u & 31, t0 = b * SEQ + c * 64;
        __syncthreads();
        if (F.wave == 0) { float bcum, ib; mlstm_gates(F, j, t0, h, bcum, ib); const float mprev = MPREV[u];
            const float pm = wave_scan_max(ib - bcum, F.lane); const float inter = bcum + mprev; const float mt = fmaxf(bcum + pm, inter);
            sm[F.lane] = bcum; sm[64 + F.lane] = ib; sm[128 + F.lane] = mt; sm[192 + F.lane] = expf(inter - mt); }
        for (int i = F.tid; i < 64 * 64; i += 512) { const int s = i >> 6, dd = (i & 63) * 2; const bf16* pr = P + (size_t)(t0 + s) * NPO + h * 128 + dd;
            const unsigned qv = *(const unsigned*)pr, kv = *(const unsigned*)(pr + 512), vv = *(const unsigned*)(pr + 1024);
            qT[dd * 64 + s] = bflo(qv); qT[(dd + 1) * 64 + s] = bfhi(qv); kT[dd * 64 + s] = bflo(kv); kT[(dd + 1) * 64 + s] = bfhi(kv); Vs[s * 128 + dd] = bflo(vv); Vs[s * 128 + dd + 1] = bfhi(vv); }
        __syncthreads();
        { const int s = F.lane, l0 = 8 * F.wave; float acc[8];
#pragma unroll
            for (int i = 0; i < 8; ++i) acc[i] = 0.f;
#pragma unroll 2
            for (int d = 0; d < 128; ++d) { const float kk = kT[d * 64 + s]; const f32x4 q0 = *(const LAS f32x4*)(qT + d * 64 + l0), q1 = *(const LAS f32x4*)(qT + d * 64 + l0 + 4);
#pragma unroll
                for (int i = 0; i < 4; ++i) { acc[i] += q0[i] * kk; acc[4 + i] += q1[i] * kk; } }
            const float gs = sm[64 + s] - sm[s];
#pragma unroll
            for (int i = 0; i < 8; ++i) { const int l = l0 + i; const float w = (s <= l) ? acc[i] * expf(sm[l] + gs - sm[128 + l]) : 0.f; WT[s * 64 + l] = w; const float dsum = wave_sum(w); if (F.lane == 0) sm[256 + l] = dsum; } }
        __syncthreads();
        if (F.tid < 64) { const int l = F.tid; float qn = 0.f; const float* np = NPREV + (size_t)u * 128; for (int d = 0; d < 128; ++d) qn += qT[d * 64 + l] * np[d]; sm[256 + l] += sm[192 + l] * qn; }
        const int v = F.tid & 127, l0 = 16 * (F.tid >> 7); float acc[16];
#pragma unroll
        for (int i = 0; i < 16; ++i) acc[i] = 0.f;
        { const float* cp = CPREV + (size_t)u * 16384;
#pragma unroll 2
            for (int d = 0; d < 128; ++d) { const float cc = cp[d * 128 + v];
#pragma unroll
                for (int li = 0; li < 16; li += 4) { const f32x4 q4 = *(const LAS f32x4*)(qT + d * 64 + l0 + li);
#pragma unroll
                    for (int i = 0; i < 4; ++i) acc[li + i] += q4[i] * cc; } } }
#pragma unroll
        for (int i = 0; i < 16; ++i) acc[i] *= sm[192 + l0 + i];
#pragma unroll 2
        for (int s = 0; s < 64; ++s) { const float vv = Vs[s * 128 + v];
#pragma unroll
            for (int li = 0; li < 16; li += 4) { const f32x4 w4 = *(const LAS f32x4*)(WT + s * 64 + l0 + li);
#pragma unroll
                for (int i = 0; i < 4; ++i) acc[li + i] += w4[i] * vv; } }
        __syncthreads();
        LAS float* hb = kT;
#pragma unroll
        for (int i = 0; i < 16; ++i) { const int l = l0 + i; const float hv = acc[i] / fmaxf(fabsf(sm[256 + l]), expf(-sm[128 + l])); acc[i] = hv; hb[l * 128 + v] = hv; }
        __syncthreads();
        { const int lb = 8 * F.wave;
#pragma unroll
            for (int i = 0; i < 8; ++i) { const int l = lb + i; const float a = hb[l * 128 + F.lane], bq = hb[l * 128 + 64 + F.lane]; const float mu = wave_sum(a + bq) * (1.f / 128.f);
                const float da = a - mu, db = bq - mu; const float var = wave_sum(da * da + db * db) * (1.f / 128.f); if (F.lane == 0) { sm[320 + l] = mu; sm[384 + l] = 1.0f / sqrtf(var + LN_EPS); } } }
        __syncthreads();
        const float hw = KIN(I_HNW)[j * 512 + h * 128 + v];
#pragma unroll
        for (int i = 0; i < 16; ++i) { const int l = l0 + i; const float og = sigmoid_f(bf2f(P[(size_t)(t0 + l) * NPO + 1536 + h * 128 + v]));
            MIX[(size_t)(t0 + l) * D + h * 128 + v] = (bf16)f2bf(og * (acc[i] - sm[320 + l]) * sm[384 + l] * hw); }
    }
}
__device__ __forceinline__ void o4_fox(Frame& F) {
    const bf16* P = (const bf16*)(F.ws + WS_R1); const float* FOXC = (const float*)(F.ws + WS_FOXC); bf16* MIX = (bf16*)(F.ws + WS_MIX);
    LAS float* QT = (LAS float*)F.lds;
    LAS float* KT = (LAS float*)(F.lds + 16384);
    LAS float* Vs = (LAS float*)(F.lds + 32768);
    LAS float* PT = (LAS float*)(F.lds + 49152) + F.wave * 512;
    LAS float* cq = (LAS float*)(F.lds + SMALL_OFF); LAS float* ck = cq + 64;
    for (int it = F.vcu; it < 2048; it += F.G) {
        const int qt = 31 - (it >> 6), bh = it & 63, b = bh >> 3, h = bh & 7, tq0 = b * SEQ + qt * 64;
        __syncthreads();
        for (int i = F.tid; i < 64 * 32; i += 512) { const int q = i >> 5, dd = (i & 31) * 2; const unsigned w = *(const unsigned*)(P + (size_t)(tq0 + q) * NPO + 2048 + h * 64 + dd); QT[dd * 64 + q] = bflo(w); QT[(dd + 1) * 64 + q] = bfhi(w); }
        if (F.tid < 64) cq[F.tid] = FOXC[(size_t)bh * SEQ + qt * 64 + F.tid];
        const int q0 = 8 * F.wave; float mrun[8], lrun[8], o[8];
#pragma unroll
        for (int i = 0; i < 8; ++i) { mrun[i] = -INFINITY; lrun[i] = 0.f; o[i] = 0.f; }
#pragma unroll 1
        for (int kt = 0; kt <= qt; ++kt) { const int tk0 = b * SEQ + kt * 64;
            __syncthreads();
            for (int i = F.tid; i < 64 * 32; i += 512) { const int k = i >> 5, dd = (i & 31) * 2; const bf16* pr = P + (size_t)(tk0 + k) * NPO + h * 64 + dd; const unsigned kw = *(const unsigned*)(pr + 2560), vw = *(const unsigned*)(pr + 3072);
                KT[dd * 64 + k] = bflo(kw); KT[(dd + 1) * 64 + k] = bfhi(kw); Vs[k * 64 + dd] = bflo(vw); Vs[k * 64 + dd + 1] = bfhi(vw); }
            if (F.tid < 64) ck[F.tid] = FOXC[(size_t)bh * SEQ + kt * 64 + F.tid];
            __syncthreads();
            float s[8];
#pragma unroll
            for (int i = 0; i < 8; ++i) s[i] = 0.f;
#pragma unroll 2
            for (int d = 0; d < 64; ++d) { const float kk = KT[d * 64 + F.lane]; const f32x4 qa = *(const LAS f32x4*)(QT + d * 64 + q0), qb = *(const LAS f32x4*)(QT + d * 64 + q0 + 4);
#pragma unroll
                for (int i = 0; i < 4; ++i) { s[i] += qa[i] * kk; s[4 + i] += qb[i] * kk; } }
            const float ckv = ck[F.lane];
#pragma unroll
            for (int i = 0; i < 8; ++i) { float sv = s[i] + cq[q0 + i] - ckv; if (kt == qt && F.lane > q0 + i) sv = -INFINITY;
                const float mn = fmaxf(mrun[i], wave_max(sv)); const float p = exp2f(sv - mn), al = exp2f(mrun[i] - mn);
                lrun[i] = lrun[i] * al + wave_sum(p); o[i] *= al; mrun[i] = mn; PT[F.lane * 8 + i] = p; }
            LDS_WAIT(); asm volatile("" ::: "memory");
#pragma unroll 2
            for (int k = 0; k < 64; ++k) { const float vv = Vs[k * 64 + F.lane]; const f32x4 pa = *(const LAS f32x4*)(PT + k * 8), pb = *(const LAS f32x4*)(PT + k * 8 + 4);
#pragma unroll
                for (int i = 0; i < 4; ++i) { o[i] += pa[i] * vv; o[4 + i] += pb[i] * vv; } }
        }
#pragma unroll
        for (int i = 0; i < 8; ++i) MIX[(size_t)(tq0 + q0 + i) * D + 512 + h * 64 + F.lane] = (bf16)f2bf(o[i] / lrun[i]);
    }
}
typedef short bf16x8 __attribute__((ext_vector_type(8)));
typedef float f32x16 __attribute__((ext_vector_type(16)));
typedef __bf16 bf16x2_t __attribute__((ext_vector_type(2)));
#define MFMA32(a, b, c) __builtin_amdgcn_mfma_f32_32x32x16_bf16((a), (b), (c), 0, 0, 0)
__device__ __forceinline__ int crow(int r, int h) { return (r & 3) + 8 * (r >> 2) + 4 * h; }
__device__ __forceinline__ unsigned cvtpk(float lo, float hi) { const f32x2 v = {lo, hi}; const bf16x2_t b = __builtin_convertvector(v, bf16x2_t); return __builtin_bit_cast(unsigned, b); }
__device__ __forceinline__ bf16x8 pack8(float a0, float a1, float a2, float a3, float a4, float a5, float a6, float a7) {
    v4u p; p.x = cvtpk(a0, a1); p.y = cvtpk(a2, a3); p.z = cvtpk(a4, a5); p.w = cvtpk(a6, a7); return __builtin_bit_cast(bf16x8, p); }
__device__ __forceinline__ bf16x8 pack_step(const f32x16& x, int s) { return pack8(x[8 * s], x[8 * s + 1], x[8 * s + 2], x[8 * s + 3], x[8 * s + 4], x[8 * s + 5], x[8 * s + 6], x[8 * s + 7]); }
__device__ __forceinline__ bf16x8 ldg8_f32(const float* p) { const f32x4 a = *(const f32x4*)p, b = *(const f32x4*)(p + 4); return pack8(a[0], a[1], a[2], a[3], b[0], b[1], b[2], b[3]); }
__device__ __forceinline__ bf16x8 lds_nat(const LAS bf16* row, int ks, int h) { return *(const LAS bf16x8*)(row + 16 * ks + 8 * h); }
__device__ __forceinline__ bf16x8 lds_krow(const LAS bf16* row, int k0, int h) { const v2u lo = *(const LAS v2u*)(row + k0 + 4 * h), hi = *(const LAS v2u*)(row + k0 + 8 + 4 * h);
    v4u p; p.x = lo.x; p.y = lo.y; p.z = hi.x; p.w = hi.y; return __builtin_bit_cast(bf16x8, p); }
__device__ __forceinline__ f32x16 zero16() { f32x16 z;
#pragma unroll
    for (int i = 0; i < 16; ++i) z[i] = 0.f;
    return z; }

__device__ __forceinline__ void ssd_gates4(Frame& F, int j, int t0, int g, LAS float* DT, LAS float* ACS) {
    if (F.wave < 4) { const int h = 4 * g + F.wave; const float* SG = (const float*)(F.ws + WS_SG); const float dtb = KIN(I_DTB)[j * 16 + h], aneg = -expf(KIN(I_ALOG)[j * 16 + h]);
        const float d0 = softplus_f(SG[(size_t)(t0 + 2 * F.lane) * 16 + h] + dtb), d1 = softplus_f(SG[(size_t)(t0 + 2 * F.lane + 1) * 16 + h] + dtb);
        const float a0 = d0 * aneg, a1 = d1 * aneg; const float inc = wave_scan_sum(a0 + a1, F.lane);
        DT[F.wave * 128 + 2 * F.lane] = d0; DT[F.wave * 128 + 2 * F.lane + 1] = d1; ACS[F.wave * 128 + 2 * F.lane] = inc - a1; ACS[F.wave * 128 + 2 * F.lane + 1] = inc; }
}
__device__ __forceinline__ void ssd_stage_xt(Frame& F, const bf16* XBC, int t0, int g, LAS bf16* XT, const LAS float* WGT) {
    for (int i = F.tid; i < 2048; i += 512) { const int cp = i & 127, s0 = 8 * (i >> 7), hl = cp >> 5; float a[8], bq[8];
#pragma unroll
        for (int k = 0; k < 8; ++k) { const unsigned w = *(const unsigned*)(XBC + (size_t)(t0 + s0 + k) * 1536 + g * 256 + 2 * cp); const float wg = WGT[hl * 128 + s0 + k]; a[k] = bflo(w) * wg; bq[k] = bfhi(w) * wg; }
        *(LAS bf16x8*)(XT + (2 * cp) * 136 + s0) = pack8(a[0], a[1], a[2], a[3], a[4], a[5], a[6], a[7]);
        *(LAS bf16x8*)(XT + (2 * cp + 1) * 136 + s0) = pack8(bq[0], bq[1], bq[2], bq[3], bq[4], bq[5], bq[6], bq[7]); }
}
__device__ __forceinline__ void e1_states_mfma(Frame& F, int j) {
    const bf16* XBC = (const bf16*)(F.ws + WS_R3); float* ST = (float*)(F.ws + WS_R4); float* DEC = (float*)(F.ws + WS_DEC);
    LAS bf16* XT = (LAS bf16*)F.lds; LAS bf16* BT = (LAS bf16*)(F.lds + 69632);
    LAS float* DT = (LAS float*)(F.lds + 98304); LAS float* ACS = DT + 512; LAS float* WGT = DT + 1024;
    for (int u = F.vcu; u < 512; u += F.G) {
        const int b = u >> 6, c = (u >> 2) & 15, g = u & 3, t0 = b * SEQ + c * 128;
        __syncthreads();
        ssd_gates4(F, j, t0, g, DT, ACS);
        { const int np = F.tid & 31, l0 = 8 * (F.tid >> 5); float a[8], bq[8];
#pragma unroll
            for (int k = 0; k < 8; ++k) { const unsigned w = *(const unsigned*)(XBC + (size_t)(t0 + l0 + k) * 1536 + 1024 + g * 64 + 2 * np); a[k] = bflo(w); bq[k] = bfhi(w); }
            *(LAS bf16x8*)(BT + (2 * np) * 136 + l0) = pack8(a[0], a[1], a[2], a[3], a[4], a[5], a[6], a[7]);
            *(LAS bf16x8*)(BT + (2 * np + 1) * 136 + l0) = pack8(bq[0], bq[1], bq[2], bq[3], bq[4], bq[5], bq[6], bq[7]); }
        __syncthreads();
        { const int hl = F.tid >> 7, l = F.tid & 127; WGT[F.tid] = expf(ACS[hl * 128 + 127] - ACS[F.tid]) * DT[F.tid]; if (l == 127) DEC[(b * 16 + c) * 16 + 4 * g + hl] = expf(ACS[F.tid]); }
        __syncthreads();
        ssd_stage_xt(F, XBC, t0, g, XT, WGT);
        __syncthreads();
        const int hl = F.wave >> 1, nt = F.wave & 1, li = F.lane & 31, hh = F.lane >> 5;
        f32x16 acc0 = zero16(), acc1 = zero16();
        const LAS bf16* ar0 = XT + (hl * 64 + li) * 136; const LAS bf16* ar1 = ar0 + 32 * 136; const LAS bf16* br = BT + (32 * nt + li) * 136;
#pragma unroll
        for (int ks = 0; ks < 8; ++ks) { const bf16x8 bf = lds_nat(br, ks, hh); acc0 = MFMA32(lds_nat(ar0, ks, hh), bf, acc0); acc1 = MFMA32(lds_nat(ar1, ks, hh), bf, acc1); }
        float* dst = ST + (size_t)((b * 16 + c) * 16 + 4 * g + hl) * 4096 + 32 * nt + li;
#pragma unroll
        for (int r = 0; r < 16; ++r) { dst[crow(r, hh) * 64] = acc0[r]; dst[(32 + crow(r, hh)) * 64] = acc1[r]; }
    }
}
__device__ __forceinline__ void e3_output_mfma(Frame& F, int j) {
    const bf16* XBC = (const bf16*)(F.ws + WS_R3); const float* ST = (const float*)(F.ws + WS_R4); float* Y = (float*)(F.ws + WS_R2);
    LAS bf16* CR = (LAS bf16*)F.lds; LAS bf16* BR = (LAS bf16*)(F.lds + 18432); LAS bf16* XT = (LAS bf16*)(F.lds + 36864);
    LAS float* DT = (LAS float*)(F.lds + 106496); LAS float* ACS = DT + 512;
    for (int u = F.vcu; u < 512; u += F.G) {
        const int b = u >> 6, c = (u >> 2) & 15, g = u & 3, t0 = b * SEQ + c * 128;
        __syncthreads();
        ssd_gates4(F, j, t0, g, DT, ACS);
        for (int i = F.tid; i < 1024; i += 512) { const int l = i >> 3, ch = i & 7; const bf16* src = XBC + (size_t)(t0 + l) * 1536 + 1024 + g * 64 + 8 * ch;
            *(LAS v4u*)(BR + l * 72 + 8 * ch) = *(const v4u*)src; *(LAS v4u*)(CR + l * 72 + 8 * ch) = *(const v4u*)(src + 256); }
        __syncthreads();
        ssd_stage_xt(F, XBC, t0, g, XT, DT);
        __syncthreads();
        const int hl = F.wave >> 1, half = F.wave & 1, li = F.lane & 31, hh = F.lane >> 5, habs = 4 * g + hl;
        const LAS float* acs = ACS + hl * 128; const LAS float* dtl = DT + hl * 128;
        bf16x8 hp[2][4];
        { const float* hsrc = ST + (size_t)((b * 16 + c) * 16 + habs) * 4096;
#pragma unroll
            for (int pt = 0; pt < 2; ++pt)
#pragma unroll
                for (int ks = 0; ks < 4; ++ks) hp[pt][ks] = ldg8_f32(hsrc + (32 * pt + li) * 64 + 16 * ks + 8 * hh); }
        const float dsk = KIN(I_DSKIP)[j * 16 + habs];
#pragma unroll
        for (int q = 0; q < 2; ++q) { const int lt = half ? 1 + q : 3 * q;
            f32x16 acc[2]; acc[0] = zero16(); acc[1] = zero16();
            const LAS bf16* crl = CR + (32 * lt + li) * 72;
#pragma unroll
            for (int ks = 0; ks < 4; ++ks) { const bf16x8 cf = lds_nat(crl, ks, hh); acc[0] = MFMA32(cf, hp[0][ks], acc[0]); acc[1] = MFMA32(cf, hp[1][ks], acc[1]); }
#pragma unroll
            for (int a4 = 0; a4 < 4; ++a4) { const f32x4 av = *(const LAS f32x4*)(acs + 32 * lt + 8 * a4 + 4 * hh);
#pragma unroll
                for (int i = 0; i < 4; ++i) { const float e = expf(av[i]); acc[0][4 * a4 + i] *= e; acc[1][4 * a4 + i] *= e; } }
            const float acl = acs[32 * lt + li];
            for (int st = 0; st <= lt; ++st) {
                f32x16 gt = zero16(); const LAS bf16* brs = BR + (32 * st + li) * 72;
#pragma unroll
                for (int ks = 0; ks < 4; ++ks) gt = MFMA32(lds_nat(brs, ks, hh), lds_nat(crl, ks, hh), gt);
#pragma unroll
                for (int a4 = 0; a4 < 4; ++a4) { const f32x4 av = *(const LAS f32x4*)(acs + 32 * st + 8 * a4 + 4 * hh);
#pragma unroll
                    for (int i = 0; i < 4; ++i) { const int r = 4 * a4 + i; const float e = expf(acl - av[i]); gt[r] = (st < lt || crow(r, hh) <= li) ? gt[r] * e : 0.f; } }
                const bf16x8 g0 = pack_step(gt, 0), g1 = pack_step(gt, 1);
#pragma unroll
                for (int pt = 0; pt < 2; ++pt) { const LAS bf16* xr = XT + (hl * 64 + 32 * pt + li) * 136 + 32 * st;
                    acc[pt] = MFMA32(g0, lds_krow(xr, 0, hh), acc[pt]); acc[pt] = MFMA32(g1, lds_krow(xr, 16, hh), acc[pt]); } }
#pragma unroll
            for (int pt = 0; pt < 2; ++pt) { const LAS bf16* xr = XT + (hl * 64 + 32 * pt + li) * 136 + 32 * lt; float* yp = Y + (size_t)(t0 + 32 * lt) * D + habs * 64 + 32 * pt + li;
#pragma unroll
                for (int r = 0; r < 16; ++r) { const int l = crow(r, hh); yp[(size_t)l * D] = acc[pt][r] + dsk * bf2f(xr[l]) / dtl[32 * lt + l]; } }
        }
    }
}
__device__ __forceinline__ void mlstm_stage_t(Frame& F, const bf16* P, int t0, int col0, LAS bf16* DST, const LAS float* wk) {
    const int vp = F.tid & 63, s0 = 8 * (F.tid >> 6); float a[8], bq[8];
#pragma unroll
    for (int k = 0; k < 8; ++k) { const unsigned w = *(const unsigned*)(P + (size_t)(t0 + s0 + k) * NPO + col0 + 2 * vp); const float wg = wk ? wk[s0 + k] : 1.f; a[k] = bflo(w) * wg; bq[k] = bfhi(w) * wg; }
    *(LAS bf16x8*)(DST + (2 * vp) * 72 + s0) = pack8(a[0], a[1], a[2], a[3], a[4], a[5], a[6], a[7]);
    *(LAS bf16x8*)(DST + (2 * vp + 1) * 72 + s0) = pack8(bq[0], bq[1], bq[2], bq[3], bq[4], bq[5], bq[6], bq[7]);
}
__device__ __forceinline__ void o1_local_mfma(Frame& F, int j) {
    const bf16* P = (const bf16*)(F.ws + WS_R1); float* KLOC = (float*)(F.ws + WS_R2); float* NLOC = (float*)(F.ws + WS_NLOC); float* MLOC = (float*)(F.ws + WS_MLOC); float* BLAST = (float*)(F.ws + WS_BLAST);
    LAS bf16* VT = (LAS bf16*)F.lds; LAS bf16* KWT = (LAS bf16*)(F.lds + 18432); LAS float* wk = (LAS float*)(F.lds + SMALL_OFF);
    for (int u = F.vcu; u < 1024; u += F.G) {
        const int b = u >> 7, h = (u >> 5) & 3, c = u & 31, t0 = b * SEQ + c * 64;
        __syncthreads();
        if (F.wave == 0) { float bcum, ib; mlstm_gates(F, j, t0, h, bcum, ib); const float blast = __shfl(bcum, 63); const float gl = blast - bcum + ib; const float ml = wave_max(gl);
            wk[F.lane] = expf(gl - ml); if (F.lane == 0) { MLOC[u] = ml; BLAST[u] = blast; } }
        mlstm_stage_t(F, P, t0, 1024 + h * 128, VT, nullptr);
        __syncthreads();
        mlstm_stage_t(F, P, t0, 512 + h * 128, KWT, wk);
        __syncthreads();
        const int vt = F.wave >> 1, dh = F.wave & 1, li = F.lane & 31, hh = F.lane >> 5;
        f32x16 acc0 = zero16(), acc1 = zero16();
        const LAS bf16* ar = VT + (32 * vt + li) * 72; const LAS bf16* b0 = KWT + (64 * dh + li) * 72; const LAS bf16* b1 = b0 + 32 * 72;
#pragma unroll
        for (int ks = 0; ks < 4; ++ks) { const bf16x8 af = lds_nat(ar, ks, hh); acc0 = MFMA32(af, lds_nat(b0, ks, hh), acc0); acc1 = MFMA32(af, lds_nat(b1, ks, hh), acc1); }
        float* dst = KLOC + (size_t)u * 16384 + (size_t)(32 * vt) * 128 + 64 * dh + li;
#pragma unroll
        for (int r = 0; r < 16; ++r) { dst[crow(r, hh) * 128] = acc0[r]; dst[crow(r, hh) * 128 + 32] = acc1[r]; }
        if (F.tid < 128) { float a = 0.f; const LAS bf16* kr = KWT + F.tid * 72;
#pragma unroll
            for (int s8 = 0; s8 < 8; ++s8) { const v4u w = *(const LAS v4u*)(kr + 8 * s8); a += (bflo(w.x) + bfhi(w.x)) + (bflo(w.y) + bfhi(w.y)) + (bflo(w.z) + bfhi(w.z)) + (bflo(w.w) + bfhi(w.w)); }
            NLOC[(size_t)u * 128 + F.tid] = a; }
    }
}
__device__ __forceinline__ void o3_output_mfma(Frame& F, int j) {
    const bf16* P = (const bf16*)(F.ws + WS_R1); const float* CPREV = (const float*)(F.ws + WS_R2); const float* NPREV = (const float*)(F.ws + WS_NLOC); const float* MPREV = (const float*)(F.ws + WS_MPREV); bf16* MIX = (bf16*)(F.ws + WS_MIX);
    LAS bf16* QR = (LAS bf16*)F.lds;
    LAS bf16* KR = (LAS bf16*)(F.lds + 17408);
    LAS bf16* VT = (LAS bf16*)(F.lds + 34816);
    LAS float* OST = (LAS float*)(F.lds + 53248);
    LAS float* sm = (LAS float*)(F.lds + 98304);
    for (int u = F.vcu; u < 1024; u += F.G) {
        const int b = u >> 7, h = (u >> 5) & 3, c = u & 31, t0 = b * SEQ + c * 64;
        __syncthreads();
        if (F.wave == 0) { float bcum, ib; mlstm_gates(F, j, t0, h, bcum, ib); const float mprev = MPREV[u];
            const float pm = wave_scan_max(ib - bcum, F.lane); const float inter = bcum + mprev; const float mt = fmaxf(bcum + pm, inter);
            sm[F.lane] = bcum; sm[64 + F.lane] = ib; sm[128 + F.lane] = mt; sm[192 + F.lane] = expf(inter - mt); }
        for (int i = F.tid; i < 1024; i += 512) { const int l = i >> 4, ch = i & 15; const bf16* src = P + (size_t)(t0 + l) * NPO + h * 128 + 8 * ch;
            *(LAS v4u*)(QR + l * 136 + 8 * ch) = *(const v4u*)src; *(LAS v4u*)(KR + l * 136 + 8 * ch) = *(const v4u*)(src + 512); }
        mlstm_stage_t(F, P, t0, 1024 + h * 128, VT, nullptr);
        __syncthreads();
        if (F.wave == 1) { const int l = F.lane; const float* np = NPREV + (size_t)u * 128; float qn = 0.f;
#pragma unroll 4
            for (int d8 = 0; d8 < 16; ++d8) { const v4u w = *(const LAS v4u*)(QR + l * 136 + 8 * d8); const f32x4 n0 = *(const f32x4*)(np + 8 * d8), n1 = *(const f32x4*)(np + 8 * d8 + 4);
                qn += (bflo(w.x) * n0[0] + bfhi(w.x) * n0[1]) + (bflo(w.y) * n0[2] + bfhi(w.y) * n0[3]) + (bflo(w.z) * n1[0] + bfhi(w.z) * n1[1]) + (bflo(w.w) * n1[2] + bfhi(w.w) * n1[3]); }
            sm[256 + l] = qn; }
        const int lt = F.wave >> 2, vt = F.wave & 3, li = F.lane & 31, hh = F.lane >> 5, l = 32 * lt + li;
        const float bcl = sm[l], mtl = sm[128 + l], sil = sm[192 + l];
        f32x16 acc = zero16();
        const LAS bf16* qrl = QR + l * 136;
        { const float* cp = CPREV + (size_t)u * 16384 + (size_t)(32 * vt + li) * 128;
#pragma unroll
            for (int ks = 0; ks < 8; ++ks) acc = MFMA32(ldg8_f32(cp + 16 * ks + 8 * hh), lds_nat(qrl, ks, hh), acc); }
#pragma unroll
        for (int r = 0; r < 16; ++r) acc[r] *= sil;
        float dsum = 0.f;
        for (int st = 0; st <= lt; ++st) {
            f32x16 wt = zero16(); const LAS bf16* krs = KR + (32 * st + li) * 136;
#pragma unroll
            for (int ks = 0; ks < 8; ++ks) wt = MFMA32(lds_nat(krs, ks, hh), lds_nat(qrl, ks, hh), wt);
#pragma unroll
            for (int a4 = 0; a4 < 4; ++a4) { const f32x4 bs = *(const LAS f32x4*)(sm + 32 * st + 8 * a4 + 4 * hh), is = *(const LAS f32x4*)(sm + 64 + 32 * st + 8 * a4 + 4 * hh);
#pragma unroll
                for (int i = 0; i < 4; ++i) { const int r = 4 * a4 + i; const float e = expf(bcl - bs[i] + is[i] - mtl); const float w = (st < lt || crow(r, hh) <= li) ? wt[r] * e : 0.f; wt[r] = w; dsum += w; } }
            const bf16x8 w0 = pack_step(wt, 0), w1 = pack_step(wt, 1); const LAS bf16* vr = VT + (32 * vt + li) * 72 + 32 * st;
            acc = MFMA32(lds_krow(vr, 0, hh), w0, acc); acc = MFMA32(lds_krow(vr, 16, hh), w1, acc); }
        __syncthreads();
        dsum += __shfl_xor(dsum, 32);
        const float den = dsum + sil * sm[256 + l]; const float rinv = 1.0f / fmaxf(fabsf(den), expf(-mtl));
        float s1 = 0.f, s2 = 0.f;
#pragma unroll
        for (int r = 0; r < 16; ++r) { acc[r] *= rinv; s1 += acc[r]; s2 += acc[r] * acc[r]; }
        s1 += __shfl_xor(s1, 32); s2 += __shfl_xor(s2, 32);
        if (hh == 0) { sm[320 + (vt * 64 + l) * 2] = s1; sm[320 + (vt * 64 + l) * 2 + 1] = s2; }
        __syncthreads();
        { float t1 = 0.f, t2 = 0.f;
#pragma unroll
            for (int q = 0; q < 4; ++q) { t1 += sm[320 + (q * 64 + l) * 2]; t2 += sm[320 + (q * 64 + l) * 2 + 1]; }
            const float mu = t1 * (1.f / 128.f), var = fmaxf(t2 * (1.f / 128.f) - mu * mu, 0.f), rstd = 1.0f / sqrtf(var + LN_EPS);
#pragma unroll
            for (int r = 0; r < 16; ++r) OST[l * 132 + 32 * vt + crow(r, hh)] = (acc[r] - mu) * rstd; }
        __syncthreads();
        for (int i = F.tid; i < 1024; i += 512) { const int ll = i >> 4, ch = i & 15; const LAS float* os = OST + ll * 132 + 8 * ch; const f32x4 o0 = *(const LAS f32x4*)os, o1 = *(const LAS f32x4*)(os + 4);
            const v4u ow = *(const v4u*)(P + (size_t)(t0 + ll) * NPO + 1536 + h * 128 + 8 * ch); const float* hw = KIN(I_HNW) + j * 512 + h * 128 + 8 * ch; const f32x4 h0 = *(const f32x4*)hw, h1 = *(const f32x4*)(hw + 4);
            v4u res; res.x = pk2(o0[0] * h0[0] * sigmoid_f(bflo(ow.x)), o0[1] * h0[1] * sigmoid_f(bfhi(ow.x))); res.y = pk2(o0[2] * h0[2] * sigmoid_f(bflo(ow.y)), o0[3] * h0[3] * sigmoid_f(bfhi(ow.y)));
            res.z = pk2(o1[0] * h1[0] * sigmoid_f(bflo(ow.z)), o1[1] * h1[1] * sigmoid_f(bfhi(ow.z))); res.w = pk2(o1[2] * h1[2] * sigmoid_f(bflo(ow.w)), o1[3] * h1[3] * sigmoid_f(bfhi(ow.w)));
            *(v4u*)(MIX + (size_t)(t0 + ll) * D + h * 128 + 8 * ch) = res; }
    }
}
template <bool XIN> __device__ __forceinline__ void p_ln1_route(Frame& F, int layer) {
    const bf16* OUTP = (const bf16*)(F.ws + WS_R1); const bf16* HB = (const bf16*)(F.ws + WS_HB); bf16* H1B = (bf16*)(F.ws + WS_H1B);
    i32x4* ROUTE = (i32x4*)(F.ws + WS_ROUTE); f32x2* GATE = (f32x2*)(F.ws + WS_GATE); int* BCNT = (int*)(F.ws + WS_BCNT);
    LAS int* cnt = (LAS int*)(F.lds + SMALL_OFF);
    const float* g1 = KIN(I_LN1G) + (size_t)layer * D; const float* b1 = KIN(I_LN1B) + (size_t)layer * D;
    const float* rgw = KIN(I_RGW) + (size_t)layer * D * 4; const float* rgb = KIN(I_RGB) + layer * 4; const float* rew = KIN(I_REW) + (size_t)layer * 4 * D * 8; const float* reb = KIN(I_REB) + layer * 32;
    __syncthreads();
    if (F.tid < 32) cnt[F.tid] = 0;
    __syncthreads();
#pragma unroll 1
    for (int m0 = F.gw; m0 < T; m0 += 2 * F.NGW) {
        const int m1 = m0 + F.NGW < T ? m0 + F.NGW : -1; const int mm[2] = {m0, m1 >= 0 ? m1 : m0};
        f32x4 v[2][4], a[2][4];
#pragma unroll
        for (int rr = 0; rr < 2; ++rr) { if constexpr (XIN) row_load(KIN(I_X) + (size_t)mm[rr] * D, F.lane, v[rr]); else row_load_bf16(HB + (size_t)mm[rr] * D, F.lane, v[rr]); row_load_bf16(OUTP + (size_t)mm[rr] * D, F.lane, a[rr]); }
#pragma unroll
        for (int rr = 0; rr < 2; ++rr) {
#pragma unroll
            for (int jj = 0; jj < 4; ++jj) v[rr][jj] = v[rr][jj] * ALPHA + a[rr][jj];
            row_layernorm(v[rr], g1, b1, F.lane); }
        row_store_bf16(H1B + (size_t)m0 * D, F.lane, v[0]); if (m1 >= 0) row_store_bf16(H1B + (size_t)m1 * D, F.lane, v[1]);
        float gl[2][4];
#pragma unroll
        for (int c = 0; c < 4; ++c) { gl[0][c] = 0.f; gl[1][c] = 0.f; }
#pragma unroll
        for (int jj = 0; jj < 4; ++jj)
#pragma unroll
            for (int i = 0; i < 4; ++i) { const f32x4 w = *(const f32x4*)(rgw + (size_t)(256 * jj + 4 * F.lane + i) * 4);
#pragma unroll
                for (int c = 0; c < 4; ++c) { gl[0][c] += v[0][jj][i] * w[c]; gl[1][c] += v[1][jj][i] * w[c]; } }
        int gi[2]; float pg[2];
#pragma unroll
        for (int rr = 0; rr < 2; ++rr) { const float red = wave_reduce_multi<4>(gl[rr], F.lane); float l4[4];
#pragma unroll
            for (int c = 0; c < 4; ++c) l4[c] = __shfl(red, 16 * c) + rgb[c];
            int g = 0; float gm = l4[0];
#pragma unroll
            for (int c = 1; c < 4; ++c) if (l4[c] > gm) { gm = l4[c]; g = c; }
            float se = 0.f;
#pragma unroll
            for (int c = 0; c < 4; ++c) se += expf(l4[c] - gm);
            gi[rr] = g; pg[rr] = 1.0f / se; }
        float el[2][8];
#pragma unroll
        for (int rr = 0; rr < 2; ++rr) { const float* rw = rew + (size_t)gi[rr] * D * 8;
#pragma unroll
            for (int c = 0; c < 8; ++c) el[rr][c] = 0.f;
#pragma unroll
            for (int jj = 0; jj < 4; ++jj)
#pragma unroll
                for (int i = 0; i < 4; ++i) { const float* wr = rw + (size_t)(256 * jj + 4 * F.lane + i) * 8; const f32x4 w0 = *(const f32x4*)wr, w1 = *(const f32x4*)(wr + 4);
#pragma unroll
                    for (int c = 0; c < 4; ++c) { el[rr][c] += v[rr][jj][i] * w0[c]; el[rr][4 + c] += v[rr][jj][i] * w1[c]; } } }
#pragma unroll
        for (int rr = 0; rr < 2; ++rr) { const float red = wave_reduce_multi<8>(el[rr], F.lane); float e8[8];
#pragma unroll
            for (int c = 0; c < 8; ++c) e8[c] = __shfl(red, 8 * c) + reb[gi[rr] * 8 + c];
            int i0 = 0; float v0 = e8[0];
#pragma unroll
            for (int c = 1; c < 8; ++c) if (e8[c] > v0) { v0 = e8[c]; i0 = c; }
            int i1 = -1; float v1 = -INFINITY;
#pragma unroll
            for (int c = 0; c < 8; ++c) if (c != i0 && e8[c] > v1) { v1 = e8[c]; i1 = c; }
            if (i1 < 0) i1 = (i0 + 1) & 7;
            const float ee = expf(v1 - v0), g0 = pg[rr] / (1.0f + ee), g1v = pg[rr] * ee / (1.0f + ee);
            if (F.lane == 0 && (rr == 0 || m1 >= 0)) { const int e0 = gi[rr] * 8 + i0, e1 = gi[rr] * 8 + i1;
                const int r0 = __hip_atomic_fetch_add(cnt + e0, 1, __ATOMIC_RELAXED, __HIP_MEMORY_SCOPE_WORKGROUP), r1 = __hip_atomic_fetch_add(cnt + e1, 1, __ATOMIC_RELAXED, __HIP_MEMORY_SCOPE_WORKGROUP);
                ROUTE[mm[rr]] = (i32x4){e0, r0, e1, r1}; GATE[mm[rr]] = (f32x2){g0, g1v}; } }
    }
    __syncthreads();
    if (F.tid < 32) BCNT[F.vcu * 32 + F.tid] = cnt[F.tid];
}
__device__ __forceinline__ void p_scatter(Frame& F) {
    const int* BCNT = (const int*)(F.ws + WS_BCNT); int* PANEL = (int*)(F.ws + WS_PANEL); const i32x4* ROUTE = (const i32x4*)(F.ws + WS_ROUTE); i32x2* POS = (i32x2*)(F.ws + WS_POS);
    const bf16* H1B = (const bf16*)(F.ws + WS_H1B); bf16* XS = (bf16*)(F.ws + WS_R1);
    LAS int* pa = (LAS int*)(F.lds + SMALL_OFF); LAS int* pb = pa + 512; LAS int* tot = pa + 1024; LAS int* bef = pa + 1056; LAS int* base = pa + 1088;
    __syncthreads();
    { const int e = F.tid & 31, part = F.tid >> 5; int sa = 0, sb = 0;
        for (int b = part; b < F.G; b += 16) { const int c = BCNT[b * 32 + e]; sa += c; if (b < F.vcu) sb += c; }
        pa[part * 32 + e] = sa; pb[part * 32 + e] = sb; }
    __syncthreads();
    if (F.tid < 32) { int sa = 0, sb = 0; for (int p = 0; p < 16; ++p) { sa += pa[p * 32 + F.tid]; sb += pb[p * 32 + F.tid]; } tot[F.tid] = sa; bef[F.tid] = sb; }
    __syncthreads();
    if (F.tid == 0) { int off = 0, np = 0;
        for (int e = 0; e < 32; ++e) { const int npan = (tot[e] + 255) >> 8; base[e] = off + bef[e];
            if (F.vcu == 0) for (int p = 0; p < npan; ++p) PANEL[1 + np + p] = e;
            np += npan; off += npan * 256; }
        if (F.vcu == 0) PANEL[0] = np; }
    __syncthreads();
#pragma unroll 1
    for (int m0 = F.gw; m0 < T; m0 += 4 * F.NGW) {
        i32x4 r[4]; v4u w[4][2];
#pragma unroll
        for (int rr = 0; rr < 4; ++rr) { const int m = m0 + rr * F.NGW < T ? m0 + rr * F.NGW : m0; r[rr] = ROUTE[m]; const v4u* src = (const v4u*)(H1B + (size_t)m * D); w[rr][0] = src[F.lane]; w[rr][1] = src[F.lane + 64]; }
#pragma unroll
        for (int rr = 0; rr < 4; ++rr) { const int m = m0 + rr * F.NGW; if (m < T) { const int p0 = base[r[rr].x] + r[rr].y, p1 = base[r[rr].z] + r[rr].w;
            if (F.lane == 0) POS[m] = (i32x2){p0, p1};
            v4u* d0 = (v4u*)(XS + (size_t)p0 * D); v4u* d1 = (v4u*)(XS + (size_t)p1 * D);
            d0[F.lane] = w[rr][0]; d0[F.lane + 64] = w[rr][1]; d1[F.lane] = w[rr][0]; d1[F.lane + 64] = w[rr][1]; } } }
}
__device__ __forceinline__ void p_combine(Frame& F, int layer) {
    const bf16* H1B = (const bf16*)(F.ws + WS_H1B); const bf16* EOUT = (const bf16*)(F.ws + WS_R1); const i32x2* POS = (const i32x2*)(F.ws + WS_POS); const f32x2* GATE = (const f32x2*)(F.ws + WS_GATE);
    bf16* HB = (bf16*)(F.ws + WS_HB);
    const float* g2 = KIN(I_LN2G) + (size_t)layer * D; const float* b2 = KIN(I_LN2B) + (size_t)layer * D;
#pragma unroll 1
    for (int m0 = F.gw; m0 < T; m0 += 2 * F.NGW) {
        const int m1 = m0 + F.NGW < T ? m0 + F.NGW : -1; const int mm[2] = {m0, m1 >= 0 ? m1 : m0};
        f32x4 v[2][4], ea[2][4], eb[2][4]; i32x2 ps[2]; f32x2 gt[2];
#pragma unroll
        for (int rr = 0; rr < 2; ++rr) { ps[rr] = POS[mm[rr]]; gt[rr] = GATE[mm[rr]]; row_load_bf16(H1B + (size_t)mm[rr] * D, F.lane, v[rr]); }
#pragma unroll
        for (int rr = 0; rr < 2; ++rr) { row_load_bf16(EOUT + (size_t)ps[rr].x * D, F.lane, ea[rr]); row_load_bf16(EOUT + (size_t)ps[rr].y * D, F.lane, eb[rr]); }
#pragma unroll
        for (int rr = 0; rr < 2; ++rr) {
#pragma unroll
            for (int jj = 0; jj < 4; ++jj) v[rr][jj] = v[rr][jj] * ALPHA + (ea[rr][jj] * gt[rr].x + eb[rr][jj] * gt[rr].y);
            row_layernorm(v[rr], g2, b2, F.lane); }
        if (layer == DEPTH - 1) { row_store_f32(F.out + (size_t)m0 * D, F.lane, v[0]); if (m1 >= 0) row_store_f32(F.out + (size_t)m1 * D, F.lane, v[1]); }
        else { row_store_bf16(HB + (size_t)m0 * D, F.lane, v[0]); if (m1 >= 0) row_store_bf16(HB + (size_t)m1 * D, F.lane, v[1]); row_gate_proj2(F, v[0], v[1], layer + 1, m0, m1); } }
}
#ifndef PHASE_MASK
#define PHASE_MASK 0x1fff
#endif
#define PH_EN(k) (((PHASE_MASK) >> (k)) & 1)
#ifndef PROBE_DUP
#define PROBE_DUP 0
#endif
#define NREP(k) (1 + (((PROBE_DUP) >> (k)) & 1))
#define IN(k) (lo <= (k) && (k) < hi)
#define SEAM(k) do { if ((k) + 1 < hi) xcd_barrier(bar); } while (0)
template <int LAYER> __device__ __forceinline__ void layer_body(Frame& F, const int lo, const int hi, const XcdBarrier& bar) {
        constexpr int layer = LAYER, pb = 1 + LAYER * NPH_LAYER, j = LAYER >> 1; constexpr bool odd = (LAYER & 1) != 0;
        bf16* HB = (bf16*)(F.ws + WS_HB); bf16* MIX = (bf16*)(F.ws + WS_MIX);
        if constexpr (PH_EN(0)) if (IN(pb + 0)) _Pragma("unroll") for (int rep_ = 0; rep_ < NREP(0); ++rep_) { if (rep_) __syncthreads();
            const int N = odd ? NPO : NPE; const bf16* Bt = odd ? (const bf16*)(F.ws + WS_WINO) + (size_t)j * NPO * D : (const bf16*)(F.ws + WS_WINE) + (size_t)j * NPE * D;
            pg8::Gemm g{HB, Bt, T, N, D, 0}; pg8::StaticOrder S; S.init(T, N, F.G, (int)blockIdx.x);
            pg8::EpiStoreBf16 E{(bf16*)(F.ws + WS_R1), N};
            pg8::gemm_phase<pg8::EpiStoreBf16, pg8::StaticOrder, true, true>(F.lds, g, S, E);
            if (rep_ == NREP(0) - 1) SEAM(pb + 0); }
        if constexpr (!odd) {
            if constexpr (PH_EN(1)) if (IN(pb + 1)) _Pragma("unroll") for (int rep_ = 0; rep_ < NREP(1); ++rep_) { if (rep_) __syncthreads(); e0_conv(F, j); if (rep_ == NREP(1) - 1) SEAM(pb + 1); }
            if constexpr (PH_EN(2)) if (IN(pb + 2)) _Pragma("unroll") for (int rep_ = 0; rep_ < NREP(2); ++rep_) { if (rep_) __syncthreads(); if constexpr (SSD_NAIVE) e1_states(F, j); else e1_states_mfma(F, j); if (rep_ == NREP(2) - 1) SEAM(pb + 2); }
            if constexpr (PH_EN(3)) if (IN(pb + 3)) _Pragma("unroll") for (int rep_ = 0; rep_ < NREP(3); ++rep_) { if (rep_) __syncthreads(); e2_scan(F); if (rep_ == NREP(3) - 1) SEAM(pb + 3); }
            if constexpr (PH_EN(4)) if (IN(pb + 4)) _Pragma("unroll") for (int rep_ = 0; rep_ < NREP(4); ++rep_) { if (rep_) __syncthreads(); if constexpr (SSD_NAIVE) e3_output(F, j); else e3_output_mfma(F, j); if (rep_ == NREP(4) - 1) SEAM(pb + 4); }
            if constexpr (PH_EN(5)) if (IN(pb + 5)) _Pragma("unroll") for (int rep_ = 0; rep_ < NREP(5); ++rep_) { if (rep_) __syncthreads(); e4_gnorm(F); if (rep_ == NREP(5) - 1) SEAM(pb + 5); }
        } else {
            if constexpr (PH_EN(1)) if (IN(pb + 1)) _Pragma("unroll") for (int rep_ = 0; rep_ < NREP(1); ++rep_) { if (rep_) __syncthreads(); o_foxscan(F, j); if constexpr (MLSTM_NAIVE) o1_local(F, j); else o1_local_mfma(F, j); if (rep_ == NREP(1) - 1) SEAM(pb + 1); }
            if constexpr (PH_EN(2)) if (IN(pb + 2)) _Pragma("unroll") for (int rep_ = 0; rep_ < NREP(2); ++rep_) { if (rep_) __syncthreads(); o2_scan(F); if (rep_ == NREP(2) - 1) SEAM(pb + 2); }
            if constexpr (PH_EN(3)) if (IN(pb + 3)) _Pragma("unroll") for (int rep_ = 0; rep_ < NREP(3); ++rep_) { if (rep_) __syncthreads(); if constexpr (MLSTM_NAIVE) o3_output(F, j); else o3_output_mfma(F, j); if (rep_ == NREP(3) - 1) SEAM(pb + 3); }
            if constexpr (PH_EN(4)) if (IN(pb + 4)) _Pragma("unroll") for (int rep_ = 0; rep_ < NREP(4); ++rep_) { if (rep_) __syncthreads();
#if FOX_NAIVE
                o4_fox(F);
#else
                const attn_body::bf16* PR = (const attn_body::bf16*)(F.ws + WS_R1);
                const attn_body::AttnTensors AT{PR + 2048, PR + 2560, PR + 3072, (attn_body::bf16*)(F.ws + WS_MIX) + 512, (const float*)(F.ws + WS_FOXC)};
                const attn_body::StaticOrder S((int)F.G, F.vcu);
                attn_body::attn_phase<attn_body::StaticOrder>((char*)F.lds, AT, S);
#endif
                if (rep_ == NREP(4) - 1) SEAM(pb + 4); }
            if constexpr (PH_EN(5)) if (IN(pb + 5)) _Pragma("unroll") for (int rep_ = 0; rep_ < NREP(5); ++rep_) { if (rep_) __syncthreads(); if (rep_ == NREP(5) - 1) SEAM(pb + 5); }
        }
        if constexpr (PH_EN(6)) if (IN(pb + 6)) _Pragma("unroll") for (int rep_ = 0; rep_ < NREP(6); ++rep_) { if (rep_) __syncthreads();
            const int K = odd ? D : 1536; const bf16* Bt = odd ? (const bf16*)(F.ws + WS_WOUTO) + (size_t)j * D * D : (const bf16*)(F.ws + WS_WOUTE) + (size_t)j * D * 1536;
            pg8::Gemm g{MIX, Bt, T, D, K, 0}; pg8::StaticOrder S; S.init(T, D, F.G, (int)blockIdx.x);
            pg8::EpiStoreBf16 E{(bf16*)(F.ws + WS_R1), D};
            pg8::gemm_phase<pg8::EpiStoreBf16, pg8::StaticOrder, false, true>(F.lds, g, S, E);
            if (rep_ == NREP(6) - 1) SEAM(pb + 6); }
        if constexpr (PH_EN(7)) if (IN(pb + 7)) _Pragma("unroll") for (int rep_ = 0; rep_ < NREP(7); ++rep_) { if (rep_) __syncthreads(); p_ln1_route<LAYER == 0>(F, layer); if (rep_ == NREP(7) - 1) SEAM(pb + 7); }
        if constexpr (PH_EN(8)) if (IN(pb + 8)) _Pragma("unroll") for (int rep_ = 0; rep_ < NREP(8); ++rep_) { if (rep_) __syncthreads(); p_scatter(F); if (rep_ == NREP(8) - 1) SEAM(pb + 8); }
        if constexpr (PH_EN(9)) if (IN(pb + 9)) _Pragma("unroll") for (int rep_ = 0; rep_ < NREP(9); ++rep_) { if (rep_) __syncthreads();
            pg8::Gemm g{(const bf16*)(F.ws + WS_R1), (const bf16*)(F.ws + WS_WGU) + (size_t)layer * 32 * D * D, RPAD, D, D, (size_t)D * D * 2};
            pg8::MoeOrder S; S.initm((const int*)(F.ws + WS_PANEL), 4, F.G, (int)blockIdx.x);
            pg8::EpiSwiglu E{(bf16*)(F.ws + WS_R3), 512};
            pg8::gemm_phase<pg8::EpiSwiglu, pg8::MoeOrder, true, true>(F.lds, g, S, E);
            if (rep_ == NREP(9) - 1) SEAM(pb + 9); }
        if constexpr (PH_EN(10)) if (IN(pb + 10)) _Pragma("unroll") for (int rep_ = 0; rep_ < NREP(10); ++rep_) { if (rep_) __syncthreads();
            pg8::Gemm g{(const bf16*)(F.ws + WS_R3), (const bf16*)(F.ws + WS_WD) + (size_t)layer * 32 * D * 512, RPAD, D, 512, (size_t)D * 512 * 2};
            pg8::MoeOrder S; S.initm((const int*)(F.ws + WS_PANEL), 4, F.G, (int)blockIdx.x);
            pg8::EpiStoreBf16 E{(bf16*)(F.ws + WS_R1), D};
            pg8::gemm_phase<pg8::EpiStoreBf16, pg8::MoeOrder, true, true>(F.lds, g, S, E);
            if (rep_ == NREP(10) - 1) SEAM(pb + 10); }
        if constexpr (PH_EN(11)) if (IN(pb + 11)) _Pragma("unroll") for (int rep_ = 0; rep_ < NREP(11); ++rep_) { if (rep_) __syncthreads(); p_combine(F, layer); if (rep_ == NREP(11) - 1) SEAM(pb + 11); }
}
struct Args { const float* in[27]; float* out; unsigned char* ws; int ph_lo, ph_hi; };
__global__ void __launch_bounds__(NWAVES * 64, 2) fwd_kernel(Args args) {
    extern __shared__ __attribute__((aligned(16))) unsigned char lds[];
    Frame F;
    F.lds = (LAS unsigned char*)lds;
    F.MISC = (volatile LAS unsigned*)(F.lds + MISC_OFF);
    F.tid = threadIdx.x; F.lane = F.tid & 63; F.wave = __builtin_amdgcn_readfirstlane(F.tid >> 6);
    F.G = gridDim.x; { const int bx = blockIdx.x; F.vcu = (F.G % 8 == 0) ? (bx % 8) * (F.G / 8) + bx / 8 : bx; }
    F.gw = F.vcu * NWAVES + F.wave; F.NGW = F.G * NWAVES;
    F.out = args.out; F.ws = args.ws; F.ctl = (unsigned*)(args.ws + WS_CTL);
    const int lo = args.ph_lo, hi = args.ph_hi;
    for (int u = F.tid; u < (LDS_BYTES - MISC_OFF) / 4; u += NWAVES * 64) ((LAS unsigned*)(F.lds + MISC_OFF))[u] = 0u;
    __syncthreads();
    XcdBarrier bar; bar.bar = F.ctl + CW_BAR; bar.x = 0; bar.st = nullptr;
    if (hi - lo > 1) bar = xcd_barrier_post(F.ctl + CW_BAR, F.MISC + 8);
    if constexpr (PH_EN(12)) if (IN(0)) { p_prologue(F); SEAM(0); }
    layer_body<0>(F, lo, hi, bar); layer_body<1>(F, lo, hi, bar); layer_body<2>(F, lo, hi, bar); layer_body<3>(F, lo, hi, bar);
#undef IN
#undef SEAM
}

extern "C" void kernel_launch(void* const* d_in, const int* in_sizes, int n_in, void* d_out, int out_size, void* d_ws, size_t ws_size, hipStream_t stream) {
    static int grid = 0;
    if (grid == 0) {
        if (n_in != 27 || in_sizes[0] != T * D || out_size != T * D || ws_size < WS_END) { fprintf(stderr, "kernel_launch: unexpected shapes (n_in %d, in0 %d, out %d, ws %zu); nothing launched\n", n_in, n_in > 0 ? in_sizes[0] : -1, out_size, ws_size); grid = -1; return; }
        int dev = 0, cus = 0, per_cu = 0;
        if (hipGetDevice(&dev) != hipSuccess || hipDeviceGetAttribute(&cus, hipDeviceAttributeMultiprocessorCount, dev) != hipSuccess) { grid = -1; return; }
        if (hipFuncSetAttribute((const void*)fwd_kernel, hipFuncAttributeMaxDynamicSharedMemorySize, LDS_BYTES) != hipSuccess) { fprintf(stderr, "kernel_launch: hipFuncSetAttribute failed\n"); grid = -1; return; }
        if (hipOccupancyMaxActiveBlocksPerMultiprocessor(&per_cu, (const void*)fwd_kernel, NWAVES * 64, LDS_BYTES) != hipSuccess || per_cu < 1) fprintf(stderr, "kernel_launch: note: occupancy query reports %d workgroups per CU\n", per_cu);
        (void)hipGetLastError();
        grid = cus;
    }
    if (grid < 0) return;
    if (hipMemsetAsync((char*)d_ws + WS_CTL, 0, CTL_ZERO_BYTES, stream) != hipSuccess) return;
    Args a{};
    for (int i = 0; i < 27; ++i) a.in[i] = (const float*)d_in[i];
    a.out = (float*)d_out; a.ws = (unsigned char*)d_ws;
#if MK_ONE_LAUNCH
    a.ph_lo = 0; a.ph_hi = NPHASES;
    hipLaunchKernelGGL(fwd_kernel, dim3(grid), dim3(NWAVES * 64), LDS_BYTES, stream, a);
#else
    for (int ph = 0; ph < NPHASES; ++ph) {
        if (ph > 0 && (((ph - 1) / NPH_LAYER) & 1) && ((ph - 1) % NPH_LAYER) == 5) continue;
        a.ph_lo = ph; a.ph_hi = ph + 1;
        hipLaunchKernelGGL(fwd_kernel, dim3(grid), dim3(NWAVES * 64), LDS_BYTES, stream, a);
    }
#endif
}
```

```cpp
#include <hip/hip_runtime.h>
#include <cstdio>
#include <cstdint>
__device__ __forceinline__ float silu_f(float x) { return x / (1.0f + __expf(-x)); }
namespace pg8 {
#define PG8_LAS __attribute__((address_space(3)))
typedef unsigned short bf16_t;
typedef short bf16x8 __attribute__((ext_vector_type(8)));
typedef float f32x4 __attribute__((ext_vector_type(4)));
typedef unsigned u32x4 __attribute__((ext_vector_type(4)));
constexpr int BM = 256, BK = 64, HALF = 128, HTB = HALF * BK * 2  , STAGE_BYTES = 8 * HTB, NXCD = 8, WGM = 8;

__host__ __device__ __forceinline__ int lds_byte(int r, int c) { const int st = (r >> 4) * 2 + (c >> 5), rr = r & 15, cc = c & 31, ob = rr * 64 + cc * 2; return st * 1024 + (ob ^ (((ob >> 9) & 1) << 5)); }
__host__ __device__ __forceinline__ void stage_rc(int b, int& R, int& C) { const int st = b / 1024, sb = b % 1024, swz = sb ^ (((sb >> 9) & 1) << 5); R = (st >> 1) * 16 + swz / 64; C = (st & 1) * 32 + (swz % 64) / 2; }
__host__ __device__ __forceinline__ int perm32(int rho) { const int n = rho >> 4, i = rho & 15; return 8 * (i >> 2) + 4 * n + (i & 3); }

struct Unit { int pm, pn, be; };
struct Gemm { const bf16_t* A; const bf16_t* Bt; int M, N, K; size_t bstride; };

struct StaticOrder {
    int nM, nN, nwg, G, c;
    __host__ __device__ void init(int M, int N, int G_, int c_) { nM = M / BM; nN = N / BM; nwg = nM * nN; G = G_; c = c_; }
    __host__ __device__ bool next(int i, Unit& u) const {
        const long L = (long)i * G + c; if (L >= nwg) return false;
        int wgid = (int)L; { const int q = nwg / NXCD, r = nwg % NXCD, xcd = wgid % NXCD, off = wgid / NXCD; wgid = (xcd < r ? xcd * (q + 1) : r * (q + 1) + (xcd - r) * q) + off; }
        const int nig = WGM * nN, gid = wgid / nig, fm = gid * WGM, gsz = (nM - fm) < WGM ? (nM - fm) : WGM;
        u.pm = fm + ((wgid % nig) % gsz); u.pn = (wgid % nig) / gsz; u.be = 0; return true;
    }
    __device__ __forceinline__ void a_ready(const Unit&) const {}
    __device__ __forceinline__ void done(const Unit&) const {}
};

__device__ __forceinline__ unsigned cvt_pk_bf16(float lo, float hi) { unsigned r; asm volatile("v_cvt_pk_bf16_f32 %0, %1, %2" : "=v"(r) : "v"(lo), "v"(hi)); return r; }
struct EpiStoreBf16 {
    static constexpr bool PERM = true, AFTER_DRAIN = false;
    bf16_t* O; int ldc;
    __device__ __forceinline__ void operator()(const f32x4 (&acc)[2][2][4][2], const Unit& u, int wr, int wc, int fr, int fq) const {
        const int row0 = u.pm * BM + wr * 64 + fr, col0 = u.pn * BM + wc * 32 + 8 * fq;
#pragma unroll
        for (int ai = 0; ai < 2; ++ai)
#pragma unroll
            for (int m = 0; m < 4; ++m) { bf16_t* rowp = O + (size_t)(row0 + ai * HALF + m * 16) * ldc + col0;
#pragma unroll
                for (int bj = 0; bj < 2; ++bj) { const f32x4 v0 = acc[ai][bj][m][0], v1 = acc[ai][bj][m][1];
                    u32x4 w; w.x = cvt_pk_bf16(v0[0], v0[1]); w.y = cvt_pk_bf16(v0[2], v0[3]); w.z = cvt_pk_bf16(v1[0], v1[1]); w.w = cvt_pk_bf16(v1[2], v1[3]);
                    *(u32x4*)(rowp + bj * HALF) = w; } }
    }
};
struct EpiStoreF32 {
    static constexpr bool PERM = false, AFTER_DRAIN = false;
    float* C; int ldc;
    __device__ __forceinline__ void operator()(const f32x4 (&acc)[2][2][4][2], const Unit& u, int wr, int wc, int fr, int fq) const {
        const int row0 = u.pm * BM + wr * 64 + fr, col0 = u.pn * BM + wc * 32 + 4 * fq;
#pragma unroll
        for (int ai = 0; ai < 2; ++ai)
#pragma unroll
            for (int m = 0; m < 4; ++m) { float* rowp = C + (size_t)(row0 + ai * HALF + m * 16) * ldc + col0;
#pragma unroll
                for (int bj = 0; bj < 2; ++bj)
#pragma unroll
                    for (int n = 0; n < 2; ++n) *(f32x4*)(rowp + bj * HALF + n * 16) = acc[ai][bj][m][n]; }
    }
};
struct EpiSwiglu {
    static constexpr bool PERM = true, AFTER_DRAIN = false;
    bf16_t* O; int ldc;
    __device__ __forceinline__ void operator()(const f32x4 (&acc)[2][2][4][2], const Unit& u, int wr, int wc, int fr, int fq) const {
        const int row0 = u.pm * BM + wr * 64 + fr, col0 = u.pn * HALF + wc * 32 + 8 * fq;
#pragma unroll
        for (int ai = 0; ai < 2; ++ai)
#pragma unroll
            for (int m = 0; m < 4; ++m) { bf16_t* rowp = O + (size_t)(row0 + ai * HALF + m * 16) * ldc + col0;
                const f32x4 g0 = acc[ai][0][m][0], g1 = acc[ai][0][m][1], u0 = acc[ai][1][m][0], u1 = acc[ai][1][m][1];
                float h[8];
#pragma unroll
                for (int i = 0; i < 4; ++i) { h[i] = silu_f(g0[i]) * u0[i]; h[4 + i] = silu_f(g1[i]) * u1[i]; }
                u32x4 w; w.x = cvt_pk_bf16(h[0], h[1]); w.y = cvt_pk_bf16(h[2], h[3]); w.z = cvt_pk_bf16(h[4], h[5]); w.w = cvt_pk_bf16(h[6], h[7]);
                *(u32x4*)rowp = w; }
    }
};
struct MoeOrder : StaticOrder {
    const int* tab;
    __device__ __forceinline__ void initm(const int* tab_, int nN_, int G_, int c_) { tab = tab_; nM = tab_[0]; nN = nN_; nwg = nM * nN; G = G_; c = c_; }
    __device__ __forceinline__ bool next(int i, Unit& u) const { if (!StaticOrder::next(i, u)) return false; u.be = tab[1 + u.pm]; return true; }
};
template <class Epi, class Sched, bool ALIGN_EPI = false, bool SP2 = false>
__device__ __forceinline__ void gemm_phase(PG8_LAS unsigned char* lds, const Gemm g, const Sched& S, const Epi& E) {
    const int tid = threadIdx.x, wid = __builtin_amdgcn_readfirstlane(tid >> 6), lane = tid & 63, wr = wid >> 2, wc = wid & 3, fr = lane & 15, fq = lane >> 4;
    const int K = g.K, nt = K / BK;
    unsigned voffA[2], voffB[2];
#pragma unroll
    for (int i = 0; i < 2; ++i) { int R, C; stage_rc(tid * 16 + i * 8192, R, C); const int Rb = Epi::PERM ? ((R & ~31) + perm32(R & 31)) : R;
        voffA[i] = (unsigned)(R * K + C) * 2u; voffB[i] = (unsigned)(Rb * K + C) * 2u; }
    const size_t kstep = (size_t)(BK * 2);
    const size_t hstep = (size_t)HALF * K * 2;
    const size_t tstep = 2 * hstep;
    const unsigned ldsw = (unsigned)wid * 1024u;
    const int aoff = lds_byte(wr * 64 + fr, fq * 8), boff = lds_byte(wc * 32 + fr, fq * 8);
#define PG8_SA(b, h) (((b) * 2 + (h)) * HTB)
#define PG8_SB(b, h) ((4 + (b) * 2 + (h)) * HTB)
#define PG8_STAGE(bufoff, gbase, voff) do { _Pragma("unroll") for (int _i = 0; _i < 2; ++_i) \
        __builtin_amdgcn_global_load_lds((const unsigned*)((const char*)(gbase) + (voff)[_i]), (PG8_LAS unsigned*)(lds + (bufoff) + ldsw + _i * 8192), 16, 0, 0); } while (0)
#define PG8_LDA(dst, b, h) do { _Pragma("unroll") for (int m = 0; m < 4; ++m) _Pragma("unroll") for (int k = 0; k < 2; ++k) dst[m][k] = *(const PG8_LAS bf16x8*)(lds + PG8_SA(b, h) + aoff + m * 2048 + k * 1024); } while (0)
#define PG8_LDB(dst, b, h) do { _Pragma("unroll") for (int n = 0; n < 2; ++n) _Pragma("unroll") for (int k = 0; k < 2; ++k) dst[n][k] = *(const PG8_LAS bf16x8*)(lds + PG8_SB(b, h) + boff + n * 2048 + k * 1024); } while (0)
#define PG8_MMA(ai, bj, At, Bt) do { __builtin_amdgcn_s_setprio(1); _Pragma("unroll") for (int m = 0; m < 4; ++m) _Pragma("unroll") for (int n = 0; n < 2; ++n) _Pragma("unroll") for (int k = 0; k < 2; ++k) \
        acc[ai][bj][m][n] = __builtin_amdgcn_mfma_f32_16x16x32_bf16(Bt[n][k], At[m][k], acc[ai][bj][m][n], 0, 0, 0); __builtin_amdgcn_s_setprio(0); } while (0)
#define PG8_WAIT_V(n) asm volatile("s_waitcnt vmcnt(" #n ")" ::: "memory")
#define PG8_WAIT_L(n) asm volatile("s_waitcnt lgkmcnt(" #n ")" ::: "memory")
#define PG8_BAR __builtin_amdgcn_s_barrier()
#define PG8_SCHED __builtin_amdgcn_sched_barrier(0)
    Unit cur, nxt; int ui = 0;
    if (!S.next(0, cur)) return;
    f32x4 acc[2][2][4][2];
#pragma unroll
    for (int a = 0; a < 2; ++a)
#pragma unroll
        for (int b = 0; b < 2; ++b)
#pragma unroll
            for (int m = 0; m < 4; ++m)
#pragma unroll
                for (int n = 0; n < 2; ++n) acc[a][b][m][n] = (f32x4){0.f, 0.f, 0.f, 0.f};
    bf16x8 At[4][2], B0[2][2], B1[2][2];
    const char* cA = (const char*)g.A + (size_t)cur.pm * tstep; const char* cB = (const char*)g.Bt + (size_t)cur.be * g.bstride + (size_t)cur.pn * tstep;
    S.a_ready(cur);
    if constexpr (SP2) {
        PG8_STAGE(PG8_SB(0, 0), cB, voffB); PG8_STAGE(PG8_SB(0, 1), cB + hstep, voffB); PG8_STAGE(PG8_SA(0, 0), cA, voffA); PG8_STAGE(PG8_SA(0, 1), cA + hstep, voffA);
        if (wr == 1) PG8_BAR;
        PG8_WAIT_V(2); PG8_BAR;
        PG8_STAGE(PG8_SB(1, 0), cB + kstep, voffB); PG8_STAGE(PG8_SA(1, 0), cA + kstep, voffA); PG8_STAGE(PG8_SB(1, 1), cB + hstep + kstep, voffB);
        PG8_WAIT_V(6); PG8_BAR;
    } else {
        PG8_STAGE(PG8_SB(0, 0), cB, voffB); PG8_STAGE(PG8_SA(0, 0), cA, voffA); PG8_STAGE(PG8_SB(0, 1), cB + hstep, voffB); PG8_STAGE(PG8_SA(0, 1), cA + hstep, voffA);
        if (wr == 1) PG8_BAR;
        PG8_WAIT_V(4); PG8_BAR;
        PG8_STAGE(PG8_SB(1, 0), cB + kstep, voffB); PG8_STAGE(PG8_SA(1, 0), cA + kstep, voffA); PG8_STAGE(PG8_SB(1, 1), cB + hstep + kstep, voffB);
        PG8_WAIT_V(6); PG8_BAR;
    }
    for (;;) {
        const bool has_next = S.next(ui + 1, nxt);
        const char* nA = has_next ? (const char*)g.A + (size_t)nxt.pm * tstep : cA; const char* nB = has_next ? (const char*)g.Bt + (size_t)nxt.be * g.bstride + (size_t)nxt.pn * tstep : cB;
        for (int t = 0; t < nt; t += 2) {
            const bool last = (t == nt - 2);
            const char* a1 = cA + (size_t)(t + 1) * kstep;
            const char* a2 = last ? nA : cA + (size_t)(t + 2) * kstep; const char* b2 = last ? nB : cB + (size_t)(t + 2) * kstep;
            const char* a3 = a2 + kstep; const char* b3 = b2 + kstep;
            if (last && has_next) S.a_ready(nxt);
            if constexpr (SP2) {
            PG8_LDB(B0, 0, 0); PG8_LDB(B1, 0, 1); PG8_SCHED; PG8_LDA(At, 0, 0); PG8_STAGE(PG8_SA(1, 1), a1 + hstep, voffA);
            PG8_WAIT_V(8); PG8_WAIT_L(0); PG8_BAR; PG8_MMA(0, 0, At, B0); PG8_MMA(0, 1, At, B1); PG8_BAR; PG8_SCHED;
            PG8_LDA(At, 0, 1); PG8_STAGE(PG8_SB(0, 0), b2, voffB); PG8_STAGE(PG8_SB(0, 1), b2 + hstep, voffB); PG8_STAGE(PG8_SA(0, 0), a2, voffA);
            PG8_WAIT_V(8); PG8_WAIT_L(0); PG8_BAR; PG8_MMA(1, 0, At, B0); PG8_MMA(1, 1, At, B1); PG8_BAR; PG8_SCHED;
            PG8_LDB(B0, 1, 0); PG8_LDB(B1, 1, 1); PG8_SCHED; PG8_LDA(At, 1, 0); PG8_STAGE(PG8_SA(0, 1), a2 + hstep, voffA);
            PG8_WAIT_V(8); PG8_WAIT_L(0); PG8_BAR; PG8_MMA(0, 0, At, B0); PG8_MMA(0, 1, At, B1); PG8_BAR; PG8_SCHED;
            PG8_LDA(At, 1, 1); PG8_STAGE(PG8_SB(1, 0), b3, voffB); PG8_STAGE(PG8_SB(1, 1), b3 + hstep, voffB); PG8_STAGE(PG8_SA(1, 0), a3, voffA);
            PG8_WAIT_V(8); PG8_WAIT_L(0); PG8_BAR; PG8_MMA(1, 0, At, B0); PG8_MMA(1, 1, At, B1); PG8_BAR; PG8_SCHED;
            } else {
            PG8_LDB(B0, 0, 0); PG8_SCHED; PG8_LDA(At, 0, 0); PG8_STAGE(PG8_SA(1, 1), a1 + hstep, voffA);
            PG8_WAIT_L(8); PG8_BAR; PG8_WAIT_L(0); PG8_MMA(0, 0, At, B0); PG8_BAR; PG8_SCHED;
            PG8_LDB(B1, 0, 1); PG8_STAGE(PG8_SB(0, 0), b2, voffB);
            PG8_BAR; PG8_WAIT_L(0); PG8_MMA(0, 1, At, B1); PG8_BAR;
            PG8_LDA(At, 0, 1); PG8_STAGE(PG8_SA(0, 0), a2, voffA);
            PG8_BAR; PG8_WAIT_L(0); PG8_MMA(1, 0, At, B0); PG8_BAR; PG8_SCHED;
            PG8_STAGE(PG8_SB(0, 1), b2 + hstep, voffB);
            PG8_WAIT_V(6); PG8_BAR; PG8_MMA(1, 1, At, B1); PG8_BAR;
            PG8_LDB(B0, 1, 0); PG8_SCHED; PG8_LDA(At, 1, 0); PG8_STAGE(PG8_SA(0, 1), a2 + hstep, voffA);
            PG8_WAIT_L(8); PG8_BAR; PG8_WAIT_L(0); PG8_MMA(0, 0, At, B0); PG8_BAR; PG8_SCHED;
            PG8_LDB(B1, 1, 1); PG8_STAGE(PG8_SB(1, 0), b3, voffB);
            PG8_BAR; PG8_WAIT_L(0); PG8_MMA(0, 1, At, B1); PG8_BAR;
            PG8_LDA(At, 1, 1); PG8_STAGE(PG8_SA(1, 0), a3, voffA);
            PG8_BAR; PG8_WAIT_L(0); PG8_MMA(1, 0, At, B0); PG8_BAR; PG8_SCHED;
            PG8_STAGE(PG8_SB(1, 1), b3 + hstep, voffB);
            PG8_WAIT_V(6); PG8_BAR; PG8_MMA(1, 1, At, B1); PG8_BAR;
            }
        }
        if constexpr (ALIGN_EPI) { if (wr == 0) PG8_BAR; }
        if constexpr (!Epi::AFTER_DRAIN) { E(acc, cur, wr, wc, fr, fq); S.done(cur); }
        if (!has_next) break;
#pragma unroll
        for (int a = 0; a < 2; ++a)
#pragma unroll
            for (int b = 0; b < 2; ++b)
#pragma unroll
                for (int m = 0; m < 4; ++m)
#pragma unroll
                    for (int n = 0; n < 2; ++n) acc[a][b][m][n] = (f32x4){0.f, 0.f, 0.f, 0.f};
        cur = nxt; cA = nA; cB = nB; ++ui;
        if constexpr (ALIGN_EPI) { if (wr == 1) PG8_BAR; }
    }
    PG8_WAIT_V(0);
    if constexpr (!ALIGN_EPI) { if (wr == 0) PG8_BAR; }
    PG8_BAR;
    if constexpr (Epi::AFTER_DRAIN) { E.fused(acc, cur, wr, wc, fr, fq, lds, wid, lane); S.done(cur); }
#undef PG8_SA
#undef PG8_SB
#undef PG8_STAGE
#undef PG8_LDA
#undef PG8_LDB
#undef PG8_MMA
#undef PG8_WAIT_V
#undef PG8_WAIT_L
#undef PG8_BAR
#undef PG8_SCHED
}
}
#ifndef SSD_NAIVE
#define SSD_NAIVE 0
#endif
#ifndef MLSTM_NAIVE
#define MLSTM_NAIVE 0
#endif
#ifndef FOX_NAIVE
#define FOX_NAIVE 0
#endif
#include <hip/hip_bf16.h>
#include <cmath>
namespace attn_body {
using bf16=__hip_bfloat16;
using bf16x8=__attribute__((ext_vector_type(8)))short;
using s16x4=__attribute__((ext_vector_type(4)))short;
using f32x16=__attribute__((ext_vector_type(16)))float;
using u32x4=__attribute__((ext_vector_type(4)))unsigned;
constexpr int BATCH=8,NHEAD=8,SEQ=2048,D=64,PQ=3584,PO=1024;
constexpr int NW=8,QBLK=32,QB=QBLK*NW,KVBLK=64,NQB=SEQ/QB;
constexpr int ATTN_UNIT_ROWS=QB;
__device__ __forceinline__ int crow(int r,int hi){return (r&3)+8*(r>>2)+4*hi;}
#define SBAR() __builtin_amdgcn_sched_barrier(0)
__device__ __forceinline__ void cmask(f32x16&p0,f32x16&p1,int jb,int qrel,int hi){
  const float NEG=-INFINITY; int kb=64*jb+4*hi;
  #pragma unroll
  for(int r=0;r<16;++r){int kv=kb+(r&3)+8*(r>>2); if(kv>qrel)p0[r]=NEG; if(kv+32>qrel)p1[r]=NEG;}
}

constexpr int NSLOT=3, SLOTB=8192;
constexpr int LDS_K=0, LDS_V=NSLOT*SLOTB, LDS_WS=2*NSLOT*SLOTB, LDS_OST=LDS_WS+NW*64*4, LDS_CK=LDS_OST+NW*4096, LDS_BYTES=LDS_CK+SEQ*4;
constexpr float C2=0.125f*1.4426950408889634f;
__device__ __forceinline__ void glds16(const void*gsrc,unsigned lds_dst){unsigned keep;
  asm volatile("s_mov_b32 %0, m0\n\ts_mov_b32 m0, %2\n\ts_nop 0\n\tglobal_load_lds_dwordx4 %1, off\n\ts_mov_b32 m0, %0":"=&s"(keep):"v"(gsrc),"s"(lds_dst):"memory");}
__device__ __forceinline__ float max3f(float a,float b,float c){float r;asm("v_max3_f32 %0, %1, %2, %3":"=v"(r):"v"(a),"v"(b),"v"(c));return r;}
__device__ __forceinline__ float max2f(float a,float b){float r;asm("v_max_f32_e32 %0, %1, %2":"=v"(r):"v"(a),"v"(b));return r;}
__device__ __forceinline__ float fadd_s(float a,float b){float r;asm("v_add_f32_e32 %0, %1, %2":"=v"(r):"v"(a),"v"(b));return r;}
__device__ __forceinline__ float fsub_s(float a,float b){float r;asm("v_sub_f32_e32 %0, %1, %2":"=v"(r):"v"(a),"v"(b));return r;}
typedef float f32x4_t __attribute__((ext_vector_type(4))); typedef float f32x2_t __attribute__((ext_vector_type(2))); typedef __bf16 bf16x2_t __attribute__((ext_vector_type(2)));
__device__ __forceinline__ unsigned cvtpk_s(float lo,float hi){f32x2_t v={lo,hi};bf16x2_t b=__builtin_convertvector(v,bf16x2_t);return __builtin_bit_cast(unsigned,b);}
#define WAIT_BAR(N) asm volatile("s_waitcnt vmcnt(" #N ") lgkmcnt(0)\n\ts_barrier":::"memory")

__device__ __forceinline__ void qkt(f32x16&p0,f32x16&p1,const char*Kslot,const bf16x8*qr,int r32,int hi){
  const char*kb=Kslot+hi*1024+r32*16;
  #pragma unroll
  for(int d0=0;d0<4;++d0){
    const bf16x8 b0=*reinterpret_cast<const bf16x8*>(kb+d0*2048);
    const bf16x8 b1=*reinterpret_cast<const bf16x8*>(kb+d0*2048+512);
    {p0=__builtin_amdgcn_mfma_f32_32x32x16_bf16(b0,qr[d0],p0,0,0,0);p1=__builtin_amdgcn_mfma_f32_32x32x16_bf16(b1,qr[d0],p1,0,0,0);}}
}
typedef __attribute__((address_space(3))) const char* lds_cptr;
typedef short v4i16_t __attribute__((ext_vector_type(4)));
__device__ __forceinline__ void kload8(bf16x8*kf,lds_cptr kp){
  kf[0]=*(const __attribute__((address_space(3))) bf16x8*)(kp);      kf[1]=*(const __attribute__((address_space(3))) bf16x8*)(kp+512);
  kf[2]=*(const __attribute__((address_space(3))) bf16x8*)(kp+2048); kf[3]=*(const __attribute__((address_space(3))) bf16x8*)(kp+2560);
  kf[4]=*(const __attribute__((address_space(3))) bf16x8*)(kp+4096); kf[5]=*(const __attribute__((address_space(3))) bf16x8*)(kp+4608);
  kf[6]=*(const __attribute__((address_space(3))) bf16x8*)(kp+6144); kf[7]=*(const __attribute__((address_space(3))) bf16x8*)(kp+6656);
}
__device__ __forceinline__ void kload2(bf16x8*kf,lds_cptr kp,int j){ kf[2*j]=*(const __attribute__((address_space(3))) bf16x8*)(kp+j*2048); kf[2*j+1]=*(const __attribute__((address_space(3))) bf16x8*)(kp+j*2048+512); }
__device__ __forceinline__ s16x4 vtr(lds_cptr p){ return __builtin_bit_cast(s16x4,__builtin_amdgcn_ds_read_tr16_b64_v4i16((__attribute__((address_space(3))) v4i16_t*)p)); }
__device__ __forceinline__ float rowmax(const f32x16&p0,const f32x16&p1){
  float a=max3f(p0[0],p0[1],p1[0]),b=max3f(p0[2],p0[3],p1[1]);a=max3f(a,p1[2],p1[3]);
  #pragma unroll
  for(int r=4;r<16;r+=4){a=max3f(a,p0[r],p0[r+1]);b=max3f(b,p0[r+2],p0[r+3]);a=max3f(a,p1[r],p1[r+1]);b=max3f(b,p1[r+2],p1[r+3]);}
  const float m=max2f(a,b);
  auto rr=__builtin_amdgcn_permlane32_swap(__float_as_uint(m),__float_as_uint(m),false,false);
  return max2f(__uint_as_float(rr[0]),__uint_as_float(rr[1]));
}
__device__ __forceinline__ void pv(f32x16*o,int vb,bf16x8 pa0,bf16x8 pa1,bf16x8 pa2,bf16x8 pa3){
  #pragma unroll
  for(int d0=0;d0<2;++d0){s16x4 lo[4],hi[4];
    #pragma unroll
    for(int ks=0;ks<4;++ks){
      asm volatile("ds_read_b64_tr_b16 %0,%1 offset:%c2":"=&v"(lo[ks]):"v"(vb),"i"(d0*4096+ks*1024):"memory");
      asm volatile("ds_read_b64_tr_b16 %0,%1 offset:%c2":"=&v"(hi[ks]):"v"(vb),"i"(d0*4096+ks*1024+512):"memory");}
    asm volatile("s_waitcnt lgkmcnt(0)":::"memory");SBAR();
    #define PK(k) (bf16x8){lo[k][0],lo[k][1],lo[k][2],lo[k][3],hi[k][0],hi[k][1],hi[k][2],hi[k][3]}
    o[d0]=__builtin_amdgcn_mfma_f32_32x32x16_bf16(pa0,PK(0),o[d0],0,0,0);
    o[d0]=__builtin_amdgcn_mfma_f32_32x32x16_bf16(pa1,PK(1),o[d0],0,0,0);
    o[d0]=__builtin_amdgcn_mfma_f32_32x32x16_bf16(pa2,PK(2),o[d0],0,0,0);
    o[d0]=__builtin_amdgcn_mfma_f32_32x32x16_bf16(pa3,PK(3),o[d0],0,0,0);
    #undef PK
  }
}

#ifndef ATTN_STORE16
#define ATTN_STORE16(p,v) (*(u32x4*)(p)=(v))
#endif
template<int THRL> __device__ __forceinline__ void attn_unit(int b,int h,int qb,const bf16*Q,const bf16*K,const bf16*V,bf16*O,const float*cum,char*shm){
  const int tid=threadIdx.x,lane=tid&63,r32=lane&31,hi=lane>>5; const int wid=__builtin_amdgcn_readfirstlane(tid>>6);
  const long rowbase=(long)b*SEQ; const int q0=qb*QB;
  const bf16*Qw=Q+(rowbase+q0+wid*QBLK)*PQ+h*D;
  const bf16*Kh=K+rowbase*PQ+h*D,*Vh=V+rowbase*PQ+h*D;
  const lds_cptr shm3_=(lds_cptr)shm;
  const unsigned lds0=(unsigned)(uintptr_t)shm;
  float*wsf=(float*)(shm+LDS_WS)+wid*64;
  const bf16*ksrc=Kh+(long)lane*PQ+wid*8;
  const bf16*vsrc=Vh+(long)(16*(wid&3)+(lane>>2))*PQ+(wid>>2)*32+(lane&3)*8;
  const unsigned kdst=lds0+LDS_K+wid*1024, vdst=lds0+LDS_V+wid*1024;
  #define DMA_K(t,slot) glds16(ksrc+(long)(t)*KVBLK*PQ,(unsigned)__builtin_amdgcn_readfirstlane(kdst+(slot)))
  #define DMA_V(t,slot) glds16(vsrc+(long)(t)*KVBLK*PQ,(unsigned)__builtin_amdgcn_readfirstlane(vdst+(slot)))
  const int vb0=(int)(lds0+LDS_V)+((lane>>4)&1)*32+(lane&3)*8+(4*hi+((lane&15)>>2))*64;
  const char*Kbase=shm+LDS_K; bf16x8 kf[8];
  const lds_cptr shm3=(lds_cptr)shm; const lds_cptr kp0=shm3+LDS_K+hi*1024+r32*16; const lds_cptr vp0=shm3+LDS_V+((lane>>4)&1)*32+(lane&3)*8+(4*hi+((lane&15)>>2))*64;
  const int NT=(q0+QB)/KVBLK;
  float cqm;
  { float*cks=(float*)(shm+LDS_CK); for(int i=tid;i<q0+QB;i+=NW*64)cks[i]=cum[i]; cqm=cum[q0+wid*QBLK+r32]; asm volatile("s_waitcnt vmcnt(0)":"+v"(cqm)::"memory"); }
  const __attribute__((address_space(3))) float*ckl=(const __attribute__((address_space(3))) float*)(shm3_+LDS_CK)+4*hi;
  #define BIASFILL(C0_,C1_,t_) do{ const __attribute__((address_space(3))) float*cp_=ckl+64*(t_); \
    _Pragma("unroll") for(int a_=0;a_<4;++a_){ const f32x4_t u_=*(const __attribute__((address_space(3))) f32x4_t*)(cp_+8*a_), w_=*(const __attribute__((address_space(3))) f32x4_t*)(cp_+32+8*a_); \
      _Pragma("unroll") for(int i_=0;i_<4;++i_){ C0_[4*a_+i_]=cqm-u_[i_]; C1_[4*a_+i_]=cqm-w_[i_]; } } }while(0)
  DMA_K(0,0);DMA_V(0,0);DMA_K(1,SLOTB);
  bf16x8 qr[4];
  #pragma unroll
  for(int d0=0;d0<4;++d0)qr[d0]=*reinterpret_cast<const bf16x8*>(&Qw[(long)r32*PQ+d0*16+hi*8]);
  float l_reg=0.f;f32x16 o[2];o[0]=f32x16{};o[1]=f32x16{};
  const int qrel=wid*QBLK+r32;
  #define CMASK(P0,P1,t) do{int jb_=(t)-(NT-4); if(jb_>=0)cmask(P0,P1,jb_,qrel,hi);}while(0)
  bool resc=false;
  #define START(P0,P1) do{ const float rm=rowmax(P0,P1); resc=false; \
    { const float dl=rm; cqm=fsub_s(cqm,dl); \
      _Pragma("unroll") for(int r=0;r<16;++r){P0[r]=fsub_s(P0[r],dl);P1[r]=fsub_s(P1[r],dl);} \
      } \
    _Pragma("unroll") for(int r=0;r<16;++r)P0[r]=__builtin_amdgcn_exp2f(P0[r]); }while(0)
  #define RESC() do{ if(resc){ asm volatile("s_waitcnt lgkmcnt(0)":::"memory"); \
      _Pragma("unroll") for(int d_=0;d_<2;++d_) _Pragma("unroll") for(int r=0;r<16;++r)o[d_][r]*=wsf[crow(r,hi)]; } }while(0)
  f32x16 pA0,pA1,pB0,pB1;
  int sl_prev=0,sl_cur=0,sl_next=SLOTB;
  #define ROT() do{sl_prev=sl_cur;sl_cur=sl_next;sl_next=(sl_next==(NSLOT-1)*SLOTB)?0:sl_next+SLOTB;}while(0)
  DMA_K(2,2*SLOTB);
  WAIT_BAR(3);
  BIASFILL(pA0,pA1,0); qkt(pA0,pA1,Kbase,qr,r32,hi);asm volatile("s_nop 15\n\ts_nop 7":"+v"(pA0),"+v"(pA1));CMASK(pA0,pA1,0);
  START(pA0,pA1);
  _Pragma("unroll") for(int r=0;r<16;++r)pA1[r]=__builtin_amdgcn_exp2f(pA1[r]);
  WAIT_BAR(0);
  DMA_K(3,0);DMA_V(1,SLOTB);
  ROT();
  kload8(kf,kp0+sl_cur);
  WAIT_BAR(2);
  s16x4 vlo[8],vhi[8]; u32x4 pw0,pw1,pw2,pw3;
  #define PKW(P,B) cvtpk_s(P[B],P[B+1])
  #define PAF(k) __builtin_bit_cast(bf16x8,pw##k)
  #define VFR(i) (bf16x8){vlo[i][0],vlo[i][1],vlo[i][2],vlo[i][3],vhi[i][0],vhi[i][1],vhi[i][2],vhi[i][3]}
  #define PIN(x) asm volatile("":"+v"(x))
  #define MX3(a,b,c) __builtin_fmaxf(__builtin_fmaxf((a),(b)),(c))
  #define GAPA(MF,A0,A1,A2,A3,W0,W1,PW) do{ MF; sacc+=A0; sacc+=A1; sacc+=A2; sacc+=A3; PIN(sacc); W0; W1; PIN(PW); SBAR(); }while(0)
  #define EX(v) __builtin_amdgcn_exp2f(v)
  #define GAPB(MF,X,B) do{ MF; X[B]=EX(X[B]); X[B+1]=EX(X[B+1]); X[B+2]=EX(X[B+2]); X[B+3]=EX(X[B+3]); PIN(X); SBAR(); }while(0)
  #define VRD(i) do{ vlo[i]=vtr(vp_+(((i)>>2)*4096+((i)&3)*1024)); vhi[i]=vtr(vp_+(((i)>>2)*4096+((i)&3)*1024+512)); }while(0)
  #define KRD(G,j) do{ if(G){ kload2(kf,kp0+sl_next,j); SBAR(); } }while(0)
  #define STEP(C0,C1,P0,P1,t,GK,GV,GL) do{ BIASFILL(C0,C1,t); SBAR(); \
    const lds_cptr vp_=vp0+sl_prev; \
    VRD(0); SBAR(); float sacc=(P0[0]+P0[1]); \
    GAPA(C0=__builtin_amdgcn_mfma_f32_32x32x16_bf16(kf[0],qr[0],C0,0,0,0), P0[2],P0[3],P0[4],P0[5],     pw0[0]=PKW(P0,0), pw0[1]=PKW(P0,2), pw0); \
    VRD(4); SBAR(); GAPA(C1=__builtin_amdgcn_mfma_f32_32x32x16_bf16(kf[1],qr[0],C1,0,0,0), P0[6],P0[7],P0[8],P0[9],     pw0[2]=PKW(P0,4), pw0[3]=PKW(P0,6), pw0); \
    VRD(1); SBAR(); GAPA(C0=__builtin_amdgcn_mfma_f32_32x32x16_bf16(kf[2],qr[1],C0,0,0,0),   P0[10],P0[11],P0[12],P0[13], pw1[0]=PKW(P0,8), pw1[1]=PKW(P0,10), pw1); \
    VRD(5); SBAR(); GAPA(C1=__builtin_amdgcn_mfma_f32_32x32x16_bf16(kf[3],qr[1],C1,0,0,0),   P0[14],P0[15],P1[0],P1[1],   pw1[2]=PKW(P0,12),pw1[3]=PKW(P0,14), pw1); \
    VRD(2); SBAR(); GAPA(C0=__builtin_amdgcn_mfma_f32_32x32x16_bf16(kf[4],qr[2],C0,0,0,0),   P1[2],P1[3],P1[4],P1[5],     pw2[0]=PKW(P1,0), pw2[1]=PKW(P1,2), pw2); \
    VRD(6); SBAR(); GAPA(C1=__builtin_amdgcn_mfma_f32_32x32x16_bf16(kf[5],qr[2],C1,0,0,0),   P1[6],P1[7],P1[8],P1[9],     pw2[2]=PKW(P1,4), pw2[3]=PKW(P1,6), pw2); \
    VRD(3); SBAR(); GAPA(C0=__builtin_amdgcn_mfma_f32_32x32x16_bf16(kf[6],qr[3],C0,0,0,0),   P1[10],P1[11],P1[12],P1[13], pw3[0]=PKW(P1,8), pw3[1]=PKW(P1,10), pw3); \
    VRD(7); SBAR(); GAPA(C1=__builtin_amdgcn_mfma_f32_32x32x16_bf16(kf[7],qr[3],C1,0,0,0),   P1[14],P1[15],0.f,0.f,       pw3[2]=PKW(P1,12),pw3[3]=PKW(P1,14), pw3); \
    l_reg+=sacc; \
    if(GK){DMA_K((t)+3,sl_cur);} if(GV){DMA_V((t)+1,sl_next);} \
    CMASK(C0,C1,t); \
    { float a=MX3(C0[0],C0[1],C1[0]),b=MX3(C0[2],C0[3],C1[1]); a=MX3(a,C1[2],C1[3]); \
      _Pragma("unroll") for(int r=4;r<16;r+=4){a=MX3(a,C0[r],C0[r+1]);b=MX3(b,C0[r+2],C0[r+3]);a=MX3(a,C1[r],C1[r+1]);b=MX3(b,C1[r+2],C1[r+3]);} \
      float rm=__builtin_fmaxf(a,b); { auto rr=__builtin_amdgcn_permlane32_swap(__float_as_uint(rm),__float_as_uint(rm),false,false); rm=__builtin_fmaxf(__uint_as_float(rr[0]),__uint_as_float(rr[1])); } \
      resc=false; \
      if(__builtin_expect(__any(rm>(float)THRL),0)){ const float dl=__builtin_fmaxf(rm,0.f); cqm-=dl; \
        _Pragma("unroll") for(int r=0;r<16;++r){C0[r]-=dl;C1[r]-=dl;} \
        const float f=__builtin_amdgcn_exp2f(-dl); l_reg*=f; if(hi==0)wsf[r32]=f; resc=true; } } \
    SBAR(); \
    GAPB(o[0]=__builtin_amdgcn_mfma_f32_32x32x16_bf16(PAF(0),VFR(0),o[0],0,0,0), C0,0); \
    GAPB(o[1]=__builtin_amdgcn_mfma_f32_32x32x16_bf16(PAF(0),VFR(4),o[1],0,0,0), C0,4); \
    KRD(GL,0); GAPB(o[0]=__builtin_amdgcn_mfma_f32_32x32x16_bf16(PAF(1),VFR(1),o[0],0,0,0), C0,8); \
    KRD(GL,1); GAPB(o[1]=__builtin_amdgcn_mfma_f32_32x32x16_bf16(PAF(1),VFR(5),o[1],0,0,0), C0,12); \
    KRD(GL,2); GAPB(o[0]=__builtin_amdgcn_mfma_f32_32x32x16_bf16(PAF(2),VFR(2),o[0],0,0,0), C1,0); \
    KRD(GL,3); GAPB(o[1]=__builtin_amdgcn_mfma_f32_32x32x16_bf16(PAF(2),VFR(6),o[1],0,0,0), C1,4); \
    GAPB(o[0]=__builtin_amdgcn_mfma_f32_32x32x16_bf16(PAF(3),VFR(3),o[0],0,0,0), C1,8); \
    GAPB(o[1]=__builtin_amdgcn_mfma_f32_32x32x16_bf16(PAF(3),VFR(7),o[1],0,0,0), C1,12); \
    }while(0)
  int t=1;
  #undef CMASK
  #define CMASK(P0,P1,t) do{}while(0)
  for(;t+5<NT;t+=2){
    STEP(pB0,pB1,pA0,pA1,t,true,true,true);     WAIT_BAR(2); RESC(); ROT();
    STEP(pA0,pA1,pB0,pB1,t+1,true,true,true);   WAIT_BAR(2); RESC(); ROT();
  }
  #undef CMASK
  #define CMASK(P0,P1,t) do{int jb_=(t)-(NT-4); if(jb_>=0)cmask(P0,P1,jb_,qrel,hi);}while(0)
  #define ENDW(tt) do{ if((tt)+3<NT){WAIT_BAR(2);} else if((tt)+2<NT){WAIT_BAR(1);} else {WAIT_BAR(0);} }while(0)
  for(;t+1<NT;t+=2){
    STEP(pB0,pB1,pA0,pA1,t,(t+3<NT),(t+1<NT),(t+1<NT));       ENDW(t);   RESC(); ROT();
    STEP(pA0,pA1,pB0,pB1,t+1,(t+4<NT),(t+2<NT),(t+2<NT));     ENDW(t+1); RESC(); ROT();
  }
  STEP(pB0,pB1,pA0,pA1,NT-1,false,false,false); RESC();
  { float sacc=pB0[0]+pB0[1]; _Pragma("unroll") for(int r=2;r<16;++r)sacc+=pB0[r]; _Pragma("unroll") for(int r=0;r<16;++r)sacc+=pB1[r]; l_reg+=sacc;
    pw0=(u32x4){PKW(pB0,0),PKW(pB0,2),PKW(pB0,4),PKW(pB0,6)};pw1=(u32x4){PKW(pB0,8),PKW(pB0,10),PKW(pB0,12),PKW(pB0,14)};pw2=(u32x4){PKW(pB1,0),PKW(pB1,2),PKW(pB1,4),PKW(pB1,6)};pw3=(u32x4){PKW(pB1,8),PKW(pB1,10),PKW(pB1,12),PKW(pB1,14)};
    SBAR(); pv(o,vb0+sl_cur,PAF(0),PAF(1),PAF(2),PAF(3)); }
  #undef PKW
  #undef PAF
  #undef VFR
  #undef PIN
  #undef MX3
  #undef GAPA
  #undef GAPB
  #undef EX
  #undef VRD
  #undef KRD
  #undef STEP
  #undef ENDW
  {auto rr=__builtin_amdgcn_permlane32_swap(__float_as_uint(l_reg),__float_as_uint(l_reg),false,false);l_reg=__uint_as_float(rr[0])+__uint_as_float(rr[1]);}
  if(hi==0)wsf[32+r32]=l_reg;asm volatile("s_waitcnt lgkmcnt(0)":::"memory");
  float rli[16];
  #pragma unroll
  for(int r=0;r<16;++r)rli[r]=__builtin_amdgcn_rcpf(wsf[32+crow(r,hi)]);
  bf16*Ow=O+(rowbase+q0+wid*QBLK)*PO+h*D;
  { bf16*stg=(bf16*)(shm+LDS_OST)+wid*2048;
    #pragma unroll
    for(int r=0;r<16;++r){const int orow=crow(r,hi);
      #pragma unroll
      for(int d0=0;d0<2;++d0)stg[orow*64+d0*32+r32]=__float2bfloat16(o[d0][r]*rli[r]);}
    asm volatile("s_waitcnt lgkmcnt(0)":::"memory");
    #pragma unroll
    for(int i=0;i<4;++i){const int row=i*8+(lane>>3),ch=lane&7; const u32x4 v=*(const u32x4*)(stg+row*64+ch*8); ATTN_STORE16(Ow+(long)row*PO+ch*8,v);} }
  asm volatile("s_waitcnt lgkmcnt(0)\n\ts_barrier":::"memory");
  #undef DMA_K
  #undef BIASFILL
  #undef DMA_V
  #undef CMASK
  #undef START
  #undef RESC
  #undef ROT
}
constexpr int ATTN_LDS_BYTES=LDS_BYTES;
struct AttnTensors { const bf16* Q; const bf16* K; const bf16* V; bf16* O; const float* cum; };
struct AttnUnit { int bh; int qb; };
struct StaticOrder {
  int vcu, G;
  __device__ __forceinline__ explicit StaticOrder(int grid,int v):vcu(v),G(grid){}
  __device__ __forceinline__ bool next(int i,AttnUnit&u)const{ const int pr=vcu+(i>>1)*G; if(pr>=256)return false; const int s=pr&3; u.bh=pr>>2; u.qb=(i&1)?7-s:s; return true; }
  __device__ __forceinline__ void a_ready(const AttnUnit&)const{}
  __device__ __forceinline__ void done(const AttnUnit&)const{}
};
template<class Sched,int THRL=8> __device__ __forceinline__ void attn_phase(char*lds,const AttnTensors&T,const Sched&S){
  AttnUnit u;
  for(int i=0;S.next(i,u);++i){ S.a_ready(u); attn_unit<THRL>(u.bh/NHEAD,u.bh%NHEAD,u.qb,T.Q,T.K,T.V,T.O,T.cum+(long)u.bh*SEQ,lds); S.done(u); }
}
#undef SBAR
#undef WAIT_BAR
}
constexpr int NWAVES = 8;
constexpr int T = 16384, D = 1024, SEQ = 2048, NBATCH = 8, DEPTH = 4;
constexpr float ALPHA = 1.6817928305074290f;
constexpr float LN_EPS = 1e-5f;
constexpr int AB_IN = 4112, CD_IN = 3600, NPE = 4096, NPO = 3584;
constexpr float LOG2E = 1.4426950408889634f;
constexpr float FOX_C2 = 0.125f * LOG2E;
constexpr float MLSTM_KSCALE = 0.08838834764831845f;
constexpr int RPAD = 40960;
constexpr int NPH_LAYER = 12, NPHASES = 1 + DEPTH * NPH_LAYER;
#ifndef MK_ONE_LAUNCH
#define MK_ONE_LAUNCH 1
#endif

constexpr size_t MiB = 1u << 20, KiB = 1u << 10;
constexpr size_t WS_CTL = 0, CTL_ZERO_BYTES = 1 * MiB;
constexpr size_t WS_BCNT = 1 * MiB, WS_PANEL = WS_BCNT + 64 * KiB, WS_ROUTE = WS_BCNT + 128 * KiB, WS_GATE = WS_BCNT + 384 * KiB, WS_POS = WS_BCNT + 512 * KiB,
                 WS_DEC = WS_BCNT + 640 * KiB, WS_MLOC = WS_BCNT + 704 * KiB, WS_BLAST = WS_BCNT + 712 * KiB, WS_MPREV = WS_BCNT + 720 * KiB,
                 WS_FOXC = 2 * MiB, WS_NLOC = 2 * MiB + 512 * KiB, WS_SG = 3 * MiB;
constexpr size_t WS_WINE = 4 * MiB, WS_WINO = 20 * MiB, WS_WOUTE = 34 * MiB, WS_WOUTO = 40 * MiB, WS_WGU = 44 * MiB, WS_WD = 300 * MiB;
constexpr size_t WS_HF = 428 * MiB, WS_HB = 492 * MiB, WS_H1F = 524 * MiB, WS_H1B = 588 * MiB;
constexpr size_t WS_R1 = 620 * MiB;
constexpr size_t WS_R2 = 748 * MiB;
constexpr size_t WS_R3 = 812 * MiB;
constexpr size_t WS_R4 = 860 * MiB;
constexpr size_t WS_MIX = 892 * MiB, WS_END = 940 * MiB;
constexpr int CW_BAR = 4096;

constexpr int RING_BYTES = 131072, SMALL_OFF = RING_BYTES, SMALL_BYTES = 8192, MISC_OFF = SMALL_OFF + SMALL_BYTES, LDS_BYTES = 147456;

#define GAS __attribute__((address_space(1)))
#define LAS __attribute__((address_space(3)))
typedef unsigned short bf16;
typedef unsigned v4u __attribute__((ext_vector_type(4)));
typedef unsigned v2u __attribute__((ext_vector_type(2)));
typedef float f32x4 __attribute__((ext_vector_type(4)));
typedef float f32x2 __attribute__((ext_vector_type(2)));
typedef int i32x4 __attribute__((ext_vector_type(4)));
typedef int i32x2 __attribute__((ext_vector_type(2)));
#define LDS_WAIT() asm volatile("s_waitcnt lgkmcnt(0)" ::: "memory")
__device__ __forceinline__ unsigned f2bf(float f) { unsigned u = __builtin_bit_cast(unsigned, f); return (u + 0x7fffu + ((u >> 16) & 1u)) >> 16; }
__device__ __forceinline__ unsigned pk2(float lo, float hi) { return f2bf(lo) | (f2bf(hi) << 16); }
__device__ __forceinline__ float bflo(unsigned w) { return __builtin_bit_cast(float, w << 16); }
__device__ __forceinline__ float bfhi(unsigned w) { return __builtin_bit_cast(float, w & 0xffff0000u); }
__device__ __forceinline__ float bf2f(bf16 b) { return __builtin_bit_cast(float, (unsigned)b << 16); }
__device__ __forceinline__ float wave_sum(float v) {
#pragma unroll
    for (int o = 1; o < 64; o <<= 1) v += __shfl_xor(v, o);
    return v;
}
__device__ __forceinline__ float wave_max(float v) {
#pragma unroll
    for (int o = 1; o < 64; o <<= 1) v = fmaxf(v, __shfl_xor(v, o));
    return v;
}
__device__ __forceinline__ float wave_scan_sum(float v, int lane) {
#pragma unroll
    for (int o = 1; o < 64; o <<= 1) { const float t = __shfl_up(v, o); if (lane >= o) v += t; }
    return v;
}
__device__ __forceinline__ float wave_scan_max(float v, int lane) {
#pragma unroll
    for (int o = 1; o < 64; o <<= 1) { const float t = __shfl_up(v, o); if (lane >= o) v = fmaxf(v, t); }
    return v;
}
__device__ __forceinline__ float softplus_f(float x) { return x > 20.f ? x : log1pf(expf(x)); }
__device__ __forceinline__ float logsigmoid_f(float x) { return fminf(x, 0.f) - log1pf(expf(-fabsf(x))); }
__device__ __forceinline__ float sigmoid_f(float x) { return 1.0f / (1.0f + expf(-x)); }
#define XB_TMO      128
#define XB_XCNT(j)  (256  + 64 * (j))
#define XB_XSUB(j)  (1280 + 64 * (j))
#define XB_XGEN(j)  (2304 + 64 * (j))
#define XB_TOP      3328
#define XB_TOPGEN   3392
#define XCD_BAR_WORDS 3456
#define XB_SPIN_CAP (1u << 18)

__device__ __forceinline__ unsigned xb_ld(unsigned* p)              { return __hip_atomic_load(p, __ATOMIC_RELAXED, __HIP_MEMORY_SCOPE_AGENT); }
__device__ __forceinline__ unsigned xb_add(unsigned* p, unsigned v) { return __hip_atomic_fetch_add(p, v, __ATOMIC_RELAXED, __HIP_MEMORY_SCOPE_AGENT); }
__device__ __forceinline__ unsigned xb_xcc_id() { return (unsigned)__builtin_amdgcn_s_getreg((3 << 11) | 20) & 0xFu; }
#define XB_SPIN(cond, bar) do { unsigned _sp = 0; while (cond) { __builtin_amdgcn_s_sleep(1); \
    if ((++_sp & 255u) == 0u) { if (xb_ld(&(bar)[XB_TMO])) break; if (_sp > XB_SPIN_CAP) { atomicAdd(&(bar)[XB_TMO], 1u); break; } } } } while (0)

struct XcdBarrier {
    unsigned* bar; unsigned x;
    volatile LAS unsigned* st;
};

__device__ __forceinline__ XcdBarrier xcd_barrier_post(unsigned* bar, volatile LAS unsigned* st) {
    XcdBarrier b; b.bar = bar; b.x = xb_xcc_id(); b.st = st;
    if (threadIdx.x == 0) (void)xb_add(&bar[XB_XCNT(b.x)], 1u);
    return b;
}
__device__ __forceinline__ void xcd_barrier_complete(unsigned* bar, unsigned x, unsigned& nloc, unsigned& nx) {
    const unsigned G = gridDim.x * gridDim.y * gridDim.z;
    unsigned sum, cnt, mine, sp = 0u;
    for (;;) {
        sum = 0u; cnt = 0u; mine = 0u;
#pragma unroll
        for (unsigned j = 0; j < 16; ++j) { const unsigned c = xb_ld(&bar[XB_XCNT(j)]); sum += c; cnt += (c > 0u) ? 1u : 0u; mine = (j == x) ? c : mine; }
        if (sum == G) break;
        __builtin_amdgcn_s_sleep(1);
        if ((++sp & 255u) == 0u) { if (xb_ld(&bar[XB_TMO])) break; if (sp > XB_SPIN_CAP) { atomicAdd(&bar[XB_TMO], 1u); break; } }
    }
    nloc = mine > 0u ? mine : 1u; nx = cnt > 0u ? cnt : 1u;
}

__device__ __forceinline__ void xcd_barrier(const XcdBarrier& b) {
    asm volatile("s_waitcnt vmcnt(0)" ::: "memory");
    __syncthreads();
    if (threadIdx.x == 0) {
        unsigned* bar = b.bar;
        __builtin_amdgcn_s_waitcnt(0);
        unsigned nloc = b.st[0], nx = b.st[1];
        if (nloc == 0u) { xcd_barrier_complete(bar, b.x, nloc, nx); b.st[0] = nloc; b.st[1] = nx; }
        const unsigned old = xb_add(&bar[XB_XSUB(b.x)], 1u);
        const unsigned gen = old / nloc;
        if (old + 1u == (gen + 1u) * nloc) {
            __builtin_amdgcn_fence(__ATOMIC_RELEASE, "agent");
            asm volatile("s_waitcnt vmcnt(0)" ::: "memory");
            const unsigned og = xb_add(&bar[XB_TOP], 1u);
            const unsigned tg = og / nx;
            if (og + 1u == (tg + 1u) * nx) xb_add(&bar[XB_TOPGEN], 1u);
            else XB_SPIN(xb_ld(&bar[XB_TOPGEN]) == tg, bar);
            __builtin_amdgcn_fence(__ATOMIC_ACQUIRE, "agent");
            xb_add(&bar[XB_XGEN(b.x)], 1u);
            asm volatile("s_waitcnt vmcnt(0)" ::: "memory");
        } else {
            XB_SPIN(xb_ld(&bar[XB_XGEN(b.x)]) == gen, bar);
            __builtin_amdgcn_fence(__ATOMIC_ACQUIRE, "agent");
            asm volatile("s_waitcnt vmcnt(0)" ::: "memory");
        }
    }
    __syncthreads();
}
struct Frame {
    LAS unsigned char* lds;
    volatile LAS unsigned* MISC;
    unsigned* ctl;
    int tid, lane, wave, vcu, G, gw, NGW;
    float* out; unsigned char* ws;
};
typedef const float* const cfpc_t; typedef __attribute__((address_space(4))) cfpc_t* kargp_t;
__device__ __forceinline__ kargp_t kin() { kargp_t p = (kargp_t)__builtin_amdgcn_kernarg_segment_ptr(); asm volatile("" : "+s"(p)); return p; }
#define KIN(i) (kin()[i])
enum { I_X = 0, I_ABWIN, I_CONVA, I_CONVW, I_CONVB, I_DTB, I_ALOG, I_DSKIP, I_NORMW, I_ABWOUT, I_CDWIN, I_IB, I_FB, I_HNW, I_FOXB, I_CDWOUT, I_LN1G, I_LN1B, I_LN2G, I_LN2B,
       I_RGW, I_RGB, I_REW, I_REB, I_WG, I_WU, I_WDN };

__device__ __forceinline__ void row_load(const float* row, int lane, f32x4 (&v)[4]) {
#pragma unroll
    for (int j = 0; j < 4; ++j) v[j] = ((const f32x4*)row)[lane + 64 * j];
}
__device__ __forceinline__ void row_store_f32(float* row, int lane, const f32x4 (&v)[4]) {
#pragma unroll
    for (int j = 0; j < 4; ++j) ((f32x4*)row)[lane + 64 * j] = v[j];
}
__device__ __forceinline__ void row_store_bf16(bf16* row, int lane, const f32x4 (&v)[4]) {
#pragma unroll
    for (int j = 0; j < 4; ++j) { v2u w; w.x = pk2(v[j][0], v[j][1]); w.y = pk2(v[j][2], v[j][3]); ((v2u*)row)[lane + 64 * j] = w; }
}
__device__ __forceinline__ void row_load_bf16(const bf16* row, int lane, f32x4 (&v)[4]) {
#pragma unroll
    for (int j = 0; j < 4; ++j) { const v2u w = ((const v2u*)row)[lane + 64 * j]; v[j] = (f32x4){bflo(w.x), bfhi(w.x), bflo(w.y), bfhi(w.y)}; }
}
__device__ __forceinline__ void row_layernorm(f32x4 (&v)[4], const float* g, const float* b, int lane) {
    float s = 0.f;
#pragma unroll
    for (int j = 0; j < 4; ++j) s += (v[j][0] + v[j][1]) + (v[j][2] + v[j][3]);
    const float mean = wave_sum(s) * (1.f / D); float s2 = 0.f;
#pragma unroll
    for (int j = 0; j < 4; ++j) { v[j] = v[j] - mean; s2 += (v[j][0] * v[j][0] + v[j][1] * v[j][1]) + (v[j][2] * v[j][2] + v[j][3] * v[j][3]); }
    const float rstd = 1.0f / sqrtf(wave_sum(s2) * (1.f / D) + LN_EPS);
#pragma unroll
    for (int j = 0; j < 4; ++j) { const f32x4 gg = ((const f32x4*)g)[lane + 64 * j], bb = ((const f32x4*)b)[lane + 64 * j]; v[j] = v[j] * rstd * gg + bb; }
}
template <int n, int o, int N> struct RedStep {
    static __device__ __forceinline__ void run(float (&a)[N], int lane) { const bool up = (lane & o) != 0;
#pragma unroll
        for (int i = 0; i < n / 2; ++i) { const float keep = up ? a[i + n / 2] : a[i], send = up ? a[i] : a[i + n / 2]; a[i] = keep + __shfl_xor(send, o); }
        RedStep<n / 2, o / 2, N>::run(a, lane); }
};
template <int o, int N> struct RedStep<1, o, N> {
    static __device__ __forceinline__ void run(float (&a)[N], int) { float r = a[0];
#pragma unroll
        for (int oo = o; oo >= 1; oo >>= 1) r += __shfl_xor(r, oo);
        a[0] = r; }
};
template <int N> __device__ __forceinline__ float wave_reduce_multi(float (&a)[N], int lane) { RedStep<N, 32, N>::run(a, lane); return a[0]; }
__device__ __forceinline__ void row_proj16x2(const f32x4 (&v0)[4], const f32x4 (&v1)[4], const float* W, int ldw, int c0a, int c0b, float* sg0, float* sg1, int lane) {
    float a[16], b[16];
#pragma unroll
    for (int c = 0; c < 16; ++c) { a[c] = 0.f; b[c] = 0.f; }
#pragma unroll
    for (int j = 0; j < 4; ++j)
#pragma unroll
        for (int i = 0; i < 4; ++i) { const float x = v0[j][i], y = v1[j][i]; const float* wr = W + (size_t)(256 * j + 4 * lane + i) * ldw;
            const f32x4 w0 = *(const f32x4*)(wr + c0a), w1 = *(const f32x4*)(wr + c0a + 4), w2 = *(const f32x4*)(wr + c0b), w3 = *(const f32x4*)(wr + c0b + 4);
#pragma unroll
            for (int c = 0; c < 4; ++c) { a[c] += x * w0[c]; a[4 + c] += x * w1[c]; a[8 + c] += x * w2[c]; a[12 + c] += x * w3[c]; b[c] += y * w0[c]; b[4 + c] += y * w1[c]; b[8 + c] += y * w2[c]; b[12 + c] += y * w3[c]; } }
    const float r0 = wave_reduce_multi<16>(a, lane), r1 = wave_reduce_multi<16>(b, lane);
    if ((lane & 3) == 0) { sg0[lane >> 2] = r0; if (sg1) sg1[lane >> 2] = r1; }
}
__device__ __forceinline__ void row_gate_proj2(Frame& F, const f32x4 (&v0)[4], const f32x4 (&v1)[4], int layer, int m0, int m1) {
    float* sg0 = (float*)(F.ws + WS_SG) + (size_t)m0 * 16; float* sg1 = m1 >= 0 ? (float*)(F.ws + WS_SG) + (size_t)m1 * 16 : nullptr; const int j = layer >> 1;
    if ((layer & 1) == 0) row_proj16x2(v0, v1, KIN(I_ABWIN) + (size_t)j * D * AB_IN, AB_IN, 4096, 4104, sg0, sg1, F.lane);
    else                  row_proj16x2(v0, v1, KIN(I_CDWIN) + (size_t)j * D * CD_IN, CD_IN, 1536, 3592, sg0, sg1, F.lane);
}

__device__ __forceinline__ void transpose_tile(const float* W, int ldw, int k0, int n0, bf16* WT, int ldt, int drow0, float scale, const float* kscale, LAS float* scr, int lane) {
    const int rs = lane >> 3, c4 = 4 * (lane & 7);
    f32x4 v[8];
#pragma unroll
    for (int i = 0; i < 8; ++i) v[i] = *(const f32x4*)(W + (size_t)(k0 + 8 * i + rs) * ldw + n0 + c4);
#pragma unroll
    for (int i = 0; i < 8; ++i) { const int kk = 8 * i + rs; float sc = scale; if (kscale) sc *= kscale[kk]; LAS float* d = scr + kk * 33 + c4;
        d[0] = v[i][0] * sc; d[1] = v[i][1] * sc; d[2] = v[i][2] * sc; d[3] = v[i][3] * sc; }
    LDS_WAIT(); asm volatile("" ::: "memory");
    const int c = lane & 7;
#pragma unroll
    for (int j = 0; j < 4; ++j) { const int n = (lane >> 3) + 8 * j; const LAS float* s = scr + (8 * c) * 33 + n;
        v4u o; o.x = pk2(s[0 * 33], s[1 * 33]); o.y = pk2(s[2 * 33], s[3 * 33]); o.z = pk2(s[4 * 33], s[5 * 33]); o.w = pk2(s[6 * 33], s[7 * 33]);
        *(v4u*)(WT + (size_t)(drow0 + n) * ldt + k0 + 8 * c) = o; }
    LDS_WAIT(); asm volatile("" ::: "memory");
}
__device__ __forceinline__ void p_prologue(Frame& F) {
    LAS float* scr = (LAS float*)(F.lds + F.wave * 16384);
    bf16* WinE = (bf16*)(F.ws + WS_WINE); bf16* WinO = (bf16*)(F.ws + WS_WINO); bf16* WoutE = (bf16*)(F.ws + WS_WOUTE); bf16* WoutO = (bf16*)(F.ws + WS_WOUTO);
    bf16* Wgu = (bf16*)(F.ws + WS_WGU); bf16* Wd = (bf16*)(F.ws + WS_WD);
    constexpr int N_WINE = 2 * 2048, N_WINO = 2 * 1792, N_WOE = 2 * 768, N_WOO = 2 * 512, N_GU = 128 * 512, N_D = 128 * 256;
    constexpr int NITEMS = N_WINE + N_WINO + N_WOE + N_WOO + N_GU + N_D;
    for (int it = F.gw; it < NITEMS; it += F.NGW) {
        int r = it;
        if (r < N_WINE) { const int j = r / 2048, q = r % 2048, kb = q / 128, nb = q % 128;
            transpose_tile(KIN(I_ABWIN) + (size_t)j * D * AB_IN, AB_IN, 64 * kb, 32 * nb, WinE + (size_t)j * NPE * D, D, 32 * nb, 1.f, nullptr, scr, F.lane); continue; } r -= N_WINE;
        if (r < N_WINO) { const int j = r / 1792, q = r % 1792, seg = q / 256, q2 = q % 256, kb = q2 / 16, nb = q2 % 16;
            const int scol = (seg < 3 ? 512 * seg : 1544 + 512 * (seg - 3)) + 32 * nb; const float sc = seg == 1 ? MLSTM_KSCALE : (seg == 4 ? FOX_C2 : 1.f);
            transpose_tile(KIN(I_CDWIN) + (size_t)j * D * CD_IN, CD_IN, 64 * kb, scol, WinO + (size_t)j * NPO * D, D, 512 * seg + 32 * nb, sc, nullptr, scr, F.lane); continue; } r -= N_WINO;
        if (r < N_WOE) { const int j = r / 768, q = r % 768, kb = q / 32, nb = q % 32;
            const float* ks = kb >= 8 ? KIN(I_NORMW) + (size_t)j * 1024 + (64 * kb - 512) : nullptr;
            transpose_tile(KIN(I_ABWOUT) + (size_t)j * 1536 * D, D, 64 * kb, 32 * nb, WoutE + (size_t)j * D * 1536, 1536, 32 * nb, 1.f, ks, scr, F.lane); continue; } r -= N_WOE;
        if (r < N_WOO) { const int j = r / 512, q = r % 512, kb = q / 32, nb = q % 32;
            transpose_tile(KIN(I_CDWOUT) + (size_t)j * D * D, D, 64 * kb, 32 * nb, WoutO + (size_t)j * D * D, D, 32 * nb, 1.f, nullptr, scr, F.lane); continue; } r -= N_WOO;
        if (r < N_GU) { const int le = r / 512, q = r % 512, half = q / 256, q2 = q % 256, kb = q2 / 16, nb = q2 % 16, n0 = 32 * nb;
            const float* src = (half ? KIN(I_WU) : KIN(I_WG)) + (size_t)le * D * 512;
            transpose_tile(src, 512, 64 * kb, n0, Wgu + (size_t)le * D * D, D, 256 * (n0 / 128) + 128 * half + (n0 % 128), 1.f, nullptr, scr, F.lane); continue; } r -= N_GU;
        { const int le = r / 256, q = r % 256, kb = q / 32, nb = q % 32;
            transpose_tile(KIN(I_WDN) + (size_t)le * 512 * D, D, 64 * kb, 32 * nb, Wd + (size_t)le * D * 512, 512, 32 * nb, 1.f, nullptr, scr, F.lane); }
    }
    bf16* HB = (bf16*)(F.ws + WS_HB);
#pragma unroll 1
    for (int m0 = F.gw; m0 < T; m0 += 2 * F.NGW) { const int m1 = m0 + F.NGW < T ? m0 + F.NGW : -1, m1c = m1 >= 0 ? m1 : m0; f32x4 v0[4], v1[4];
        row_load(KIN(I_X) + (size_t)m0 * D, F.lane, v0); row_load(KIN(I_X) + (size_t)m1c * D, F.lane, v1);
        row_store_bf16(HB + (size_t)m0 * D, F.lane, v0); if (m1 >= 0) row_store_bf16(HB + (size_t)m1 * D, F.lane, v1);
        row_gate_proj2(F, v0, v1, 0, m0, m1); }
}
__device__ __forceinline__ void e0_conv(Frame& F, int j) {
    const bf16* P = (const bf16*)(F.ws + WS_R1); bf16* XBC = (bf16*)(F.ws + WS_R3); bf16* MIX = (bf16*)(F.ws + WS_MIX);
    const float* cw = KIN(I_CONVW) + (size_t)j * 4 * 1536; const float* cb = KIN(I_CONVB) + (size_t)j * 1536; const float* ca = KIN(I_CONVA) + (size_t)j * 3 * 512;
    constexpr int TT = 16;
    for (int it = F.gw; it < (T / TT) * 16; it += F.NGW) {
        const int tt = it >> 4, cg = it & 15, t0 = tt * TT, s0 = t0 & (SEQ - 1);
        if (cg < 12) {
            const int c = cg * 128 + 2 * F.lane;
            float w0[4], w1[4];
#pragma unroll
            for (int k = 0; k < 4; ++k) { w0[k] = cw[k * 1536 + c]; w1[k] = cw[k * 1536 + c + 1]; }
            const float b0 = cb[c], b1 = cb[c + 1];
            float xa[TT + 3], xb[TT + 3];
#pragma unroll
            for (int r = 0; r < TT + 3; ++r) { unsigned w = 0u; if (s0 - 3 + r >= 0) w = *(const unsigned*)(P + (size_t)(t0 - 3 + r) * NPE + 2560 + c); xa[r] = bflo(w); xb[r] = bfhi(w); }
#pragma unroll
            for (int o = 0; o < TT; ++o) { float a0 = b0, a1 = b1;
#pragma unroll
                for (int k = 0; k < 4; ++k) { a0 += w0[k] * xa[o + k]; a1 += w1[k] * xb[o + k]; }
                *(unsigned*)(XBC + (size_t)(t0 + o) * 1536 + c) = pk2(silu_f(a0), silu_f(a1)); }
        } else {
            const int c = (cg - 12) * 128 + 2 * F.lane;
            float w0[3], w1[3];
#pragma unroll
            for (int k = 0; k < 3; ++k) { w0[k] = ca[k * 512 + c]; w1[k] = ca[k * 512 + c + 1]; }
            float ua[TT + 2], ub[TT + 2]; unsigned bgw[TT];
#pragma unroll
            for (int o = 0; o < TT; ++o) bgw[o] = *(const unsigned*)(P + (size_t)(t0 + o) * NPE + c);
#pragma unroll
            for (int r = 0; r < TT + 2; ++r) { float a = 0.f, b = 0.f;
                if (s0 - 2 + r >= 0) { const bf16* pr = P + (size_t)(t0 - 2 + r) * NPE; const unsigned cgw = *(const unsigned*)(pr + 512 + c), xw = *(const unsigned*)(pr + 1024 + c); a = bflo(cgw) * bflo(xw); b = bfhi(cgw) * bfhi(xw); }
                ua[r] = a; ub[r] = b; }
#pragma unroll
            for (int o = 0; o < TT; ++o) { float a0 = 0.f, a1 = 0.f;
#pragma unroll
                for (int k = 0; k < 3; ++k) { a0 += w0[k] * ua[o + k]; a1 += w1[k] * ub[o + k]; }
                const unsigned bg = bgw[o];
                *(unsigned*)(MIX + (size_t)(t0 + o) * 1536 + c) = pk2(bflo(bg) * a0, bfhi(bg) * a1); }
        }
    }
}
__device__ __forceinline__ void ssd_gates(Frame& F, int j, int t0, int h, LAS float* dtl, LAS float* acs) {
    if (F.wave == 0) {
        const float* SG = (const float*)(F.ws + WS_SG); const float dtb = KIN(I_DTB)[j * 16 + h], aneg = -expf(KIN(I_ALOG)[j * 16 + h]);
        const float d0 = softplus_f(SG[(size_t)(t0 + 2 * F.lane) * 16 + h] + dtb), d1 = softplus_f(SG[(size_t)(t0 + 2 * F.lane + 1) * 16 + h] + dtb);
        const float a0 = d0 * aneg, a1 = d1 * aneg; const float inc = wave_scan_sum(a0 + a1, F.lane);
        dtl[2 * F.lane] = d0; dtl[2 * F.lane + 1] = d1; acs[2 * F.lane] = inc - a1; acs[2 * F.lane + 1] = inc;
    }
}
__device__ __forceinline__ void e1_states(Frame& F, int j) {
    const bf16* XBC = (const bf16*)(F.ws + WS_R3); float* ST = (float*)(F.ws + WS_R4); float* DEC = (float*)(F.ws + WS_DEC);
    LAS float* xw = (LAS float*)F.lds; LAS float* Bm = (LAS float*)(F.lds + 32768); LAS float* dtl = (LAS float*)(F.lds + SMALL_OFF); LAS float* acs = dtl + 128;
    for (int u = F.vcu; u < 2048; u += F.G) {
        const int b = u >> 8, c = (u >> 4) & 15, h = u & 15, g = h >> 2, t0 = b * SEQ + c * 128;
        __syncthreads();
        ssd_gates(F, j, t0, h, dtl, acs);
        __syncthreads();
        for (int i = F.tid; i < 128 * 32; i += 512) { const int l = i >> 5, pp = (i & 31) * 2; const float wgt = expf(acs[127] - acs[l]) * dtl[l];
            const unsigned xv = *(const unsigned*)(XBC + (size_t)(t0 + l) * 1536 + h * 64 + pp), bv = *(const unsigned*)(XBC + (size_t)(t0 + l) * 1536 + 1024 + g * 64 + pp);
            xw[l * 64 + pp] = bflo(xv) * wgt; xw[l * 64 + pp + 1] = bfhi(xv) * wgt; Bm[l * 64 + pp] = bflo(bv); Bm[l * 64 + pp + 1] = bfhi(bv); }
        __syncthreads();
        const int n = F.lane, p0 = 8 * F.wave; float acc[8];
#pragma unroll
        for (int i = 0; i < 8; ++i) acc[i] = 0.f;
#pragma unroll 2
        for (int l = 0; l < 128; ++l) { const float bm = Bm[l * 64 + n]; const f32x4 x0 = *(const LAS f32x4*)(xw + l * 64 + p0), x1 = *(const LAS f32x4*)(xw + l * 64 + p0 + 4);
#pragma unroll
            for (int i = 0; i < 4; ++i) { acc[i] += x0[i] * bm; acc[4 + i] += x1[i] * bm; } }
        float* dst = ST + (size_t)u * 4096;
#pragma unroll
        for (int i = 0; i < 8; ++i) dst[(p0 + i) * 64 + n] = acc[i];
        if (F.tid == 0) DEC[u] = expf(acs[127]);
    }
}
__device__ __forceinline__ void e2_scan(Frame& F) {
    float* ST = (float*)(F.ws + WS_R4); const float* DEC = (const float*)(F.ws + WS_DEC);
    for (int e = F.vcu * 512 + F.tid; e < NBATCH * 16 * 4096; e += F.G * 512) {
        const int b = e >> 16, h = (e >> 12) & 15, pn = e & 4095; float run = 0.f; float s[16], dc[16];
#pragma unroll
        for (int c = 0; c < 16; ++c) { const int u = (b * 16 + c) * 16 + h; s[c] = ST[(size_t)u * 4096 + pn]; dc[c] = DEC[u]; }
#pragma unroll
        for (int c = 0; c < 16; ++c) { const int u = (b * 16 + c) * 16 + h; ST[(size_t)u * 4096 + pn] = run; run = run * dc[c] + s[c]; }
    }
}
__device__ __forceinline__ void e3_output(Frame& F, int j) {
    const bf16* XBC = (const bf16*)(F.ws + WS_R3); const float* ST = (const float*)(F.ws + WS_R4); float* Y = (float*)(F.ws + WS_R2);
    LAS float* R0 = (LAS float*)F.lds;
    LAS float* R1 = (LAS float*)(F.lds + 32768);
    LAS float* R2 = (LAS float*)(F.lds + 65536);
    LAS float* dtl = (LAS float*)(F.lds + SMALL_OFF); LAS float* acs = dtl + 128;
    for (int u = F.vcu; u < 2048; u += F.G) {
        const int b = u >> 8, c = (u >> 4) & 15, h = u & 15, g = h >> 2, t0 = b * SEQ + c * 128;
        __syncthreads();
        ssd_gates(F, j, t0, h, dtl, acs);
        for (int i = F.tid; i < 128 * 32; i += 512) { const int l = i >> 5, nn = (i & 31) * 2;
            const unsigned bv = *(const unsigned*)(XBC + (size_t)(t0 + l) * 1536 + 1024 + g * 64 + nn), cv = *(const unsigned*)(XBC + (size_t)(t0 + l) * 1536 + 1280 + g * 64 + nn);
            R0[l * 64 + nn] = bflo(cv); R0[l * 64 + nn + 1] = bfhi(cv); R1[nn * 128 + l] = bflo(bv); R1[(nn + 1) * 128 + l] = bfhi(bv); }
        { const float* hp = ST + (size_t)u * 4096; for (int i = F.tid; i < 4096; i += 512) { const int p = i >> 6, n = i & 63; R2[n * 64 + p] = hp[i]; } }
        __syncthreads();
        const int p = F.lane, l0 = 16 * F.wave; float acc[16];
#pragma unroll
        for (int i = 0; i < 16; ++i) acc[i] = 0.f;
#pragma unroll 1
        for (int n0 = 0; n0 < 64; n0 += 4) { float hp[4];
#pragma unroll
            for (int i = 0; i < 4; ++i) hp[i] = R2[(n0 + i) * 64 + p];
#pragma unroll
            for (int li = 0; li < 16; ++li) { const f32x4 c4 = *(const LAS f32x4*)(R0 + (l0 + li) * 64 + n0); acc[li] += (c4[0] * hp[0] + c4[1] * hp[1]) + (c4[2] * hp[2] + c4[3] * hp[3]); } }
#pragma unroll
        for (int li = 0; li < 16; ++li) acc[li] *= expf(acs[l0 + li]);
        __syncthreads();
#pragma unroll 1
        for (int half = 0; half < 2; ++half) { const int s = F.tid & 127, lg = 32 * (F.tid >> 7) + 16 * half; float gacc[16];
#pragma unroll
            for (int i = 0; i < 16; ++i) gacc[i] = 0.f;
#pragma unroll 1
            for (int n0 = 0; n0 < 64; n0 += 4) { float bb[4];
#pragma unroll
                for (int i = 0; i < 4; ++i) bb[i] = R1[(n0 + i) * 128 + s];
#pragma unroll
                for (int li = 0; li < 16; ++li) { const f32x4 c4 = *(const LAS f32x4*)(R0 + (lg + li) * 64 + n0); gacc[li] += (c4[0] * bb[0] + c4[1] * bb[1]) + (c4[2] * bb[2] + c4[3] * bb[3]); } }
            const float as = acs[s];
#pragma unroll
            for (int li = 0; li < 16; ++li) { const int l = lg + li; R2[l * 128 + s] = (s <= l) ? gacc[li] * expf(acs[l] - as) : 0.f; } }
        __syncthreads();
        for (int i = F.tid; i < 128 * 32; i += 512) { const int l = i >> 5, pp = (i & 31) * 2; const unsigned xv = *(const unsigned*)(XBC + (size_t)(t0 + l) * 1536 + h * 64 + pp);
            R0[l * 64 + pp] = bflo(xv); R0[l * 64 + pp + 1] = bfhi(xv); }
        __syncthreads();
#pragma unroll 1
        for (int s0 = 0; s0 < l0 + 16; s0 += 4) { float xv[4];
#pragma unroll
            for (int i = 0; i < 4; ++i) xv[i] = R0[(s0 + i) * 64 + p] * dtl[s0 + i];
#pragma unroll
            for (int li = 0; li < 16; ++li) { const f32x4 g4 = *(const LAS f32x4*)(R2 + (l0 + li) * 128 + s0); acc[li] += (g4[0] * xv[0] + g4[1] * xv[1]) + (g4[2] * xv[2] + g4[3] * xv[3]); } }
        const float dsk = KIN(I_DSKIP)[j * 16 + h];
#pragma unroll
        for (int li = 0; li < 16; ++li) Y[(size_t)(t0 + l0 + li) * D + h * 64 + p] = acc[li] + dsk * R0[(l0 + li) * 64 + p];
    }
}
__device__ __forceinline__ void e4_gnorm(Frame& F) {
    const float* Y = (const float*)(F.ws + WS_R2); const bf16* P = (const bf16*)(F.ws + WS_R1); bf16* MIX = (bf16*)(F.ws + WS_MIX);
#pragma unroll 1
    for (int m0 = F.gw; m0 < T; m0 += 2 * F.NGW) { const int m1 = m0 + F.NGW < T ? m0 + F.NGW : m0; const int mm[2] = {m0, m1}; f32x4 y[2][4], z[2][4]; float rstd[2];
#pragma unroll
        for (int rr = 0; rr < 2; ++rr) { row_load(Y + (size_t)mm[rr] * D, F.lane, y[rr]); row_load_bf16(P + (size_t)mm[rr] * NPE + 1536, F.lane, z[rr]); }
#pragma unroll
        for (int rr = 0; rr < 2; ++rr) { float ss = 0.f;
#pragma unroll
            for (int jj = 0; jj < 4; ++jj)
#pragma unroll
                for (int i = 0; i < 4; ++i) { const float uu = y[rr][jj][i] * silu_f(z[rr][jj][i]); y[rr][jj][i] = uu; ss += uu * uu; }
            rstd[rr] = 1.0f / sqrtf(wave_sum(ss) * (1.f / D) + LN_EPS); }
#pragma unroll
        for (int rr = 0; rr < 2; ++rr) {
#pragma unroll
            for (int jj = 0; jj < 4; ++jj) y[rr][jj] = y[rr][jj] * rstd[rr];
            if (rr == 0 || m1 != m0) row_store_bf16(MIX + (size_t)mm[rr] * 1536 + 512, F.lane, y[rr]); } }
}
__device__ __forceinline__ void o_foxscan(Frame& F, int j) {
    const float* SG = (const float*)(F.ws + WS_SG); float* FOXC = (float*)(F.ws + WS_FOXC);
    for (int bh = F.gw; bh < 64; bh += F.NGW) { const int b = bh >> 3, h = bh & 7; const float bias = KIN(I_FOXB)[j * 8 + h];
        float v[32], run = 0.f;
#pragma unroll
        for (int i = 0; i < 32; ++i) { run += logsigmoid_f(SG[(size_t)(b * SEQ + 32 * F.lane + i) * 16 + 8 + h] + bias); v[i] = run; }
        const float off = wave_scan_sum(run, F.lane) - run;
#pragma unroll
        for (int i = 0; i < 32; ++i) FOXC[(size_t)bh * SEQ + 32 * F.lane + i] = (v[i] + off) * LOG2E; }
}
__device__ __forceinline__ void mlstm_gates(Frame& F, int j, int t0, int h, float& bcum, float& ib) {
    const float* SG = (const float*)(F.ws + WS_SG);
    ib = SG[(size_t)(t0 + F.lane) * 16 + h] + KIN(I_IB)[j * 4 + h];
    bcum = wave_scan_sum(logsigmoid_f(SG[(size_t)(t0 + F.lane) * 16 + 4 + h] + KIN(I_FB)[j * 4 + h]), F.lane);
}
__device__ __forceinline__ void o1_local(Frame& F, int j) {
    const bf16* P = (const bf16*)(F.ws + WS_R1); float* KLOC = (float*)(F.ws + WS_R2); float* NLOC = (float*)(F.ws + WS_NLOC); float* MLOC = (float*)(F.ws + WS_MLOC); float* BLAST = (float*)(F.ws + WS_BLAST);
    LAS float* kw = (LAS float*)F.lds; LAS float* Vs = (LAS float*)(F.lds + 32768); LAS float* wk = (LAS float*)(F.lds + SMALL_OFF);
    for (int u = F.vcu; u < 1024; u += F.G) {
        const int b = u >> 7, h = (u >> 5) & 3, c = u & 31, t0 = b * SEQ + c * 64;
        __syncthreads();
        if (F.wave == 0) { float bcum, ib; mlstm_gates(F, j, t0, h, bcum, ib); const float blast = __shfl(bcum, 63); const float gl = blast - bcum + ib; const float ml = wave_max(gl);
            wk[F.lane] = expf(gl - ml); if (F.lane == 0) { MLOC[u] = ml; BLAST[u] = blast; } }
        __syncthreads();
        for (int i = F.tid; i < 64 * 64; i += 512) { const int s = i >> 6, dd = (i & 63) * 2; const float w = wk[s];
            const unsigned kv = *(const unsigned*)(P + (size_t)(t0 + s) * NPO + 512 + h * 128 + dd), vv = *(const unsigned*)(P + (size_t)(t0 + s) * NPO + 1024 + h * 128 + dd);
            kw[s * 128 + dd] = bflo(kv) * w; kw[s * 128 + dd + 1] = bfhi(kv) * w; Vs[s * 128 + dd] = bflo(vv); Vs[s * 128 + dd + 1] = bfhi(vv); }
        __syncthreads();
        const int v = F.tid & 127, d0 = 32 * (F.tid >> 7); float acc[32];
#pragma unroll
        for (int i = 0; i < 32; ++i) acc[i] = 0.f;
#pragma unroll 1
        for (int s = 0; s < 64; ++s) { const float vv = Vs[s * 128 + v];
#pragma unroll
            for (int di = 0; di < 32; di += 4) { const f32x4 k4 = *(const LAS f32x4*)(kw + s * 128 + d0 + di);
#pragma unroll
                for (int i = 0; i < 4; ++i) acc[di + i] += k4[i] * vv; } }
        float* dst = KLOC + (size_t)u * 16384;
#pragma unroll
        for (int i = 0; i < 32; ++i) dst[(d0 + i) * 128 + v] = acc[i];
        if (F.tid < 128) { float a = 0.f; for (int s = 0; s < 64; ++s) a += kw[s * 128 + F.tid]; NLOC[(size_t)u * 128 + F.tid] = a; }
    }
}
__device__ __forceinline__ void o2_scan(Frame& F) {
    float* KLOC = (float*)(F.ws + WS_R2); float* NLOC = (float*)(F.ws + WS_NLOC); const float* MLOC = (const float*)(F.ws + WS_MLOC); const float* BLAST = (const float*)(F.ws + WS_BLAST); float* MPREV = (float*)(F.ws + WS_MPREV);
    constexpr int PER = 16384 + 128;
    for (int e = F.vcu * 512 + F.tid; e < 32 * PER; e += F.G * 512) {
        const int bh = e / PER, r = e % PER; float run = 0.f, m = 0.f;
#pragma unroll 1
        for (int c0 = 0; c0 < 32; c0 += 16) { float loc[16], bl[16], ml[16];
#pragma unroll
            for (int i = 0; i < 16; ++i) { const int u = bh * 32 + c0 + i; const float* p = r < 16384 ? KLOC + (size_t)u * 16384 + r : NLOC + (size_t)u * 128 + (r - 16384); loc[i] = *p; bl[i] = BLAST[u]; ml[i] = MLOC[u]; }
#pragma unroll
            for (int i = 0; i < 16; ++i) { const int u = bh * 32 + c0 + i; float* p = r < 16384 ? KLOC + (size_t)u * 16384 + r : NLOC + (size_t)u * 128 + (r - 16384);
                *p = run; if (r == 0) MPREV[u] = m;
                const float mn = fmaxf(bl[i] + m, ml[i]);
                run = expf(bl[i] + m - mn) * run + expf(ml[i] - mn) * loc[i]; m = mn; } }
    }
}
__device__ __forceinline__ void o3_output(Frame& F, int j) {
    const bf16* P = (const bf16*)(F.ws + WS_R1); const float* CPREV = (const float*)(F.ws + WS_R2); const float* NPREV = (const float*)(F.ws + WS_NLOC); const float* MPREV = (const float*)(F.ws + WS_MPREV); bf16* MIX = (bf16*)(F.ws + WS_MIX);
    LAS float* qT = (LAS float*)F.lds;
    LAS float* kT = (LAS float*)(F.lds + 32768);
    LAS float* Vs = (LAS float*)(F.lds + 65536);
    LAS float* WT = (LAS float*)(F.lds + 98304);
    LAS float* sm = (LAS float*)(F.lds + SMALL_OFF);
    for (int u = F.vcu; u < 1024; u += F.G) {
        const int b = u >> 7, h = (u >> 5) & 3, c = u & 31, t0 = b * SEQ + c * 64;
        __syncthreads();
        if (F.wave == 0) { float bcum, ib; mlstm_gates(F, j, t0, h, bcum, ib); const float mprev = MPREV[u];
            const float pm = wave_scan_max(ib - bcum, F.lane); const float inter = bcum + mprev; const float mt = fmaxf(bcum + pm, inter);
            sm[F.lane] = bcum; sm[64 + F.lane] = ib; sm[128 + F.lane] = mt; sm[192 + F.lane] = expf(inter - mt); }
        for (int i = F.tid; i < 64 * 64; i += 512) { const int s = i >> 6, dd = (i & 63) * 2; const bf16* pr = P + (size_t)(t0 + s) * NPO + h * 128 + dd;
            const unsigned qv = *(const unsigned*)pr, kv = *(const unsigned*)(pr + 512), vv = *(const unsigned*)(pr + 1024);
            qT[dd * 64 + s] = bflo(qv); qT[(dd + 1) * 64 + s] = bfhi(qv); kT[dd * 64 + s] = bflo(kv); kT[(dd + 1) * 64 + s] = bfhi(kv); Vs[s * 128 + dd] = bflo(vv); Vs[s * 128 + dd + 1] = bfhi(vv); }
        __syncthreads();
        { const int s = F.lane, l0 = 8 * F.wave; float acc[8];
#pragma unroll
            for (int i = 0; i < 8; ++i) acc[i] = 0.f;
#pragma unroll 2
            for (int d = 0; d < 128; ++d) { const float kk = kT[d * 64 + s]; const f32x4 q0 = *(const LAS f32x4*)(qT + d * 64 + l0), q1 = *(const LAS f32x4*)(qT + d * 64 + l0 + 4);
#pragma unroll
                for (int i = 0; i < 4; ++i) { acc[i] += q0[i] * kk; acc[4 + i] += q1[i] * kk; } }
            const float gs = sm[64 + s] - sm[s];
#pragma unroll
            for (int i = 0; i < 8; ++i) { const int l = l0 + i; const float w = (s <= l) ? acc[i] * expf(sm[l] + gs - sm[128 + l]) : 0.f; WT[s * 64 + l] = w; const float dsum = wave_sum(w); if (F.lane == 0) sm[256 + l] = dsum; } }
        __syncthreads();
        if (F.tid < 64) { const int l = F.tid; float qn = 0.f; const float* np = NPREV + (size_t)u * 128; for (int d = 0; d < 128; ++d) qn += qT[d * 64 + l] * np[d]; sm[256 + l] += sm[192 + l] * qn; }
        const int v = F.tid & 127, l0 = 16 * (F.tid >> 7); float acc[16];
#pragma unroll
        for (int i = 0; i < 16; ++i) acc[i] = 0.f;
        { const float* cp = CPREV + (size_t)u * 16384;
#pragma unroll 2
            for (int d = 0; d < 128; ++d) { const float cc = cp[d * 128 + v];
#pragma unroll
                for (int li = 0; li < 16; li += 4) { const f32x4 q4 = *(const LAS f32x4*)(qT + d * 64 + l0 + li);
#pragma unroll
                    for (int i = 0; i < 4; ++i) acc[li + i] += q4[i] * cc; } } }
#pragma unroll
        for (int i = 0; i < 16; ++i) acc[i] *= sm[192 + l0 + i];
#pragma unroll 2
        for (int s = 0; s < 64; ++s) { const float vv = Vs[s * 128 + v];
#pragma unroll
            for (int li = 0; li < 16; li += 4) { const f32x4 w4 = *(const LAS f32x4*)(WT + s * 64 + l0 + li);
#pragma unroll
                for (int i = 0; i < 4; ++i) acc[li + i] += w4[i] * vv; } }
        __syncthreads();
        LAS float* hb = kT;
#pragma unroll
        for (int i = 0; i < 16; ++i) { const int l = l0 + i; const float hv = acc[i] / fmaxf(fabsf(sm[256 + l]), expf(-sm[128 + l])); acc[i] = hv; hb[l * 128 + v] = hv; }
        __syncthreads();
        { const int lb = 8 * F.wave;
#pragma unroll
            for (int i = 0; i < 8; ++i) { const int l = lb + i; const float a = hb[l * 128 + F.lane], bq = hb[l * 128 + 64 + F.lane]; const float mu = wave_sum(a + bq) * (1.f / 128.f);
                const float da = a - mu, db = bq - mu; const float var = wave_sum(da * da + db * db) * (1.f / 128.f); if (F.lane == 0) { sm[320 + l] = mu; sm[384 + l] = 1.0f / sqrtf(var + LN_EPS); } } }
        __syncthreads();
        const float hw = KIN(I_HNW)[j * 512 + h * 128 + v];
#pragma unroll
        for (int i = 0; i < 16; ++i) { const int l = l0 + i; const float og = sigmoid_f(bf2f(P[(size_t)(t0 + l) * NPO + 1536 + h * 128 + v]));
            MIX[(size_t)(t0 + l) * D + h * 128 + v] = (bf16)f2bf(og * (acc[i] - sm[320 + l]) * sm[384 + l] * hw); }
    }
}
__device__ __forceinline__ void o4_fox(Frame& F) {
    const bf16* P = (const bf16*)(F.ws + WS_R1); const float* FOXC = (const float*)(F.ws + WS_FOXC); bf16* MIX = (bf16*)(F.ws + WS_MIX);
    LAS float* QT = (LAS float*)F.lds;
    LAS float* KT = (LAS float*)(F.lds + 16384);
    LAS float* Vs = (LAS float*)(F.lds + 32768);
    LAS float* PT = (LAS float*)(F.lds + 49152) + F.wave * 512;
    LAS float* cq = (LAS float*)(F.lds + SMALL_OFF); LAS float* ck = cq + 64;
    for (int it = F.vcu; it < 2048; it += F.G) {
        const int qt = 31 - (it >> 6), bh = it & 63, b = bh >> 3, h = bh & 7, tq0 = b * SEQ + qt * 64;
        __syncthreads();
        for (int i = F.tid; i < 64 * 32; i += 512) { const int q = i >> 5, dd = (i & 31) * 2; const unsigned w = *(const unsigned*)(P + (size_t)(tq0 + q) * NPO + 2048 + h * 64 + dd); QT[dd * 64 + q] = bflo(w); QT[(dd + 1) * 64 + q] = bfhi(w); }
        if (F.tid < 64) cq[F.tid] = FOXC[(size_t)bh * SEQ + qt * 64 + F.tid];
        const int q0 = 8 * F.wave; float mrun[8], lrun[8], o[8];
#pragma unroll
        for (int i = 0; i < 8; ++i) { mrun[i] = -INFINITY; lrun[i] = 0.f; o[i] = 0.f; }
#pragma unroll 1
        for (int kt = 0; kt <= qt; ++kt) { const int tk0 = b * SEQ + kt * 64;
            __syncthreads();
            for (int i = F.tid; i < 64 * 32; i += 512) { const int k = i >> 5, dd = (i & 31) * 2; const bf16* pr = P + (size_t)(tk0 + k) * NPO + h * 64 + dd; const unsigned kw = *(const unsigned*)(pr + 2560), vw = *(const unsigned*)(pr + 3072);
                KT[dd * 64 + k] = bflo(kw); KT[(dd + 1) * 64 + k] = bfhi(kw); Vs[k * 64 + dd] = bflo(vw); Vs[k * 64 + dd + 1] = bfhi(vw); }
            if (F.tid < 64) ck[F.tid] = FOXC[(size_t)bh * SEQ + kt * 64 + F.tid];
            __syncthreads();
            float s[8];
#pragma unroll
            for (int i = 0; i < 8; ++i) s[i] = 0.f;
#pragma unroll 2
            for (int d = 0; d < 64; ++d) { const float kk = KT[d * 64 + F.lane]; const f32x4 qa = *(const LAS f32x4*)(QT + d * 64 + q0), qb = *(const LAS f32x4*)(QT + d * 64 + q0 + 4);
#pragma unroll
                for (int i = 0; i < 4; ++i) { s[i] += qa[i] * kk; s[4 + i] += qb[i] * kk; } }
            const float ckv = ck[F.lane];
#pragma unroll
            for (int i = 0; i < 8; ++i) { float sv = s[i] + cq[q0 + i] - ckv; if (kt == qt && F.lane > q0 + i) sv = -INFINITY;
                const float mn = fmaxf(mrun[i], wave_max(sv)); const float p = exp2f(sv - mn), al = exp2f(mrun[i] - mn);
                lrun[i] = lrun[i] * al + wave_sum(p); o[i] *= al; mrun[i] = mn; PT[F.lane * 8 + i] = p; }
            LDS_WAIT(); asm volatile("" ::: "memory");
#pragma unroll 2
            for (int k = 0; k < 64; ++k) { const float vv = Vs[k * 64 + F.lane]; const f32x4 pa = *(const LAS f32x4*)(PT + k * 8), pb = *(const LAS f32x4*)(PT + k * 8 + 4);
#pragma unroll
                for (int i = 0; i < 4; ++i) { o[i] += pa[i] * vv; o[4 + i] += pb[i] * vv; } }
        }
#pragma unroll
        for (int i = 0; i < 8; ++i) MIX[(size_t)(tq0 + q0 + i) * D + 512 + h * 64 + F.lane] = (bf16)f2bf(o[i] / lrun[i]);
    }
}
typedef short bf16x8 __attribute__((ext_vector_type(8)));
typedef float f32x16 __attribute__((ext_vector_type(16)));
typedef __bf16 bf16x2_t __attribute__((ext_vector_type(2)));
#define MFMA32(a, b, c) __builtin_amdgcn_mfma_f32_32x32x16_bf16((a), (b), (c), 0, 0, 0)
__device__ __forceinline__ int crow(int r, int h) { return (r & 3) + 8 * (r >> 2) + 4 * h; }
__device__ __forceinline__ unsigned cvtpk(float lo, float hi) { const f32x2 v = {lo, hi}; const bf16x2_t b = __builtin_convertvector(v, bf16x2_t); return __builtin_bit_cast(unsigned, b); }
__device__ __forceinline__ bf16x8 pack8(float a0, float a1, float a2, float a3, float a4, float a5, float a6, float a7) {
    v4u p; p.x = cvtpk(a0, a1); p.y = cvtpk(a2, a3); p.z = cvtpk(a4, a5); p.w = cvtpk(a6, a7); return __builtin_bit_cast(bf16x8, p); }
__device__ __forceinline__ bf16x8 pack_step(const f32x16& x, int s) { return pack8(x[8 * s], x[8 * s + 1], x[8 * s + 2], x[8 * s + 3], x[8 * s + 4], x[8 * s + 5], x[8 * s + 6], x[8 * s + 7]); }
__device__ __forceinline__ bf16x8 ldg8_f32(const float* p) { const f32x4 a = *(const f32x4*)p, b = *(const f32x4*)(p + 4); return pack8(a[0], a[1], a[2], a[3], b[0], b[1], b[2], b[3]); }
__device__ __forceinline__ bf16x8 lds_nat(const LAS bf16* row, int ks, int h) { return *(const LAS bf16x8*)(row + 16 * ks + 8 * h); }
__device__ __forceinline__ bf16x8 lds_krow(const LAS bf16* row, int k0, int h) { const v2u lo = *(const LAS v2u*)(row + k0 + 4 * h), hi = *(const LAS v2u*)(row + k0 + 8 + 4 * h);
    v4u p; p.x = lo.x; p.y = lo.y; p.z = hi.x; p.w = hi.y; return __builtin_bit_cast(bf16x8, p); }
__device__ __forceinline__ f32x16 zero16() { f32x16 z;
#pragma unroll
    for (int i = 0; i < 16; ++i) z[i] = 0.f;
    return z; }

__device__ __forceinline__ void ssd_gates4(Frame& F, int j, int t0, int g, LAS float* DT, LAS float* ACS) {
    if (F.wave < 4) { const int h = 4 * g + F.wave; const float* SG = (const float*)(F.ws + WS_SG); const float dtb = KIN(I_DTB)[j * 16 + h], aneg = -expf(KIN(I_ALOG)[j * 16 + h]);
        const float d0 = softplus_f(SG[(size_t)(t0 + 2 * F.lane) * 16 + h] + dtb), d1 = softplus_f(SG[(size_t)(t0 + 2 * F.lane + 1) * 16 + h] + dtb);
        const float a0 = d0 * aneg, a1 = d1 * aneg; const float inc = wave_scan_sum(a0 + a1, F.lane);
        DT[F.wave * 128 + 2 * F.lane] = d0; DT[F.wave * 128 + 2 * F.lane + 1] = d1; ACS[F.wave * 128 + 2 * F.lane] = inc - a1; ACS[F.wave * 128 + 2 * F.lane + 1] = inc; }
}
__device__ __forceinline__ void ssd_stage_xt(Frame& F, const bf16* XBC, int t0, int g, LAS bf16* XT, const LAS float* WGT) {
    for (int i = F.tid; i < 2048; i += 512) { const int cp = i & 127, s0 = 8 * (i >> 7), hl = cp >> 5; float a[8], bq[8];
#pragma unroll
        for (int k = 0; k < 8; ++k) { const unsigned w = *(const unsigned*)(XBC + (size_t)(t0 + s0 + k) * 1536 + g * 256 + 2 * cp); const float wg = WGT[hl * 128 + s0 + k]; a[k] = bflo(w) * wg; bq[k] = bfhi(w) * wg; }
        *(LAS bf16x8*)(XT + (2 * cp) * 136 + s0) = pack8(a[0], a[1], a[2], a[3], a[4], a[5], a[6], a[7]);
        *(LAS bf16x8*)(XT + (2 * cp + 1) * 136 + s0) = pack8(bq[0], bq[1], bq[2], bq[3], bq[4], bq[5], bq[6], bq[7]); }
}
__device__ __forceinline__ void e1_states_mfma(Frame& F, int j) {
    const bf16* XBC = (const bf16*)(F.ws + WS_R3); float* ST = (float*)(F.ws + WS_R4); float* DEC = (float*)(F.ws + WS_DEC);
    LAS bf16* XT = (LAS bf16*)F.lds; LAS bf16* BT = (LAS bf16*)(F.lds + 69632);
    LAS float* DT = (LAS float*)(F.lds + 98304); LAS float* ACS = DT + 512; LAS float* WGT = DT + 1024;
    for (int u = F.vcu; u < 512; u += F.G) {
        const int b = u >> 6, c = (u >> 2) & 15, g = u & 3, t0 = b * SEQ + c * 128;
        __syncthreads();
        ssd_gates4(F, j, t0, g, DT, ACS);
        { const int np = F.tid & 31, l0 = 8 * (F.tid >> 5); float a[8], bq[8];
#pragma unroll
            for (int k = 0; k < 8; ++k) { const unsigned w = *(const unsigned*)(XBC + (size_t)(t0 + l0 + k) * 1536 + 1024 + g * 64 + 2 * np); a[k] = bflo(w); bq[k] = bfhi(w); }
            *(LAS bf16x8*)(BT + (2 * np) * 136 + l0) = pack8(a[0], a[1], a[2], a[3], a[4], a[5], a[6], a[7]);
            *(LAS bf16x8*)(BT + (2 * np + 1) * 136 + l0) = pack8(bq[0], bq[1], bq[2], bq[3], bq[4], bq[5], bq[6], bq[7]); }
        __syncthreads();
        { const int hl = F.tid >> 7, l = F.tid & 127; WGT[F.tid] = expf(ACS[hl * 128 + 127] - ACS[F.tid]) * DT[F.tid]; if (l == 127) DEC[(b * 16 + c) * 16 + 4 * g + hl] = expf(ACS[F.tid]); }
        __syncthreads();
        ssd_stage_xt(F, XBC, t0, g, XT, WGT);
        __syncthreads();
        const int hl = F.wave >> 1, nt = F.wave & 1, li = F.lane & 31, hh = F.lane >> 5;
        f32x16 acc0 = zero16(), acc1 = zero16();
        const LAS bf16* ar0 = XT + (hl * 64 + li) * 136; const LAS bf16* ar1 = ar0 + 32 * 136; const LAS bf16* br = BT + (32 * nt + li) * 136;
#pragma unroll
        for (int ks = 0; ks < 8; ++ks) { const bf16x8 bf = lds_nat(br, ks, hh); acc0 = MFMA32(lds_nat(ar0, ks, hh), bf, acc0); acc1 = MFMA32(lds_nat(ar1, ks, hh), bf, acc1); }
        float* dst = ST + (size_t)((b * 16 + c) * 16 + 4 * g + hl) * 4096 + 32 * nt + li;
#pragma unroll
        for (int r = 0; r < 16; ++r) { dst[crow(r, hh) * 64] = acc0[r]; dst[(32 + crow(r, hh)) * 64] = acc1[r]; }
    }
}
__device__ __forceinline__ void e3_output_mfma(Frame& F, int j) {
    const bf16* XBC = (const bf16*)(F.ws + WS_R3); const float* ST = (const float*)(F.ws + WS_R4); float* Y = (float*)(F.ws + WS_R2);
    LAS bf16* CR = (LAS bf16*)F.lds; LAS bf16* BR = (LAS bf16*)(F.lds + 18432); LAS bf16* XT = (LAS bf16*)(F.lds + 36864);
    LAS float* DT = (LAS float*)(F.lds + 106496); LAS float* ACS = DT + 512;
    for (int u = F.vcu; u < 512; u += F.G) {
        const int b = u >> 6, c = (u >> 2) & 15, g = u & 3, t0 = b * SEQ + c * 128;
        __syncthreads();
        ssd_gates4(F, j, t0, g, DT, ACS);
        for (int i = F.tid; i < 1024; i += 512) { const int l = i >> 3, ch = i & 7; const bf16* src = XBC + (size_t)(t0 + l) * 1536 + 1024 + g * 64 + 8 * ch;
            *(LAS v4u*)(BR + l * 72 + 8 * ch) = *(const v4u*)src; *(LAS v4u*)(CR + l * 72 + 8 * ch) = *(const v4u*)(src + 256); }
        __syncthreads();
        ssd_stage_xt(F, XBC, t0, g, XT, DT);
        __syncthreads();
        const int hl = F.wave >> 1, half = F.wave & 1, li = F.lane & 31, hh = F.lane >> 5, habs = 4 * g + hl;
        const LAS float* acs = ACS + hl * 128; const LAS float* dtl = DT + hl * 128;
        bf16x8 hp[2][4];
        { const float* hsrc = ST + (size_t)((b * 16 + c) * 16 + habs) * 4096;
#pragma unroll
            for (int pt = 0; pt < 2; ++pt)
#pragma unroll
                for (int ks = 0; ks < 4; ++ks) hp[pt][ks] = ldg8_f32(hsrc + (32 * pt + li) * 64 + 16 * ks + 8 * hh); }
        const float dsk = KIN(I_DSKIP)[j * 16 + habs];
#pragma unroll
        for (int q = 0; q < 2; ++q) { const int lt = half ? 1 + q : 3 * q;
            f32x16 acc[2]; acc[0] = zero16(); acc[1] = zero16();
            const LAS bf16* crl = CR + (32 * lt + li) * 72;
#pragma unroll
            for (int ks = 0; ks < 4; ++ks) { const bf16x8 cf = lds_nat(crl, ks, hh); acc[0] = MFMA32(cf, hp[0][ks], acc[0]); acc[1] = MFMA32(cf, hp[1][ks], acc[1]); }
#pragma unroll
            for (int a4 = 0; a4 < 4; ++a4) { const f32x4 av = *(const LAS f32x4*)(acs + 32 * lt + 8 * a4 + 4 * hh);
#pragma unroll
                for (int i = 0; i < 4; ++i) { const float e = expf(av[i]); acc[0][4 * a4 + i] *= e; acc[1][4 * a4 + i] *= e; } }
            const float acl = acs[32 * lt + li];
            for (int st = 0; st <= lt; ++st) {
                f32x16 gt = zero16(); const LAS bf16* brs = BR + (32 * st + li) * 72;
#pragma unroll
                for (int ks = 0; ks < 4; ++ks) gt = MFMA32(lds_nat(brs, ks, hh), lds_nat(crl, ks, hh), gt);
#pragma unroll
                for (int a4 = 0; a4 < 4; ++a4) { const f32x4 av = *(const LAS f32x4*)(acs + 32 * st + 8 * a4 + 4 * hh);
#pragma unroll
                    for (int i = 0; i < 4; ++i) { const int r = 4 * a4 + i; const float e = expf(acl - av[i]); gt[r] = (st < lt || crow(r, hh) <= li) ? gt[r] * e : 0.f; } }
                const bf16x8 g0 = pack_step(gt, 0), g1 = pack_step(gt, 1);
#pragma unroll
                for (int pt = 0; pt < 2; ++pt) { const LAS bf16* xr = XT + (hl * 64 + 32 * pt + li) * 136 + 32 * st;
                    acc[pt] = MFMA32(g0, lds_krow(xr, 0, hh), acc[pt]); acc[pt] = MFMA32(g1, lds_krow(xr, 16, hh), acc[pt]); } }
#pragma unroll
            for (int pt = 0; pt < 2; ++pt) { const LAS bf16* xr = XT + (hl * 64 + 32 * pt + li) * 136 + 32 * lt; float* yp = Y + (size_t)(t0 + 32 * lt) * D + habs * 64 + 32 * pt + li;
#pragma unroll
                for (int r = 0; r < 16; ++r) { const int l = crow(r, hh); yp[(size_t)l * D] = acc[pt][r] + dsk * bf2f(xr[l]) / dtl[32 * lt + l]; } }
        }
    }
}
__device__ __forceinline__ void mlstm_stage_t(Frame& F, const bf16* P, int t0, int col0, LAS bf16* DST, const LAS float* wk) {
    const int vp = F.tid & 63, s0 = 8 * (F.tid >> 6); float a[8], bq[8];
#pragma unroll
    for (int k = 0; k < 8; ++k) { const unsigned w = *(const unsigned*)(P + (size_t)(t0 + s0 + k) * NPO + col0 + 2 * vp); const float wg = wk ? wk[s0 + k] : 1.f; a[k] = bflo(w) * wg; bq[k] = bfhi(w) * wg; }
    *(LAS bf16x8*)(DST + (2 * vp) * 72 + s0) = pack8(a[0], a[1], a[2], a[3], a[4], a[5], a[6], a[7]);
    *(LAS bf16x8*)(DST + (2 * vp + 1) * 72 + s0) = pack8(bq[0], bq[1], bq[2], bq[3], bq[4], bq[5], bq[6], bq[7]);
}
__device__ __forceinline__ void o1_local_mfma(Frame& F, int j) {
    const bf16* P = (const bf16*)(F.ws + WS_R1); float* KLOC = (float*)(F.ws + WS_R2); float* NLOC = (float*)(F.ws + WS_NLOC); float* MLOC = (float*)(F.ws + WS_MLOC); float* BLAST = (float*)(F.ws + WS_BLAST);
    LAS bf16* VT = (LAS bf16*)F.lds; LAS bf16* KWT = (LAS bf16*)(F.lds + 18432); LAS float* wk = (LAS float*)(F.lds + SMALL_OFF);
    for (int u = F.vcu; u < 1024; u += F.G) {
        const int b = u >> 7, h = (u >> 5) & 3, c = u & 31, t0 = b * SEQ + c * 64;
        __syncthreads();
        if (F.wave == 0) { float bcum, ib; mlstm_gates(F, j, t0, h, bcum, ib); const float blast = __shfl(bcum, 63); const float gl = blast - bcum + ib; const float ml = wave_max(gl);
            wk[F.lane] = expf(gl - ml); if (F.lane == 0) { MLOC[u] = ml; BLAST[u] = blast; } }
        mlstm_stage_t(F, P, t0, 1024 + h * 128, VT, nullptr);
        __syncthreads();
        mlstm_stage_t(F, P, t0, 512 + h * 128, KWT, wk);
        __syncthreads();
        const int vt = F.wave >> 1, dh = F.wave & 1, li = F.lane & 31, hh = F.lane >> 5;
        f32x16 acc0 = zero16(), acc1 = zero16();
        const LAS bf16* ar = VT + (32 * vt + li) * 72; const LAS bf16* b0 = KWT + (64 * dh + li) * 72; const LAS bf16* b1 = b0 + 32 * 72;
#pragma unroll
        for (int ks = 0; ks < 4; ++ks) { const bf16x8 af = lds_nat(ar, ks, hh); acc0 = MFMA32(af, lds_nat(b0, ks, hh), acc0); acc1 = MFMA32(af, lds_nat(b1, ks, hh), acc1); }
        float* dst = KLOC + (size_t)u * 16384 + (size_t)(32 * vt) * 128 + 64 * dh + li;
#pragma unroll
        for (int r = 0; r < 16; ++r) { dst[crow(r, hh) * 128] = acc0[r]; dst[crow(r, hh) * 128 + 32] = acc1[r]; }
        if (F.tid < 128) { float a = 0.f; const LAS bf16* kr = KWT + F.tid * 72;
#pragma unroll
            for (int s8 = 0; s8 < 8; ++s8) { const v4u w = *(const LAS v4u*)(kr + 8 * s8); a += (bflo(w.x) + bfhi(w.x)) + (bflo(w.y) + bfhi(w.y)) + (bflo(w.z) + bfhi(w.z)) + (bflo(w.w) + bfhi(w.w)); }
            NLOC[(size_t)u * 128 + F.tid] = a; }
    }
}
__device__ __forceinline__ void o3_output_mfma(Frame& F0, int j) {
    Frame F = F0; asm volatile("" : "+v"(F.tid), "+v"(F.lane));
    const bf16* P = (const bf16*)(F.ws + WS_R1); const float* CPREV = (const float*)(F.ws + WS_R2); const float* NPREV = (const float*)(F.ws + WS_NLOC); const float* MPREV = (const float*)(F.ws + WS_MPREV); bf16* MIX = (bf16*)(F.ws + WS_MIX);
    LAS bf16* QR = (LAS bf16*)F.lds;
    LAS bf16* KR = (LAS bf16*)(F.lds + 17408);
    LAS bf16* VT = (LAS bf16*)(F.lds + 34816);
    LAS float* OST = (LAS float*)(F.lds + 53248);
    LAS float* sm = (LAS float*)(F.lds + 98304);
    for (int u = F.vcu; u < 1024; u += F.G) {
        const int b = u >> 7, h = (u >> 5) & 3, c = u & 31, t0 = b * SEQ + c * 64;
        __syncthreads();
        if (F.wave == 0) { float bcum, ib; mlstm_gates(F, j, t0, h, bcum, ib); const float mprev = MPREV[u];
            const float pm = wave_scan_max(ib - bcum, F.lane); const float inter = bcum + mprev; const float mt = fmaxf(bcum + pm, inter);
            sm[F.lane] = bcum; sm[64 + F.lane] = ib; sm[128 + F.lane] = mt; sm[192 + F.lane] = expf(inter - mt); }
        for (int i = F.tid; i < 1024; i += 512) { const int l = i >> 4, ch = i & 15; const bf16* src = P + (size_t)(t0 + l) * NPO + h * 128 + 8 * ch;
            *(LAS v4u*)(QR + l * 136 + 8 * ch) = *(const v4u*)src; *(LAS v4u*)(KR + l * 136 + 8 * ch) = *(const v4u*)(src + 512); }
        mlstm_stage_t(F, P, t0, 1024 + h * 128, VT, nullptr);
        __syncthreads();
        if (F.wave == 1) { const int l = F.lane; const float* np = NPREV + (size_t)u * 128; float qn = 0.f;
#pragma unroll 4
            for (int d8 = 0; d8 < 16; ++d8) { const v4u w = *(const LAS v4u*)(QR + l * 136 + 8 * d8); const f32x4 n0 = *(const f32x4*)(np + 8 * d8), n1 = *(const f32x4*)(np + 8 * d8 + 4);
                qn += (bflo(w.x) * n0[0] + bfhi(w.x) * n0[1]) + (bflo(w.y) * n0[2] + bfhi(w.y) * n0[3]) + (bflo(w.z) * n1[0] + bfhi(w.z) * n1[1]) + (bflo(w.w) * n1[2] + bfhi(w.w) * n1[3]); }
            sm[256 + l] = qn; }
        const int lt = F.wave >> 2, vt = F.wave & 3, li = F.lane & 31, hh = F.lane >> 5, l = 32 * lt + li;
        const float bcl = sm[l], mtl = sm[128 + l], sil = sm[192 + l];
        f32x16 acc = zero16();
        const LAS bf16* qrl = QR + l * 136;
        { const float* cp = CPREV + (size_t)u * 16384 + (size_t)(32 * vt + li) * 128;
#pragma unroll
            for (int ks = 0; ks < 8; ++ks) acc = MFMA32(ldg8_f32(cp + 16 * ks + 8 * hh), lds_nat(qrl, ks, hh), acc); }
#pragma unroll
        for (int r = 0; r < 16; ++r) acc[r] *= sil;
        float dsum = 0.f;
        for (int st = 0; st <= lt; ++st) {
            f32x16 wt = zero16(); const LAS bf16* krs = KR + (32 * st + li) * 136;
#pragma unroll
            for (int ks = 0; ks < 8; ++ks) wt = MFMA32(lds_nat(krs, ks, hh), lds_nat(qrl, ks, hh), wt);
#pragma unroll
            for (int a4 = 0; a4 < 4; ++a4) { const f32x4 bs = *(const LAS f32x4*)(sm + 32 * st + 8 * a4 + 4 * hh), is = *(const LAS f32x4*)(sm + 64 + 32 * st + 8 * a4 + 4 * hh);
#pragma unroll
                for (int i = 0; i < 4; ++i) { const int r = 4 * a4 + i; const float e = expf(bcl - bs[i] + is[i] - mtl); const float w = (st < lt || crow(r, hh) <= li) ? wt[r] * e : 0.f; wt[r] = w; dsum += w; } }
            const bf16x8 w0 = pack_step(wt, 0), w1 = pack_step(wt, 1); const LAS bf16* vr = VT + (32 * vt + li) * 72 + 32 * st;
            acc = MFMA32(lds_krow(vr, 0, hh), w0, acc); acc = MFMA32(lds_krow(vr, 16, hh), w1, acc); }
        __syncthreads();
        dsum += __shfl_xor(dsum, 32);
        const float den = dsum + sil * sm[256 + l]; const float rinv = 1.0f / fmaxf(fabsf(den), expf(-mtl));
        float s1 = 0.f, s2 = 0.f;
#pragma unroll
        for (int r = 0; r < 16; ++r) { acc[r] *= rinv; s1 += acc[r]; s2 += acc[r] * acc[r]; }
        s1 += __shfl_xor(s1, 32); s2 += __shfl_xor(s2, 32);
        if (hh == 0) { sm[320 + (vt * 64 + l) * 2] = s1; sm[320 + (vt * 64 + l) * 2 + 1] = s2; }
        __syncthreads();
        { float t1 = 0.f, t2 = 0.f;
#pragma unroll
            for (int q = 0; q < 4; ++q) { t1 += sm[320 + (q * 64 + l) * 2]; t2 += sm[320 + (q * 64 + l) * 2 + 1]; }
            const float mu = t1 * (1.f / 128.f), var = fmaxf(t2 * (1.f / 128.f) - mu * mu, 0.f), rstd = 1.0f / sqrtf(var + LN_EPS);
#pragma unroll
            for (int r = 0; r < 16; ++r) OST[l * 132 + 32 * vt + crow(r, hh)] = (acc[r] - mu) * rstd; }
        __syncthreads();
        for (int i = F.tid; i < 1024; i += 512) { const int ll = i >> 4, ch = i & 15; const LAS float* os = OST + ll * 132 + 8 * ch; const f32x4 o0 = *(const LAS f32x4*)os, o1 = *(const LAS f32x4*)(os + 4);
            const v4u ow = *(const v4u*)(P + (size_t)(t0 + ll) * NPO + 1536 + h * 128 + 8 * ch); const float* hw = KIN(I_HNW) + j * 512 + h * 128 + 8 * ch; const f32x4 h0 = *(const f32x4*)hw, h1 = *(const f32x4*)(hw + 4);
            v4u res; res.x = pk2(o0[0] * h0[0] * sigmoid_f(bflo(ow.x)), o0[1] * h0[1] * sigmoid_f(bfhi(ow.x))); res.y = pk2(o0[2] * h0[2] * sigmoid_f(bflo(ow.y)), o0[3] * h0[3] * sigmoid_f(bfhi(ow.y)));
            res.z = pk2(o1[0] * h1[0] * sigmoid_f(bflo(ow.z)), o1[1] * h1[1] * sigmoid_f(bfhi(ow.z))); res.w = pk2(o1[2] * h1[2] * sigmoid_f(bflo(ow.w)), o1[3] * h1[3] * sigmoid_f(bfhi(ow.w)));
            *(v4u*)(MIX + (size_t)(t0 + ll) * D + h * 128 + 8 * ch) = res; }
    }
}
template <bool XIN> __device__ __forceinline__ void p_ln1_route(Frame& F, int layer) {
    const bf16* OUTP = (const bf16*)(F.ws + WS_R1); const bf16* HB = (const bf16*)(F.ws + WS_HB); bf16* H1B = (bf16*)(F.ws + WS_H1B);
    i32x4* ROUTE = (i32x4*)(F.ws + WS_ROUTE); f32x2* GATE = (f32x2*)(F.ws + WS_GATE); int* BCNT = (int*)(F.ws + WS_BCNT);
    LAS int* cnt = (LAS int*)(F.lds + SMALL_OFF);
    const float* g1 = KIN(I_LN1G) + (size_t)layer * D; const float* b1 = KIN(I_LN1B) + (size_t)layer * D;
    const float* rgw = KIN(I_RGW) + (size_t)layer * D * 4; const float* rgb = KIN(I_RGB) + layer * 4; const float* rew = KIN(I_REW) + (size_t)layer * 4 * D * 8; const float* reb = KIN(I_REB) + layer * 32;
    __syncthreads();
    if (F.tid < 32) cnt[F.tid] = 0;
    __syncthreads();
#pragma unroll 1
    for (int m0 = F.gw; m0 < T; m0 += 2 * F.NGW) {
        const int m1 = m0 + F.NGW < T ? m0 + F.NGW : -1; const int mm[2] = {m0, m1 >= 0 ? m1 : m0};
        f32x4 v[2][4], a[2][4];
#pragma unroll
        for (int rr = 0; rr < 2; ++rr) { if constexpr (XIN) row_load(KIN(I_X) + (size_t)mm[rr] * D, F.lane, v[rr]); else row_load_bf16(HB + (size_t)mm[rr] * D, F.lane, v[rr]); row_load_bf16(OUTP + (size_t)mm[rr] * D, F.lane, a[rr]); }
#pragma unroll
        for (int rr = 0; rr < 2; ++rr) {
#pragma unroll
            for (int jj = 0; jj < 4; ++jj) v[rr][jj] = v[rr][jj] * ALPHA + a[rr][jj];
            row_layernorm(v[rr], g1, b1, F.lane); }
        row_store_bf16(H1B + (size_t)m0 * D, F.lane, v[0]); if (m1 >= 0) row_store_bf16(H1B + (size_t)m1 * D, F.lane, v[1]);
        float gl[2][4];
#pragma unroll
        for (int c = 0; c < 4; ++c) { gl[0][c] = 0.f; gl[1][c] = 0.f; }
#pragma unroll
        for (int jj = 0; jj < 4; ++jj)
#pragma unroll
            for (int i = 0; i < 4; ++i) { const f32x4 w = *(const f32x4*)(rgw + (size_t)(256 * jj + 4 * F.lane + i) * 4);
#pragma unroll
                for (int c = 0; c < 4; ++c) { gl[0][c] += v[0][jj][i] * w[c]; gl[1][c] += v[1][jj][i] * w[c]; } }
        int gi[2]; float pg[2];
#pragma unroll
        for (int rr = 0; rr < 2; ++rr) { const float red = wave_reduce_multi<4>(gl[rr], F.lane); float l4[4];
#pragma unroll
            for (int c = 0; c < 4; ++c) l4[c] = __shfl(red, 16 * c) + rgb[c];
            int g = 0; float gm = l4[0];
#pragma unroll
            for (int c = 1; c < 4; ++c) if (l4[c] > gm) { gm = l4[c]; g = c; }
            float se = 0.f;
#pragma unroll
            for (int c = 0; c < 4; ++c) se += expf(l4[c] - gm);
            gi[rr] = g; pg[rr] = 1.0f / se; }
        float el[2][8];
#pragma unroll
        for (int rr = 0; rr < 2; ++rr) { const float* rw = rew + (size_t)gi[rr] * D * 8;
#pragma unroll
            for (int c = 0; c < 8; ++c) el[rr][c] = 0.f;
#pragma unroll
            for (int jj = 0; jj < 4; ++jj)
#pragma unroll
                for (int i = 0; i < 4; ++i) { const float* wr = rw + (size_t)(256 * jj + 4 * F.lane + i) * 8; const f32x4 w0 = *(const f32x4*)wr, w1 = *(const f32x4*)(wr + 4);
#pragma unroll
                    for (int c = 0; c < 4; ++c) { el[rr][c] += v[rr][jj][i] * w0[c]; el[rr][4 + c] += v[rr][jj][i] * w1[c]; } } }
#pragma unroll
        for (int rr = 0; rr < 2; ++rr) { const float red = wave_reduce_multi<8>(el[rr], F.lane); float e8[8];
#pragma unroll
            for (int c = 0; c < 8; ++c) e8[c] = __shfl(red, 8 * c) + reb[gi[rr] * 8 + c];
            int i0 = 0; float v0 = e8[0];
#pragma unroll
            for (int c = 1; c < 8; ++c) if (e8[c] > v0) { v0 = e8[c]; i0 = c; }
            int i1 = -1; float v1 = -INFINITY;
#pragma unroll
            for (int c = 0; c < 8; ++c) if (c != i0 && e8[c] > v1) { v1 = e8[c]; i1 = c; }
            if (i1 < 0) i1 = (i0 + 1) & 7;
            const float ee = expf(v1 - v0), g0 = pg[rr] / (1.0f + ee), g1v = pg[rr] * ee / (1.0f + ee);
            if (F.lane == 0 && (rr == 0 || m1 >= 0)) { const int e0 = gi[rr] * 8 + i0, e1 = gi[rr] * 8 + i1;
                const int r0 = __hip_atomic_fetch_add(cnt + e0, 1, __ATOMIC_RELAXED, __HIP_MEMORY_SCOPE_WORKGROUP), r1 = __hip_atomic_fetch_add(cnt + e1, 1, __ATOMIC_RELAXED, __HIP_MEMORY_SCOPE_WORKGROUP);
                ROUTE[mm[rr]] = (i32x4){e0, r0, e1, r1}; GATE[mm[rr]] = (f32x2){g0, g1v}; } }
    }
    __syncthreads();
    if (F.tid < 32) BCNT[F.vcu * 32 + F.tid] = cnt[F.tid];
}
__device__ __forceinline__ void p_scatter(Frame& F) {
    const int* BCNT = (const int*)(F.ws + WS_BCNT); int* PANEL = (int*)(F.ws + WS_PANEL); const i32x4* ROUTE = (const i32x4*)(F.ws + WS_ROUTE); i32x2* POS = (i32x2*)(F.ws + WS_POS);
    const bf16* H1B = (const bf16*)(F.ws + WS_H1B); bf16* XS = (bf16*)(F.ws + WS_R1);
    LAS int* pa = (LAS int*)(F.lds + SMALL_OFF); LAS int* pb = pa + 512; LAS int* tot = pa + 1024; LAS int* bef = pa + 1056; LAS int* base = pa + 1088;
    __syncthreads();
    { const int e = F.tid & 31, part = F.tid >> 5; int sa = 0, sb = 0;
        for (int b = part; b < F.G; b += 16) { const int c = BCNT[b * 32 + e]; sa += c; if (b < F.vcu) sb += c; }
        pa[part * 32 + e] = sa; pb[part * 32 + e] = sb; }
    __syncthreads();
    if (F.tid < 32) { int sa = 0, sb = 0; for (int p = 0; p < 16; ++p) { sa += pa[p * 32 + F.tid]; sb += pb[p * 32 + F.tid]; } tot[F.tid] = sa; bef[F.tid] = sb; }
    __syncthreads();
    if (F.tid == 0) { int off = 0, np = 0;
        for (int e = 0; e < 32; ++e) { const int npan = (tot[e] + 255) >> 8; base[e] = off + bef[e];
            if (F.vcu == 0) for (int p = 0; p < npan; ++p) PANEL[1 + np + p] = e;
            np += npan; off += npan * 256; }
        if (F.vcu == 0) PANEL[0] = np; }
    __syncthreads();
#pragma unroll 1
    for (int m0 = F.gw; m0 < T; m0 += 4 * F.NGW) {
        i32x4 r[4]; v4u w[4][2];
#pragma unroll
        for (int rr = 0; rr < 4; ++rr) { const int m = m0 + rr * F.NGW < T ? m0 + rr * F.NGW : m0; r[rr] = ROUTE[m]; const v4u* src = (const v4u*)(H1B + (size_t)m * D); w[rr][0] = src[F.lane]; w[rr][1] = src[F.lane + 64]; }
#pragma unroll
        for (int rr = 0; rr < 4; ++rr) { const int m = m0 + rr * F.NGW; if (m < T) { const int p0 = base[r[rr].x] + r[rr].y, p1 = base[r[rr].z] + r[rr].w;
            if (F.lane == 0) POS[m] = (i32x2){p0, p1};
            v4u* d0 = (v4u*)(XS + (size_t)p0 * D); v4u* d1 = (v4u*)(XS + (size_t)p1 * D);
            d0[F.lane] = w[rr][0]; d0[F.lane + 64] = w[rr][1]; d1[F.lane] = w[rr][0]; d1[F.lane + 64] = w[rr][1]; } } }
}
__device__ __forceinline__ void p_combine(Frame& F, int layer) {
    const bf16* H1B = (const bf16*)(F.ws + WS_H1B); const bf16* EOUT = (const bf16*)(F.ws + WS_R1); const i32x2* POS = (const i32x2*)(F.ws + WS_POS); const f32x2* GATE = (const f32x2*)(F.ws + WS_GATE);
    bf16* HB = (bf16*)(F.ws + WS_HB);
    const float* g2 = KIN(I_LN2G) + (size_t)layer * D; const float* b2 = KIN(I_LN2B) + (size_t)layer * D;
#pragma unroll 1
    for (int m0 = F.gw; m0 < T; m0 += 2 * F.NGW) {
        const int m1 = m0 + F.NGW < T ? m0 + F.NGW : -1; const int mm[2] = {m0, m1 >= 0 ? m1 : m0};
        f32x4 v[2][4], ea[2][4], eb[2][4]; i32x2 ps[2]; f32x2 gt[2];
#pragma unroll
        for (int rr = 0; rr < 2; ++rr) { ps[rr] = POS[mm[rr]]; gt[rr] = GATE[mm[rr]]; row_load_bf16(H1B + (size_t)mm[rr] * D, F.lane, v[rr]); }
#pragma unroll
        for (int rr = 0; rr < 2; ++rr) { row_load_bf16(EOUT + (size_t)ps[rr].x * D, F.lane, ea[rr]); row_load_bf16(EOUT + (size_t)ps[rr].y * D, F.lane, eb[rr]); }
#pragma unroll
        for (int rr = 0; rr < 2; ++rr) {
#pragma unroll
            for (int jj = 0; jj < 4; ++jj) v[rr][jj] = v[rr][jj] * ALPHA + (ea[rr][jj] * gt[rr].x + eb[rr][jj] * gt[rr].y);
            row_layernorm(v[rr], g2, b2, F.lane); }
        if (layer == DEPTH - 1) { row_store_f32(F.out + (size_t)m0 * D, F.lane, v[0]); if (m1 >= 0) row_store_f32(F.out + (size_t)m1 * D, F.lane, v[1]); }
        else { row_store_bf16(HB + (size_t)m0 * D, F.lane, v[0]); if (m1 >= 0) row_store_bf16(HB + (size_t)m1 * D, F.lane, v[1]); row_gate_proj2(F, v[0], v[1], layer + 1, m0, m1); } }
}
#ifndef PHASE_MASK
#define PHASE_MASK 0x1fff
#endif
#define PH_EN(k) (((PHASE_MASK) >> (k)) & 1)
#ifndef PROBE_DUP
#define PROBE_DUP 0
#endif
#define TPROBE(k) ((((PROBE_DUP) >> (k)) & 1) != 0)
#define TWAIT(k) do { if constexpr (TPROBE(k)) { const unsigned long long t1_ = __builtin_amdgcn_s_memrealtime(); while (__builtin_amdgcn_s_memrealtime() - t1_ < (t1_ - tp0_)) __builtin_amdgcn_s_sleep(8); } } while (0)
#define IN(k) (lo <= (k) && (k) < hi)
#define SEAM(k) do { if ((k) + 1 < hi) xcd_barrier(bar); } while (0)
template <int LAYER> __device__ __forceinline__ void layer_body(Frame& F, const int lo, const int hi, const XcdBarrier& bar) {
        constexpr int layer = LAYER, pb = 1 + LAYER * NPH_LAYER, j = LAYER >> 1; constexpr bool odd = (LAYER & 1) != 0;
        bf16* HB = (bf16*)(F.ws + WS_HB); bf16* MIX = (bf16*)(F.ws + WS_MIX);
        if constexpr (PH_EN(0)) if (IN(pb + 0)) { const unsigned long long tp0_ = TPROBE(0) ? __builtin_amdgcn_s_memrealtime() : 0ull;
            const int N = odd ? NPO : NPE; const bf16* Bt = odd ? (const bf16*)(F.ws + WS_WINO) + (size_t)j * NPO * D : (const bf16*)(F.ws + WS_WINE) + (size_t)j * NPE * D;
            pg8::Gemm g{HB, Bt, T, N, D, 0}; pg8::StaticOrder S; S.init(T, N, F.G, (int)blockIdx.x);
            pg8::EpiStoreBf16 E{(bf16*)(F.ws + WS_R1), N};
            pg8::gemm_phase<pg8::EpiStoreBf16, pg8::StaticOrder, true, true>(F.lds, g, S, E);
            SEAM(pb + 0); TWAIT(0); }
        if constexpr (!odd) {
            if constexpr (PH_EN(1)) if (IN(pb + 1)) { const unsigned long long tp0_ = TPROBE(1) ? __builtin_amdgcn_s_memrealtime() : 0ull; e0_conv(F, j); SEAM(pb + 1); TWAIT(1); }
            if constexpr (PH_EN(2)) if (IN(pb + 2)) { const unsigned long long tp0_ = TPROBE(2) ? __builtin_amdgcn_s_memrealtime() : 0ull; if constexpr (SSD_NAIVE) e1_states(F, j); else e1_states_mfma(F, j); SEAM(pb + 2); TWAIT(2); }
            if constexpr (PH_EN(3)) if (IN(pb + 3)) { const unsigned long long tp0_ = TPROBE(3) ? __builtin_amdgcn_s_memrealtime() : 0ull; e2_scan(F); SEAM(pb + 3); TWAIT(3); }
            if constexpr (PH_EN(4)) if (IN(pb + 4)) { const unsigned long long tp0_ = TPROBE(4) ? __builtin_amdgcn_s_memrealtime() : 0ull; if constexpr (SSD_NAIVE) e3_output(F, j); else e3_output_mfma(F, j); SEAM(pb + 4); TWAIT(4); }
            if constexpr (PH_EN(5)) if (IN(pb + 5)) { const unsigned long long tp0_ = TPROBE(5) ? __builtin_amdgcn_s_memrealtime() : 0ull; e4_gnorm(F); SEAM(pb + 5); TWAIT(5); }
        } else {
            if constexpr (PH_EN(1)) if (IN(pb + 1)) { const unsigned long long tp0_ = TPROBE(1) ? __builtin_amdgcn_s_memrealtime() : 0ull; o_foxscan(F, j); if constexpr (MLSTM_NAIVE) o1_local(F, j); else o1_local_mfma(F, j); SEAM(pb + 1); TWAIT(1); }
            if constexpr (PH_EN(2)) if (IN(pb + 2)) { const unsigned long long tp0_ = TPROBE(2) ? __builtin_amdgcn_s_memrealtime() : 0ull; o2_scan(F); SEAM(pb + 2); TWAIT(2); }
            if constexpr (PH_EN(3)) if (IN(pb + 3)) { const unsigned long long tp0_ = TPROBE(3) ? __builtin_amdgcn_s_memrealtime() : 0ull;
#if FOX_NAIVE
                o4_fox(F);
#else
                const attn_body::bf16* PR = (const attn_body::bf16*)(F.ws + WS_R1);
                const attn_body::AttnTensors AT{PR + 2048, PR + 2560, PR + 3072, (attn_body::bf16*)(F.ws + WS_MIX) + 512, (const float*)(F.ws + WS_FOXC)};
                const attn_body::StaticOrder S((int)F.G, F.vcu);
                attn_body::attn_phase<attn_body::StaticOrder>((char*)F.lds, AT, S);
#endif
                __syncthreads();
                if constexpr (MLSTM_NAIVE) o3_output(F, j); else o3_output_mfma(F, j); SEAM(pb + 3); TWAIT(3); }
        }
        if constexpr (PH_EN(6)) if (IN(pb + 6)) { const unsigned long long tp0_ = TPROBE(6) ? __builtin_amdgcn_s_memrealtime() : 0ull;
            const int K = odd ? D : 1536; const bf16* Bt = odd ? (const bf16*)(F.ws + WS_WOUTO) + (size_t)j * D * D : (const bf16*)(F.ws + WS_WOUTE) + (size_t)j * D * 1536;
            pg8::Gemm g{MIX, Bt, T, D, K, 0}; pg8::StaticOrder S; S.init(T, D, F.G, (int)blockIdx.x);
            pg8::EpiStoreBf16 E{(bf16*)(F.ws + WS_R1), D};
            pg8::gemm_phase<pg8::EpiStoreBf16, pg8::StaticOrder, false, true>(F.lds, g, S, E);
            SEAM(pb + 6); TWAIT(6); }
        if constexpr (PH_EN(7)) if (IN(pb + 7)) { const unsigned long long tp0_ = TPROBE(7) ? __builtin_amdgcn_s_memrealtime() : 0ull; p_ln1_route<LAYER == 0>(F, layer); SEAM(pb + 7); TWAIT(7); }
        if constexpr (PH_EN(8)) if (IN(pb + 8)) { const unsigned long long tp0_ = TPROBE(8) ? __builtin_amdgcn_s_memrealtime() : 0ull; p_scatter(F); SEAM(pb + 8); TWAIT(8); }
        if constexpr (PH_EN(9)) if (IN(pb + 9)) { const unsigned long long tp0_ = TPROBE(9) ? __builtin_amdgcn_s_memrealtime() : 0ull;
            pg8::Gemm g{(const bf16*)(F.ws + WS_R1), (const bf16*)(F.ws + WS_WGU) + (size_t)layer * 32 * D * D, RPAD, D, D, (size_t)D * D * 2};
            pg8::MoeOrder S; S.initm((const int*)(F.ws + WS_PANEL), 4, F.G, (int)blockIdx.x);
            pg8::EpiSwiglu E{(bf16*)(F.ws + WS_R3), 512};
            pg8::gemm_phase<pg8::EpiSwiglu, pg8::MoeOrder, true, true>(F.lds, g, S, E);
            SEAM(pb + 9); TWAIT(9); }
        if constexpr (PH_EN(10)) if (IN(pb + 10)) { const unsigned long long tp0_ = TPROBE(10) ? __builtin_amdgcn_s_memrealtime() : 0ull;
            pg8::Gemm g{(const bf16*)(F.ws + WS_R3), (const bf16*)(F.ws + WS_WD) + (size_t)layer * 32 * D * 512, RPAD, D, 512, (size_t)D * 512 * 2};
            pg8::MoeOrder S; S.initm((const int*)(F.ws + WS_PANEL), 4, F.G, (int)blockIdx.x);
            pg8::EpiStoreBf16 E{(bf16*)(F.ws + WS_R1), D};
            pg8::gemm_phase<pg8::EpiStoreBf16, pg8::MoeOrder, true, true>(F.lds, g, S, E);
            SEAM(pb + 10); TWAIT(10); }
        if constexpr (PH_EN(11)) if (IN(pb + 11)) { const unsigned long long tp0_ = TPROBE(11) ? __builtin_amdgcn_s_memrealtime() : 0ull; p_combine(F, layer); SEAM(pb + 11); TWAIT(11); }
}
struct Args { const float* in[27]; float* out; unsigned char* ws; int ph_lo, ph_hi; };
__global__ void __launch_bounds__(NWAVES * 64, 2) fwd_kernel(Args args) {
    extern __shared__ __attribute__((aligned(16))) unsigned char lds[];
    Frame F;
    F.lds = (LAS unsigned char*)lds;
    F.MISC = (volatile LAS unsigned*)(F.lds + MISC_OFF);
    F.tid = threadIdx.x; F.lane = F.tid & 63; F.wave = __builtin_amdgcn_readfirstlane(F.tid >> 6);
    F.G = gridDim.x; { const int bx = blockIdx.x; F.vcu = (F.G % 8 == 0) ? (bx % 8) * (F.G / 8) + bx / 8 : bx; }
    F.gw = F.vcu * NWAVES + F.wave; F.NGW = F.G * NWAVES;
    F.out = args.out; F.ws = args.ws; F.ctl = (unsigned*)(args.ws + WS_CTL);
    const int lo = args.ph_lo, hi = args.ph_hi;
    for (int u = F.tid; u < (LDS_BYTES - MISC_OFF) / 4; u += NWAVES * 64) ((LAS unsigned*)(F.lds + MISC_OFF))[u] = 0u;
    __syncthreads();
    XcdBarrier bar; bar.bar = F.ctl + CW_BAR; bar.x = 0; bar.st = nullptr;
    if (hi - lo > 1) bar = xcd_barrier_post(F.ctl + CW_BAR, F.MISC + 8);
    if constexpr (PH_EN(12)) if (IN(0)) { const unsigned long long tp0_ = TPROBE(12) ? __builtin_amdgcn_s_memrealtime() : 0ull; p_prologue(F); SEAM(0); TWAIT(12); }
    layer_body<0>(F, lo, hi, bar); layer_body<1>(F, lo, hi, bar); layer_body<2>(F, lo, hi, bar); layer_body<3>(F, lo, hi, bar);
#undef IN
#undef SEAM
}

extern "C" void kernel_launch(void* const* d_in, const int* in_sizes, int n_in, void* d_out, int out_size, void* d_ws, size_t ws_size, hipStream_t stream) {
    static int grid = 0;
    if (grid == 0) {
        if (n_in != 27 || in_sizes[0] != T * D || out_size != T * D || ws_size < WS_END) { fprintf(stderr, "kernel_launch: unexpected shapes (n_in %d, in0 %d, out %d, ws %zu); nothing launched\n", n_in, n_in > 0 ? in_sizes[0] : -1, out_size, ws_size); grid = -1; return; }
        int dev = 0, cus = 0, per_cu = 0;
        if (hipGetDevice(&dev) != hipSuccess || hipDeviceGetAttribute(&cus, hipDeviceAttributeMultiprocessorCount, dev) != hipSuccess) { grid = -1; return; }
        if (hipFuncSetAttribute((const void*)fwd_kernel, hipFuncAttributeMaxDynamicSharedMemorySize, LDS_BYTES) != hipSuccess) { fprintf(stderr, "kernel_launch: hipFuncSetAttribute failed\n"); grid = -1; return; }
        if (hipOccupancyMaxActiveBlocksPerMultiprocessor(&per_cu, (const void*)fwd_kernel, NWAVES * 64, LDS_BYTES) != hipSuccess || per_cu < 1) fprintf(stderr, "kernel_launch: note: occupancy query reports %d workgroups per CU\n", per_cu);
        (void)hipGetLastError();
        grid = cus;
    }
    if (grid < 0) return;
    if (hipMemsetAsync((char*)d_ws + WS_CTL, 0, CTL_ZERO_BYTES, stream) != hipSuccess) return;
    Args a{};
    for (int i = 0; i < 27; ++i) a.in[i] = (const float*)d_in[i];
    a.out = (float*)d_out; a.ws = (unsigned char*)d_ws;
#if MK_ONE_LAUNCH
    a.ph_lo = 0; a.ph_hi = NPHASES;
    hipLaunchKernelGGL(fwd_kernel, dim3(grid), dim3(NWAVES * 64), LDS_BYTES, stream, a);
#else
    for (int ph = 0; ph < NPHASES; ++ph) {
        if (ph > 0 && (((ph - 1) / NPH_LAYER) & 1) && ((ph - 1) % NPH_LAYER) == 5) continue;
        a.ph_lo = ph; a.ph_hi = ph + 1;
        hipLaunchKernelGGL(fwd_kernel, dim3(grid), dim3(NWAVES * 64), LDS_BYTES, stream, a);
    }
#endif
}
```

```cpp
#include <hip/hip_runtime.h>
#include <cstdio>
#include <cstdint>
__device__ __forceinline__ float silu_f(float x) { return x / (1.0f + __expf(-x)); }
namespace pg8 {
#define PG8_LAS __attribute__((address_space(3)))
typedef unsigned short bf16_t;
typedef short bf16x8 __attribute__((ext_vector_type(8)));
typedef float f32x4 __attribute__((ext_vector_type(4)));
typedef unsigned u32x4 __attribute__((ext_vector_type(4)));
constexpr int BM = 256, BK = 64, HALF = 128, HTB = HALF * BK * 2  , STAGE_BYTES = 8 * HTB, NXCD = 8, WGM = 8;

__host__ __device__ __forceinline__ int lds_byte(int r, int c) { const int st = (r >> 4) * 2 + (c >> 5), rr = r & 15, cc = c & 31, ob = rr * 64 + cc * 2; return st * 1024 + (ob ^ (((ob >> 9) & 1) << 5)); }
__host__ __device__ __forceinline__ void stage_rc(int b, int& R, int& C) { const int st = b / 1024, sb = b % 1024, swz = sb ^ (((sb >> 9) & 1) << 5); R = (st >> 1) * 16 + swz / 64; C = (st & 1) * 32 + (swz % 64) / 2; }
__host__ __device__ __forceinline__ int perm32(int rho) { const int n = rho >> 4, i = rho & 15; return 8 * (i >> 2) + 4 * n + (i & 3); }

struct Unit { int pm, pn, be; };
struct Gemm { const bf16_t* A; const bf16_t* Bt; int M, N, K; size_t bstride; };

struct StaticOrder {
    int nM, nN, nwg, G, c;
    __host__ __device__ void init(int M, int N, int G_, int c_) { nM = M / BM; nN = N / BM; nwg = nM * nN; G = G_; c = c_; }
    __host__ __device__ bool next(int i, Unit& u) const {
        const long L = (long)i * G + c; if (L >= nwg) return false;
        int wgid = (int)L; { const int q = nwg / NXCD, r = nwg % NXCD, xcd = wgid % NXCD, off = wgid / NXCD; wgid = (xcd < r ? xcd * (q + 1) : r * (q + 1) + (xcd - r) * q) + off; }
        const int nig = WGM * nN, gid = wgid / nig, fm = gid * WGM, gsz = (nM - fm) < WGM ? (nM - fm) : WGM;
        u.pm = fm + ((wgid % nig) % gsz); u.pn = (wgid % nig) / gsz; u.be = 0; return true;
    }
    __device__ __forceinline__ void a_ready(const Unit&) const {}
    __device__ __forceinline__ void done(const Unit&) const {}
};

__device__ __forceinline__ unsigned cvt_pk_bf16(float lo, float hi) { unsigned r; asm volatile("v_cvt_pk_bf16_f32 %0, %1, %2" : "=v"(r) : "v"(lo), "v"(hi)); return r; }
struct EpiStoreBf16 {
    static constexpr bool PERM = true, AFTER_DRAIN = false;
    bf16_t* O; int ldc;
    __device__ __forceinline__ void operator()(const f32x4 (&acc)[2][2][4][2], const Unit& u, int wr, int wc, int fr, int fq) const {
        const int row0 = u.pm * BM + wr * 64 + fr, col0 = u.pn * BM + wc * 32 + 8 * fq;
#pragma unroll
        for (int ai = 0; ai < 2; ++ai)
#pragma unroll
            for (int m = 0; m < 4; ++m) { bf16_t* rowp = O + (size_t)(row0 + ai * HALF + m * 16) * ldc + col0;
#pragma unroll
                for (int bj = 0; bj < 2; ++bj) { const f32x4 v0 = acc[ai][bj][m][0], v1 = acc[ai][bj][m][1];
                    u32x4 w; w.x = cvt_pk_bf16(v0[0], v0[1]); w.y = cvt_pk_bf16(v0[2], v0[3]); w.z = cvt_pk_bf16(v1[0], v1[1]); w.w = cvt_pk_bf16(v1[2], v1[3]);
                    *(u32x4*)(rowp + bj * HALF) = w; } }
    }
};
struct EpiStoreF32 {
    static constexpr bool PERM = false, AFTER_DRAIN = false;
    float* C; int ldc;
    __device__ __forceinline__ void operator()(const f32x4 (&acc)[2][2][4][2], const Unit& u, int wr, int wc, int fr, int fq) const {
        const int row0 = u.pm * BM + wr * 64 + fr, col0 = u.pn * BM + wc * 32 + 4 * fq;
#pragma unroll
        for (int ai = 0; ai < 2; ++ai)
#pragma unroll
            for (int m = 0; m < 4; ++m) { float* rowp = C + (size_t)(row0 + ai * HALF + m * 16) * ldc + col0;
#pragma unroll
                for (int bj = 0; bj < 2; ++bj)
#pragma unroll
                    for (int n = 0; n < 2; ++n) *(f32x4*)(rowp + bj * HALF + n * 16) = acc[ai][bj][m][n]; }
    }
};
struct EpiSwiglu {
    static constexpr bool PERM = true, AFTER_DRAIN = false;
    bf16_t* O; int ldc;
    __device__ __forceinline__ void operator()(const f32x4 (&acc)[2][2][4][2], const Unit& u, int wr, int wc, int fr, int fq) const {
        const int row0 = u.pm * BM + wr * 64 + fr, col0 = u.pn * HALF + wc * 32 + 8 * fq;
#pragma unroll
        for (int ai = 0; ai < 2; ++ai)
#pragma unroll
            for (int m = 0; m < 4; ++m) { bf16_t* rowp = O + (size_t)(row0 + ai * HALF + m * 16) * ldc + col0;
                const f32x4 g0 = acc[ai][0][m][0], g1 = acc[ai][0][m][1], u0 = acc[ai][1][m][0], u1 = acc[ai][1][m][1];
                float h[8];
#pragma unroll
                for (int i = 0; i < 4; ++i) { h[i] = silu_f(g0[i]) * u0[i]; h[4 + i] = silu_f(g1[i]) * u1[i]; }
                u32x4 w; w.x = cvt_pk_bf16(h[0], h[1]); w.y = cvt_pk_bf16(h[2], h[3]); w.z = cvt_pk_bf16(h[4], h[5]); w.w = cvt_pk_bf16(h[6], h[7]);
                *(u32x4*)rowp = w; }
    }
};
struct MoeOrder : StaticOrder {
    const int* tab;
    __device__ __forceinline__ void initm(const int* tab_, int nN_, int G_, int c_) { tab = tab_; nM = tab_[0]; nN = nN_; nwg = nM * nN; G = G_; c = c_; }
    __device__ __forceinline__ bool next(int i, Unit& u) const { if (!StaticOrder::next(i, u)) return false; u.be = tab[1 + u.pm]; return true; }
};
template <class Epi, class Sched, bool ALIGN_EPI = false, bool SP2 = false>
__device__ __forceinline__ void gemm_phase(PG8_LAS unsigned char* lds, const Gemm g, const Sched& S, const Epi& E) {
    const int tid = threadIdx.x, wid = __builtin_amdgcn_readfirstlane(tid >> 6), lane = tid & 63, wr = wid >> 2, wc = wid & 3, fr = lane & 15, fq = lane >> 4;
    const int K = g.K, nt = K / BK;
    unsigned voffA[2], voffB[2];
#pragma unroll
    for (int i = 0; i < 2; ++i) { int R, C; stage_rc(tid * 16 + i * 8192, R, C); const int Rb = Epi::PERM ? ((R & ~31) + perm32(R & 31)) : R;
        voffA[i] = (unsigned)(R * K + C) * 2u; voffB[i] = (unsigned)(Rb * K + C) * 2u; }
    const size_t kstep = (size_t)(BK * 2);
    const size_t hstep = (size_t)HALF * K * 2;
    const size_t tstep = 2 * hstep;
    const unsigned ldsw = (unsigned)wid * 1024u;
    const int aoff = lds_byte(wr * 64 + fr, fq * 8), boff = lds_byte(wc * 32 + fr, fq * 8);
#define PG8_SA(b, h) (((b) * 2 + (h)) * HTB)
#define PG8_SB(b, h) ((4 + (b) * 2 + (h)) * HTB)
#define PG8_STAGE(bufoff, gbase, voff) do { _Pragma("unroll") for (int _i = 0; _i < 2; ++_i) \
        __builtin_amdgcn_global_load_lds((const unsigned*)((const char*)(gbase) + (voff)[_i]), (PG8_LAS unsigned*)(lds + (bufoff) + ldsw + _i * 8192), 16, 0, 0); } while (0)
#define PG8_LDA(dst, b, h) do { _Pragma("unroll") for (int m = 0; m < 4; ++m) _Pragma("unroll") for (int k = 0; k < 2; ++k) dst[m][k] = *(const PG8_LAS bf16x8*)(lds + PG8_SA(b, h) + aoff + m * 2048 + k * 1024); } while (0)
#define PG8_LDB(dst, b, h) do { _Pragma("unroll") for (int n = 0; n < 2; ++n) _Pragma("unroll") for (int k = 0; k < 2; ++k) dst[n][k] = *(const PG8_LAS bf16x8*)(lds + PG8_SB(b, h) + boff + n * 2048 + k * 1024); } while (0)
#define PG8_MMA(ai, bj, At, Bt) do { __builtin_amdgcn_s_setprio(1); _Pragma("unroll") for (int m = 0; m < 4; ++m) _Pragma("unroll") for (int n = 0; n < 2; ++n) _Pragma("unroll") for (int k = 0; k < 2; ++k) \
        acc[ai][bj][m][n] = __builtin_amdgcn_mfma_f32_16x16x32_bf16(Bt[n][k], At[m][k], acc[ai][bj][m][n], 0, 0, 0); __builtin_amdgcn_s_setprio(0); } while (0)
#define PG8_WAIT_V(n) asm volatile("s_waitcnt vmcnt(" #n ")" ::: "memory")
#define PG8_WAIT_L(n) asm volatile("s_waitcnt lgkmcnt(" #n ")" ::: "memory")
#define PG8_BAR __builtin_amdgcn_s_barrier()
#define PG8_SCHED __builtin_amdgcn_sched_barrier(0)
    Unit cur, nxt; int ui = 0;
    if (!S.next(0, cur)) return;
    f32x4 acc[2][2][4][2];
#pragma unroll
    for (int a = 0; a < 2; ++a)
#pragma unroll
        for (int b = 0; b < 2; ++b)
#pragma unroll
            for (int m = 0; m < 4; ++m)
#pragma unroll
                for (int n = 0; n < 2; ++n) acc[a][b][m][n] = (f32x4){0.f, 0.f, 0.f, 0.f};
    bf16x8 At[4][2], B0[2][2], B1[2][2];
    const char* cA = (const char*)g.A + (size_t)cur.pm * tstep; const char* cB = (const char*)g.Bt + (size_t)cur.be * g.bstride + (size_t)cur.pn * tstep;
    S.a_ready(cur);
    if constexpr (SP2) {
        PG8_STAGE(PG8_SB(0, 0), cB, voffB); PG8_STAGE(PG8_SB(0, 1), cB + hstep, voffB); PG8_STAGE(PG8_SA(0, 0), cA, voffA); PG8_STAGE(PG8_SA(0, 1), cA + hstep, voffA);
        if (wr == 1) PG8_BAR;
        PG8_WAIT_V(2); PG8_BAR;
        PG8_STAGE(PG8_SB(1, 0), cB + kstep, voffB); PG8_STAGE(PG8_SA(1, 0), cA + kstep, voffA); PG8_STAGE(PG8_SB(1, 1), cB + hstep + kstep, voffB);
        PG8_WAIT_V(6); PG8_BAR;
    } else {
        PG8_STAGE(PG8_SB(0, 0), cB, voffB); PG8_STAGE(PG8_SA(0, 0), cA, voffA); PG8_STAGE(PG8_SB(0, 1), cB + hstep, voffB); PG8_STAGE(PG8_SA(0, 1), cA + hstep, voffA);
        if (wr == 1) PG8_BAR;
        PG8_WAIT_V(4); PG8_BAR;
        PG8_STAGE(PG8_SB(1, 0), cB + kstep, voffB); PG8_STAGE(PG8_SA(1, 0), cA + kstep, voffA); PG8_STAGE(PG8_SB(1, 1), cB + hstep + kstep, voffB);
        PG8_WAIT_V(6); PG8_BAR;
    }
    for (;;) {
        const bool has_next = S.next(ui + 1, nxt);
        const char* nA = has_next ? (const char*)g.A + (size_t)nxt.pm * tstep : cA; const char* nB = has_next ? (const char*)g.Bt + (size_t)nxt.be * g.bstride + (size_t)nxt.pn * tstep : cB;
        for (int t = 0; t < nt; t += 2) {
            const bool last = (t == nt - 2);
            const char* a1 = cA + (size_t)(t + 1) * kstep;
            const char* a2 = last ? nA : cA + (size_t)(t + 2) * kstep; const char* b2 = last ? nB : cB + (size_t)(t + 2) * kstep;
            const char* a3 = a2 + kstep; const char* b3 = b2 + kstep;
            if (last && has_next) S.a_ready(nxt);
            if constexpr (SP2) {
            PG8_LDB(B0, 0, 0); PG8_LDB(B1, 0, 1); PG8_SCHED; PG8_LDA(At, 0, 0); PG8_STAGE(PG8_SA(1, 1), a1 + hstep, voffA);
            PG8_WAIT_V(8); PG8_WAIT_L(0); PG8_BAR; PG8_MMA(0, 0, At, B0); PG8_MMA(0, 1, At, B1); PG8_BAR; PG8_SCHED;
            PG8_LDA(At, 0, 1); PG8_STAGE(PG8_SB(0, 0), b2, voffB); PG8_STAGE(PG8_SB(0, 1), b2 + hstep, voffB); PG8_STAGE(PG8_SA(0, 0), a2, voffA);
            PG8_WAIT_V(8); PG8_WAIT_L(0); PG8_BAR; PG8_MMA(1, 0, At, B0); PG8_MMA(1, 1, At, B1); PG8_BAR; PG8_SCHED;
            PG8_LDB(B0, 1, 0); PG8_LDB(B1, 1, 1); PG8_SCHED; PG8_LDA(At, 1, 0); PG8_STAGE(PG8_SA(0, 1), a2 + hstep, voffA);
            PG8_WAIT_V(8); PG8_WAIT_L(0); PG8_BAR; PG8_MMA(0, 0, At, B0); PG8_MMA(0, 1, At, B1); PG8_BAR; PG8_SCHED;
            PG8_LDA(At, 1, 1); PG8_STAGE(PG8_SB(1, 0), b3, voffB); PG8_STAGE(PG8_SB(1, 1), b3 + hstep, voffB); PG8_STAGE(PG8_SA(1, 0), a3, voffA);
            PG8_WAIT_V(8); PG8_WAIT_L(0); PG8_BAR; PG8_MMA(1, 0, At, B0); PG8_MMA(1, 1, At, B1); PG8_BAR; PG8_SCHED;
            } else {
            PG8_LDB(B0, 0, 0); PG8_SCHED; PG8_LDA(At, 0, 0); PG8_STAGE(PG8_SA(1, 1), a1 + hstep, voffA);
            PG8_WAIT_L(8); PG8_BAR; PG8_WAIT_L(0); PG8_MMA(0, 0, At, B0); PG8_BAR; PG8_SCHED;
            PG8_LDB(B1, 0, 1); PG8_STAGE(PG8_SB(0, 0), b2, voffB);
            PG8_BAR; PG8_WAIT_L(0); PG8_MMA(0, 1, At, B1); PG8_BAR;
            PG8_LDA(At, 0, 1); PG8_STAGE(PG8_SA(0, 0), a2, voffA);
            PG8_BAR; PG8_WAIT_L(0); PG8_MMA(1, 0, At, B0); PG8_BAR; PG8_SCHED;
            PG8_STAGE(PG8_SB(0, 1), b2 + hstep, voffB);
            PG8_WAIT_V(6); PG8_BAR; PG8_MMA(1, 1, At, B1); PG8_BAR;
            PG8_LDB(B0, 1, 0); PG8_SCHED; PG8_LDA(At, 1, 0); PG8_STAGE(PG8_SA(0, 1), a2 + hstep, voffA);
            PG8_WAIT_L(8); PG8_BAR; PG8_WAIT_L(0); PG8_MMA(0, 0, At, B0); PG8_BAR; PG8_SCHED;
            PG8_LDB(B1, 1, 1); PG8_STAGE(PG8_SB(1, 0), b3, voffB);
            PG8_BAR; PG8_WAIT_L(0); PG8_MMA(0, 1, At, B1); PG8_BAR;
            PG8_LDA(At, 1, 1); PG8_STAGE(PG8_SA(1, 0), a3, voffA);
            PG8_BAR; PG8_WAIT_L(0); PG8_MMA(1, 0, At, B0); PG8_BAR; PG8_SCHED;
            PG8_STAGE(PG8_SB(1, 1), b3 + hstep, voffB);
            PG8_WAIT_V(6); PG8_BAR; PG8_MMA(1, 1, At, B1); PG8_BAR;
            }
        }
        if constexpr (ALIGN_EPI) { if (wr == 0) PG8_BAR; }
        if constexpr (!Epi::AFTER_DRAIN) { E(acc, cur, wr, wc, fr, fq); S.done(cur); }
        if (!has_next) break;
#pragma unroll
        for (int a = 0; a < 2; ++a)
#pragma unroll
            for (int b = 0; b < 2; ++b)
#pragma unroll
                for (int m = 0; m < 4; ++m)
#pragma unroll
                    for (int n = 0; n < 2; ++n) acc[a][b][m][n] = (f32x4){0.f, 0.f, 0.f, 0.f};
        cur = nxt; cA = nA; cB = nB; ++ui;
        if constexpr (ALIGN_EPI) { if (wr == 1) PG8_BAR; }
    }
    PG8_WAIT_V(0);
    if constexpr (!ALIGN_EPI) { if (wr == 0) PG8_BAR; }
    PG8_BAR;
    if constexpr (Epi::AFTER_DRAIN) { E.fused(acc, cur, wr, wc, fr, fq, lds, wid, lane); S.done(cur); }
#undef PG8_SA
#undef PG8_SB
#undef PG8_STAGE
#undef PG8_LDA
#undef PG8_LDB
#undef PG8_MMA
#undef PG8_WAIT_V
#undef PG8_WAIT_L
#undef PG8_BAR
#undef PG8_SCHED
}
}
#ifndef SSD_NAIVE
#define SSD_NAIVE 0
#endif
#ifndef MLSTM_NAIVE
#define MLSTM_NAIVE 0
#endif
#ifndef FOX_NAIVE
#define FOX_NAIVE 0
#endif
#include <hip/hip_bf16.h>
#include <cmath>
namespace attn_body {
using bf16=__hip_bfloat16;
using bf16x8=__attribute__((ext_vector_type(8)))short;
using s16x4=__attribute__((ext_vector_type(4)))short;
using f32x16=__attribute__((ext_vector_type(16)))float;
using u32x4=__attribute__((ext_vector_type(4)))unsigned;
constexpr int BATCH=8,NHEAD=8,SEQ=2048,D=64,PQ=3584,PO=1024;
constexpr int NW=8,QBLK=32,QB=QBLK*NW,KVBLK=64,NQB=SEQ/QB;
constexpr int ATTN_UNIT_ROWS=QB;
__device__ __forceinline__ int crow(int r,int hi){return (r&3)+8*(r>>2)+4*hi;}
#define SBAR() __builtin_amdgcn_sched_barrier(0)
__device__ __forceinline__ void cmask(f32x16&p0,f32x16&p1,int jb,int qrel,int hi){
  const float NEG=-INFINITY; int kb=64*jb+4*hi;
  #pragma unroll
  for(int r=0;r<16;++r){int kv=kb+(r&3)+8*(r>>2); if(kv>qrel)p0[r]=NEG; if(kv+32>qrel)p1[r]=NEG;}
}

constexpr int NSLOT=3, SLOTB=8192;
constexpr int LDS_K=0, LDS_V=NSLOT*SLOTB, LDS_WS=2*NSLOT*SLOTB, LDS_OST=LDS_WS+NW*64*4, LDS_CK=LDS_OST+NW*4096, LDS_BYTES=LDS_CK+SEQ*4;
constexpr float C2=0.125f*1.4426950408889634f;
__device__ __forceinline__ void glds16(const void*gsrc,unsigned lds_dst){unsigned keep;
  asm volatile("s_mov_b32 %0, m0\n\ts_mov_b32 m0, %2\n\ts_nop 0\n\tglobal_load_lds_dwordx4 %1, off\n\ts_mov_b32 m0, %0":"=&s"(keep):"v"(gsrc),"s"(lds_dst):"memory");}
__device__ __forceinline__ float max3f(float a,float b,float c){float r;asm("v_max3_f32 %0, %1, %2, %3":"=v"(r):"v"(a),"v"(b),"v"(c));return r;}
__device__ __forceinline__ float max2f(float a,float b){float r;asm("v_max_f32_e32 %0, %1, %2":"=v"(r):"v"(a),"v"(b));return r;}
__device__ __forceinline__ float fadd_s(float a,float b){float r;asm("v_add_f32_e32 %0, %1, %2":"=v"(r):"v"(a),"v"(b));return r;}
__device__ __forceinline__ float fsub_s(float a,float b){float r;asm("v_sub_f32_e32 %0, %1, %2":"=v"(r):"v"(a),"v"(b));return r;}
typedef float f32x4_t __attribute__((ext_vector_type(4))); typedef float f32x2_t __attribute__((ext_vector_type(2))); typedef __bf16 bf16x2_t __attribute__((ext_vector_type(2)));
__device__ __forceinline__ unsigned cvtpk_s(float lo,float hi){f32x2_t v={lo,hi};bf16x2_t b=__builtin_convertvector(v,bf16x2_t);return __builtin_bit_cast(unsigned,b);}
#define WAIT_BAR(N) asm volatile("s_waitcnt vmcnt(" #N ") lgkmcnt(0)\n\ts_barrier":::"memory")

__device__ __forceinline__ void qkt(f32x16&p0,f32x16&p1,const char*Kslot,const bf16x8*qr,int r32,int hi){
  const char*kb=Kslot+hi*1024+r32*16;
  #pragma unroll
  for(int d0=0;d0<4;++d0){
    const bf16x8 b0=*reinterpret_cast<const bf16x8*>(kb+d0*2048);
    const bf16x8 b1=*reinterpret_cast<const bf16x8*>(kb+d0*2048+512);
    {p0=__builtin_amdgcn_mfma_f32_32x32x16_bf16(b0,qr[d0],p0,0,0,0);p1=__builtin_amdgcn_mfma_f32_32x32x16_bf16(b1,qr[d0],p1,0,0,0);}}
}
typedef __attribute__((address_space(3))) const char* lds_cptr;
typedef short v4i16_t __attribute__((ext_vector_type(4)));
__device__ __forceinline__ void kload8(bf16x8*kf,lds_cptr kp){
  kf[0]=*(const __attribute__((address_space(3))) bf16x8*)(kp);      kf[1]=*(const __attribute__((address_space(3))) bf16x8*)(kp+512);
  kf[2]=*(const __attribute__((address_space(3))) bf16x8*)(kp+2048); kf[3]=*(const __attribute__((address_space(3))) bf16x8*)(kp+2560);
  kf[4]=*(const __attribute__((address_space(3))) bf16x8*)(kp+4096); kf[5]=*(const __attribute__((address_space(3))) bf16x8*)(kp+4608);
  kf[6]=*(const __attribute__((address_space(3))) bf16x8*)(kp+6144); kf[7]=*(const __attribute__((address_space(3))) bf16x8*)(kp+6656);
}
__device__ __forceinline__ void kload2(bf16x8*kf,lds_cptr kp,int j){ kf[2*j]=*(const __attribute__((address_space(3))) bf16x8*)(kp+j*2048); kf[2*j+1]=*(const __attribute__((address_space(3))) bf16x8*)(kp+j*2048+512); }
__device__ __forceinline__ s16x4 vtr(lds_cptr p){ return __builtin_bit_cast(s16x4,__builtin_amdgcn_ds_read_tr16_b64_v4i16((__attribute__((address_space(3))) v4i16_t*)p)); }
__device__ __forceinline__ float rowmax(const f32x16&p0,const f32x16&p1){
  float a=max3f(p0[0],p0[1],p1[0]),b=max3f(p0[2],p0[3],p1[1]);a=max3f(a,p1[2],p1[3]);
  #pragma unroll
  for(int r=4;r<16;r+=4){a=max3f(a,p0[r],p0[r+1]);b=max3f(b,p0[r+2],p0[r+3]);a=max3f(a,p1[r],p1[r+1]);b=max3f(b,p1[r+2],p1[r+3]);}
  const float m=max2f(a,b);
  auto rr=__builtin_amdgcn_permlane32_swap(__float_as_uint(m),__float_as_uint(m),false,false);
  return max2f(__uint_as_float(rr[0]),__uint_as_float(rr[1]));
}
__device__ __forceinline__ void pv(f32x16*o,int vb,bf16x8 pa0,bf16x8 pa1,bf16x8 pa2,bf16x8 pa3){
  #pragma unroll
  for(int d0=0;d0<2;++d0){s16x4 lo[4],hi[4];
    #pragma unroll
    for(int ks=0;ks<4;++ks){
      asm volatile("ds_read_b64_tr_b16 %0,%1 offset:%c2":"=&v"(lo[ks]):"v"(vb),"i"(d0*4096+ks*1024):"memory");
      asm volatile("ds_read_b64_tr_b16 %0,%1 offset:%c2":"=&v"(hi[ks]):"v"(vb),"i"(d0*4096+ks*1024+512):"memory");}
    asm volatile("s_waitcnt lgkmcnt(0)":::"memory");SBAR();
    #define PK(k) (bf16x8){lo[k][0],lo[k][1],lo[k][2],lo[k][3],hi[k][0],hi[k][1],hi[k][2],hi[k][3]}
    o[d0]=__builtin_amdgcn_mfma_f32_32x32x16_bf16(pa0,PK(0),o[d0],0,0,0);
    o[d0]=__builtin_amdgcn_mfma_f32_32x32x16_bf16(pa1,PK(1),o[d0],0,0,0);
    o[d0]=__builtin_amdgcn_mfma_f32_32x32x16_bf16(pa2,PK(2),o[d0],0,0,0);
    o[d0]=__builtin_amdgcn_mfma_f32_32x32x16_bf16(pa3,PK(3),o[d0],0,0,0);
    #undef PK
  }
}

#ifndef ATTN_STORE16
#define ATTN_STORE16(p,v) (*(u32x4*)(p)=(v))
#endif
template<int THRL> __device__ __forceinline__ void attn_unit(int b,int h,int qb,const bf16*Q,const bf16*K,const bf16*V,bf16*O,const float*cum,char*shm){
  const int tid=threadIdx.x,lane=tid&63,r32=lane&31,hi=lane>>5; const int wid=__builtin_amdgcn_readfirstlane(tid>>6);
  const long rowbase=(long)b*SEQ; const int q0=qb*QB;
  const bf16*Qw=Q+(rowbase+q0+wid*QBLK)*PQ+h*D;
  const bf16*Kh=K+rowbase*PQ+h*D,*Vh=V+rowbase*PQ+h*D;
  const lds_cptr shm3_=(lds_cptr)shm;
  const unsigned lds0=(unsigned)(uintptr_t)shm;
  float*wsf=(float*)(shm+LDS_WS)+wid*64;
  const bf16*ksrc=Kh+(long)lane*PQ+wid*8;
  const bf16*vsrc=Vh+(long)(16*(wid&3)+(lane>>2))*PQ+(wid>>2)*32+(lane&3)*8;
  const unsigned kdst=lds0+LDS_K+wid*1024, vdst=lds0+LDS_V+wid*1024;
  #define DMA_K(t,slot) glds16(ksrc+(long)(t)*KVBLK*PQ,(unsigned)__builtin_amdgcn_readfirstlane(kdst+(slot)))
  #define DMA_V(t,slot) glds16(vsrc+(long)(t)*KVBLK*PQ,(unsigned)__builtin_amdgcn_readfirstlane(vdst+(slot)))
  const int vb0=(int)(lds0+LDS_V)+((lane>>4)&1)*32+(lane&3)*8+(4*hi+((lane&15)>>2))*64;
  const char*Kbase=shm+LDS_K; bf16x8 kf[8];
  const lds_cptr shm3=(lds_cptr)shm; const lds_cptr kp0=shm3+LDS_K+hi*1024+r32*16; const lds_cptr vp0=shm3+LDS_V+((lane>>4)&1)*32+(lane&3)*8+(4*hi+((lane&15)>>2))*64;
  const int NT=(q0+QB)/KVBLK;
  float cqm;
  { float*cks=(float*)(shm+LDS_CK); for(int i=tid;i<q0+QB;i+=NW*64)cks[i]=cum[i]; cqm=cum[q0+wid*QBLK+r32]; asm volatile("s_waitcnt vmcnt(0)":"+v"(cqm)::"memory"); }
  const __attribute__((address_space(3))) float*ckl=(const __attribute__((address_space(3))) float*)(shm3_+LDS_CK)+4*hi;
  #define BIASFILL(C0_,C1_,t_) do{ const __attribute__((address_space(3))) float*cp_=ckl+64*(t_); \
    _Pragma("unroll") for(int a_=0;a_<4;++a_){ const f32x4_t u_=*(const __attribute__((address_space(3))) f32x4_t*)(cp_+8*a_), w_=*(const __attribute__((address_space(3))) f32x4_t*)(cp_+32+8*a_); \
      _Pragma("unroll") for(int i_=0;i_<4;++i_){ C0_[4*a_+i_]=cqm-u_[i_]; C1_[4*a_+i_]=cqm-w_[i_]; } } }while(0)
  DMA_K(0,0);DMA_V(0,0);DMA_K(1,SLOTB);
  bf16x8 qr[4];
  #pragma unroll
  for(int d0=0;d0<4;++d0)qr[d0]=*reinterpret_cast<const bf16x8*>(&Qw[(long)r32*PQ+d0*16+hi*8]);
  float l_reg=0.f;f32x16 o[2];o[0]=f32x16{};o[1]=f32x16{};
  const int qrel=wid*QBLK+r32;
  #define CMASK(P0,P1,t) do{int jb_=(t)-(NT-4); if(jb_>=0)cmask(P0,P1,jb_,qrel,hi);}while(0)
  bool resc=false;
  #define START(P0,P1) do{ const float rm=rowmax(P0,P1); resc=false; \
    { const float dl=rm; cqm=fsub_s(cqm,dl); \
      _Pragma("unroll") for(int r=0;r<16;++r){P0[r]=fsub_s(P0[r],dl);P1[r]=fsub_s(P1[r],dl);} \
      } \
    _Pragma("unroll") for(int r=0;r<16;++r)P0[r]=__builtin_amdgcn_exp2f(P0[r]); }while(0)
  #define RESC() do{ if(resc){ asm volatile("s_waitcnt lgkmcnt(0)":::"memory"); \
      _Pragma("unroll") for(int d_=0;d_<2;++d_) _Pragma("unroll") for(int r=0;r<16;++r)o[d_][r]*=wsf[crow(r,hi)]; } }while(0)
  f32x16 pA0,pA1,pB0,pB1;
  int sl_prev=0,sl_cur=0,sl_next=SLOTB;
  #define ROT() do{sl_prev=sl_cur;sl_cur=sl_next;sl_next=(sl_next==(NSLOT-1)*SLOTB)?0:sl_next+SLOTB;}while(0)
  DMA_K(2,2*SLOTB);
  WAIT_BAR(3);
  BIASFILL(pA0,pA1,0); qkt(pA0,pA1,Kbase,qr,r32,hi);asm volatile("s_nop 15\n\ts_nop 7":"+v"(pA0),"+v"(pA1));CMASK(pA0,pA1,0);
  START(pA0,pA1);
  _Pragma("unroll") for(int r=0;r<16;++r)pA1[r]=__builtin_amdgcn_exp2f(pA1[r]);
  WAIT_BAR(0);
  DMA_K(3,0);DMA_V(1,SLOTB);
  ROT();
  kload8(kf,kp0+sl_cur);
  WAIT_BAR(2);
  s16x4 vlo[8],vhi[8]; u32x4 pw0,pw1,pw2,pw3;
  #define PKW(P,B) cvtpk_s(P[B],P[B+1])
  #define PAF(k) __builtin_bit_cast(bf16x8,pw##k)
  #define VFR(i) (bf16x8){vlo[i][0],vlo[i][1],vlo[i][2],vlo[i][3],vhi[i][0],vhi[i][1],vhi[i][2],vhi[i][3]}
  #define PIN(x) asm volatile("":"+v"(x))
  #define MX3(a,b,c) __builtin_fmaxf(__builtin_fmaxf((a),(b)),(c))
  #define GAPA(MF,A0,A1,A2,A3,W0,W1,PW) do{ MF; sacc+=A0; sacc+=A1; sacc+=A2; sacc+=A3; PIN(sacc); W0; W1; PIN(PW); SBAR(); }while(0)
  #define EX(v) __builtin_amdgcn_exp2f(v)
  #define GAPB(MF,X,B) do{ MF; X[B]=EX(X[B]); X[B+1]=EX(X[B+1]); X[B+2]=EX(X[B+2]); X[B+3]=EX(X[B+3]); PIN(X); SBAR(); }while(0)
  #define VRD(i) do{ vlo[i]=vtr(vp_+(((i)>>2)*4096+((i)&3)*1024)); vhi[i]=vtr(vp_+(((i)>>2)*4096+((i)&3)*1024+512)); }while(0)
  #define KRD(G,j) do{ if(G){ kload2(kf,kp0+sl_next,j); SBAR(); } }while(0)
  #define STEP(C0,C1,P0,P1,t,GK,GV,GL) do{ BIASFILL(C0,C1,t); SBAR(); \
    const lds_cptr vp_=vp0+sl_prev; \
    VRD(0); SBAR(); float sacc=(P0[0]+P0[1]); \
    GAPA(C0=__builtin_amdgcn_mfma_f32_32x32x16_bf16(kf[0],qr[0],C0,0,0,0), P0[2],P0[3],P0[4],P0[5],     pw0[0]=PKW(P0,0), pw0[1]=PKW(P0,2), pw0); \
    VRD(4); SBAR(); GAPA(C1=__builtin_amdgcn_mfma_f32_32x32x16_bf16(kf[1],qr[0],C1,0,0,0), P0[6],P0[7],P0[8],P0[9],     pw0[2]=PKW(P0,4), pw0[3]=PKW(P0,6), pw0); \
    VRD(1); SBAR(); GAPA(C0=__builtin_amdgcn_mfma_f32_32x32x16_bf16(kf[2],qr[1],C0,0,0,0),   P0[10],P0[11],P0[12],P0[13], pw1[0]=PKW(P0,8), pw1[1]=PKW(P0,10), pw1); \
    VRD(5); SBAR(); GAPA(C1=__builtin_amdgcn_mfma_f32_32x32x16_bf16(kf[3],qr[1],C1,0,0,0),   P0[14],P0[15],P1[0],P1[1],   pw1[2]=PKW(P0,12),pw1[3]=PKW(P0,14), pw1); \
    VRD(2); SBAR(); GAPA(C0=__builtin_amdgcn_mfma_f32_32x32x16_bf16(kf[4],qr[2],C0,0,0,0),   P1[2],P1[3],P1[4],P1[5],     pw2[0]=PKW(P1,0), pw2[1]=PKW(P1,2), pw2); \
    VRD(6); SBAR(); GAPA(C1=__builtin_amdgcn_mfma_f32_32x32x16_bf16(kf[5],qr[2],C1,0,0,0),   P1[6],P1[7],P1[8],P1[9],     pw2[2]=PKW(P1,4), pw2[3]=PKW(P1,6), pw2); \
    VRD(3); SBAR(); GAPA(C0=__builtin_amdgcn_mfma_f32_32x32x16_bf16(kf[6],qr[3],C0,0,0,0),   P1[10],P1[11],P1[12],P1[13], pw3[0]=PKW(P1,8), pw3[1]=PKW(P1,10), pw3); \
    VRD(7); SBAR(); GAPA(C1=__builtin_amdgcn_mfma_f32_32x32x16_bf16(kf[7],qr[3],C1,0,0,0),   P1[14],P1[15],0.f,0.f,       pw3[2]=PKW(P1,12),pw3[3]=PKW(P1,14), pw3); \
    l_reg+=sacc; \
    if(GK){DMA_K((t)+3,sl_cur);} if(GV){DMA_V((t)+1,sl_next);} \
    CMASK(C0,C1,t); \
    { float a=MX3(C0[0],C0[1],C1[0]),b=MX3(C0[2],C0[3],C1[1]); a=MX3(a,C1[2],C1[3]); \
      _Pragma("unroll") for(int r=4;r<16;r+=4){a=MX3(a,C0[r],C0[r+1]);b=MX3(b,C0[r+2],C0[r+3]);a=MX3(a,C1[r],C1[r+1]);b=MX3(b,C1[r+2],C1[r+3]);} \
      float rm=__builtin_fmaxf(a,b); { auto rr=__builtin_amdgcn_permlane32_swap(__float_as_uint(rm),__float_as_uint(rm),false,false); rm=__builtin_fmaxf(__uint_as_float(rr[0]),__uint_as_float(rr[1])); } \
      resc=false; \
      if(__builtin_expect(__any(rm>(float)THRL),0)){ const float dl=__builtin_fmaxf(rm,0.f); cqm-=dl; \
        _Pragma("unroll") for(int r=0;r<16;++r){C0[r]-=dl;C1[r]-=dl;} \
        const float f=__builtin_amdgcn_exp2f(-dl); l_reg*=f; if(hi==0)wsf[r32]=f; resc=true; } } \
    SBAR(); \
    GAPB(o[0]=__builtin_amdgcn_mfma_f32_32x32x16_bf16(PAF(0),VFR(0),o[0],0,0,0), C0,0); \
    GAPB(o[1]=__builtin_amdgcn_mfma_f32_32x32x16_bf16(PAF(0),VFR(4),o[1],0,0,0), C0,4); \
    KRD(GL,0); GAPB(o[0]=__builtin_amdgcn_mfma_f32_32x32x16_bf16(PAF(1),VFR(1),o[0],0,0,0), C0,8); \
    KRD(GL,1); GAPB(o[1]=__builtin_amdgcn_mfma_f32_32x32x16_bf16(PAF(1),VFR(5),o[1],0,0,0), C0,12); \
    KRD(GL,2); GAPB(o[0]=__builtin_amdgcn_mfma_f32_32x32x16_bf16(PAF(2),VFR(2),o[0],0,0,0), C1,0); \
    KRD(GL,3); GAPB(o[1]=__builtin_amdgcn_mfma_f32_32x32x16_bf16(PAF(2),VFR(6),o[1],0,0,0), C1,4); \
    GAPB(o[0]=__builtin_amdgcn_mfma_f32_32x32x16_bf16(PAF(3),VFR(3),o[0],0,0,0), C1,8); \
    GAPB(o[1]=__builtin_amdgcn_mfma_f32_32x32x16_bf16(PAF(3),VFR(7),o[1],0,0,0), C1,12); \
    }while(0)
  int t=1;
  #undef CMASK
  #define CMASK(P0,P1,t) do{}while(0)
  for(;t+5<NT;t+=2){
    STEP(pB0,pB1,pA0,pA1,t,true,true,true);     WAIT_BAR(2); RESC(); ROT();
    STEP(pA0,pA1,pB0,pB1,t+1,true,true,true);   WAIT_BAR(2); RESC(); ROT();
  }
  #undef CMASK
  #define CMASK(P0,P1,t) do{int jb_=(t)-(NT-4); if(jb_>=0)cmask(P0,P1,jb_,qrel,hi);}while(0)
  #define ENDW(tt) do{ if((tt)+3<NT){WAIT_BAR(2);} else if((tt)+2<NT){WAIT_BAR(1);} else {WAIT_BAR(0);} }while(0)
  for(;t+1<NT;t+=2){
    STEP(pB0,pB1,pA0,pA1,t,(t+3<NT),(t+1<NT),(t+1<NT));       ENDW(t);   RESC(); ROT();
    STEP(pA0,pA1,pB0,pB1,t+1,(t+4<NT),(t+2<NT),(t+2<NT));     ENDW(t+1); RESC(); ROT();
  }
  STEP(pB0,pB1,pA0,pA1,NT-1,false,false,false); RESC();
  { float sacc=pB0[0]+pB0[1]; _Pragma("unroll") for(int r=2;r<16;++r)sacc+=pB0[r]; _Pragma("unroll") for(int r=0;r<16;++r)sacc+=pB1[r]; l_reg+=sacc;
    pw0=(u32x4){PKW(pB0,0),PKW(pB0,2),PKW(pB0,4),PKW(pB0,6)};pw1=(u32x4){PKW(pB0,8),PKW(pB0,10),PKW(pB0,12),PKW(pB0,14)};pw2=(u32x4){PKW(pB1,0),PKW(pB1,2),PKW(pB1,4),PKW(pB1,6)};pw3=(u32x4){PKW(pB1,8),PKW(pB1,10),PKW(pB1,12),PKW(pB1,14)};
    SBAR(); pv(o,vb0+sl_cur,PAF(0),PAF(1),PAF(2),PAF(3)); }
  #undef PKW
  #undef PAF
  #undef VFR
  #undef PIN
  #undef MX3
  #undef GAPA
  #undef GAPB
  #undef EX
  #undef VRD
  #undef KRD
  #undef STEP
  #undef ENDW
  {auto rr=__builtin_amdgcn_permlane32_swap(__float_as_uint(l_reg),__float_as_uint(l_reg),false,false);l_reg=__uint_as_float(rr[0])+__uint_as_float(rr[1]);}
  if(hi==0)wsf[32+r32]=l_reg;asm volatile("s_waitcnt lgkmcnt(0)":::"memory");
  float rli[16];
  #pragma unroll
  for(int r=0;r<16;++r)rli[r]=__builtin_amdgcn_rcpf(wsf[32+crow(r,hi)]);
  bf16*Ow=O+(rowbase+q0+wid*QBLK)*PO+h*D;
  { bf16*stg=(bf16*)(shm+LDS_OST)+wid*2048;
    #pragma unroll
    for(int r=0;r<16;++r){const int orow=crow(r,hi);
      #pragma unroll
      for(int d0=0;d0<2;++d0)stg[orow*64+d0*32+r32]=__float2bfloat16(o[d0][r]*rli[r]);}
    asm volatile("s_waitcnt lgkmcnt(0)":::"memory");
    #pragma unroll
    for(int i=0;i<4;++i){const int row=i*8+(lane>>3),ch=lane&7; const u32x4 v=*(const u32x4*)(stg+row*64+ch*8); ATTN_STORE16(Ow+(long)row*PO+ch*8,v);} }
  asm volatile("s_waitcnt lgkmcnt(0)\n\ts_barrier":::"memory");
  #undef DMA_K
  #undef BIASFILL
  #undef DMA_V
  #undef CMASK
  #undef START
  #undef RESC
  #undef ROT
}
constexpr int ATTN_LDS_BYTES=LDS_BYTES;
struct AttnTensors { const bf16* Q; const bf16* K; const bf16* V; bf16* O; const float* cum; };
struct AttnUnit { int bh; int qb; };
struct StaticOrder {
  int vcu, G;
  __device__ __forceinline__ explicit StaticOrder(int grid,int v):vcu(v),G(grid){}
  __device__ __forceinline__ bool next(int i,AttnUnit&u)const{ const int pr=vcu+(i>>1)*G; if(pr>=256)return false; const int s=pr&3; u.bh=pr>>2; u.qb=(i&1)?7-s:s; return true; }
  __device__ __forceinline__ void a_ready(const AttnUnit&)const{}
  __device__ __forceinline__ void done(const AttnUnit&)const{}
};
template<class Sched,int THRL=8> __device__ __forceinline__ void attn_phase(char*lds,const AttnTensors&T,const Sched&S){
  AttnUnit u;
  for(int i=0;S.next(i,u);++i){ S.a_ready(u); attn_unit<THRL>(u.bh/NHEAD,u.bh%NHEAD,u.qb,T.Q,T.K,T.V,T.O,T.cum+(long)u.bh*SEQ,lds); S.done(u); }
}
#undef SBAR
#undef WAIT_BAR
}
constexpr int NWAVES = 8;
constexpr int T = 16384, D = 1024, SEQ = 2048, NBATCH = 8, DEPTH = 4;
constexpr float ALPHA = 1.6817928305074290f;
constexpr float LN_EPS = 1e-5f;
constexpr int AB_IN = 4112, CD_IN = 3600, NPE = 4096, NPO = 3584;
constexpr float LOG2E = 1.4426950408889634f;
constexpr float FOX_C2 = 0.125f * LOG2E;
constexpr float MLSTM_KSCALE = 0.08838834764831845f;
constexpr int RPAD = 40960;
constexpr int NPH_LAYER = 12, NPHASES = 1 + DEPTH * NPH_LAYER;
#ifndef MK_ONE_LAUNCH
#define MK_ONE_LAUNCH 1
#endif

constexpr size_t MiB = 1u << 20, KiB = 1u << 10;
constexpr size_t WS_CTL = 0, CTL_ZERO_BYTES = 1 * MiB;
constexpr size_t WS_BCNT = 1 * MiB, WS_PANEL = WS_BCNT + 64 * KiB, WS_ROUTE = WS_BCNT + 128 * KiB, WS_GATE = WS_BCNT + 384 * KiB, WS_POS = WS_BCNT + 512 * KiB,
                 WS_DEC = WS_BCNT + 640 * KiB, WS_MLOC = WS_BCNT + 704 * KiB, WS_BLAST = WS_BCNT + 712 * KiB, WS_MPREV = WS_BCNT + 720 * KiB,
                 WS_FOXC = 2 * MiB, WS_NLOC = 2 * MiB + 512 * KiB, WS_SG = 3 * MiB;
constexpr size_t WS_WINE = 4 * MiB, WS_WINO = 20 * MiB, WS_WOUTE = 34 * MiB, WS_WOUTO = 40 * MiB, WS_WGU = 44 * MiB, WS_WD = 300 * MiB;
constexpr size_t WS_HF = 428 * MiB, WS_HB = 492 * MiB, WS_H1F = 524 * MiB, WS_H1B = 588 * MiB;
constexpr size_t WS_R1 = 620 * MiB;
constexpr size_t WS_R2 = 748 * MiB;
constexpr size_t WS_R3 = 812 * MiB;
constexpr size_t WS_R4 = 860 * MiB;
constexpr size_t WS_MIX = 892 * MiB;
constexpr size_t WS_TAB = 940 * MiB, TAB_LAYER = 208 * KiB, TAB_GPW = 0, TAB_RGW = 64 * KiB, TAB_REW = 80 * KiB;
constexpr size_t WS_END = 941 * MiB;
constexpr int CW_BAR = 4096;

constexpr int RING_BYTES = 131072, SMALL_OFF = RING_BYTES, SMALL_BYTES = 8192, MISC_OFF = SMALL_OFF + SMALL_BYTES, LDS_BYTES = 147456;

#define GAS __attribute__((address_space(1)))
#define LAS __attribute__((address_space(3)))
typedef unsigned short bf16;
typedef unsigned v4u __attribute__((ext_vector_type(4)));
typedef unsigned v2u __attribute__((ext_vector_type(2)));
typedef float f32x4 __attribute__((ext_vector_type(4)));
typedef float f32x2 __attribute__((ext_vector_type(2)));
typedef int i32x4 __attribute__((ext_vector_type(4)));
typedef int i32x2 __attribute__((ext_vector_type(2)));
#define LDS_WAIT() asm volatile("s_waitcnt lgkmcnt(0)" ::: "memory")
__device__ __forceinline__ unsigned f2bf(float f) { unsigned u = __builtin_bit_cast(unsigned, f); return (u + 0x7fffu + ((u >> 16) & 1u)) >> 16; }
__device__ __forceinline__ unsigned pk2(float lo, float hi) { return f2bf(lo) | (f2bf(hi) << 16); }
__device__ __forceinline__ float bflo(unsigned w) { return __builtin_bit_cast(float, w << 16); }
__device__ __forceinline__ float bfhi(unsigned w) { return __builtin_bit_cast(float, w & 0xffff0000u); }
__device__ __forceinline__ float bf2f(bf16 b) { return __builtin_bit_cast(float, (unsigned)b << 16); }
__device__ __forceinline__ float wave_sum(float v) {
#pragma unroll
    for (int o = 1; o < 64; o <<= 1) v += __shfl_xor(v, o);
    return v;
}
__device__ __forceinline__ float wave_max(float v) {
#pragma unroll
    for (int o = 1; o < 64; o <<= 1) v = fmaxf(v, __shfl_xor(v, o));
    return v;
}
__device__ __forceinline__ float wave_scan_sum(float v, int lane) {
#pragma unroll
    for (int o = 1; o < 64; o <<= 1) { const float t = __shfl_up(v, o); if (lane >= o) v += t; }
    return v;
}
__device__ __forceinline__ float wave_scan_max(float v, int lane) {
#pragma unroll
    for (int o = 1; o < 64; o <<= 1) { const float t = __shfl_up(v, o); if (lane >= o) v = fmaxf(v, t); }
    return v;
}
__device__ __forceinline__ float softplus_f(float x) { return x > 20.f ? x : log1pf(expf(x)); }
__device__ __forceinline__ float logsigmoid_f(float x) { return fminf(x, 0.f) - log1pf(expf(-fabsf(x))); }
__device__ __forceinline__ float sigmoid_f(float x) { return 1.0f / (1.0f + expf(-x)); }
#define XB_TMO      128
#define XB_XCNT(j)  (256  + 64 * (j))
#define XB_XSUB(j)  (1280 + 64 * (j))
#define XB_XGEN(j)  (2304 + 64 * (j))
#define XB_TOP      3328
#define XB_TOPGEN   3392
#define XCD_BAR_WORDS 3456
#define XB_SPIN_CAP (1u << 18)

__device__ __forceinline__ unsigned xb_ld(unsigned* p)              { return __hip_atomic_load(p, __ATOMIC_RELAXED, __HIP_MEMORY_SCOPE_AGENT); }
__device__ __forceinline__ unsigned xb_add(unsigned* p, unsigned v) { return __hip_atomic_fetch_add(p, v, __ATOMIC_RELAXED, __HIP_MEMORY_SCOPE_AGENT); }
__device__ __forceinline__ unsigned xb_xcc_id() { return (unsigned)__builtin_amdgcn_s_getreg((3 << 11) | 20) & 0xFu; }
#define XB_SPIN(cond, bar) do { unsigned _sp = 0; while (cond) { __builtin_amdgcn_s_sleep(1); \
    if ((++_sp & 255u) == 0u) { if (xb_ld(&(bar)[XB_TMO])) break; if (_sp > XB_SPIN_CAP) { atomicAdd(&(bar)[XB_TMO], 1u); break; } } } } while (0)

struct XcdBarrier {
    unsigned* bar; unsigned x;
    volatile LAS unsigned* st;
};

__device__ __forceinline__ XcdBarrier xcd_barrier_post(unsigned* bar, volatile LAS unsigned* st) {
    XcdBarrier b; b.bar = bar; b.x = xb_xcc_id(); b.st = st;
    if (threadIdx.x == 0) (void)xb_add(&bar[XB_XCNT(b.x)], 1u);
    return b;
}
__device__ __forceinline__ void xcd_barrier_complete(unsigned* bar, unsigned x, unsigned& nloc, unsigned& nx) {
    const unsigned G = gridDim.x * gridDim.y * gridDim.z;
    unsigned sum, cnt, mine, sp = 0u;
    for (;;) {
        sum = 0u; cnt = 0u; mine = 0u;
#pragma unroll
        for (unsigned j = 0; j < 16; ++j) { const unsigned c = xb_ld(&bar[XB_XCNT(j)]); sum += c; cnt += (c > 0u) ? 1u : 0u; mine = (j == x) ? c : mine; }
        if (sum == G) break;
        __builtin_amdgcn_s_sleep(1);
        if ((++sp & 255u) == 0u) { if (xb_ld(&bar[XB_TMO])) break; if (sp > XB_SPIN_CAP) { atomicAdd(&bar[XB_TMO], 1u); break; } }
    }
    nloc = mine > 0u ? mine : 1u; nx = cnt > 0u ? cnt : 1u;
}

__device__ __forceinline__ void xcd_barrier(const XcdBarrier& b) {
    asm volatile("s_waitcnt vmcnt(0)" ::: "memory");
    __syncthreads();
    if (threadIdx.x == 0) {
        unsigned* bar = b.bar;
        __builtin_amdgcn_s_waitcnt(0);
        unsigned nloc = b.st[0], nx = b.st[1];
        if (nloc == 0u) { xcd_barrier_complete(bar, b.x, nloc, nx); b.st[0] = nloc; b.st[1] = nx; }
        const unsigned old = xb_add(&bar[XB_XSUB(b.x)], 1u);
        const unsigned gen = old / nloc;
        if (old + 1u == (gen + 1u) * nloc) {
            __builtin_amdgcn_fence(__ATOMIC_RELEASE, "agent");
            asm volatile("s_waitcnt vmcnt(0)" ::: "memory");
            const unsigned og = xb_add(&bar[XB_TOP], 1u);
            const unsigned tg = og / nx;
            if (og + 1u == (tg + 1u) * nx) xb_add(&bar[XB_TOPGEN], 1u);
            else XB_SPIN(xb_ld(&bar[XB_TOPGEN]) == tg, bar);
            __builtin_amdgcn_fence(__ATOMIC_ACQUIRE, "agent");
            xb_add(&bar[XB_XGEN(b.x)], 1u);
            asm volatile("s_waitcnt vmcnt(0)" ::: "memory");
        } else {
            XB_SPIN(xb_ld(&bar[XB_XGEN(b.x)]) == gen, bar);
            __builtin_amdgcn_fence(__ATOMIC_ACQUIRE, "agent");
            asm volatile("s_waitcnt vmcnt(0)" ::: "memory");
        }
    }
    __syncthreads();
}
struct Frame {
    LAS unsigned char* lds;
    volatile LAS unsigned* MISC;
    unsigned* ctl;
    int tid, lane, wave, vcu, G, gw, NGW;
};
typedef const float* const cfpc_t; typedef __attribute__((address_space(4))) cfpc_t* kargp_t;
__device__ __forceinline__ kargp_t kin() { kargp_t p = (kargp_t)__builtin_amdgcn_kernarg_segment_ptr(); asm volatile("" : "+s"(p)); return p; }
#define KIN(i) (kin()[i])
typedef unsigned char* const ucpc_t; typedef __attribute__((address_space(4))) ucpc_t* kargu_t;
__device__ __forceinline__ unsigned char* kws() { return ((kargu_t)kin())[28]; }
__device__ __forceinline__ float* kout() { return (float*)((kargu_t)kin())[27]; }
enum { I_X = 0, I_ABWIN, I_CONVA, I_CONVW, I_CONVB, I_DTB, I_ALOG, I_DSKIP, I_NORMW, I_ABWOUT, I_CDWIN, I_IB, I_FB, I_HNW, I_FOXB, I_CDWOUT, I_LN1G, I_LN1B, I_LN2G, I_LN2B,
       I_RGW, I_RGB, I_REW, I_REB, I_WG, I_WU, I_WDN };

__device__ __forceinline__ void row_load(const float* row, int lane, f32x4 (&v)[4]) {
#pragma unroll
    for (int j = 0; j < 4; ++j) v[j] = ((const f32x4*)row)[lane + 64 * j];
}
__device__ __forceinline__ void row_store_f32(float* row, int lane, const f32x4 (&v)[4]) {
#pragma unroll
    for (int j = 0; j < 4; ++j) ((f32x4*)row)[lane + 64 * j] = v[j];
}
__device__ __forceinline__ void row_store_bf16(bf16* row, int lane, const f32x4 (&v)[4]) {
#pragma unroll
    for (int j = 0; j < 4; ++j) { v2u w; w.x = pk2(v[j][0], v[j][1]); w.y = pk2(v[j][2], v[j][3]); ((v2u*)row)[lane + 64 * j] = w; }
}
__device__ __forceinline__ void row_load_bf16(const bf16* row, int lane, f32x4 (&v)[4]) {
#pragma unroll
    for (int j = 0; j < 4; ++j) { const v2u w = ((const v2u*)row)[lane + 64 * j]; v[j] = (f32x4){bflo(w.x), bfhi(w.x), bflo(w.y), bfhi(w.y)}; }
}
__device__ __forceinline__ void dma1k(const void* gsrc, unsigned lds_dst) { unsigned keep;
    asm volatile("s_mov_b32 %0, m0\n\ts_mov_b32 m0, %2\n\ts_nop 0\n\tglobal_load_lds_dwordx4 %1, off\n\ts_mov_b32 m0, %0" : "=&s"(keep) : "v"(gsrc), "s"(lds_dst) : "memory"); }
template <int KB> __device__ __forceinline__ void row_dma(const void* grow, unsigned lds_dst, int lane) {
#pragma unroll
    for (int i = 0; i < KB; ++i) dma1k((const char*)grow + 1024 * i + 16 * lane, (unsigned)__builtin_amdgcn_readfirstlane(lds_dst + 1024 * i));
}
#define DMA_WAIT_ALL() asm volatile("s_waitcnt vmcnt(0)" ::: "memory")
__device__ __forceinline__ void row_load_bf16_lds(const LAS unsigned char* row, int lane, f32x4 (&v)[4]) {
#pragma unroll
    for (int j = 0; j < 4; ++j) { const v2u w = ((const LAS v2u*)row)[lane + 64 * j]; v[j] = (f32x4){bflo(w.x), bfhi(w.x), bflo(w.y), bfhi(w.y)}; }
}
__device__ __forceinline__ void row_load_f32_lds(const LAS unsigned char* row, int lane, f32x4 (&v)[4]) {
#pragma unroll
    for (int j = 0; j < 4; ++j) v[j] = ((const LAS f32x4*)row)[lane + 64 * j];
}
__device__ __forceinline__ void row_layernorm(f32x4 (&v)[4], const float* g, const float* b, int lane) {
    float s = 0.f;
#pragma unroll
    for (int j = 0; j < 4; ++j) s += (v[j][0] + v[j][1]) + (v[j][2] + v[j][3]);
    const float mean = wave_sum(s) * (1.f / D); float s2 = 0.f;
#pragma unroll
    for (int j = 0; j < 4; ++j) { v[j] = v[j] - mean; s2 += (v[j][0] * v[j][0] + v[j][1] * v[j][1]) + (v[j][2] * v[j][2] + v[j][3] * v[j][3]); }
    const float rstd = 1.0f / sqrtf(wave_sum(s2) * (1.f / D) + LN_EPS);
#pragma unroll
    for (int j = 0; j < 4; ++j) { const f32x4 gg = ((const f32x4*)g)[lane + 64 * j], bb = ((const f32x4*)b)[lane + 64 * j]; v[j] = v[j] * rstd * gg + bb; }
}
template <int n, int o, int N> struct RedStep {
    static __device__ __forceinline__ void run(float (&a)[N], int lane) { const bool up = (lane & o) != 0;
#pragma unroll
        for (int i = 0; i < n / 2; ++i) { const float keep = up ? a[i + n / 2] : a[i], send = up ? a[i] : a[i + n / 2]; a[i] = keep + __shfl_xor(send, o); }
        RedStep<n / 2, o / 2, N>::run(a, lane); }
};
template <int o, int N> struct RedStep<1, o, N> {
    static __device__ __forceinline__ void run(float (&a)[N], int) { float r = a[0];
#pragma unroll
        for (int oo = o; oo >= 1; oo >>= 1) r += __shfl_xor(r, oo);
        a[0] = r; }
};
template <int N> __device__ __forceinline__ float wave_reduce_multi(float (&a)[N], int lane) { RedStep<N, 32, N>::run(a, lane); return a[0]; }
__device__ __forceinline__ void row_proj16x2(const f32x4 (&v0)[4], const f32x4 (&v1)[4], const f32x4* TB, float* sg0, float* sg1, int lane) {
    float a[16], b[16];
#pragma unroll
    for (int c = 0; c < 16; ++c) { a[c] = 0.f; b[c] = 0.f; }
#pragma unroll
    for (int j = 0; j < 4; ++j)
#pragma unroll
        for (int i = 0; i < 4; ++i) { const float x = v0[j][i], y = v1[j][i]; const f32x4* tb = TB + (size_t)((j * 4 + i) * 4) * 64 + lane;
            const f32x4 w0 = tb[0], w1 = tb[64], w2 = tb[128], w3 = tb[192];
#pragma unroll
            for (int c = 0; c < 4; ++c) { a[c] += x * w0[c]; a[4 + c] += x * w1[c]; a[8 + c] += x * w2[c]; a[12 + c] += x * w3[c]; b[c] += y * w0[c]; b[4 + c] += y * w1[c]; b[8 + c] += y * w2[c]; b[12 + c] += y * w3[c]; } }
    const float r0 = wave_reduce_multi<16>(a, lane), r1 = wave_reduce_multi<16>(b, lane);
    if ((lane & 3) == 0) { sg0[lane >> 2] = r0; if (sg1) sg1[lane >> 2] = r1; }
}
__device__ __forceinline__ void row_gate_proj2(Frame& F, const f32x4 (&v0)[4], const f32x4 (&v1)[4], int layer, int m0, int m1) {
    float* sg0 = (float*)(kws() + WS_SG) + (size_t)m0 * 16; float* sg1 = m1 >= 0 ? (float*)(kws() + WS_SG) + (size_t)m1 * 16 : nullptr;
    row_proj16x2(v0, v1, (const f32x4*)(kws() + WS_TAB + (size_t)layer * TAB_LAYER + TAB_GPW), sg0, sg1, F.lane);
}

__device__ __forceinline__ void row_gate_proj2_direct(Frame& F, const f32x4 (&v0)[4], const f32x4 (&v1)[4], int m0, int m1) {
    float* sg0 = (float*)(kws() + WS_SG) + (size_t)m0 * 16; float* sg1 = m1 >= 0 ? (float*)(kws() + WS_SG) + (size_t)m1 * 16 : nullptr; const float* W = KIN(I_ABWIN);
    float a[16], b[16];
#pragma unroll
    for (int c = 0; c < 16; ++c) { a[c] = 0.f; b[c] = 0.f; }
#pragma unroll
    for (int j = 0; j < 4; ++j)
#pragma unroll
        for (int i = 0; i < 4; ++i) { const float x = v0[j][i], y = v1[j][i]; const float* wr = W + (size_t)(256 * j + 4 * F.lane + i) * AB_IN + 4096;
            const f32x4 w0 = *(const f32x4*)wr, w1 = *(const f32x4*)(wr + 4), w2 = *(const f32x4*)(wr + 8), w3 = *(const f32x4*)(wr + 12);
#pragma unroll
            for (int c = 0; c < 4; ++c) { a[c] += x * w0[c]; a[4 + c] += x * w1[c]; a[8 + c] += x * w2[c]; a[12 + c] += x * w3[c]; b[c] += y * w0[c]; b[4 + c] += y * w1[c]; b[8 + c] += y * w2[c]; b[12 + c] += y * w3[c]; } }
    const float r0 = wave_reduce_multi<16>(a, F.lane), r1 = wave_reduce_multi<16>(b, F.lane);
    if ((F.lane & 3) == 0) { sg0[F.lane >> 2] = r0; if (sg1) sg1[F.lane >> 2] = r1; }
}
__device__ __forceinline__ void transpose_tile(const float* W, int ldw, int k0, int n0, bf16* WT, int ldt, int drow0, float scale, const float* kscale, LAS float* scr, int lane) {
    const int rs = lane >> 3, c4 = 4 * (lane & 7);
    f32x4 v[8];
#pragma unroll
    for (int i = 0; i < 8; ++i) v[i] = *(const f32x4*)(W + (size_t)(k0 + 8 * i + rs) * ldw + n0 + c4);
#pragma unroll
    for (int i = 0; i < 8; ++i) { const int kk = 8 * i + rs; float sc = scale; if (kscale) sc *= kscale[kk]; LAS float* d = scr + kk * 33 + c4;
        d[0] = v[i][0] * sc; d[1] = v[i][1] * sc; d[2] = v[i][2] * sc; d[3] = v[i][3] * sc; }
    LDS_WAIT(); asm volatile("" ::: "memory");
    const int c = lane & 7;
#pragma unroll
    for (int j = 0; j < 4; ++j) { const int n = (lane >> 3) + 8 * j; const LAS float* s = scr + (8 * c) * 33 + n;
        v4u o; o.x = pk2(s[0 * 33], s[1 * 33]); o.y = pk2(s[2 * 33], s[3 * 33]); o.z = pk2(s[4 * 33], s[5 * 33]); o.w = pk2(s[6 * 33], s[7 * 33]);
        *(v4u*)(WT + (size_t)(drow0 + n) * ldt + k0 + 8 * c) = o; }
    LDS_WAIT(); asm volatile("" ::: "memory");
}
__device__ __forceinline__ void p_prologue(Frame& F0) {   Frame F = F0; asm volatile("" : "+v"(F.tid), "+v"(F.lane));
    LAS float* scr = (LAS float*)(F.lds + F.wave * 16384);
    bf16* WinE = (bf16*)(kws() + WS_WINE); bf16* WinO = (bf16*)(kws() + WS_WINO); bf16* WoutE = (bf16*)(kws() + WS_WOUTE); bf16* WoutO = (bf16*)(kws() + WS_WOUTO);
    bf16* Wgu = (bf16*)(kws() + WS_WGU); bf16* Wd = (bf16*)(kws() + WS_WD);
    constexpr int N_WINE = 2 * 2048, N_WINO = 2 * 1792, N_WOE = 2 * 768, N_WOO = 2 * 512, N_GU = 128 * 512, N_D = 128 * 256;
    constexpr int NITEMS = N_WINE + N_WINO + N_WOE + N_WOO + N_GU + N_D;
    for (int it = F.gw; it < NITEMS; it += F.NGW) {
        int r = it;
        if (r < N_WINE) { const int j = r / 2048, q = r % 2048, kb = q / 128, nb = q % 128;
            transpose_tile(KIN(I_ABWIN) + (size_t)j * D * AB_IN, AB_IN, 64 * kb, 32 * nb, WinE + (size_t)j * NPE * D, D, 32 * nb, 1.f, nullptr, scr, F.lane); continue; } r -= N_WINE;
        if (r < N_WINO) { const int j = r / 1792, q = r % 1792, seg = q / 256, q2 = q % 256, kb = q2 / 16, nb = q2 % 16;
            const int scol = (seg < 3 ? 512 * seg : 1544 + 512 * (seg - 3)) + 32 * nb; const float sc = seg == 1 ? MLSTM_KSCALE : (seg == 4 ? FOX_C2 : 1.f);
            transpose_tile(KIN(I_CDWIN) + (size_t)j * D * CD_IN, CD_IN, 64 * kb, scol, WinO + (size_t)j * NPO * D, D, 512 * seg + 32 * nb, sc, nullptr, scr, F.lane); continue; } r -= N_WINO;
        if (r < N_WOE) { const int j = r / 768, q = r % 768, kb = q / 32, nb = q % 32;
            const float* ks = kb >= 8 ? KIN(I_NORMW) + (size_t)j * 1024 + (64 * kb - 512) : nullptr;
            transpose_tile(KIN(I_ABWOUT) + (size_t)j * 1536 * D, D, 64 * kb, 32 * nb, WoutE + (size_t)j * D * 1536, 1536, 32 * nb, 1.f, ks, scr, F.lane); continue; } r -= N_WOE;
        if (r < N_WOO) { const int j = r / 512, q = r % 512, kb = q / 32, nb = q % 32;
            transpose_tile(KIN(I_CDWOUT) + (size_t)j * D * D, D, 64 * kb, 32 * nb, WoutO + (size_t)j * D * D, D, 32 * nb, 1.f, nullptr, scr, F.lane); continue; } r -= N_WOO;
        if (r < N_GU) { const int le = r / 512, q = r % 512, half = q / 256, q2 = q % 256, kb = q2 / 16, nb = q2 % 16, n0 = 32 * nb;
            const float* src = (half ? KIN(I_WU) : KIN(I_WG)) + (size_t)le * D * 512;
            transpose_tile(src, 512, 64 * kb, n0, Wgu + (size_t)le * D * D, D, 256 * (n0 / 128) + 128 * half + (n0 % 128), 1.f, nullptr, scr, F.lane); continue; } r -= N_GU;
        { const int le = r / 256, q = r % 256, kb = q / 32, nb = q % 32;
            transpose_tile(KIN(I_WDN) + (size_t)le * 512 * D, D, 64 * kb, 32 * nb, Wd + (size_t)le * D * 512, 512, 32 * nb, 1.f, nullptr, scr, F.lane); }
    }
    for (int e = F.vcu * 512 + F.tid; e < DEPTH * 13312; e += F.G * 512) { const int L = e / 13312, r = e % 13312, ln = r & 63; f32x4* tab = (f32x4*)(kws() + WS_TAB + (size_t)L * TAB_LAYER);
        if (r < 4096) { const int ch = (r >> 6) & 3, ji = r >> 8, k = 256 * (ji >> 2) + 4 * ln + (ji & 3); const int jj = L >> 1;
            const float* src = (L & 1) ? KIN(I_CDWIN) + (size_t)jj * D * CD_IN + (size_t)k * CD_IN + (ch < 2 ? 1536 + 4 * ch : 3592 + 4 * (ch - 2)) : KIN(I_ABWIN) + (size_t)jj * D * AB_IN + (size_t)k * AB_IN + 4096 + 4 * ch;
            tab[TAB_GPW / 16 + r] = *(const f32x4*)src; }
        else if (r < 5120) { const int q = r - 4096, ji = q >> 6, k = 256 * (ji >> 2) + 4 * ln + (ji & 3); tab[TAB_RGW / 16 + q] = *(const f32x4*)(KIN(I_RGW) + (size_t)L * D * 4 + (size_t)k * 4); }
        else { const int q = r - 5120, half = (q >> 6) & 1, ji = (q >> 7) & 15, g = q >> 11, k = 256 * (ji >> 2) + 4 * ln + (ji & 3); tab[TAB_REW / 16 + q] = *(const f32x4*)(KIN(I_REW) + ((size_t)(L * 4 + g) * D + k) * 8 + 4 * half); } }
    bf16* HB = (bf16*)(kws() + WS_HB);
#pragma unroll 1
    for (int m0 = F.gw; m0 < T; m0 += 2 * F.NGW) { const int m1 = m0 + F.NGW < T ? m0 + F.NGW : -1, m1c = m1 >= 0 ? m1 : m0; f32x4 v0[4], v1[4];
        row_load(KIN(I_X) + (size_t)m0 * D, F.lane, v0); row_load(KIN(I_X) + (size_t)m1c * D, F.lane, v1);
        row_store_bf16(HB + (size_t)m0 * D, F.lane, v0); if (m1 >= 0) row_store_bf16(HB + (size_t)m1 * D, F.lane, v1);
        row_gate_proj2_direct(F, v0, v1, m0, m1); }
}
__device__ __forceinline__ void e0_conv(Frame& F0, int j) {   Frame F = F0; asm volatile("" : "+v"(F.tid), "+v"(F.lane));
    const bf16* P = (const bf16*)(kws() + WS_R1); bf16* XBC = (bf16*)(kws() + WS_R3); bf16* MIX = (bf16*)(kws() + WS_MIX);
    const float* cw = KIN(I_CONVW) + (size_t)j * 4 * 1536; const float* cb = KIN(I_CONVB) + (size_t)j * 1536; const float* ca = KIN(I_CONVA) + (size_t)j * 3 * 512;
    constexpr int TT = 16;
    for (int it = F.gw; it < (T / TT) * 16; it += F.NGW) {
        const int tt = it >> 4, cg = it & 15, t0 = tt * TT, s0 = t0 & (SEQ - 1);
        if (cg < 12) {
            const int c = cg * 128 + 2 * F.lane;
            float w0[4], w1[4];
#pragma unroll
            for (int k = 0; k < 4; ++k) { w0[k] = cw[k * 1536 + c]; w1[k] = cw[k * 1536 + c + 1]; }
            const float b0 = cb[c], b1 = cb[c + 1];
            float xa[TT + 3], xb[TT + 3];
#pragma unroll
            for (int r = 0; r < TT + 3; ++r) { unsigned w = 0u; if (s0 - 3 + r >= 0) w = *(const unsigned*)(P + (size_t)(t0 - 3 + r) * NPE + 2560 + c); xa[r] = bflo(w); xb[r] = bfhi(w); }
#pragma unroll
            for (int o = 0; o < TT; ++o) { float a0 = b0, a1 = b1;
#pragma unroll
                for (int k = 0; k < 4; ++k) { a0 += w0[k] * xa[o + k]; a1 += w1[k] * xb[o + k]; }
                *(unsigned*)(XBC + (size_t)(t0 + o) * 1536 + c) = pk2(silu_f(a0), silu_f(a1)); }
        } else {
            const int c = (cg - 12) * 128 + 2 * F.lane;
            float w0[3], w1[3];
#pragma unroll
            for (int k = 0; k < 3; ++k) { w0[k] = ca[k * 512 + c]; w1[k] = ca[k * 512 + c + 1]; }
            float ua[TT + 2], ub[TT + 2]; unsigned bgw[TT];
#pragma unroll
            for (int o = 0; o < TT; ++o) bgw[o] = *(const unsigned*)(P + (size_t)(t0 + o) * NPE + c);
#pragma unroll
            for (int r = 0; r < TT + 2; ++r) { float a = 0.f, b = 0.f;
                if (s0 - 2 + r >= 0) { const bf16* pr = P + (size_t)(t0 - 2 + r) * NPE; const unsigned cgw = *(const unsigned*)(pr + 512 + c), xw = *(const unsigned*)(pr + 1024 + c); a = bflo(cgw) * bflo(xw); b = bfhi(cgw) * bfhi(xw); }
                ua[r] = a; ub[r] = b; }
#pragma unroll
            for (int o = 0; o < TT; ++o) { float a0 = 0.f, a1 = 0.f;
#pragma unroll
                for (int k = 0; k < 3; ++k) { a0 += w0[k] * ua[o + k]; a1 += w1[k] * ub[o + k]; }
                const unsigned bg = bgw[o];
                *(unsigned*)(MIX + (size_t)(t0 + o) * 1536 + c) = pk2(bflo(bg) * a0, bfhi(bg) * a1); }
        }
    }
}
__device__ __forceinline__ void ssd_gates(Frame& F, int j, int t0, int h, LAS float* dtl, LAS float* acs) {
    if (F.wave == 0) {
        const float* SG = (const float*)(kws() + WS_SG); const float dtb = KIN(I_DTB)[j * 16 + h], aneg = -expf(KIN(I_ALOG)[j * 16 + h]);
        const float d0 = softplus_f(SG[(size_t)(t0 + 2 * F.lane) * 16 + h] + dtb), d1 = softplus_f(SG[(size_t)(t0 + 2 * F.lane + 1) * 16 + h] + dtb);
        const float a0 = d0 * aneg, a1 = d1 * aneg; const float inc = wave_scan_sum(a0 + a1, F.lane);
        dtl[2 * F.lane] = d0; dtl[2 * F.lane + 1] = d1; acs[2 * F.lane] = inc - a1; acs[2 * F.lane + 1] = inc;
    }
}
__device__ __forceinline__ void e1_states(Frame& F0, int j) {   Frame F = F0; asm volatile("" : "+v"(F.tid), "+v"(F.lane));
    const bf16* XBC = (const bf16*)(kws() + WS_R3); float* ST = (float*)(kws() + WS_R4); float* DEC = (float*)(kws() + WS_DEC);
    LAS float* xw = (LAS float*)F.lds; LAS float* Bm = (LAS float*)(F.lds + 32768); LAS float* dtl = (LAS float*)(F.lds + SMALL_OFF); LAS float* acs = dtl + 128;
    for (int u = F.vcu; u < 2048; u += F.G) {
        const int b = u >> 8, c = (u >> 4) & 15, h = u & 15, g = h >> 2, t0 = b * SEQ + c * 128;
        __syncthreads();
        ssd_gates(F, j, t0, h, dtl, acs);
        __syncthreads();
        for (int i = F.tid; i < 128 * 32; i += 512) { const int l = i >> 5, pp = (i & 31) * 2; const float wgt = expf(acs[127] - acs[l]) * dtl[l];
            const unsigned xv = *(const unsigned*)(XBC + (size_t)(t0 + l) * 1536 + h * 64 + pp), bv = *(const unsigned*)(XBC + (size_t)(t0 + l) * 1536 + 1024 + g * 64 + pp);
            xw[l * 64 + pp] = bflo(xv) * wgt; xw[l * 64 + pp + 1] = bfhi(xv) * wgt; Bm[l * 64 + pp] = bflo(bv); Bm[l * 64 + pp + 1] = bfhi(bv); }
        __syncthreads();
        const int n = F.lane, p0 = 8 * F.wave; float acc[8];
#pragma unroll
        for (int i = 0; i < 8; ++i) acc[i] = 0.f;
#pragma unroll 2
        for (int l = 0; l < 128; ++l) { const float bm = Bm[l * 64 + n]; const f32x4 x0 = *(const LAS f32x4*)(xw + l * 64 + p0), x1 = *(const LAS f32x4*)(xw + l * 64 + p0 + 4);
#pragma unroll
            for (int i = 0; i < 4; ++i) { acc[i] += x0[i] * bm; acc[4 + i] += x1[i] * bm; } }
        float* dst = ST + (size_t)u * 4096;
#pragma unroll
        for (int i = 0; i < 8; ++i) dst[(p0 + i) * 64 + n] = acc[i];
        if (F.tid == 0) DEC[u] = expf(acs[127]);
    }
}
__device__ __forceinline__ void e2_scan(Frame& F0) {   Frame F = F0; asm volatile("" : "+v"(F.tid), "+v"(F.lane));
    float* ST = (float*)(kws() + WS_R4); const float* DEC = (const float*)(kws() + WS_DEC);
    for (int e = F.vcu * 512 + F.tid; e < NBATCH * 16 * 4096; e += F.G * 512) {
        const int b = e >> 16, h = (e >> 12) & 15, pn = e & 4095; float run = 0.f; float s[16], dc[16];
#pragma unroll
        for (int c = 0; c < 16; ++c) { const int u = (b * 16 + c) * 16 + h; s[c] = ST[(size_t)u * 4096 + pn]; dc[c] = DEC[u]; }
#pragma unroll
        for (int c = 0; c < 16; ++c) { const int u = (b * 16 + c) * 16 + h; ST[(size_t)u * 4096 + pn] = run; run = run * dc[c] + s[c]; }
    }
}
__device__ __forceinline__ void e3_output(Frame& F0, int j) {   Frame F = F0; asm volatile("" : "+v"(F.tid), "+v"(F.lane));
    const bf16* XBC = (const bf16*)(kws() + WS_R3); const float* ST = (const float*)(kws() + WS_R4); float* Y = (float*)(kws() + WS_R2);
    LAS float* R0 = (LAS float*)F.lds;
    LAS float* R1 = (LAS float*)(F.lds + 32768);
    LAS float* R2 = (LAS float*)(F.lds + 65536);
    LAS float* dtl = (LAS float*)(F.lds + SMALL_OFF); LAS float* acs = dtl + 128;
    for (int u = F.vcu; u < 2048; u += F.G) {
        const int b = u >> 8, c = (u >> 4) & 15, h = u & 15, g = h >> 2, t0 = b * SEQ + c * 128;
        __syncthreads();
        ssd_gates(F, j, t0, h, dtl, acs);
        for (int i = F.tid; i < 128 * 32; i += 512) { const int l = i >> 5, nn = (i & 31) * 2;
            const unsigned bv = *(const unsigned*)(XBC + (size_t)(t0 + l) * 1536 + 1024 + g * 64 + nn), cv = *(const unsigned*)(XBC + (size_t)(t0 + l) * 1536 + 1280 + g * 64 + nn);
            R0[l * 64 + nn] = bflo(cv); R0[l * 64 + nn + 1] = bfhi(cv); R1[nn * 128 + l] = bflo(bv); R1[(nn + 1) * 128 + l] = bfhi(bv); }
        { const float* hp = ST + (size_t)u * 4096; for (int i = F.tid; i < 4096; i += 512) { const int p = i >> 6, n = i & 63; R2[n * 64 + p] = hp[i]; } }
        __syncthreads();
        const int p = F.lane, l0 = 16 * F.wave; float acc[16];
#pragma unroll
        for (int i = 0; i < 16; ++i) acc[i] = 0.f;
#pragma unroll 1
        for (int n0 = 0; n0 < 64; n0 += 4) { float hp[4];
#pragma unroll
            for (int i = 0; i < 4; ++i) hp[i] = R2[(n0 + i) * 64 + p];
#pragma unroll
            for (int li = 0; li < 16; ++li) { const f32x4 c4 = *(const LAS f32x4*)(R0 + (l0 + li) * 64 + n0); acc[li] += (c4[0] * hp[0] + c4[1] * hp[1]) + (c4[2] * hp[2] + c4[3] * hp[3]); } }
#pragma unroll
        for (int li = 0; li < 16; ++li) acc[li] *= expf(acs[l0 + li]);
        __syncthreads();
#pragma unroll 1
        for (int half = 0; half < 2; ++half) { const int s = F.tid & 127, lg = 32 * (F.tid >> 7) + 16 * half; float gacc[16];
#pragma unroll
            for (int i = 0; i < 16; ++i) gacc[i] = 0.f;
#pragma unroll 1
            for (int n0 = 0; n0 < 64; n0 += 4) { float bb[4];
#pragma unroll
                for (int i = 0; i < 4; ++i) bb[i] = R1[(n0 + i) * 128 + s];
#pragma unroll
                for (int li = 0; li < 16; ++li) { const f32x4 c4 = *(const LAS f32x4*)(R0 + (lg + li) * 64 + n0); gacc[li] += (c4[0] * bb[0] + c4[1] * bb[1]) + (c4[2] * bb[2] + c4[3] * bb[3]); } }
            const float as = acs[s];
#pragma unroll
            for (int li = 0; li < 16; ++li) { const int l = lg + li; R2[l * 128 + s] = (s <= l) ? gacc[li] * expf(acs[l] - as) : 0.f; } }
        __syncthreads();
        for (int i = F.tid; i < 128 * 32; i += 512) { const int l = i >> 5, pp = (i & 31) * 2; const unsigned xv = *(const unsigned*)(XBC + (size_t)(t0 + l) * 1536 + h * 64 + pp);
            R0[l * 64 + pp] = bflo(xv); R0[l * 64 + pp + 1] = bfhi(xv); }
        __syncthreads();
#pragma unroll 1
        for (int s0 = 0; s0 < l0 + 16; s0 += 4) { float xv[4];
#pragma unroll
            for (int i = 0; i < 4; ++i) xv[i] = R0[(s0 + i) * 64 + p] * dtl[s0 + i];
#pragma unroll
            for (int li = 0; li < 16; ++li) { const f32x4 g4 = *(const LAS f32x4*)(R2 + (l0 + li) * 128 + s0); acc[li] += (g4[0] * xv[0] + g4[1] * xv[1]) + (g4[2] * xv[2] + g4[3] * xv[3]); } }
        const float dsk = KIN(I_DSKIP)[j * 16 + h];
#pragma unroll
        for (int li = 0; li < 16; ++li) Y[(size_t)(t0 + l0 + li) * D + h * 64 + p] = acc[li] + dsk * R0[(l0 + li) * 64 + p];
    }
}
__device__ __forceinline__ void e4_gnorm(Frame& F0) {   Frame F = F0; asm volatile("" : "+v"(F.tid), "+v"(F.lane));
    const float* Y = (const float*)(kws() + WS_R2); const bf16* P = (const bf16*)(kws() + WS_R1); bf16* MIX = (bf16*)(kws() + WS_MIX);
#pragma unroll 1
    for (int m0 = F.gw; m0 < T; m0 += 2 * F.NGW) { const int m1 = m0 + F.NGW < T ? m0 + F.NGW : m0; const int mm[2] = {m0, m1}; f32x4 y[2][4], z[2][4]; float rstd[2];
#pragma unroll
        for (int rr = 0; rr < 2; ++rr) { row_load(Y + (size_t)mm[rr] * D, F.lane, y[rr]); row_load_bf16(P + (size_t)mm[rr] * NPE + 1536, F.lane, z[rr]); }
#pragma unroll
        for (int rr = 0; rr < 2; ++rr) { float ss = 0.f;
#pragma unroll
            for (int jj = 0; jj < 4; ++jj)
#pragma unroll
                for (int i = 0; i < 4; ++i) { const float uu = y[rr][jj][i] * silu_f(z[rr][jj][i]); y[rr][jj][i] = uu; ss += uu * uu; }
            rstd[rr] = 1.0f / sqrtf(wave_sum(ss) * (1.f / D) + LN_EPS); }
#pragma unroll
        for (int rr = 0; rr < 2; ++rr) {
#pragma unroll
            for (int jj = 0; jj < 4; ++jj) y[rr][jj] = y[rr][jj] * rstd[rr];
            if (rr == 0 || m1 != m0) row_store_bf16(MIX + (size_t)mm[rr] * 1536 + 512, F.lane, y[rr]); } }
}
__device__ __forceinline__ void o_foxscan(Frame& F0, int j) {   Frame F = F0; asm volatile("" : "+v"(F.tid), "+v"(F.lane));
    const float* SG = (const float*)(kws() + WS_SG); float* FOXC = (float*)(kws() + WS_FOXC);
    for (int bh = F.gw; bh < 64; bh += F.NGW) { const int b = bh >> 3, h = bh & 7; const float bias = KIN(I_FOXB)[j * 8 + h];
        float v[32], run = 0.f;
#pragma unroll
        for (int i = 0; i < 32; ++i) { run += logsigmoid_f(SG[(size_t)(b * SEQ + 32 * F.lane + i) * 16 + 8 + h] + bias); v[i] = run; }
        const float off = wave_scan_sum(run, F.lane) - run;
#pragma unroll
        for (int i = 0; i < 32; ++i) FOXC[(size_t)bh * SEQ + 32 * F.lane + i] = (v[i] + off) * LOG2E; }
}
__device__ __forceinline__ void mlstm_gates(Frame& F, int j, int t0, int h, float& bcum, float& ib) {
    const float* SG = (const float*)(kws() + WS_SG);
    ib = SG[(size_t)(t0 + F.lane) * 16 + h] + KIN(I_IB)[j * 4 + h];
    bcum = wave_scan_sum(logsigmoid_f(SG[(size_t)(t0 + F.lane) * 16 + 4 + h] + KIN(I_FB)[j * 4 + h]), F.lane);
}
__device__ __forceinline__ void o1_local(Frame& F0, int j) {   Frame F = F0; asm volatile("" : "+v"(F.tid), "+v"(F.lane));
    const bf16* P = (const bf16*)(kws() + WS_R1); float* KLOC = (float*)(kws() + WS_R2); float* NLOC = (float*)(kws() + WS_NLOC); float* MLOC = (float*)(kws() + WS_MLOC); float* BLAST = (float*)(kws() + WS_BLAST);
    LAS float* kw = (LAS float*)F.lds; LAS float* Vs = (LAS float*)(F.lds + 32768); LAS float* wk = (LAS float*)(F.lds + SMALL_OFF);
    for (int u = F.vcu; u < 1024; u += F.G) {
        const int b = u >> 7, h = (u >> 5) & 3, c = u & 31, t0 = b * SEQ + c * 64;
        __syncthreads();
        if (F.wave == 0) { float bcum, ib; mlstm_gates(F, j, t0, h, bcum, ib); const float blast = __shfl(bcum, 63); const float gl = blast - bcum + ib; const float ml = wave_max(gl);
            wk[F.lane] = expf(gl - ml); if (F.lane == 0) { MLOC[u] = ml; BLAST[u] = blast; } }
        __syncthreads();
        for (int i = F.tid; i < 64 * 64; i += 512) { const int s = i >> 6, dd = (i & 63) * 2; const float w = wk[s];
            const unsigned kv = *(const unsigned*)(P + (size_t)(t0 + s) * NPO + 512 + h * 128 + dd), vv = *(const unsigned*)(P + (size_t)(t0 + s) * NPO + 1024 + h * 128 + dd);
            kw[s * 128 + dd] = bflo(kv) * w; kw[s * 128 + dd + 1] = bfhi(kv) * w; Vs[s * 128 + dd] = bflo(vv); Vs[s * 128 + dd + 1] = bfhi(vv); }
        __syncthreads();
        const int v = F.tid & 127, d0 = 32 * (F.tid >> 7); float acc[32];
#pragma unroll
        for (int i = 0; i < 32; ++i) acc[i] = 0.f;
#pragma unroll 1
        for (int s = 0; s < 64; ++s) { const float vv = Vs[s * 128 + v];
#pragma unroll
            for (int di = 0; di < 32; di += 4) { const f32x4 k4 = *(const LAS f32x4*)(kw + s * 128 + d0 + di);
#pragma unroll
                for (int i = 0; i < 4; ++i) acc[di + i] += k4[i] * vv; } }
        float* dst = KLOC + (size_t)u * 16384;
#pragma unroll
        for (int i = 0; i < 32; ++i) dst[(d0 + i) * 128 + v] = acc[i];
        if (F.tid < 128) { float a = 0.f; for (int s = 0; s < 64; ++s) a += kw[s * 128 + F.tid]; NLOC[(size_t)u * 128 + F.tid] = a; }
    }
}
__device__ __forceinline__ void o2_scan(Frame& F0) {   Frame F = F0; asm volatile("" : "+v"(F.tid), "+v"(F.lane));
    float* KLOC = (float*)(kws() + WS_R2); float* NLOC = (float*)(kws() + WS_NLOC); const float* MLOC = (const float*)(kws() + WS_MLOC); const float* BLAST = (const float*)(kws() + WS_BLAST); float* MPREV = (float*)(kws() + WS_MPREV);
    constexpr int PER = 16384 + 128;
    for (int e = F.vcu * 512 + F.tid; e < 32 * PER; e += F.G * 512) {
        const int bh = e / PER, r = e % PER; float run = 0.f, m = 0.f;
#pragma unroll 1
        for (int c0 = 0; c0 < 32; c0 += 16) { float loc[16], bl[16], ml[16];
#pragma unroll
            for (int i = 0; i < 16; ++i) { const int u = bh * 32 + c0 + i; const float* p = r < 16384 ? KLOC + (size_t)u * 16384 + r : NLOC + (size_t)u * 128 + (r - 16384); loc[i] = *p; bl[i] = BLAST[u]; ml[i] = MLOC[u]; }
#pragma unroll
            for (int i = 0; i < 16; ++i) { const int u = bh * 32 + c0 + i; float* p = r < 16384 ? KLOC + (size_t)u * 16384 + r : NLOC + (size_t)u * 128 + (r - 16384);
                *p = run; if (r == 0) MPREV[u] = m;
                const float mn = fmaxf(bl[i] + m, ml[i]);
                run = expf(bl[i] + m - mn) * run + expf(ml[i] - mn) * loc[i]; m = mn; } }
    }
}
__device__ __forceinline__ void o3_output(Frame& F0, int j) {   Frame F = F0; asm volatile("" : "+v"(F.tid), "+v"(F.lane));
    const bf16* P = (const bf16*)(kws() + WS_R1); const float* CPREV = (const float*)(kws() + WS_R2); const float* NPREV = (const float*)(kws() + WS_NLOC); const float* MPREV = (const float*)(kws() + WS_MPREV); bf16* MIX = (bf16*)(kws() + WS_MIX);
    LAS float* qT = (LAS float*)F.lds;
    LAS float* kT = (LAS float*)(F.lds + 32768);
    LAS float* Vs = (LAS float*)(F.lds + 65536);
    LAS float* WT = (LAS float*)(F.lds + 98304);
    LAS float* sm = (LAS float*)(F.lds + SMALL_OFF);
    for (int u = F.vcu; u < 1024; u += F.G) {
        const int b = u >> 7, h = (u >> 5) & 3, c = u & 31, t0 = b * SEQ + c * 64;
        __syncthreads();
        if (F.wave == 0) { float bcum, ib; mlstm_gates(F, j, t0, h, bcum, ib); const float mprev = MPREV[u];
            const float pm = wave_scan_max(ib - bcum, F.lane); const float inter = bcum + mprev; const float mt = fmaxf(bcum + pm, inter);
            sm[F.lane] = bcum; sm[64 + F.lane] = ib; sm[128 + F.lane] = mt; sm[192 + F.lane] = expf(inter - mt); }
        for (int i = F.tid; i < 64 * 64; i += 512) { const int s = i >> 6, dd = (i & 63) * 2; const bf16* pr = P + (size_t)(t0 + s) * NPO + h * 128 + dd;
            const unsigned qv = *(const unsigned*)pr, kv = *(const unsigned*)(pr + 512), vv = *(const unsigned*)(pr + 1024);
            qT[dd * 64 + s] = bflo(qv); qT[(dd + 1) * 64 + s] = bfhi(qv); kT[dd * 64 + s] = bflo(kv); kT[(dd + 1) * 64 + s] = bfhi(kv); Vs[s * 128 + dd] = bflo(vv); Vs[s * 128 + dd + 1] = bfhi(vv); }
        __syncthreads();
        { const int s = F.lane, l0 = 8 * F.wave; float acc[8];
#pragma unroll
            for (int i = 0; i < 8; ++i) acc[i] = 0.f;
#pragma unroll 2
            for (int d = 0; d < 128; ++d) { const float kk = kT[d * 64 + s]; const f32x4 q0 = *(const LAS f32x4*)(qT + d * 64 + l0), q1 = *(const LAS f32x4*)(qT + d * 64 + l0 + 4);
#pragma unroll
                for (int i = 0; i < 4; ++i) { acc[i] += q0[i] * kk; acc[4 + i] += q1[i] * kk; } }
            const float gs = sm[64 + s] - sm[s];
#pragma unroll
            for (int i = 0; i < 8; ++i) { const int l = l0 + i; const float w = (s <= l) ? acc[i] * expf(sm[l] + gs - sm[128 + l]) : 0.f; WT[s * 64 + l] = w; const float dsum = wave_sum(w); if (F.lane == 0) sm[256 + l] = dsum; } }
        __syncthreads();
        if (F.tid < 64) { const int l = F.tid; float qn = 0.f; const float* np = NPREV + (size_t)u * 128; for (int d = 0; d < 128; ++d) qn += qT[d * 64 + l] * np[d]; sm[256 + l] += sm[192 + l] * qn; }
        const int v = F.tid & 127, l0 = 16 * (F.tid >> 7); float acc[16];
#pragma unroll
        for (int i = 0; i < 16; ++i) acc[i] = 0.f;
        { const float* cp = CPREV + (size_t)u * 16384;
#pragma unroll 2
            for (int d = 0; d < 128; ++d) { const float cc = cp[d * 128 + v];
#pragma unroll
                for (int li = 0; li < 16; li += 4) { const f32x4 q4 = *(const LAS f32x4*)(qT + d * 64 + l0 + li);
#pragma unroll
                    for (int i = 0; i < 4; ++i) acc[li + i] += q4[i] * cc; } } }
#pragma unroll
        for (int i = 0; i < 16; ++i) acc[i] *= sm[192 + l0 + i];
#pragma unroll 2
        for (int s = 0; s < 64; ++s) { const float vv = Vs[s * 128 + v];
#pragma unroll
            for (int li = 0; li < 16; li += 4) { const f32x4 w4 = *(const LAS f32x4*)(WT + s * 64 + l0 + li);
#pragma unroll
                for (int i = 0; i < 4; ++i) acc[li + i] += w4[i] * vv; } }
        __syncthreads();
        LAS float* hb = kT;
#pragma unroll
        for (int i = 0; i < 16; ++i) { const int l = l0 + i; const float hv = acc[i] / fmaxf(fabsf(sm[256 + l]), expf(-sm[128 + l])); acc[i] = hv; hb[l * 128 + v] = hv; }
        __syncthreads();
        { const int lb = 8 * F.wave;
#pragma unroll
            for (int i = 0; i < 8; ++i) { const int l = lb + i; const float a = hb[l * 128 + F.lane], bq = hb[l * 128 + 64 + F.lane]; const float mu = wave_sum(a + bq) * (1.f / 128.f);
                const float da = a - mu, db = bq - mu; const float var = wave_sum(da * da + db * db) * (1.f / 128.f); if (F.lane == 0) { sm[320 + l] = mu; sm[384 + l] = 1.0f / sqrtf(var + LN_EPS); } } }
        __syncthreads();
        const float hw = KIN(I_HNW)[j * 512 + h * 128 + v];
#pragma unroll
        for (int i = 0; i < 16; ++i) { const int l = l0 + i; const float og = sigmoid_f(bf2f(P[(size_t)(t0 + l) * NPO + 1536 + h * 128 + v]));
            MIX[(size_t)(t0 + l) * D + h * 128 + v] = (bf16)f2bf(og * (acc[i] - sm[320 + l]) * sm[384 + l] * hw); }
    }
}
__device__ __forceinline__ void o4_fox(Frame& F0) {   Frame F = F0; asm volatile("" : "+v"(F.tid), "+v"(F.lane));
    const bf16* P = (const bf16*)(kws() + WS_R1); const float* FOXC = (const float*)(kws() + WS_FOXC); bf16* MIX = (bf16*)(kws() + WS_MIX);
    LAS float* QT = (LAS float*)F.lds;
    LAS float* KT = (LAS float*)(F.lds + 16384);
    LAS float* Vs = (LAS float*)(F.lds + 32768);
    LAS float* PT = (LAS float*)(F.lds + 49152) + F.wave * 512;
    LAS float* cq = (LAS float*)(F.lds + SMALL_OFF); LAS float* ck = cq + 64;
    for (int it = F.vcu; it < 2048; it += F.G) {
        const int qt = 31 - (it >> 6), bh = it & 63, b = bh >> 3, h = bh & 7, tq0 = b * SEQ + qt * 64;
        __syncthreads();
        for (int i = F.tid; i < 64 * 32; i += 512) { const int q = i >> 5, dd = (i & 31) * 2; const unsigned w = *(const unsigned*)(P + (size_t)(tq0 + q) * NPO + 2048 + h * 64 + dd); QT[dd * 64 + q] = bflo(w); QT[(dd + 1) * 64 + q] = bfhi(w); }
        if (F.tid < 64) cq[F.tid] = FOXC[(size_t)bh * SEQ + qt * 64 + F.tid];
        const int q0 = 8 * F.wave; float mrun[8], lrun[8], o[8];
#pragma unroll
        for (int i = 0; i < 8; ++i) { mrun[i] = -INFINITY; lrun[i] = 0.f; o[i] = 0.f; }
#pragma unroll 1
        for (int kt = 0; kt <= qt; ++kt) { const int tk0 = b * SEQ + kt * 64;
            __syncthreads();
            for (int i = F.tid; i < 64 * 32; i += 512) { const int k = i >> 5, dd = (i & 31) * 2; const bf16* pr = P + (size_t)(tk0 + k) * NPO + h * 64 + dd; const unsigned kw = *(const unsigned*)(pr + 2560), vw = *(const unsigned*)(pr + 3072);
                KT[dd * 64 + k] = bflo(kw); KT[(dd + 1) * 64 + k] = bfhi(kw); Vs[k * 64 + dd] = bflo(vw); Vs[k * 64 + dd + 1] = bfhi(vw); }
            if (F.tid < 64) ck[F.tid] = FOXC[(size_t)bh * SEQ + kt * 64 + F.tid];
            __syncthreads();
            float s[8];
#pragma unroll
            for (int i = 0; i < 8; ++i) s[i] = 0.f;
#pragma unroll 2
            for (int d = 0; d < 64; ++d) { const float kk = KT[d * 64 + F.lane]; const f32x4 qa = *(const LAS f32x4*)(QT + d * 64 + q0), qb = *(const LAS f32x4*)(QT + d * 64 + q0 + 4);
#pragma unroll
                for (int i = 0; i < 4; ++i) { s[i] += qa[i] * kk; s[4 + i] += qb[i] * kk; } }
            const float ckv = ck[F.lane];
#pragma unroll
            for (int i = 0; i < 8; ++i) { float sv = s[i] + cq[q0 + i] - ckv; if (kt == qt && F.lane > q0 + i) sv = -INFINITY;
                const float mn = fmaxf(mrun[i], wave_max(sv)); const float p = exp2f(sv - mn), al = exp2f(mrun[i] - mn);
                lrun[i] = lrun[i] * al + wave_sum(p); o[i] *= al; mrun[i] = mn; PT[F.lane * 8 + i] = p; }
            LDS_WAIT(); asm volatile("" ::: "memory");
#pragma unroll 2
            for (int k = 0; k < 64; ++k) { const float vv = Vs[k * 64 + F.lane]; const f32x4 pa = *(const LAS f32x4*)(PT + k * 8), pb = *(const LAS f32x4*)(PT + k * 8 + 4);
#pragma unroll
                for (int i = 0; i < 4; ++i) { o[i] += pa[i] * vv; o[4 + i] += pb[i] * vv; } }
        }
#pragma unroll
        for (int i = 0; i < 8; ++i) MIX[(size_t)(tq0 + q0 + i) * D + 512 + h * 64 + F.lane] = (bf16)f2bf(o[i] / lrun[i]);
    }
}
typedef short bf16x8 __attribute__((ext_vector_type(8)));
typedef float f32x16 __attribute__((ext_vector_type(16)));
typedef __bf16 bf16x2_t __attribute__((ext_vector_type(2)));
#define MFMA32(a, b, c) __builtin_amdgcn_mfma_f32_32x32x16_bf16((a), (b), (c), 0, 0, 0)
__device__ __forceinline__ int crow(int r, int h) { return (r & 3) + 8 * (r >> 2) + 4 * h; }
__device__ __forceinline__ unsigned cvtpk(float lo, float hi) { const f32x2 v = {lo, hi}; const bf16x2_t b = __builtin_convertvector(v, bf16x2_t); return __builtin_bit_cast(unsigned, b); }
__device__ __forceinline__ bf16x8 pack8(float a0, float a1, float a2, float a3, float a4, float a5, float a6, float a7) {
    v4u p; p.x = cvtpk(a0, a1); p.y = cvtpk(a2, a3); p.z = cvtpk(a4, a5); p.w = cvtpk(a6, a7); return __builtin_bit_cast(bf16x8, p); }
__device__ __forceinline__ bf16x8 pack_step(const f32x16& x, int s) { return pack8(x[8 * s], x[8 * s + 1], x[8 * s + 2], x[8 * s + 3], x[8 * s + 4], x[8 * s + 5], x[8 * s + 6], x[8 * s + 7]); }
__device__ __forceinline__ bf16x8 ldg8_f32(const float* p) { const f32x4 a = *(const f32x4*)p, b = *(const f32x4*)(p + 4); return pack8(a[0], a[1], a[2], a[3], b[0], b[1], b[2], b[3]); }
__device__ __forceinline__ bf16x8 lds_nat(const LAS bf16* row, int ks, int h) { return *(const LAS bf16x8*)(row + 16 * ks + 8 * h); }
__device__ __forceinline__ bf16x8 lds_krow(const LAS bf16* row, int k0, int h) { const v2u lo = *(const LAS v2u*)(row + k0 + 4 * h), hi = *(const LAS v2u*)(row + k0 + 8 + 4 * h);
    v4u p; p.x = lo.x; p.y = lo.y; p.z = hi.x; p.w = hi.y; return __builtin_bit_cast(bf16x8, p); }
__device__ __forceinline__ f32x16 zero16() { f32x16 z;
#pragma unroll
    for (int i = 0; i < 16; ++i) z[i] = 0.f;
    return z; }

__device__ __forceinline__ void ssd_gates4(Frame& F, int j, int t0, int g, LAS float* DT, LAS float* ACS) {
    if (F.wave < 4) { const int h = 4 * g + F.wave; const float* SG = (const float*)(kws() + WS_SG); const float dtb = KIN(I_DTB)[j * 16 + h], aneg = -expf(KIN(I_ALOG)[j * 16 + h]);
        const float d0 = softplus_f(SG[(size_t)(t0 + 2 * F.lane) * 16 + h] + dtb), d1 = softplus_f(SG[(size_t)(t0 + 2 * F.lane + 1) * 16 + h] + dtb);
        const float a0 = d0 * aneg, a1 = d1 * aneg; const float inc = wave_scan_sum(a0 + a1, F.lane);
        DT[F.wave * 128 + 2 * F.lane] = d0; DT[F.wave * 128 + 2 * F.lane + 1] = d1; ACS[F.wave * 128 + 2 * F.lane] = inc - a1; ACS[F.wave * 128 + 2 * F.lane + 1] = inc; }
}
__device__ __forceinline__ void ssd_stage_xt(Frame& F, const bf16* XBC, int t0, int g, LAS bf16* XT, const LAS float* WGT) {
    for (int i = F.tid; i < 2048; i += 512) { const int cp = i & 127, s0 = 8 * (i >> 7), hl = cp >> 5; float a[8], bq[8];
#pragma unroll
        for (int k = 0; k < 8; ++k) { const unsigned w = *(const unsigned*)(XBC + (size_t)(t0 + s0 + k) * 1536 + g * 256 + 2 * cp); const float wg = WGT[hl * 128 + s0 + k]; a[k] = bflo(w) * wg; bq[k] = bfhi(w) * wg; }
        *(LAS bf16x8*)(XT + (2 * cp) * 136 + s0) = pack8(a[0], a[1], a[2], a[3], a[4], a[5], a[6], a[7]);
        *(LAS bf16x8*)(XT + (2 * cp + 1) * 136 + s0) = pack8(bq[0], bq[1], bq[2], bq[3], bq[4], bq[5], bq[6], bq[7]); }
}
__device__ __forceinline__ void e1_states_mfma(Frame& F0, int j) {   Frame F = F0; asm volatile("" : "+v"(F.tid), "+v"(F.lane));
    const bf16* XBC = (const bf16*)(kws() + WS_R3); float* ST = (float*)(kws() + WS_R4); float* DEC = (float*)(kws() + WS_DEC);
    LAS bf16* XT = (LAS bf16*)F.lds; LAS bf16* BT = (LAS bf16*)(F.lds + 69632);
    LAS float* DT = (LAS float*)(F.lds + 98304); LAS float* ACS = DT + 512; LAS float* WGT = DT + 1024;
    for (int u = F.vcu; u < 512; u += F.G) {
        const int b = u >> 6, c = (u >> 2) & 15, g = u & 3, t0 = b * SEQ + c * 128;
        __syncthreads();
        ssd_gates4(F, j, t0, g, DT, ACS);
        { const int np = F.tid & 31, l0 = 8 * (F.tid >> 5); float a[8], bq[8];
#pragma unroll
            for (int k = 0; k < 8; ++k) { const unsigned w = *(const unsigned*)(XBC + (size_t)(t0 + l0 + k) * 1536 + 1024 + g * 64 + 2 * np); a[k] = bflo(w); bq[k] = bfhi(w); }
            *(LAS bf16x8*)(BT + (2 * np) * 136 + l0) = pack8(a[0], a[1], a[2], a[3], a[4], a[5], a[6], a[7]);
            *(LAS bf16x8*)(BT + (2 * np + 1) * 136 + l0) = pack8(bq[0], bq[1], bq[2], bq[3], bq[4], bq[5], bq[6], bq[7]); }
        __syncthreads();
        { const int hl = F.tid >> 7, l = F.tid & 127; WGT[F.tid] = expf(ACS[hl * 128 + 127] - ACS[F.tid]) * DT[F.tid]; if (l == 127) DEC[(b * 16 + c) * 16 + 4 * g + hl] = expf(ACS[F.tid]); }
        __syncthreads();
        ssd_stage_xt(F, XBC, t0, g, XT, WGT);
        __syncthreads();
        const int hl = F.wave >> 1, nt = F.wave & 1, li = F.lane & 31, hh = F.lane >> 5;
        f32x16 acc0 = zero16(), acc1 = zero16();
        const LAS bf16* ar0 = XT + (hl * 64 + li) * 136; const LAS bf16* ar1 = ar0 + 32 * 136; const LAS bf16* br = BT + (32 * nt + li) * 136;
#pragma unroll
        for (int ks = 0; ks < 8; ++ks) { const bf16x8 bf = lds_nat(br, ks, hh); acc0 = MFMA32(lds_nat(ar0, ks, hh), bf, acc0); acc1 = MFMA32(lds_nat(ar1, ks, hh), bf, acc1); }
        float* dst = ST + (size_t)((b * 16 + c) * 16 + 4 * g + hl) * 4096 + 32 * nt + li;
#pragma unroll
        for (int r = 0; r < 16; ++r) { dst[crow(r, hh) * 64] = acc0[r]; dst[(32 + crow(r, hh)) * 64] = acc1[r]; }
    }
}
__device__ __forceinline__ void e3_output_mfma(Frame& F0, int j) {   Frame F = F0; asm volatile("" : "+v"(F.tid), "+v"(F.lane));
    const bf16* XBC = (const bf16*)(kws() + WS_R3); const float* ST = (const float*)(kws() + WS_R4); float* Y = (float*)(kws() + WS_R2);
    LAS bf16* CR = (LAS bf16*)F.lds; LAS bf16* BR = (LAS bf16*)(F.lds + 18432); LAS bf16* XT = (LAS bf16*)(F.lds + 36864);
    LAS float* DT = (LAS float*)(F.lds + 106496); LAS float* ACS = DT + 512;
    for (int u = F.vcu; u < 512; u += F.G) {
        const int b = u >> 6, c = (u >> 2) & 15, g = u & 3, t0 = b * SEQ + c * 128;
        __syncthreads();
        ssd_gates4(F, j, t0, g, DT, ACS);
        for (int i = F.tid; i < 1024; i += 512) { const int l = i >> 3, ch = i & 7; const bf16* src = XBC + (size_t)(t0 + l) * 1536 + 1024 + g * 64 + 8 * ch;
            *(LAS v4u*)(BR + l * 72 + 8 * ch) = *(const v4u*)src; *(LAS v4u*)(CR + l * 72 + 8 * ch) = *(const v4u*)(src + 256); }
        __syncthreads();
        ssd_stage_xt(F, XBC, t0, g, XT, DT);
        __syncthreads();
        const int hl = F.wave >> 1, half = F.wave & 1, li = F.lane & 31, hh = F.lane >> 5, habs = 4 * g + hl;
        const LAS float* acs = ACS + hl * 128; const LAS float* dtl = DT + hl * 128;
        bf16x8 hp[2][4];
        { const float* hsrc = ST + (size_t)((b * 16 + c) * 16 + habs) * 4096;
#pragma unroll
            for (int pt = 0; pt < 2; ++pt)
#pragma unroll
                for (int ks = 0; ks < 4; ++ks) hp[pt][ks] = ldg8_f32(hsrc + (32 * pt + li) * 64 + 16 * ks + 8 * hh); }
        const float dsk = KIN(I_DSKIP)[j * 16 + habs];
#pragma unroll
        for (int q = 0; q < 2; ++q) { const int lt = half ? 1 + q : 3 * q;
            f32x16 acc[2]; acc[0] = zero16(); acc[1] = zero16();
            const LAS bf16* crl = CR + (32 * lt + li) * 72;
#pragma unroll
            for (int ks = 0; ks < 4; ++ks) { const bf16x8 cf = lds_nat(crl, ks, hh); acc[0] = MFMA32(cf, hp[0][ks], acc[0]); acc[1] = MFMA32(cf, hp[1][ks], acc[1]); }
#pragma unroll
            for (int a4 = 0; a4 < 4; ++a4) { const f32x4 av = *(const LAS f32x4*)(acs + 32 * lt + 8 * a4 + 4 * hh);
#pragma unroll
                for (int i = 0; i < 4; ++i) { const float e = expf(av[i]); acc[0][4 * a4 + i] *= e; acc[1][4 * a4 + i] *= e; } }
            const float acl = acs[32 * lt + li];
            for (int st = 0; st <= lt; ++st) {
                f32x16 gt = zero16(); const LAS bf16* brs = BR + (32 * st + li) * 72;
#pragma unroll
                for (int ks = 0; ks < 4; ++ks) gt = MFMA32(lds_nat(brs, ks, hh), lds_nat(crl, ks, hh), gt);
#pragma unroll
                for (int a4 = 0; a4 < 4; ++a4) { const f32x4 av = *(const LAS f32x4*)(acs + 32 * st + 8 * a4 + 4 * hh);
#pragma unroll
                    for (int i = 0; i < 4; ++i) { const int r = 4 * a4 + i; const float e = expf(acl - av[i]); gt[r] = (st < lt || crow(r, hh) <= li) ? gt[r] * e : 0.f; } }
                const bf16x8 g0 = pack_step(gt, 0), g1 = pack_step(gt, 1);
#pragma unroll
                for (int pt = 0; pt < 2; ++pt) { const LAS bf16* xr = XT + (hl * 64 + 32 * pt + li) * 136 + 32 * st;
                    acc[pt] = MFMA32(g0, lds_krow(xr, 0, hh), acc[pt]); acc[pt] = MFMA32(g1, lds_krow(xr, 16, hh), acc[pt]); } }
#pragma unroll
            for (int pt = 0; pt < 2; ++pt) { const LAS bf16* xr = XT + (hl * 64 + 32 * pt + li) * 136 + 32 * lt; float* yp = Y + (size_t)(t0 + 32 * lt) * D + habs * 64 + 32 * pt + li;
#pragma unroll
                for (int r = 0; r < 16; ++r) { const int l = crow(r, hh); yp[(size_t)l * D] = acc[pt][r] + dsk * bf2f(xr[l]) / dtl[32 * lt + l]; } }
        }
    }
}
__device__ __forceinline__ void mlstm_stage_t(Frame& F, const bf16* P, int t0, int col0, LAS bf16* DST, const LAS float* wk) {
    const int vp = F.tid & 63, s0 = 8 * (F.tid >> 6); float a[8], bq[8];
#pragma unroll
    for (int k = 0; k < 8; ++k) { const unsigned w = *(const unsigned*)(P + (size_t)(t0 + s0 + k) * NPO + col0 + 2 * vp); const float wg = wk ? wk[s0 + k] : 1.f; a[k] = bflo(w) * wg; bq[k] = bfhi(w) * wg; }
    *(LAS bf16x8*)(DST + (2 * vp) * 72 + s0) = pack8(a[0], a[1], a[2], a[3], a[4], a[5], a[6], a[7]);
    *(LAS bf16x8*)(DST + (2 * vp + 1) * 72 + s0) = pack8(bq[0], bq[1], bq[2], bq[3], bq[4], bq[5], bq[6], bq[7]);
}
__device__ __forceinline__ void o1_local_mfma(Frame& F0, int j) {   Frame F = F0; asm volatile("" : "+v"(F.tid), "+v"(F.lane));
    const bf16* P = (const bf16*)(kws() + WS_R1); float* KLOC = (float*)(kws() + WS_R2); float* NLOC = (float*)(kws() + WS_NLOC); float* MLOC = (float*)(kws() + WS_MLOC); float* BLAST = (float*)(kws() + WS_BLAST);
    LAS bf16* VT = (LAS bf16*)F.lds; LAS bf16* KWT = (LAS bf16*)(F.lds + 18432); LAS float* wk = (LAS float*)(F.lds + SMALL_OFF);
    for (int u = F.vcu; u < 1024; u += F.G) {
        const int b = u >> 7, h = (u >> 5) & 3, c = u & 31, t0 = b * SEQ + c * 64;
        __syncthreads();
        if (F.wave == 0) { float bcum, ib; mlstm_gates(F, j, t0, h, bcum, ib); const float blast = __shfl(bcum, 63); const float gl = blast - bcum + ib; const float ml = wave_max(gl);
            wk[F.lane] = expf(gl - ml); if (F.lane == 0) { MLOC[u] = ml; BLAST[u] = blast; } }
        mlstm_stage_t(F, P, t0, 1024 + h * 128, VT, nullptr);
        __syncthreads();
        mlstm_stage_t(F, P, t0, 512 + h * 128, KWT, wk);
        __syncthreads();
        const int vt = F.wave >> 1, dh = F.wave & 1, li = F.lane & 31, hh = F.lane >> 5;
        f32x16 acc0 = zero16(), acc1 = zero16();
        const LAS bf16* ar = VT + (32 * vt + li) * 72; const LAS bf16* b0 = KWT + (64 * dh + li) * 72; const LAS bf16* b1 = b0 + 32 * 72;
#pragma unroll
        for (int ks = 0; ks < 4; ++ks) { const bf16x8 af = lds_nat(ar, ks, hh); acc0 = MFMA32(af, lds_nat(b0, ks, hh), acc0); acc1 = MFMA32(af, lds_nat(b1, ks, hh), acc1); }
        float* dst = KLOC + (size_t)u * 16384 + (size_t)(32 * vt) * 128 + 64 * dh + li;
#pragma unroll
        for (int r = 0; r < 16; ++r) { dst[crow(r, hh) * 128] = acc0[r]; dst[crow(r, hh) * 128 + 32] = acc1[r]; }
        if (F.tid < 128) { float a = 0.f; const LAS bf16* kr = KWT + F.tid * 72;
#pragma unroll
            for (int s8 = 0; s8 < 8; ++s8) { const v4u w = *(const LAS v4u*)(kr + 8 * s8); a += (bflo(w.x) + bfhi(w.x)) + (bflo(w.y) + bfhi(w.y)) + (bflo(w.z) + bfhi(w.z)) + (bflo(w.w) + bfhi(w.w)); }
            NLOC[(size_t)u * 128 + F.tid] = a; }
    }
}
__device__ __forceinline__ void o3_output_mfma(Frame& F0, int j) {
    Frame F = F0; asm volatile("" : "+v"(F.tid), "+v"(F.lane));
    const bf16* P = (const bf16*)(kws() + WS_R1); const float* CPREV = (const float*)(kws() + WS_R2); const float* NPREV = (const float*)(kws() + WS_NLOC); const float* MPREV = (const float*)(kws() + WS_MPREV); bf16* MIX = (bf16*)(kws() + WS_MIX);
    LAS bf16* QR = (LAS bf16*)F.lds;
    LAS bf16* KR = (LAS bf16*)(F.lds + 17408);
    LAS bf16* VT = (LAS bf16*)(F.lds + 34816);
    LAS float* OST = (LAS float*)(F.lds + 53248);
    LAS float* sm = (LAS float*)(F.lds + 98304);
    for (int u = F.vcu; u < 1024; u += F.G) {
        const int b = u >> 7, h = (u >> 5) & 3, c = u & 31, t0 = b * SEQ + c * 64;
        __syncthreads();
        if (F.wave == 0) { float bcum, ib; mlstm_gates(F, j, t0, h, bcum, ib); const float mprev = MPREV[u];
            const float pm = wave_scan_max(ib - bcum, F.lane); const float inter = bcum + mprev; const float mt = fmaxf(bcum + pm, inter);
            sm[F.lane] = bcum; sm[64 + F.lane] = ib; sm[128 + F.lane] = mt; sm[192 + F.lane] = expf(inter - mt); }
        for (int i = F.tid; i < 1024; i += 512) { const int l = i >> 4, ch = i & 15; const bf16* src = P + (size_t)(t0 + l) * NPO + h * 128 + 8 * ch;
            *(LAS v4u*)(QR + l * 136 + 8 * ch) = *(const v4u*)src; *(LAS v4u*)(KR + l * 136 + 8 * ch) = *(const v4u*)(src + 512); }
        mlstm_stage_t(F, P, t0, 1024 + h * 128, VT, nullptr);
        __syncthreads();
        if (F.wave == 1) { const int l = F.lane; const float* np = NPREV + (size_t)u * 128; float qn = 0.f;
#pragma unroll 4
            for (int d8 = 0; d8 < 16; ++d8) { const v4u w = *(const LAS v4u*)(QR + l * 136 + 8 * d8); const f32x4 n0 = *(const f32x4*)(np + 8 * d8), n1 = *(const f32x4*)(np + 8 * d8 + 4);
                qn += (bflo(w.x) * n0[0] + bfhi(w.x) * n0[1]) + (bflo(w.y) * n0[2] + bfhi(w.y) * n0[3]) + (bflo(w.z) * n1[0] + bfhi(w.z) * n1[1]) + (bflo(w.w) * n1[2] + bfhi(w.w) * n1[3]); }
            sm[256 + l] = qn; }
        const int lt = F.wave >> 2, vt = F.wave & 3, li = F.lane & 31, hh = F.lane >> 5, l = 32 * lt + li;
        const float bcl = sm[l], mtl = sm[128 + l], sil = sm[192 + l];
        f32x16 acc = zero16();
        const LAS bf16* qrl = QR + l * 136;
        { const float* cp = CPREV + (size_t)u * 16384 + (size_t)(32 * vt + li) * 128;
#pragma unroll
            for (int ks = 0; ks < 8; ++ks) acc = MFMA32(ldg8_f32(cp + 16 * ks + 8 * hh), lds_nat(qrl, ks, hh), acc); }
#pragma unroll
        for (int r = 0; r < 16; ++r) acc[r] *= sil;
        float dsum = 0.f;
        for (int st = 0; st <= lt; ++st) {
            f32x16 wt = zero16(); const LAS bf16* krs = KR + (32 * st + li) * 136;
#pragma unroll
            for (int ks = 0; ks < 8; ++ks) wt = MFMA32(lds_nat(krs, ks, hh), lds_nat(qrl, ks, hh), wt);
#pragma unroll
            for (int a4 = 0; a4 < 4; ++a4) { const f32x4 bs = *(const LAS f32x4*)(sm + 32 * st + 8 * a4 + 4 * hh), is = *(const LAS f32x4*)(sm + 64 + 32 * st + 8 * a4 + 4 * hh);
#pragma unroll
                for (int i = 0; i < 4; ++i) { const int r = 4 * a4 + i; const float e = expf(bcl - bs[i] + is[i] - mtl); const float w = (st < lt || crow(r, hh) <= li) ? wt[r] * e : 0.f; wt[r] = w; dsum += w; } }
            const bf16x8 w0 = pack_step(wt, 0), w1 = pack_step(wt, 1); const LAS bf16* vr = VT + (32 * vt + li) * 72 + 32 * st;
            acc = MFMA32(lds_krow(vr, 0, hh), w0, acc); acc = MFMA32(lds_krow(vr, 16, hh), w1, acc); }
        __syncthreads();
        dsum += __shfl_xor(dsum, 32);
        const float den = dsum + sil * sm[256 + l]; const float rinv = 1.0f / fmaxf(fabsf(den), expf(-mtl));
        float s1 = 0.f, s2 = 0.f;
#pragma unroll
        for (int r = 0; r < 16; ++r) { acc[r] *= rinv; s1 += acc[r]; s2 += acc[r] * acc[r]; }
        s1 += __shfl_xor(s1, 32); s2 += __shfl_xor(s2, 32);
        if (hh == 0) { sm[320 + (vt * 64 + l) * 2] = s1; sm[320 + (vt * 64 + l) * 2 + 1] = s2; }
        __syncthreads();
        { float t1 = 0.f, t2 = 0.f;
#pragma unroll
            for (int q = 0; q < 4; ++q) { t1 += sm[320 + (q * 64 + l) * 2]; t2 += sm[320 + (q * 64 + l) * 2 + 1]; }
            const float mu = t1 * (1.f / 128.f), var = fmaxf(t2 * (1.f / 128.f) - mu * mu, 0.f), rstd = 1.0f / sqrtf(var + LN_EPS);
#pragma unroll
            for (int r = 0; r < 16; ++r) OST[l * 132 + 32 * vt + crow(r, hh)] = (acc[r] - mu) * rstd; }
        __syncthreads();
        for (int i = F.tid; i < 1024; i += 512) { const int ll = i >> 4, ch = i & 15; const LAS float* os = OST + ll * 132 + 8 * ch; const f32x4 o0 = *(const LAS f32x4*)os, o1 = *(const LAS f32x4*)(os + 4);
            const v4u ow = *(const v4u*)(P + (size_t)(t0 + ll) * NPO + 1536 + h * 128 + 8 * ch); const float* hw = KIN(I_HNW) + j * 512 + h * 128 + 8 * ch; const f32x4 h0 = *(const f32x4*)hw, h1 = *(const f32x4*)(hw + 4);
            v4u res; res.x = pk2(o0[0] * h0[0] * sigmoid_f(bflo(ow.x)), o0[1] * h0[1] * sigmoid_f(bfhi(ow.x))); res.y = pk2(o0[2] * h0[2] * sigmoid_f(bflo(ow.y)), o0[3] * h0[3] * sigmoid_f(bfhi(ow.y)));
            res.z = pk2(o1[0] * h1[0] * sigmoid_f(bflo(ow.z)), o1[1] * h1[1] * sigmoid_f(bfhi(ow.z))); res.w = pk2(o1[2] * h1[2] * sigmoid_f(bflo(ow.w)), o1[3] * h1[3] * sigmoid_f(bfhi(ow.w)));
            *(v4u*)(MIX + (size_t)(t0 + ll) * D + h * 128 + 8 * ch) = res; }
    }
}
template <bool XIN> __device__ __forceinline__ void p_ln1_route(Frame& F0, int layer) {   Frame F = F0; asm volatile("" : "+v"(F.tid), "+v"(F.lane));
    const bf16* OUTP = (const bf16*)(kws() + WS_R1); const bf16* HB = (const bf16*)(kws() + WS_HB); bf16* H1B = (bf16*)(kws() + WS_H1B);
    i32x4* ROUTE = (i32x4*)(kws() + WS_ROUTE); f32x2* GATE = (f32x2*)(kws() + WS_GATE); int* BCNT = (int*)(kws() + WS_BCNT);
    LAS int* cnt = (LAS int*)(F.lds + SMALL_OFF);
    const float* g1 = KIN(I_LN1G) + (size_t)layer * D; const float* b1 = KIN(I_LN1B) + (size_t)layer * D;
    const f32x4* rgw = (const f32x4*)(kws() + WS_TAB + (size_t)layer * TAB_LAYER + TAB_RGW); const float* rgb = KIN(I_RGB) + layer * 4; const f32x4* rew = (const f32x4*)(kws() + WS_TAB + (size_t)layer * TAB_LAYER + TAB_REW); const float* reb = KIN(I_REB) + layer * 32;
    __syncthreads();
    if (F.tid < 32) cnt[F.tid] = 0;
    __syncthreads();
    const LAS unsigned char* wl = F.lds + F.wave * 12288; const unsigned wla = (unsigned)(uintptr_t)(F.lds) + F.wave * 12288;
#define LN1_ISSUE(m0_) do { _Pragma("unroll") for (int rr = 0; rr < 2; ++rr) { const int m_ = (m0_) + rr * F.NGW < T ? (m0_) + rr * F.NGW : (m0_); \
        if constexpr (XIN) row_dma<4>(KIN(I_X) + (size_t)m_ * D, wla + rr * 6144, F.lane); else row_dma<2>(HB + (size_t)m_ * D, wla + rr * 6144, F.lane); \
        row_dma<2>(OUTP + (size_t)m_ * D, wla + rr * 6144 + 4096, F.lane); } } while (0)
    if (F.gw < T) LN1_ISSUE(F.gw);
#pragma unroll 1
    for (int m0 = F.gw; m0 < T; m0 += 2 * F.NGW) {
        const int m1 = m0 + F.NGW < T ? m0 + F.NGW : -1; const int mm[2] = {m0, m1 >= 0 ? m1 : m0};
        f32x4 v[2][4], a[2][4];
        DMA_WAIT_ALL();
#pragma unroll
        for (int rr = 0; rr < 2; ++rr) { if constexpr (XIN) row_load_f32_lds(wl + rr * 6144, F.lane, v[rr]); else row_load_bf16_lds(wl + rr * 6144, F.lane, v[rr]); row_load_bf16_lds(wl + rr * 6144 + 4096, F.lane, a[rr]); }
        LDS_WAIT();
        if (m0 + 2 * F.NGW < T) LN1_ISSUE(m0 + 2 * F.NGW);
#pragma unroll
        for (int rr = 0; rr < 2; ++rr) {
#pragma unroll
            for (int jj = 0; jj < 4; ++jj) v[rr][jj] = v[rr][jj] * ALPHA + a[rr][jj];
            row_layernorm(v[rr], g1, b1, F.lane); }
        row_store_bf16(H1B + (size_t)m0 * D, F.lane, v[0]); if (m1 >= 0) row_store_bf16(H1B + (size_t)m1 * D, F.lane, v[1]);
        float gl[2][4];
#pragma unroll
        for (int c = 0; c < 4; ++c) { gl[0][c] = 0.f; gl[1][c] = 0.f; }
#pragma unroll
        for (int jj = 0; jj < 4; ++jj)
#pragma unroll
            for (int i = 0; i < 4; ++i) { const f32x4 w = rgw[(jj * 4 + i) * 64 + F.lane];
#pragma unroll
                for (int c = 0; c < 4; ++c) { gl[0][c] += v[0][jj][i] * w[c]; gl[1][c] += v[1][jj][i] * w[c]; } }
        int gi[2]; float pg[2];
#pragma unroll
        for (int rr = 0; rr < 2; ++rr) { const float red = wave_reduce_multi<4>(gl[rr], F.lane); float l4[4];
#pragma unroll
            for (int c = 0; c < 4; ++c) l4[c] = __shfl(red, 16 * c) + rgb[c];
            int g = 0; float gm = l4[0];
#pragma unroll
            for (int c = 1; c < 4; ++c) if (l4[c] > gm) { gm = l4[c]; g = c; }
            float se = 0.f;
#pragma unroll
            for (int c = 0; c < 4; ++c) se += expf(l4[c] - gm);
            gi[rr] = g; pg[rr] = 1.0f / se; }
        float el[2][8];
#pragma unroll
        for (int rr = 0; rr < 2; ++rr) { const f32x4* rw = rew + (size_t)gi[rr] * 2048 + F.lane;
#pragma unroll
            for (int c = 0; c < 8; ++c) el[rr][c] = 0.f;
#pragma unroll
            for (int jj = 0; jj < 4; ++jj)
#pragma unroll
                for (int i = 0; i < 4; ++i) { const f32x4 w0 = rw[(jj * 4 + i) * 128], w1 = rw[(jj * 4 + i) * 128 + 64];
#pragma unroll
                    for (int c = 0; c < 4; ++c) { el[rr][c] += v[rr][jj][i] * w0[c]; el[rr][4 + c] += v[rr][jj][i] * w1[c]; } } }
#pragma unroll
        for (int rr = 0; rr < 2; ++rr) { const float red = wave_reduce_multi<8>(el[rr], F.lane); float e8[8];
#pragma unroll
            for (int c = 0; c < 8; ++c) e8[c] = __shfl(red, 8 * c) + reb[gi[rr] * 8 + c];
            int i0 = 0; float v0 = e8[0];
#pragma unroll
            for (int c = 1; c < 8; ++c) if (e8[c] > v0) { v0 = e8[c]; i0 = c; }
            int i1 = -1; float v1 = -INFINITY;
#pragma unroll
            for (int c = 0; c < 8; ++c) if (c != i0 && e8[c] > v1) { v1 = e8[c]; i1 = c; }
            if (i1 < 0) i1 = (i0 + 1) & 7;
            const float ee = expf(v1 - v0), g0 = pg[rr] / (1.0f + ee), g1v = pg[rr] * ee / (1.0f + ee);
            if (F.lane == 0 && (rr == 0 || m1 >= 0)) { const int e0 = gi[rr] * 8 + i0, e1 = gi[rr] * 8 + i1;
                const int r0 = __hip_atomic_fetch_add(cnt + e0, 1, __ATOMIC_RELAXED, __HIP_MEMORY_SCOPE_WORKGROUP), r1 = __hip_atomic_fetch_add(cnt + e1, 1, __ATOMIC_RELAXED, __HIP_MEMORY_SCOPE_WORKGROUP);
                ROUTE[mm[rr]] = (i32x4){e0, r0, e1, r1}; GATE[mm[rr]] = (f32x2){g0, g1v}; } }
    }
#undef LN1_ISSUE
    __syncthreads();
    if (F.tid < 32) BCNT[F.vcu * 32 + F.tid] = cnt[F.tid];
}
__device__ __forceinline__ void p_scatter(Frame& F0) {   Frame F = F0; asm volatile("" : "+v"(F.tid), "+v"(F.lane));
    const int* BCNT = (const int*)(kws() + WS_BCNT); int* PANEL = (int*)(kws() + WS_PANEL); const i32x4* ROUTE = (const i32x4*)(kws() + WS_ROUTE); i32x2* POS = (i32x2*)(kws() + WS_POS);
    const bf16* H1B = (const bf16*)(kws() + WS_H1B); bf16* XS = (bf16*)(kws() + WS_R1);
    LAS int* pa = (LAS int*)(F.lds + SMALL_OFF); LAS int* pb = pa + 512; LAS int* tot = pa + 1024; LAS int* bef = pa + 1056; LAS int* base = pa + 1088;
    __syncthreads();
    { const int e = F.tid & 31, part = F.tid >> 5; int sa = 0, sb = 0;
        for (int b = part; b < F.G; b += 16) { const int c = BCNT[b * 32 + e]; sa += c; if (b < F.vcu) sb += c; }
        pa[part * 32 + e] = sa; pb[part * 32 + e] = sb; }
    __syncthreads();
    if (F.tid < 32) { int sa = 0, sb = 0; for (int p = 0; p < 16; ++p) { sa += pa[p * 32 + F.tid]; sb += pb[p * 32 + F.tid]; } tot[F.tid] = sa; bef[F.tid] = sb; }
    __syncthreads();
    if (F.tid == 0) { int off = 0, np = 0;
        for (int e = 0; e < 32; ++e) { const int npan = (tot[e] + 255) >> 8; base[e] = off + bef[e];
            if (F.vcu == 0) for (int p = 0; p < npan; ++p) PANEL[1 + np + p] = e;
            np += npan; off += npan * 256; }
        if (F.vcu == 0) PANEL[0] = np; }
    __syncthreads();
#pragma unroll 1
    for (int m0 = F.gw; m0 < T; m0 += 4 * F.NGW) {
        i32x4 r[4]; v4u w[4][2];
#pragma unroll
        for (int rr = 0; rr < 4; ++rr) { const int m = m0 + rr * F.NGW < T ? m0 + rr * F.NGW : m0; r[rr] = ROUTE[m]; const v4u* src = (const v4u*)(H1B + (size_t)m * D); w[rr][0] = src[F.lane]; w[rr][1] = src[F.lane + 64]; }
#pragma unroll
        for (int rr = 0; rr < 4; ++rr) { const int m = m0 + rr * F.NGW; if (m < T) { const int p0 = base[r[rr].x] + r[rr].y, p1 = base[r[rr].z] + r[rr].w;
            if (F.lane == 0) POS[m] = (i32x2){p0, p1};
            v4u* d0 = (v4u*)(XS + (size_t)p0 * D); v4u* d1 = (v4u*)(XS + (size_t)p1 * D);
            d0[F.lane] = w[rr][0]; d0[F.lane + 64] = w[rr][1]; d1[F.lane] = w[rr][0]; d1[F.lane + 64] = w[rr][1]; } } }
}
__device__ __forceinline__ void p_combine(Frame& F0, int layer) {   Frame F = F0; asm volatile("" : "+v"(F.tid), "+v"(F.lane));
    const bf16* H1B = (const bf16*)(kws() + WS_H1B); const bf16* EOUT = (const bf16*)(kws() + WS_R1); const i32x2* POS = (const i32x2*)(kws() + WS_POS); const f32x2* GATE = (const f32x2*)(kws() + WS_GATE);
    bf16* HB = (bf16*)(kws() + WS_HB);
    const float* g2 = KIN(I_LN2G) + (size_t)layer * D; const float* b2 = KIN(I_LN2B) + (size_t)layer * D;
    const LAS unsigned char* wl = F.lds + F.wave * 12288; const unsigned wla = (unsigned)(uintptr_t)(F.lds) + F.wave * 12288;
    i32x2 myps = (i32x2){0, 0}; f32x2 mygt = (f32x2){0.f, 0.f};
    { const int mr = F.gw + F.lane * F.NGW; if (mr < T) { myps = POS[mr]; mygt = GATE[mr]; } }
#define CMB_ISSUE(m0_, i_) do { _Pragma("unroll") for (int rr = 0; rr < 2; ++rr) { const bool ok_ = (m0_) + rr * F.NGW < T; const int m_ = ok_ ? (m0_) + rr * F.NGW : (m0_); const int ri_ = ok_ ? (i_) + rr : (i_); \
        const int px_ = __shfl(myps.x, ri_), py_ = __shfl(myps.y, ri_); \
        row_dma<2>(H1B + (size_t)m_ * D, wla + rr * 6144, F.lane); row_dma<2>(EOUT + (size_t)px_ * D, wla + rr * 6144 + 2048, F.lane); row_dma<2>(EOUT + (size_t)py_ * D, wla + rr * 6144 + 4096, F.lane); } } while (0)
    if (F.gw < T) CMB_ISSUE(F.gw, 0);
    int ri = 0;
#pragma unroll 1
    for (int m0 = F.gw; m0 < T; m0 += 2 * F.NGW, ri += 2) {
        const int m1 = m0 + F.NGW < T ? m0 + F.NGW : -1;
        f32x4 v[2][4], ea[2][4], eb[2][4]; f32x2 gt[2];
        gt[0] = (f32x2){__shfl(mygt.x, ri), __shfl(mygt.y, ri)}; gt[1] = (f32x2){__shfl(mygt.x, ri + (m1 >= 0)), __shfl(mygt.y, ri + (m1 >= 0))};
        DMA_WAIT_ALL();
#pragma unroll
        for (int rr = 0; rr < 2; ++rr) { row_load_bf16_lds(wl + rr * 6144, F.lane, v[rr]); row_load_bf16_lds(wl + rr * 6144 + 2048, F.lane, ea[rr]); row_load_bf16_lds(wl + rr * 6144 + 4096, F.lane, eb[rr]); }
        LDS_WAIT();
        if (m0 + 2 * F.NGW < T) CMB_ISSUE(m0 + 2 * F.NGW, ri + 2);
#pragma unroll
        for (int rr = 0; rr < 2; ++rr) {
#pragma unroll
            for (int jj = 0; jj < 4; ++jj) v[rr][jj] = v[rr][jj] * ALPHA + (ea[rr][jj] * gt[rr].x + eb[rr][jj] * gt[rr].y);
            row_layernorm(v[rr], g2, b2, F.lane); }
        if (layer == DEPTH - 1) { row_store_f32(kout() + (size_t)m0 * D, F.lane, v[0]); if (m1 >= 0) row_store_f32(kout() + (size_t)m1 * D, F.lane, v[1]); }
        else { row_store_bf16(HB + (size_t)m0 * D, F.lane, v[0]); if (m1 >= 0) row_store_bf16(HB + (size_t)m1 * D, F.lane, v[1]); row_gate_proj2(F, v[0], v[1], layer + 1, m0, m1); } }
#undef CMB_ISSUE
}
#ifndef PHASE_MASK
#define PHASE_MASK 0x1fff
#endif
#define PH_EN(k) (((PHASE_MASK) >> (k)) & 1)
#ifndef PROBE_DUP
#define PROBE_DUP 0
#endif
#define TPROBE(k) ((((PROBE_DUP) >> (k)) & 1) != 0)
#define TWAIT(k) do { if constexpr (TPROBE(k)) { const unsigned long long t1_ = __builtin_amdgcn_s_memrealtime(); while (__builtin_amdgcn_s_memrealtime() - t1_ < (t1_ - tp0_)) __builtin_amdgcn_s_sleep(8); } } while (0)
#define IN(k) (lo <= (k) && (k) < hi)
#define SEAM(k) do { if ((k) + 1 < hi) xcd_barrier(bar); } while (0)
template <int LAYER> __device__ __forceinline__ void layer_body(Frame& F, const int lo, const int hi, const XcdBarrier& bar) {
        constexpr int layer = LAYER, pb = 1 + LAYER * NPH_LAYER, j = LAYER >> 1; constexpr bool odd = (LAYER & 1) != 0;
        bf16* HB = (bf16*)(kws() + WS_HB); bf16* MIX = (bf16*)(kws() + WS_MIX);
        if constexpr (PH_EN(0)) if (IN(pb + 0)) { const unsigned long long tp0_ = TPROBE(0) ? __builtin_amdgcn_s_memrealtime() : 0ull;
            const int N = odd ? NPO : NPE; const bf16* Bt = odd ? (const bf16*)(kws() + WS_WINO) + (size_t)j * NPO * D : (const bf16*)(kws() + WS_WINE) + (size_t)j * NPE * D;
            pg8::Gemm g{HB, Bt, T, N, D, 0}; pg8::StaticOrder S; S.init(T, N, F.G, (int)blockIdx.x);
            pg8::EpiStoreBf16 E{(bf16*)(kws() + WS_R1), N};
            pg8::gemm_phase<pg8::EpiStoreBf16, pg8::StaticOrder, true, true>(F.lds, g, S, E);
            SEAM(pb + 0); TWAIT(0); }
        if constexpr (!odd) {
            if constexpr (PH_EN(1)) if (IN(pb + 1)) { const unsigned long long tp0_ = TPROBE(1) ? __builtin_amdgcn_s_memrealtime() : 0ull; e0_conv(F, j); SEAM(pb + 1); TWAIT(1); }
            if constexpr (PH_EN(2)) if (IN(pb + 2)) { const unsigned long long tp0_ = TPROBE(2) ? __builtin_amdgcn_s_memrealtime() : 0ull; if constexpr (SSD_NAIVE) e1_states(F, j); else e1_states_mfma(F, j); SEAM(pb + 2); TWAIT(2); }
            if constexpr (PH_EN(3)) if (IN(pb + 3)) { const unsigned long long tp0_ = TPROBE(3) ? __builtin_amdgcn_s_memrealtime() : 0ull; e2_scan(F); SEAM(pb + 3); TWAIT(3); }
            if constexpr (PH_EN(4)) if (IN(pb + 4)) { const unsigned long long tp0_ = TPROBE(4) ? __builtin_amdgcn_s_memrealtime() : 0ull; if constexpr (SSD_NAIVE) e3_output(F, j); else e3_output_mfma(F, j); SEAM(pb + 4); TWAIT(4); }
            if constexpr (PH_EN(5)) if (IN(pb + 5)) { const unsigned long long tp0_ = TPROBE(5) ? __builtin_amdgcn_s_memrealtime() : 0ull; e4_gnorm(F); SEAM(pb + 5); TWAIT(5); }
        } else {
            if constexpr (PH_EN(1)) if (IN(pb + 1)) { const unsigned long long tp0_ = TPROBE(1) ? __builtin_amdgcn_s_memrealtime() : 0ull; o_foxscan(F, j); if constexpr (MLSTM_NAIVE) o1_local(F, j); else o1_local_mfma(F, j); SEAM(pb + 1); TWAIT(1); }
            if constexpr (PH_EN(2)) if (IN(pb + 2)) { const unsigned long long tp0_ = TPROBE(2) ? __builtin_amdgcn_s_memrealtime() : 0ull; o2_scan(F); SEAM(pb + 2); TWAIT(2); }
            if constexpr (PH_EN(3)) if (IN(pb + 3)) { const unsigned long long tp0_ = TPROBE(3) ? __builtin_amdgcn_s_memrealtime() : 0ull;
#if FOX_NAIVE
                o4_fox(F);
#else
                const attn_body::bf16* PR = (const attn_body::bf16*)(kws() + WS_R1);
                const attn_body::AttnTensors AT{PR + 2048, PR + 2560, PR + 3072, (attn_body::bf16*)(kws() + WS_MIX) + 512, (const float*)(kws() + WS_FOXC)};
                const attn_body::StaticOrder S((int)F.G, F.vcu);
                attn_body::attn_phase<attn_body::StaticOrder>((char*)F.lds, AT, S);
#endif
                __syncthreads();
                if constexpr (MLSTM_NAIVE) o3_output(F, j); else o3_output_mfma(F, j); SEAM(pb + 3); TWAIT(3); }
        }
        if constexpr (PH_EN(6)) if (IN(pb + 6)) { const unsigned long long tp0_ = TPROBE(6) ? __builtin_amdgcn_s_memrealtime() : 0ull;
            const int K = odd ? D : 1536; const bf16* Bt = odd ? (const bf16*)(kws() + WS_WOUTO) + (size_t)j * D * D : (const bf16*)(kws() + WS_WOUTE) + (size_t)j * D * 1536;
            pg8::Gemm g{MIX, Bt, T, D, K, 0}; pg8::StaticOrder S; S.init(T, D, F.G, (int)blockIdx.x);
            pg8::EpiStoreBf16 E{(bf16*)(kws() + WS_R1), D};
            pg8::gemm_phase<pg8::EpiStoreBf16, pg8::StaticOrder, false, true>(F.lds, g, S, E);
            SEAM(pb + 6); TWAIT(6); }
        if constexpr (PH_EN(7)) if (IN(pb + 7)) { const unsigned long long tp0_ = TPROBE(7) ? __builtin_amdgcn_s_memrealtime() : 0ull; p_ln1_route<LAYER == 0>(F, layer); SEAM(pb + 7); TWAIT(7); }
        if constexpr (PH_EN(8)) if (IN(pb + 8)) { const unsigned long long tp0_ = TPROBE(8) ? __builtin_amdgcn_s_memrealtime() : 0ull; p_scatter(F); SEAM(pb + 8); TWAIT(8); }
        if constexpr (PH_EN(9)) if (IN(pb + 9)) { const unsigned long long tp0_ = TPROBE(9) ? __builtin_amdgcn_s_memrealtime() : 0ull;
            pg8::Gemm g{(const bf16*)(kws() + WS_R1), (const bf16*)(kws() + WS_WGU) + (size_t)layer * 32 * D * D, RPAD, D, D, (size_t)D * D * 2};
            pg8::MoeOrder S; S.initm((const int*)(kws() + WS_PANEL), 4, F.G, (int)blockIdx.x);
            pg8::EpiSwiglu E{(bf16*)(kws() + WS_R3), 512};
            pg8::gemm_phase<pg8::EpiSwiglu, pg8::MoeOrder, true, true>(F.lds, g, S, E);
            SEAM(pb + 9); TWAIT(9); }
        if constexpr (PH_EN(10)) if (IN(pb + 10)) { const unsigned long long tp0_ = TPROBE(10) ? __builtin_amdgcn_s_memrealtime() : 0ull;
            pg8::Gemm g{(const bf16*)(kws() + WS_R3), (const bf16*)(kws() + WS_WD) + (size_t)layer * 32 * D * 512, RPAD, D, 512, (size_t)D * 512 * 2};
            pg8::MoeOrder S; S.initm((const int*)(kws() + WS_PANEL), 4, F.G, (int)blockIdx.x);
            pg8::EpiStoreBf16 E{(bf16*)(kws() + WS_R1), D};
            pg8::gemm_phase<pg8::EpiStoreBf16, pg8::MoeOrder, true, true>(F.lds, g, S, E);
            SEAM(pb + 10); TWAIT(10); }
        if constexpr (PH_EN(11)) if (IN(pb + 11)) { const unsigned long long tp0_ = TPROBE(11) ? __builtin_amdgcn_s_memrealtime() : 0ull; p_combine(F, layer); SEAM(pb + 11); TWAIT(11); }
}
struct Args { const float* in[27]; float* out; unsigned char* ws; int ph_lo, ph_hi; };
__global__ void __launch_bounds__(NWAVES * 64, 2) fwd_kernel(Args args) {
    extern __shared__ __attribute__((aligned(16))) unsigned char lds[];
    Frame F;
    F.lds = (LAS unsigned char*)lds;
    F.MISC = (volatile LAS unsigned*)(F.lds + MISC_OFF);
    F.tid = threadIdx.x; F.lane = F.tid & 63; F.wave = __builtin_amdgcn_readfirstlane(F.tid >> 6);
    F.G = gridDim.x; { const int bx = blockIdx.x; F.vcu = (F.G % 8 == 0) ? (bx % 8) * (F.G / 8) + bx / 8 : bx; }
    F.gw = F.vcu * NWAVES + F.wave; F.NGW = F.G * NWAVES;
    F.ctl = (unsigned*)(args.ws + WS_CTL);
    const int lo = args.ph_lo, hi = args.ph_hi;
    for (int u = F.tid; u < (LDS_BYTES - MISC_OFF) / 4; u += NWAVES * 64) ((LAS unsigned*)(F.lds + MISC_OFF))[u] = 0u;
    __syncthreads();
    XcdBarrier bar; bar.bar = F.ctl + CW_BAR; bar.x = 0; bar.st = nullptr;
    if (hi - lo > 1) bar = xcd_barrier_post(F.ctl + CW_BAR, F.MISC + 8);
    if constexpr (PH_EN(12)) if (IN(0)) { const unsigned long long tp0_ = TPROBE(12) ? __builtin_amdgcn_s_memrealtime() : 0ull; p_prologue(F); SEAM(0); TWAIT(12); }
    layer_body<0>(F, lo, hi, bar); layer_body<1>(F, lo, hi, bar); layer_body<2>(F, lo, hi, bar); layer_body<3>(F, lo, hi, bar);
#undef IN
#undef SEAM
}

extern "C" void kernel_launch(void* const* d_in, const int* in_sizes, int n_in, void* d_out, int out_size, void* d_ws, size_t ws_size, hipStream_t stream) {
    static int grid = 0;
    if (grid == 0) {
        if (n_in != 27 || in_sizes[0] != T * D || out_size != T * D || ws_size < WS_END) { fprintf(stderr, "kernel_launch: unexpected shapes (n_in %d, in0 %d, out %d, ws %zu); nothing launched\n", n_in, n_in > 0 ? in_sizes[0] : -1, out_size, ws_size); grid = -1; return; }
        int dev = 0, cus = 0, per_cu = 0;
        if (hipGetDevice(&dev) != hipSuccess || hipDeviceGetAttribute(&cus, hipDeviceAttributeMultiprocessorCount, dev) != hipSuccess) { grid = -1; return; }
        if (hipFuncSetAttribute((const void*)fwd_kernel, hipFuncAttributeMaxDynamicSharedMemorySize, LDS_BYTES) != hipSuccess) { fprintf(stderr, "kernel_launch: hipFuncSetAttribute failed\n"); grid = -1; return; }
        if (hipOccupancyMaxActiveBlocksPerMultiprocessor(&per_cu, (const void*)fwd_kernel, NWAVES * 64, LDS_BYTES) != hipSuccess || per_cu < 1) fprintf(stderr, "kernel_launch: note: occupancy query reports %d workgroups per CU\n", per_cu);
        (void)hipGetLastError();
        grid = cus;
    }
    if (grid < 0) return;
    if (hipMemsetAsync((char*)d_ws + WS_CTL, 0, CTL_ZERO_BYTES, stream) != hipSuccess) return;
    Args a{};
    for (int i = 0; i < 27; ++i) a.in[i] = (const float*)d_in[i];
    a.out = (float*)d_out; a.ws = (unsigned char*)d_ws;
#if MK_ONE_LAUNCH
    a.ph_lo = 0; a.ph_hi = NPHASES;
    hipLaunchKernelGGL(fwd_kernel, dim3(grid), dim3(NWAVES * 64), LDS_BYTES, stream, a);
#else
    for (int ph = 0; ph < NPHASES; ++ph) {
        if (ph > 0 && (((ph - 1) / NPH_LAYER) & 1) && ((ph - 1) % NPH_LAYER) == 5) continue;
        a.ph_lo = ph; a.ph_hi = ph + 1;
        hipLaunchKernelGGL(fwd_kernel, dim3(grid), dim3(NWAVES * 64), LDS_BYTES, stream, a);
    }
#endif
}
```

```cpp
#include <hip/hip_runtime.h>
#include <cstdio>
#include <cstdint>
__device__ __forceinline__ float silu_f(float x) { return x / (1.0f + __expf(-x)); }
namespace pg8 {
#define PG8_LAS __attribute__((address_space(3)))
typedef unsigned short bf16_t;
typedef short bf16x8 __attribute__((ext_vector_type(8)));
typedef float f32x4 __attribute__((ext_vector_type(4)));
typedef unsigned u32x4 __attribute__((ext_vector_type(4)));
constexpr int BM = 256, BK = 64, HALF = 128, HTB = HALF * BK * 2  , STAGE_BYTES = 8 * HTB, NXCD = 8, WGM = 8;

__host__ __device__ __forceinline__ int lds_byte(int r, int c) { const int st = (r >> 4) * 2 + (c >> 5), rr = r & 15, cc = c & 31, ob = rr * 64 + cc * 2; return st * 1024 + (ob ^ (((ob >> 9) & 1) << 5)); }
__host__ __device__ __forceinline__ void stage_rc(int b, int& R, int& C) { const int st = b / 1024, sb = b % 1024, swz = sb ^ (((sb >> 9) & 1) << 5); R = (st >> 1) * 16 + swz / 64; C = (st & 1) * 32 + (swz % 64) / 2; }
__host__ __device__ __forceinline__ int perm32(int rho) { const int n = rho >> 4, i = rho & 15; return 8 * (i >> 2) + 4 * n + (i & 3); }

struct Unit { int pm, pn, be; };
struct Gemm { const bf16_t* A; const bf16_t* Bt; int M, N, K; size_t bstride; };

struct StaticOrder {
    int nM, nN, nwg, G, c;
    __host__ __device__ void init(int M, int N, int G_, int c_) { nM = M / BM; nN = N / BM; nwg = nM * nN; G = G_; c = c_; }
    __host__ __device__ bool next(int i, Unit& u) const {
        const long L = (long)i * G + c; if (L >= nwg) return false;
        int wgid = (int)L; { const int q = nwg / NXCD, r = nwg % NXCD, xcd = wgid % NXCD, off = wgid / NXCD; wgid = (xcd < r ? xcd * (q + 1) : r * (q + 1) + (xcd - r) * q) + off; }
        const int nig = WGM * nN, gid = wgid / nig, fm = gid * WGM, gsz = (nM - fm) < WGM ? (nM - fm) : WGM;
        u.pm = fm + ((wgid % nig) % gsz); u.pn = (wgid % nig) / gsz; u.be = 0; return true;
    }
    __device__ __forceinline__ void a_ready(const Unit&) const {}
    __device__ __forceinline__ void done(const Unit&) const {}
};

__device__ __forceinline__ unsigned cvt_pk_bf16(float lo, float hi) { unsigned r; asm volatile("v_cvt_pk_bf16_f32 %0, %1, %2" : "=v"(r) : "v"(lo), "v"(hi)); return r; }
struct EpiStoreBf16 {
    static constexpr bool PERM = true, AFTER_DRAIN = false;
    bf16_t* O; int ldc;
    __device__ __forceinline__ void operator()(const f32x4 (&acc)[2][2][4][2], const Unit& u, int wr, int wc, int fr, int fq) const {
        const int row0 = u.pm * BM + wr * 64 + fr, col0 = u.pn * BM + wc * 32 + 8 * fq;
#pragma unroll
        for (int ai = 0; ai < 2; ++ai)
#pragma unroll
            for (int m = 0; m < 4; ++m) { bf16_t* rowp = O + (size_t)(row0 + ai * HALF + m * 16) * ldc + col0;
#pragma unroll
                for (int bj = 0; bj < 2; ++bj) { const f32x4 v0 = acc[ai][bj][m][0], v1 = acc[ai][bj][m][1];
                    u32x4 w; w.x = cvt_pk_bf16(v0[0], v0[1]); w.y = cvt_pk_bf16(v0[2], v0[3]); w.z = cvt_pk_bf16(v1[0], v1[1]); w.w = cvt_pk_bf16(v1[2], v1[3]);
                    *(u32x4*)(rowp + bj * HALF) = w; } }
    }
};
struct EpiStoreF32 {
    static constexpr bool PERM = false, AFTER_DRAIN = false;
    float* C; int ldc;
    __device__ __forceinline__ void operator()(const f32x4 (&acc)[2][2][4][2], const Unit& u, int wr, int wc, int fr, int fq) const {
        const int row0 = u.pm * BM + wr * 64 + fr, col0 = u.pn * BM + wc * 32 + 4 * fq;
#pragma unroll
        for (int ai = 0; ai < 2; ++ai)
#pragma unroll
            for (int m = 0; m < 4; ++m) { float* rowp = C + (size_t)(row0 + ai * HALF + m * 16) * ldc + col0;
#pragma unroll
                for (int bj = 0; bj < 2; ++bj)
#pragma unroll
                    for (int n = 0; n < 2; ++n) *(f32x4*)(rowp + bj * HALF + n * 16) = acc[ai][bj][m][n]; }
    }
};
struct EpiSwiglu {
    static constexpr bool PERM = true, AFTER_DRAIN = false;
    bf16_t* O; int ldc;
    __device__ __forceinline__ void operator()(const f32x4 (&acc)[2][2][4][2], const Unit& u, int wr, int wc, int fr, int fq) const {
        const int row0 = u.pm * BM + wr * 64 + fr, col0 = u.pn * HALF + wc * 32 + 8 * fq;
#pragma unroll
        for (int ai = 0; ai < 2; ++ai)
#pragma unroll
            for (int m = 0; m < 4; ++m) { bf16_t* rowp = O + (size_t)(row0 + ai * HALF + m * 16) * ldc + col0;
                const f32x4 g0 = acc[ai][0][m][0], g1 = acc[ai][0][m][1], u0 = acc[ai][1][m][0], u1 = acc[ai][1][m][1];
                float h[8];
#pragma unroll
                for (int i = 0; i < 4; ++i) { h[i] = silu_f(g0[i]) * u0[i]; h[4 + i] = silu_f(g1[i]) * u1[i]; }
                u32x4 w; w.x = cvt_pk_bf16(h[0], h[1]); w.y = cvt_pk_bf16(h[2], h[3]); w.z = cvt_pk_bf16(h[4], h[5]); w.w = cvt_pk_bf16(h[6], h[7]);
                *(u32x4*)rowp = w; }
    }
};
struct MoeOrder : StaticOrder {
    const int* tab;
    __device__ __forceinline__ void initm(const int* tab_, int nN_, int G_, int c_) { tab = tab_; nM = tab_[0]; nN = nN_; nwg = nM * nN; G = G_; c = c_; }
    __device__ __forceinline__ bool next(int i, Unit& u) const { if (!StaticOrder::next(i, u)) return false; u.be = tab[1 + u.pm]; return true; }
};
template <class Epi, class Sched, bool ALIGN_EPI = false, bool SP2 = false>
__device__ __forceinline__ void gemm_phase(PG8_LAS unsigned char* lds, const Gemm g, const Sched& S, const Epi& E) {
    const int tid = threadIdx.x, wid = __builtin_amdgcn_readfirstlane(tid >> 6), lane = tid & 63, wr = wid >> 2, wc = wid & 3, fr = lane & 15, fq = lane >> 4;
    const int K = g.K, nt = K / BK;
    unsigned voffA[2], voffB[2];
#pragma unroll
    for (int i = 0; i < 2; ++i) { int R, C; stage_rc(tid * 16 + i * 8192, R, C); const int Rb = Epi::PERM ? ((R & ~31) + perm32(R & 31)) : R;
        voffA[i] = (unsigned)(R * K + C) * 2u; voffB[i] = (unsigned)(Rb * K + C) * 2u; }
    const size_t kstep = (size_t)(BK * 2);
    const size_t hstep = (size_t)HALF * K * 2;
    const size_t tstep = 2 * hstep;
    const unsigned ldsw = (unsigned)wid * 1024u;
    const int aoff = lds_byte(wr * 64 + fr, fq * 8), boff = lds_byte(wc * 32 + fr, fq * 8);
#define PG8_SA(b, h) (((b) * 2 + (h)) * HTB)
#define PG8_SB(b, h) ((4 + (b) * 2 + (h)) * HTB)
#define PG8_STAGE(bufoff, gbase, voff) do { _Pragma("unroll") for (int _i = 0; _i < 2; ++_i) \
        __builtin_amdgcn_global_load_lds((const unsigned*)((const char*)(gbase) + (voff)[_i]), (PG8_LAS unsigned*)(lds + (bufoff) + ldsw + _i * 8192), 16, 0, 0); } while (0)
#define PG8_LDA(dst, b, h) do { _Pragma("unroll") for (int m = 0; m < 4; ++m) _Pragma("unroll") for (int k = 0; k < 2; ++k) dst[m][k] = *(const PG8_LAS bf16x8*)(lds + PG8_SA(b, h) + aoff + m * 2048 + k * 1024); } while (0)
#define PG8_LDB(dst, b, h) do { _Pragma("unroll") for (int n = 0; n < 2; ++n) _Pragma("unroll") for (int k = 0; k < 2; ++k) dst[n][k] = *(const PG8_LAS bf16x8*)(lds + PG8_SB(b, h) + boff + n * 2048 + k * 1024); } while (0)
#define PG8_MMA(ai, bj, At, Bt) do { __builtin_amdgcn_s_setprio(1); _Pragma("unroll") for (int m = 0; m < 4; ++m) _Pragma("unroll") for (int n = 0; n < 2; ++n) _Pragma("unroll") for (int k = 0; k < 2; ++k) \
        acc[ai][bj][m][n] = __builtin_amdgcn_mfma_f32_16x16x32_bf16(Bt[n][k], At[m][k], acc[ai][bj][m][n], 0, 0, 0); __builtin_amdgcn_s_setprio(0); } while (0)
#define PG8_WAIT_V(n) asm volatile("s_waitcnt vmcnt(" #n ")" ::: "memory")
#define PG8_WAIT_L(n) asm volatile("s_waitcnt lgkmcnt(" #n ")" ::: "memory")
#define PG8_BAR __builtin_amdgcn_s_barrier()
#define PG8_SCHED __builtin_amdgcn_sched_barrier(0)
    Unit cur, nxt; int ui = 0;
    if (!S.next(0, cur)) return;
    f32x4 acc[2][2][4][2];
#pragma unroll
    for (int a = 0; a < 2; ++a)
#pragma unroll
        for (int b = 0; b < 2; ++b)
#pragma unroll
            for (int m = 0; m < 4; ++m)
#pragma unroll
                for (int n = 0; n < 2; ++n) acc[a][b][m][n] = (f32x4){0.f, 0.f, 0.f, 0.f};
    bf16x8 At[4][2], B0[2][2], B1[2][2];
    const char* cA = (const char*)g.A + (size_t)cur.pm * tstep; const char* cB = (const char*)g.Bt + (size_t)cur.be * g.bstride + (size_t)cur.pn * tstep;
    S.a_ready(cur);
    if constexpr (SP2) {
        PG8_STAGE(PG8_SB(0, 0), cB, voffB); PG8_STAGE(PG8_SB(0, 1), cB + hstep, voffB); PG8_STAGE(PG8_SA(0, 0), cA, voffA); PG8_STAGE(PG8_SA(0, 1), cA + hstep, voffA);
        if (wr == 1) PG8_BAR;
        PG8_WAIT_V(2); PG8_BAR;
        PG8_STAGE(PG8_SB(1, 0), cB + kstep, voffB); PG8_STAGE(PG8_SA(1, 0), cA + kstep, voffA); PG8_STAGE(PG8_SB(1, 1), cB + hstep + kstep, voffB);
        PG8_WAIT_V(6); PG8_BAR;
    } else {
        PG8_STAGE(PG8_SB(0, 0), cB, voffB); PG8_STAGE(PG8_SA(0, 0), cA, voffA); PG8_STAGE(PG8_SB(0, 1), cB + hstep, voffB); PG8_STAGE(PG8_SA(0, 1), cA + hstep, voffA);
        if (wr == 1) PG8_BAR;
        PG8_WAIT_V(4); PG8_BAR;
        PG8_STAGE(PG8_SB(1, 0), cB + kstep, voffB); PG8_STAGE(PG8_SA(1, 0), cA + kstep, voffA); PG8_STAGE(PG8_SB(1, 1), cB + hstep + kstep, voffB);
        PG8_WAIT_V(6); PG8_BAR;
    }
    for (;;) {
        const bool has_next = S.next(ui + 1, nxt);
        const char* nA = has_next ? (const char*)g.A + (size_t)nxt.pm * tstep : cA; const char* nB = has_next ? (const char*)g.Bt + (size_t)nxt.be * g.bstride + (size_t)nxt.pn * tstep : cB;
        for (int t = 0; t < nt; t += 2) {
            const bool last = (t == nt - 2);
            const char* a1 = cA + (size_t)(t + 1) * kstep;
            const char* a2 = last ? nA : cA + (size_t)(t + 2) * kstep; const char* b2 = last ? nB : cB + (size_t)(t + 2) * kstep;
            const char* a3 = a2 + kstep; const char* b3 = b2 + kstep;
            if (last && has_next) S.a_ready(nxt);
            if constexpr (SP2) {
            PG8_LDB(B0, 0, 0); PG8_LDB(B1, 0, 1); PG8_SCHED; PG8_LDA(At, 0, 0); PG8_STAGE(PG8_SA(1, 1), a1 + hstep, voffA);
            PG8_WAIT_V(8); PG8_WAIT_L(0); PG8_BAR; PG8_MMA(0, 0, At, B0); PG8_MMA(0, 1, At, B1); PG8_BAR; PG8_SCHED;
            PG8_LDA(At, 0, 1); PG8_STAGE(PG8_SB(0, 0), b2, voffB); PG8_STAGE(PG8_SB(0, 1), b2 + hstep, voffB); PG8_STAGE(PG8_SA(0, 0), a2, voffA);
            PG8_WAIT_V(8); PG8_WAIT_L(0); PG8_BAR; PG8_MMA(1, 0, At, B0); PG8_MMA(1, 1, At, B1); PG8_BAR; PG8_SCHED;
            PG8_LDB(B0, 1, 0); PG8_LDB(B1, 1, 1); PG8_SCHED; PG8_LDA(At, 1, 0); PG8_STAGE(PG8_SA(0, 1), a2 + hstep, voffA);
            PG8_WAIT_V(8); PG8_WAIT_L(0); PG8_BAR; PG8_MMA(0, 0, At, B0); PG8_MMA(0, 1, At, B1); PG8_BAR; PG8_SCHED;
            PG8_LDA(At, 1, 1); PG8_STAGE(PG8_SB(1, 0), b3, voffB); PG8_STAGE(PG8_SB(1, 1), b3 + hstep, voffB); PG8_STAGE(PG8_SA(1, 0), a3, voffA);
            PG8_WAIT_V(8); PG8_WAIT_L(0); PG8_BAR; PG8_MMA(1, 0, At, B0); PG8_MMA(1, 1, At, B1); PG8_BAR; PG8_SCHED;
            } else {
            PG8_LDB(B0, 0, 0); PG8_SCHED; PG8_LDA(At, 0, 0); PG8_STAGE(PG8_SA(1, 1), a1 + hstep, voffA);
            PG8_WAIT_L(8); PG8_BAR; PG8_WAIT_L(0); PG8_MMA(0, 0, At, B0); PG8_BAR; PG8_SCHED;
            PG8_LDB(B1, 0, 1); PG8_STAGE(PG8_SB(0, 0), b2, voffB);
            PG8_BAR; PG8_WAIT_L(0); PG8_MMA(0, 1, At, B1); PG8_BAR;
            PG8_LDA(At, 0, 1); PG8_STAGE(PG8_SA(0, 0), a2, voffA);
            PG8_BAR; PG8_WAIT_L(0); PG8_MMA(1, 0, At, B0); PG8_BAR; PG8_SCHED;
            PG8_STAGE(PG8_SB(0, 1), b2 + hstep, voffB);
            PG8_WAIT_V(6); PG8_BAR; PG8_MMA(1, 1, At, B1); PG8_BAR;
            PG8_LDB(B0, 1, 0); PG8_SCHED; PG8_LDA(At, 1, 0); PG8_STAGE(PG8_SA(0, 1), a2 + hstep, voffA);
            PG8_WAIT_L(8); PG8_BAR; PG8_WAIT_L(0); PG8_MMA(0, 0, At, B0); PG8_BAR; PG8_SCHED;
            PG8_LDB(B1, 1, 1); PG8_STAGE(PG8_SB(1, 0), b3, voffB);
            PG8_BAR; PG8_WAIT_L(0); PG8_MMA(0, 1, At, B1); PG8_BAR;
            PG8_LDA(At, 1, 1); PG8_STAGE(PG8_SA(1, 0), a3, voffA);
            PG8_BAR; PG8_WAIT_L(0); PG8_MMA(1, 0, At, B0); PG8_BAR; PG8_SCHED;
            PG8_STAGE(PG8_SB(1, 1), b3 + hstep, voffB);
            PG8_WAIT_V(6); PG8_BAR; PG8_MMA(1, 1, At, B1); PG8_BAR;
            }
        }
        if constexpr (ALIGN_EPI) { if (wr == 0) PG8_BAR; }
        if constexpr (!Epi::AFTER_DRAIN) { E(acc, cur, wr, wc, fr, fq); S.done(cur); }
        if (!has_next) break;
#pragma unroll
        for (int a = 0; a < 2; ++a)
#pragma unroll
            for (int b = 0; b < 2; ++b)
#pragma unroll
                for (int m = 0; m < 4; ++m)
#pragma unroll
                    for (int n = 0; n < 2; ++n) acc[a][b][m][n] = (f32x4){0.f, 0.f, 0.f, 0.f};
        cur = nxt; cA = nA; cB = nB; ++ui;
        if constexpr (ALIGN_EPI) { if (wr == 1) PG8_BAR; }
    }
    PG8_WAIT_V(0);
    if constexpr (!ALIGN_EPI) { if (wr == 0) PG8_BAR; }
    PG8_BAR;
    if constexpr (Epi::AFTER_DRAIN) { E.fused(acc, cur, wr, wc, fr, fq, lds, wid, lane); S.done(cur); }
#undef PG8_SA
#undef PG8_SB
#undef PG8_STAGE
#undef PG8_LDA
#undef PG8_LDB
#undef PG8_MMA
#undef PG8_WAIT_V
#undef PG8_WAIT_L
#undef PG8_BAR
#undef PG8_SCHED
}
}
#ifndef SSD_NAIVE
#define SSD_NAIVE 0
#endif
#ifndef MLSTM_NAIVE
#define MLSTM_NAIVE 0
#endif
#ifndef FOX_NAIVE
#define FOX_NAIVE 0
#endif
#include <hip/hip_bf16.h>
#include <cmath>
namespace attn_body {
using bf16=__hip_bfloat16;
using bf16x8=__attribute__((ext_vector_type(8)))short;
using s16x4=__attribute__((ext_vector_type(4)))short;
using f32x16=__attribute__((ext_vector_type(16)))float;
using u32x4=__attribute__((ext_vector_type(4)))unsigned;
constexpr int BATCH=8,NHEAD=8,SEQ=2048,D=64,PQ=3584,PO=1024;
constexpr int NW=8,QBLK=32,QB=QBLK*NW,KVBLK=64,NQB=SEQ/QB;
constexpr int ATTN_UNIT_ROWS=QB;
__device__ __forceinline__ int crow(int r,int hi){return (r&3)+8*(r>>2)+4*hi;}
#define SBAR() __builtin_amdgcn_sched_barrier(0)
__device__ __forceinline__ void cmask(f32x16&p0,f32x16&p1,int jb,int qrel,int hi){
  const float NEG=-INFINITY; int kb=64*jb+4*hi;
  #pragma unroll
  for(int r=0;r<16;++r){int kv=kb+(r&3)+8*(r>>2); if(kv>qrel)p0[r]=NEG; if(kv+32>qrel)p1[r]=NEG;}
}

constexpr int NSLOT=3, SLOTB=8192;
constexpr int LDS_K=0, LDS_V=NSLOT*SLOTB, LDS_WS=2*NSLOT*SLOTB, LDS_OST=LDS_WS+NW*64*4, LDS_CK=LDS_OST+NW*4096, LDS_BYTES=LDS_CK+SEQ*4;
constexpr float C2=0.125f*1.4426950408889634f;
__device__ __forceinline__ void glds16(const void*gsrc,unsigned lds_dst){unsigned keep;
  asm volatile("s_mov_b32 %0, m0\n\ts_mov_b32 m0, %2\n\ts_nop 0\n\tglobal_load_lds_dwordx4 %1, off\n\ts_mov_b32 m0, %0":"=&s"(keep):"v"(gsrc),"s"(lds_dst):"memory");}
__device__ __forceinline__ float max3f(float a,float b,float c){float r;asm("v_max3_f32 %0, %1, %2, %3":"=v"(r):"v"(a),"v"(b),"v"(c));return r;}
__device__ __forceinline__ float max2f(float a,float b){float r;asm("v_max_f32_e32 %0, %1, %2":"=v"(r):"v"(a),"v"(b));return r;}
__device__ __forceinline__ float fadd_s(float a,float b){float r;asm("v_add_f32_e32 %0, %1, %2":"=v"(r):"v"(a),"v"(b));return r;}
__device__ __forceinline__ float fsub_s(float a,float b){float r;asm("v_sub_f32_e32 %0, %1, %2":"=v"(r):"v"(a),"v"(b));return r;}
typedef float f32x4_t __attribute__((ext_vector_type(4))); typedef float f32x2_t __attribute__((ext_vector_type(2))); typedef __bf16 bf16x2_t __attribute__((ext_vector_type(2)));
__device__ __forceinline__ unsigned cvtpk_s(float lo,float hi){f32x2_t v={lo,hi};bf16x2_t b=__builtin_convertvector(v,bf16x2_t);return __builtin_bit_cast(unsigned,b);}
#define WAIT_BAR(N) asm volatile("s_waitcnt vmcnt(" #N ") lgkmcnt(0)\n\ts_barrier":::"memory")

__device__ __forceinline__ void qkt(f32x16&p0,f32x16&p1,const char*Kslot,const bf16x8*qr,int r32,int hi){
  const char*kb=Kslot+hi*1024+r32*16;
  #pragma unroll
  for(int d0=0;d0<4;++d0){
    const bf16x8 b0=*reinterpret_cast<const bf16x8*>(kb+d0*2048);
    const bf16x8 b1=*reinterpret_cast<const bf16x8*>(kb+d0*2048+512);
    {p0=__builtin_amdgcn_mfma_f32_32x32x16_bf16(b0,qr[d0],p0,0,0,0);p1=__builtin_amdgcn_mfma_f32_32x32x16_bf16(b1,qr[d0],p1,0,0,0);}}
}
typedef __attribute__((address_space(3))) const char* lds_cptr;
typedef short v4i16_t __attribute__((ext_vector_type(4)));
__device__ __forceinline__ void kload8(bf16x8*kf,lds_cptr kp){
  kf[0]=*(const __attribute__((address_space(3))) bf16x8*)(kp);      kf[1]=*(const __attribute__((address_space(3))) bf16x8*)(kp+512);
  kf[2]=*(const __attribute__((address_space(3))) bf16x8*)(kp+2048); kf[3]=*(const __attribute__((address_space(3))) bf16x8*)(kp+2560);
  kf[4]=*(const __attribute__((address_space(3))) bf16x8*)(kp+4096); kf[5]=*(const __attribute__((address_space(3))) bf16x8*)(kp+4608);
  kf[6]=*(const __attribute__((address_space(3))) bf16x8*)(kp+6144); kf[7]=*(const __attribute__((address_space(3))) bf16x8*)(kp+6656);
}
__device__ __forceinline__ void kload2(bf16x8*kf,lds_cptr kp,int j){ kf[2*j]=*(const __attribute__((address_space(3))) bf16x8*)(kp+j*2048); kf[2*j+1]=*(const __attribute__((address_space(3))) bf16x8*)(kp+j*2048+512); }
__device__ __forceinline__ s16x4 vtr(lds_cptr p){ return __builtin_bit_cast(s16x4,__builtin_amdgcn_ds_read_tr16_b64_v4i16((__attribute__((address_space(3))) v4i16_t*)p)); }
__device__ __forceinline__ float rowmax(const f32x16&p0,const f32x16&p1){
  float a=max3f(p0[0],p0[1],p1[0]),b=max3f(p0[2],p0[3],p1[1]);a=max3f(a,p1[2],p1[3]);
  #pragma unroll
  for(int r=4;r<16;r+=4){a=max3f(a,p0[r],p0[r+1]);b=max3f(b,p0[r+2],p0[r+3]);a=max3f(a,p1[r],p1[r+1]);b=max3f(b,p1[r+2],p1[r+3]);}
  const float m=max2f(a,b);
  auto rr=__builtin_amdgcn_permlane32_swap(__float_as_uint(m),__float_as_uint(m),false,false);
  return max2f(__uint_as_float(rr[0]),__uint_as_float(rr[1]));
}
__device__ __forceinline__ void pv(f32x16*o,int vb,bf16x8 pa0,bf16x8 pa1,bf16x8 pa2,bf16x8 pa3){
  #pragma unroll
  for(int d0=0;d0<2;++d0){s16x4 lo[4],hi[4];
    #pragma unroll
    for(int ks=0;ks<4;++ks){
      asm volatile("ds_read_b64_tr_b16 %0,%1 offset:%c2":"=&v"(lo[ks]):"v"(vb),"i"(d0*4096+ks*1024):"memory");
      asm volatile("ds_read_b64_tr_b16 %0,%1 offset:%c2":"=&v"(hi[ks]):"v"(vb),"i"(d0*4096+ks*1024+512):"memory");}
    asm volatile("s_waitcnt lgkmcnt(0)":::"memory");SBAR();
    #define PK(k) (bf16x8){lo[k][0],lo[k][1],lo[k][2],lo[k][3],hi[k][0],hi[k][1],hi[k][2],hi[k][3]}
    o[d0]=__builtin_amdgcn_mfma_f32_32x32x16_bf16(pa0,PK(0),o[d0],0,0,0);
    o[d0]=__builtin_amdgcn_mfma_f32_32x32x16_bf16(pa1,PK(1),o[d0],0,0,0);
    o[d0]=__builtin_amdgcn_mfma_f32_32x32x16_bf16(pa2,PK(2),o[d0],0,0,0);
    o[d0]=__builtin_amdgcn_mfma_f32_32x32x16_bf16(pa3,PK(3),o[d0],0,0,0);
    #undef PK
  }
}

#ifndef ATTN_STORE16
#define ATTN_STORE16(p,v) (*(u32x4*)(p)=(v))
#endif
template<int THRL> __device__ __forceinline__ void attn_unit(int b,int h,int qb,const bf16*Q,const bf16*K,const bf16*V,bf16*O,const float*cum,char*shm){
  const int tid=threadIdx.x,lane=tid&63,r32=lane&31,hi=lane>>5; const int wid=__builtin_amdgcn_readfirstlane(tid>>6);
  const long rowbase=(long)b*SEQ; const int q0=qb*QB;
  const bf16*Qw=Q+(rowbase+q0+wid*QBLK)*PQ+h*D;
  const bf16*Kh=K+rowbase*PQ+h*D,*Vh=V+rowbase*PQ+h*D;
  const lds_cptr shm3_=(lds_cptr)shm;
  const unsigned lds0=(unsigned)(uintptr_t)shm;
  float*wsf=(float*)(shm+LDS_WS)+wid*64;
  const bf16*ksrc=Kh+(long)lane*PQ+wid*8;
  const bf16*vsrc=Vh+(long)(16*(wid&3)+(lane>>2))*PQ+(wid>>2)*32+(lane&3)*8;
  const unsigned kdst=lds0+LDS_K+wid*1024, vdst=lds0+LDS_V+wid*1024;
  #define DMA_K(t,slot) glds16(ksrc+(long)(t)*KVBLK*PQ,(unsigned)__builtin_amdgcn_readfirstlane(kdst+(slot)))
  #define DMA_V(t,slot) glds16(vsrc+(long)(t)*KVBLK*PQ,(unsigned)__builtin_amdgcn_readfirstlane(vdst+(slot)))
  const int vb0=(int)(lds0+LDS_V)+((lane>>4)&1)*32+(lane&3)*8+(4*hi+((lane&15)>>2))*64;
  const char*Kbase=shm+LDS_K; bf16x8 kf[8];
  const lds_cptr shm3=(lds_cptr)shm; const lds_cptr kp0=shm3+LDS_K+hi*1024+r32*16; const lds_cptr vp0=shm3+LDS_V+((lane>>4)&1)*32+(lane&3)*8+(4*hi+((lane&15)>>2))*64;
  const int NT=(q0+QB)/KVBLK;
  float cqm;
  { float*cks=(float*)(shm+LDS_CK); for(int i=tid;i<q0+QB;i+=NW*64)cks[i]=cum[i]; cqm=cum[q0+wid*QBLK+r32]; asm volatile("s_waitcnt vmcnt(0)":"+v"(cqm)::"memory"); }
  const __attribute__((address_space(3))) float*ckl=(const __attribute__((address_space(3))) float*)(shm3_+LDS_CK)+4*hi;
  #define BIASFILL(C0_,C1_,t_) do{ const __attribute__((address_space(3))) float*cp_=ckl+64*(t_); \
    _Pragma("unroll") for(int a_=0;a_<4;++a_){ const f32x4_t u_=*(const __attribute__((address_space(3))) f32x4_t*)(cp_+8*a_), w_=*(const __attribute__((address_space(3))) f32x4_t*)(cp_+32+8*a_); \
      _Pragma("unroll") for(int i_=0;i_<4;++i_){ C0_[4*a_+i_]=cqm-u_[i_]; C1_[4*a_+i_]=cqm-w_[i_]; } } }while(0)
  DMA_K(0,0);DMA_V(0,0);DMA_K(1,SLOTB);
  bf16x8 qr[4];
  #pragma unroll
  for(int d0=0;d0<4;++d0)qr[d0]=*reinterpret_cast<const bf16x8*>(&Qw[(long)r32*PQ+d0*16+hi*8]);
  float l_reg=0.f;f32x16 o[2];o[0]=f32x16{};o[1]=f32x16{};
  const int qrel=wid*QBLK+r32;
  #define CMASK(P0,P1,t) do{int jb_=(t)-(NT-4); if(jb_>=0)cmask(P0,P1,jb_,qrel,hi);}while(0)
  bool resc=false;
  #define START(P0,P1) do{ const float rm=rowmax(P0,P1); resc=false; \
    { const float dl=rm; cqm=fsub_s(cqm,dl); \
      _Pragma("unroll") for(int r=0;r<16;++r){P0[r]=fsub_s(P0[r],dl);P1[r]=fsub_s(P1[r],dl);} \
      } \
    _Pragma("unroll") for(int r=0;r<16;++r)P0[r]=__builtin_amdgcn_exp2f(P0[r]); }while(0)
  #define RESC() do{ if(resc){ asm volatile("s_waitcnt lgkmcnt(0)":::"memory"); \
      _Pragma("unroll") for(int d_=0;d_<2;++d_) _Pragma("unroll") for(int r=0;r<16;++r)o[d_][r]*=wsf[crow(r,hi)]; } }while(0)
  f32x16 pA0,pA1,pB0,pB1;
  int sl_prev=0,sl_cur=0,sl_next=SLOTB;
  #define ROT() do{sl_prev=sl_cur;sl_cur=sl_next;sl_next=(sl_next==(NSLOT-1)*SLOTB)?0:sl_next+SLOTB;}while(0)
  DMA_K(2,2*SLOTB);
  WAIT_BAR(3);
  BIASFILL(pA0,pA1,0); qkt(pA0,pA1,Kbase,qr,r32,hi);asm volatile("s_nop 15\n\ts_nop 7":"+v"(pA0),"+v"(pA1));CMASK(pA0,pA1,0);
  START(pA0,pA1);
  _Pragma("unroll") for(int r=0;r<16;++r)pA1[r]=__builtin_amdgcn_exp2f(pA1[r]);
  WAIT_BAR(0);
  DMA_K(3,0);DMA_V(1,SLOTB);
  ROT();
  kload8(kf,kp0+sl_cur);
  WAIT_BAR(2);
  s16x4 vlo[8],vhi[8]; u32x4 pw0,pw1,pw2,pw3;
  #define PKW(P,B) cvtpk_s(P[B],P[B+1])
  #define PAF(k) __builtin_bit_cast(bf16x8,pw##k)
  #define VFR(i) (bf16x8){vlo[i][0],vlo[i][1],vlo[i][2],vlo[i][3],vhi[i][0],vhi[i][1],vhi[i][2],vhi[i][3]}
  #define PIN(x) asm volatile("":"+v"(x))
  #define MX3(a,b,c) __builtin_fmaxf(__builtin_fmaxf((a),(b)),(c))
  #define GAPA(MF,A0,A1,A2,A3,W0,W1,PW) do{ MF; sacc+=A0; sacc+=A1; sacc+=A2; sacc+=A3; PIN(sacc); W0; W1; PIN(PW); SBAR(); }while(0)
  #define EX(v) __builtin_amdgcn_exp2f(v)
  #define GAPB(MF,X,B) do{ MF; X[B]=EX(X[B]); X[B+1]=EX(X[B+1]); X[B+2]=EX(X[B+2]); X[B+3]=EX(X[B+3]); PIN(X); SBAR(); }while(0)
  #define VRD(i) do{ vlo[i]=vtr(vp_+(((i)>>2)*4096+((i)&3)*1024)); vhi[i]=vtr(vp_+(((i)>>2)*4096+((i)&3)*1024+512)); }while(0)
  #define KRD(G,j) do{ if(G){ kload2(kf,kp0+sl_next,j); SBAR(); } }while(0)
  #define STEP(C0,C1,P0,P1,t,GK,GV,GL) do{ BIASFILL(C0,C1,t); SBAR(); \
    const lds_cptr vp_=vp0+sl_prev; \
    VRD(0); SBAR(); float sacc=(P0[0]+P0[1]); \
    GAPA(C0=__builtin_amdgcn_mfma_f32_32x32x16_bf16(kf[0],qr[0],C0,0,0,0), P0[2],P0[3],P0[4],P0[5],     pw0[0]=PKW(P0,0), pw0[1]=PKW(P0,2), pw0); \
    VRD(4); SBAR(); GAPA(C1=__builtin_amdgcn_mfma_f32_32x32x16_bf16(kf[1],qr[0],C1,0,0,0), P0[6],P0[7],P0[8],P0[9],     pw0[2]=PKW(P0,4), pw0[3]=PKW(P0,6), pw0); \
    VRD(1); SBAR(); GAPA(C0=__builtin_amdgcn_mfma_f32_32x32x16_bf16(kf[2],qr[1],C0,0,0,0),   P0[10],P0[11],P0[12],P0[13], pw1[0]=PKW(P0,8), pw1[1]=PKW(P0,10), pw1); \
    VRD(5); SBAR(); GAPA(C1=__builtin_amdgcn_mfma_f32_32x32x16_bf16(kf[3],qr[1],C1,0,0,0),   P0[14],P0[15],P1[0],P1[1],   pw1[2]=PKW(P0,12),pw1[3]=PKW(P0,14), pw1); \
    VRD(2); SBAR(); GAPA(C0=__builtin_amdgcn_mfma_f32_32x32x16_bf16(kf[4],qr[2],C0,0,0,0),   P1[2],P1[3],P1[4],P1[5],     pw2[0]=PKW(P1,0), pw2[1]=PKW(P1,2), pw2); \
    VRD(6); SBAR(); GAPA(C1=__builtin_amdgcn_mfma_f32_32x32x16_bf16(kf[5],qr[2],C1,0,0,0),   P1[6],P1[7],P1[8],P1[9],     pw2[2]=PKW(P1,4), pw2[3]=PKW(P1,6), pw2); \
    VRD(3); SBAR(); GAPA(C0=__builtin_amdgcn_mfma_f32_32x32x16_bf16(kf[6],qr[3],C0,0,0,0),   P1[10],P1[11],P1[12],P1[13], pw3[0]=PKW(P1,8), pw3[1]=PKW(P1,10), pw3); \
    VRD(7); SBAR(); GAPA(C1=__builtin_amdgcn_mfma_f32_32x32x16_bf16(kf[7],qr[3],C1,0,0,0),   P1[14],P1[15],0.f,0.f,       pw3[2]=PKW(P1,12),pw3[3]=PKW(P1,14), pw3); \
    l_reg+=sacc; \
    if(GK){DMA_K((t)+3,sl_cur);} if(GV){DMA_V((t)+1,sl_next);} \
    CMASK(C0,C1,t); \
    { float a=MX3(C0[0],C0[1],C1[0]),b=MX3(C0[2],C0[3],C1[1]); a=MX3(a,C1[2],C1[3]); \
      _Pragma("unroll") for(int r=4;r<16;r+=4){a=MX3(a,C0[r],C0[r+1]);b=MX3(b,C0[r+2],C0[r+3]);a=MX3(a,C1[r],C1[r+1]);b=MX3(b,C1[r+2],C1[r+3]);} \
      float rm=__builtin_fmaxf(a,b); { auto rr=__builtin_amdgcn_permlane32_swap(__float_as_uint(rm),__float_as_uint(rm),false,false); rm=__builtin_fmaxf(__uint_as_float(rr[0]),__uint_as_float(rr[1])); } \
      resc=false; \
      if(__builtin_expect(__any(rm>(float)THRL),0)){ const float dl=__builtin_fmaxf(rm,0.f); cqm-=dl; \
        _Pragma("unroll") for(int r=0;r<16;++r){C0[r]-=dl;C1[r]-=dl;} \
        const float f=__builtin_amdgcn_exp2f(-dl); l_reg*=f; if(hi==0)wsf[r32]=f; resc=true; } } \
    SBAR(); \
    GAPB(o[0]=__builtin_amdgcn_mfma_f32_32x32x16_bf16(PAF(0),VFR(0),o[0],0,0,0), C0,0); \
    GAPB(o[1]=__builtin_amdgcn_mfma_f32_32x32x16_bf16(PAF(0),VFR(4),o[1],0,0,0), C0,4); \
    KRD(GL,0); GAPB(o[0]=__builtin_amdgcn_mfma_f32_32x32x16_bf16(PAF(1),VFR(1),o[0],0,0,0), C0,8); \
    KRD(GL,1); GAPB(o[1]=__builtin_amdgcn_mfma_f32_32x32x16_bf16(PAF(1),VFR(5),o[1],0,0,0), C0,12); \
    KRD(GL,2); GAPB(o[0]=__builtin_amdgcn_mfma_f32_32x32x16_bf16(PAF(2),VFR(2),o[0],0,0,0), C1,0); \
    KRD(GL,3); GAPB(o[1]=__builtin_amdgcn_mfma_f32_32x32x16_bf16(PAF(2),VFR(6),o[1],0,0,0), C1,4); \
    GAPB(o[0]=__builtin_amdgcn_mfma_f32_32x32x16_bf16(PAF(3),VFR(3),o[0],0,0,0), C1,8); \
    GAPB(o[1]=__builtin_amdgcn_mfma_f32_32x32x16_bf16(PAF(3),VFR(7),o[1],0,0,0), C1,12); \
    }while(0)
  int t=1;
  #undef CMASK
  #define CMASK(P0,P1,t) do{}while(0)
  for(;t+5<NT;t+=2){
    STEP(pB0,pB1,pA0,pA1,t,true,true,true);     WAIT_BAR(2); RESC(); ROT();
    STEP(pA0,pA1,pB0,pB1,t+1,true,true,true);   WAIT_BAR(2); RESC(); ROT();
  }
  #undef CMASK
  #define CMASK(P0,P1,t) do{int jb_=(t)-(NT-4); if(jb_>=0)cmask(P0,P1,jb_,qrel,hi);}while(0)
  #define ENDW(tt) do{ if((tt)+3<NT){WAIT_BAR(2);} else if((tt)+2<NT){WAIT_BAR(1);} else {WAIT_BAR(0);} }while(0)
  for(;t+1<NT;t+=2){
    STEP(pB0,pB1,pA0,pA1,t,(t+3<NT),(t+1<NT),(t+1<NT));       ENDW(t);   RESC(); ROT();
    STEP(pA0,pA1,pB0,pB1,t+1,(t+4<NT),(t+2<NT),(t+2<NT));     ENDW(t+1); RESC(); ROT();
  }
  STEP(pB0,pB1,pA0,pA1,NT-1,false,false,false); RESC();
  { float sacc=pB0[0]+pB0[1]; _Pragma("unroll") for(int r=2;r<16;++r)sacc+=pB0[r]; _Pragma("unroll") for(int r=0;r<16;++r)sacc+=pB1[r]; l_reg+=sacc;
    pw0=(u32x4){PKW(pB0,0),PKW(pB0,2),PKW(pB0,4),PKW(pB0,6)};pw1=(u32x4){PKW(pB0,8),PKW(pB0,10),PKW(pB0,12),PKW(pB0,14)};pw2=(u32x4){PKW(pB1,0),PKW(pB1,2),PKW(pB1,4),PKW(pB1,6)};pw3=(u32x4){PKW(pB1,8),PKW(pB1,10),PKW(pB1,12),PKW(pB1,14)};
    SBAR(); pv(o,vb0+sl_cur,PAF(0),PAF(1),PAF(2),PAF(3)); }
  #undef PKW
  #undef PAF
  #undef VFR
  #undef PIN
  #undef MX3
  #undef GAPA
  #undef GAPB
  #undef EX
  #undef VRD
  #undef KRD
  #undef STEP
  #undef ENDW
  {auto rr=__builtin_amdgcn_permlane32_swap(__float_as_uint(l_reg),__float_as_uint(l_reg),false,false);l_reg=__uint_as_float(rr[0])+__uint_as_float(rr[1]);}
  if(hi==0)wsf[32+r32]=l_reg;asm volatile("s_waitcnt lgkmcnt(0)":::"memory");
  float rli[16];
  #pragma unroll
  for(int r=0;r<16;++r)rli[r]=__builtin_amdgcn_rcpf(wsf[32+crow(r,hi)]);
  bf16*Ow=O+(rowbase+q0+wid*QBLK)*PO+h*D;
  { bf16*stg=(bf16*)(shm+LDS_OST)+wid*2048;
    #pragma unroll
    for(int r=0;r<16;++r){const int orow=crow(r,hi);
      #pragma unroll
      for(int d0=0;d0<2;++d0)stg[orow*64+d0*32+r32]=__float2bfloat16(o[d0][r]*rli[r]);}
    asm volatile("s_waitcnt lgkmcnt(0)":::"memory");
    #pragma unroll
    for(int i=0;i<4;++i){const int row=i*8+(lane>>3),ch=lane&7; const u32x4 v=*(const u32x4*)(stg+row*64+ch*8); ATTN_STORE16(Ow+(long)row*PO+ch*8,v);} }
  asm volatile("s_waitcnt lgkmcnt(0)\n\ts_barrier":::"memory");
  #undef DMA_K
  #undef BIASFILL
  #undef DMA_V
  #undef CMASK
  #undef START
  #undef RESC
  #undef ROT
}
constexpr int ATTN_LDS_BYTES=LDS_BYTES;
struct AttnTensors { const bf16* Q; const bf16* K; const bf16* V; bf16* O; const float* cum; };
struct AttnUnit { int bh; int qb; };
struct StaticOrder {
  int vcu, G;
  __device__ __forceinline__ explicit StaticOrder(int grid,int v):vcu(v),G(grid){}
  __device__ __forceinline__ bool next(int i,AttnUnit&u)const{ const int pr=vcu+(i>>1)*G; if(pr>=256)return false; const int s=pr&3; u.bh=pr>>2; u.qb=(i&1)?7-s:s; return true; }
  __device__ __forceinline__ void a_ready(const AttnUnit&)const{}
  __device__ __forceinline__ void done(const AttnUnit&)const{}
};
template<class Sched,int THRL=8> __device__ __forceinline__ void attn_phase(char*lds,const AttnTensors&T,const Sched&S){
  AttnUnit u;
  for(int i=0;S.next(i,u);++i){ S.a_ready(u); attn_unit<THRL>(u.bh/NHEAD,u.bh%NHEAD,u.qb,T.Q,T.K,T.V,T.O,T.cum+(long)u.bh*SEQ,lds); S.done(u); }
}
#undef SBAR
#undef WAIT_BAR
}
constexpr int NWAVES = 8;
constexpr int T = 16384, D = 1024, SEQ = 2048, NBATCH = 8, DEPTH = 4;
constexpr float ALPHA = 1.6817928305074290f;
constexpr float LN_EPS = 1e-5f;
constexpr int AB_IN = 4112, CD_IN = 3600, NPE = 4096, NPO = 3584;
constexpr float LOG2E = 1.4426950408889634f;
constexpr float FOX_C2 = 0.125f * LOG2E;
constexpr float MLSTM_KSCALE = 0.08838834764831845f;
constexpr int RPAD = 40960;
constexpr int NPH_LAYER = 12, NPHASES = 1 + DEPTH * NPH_LAYER;
#ifndef MK_ONE_LAUNCH
#define MK_ONE_LAUNCH 1
#endif

constexpr size_t MiB = 1u << 20, KiB = 1u << 10;
constexpr size_t WS_CTL = 0, CTL_ZERO_BYTES = 1 * MiB;
constexpr size_t WS_BCNT = 1 * MiB, WS_PANEL = WS_BCNT + 64 * KiB, WS_ROUTE = WS_BCNT + 128 * KiB, WS_GATE = WS_BCNT + 384 * KiB, WS_POS = WS_BCNT + 512 * KiB,
                 WS_DEC = WS_BCNT + 640 * KiB, WS_MLOC = WS_BCNT + 704 * KiB, WS_BLAST = WS_BCNT + 712 * KiB, WS_MPREV = WS_BCNT + 720 * KiB,
                 WS_FOXC = 2 * MiB, WS_NLOC = 2 * MiB + 512 * KiB, WS_SG = 3 * MiB;
constexpr size_t WS_WINE = 4 * MiB, WS_WINO = 20 * MiB, WS_WOUTE = 34 * MiB, WS_WOUTO = 40 * MiB, WS_WGU = 44 * MiB, WS_WD = 300 * MiB;
constexpr size_t WS_HF = 428 * MiB, WS_HB = 492 * MiB, WS_H1F = 524 * MiB, WS_H1B = 588 * MiB;
constexpr size_t WS_R1 = 620 * MiB;
constexpr size_t WS_R2 = 748 * MiB;
constexpr size_t WS_R3 = 812 * MiB;
constexpr size_t WS_R4 = 860 * MiB;
constexpr size_t WS_MIX = 892 * MiB;
constexpr size_t WS_TAB = 940 * MiB, TAB_LAYER = 208 * KiB, TAB_GPW = 0, TAB_RGW = 64 * KiB, TAB_REW = 80 * KiB;
constexpr size_t WS_END = 941 * MiB;
constexpr int CW_BAR = 4096;

constexpr int RING_BYTES = 131072, SMALL_OFF = RING_BYTES, SMALL_BYTES = 8192, MISC_OFF = SMALL_OFF + SMALL_BYTES, LDS_BYTES = 147456;

#define GAS __attribute__((address_space(1)))
#define LAS __attribute__((address_space(3)))
typedef unsigned short bf16;
typedef unsigned v4u __attribute__((ext_vector_type(4)));
typedef unsigned v2u __attribute__((ext_vector_type(2)));
typedef float f32x4 __attribute__((ext_vector_type(4)));
typedef float f32x2 __attribute__((ext_vector_type(2)));
typedef int i32x4 __attribute__((ext_vector_type(4)));
typedef int i32x2 __attribute__((ext_vector_type(2)));
#define LDS_WAIT() asm volatile("s_waitcnt lgkmcnt(0)" ::: "memory")
__device__ __forceinline__ unsigned f2bf(float f) { unsigned u = __builtin_bit_cast(unsigned, f); return (u + 0x7fffu + ((u >> 16) & 1u)) >> 16; }
typedef __bf16 bf16x2_t __attribute__((ext_vector_type(2)));
__device__ __forceinline__ unsigned cvtpk(float lo, float hi) { const f32x2 v = {lo, hi}; const bf16x2_t b = __builtin_convertvector(v, bf16x2_t); return __builtin_bit_cast(unsigned, b); }
__device__ __forceinline__ unsigned pk2(float lo, float hi) { return cvtpk(lo, hi); }
__device__ __forceinline__ float bflo(unsigned w) { return __builtin_bit_cast(float, w << 16); }
__device__ __forceinline__ float bfhi(unsigned w) { return __builtin_bit_cast(float, w & 0xffff0000u); }
__device__ __forceinline__ float bf2f(bf16 b) { return __builtin_bit_cast(float, (unsigned)b << 16); }
__device__ __forceinline__ float wave_sum(float v) {
#pragma unroll
    for (int o = 1; o < 64; o <<= 1) v += __shfl_xor(v, o);
    return v;
}
__device__ __forceinline__ float wave_max(float v) {
#pragma unroll
    for (int o = 1; o < 64; o <<= 1) v = fmaxf(v, __shfl_xor(v, o));
    return v;
}
__device__ __forceinline__ float wave_scan_sum(float v, int lane) {
#pragma unroll
    for (int o = 1; o < 64; o <<= 1) { const float t = __shfl_up(v, o); if (lane >= o) v += t; }
    return v;
}
__device__ __forceinline__ float wave_scan_max(float v, int lane) {
#pragma unroll
    for (int o = 1; o < 64; o <<= 1) { const float t = __shfl_up(v, o); if (lane >= o) v = fmaxf(v, t); }
    return v;
}
__device__ __forceinline__ float softplus_f(float x) { return x > 20.f ? x : log1pf(expf(x)); }
__device__ __forceinline__ float logsigmoid_f(float x) { return fminf(x, 0.f) - log1pf(expf(-fabsf(x))); }
__device__ __forceinline__ float sigmoid_f(float x) { return 1.0f / (1.0f + expf(-x)); }
#define XB_TMO      128
#define XB_XCNT(j)  (256  + 64 * (j))
#define XB_XSUB(j)  (1280 + 64 * (j))
#define XB_XGEN(j)  (2304 + 64 * (j))
#define XB_TOP      3328
#define XB_TOPGEN   3392
#define XCD_BAR_WORDS 3456
#define XB_SPIN_CAP (1u << 18)

__device__ __forceinline__ unsigned xb_ld(unsigned* p)              { return __hip_atomic_load(p, __ATOMIC_RELAXED, __HIP_MEMORY_SCOPE_AGENT); }
__device__ __forceinline__ unsigned xb_add(unsigned* p, unsigned v) { return __hip_atomic_fetch_add(p, v, __ATOMIC_RELAXED, __HIP_MEMORY_SCOPE_AGENT); }
__device__ __forceinline__ unsigned xb_xcc_id() { return (unsigned)__builtin_amdgcn_s_getreg((3 << 11) | 20) & 0xFu; }
#define XB_SPIN(cond, bar) do { unsigned _sp = 0; while (cond) { __builtin_amdgcn_s_sleep(1); \
    if ((++_sp & 255u) == 0u) { if (xb_ld(&(bar)[XB_TMO])) break; if (_sp > XB_SPIN_CAP) { atomicAdd(&(bar)[XB_TMO], 1u); break; } } } } while (0)

struct XcdBarrier {
    unsigned* bar; unsigned x;
    volatile LAS unsigned* st;
};

__device__ __forceinline__ XcdBarrier xcd_barrier_post(unsigned* bar, volatile LAS unsigned* st) {
    XcdBarrier b; b.bar = bar; b.x = xb_xcc_id(); b.st = st;
    if (threadIdx.x == 0) (void)xb_add(&bar[XB_XCNT(b.x)], 1u);
    return b;
}
__device__ __forceinline__ void xcd_barrier_complete(unsigned* bar, unsigned x, unsigned& nloc, unsigned& nx) {
    const unsigned G = gridDim.x * gridDim.y * gridDim.z;
    unsigned sum, cnt, mine, sp = 0u;
    for (;;) {
        sum = 0u; cnt = 0u; mine = 0u;
#pragma unroll
        for (unsigned j = 0; j < 16; ++j) { const unsigned c = xb_ld(&bar[XB_XCNT(j)]); sum += c; cnt += (c > 0u) ? 1u : 0u; mine = (j == x) ? c : mine; }
        if (sum == G) break;
        __builtin_amdgcn_s_sleep(1);
        if ((++sp & 255u) == 0u) { if (xb_ld(&bar[XB_TMO])) break; if (sp > XB_SPIN_CAP) { atomicAdd(&bar[XB_TMO], 1u); break; } }
    }
    nloc = mine > 0u ? mine : 1u; nx = cnt > 0u ? cnt : 1u;
}

__device__ __forceinline__ void xcd_barrier(const XcdBarrier& b) {
    asm volatile("s_waitcnt vmcnt(0)" ::: "memory");
    __syncthreads();
    if (threadIdx.x == 0) {
        unsigned* bar = b.bar;
        __builtin_amdgcn_s_waitcnt(0);
        unsigned nloc = b.st[0], nx = b.st[1];
        if (nloc == 0u) { xcd_barrier_complete(bar, b.x, nloc, nx); b.st[0] = nloc; b.st[1] = nx; }
        const unsigned old = xb_add(&bar[XB_XSUB(b.x)], 1u);
        const unsigned gen = old / nloc;
        if (old + 1u == (gen + 1u) * nloc) {
            __builtin_amdgcn_fence(__ATOMIC_RELEASE, "agent");
            asm volatile("s_waitcnt vmcnt(0)" ::: "memory");
            const unsigned og = xb_add(&bar[XB_TOP], 1u);
            const unsigned tg = og / nx;
            if (og + 1u == (tg + 1u) * nx) xb_add(&bar[XB_TOPGEN], 1u);
            else XB_SPIN(xb_ld(&bar[XB_TOPGEN]) == tg, bar);
            __builtin_amdgcn_fence(__ATOMIC_ACQUIRE, "agent");
            xb_add(&bar[XB_XGEN(b.x)], 1u);
            asm volatile("s_waitcnt vmcnt(0)" ::: "memory");
        } else {
            XB_SPIN(xb_ld(&bar[XB_XGEN(b.x)]) == gen, bar);
            __builtin_amdgcn_fence(__ATOMIC_ACQUIRE, "agent");
            asm volatile("s_waitcnt vmcnt(0)" ::: "memory");
        }
    }
    __syncthreads();
}
struct Frame {
    LAS unsigned char* lds;
    volatile LAS unsigned* MISC;
    unsigned* ctl;
    int tid, lane, wave, vcu, G, gw, NGW;
};
typedef const float* const cfpc_t; typedef __attribute__((address_space(4))) cfpc_t* kargp_t;
__device__ __forceinline__ kargp_t kin() { kargp_t p = (kargp_t)__builtin_amdgcn_kernarg_segment_ptr(); asm volatile("" : "+s"(p)); return p; }
#define KIN(i) (kin()[i])
typedef unsigned char* const ucpc_t; typedef __attribute__((address_space(4))) ucpc_t* kargu_t;
__device__ __forceinline__ unsigned char* kws() { return ((kargu_t)kin())[28]; }
__device__ __forceinline__ float* kout() { return (float*)((kargu_t)kin())[27]; }
enum { I_X = 0, I_ABWIN, I_CONVA, I_CONVW, I_CONVB, I_DTB, I_ALOG, I_DSKIP, I_NORMW, I_ABWOUT, I_CDWIN, I_IB, I_FB, I_HNW, I_FOXB, I_CDWOUT, I_LN1G, I_LN1B, I_LN2G, I_LN2B,
       I_RGW, I_RGB, I_REW, I_REB, I_WG, I_WU, I_WDN };

__device__ __forceinline__ void row_load(const float* row, int lane, f32x4 (&v)[4]) {
#pragma unroll
    for (int j = 0; j < 4; ++j) v[j] = ((const f32x4*)row)[lane + 64 * j];
}
__device__ __forceinline__ void row_store_f32(float* row, int lane, const f32x4 (&v)[4]) {
#pragma unroll
    for (int j = 0; j < 4; ++j) ((f32x4*)row)[lane + 64 * j] = v[j];
}
__device__ __forceinline__ void row_store_bf16(bf16* row, int lane, const f32x4 (&v)[4]) {
#pragma unroll
    for (int j = 0; j < 4; ++j) { v2u w; w.x = pk2(v[j][0], v[j][1]); w.y = pk2(v[j][2], v[j][3]); ((v2u*)row)[lane + 64 * j] = w; }
}
__device__ __forceinline__ void row_load_bf16(const bf16* row, int lane, f32x4 (&v)[4]) {
#pragma unroll
    for (int j = 0; j < 4; ++j) { const v2u w = ((const v2u*)row)[lane + 64 * j]; v[j] = (f32x4){bflo(w.x), bfhi(w.x), bflo(w.y), bfhi(w.y)}; }
}
__device__ __forceinline__ void dma1k(const void* gsrc, unsigned lds_dst) { unsigned keep;
    asm volatile("s_mov_b32 %0, m0\n\ts_mov_b32 m0, %2\n\ts_nop 0\n\tglobal_load_lds_dwordx4 %1, off\n\ts_mov_b32 m0, %0" : "=&s"(keep) : "v"(gsrc), "s"(lds_dst) : "memory"); }
template <int KB> __device__ __forceinline__ void row_dma(const void* grow, unsigned lds_dst, int lane) {
#pragma unroll
    for (int i = 0; i < KB; ++i) dma1k((const char*)grow + 1024 * i + 16 * lane, (unsigned)__builtin_amdgcn_readfirstlane(lds_dst + 1024 * i));
}
#define DMA_WAIT_ALL() asm volatile("s_waitcnt vmcnt(0)" ::: "memory")
__device__ __forceinline__ void row_load_bf16_lds(const LAS unsigned char* row, int lane, f32x4 (&v)[4]) {
#pragma unroll
    for (int j = 0; j < 4; ++j) { const v2u w = ((const LAS v2u*)row)[lane + 64 * j]; v[j] = (f32x4){bflo(w.x), bfhi(w.x), bflo(w.y), bfhi(w.y)}; }
}
__device__ __forceinline__ void row_load_f32_lds(const LAS unsigned char* row, int lane, f32x4 (&v)[4]) {
#pragma unroll
    for (int j = 0; j < 4; ++j) v[j] = ((const LAS f32x4*)row)[lane + 64 * j];
}
__device__ __forceinline__ void row_layernorm(f32x4 (&v)[4], const float* g, const float* b, int lane) {
    float s = 0.f;
#pragma unroll
    for (int j = 0; j < 4; ++j) s += (v[j][0] + v[j][1]) + (v[j][2] + v[j][3]);
    const float mean = wave_sum(s) * (1.f / D); float s2 = 0.f;
#pragma unroll
    for (int j = 0; j < 4; ++j) { v[j] = v[j] - mean; s2 += (v[j][0] * v[j][0] + v[j][1] * v[j][1]) + (v[j][2] * v[j][2] + v[j][3] * v[j][3]); }
    const float rstd = 1.0f / sqrtf(wave_sum(s2) * (1.f / D) + LN_EPS);
#pragma unroll
    for (int j = 0; j < 4; ++j) { const f32x4 gg = ((const f32x4*)g)[lane + 64 * j], bb = ((const f32x4*)b)[lane + 64 * j]; v[j] = v[j] * rstd * gg + bb; }
}
template <int n, int o, int N> struct RedStep {
    static __device__ __forceinline__ void run(float (&a)[N], int lane) { const bool up = (lane & o) != 0;
#pragma unroll
        for (int i = 0; i < n / 2; ++i) { const float keep = up ? a[i + n / 2] : a[i], send = up ? a[i] : a[i + n / 2]; a[i] = keep + __shfl_xor(send, o); }
        RedStep<n / 2, o / 2, N>::run(a, lane); }
};
template <int o, int N> struct RedStep<1, o, N> {
    static __device__ __forceinline__ void run(float (&a)[N], int) { float r = a[0];
#pragma unroll
        for (int oo = o; oo >= 1; oo >>= 1) r += __shfl_xor(r, oo);
        a[0] = r; }
};
template <int N> __device__ __forceinline__ float wave_reduce_multi(float (&a)[N], int lane) { RedStep<N, 32, N>::run(a, lane); return a[0]; }
__device__ __forceinline__ void row_proj16x2(const f32x4 (&v0)[4], const f32x4 (&v1)[4], const f32x4* TB, float* sg0, float* sg1, int lane) {
    float a[16], b[16];
#pragma unroll
    for (int c = 0; c < 16; ++c) { a[c] = 0.f; b[c] = 0.f; }
#pragma unroll
    for (int j = 0; j < 4; ++j)
#pragma unroll
        for (int i = 0; i < 4; ++i) { const float x = v0[j][i], y = v1[j][i]; const f32x4* tb = TB + (size_t)((j * 4 + i) * 4) * 64 + lane;
            const f32x4 w0 = tb[0], w1 = tb[64], w2 = tb[128], w3 = tb[192];
#pragma unroll
            for (int c = 0; c < 4; ++c) { a[c] += x * w0[c]; a[4 + c] += x * w1[c]; a[8 + c] += x * w2[c]; a[12 + c] += x * w3[c]; b[c] += y * w0[c]; b[4 + c] += y * w1[c]; b[8 + c] += y * w2[c]; b[12 + c] += y * w3[c]; } }
    const float r0 = wave_reduce_multi<16>(a, lane), r1 = wave_reduce_multi<16>(b, lane);
    if ((lane & 3) == 0) { sg0[lane >> 2] = r0; if (sg1) sg1[lane >> 2] = r1; }
}
__device__ __forceinline__ void row_gate_proj2(Frame& F, const f32x4 (&v0)[4], const f32x4 (&v1)[4], int layer, int m0, int m1) {
    float* sg0 = (float*)(kws() + WS_SG) + (size_t)m0 * 16; float* sg1 = m1 >= 0 ? (float*)(kws() + WS_SG) + (size_t)m1 * 16 : nullptr;
    row_proj16x2(v0, v1, (const f32x4*)(kws() + WS_TAB + (size_t)layer * TAB_LAYER + TAB_GPW), sg0, sg1, F.lane);
}

__device__ __forceinline__ void row_gate_proj2_lds(Frame& F, const f32x4 (&v0)[4], const f32x4 (&v1)[4], const LAS f32x4* TB, int m0, int m1) {
    float* sg0 = (float*)(kws() + WS_SG) + (size_t)m0 * 16; float* sg1 = m1 >= 0 ? (float*)(kws() + WS_SG) + (size_t)m1 * 16 : nullptr;
    float a[16], b[16];
#pragma unroll
    for (int c = 0; c < 16; ++c) { a[c] = 0.f; b[c] = 0.f; }
#pragma unroll
    for (int j = 0; j < 4; ++j)
#pragma unroll
        for (int i = 0; i < 4; ++i) { const float x = v0[j][i], y = v1[j][i]; const LAS f32x4* tb = TB + ((j * 4 + i) * 4) * 64 + F.lane;
            const f32x4 w0 = tb[0], w1 = tb[64], w2 = tb[128], w3 = tb[192];
#pragma unroll
            for (int c = 0; c < 4; ++c) { a[c] += x * w0[c]; a[4 + c] += x * w1[c]; a[8 + c] += x * w2[c]; a[12 + c] += x * w3[c]; b[c] += y * w0[c]; b[4 + c] += y * w1[c]; b[8 + c] += y * w2[c]; b[12 + c] += y * w3[c]; } }
    const float r0 = wave_reduce_multi<16>(a, F.lane), r1 = wave_reduce_multi<16>(b, F.lane);
    if ((F.lane & 3) == 0) { sg0[F.lane >> 2] = r0; if (sg1) sg1[F.lane >> 2] = r1; }
}
struct TDesc { const float* src; bf16* dst; const float* ks; int ldw, ldt; float scale; };
__device__ __forceinline__ void tload(const TDesc& d, int lane, f32x4 (&v)[8]) { const int rs = lane >> 3, c4 = 4 * (lane & 7);
#pragma unroll
    for (int i = 0; i < 8; ++i) v[i] = *(const f32x4*)(d.src + (size_t)(8 * i + rs) * d.ldw + c4);
}
template <bool KS> __device__ __forceinline__ void tfinish(const TDesc& d, const f32x4 (&v)[8], LAS float* scr, int lane) { const int rs = lane >> 3, c4 = 4 * (lane & 7);
#pragma unroll
    for (int i = 0; i < 8; ++i) { const int kk = 8 * i + rs; float sc = d.scale; if constexpr (KS) { if (d.ks) sc *= d.ks[kk]; } LAS float* p = scr + kk * 33 + c4;
        p[0] = v[i][0] * sc; p[1] = v[i][1] * sc; p[2] = v[i][2] * sc; p[3] = v[i][3] * sc; }
    LDS_WAIT(); asm volatile("" ::: "memory");
    const int c = lane & 7;
#pragma unroll
    for (int j = 0; j < 4; ++j) { const int n = (lane >> 3) + 8 * j; const LAS float* s = scr + (8 * c) * 33 + n;
        v4u o; o.x = cvtpk(s[0 * 33], s[1 * 33]); o.y = cvtpk(s[2 * 33], s[3 * 33]); o.z = cvtpk(s[4 * 33], s[5 * 33]); o.w = cvtpk(s[6 * 33], s[7 * 33]);
        *(v4u*)(d.dst + (size_t)n * d.ldt + 8 * c) = o; }
    LDS_WAIT(); asm volatile("" ::: "memory");
}
constexpr int N_WINE = 2 * 2048, N_WINO = 2 * 1792, N_WOE = 2 * 768, N_WOO = 2 * 512, N_GU = 128 * 512, N_D = 128 * 256, N_TITEMS = N_WINE + N_WINO + N_WOE + N_WOO + N_GU + N_D;
__device__ __forceinline__ void tdecode(int it, TDesc& d) {
    bf16* WinE = (bf16*)(kws() + WS_WINE); bf16* WinO = (bf16*)(kws() + WS_WINO); bf16* WoutE = (bf16*)(kws() + WS_WOUTE); bf16* WoutO = (bf16*)(kws() + WS_WOUTO);
    bf16* Wgu = (bf16*)(kws() + WS_WGU); bf16* Wd = (bf16*)(kws() + WS_WD);
    int r = it; d.ks = nullptr; d.scale = 1.f;
    if (r < N_WINE) { const int j = r / 2048, q = r % 2048, kb = q / 128, nb = q % 128;
        d.src = KIN(I_ABWIN) + (size_t)j * D * AB_IN + (size_t)(64 * kb) * AB_IN + 32 * nb; d.ldw = AB_IN; d.dst = WinE + (size_t)j * NPE * D + (size_t)(32 * nb) * D + 64 * kb; d.ldt = D; return; } r -= N_WINE;
    if (r < N_WINO) { const int j = r / 1792, q = r % 1792, seg = q / 256, q2 = q % 256, kb = q2 / 16, nb = q2 % 16;
        const int scol = (seg < 3 ? 512 * seg : 1544 + 512 * (seg - 3)) + 32 * nb; d.scale = seg == 1 ? MLSTM_KSCALE : (seg == 4 ? FOX_C2 : 1.f);
        d.src = KIN(I_CDWIN) + (size_t)j * D * CD_IN + (size_t)(64 * kb) * CD_IN + scol; d.ldw = CD_IN; d.dst = WinO + (size_t)j * NPO * D + (size_t)(512 * seg + 32 * nb) * D + 64 * kb; d.ldt = D; return; } r -= N_WINO;
    if (r < N_WOE) { const int j = r / 768, q = r % 768, kb = q / 32, nb = q % 32;
        d.ks = kb >= 8 ? KIN(I_NORMW) + (size_t)j * 1024 + (64 * kb - 512) : nullptr;
        d.src = KIN(I_ABWOUT) + (size_t)j * 1536 * D + (size_t)(64 * kb) * D + 32 * nb; d.ldw = D; d.dst = WoutE + (size_t)j * D * 1536 + (size_t)(32 * nb) * 1536 + 64 * kb; d.ldt = 1536; return; } r -= N_WOE;
    if (r < N_WOO) { const int j = r / 512, q = r % 512, kb = q / 32, nb = q % 32;
        d.src = KIN(I_CDWOUT) + (size_t)j * D * D + (size_t)(64 * kb) * D + 32 * nb; d.ldw = D; d.dst = WoutO + (size_t)j * D * D + (size_t)(32 * nb) * D + 64 * kb; d.ldt = D; return; } r -= N_WOO;
    if (r < N_GU) { const int le = r / 512, q = r % 512, half = q / 256, q2 = q % 256, kb = q2 % 16, nb = q2 / 16, n0 = 32 * nb;
        d.src = (half ? KIN(I_WU) : KIN(I_WG)) + (size_t)le * D * 512 + (size_t)(64 * kb) * 512 + n0; d.ldw = 512;
        d.dst = Wgu + (size_t)le * D * D + (size_t)(256 * (n0 / 128) + 128 * half + (n0 % 128)) * D + 64 * kb; d.ldt = D; return; } r -= N_GU;
    { const int le = r / 256, q = r % 256, kb = q % 8, nb = q / 8;
        d.src = KIN(I_WDN) + (size_t)le * 512 * D + (size_t)(64 * kb) * D + 32 * nb; d.ldw = D; d.dst = Wd + (size_t)le * D * 512 + (size_t)(32 * nb) * 512 + 64 * kb; d.ldt = 512; }
}
__device__ __forceinline__ void p_prologue(Frame& F0) {   Frame F = F0; asm volatile("" : "+v"(F.tid), "+v"(F.lane));
    LAS float* scr = (LAS float*)(F.lds + F.wave * 16384);
    constexpr int KS_LO = N_WINE + N_WINO, KS_HI = KS_LO + N_WOE, N_PIPE = N_TITEMS - N_WOE;
#define PIPE_ITEM(q_) ((q_) < KS_LO ? (q_) : (q_) + N_WOE)
    { int q = F.gw; TDesc dA, dB; f32x4 vA[8], vB[8];
        { const int qc = q < N_PIPE ? q : N_PIPE - 1; tdecode(PIPE_ITEM(qc), dA); tload(dA, F.lane, vA); }
#pragma unroll 1
        while (q < N_PIPE) {
            const int qn = q + F.NGW; { const int qc = qn < N_PIPE ? qn : N_PIPE - 1; tdecode(PIPE_ITEM(qc), dB); tload(dB, F.lane, vB); }
            tfinish<false>(dA, vA, scr, F.lane);
            if (qn >= N_PIPE) break;
            q = qn + F.NGW; { const int qc = q < N_PIPE ? q : N_PIPE - 1; tdecode(PIPE_ITEM(qc), dA); tload(dA, F.lane, vA); }
            tfinish<false>(dB, vB, scr, F.lane); } }
#undef PIPE_ITEM
    asm volatile("s_waitcnt vmcnt(0)" ::: "memory");
    for (int it = KS_LO + F.gw; it < KS_HI; it += F.NGW) { TDesc d; f32x4 v[8]; tdecode(it, d); tload(d, F.lane, v); tfinish<true>(d, v, scr, F.lane); }
    for (int e = F.vcu * 512 + F.tid; e < DEPTH * 13312; e += F.G * 512) { const int L = e / 13312, r = e % 13312, ln = r & 63; f32x4* tab = (f32x4*)(kws() + WS_TAB + (size_t)L * TAB_LAYER);
        if (r < 4096) { const int ch = (r >> 6) & 3, ji = r >> 8, k = 256 * (ji >> 2) + 4 * ln + (ji & 3); const int jj = L >> 1;
            const float* src = (L & 1) ? KIN(I_CDWIN) + (size_t)jj * D * CD_IN + (size_t)k * CD_IN + (ch < 2 ? 1536 + 4 * ch : 3592 + 4 * (ch - 2)) : KIN(I_ABWIN) + (size_t)jj * D * AB_IN + (size_t)k * AB_IN + 4096 + 4 * ch;
            tab[TAB_GPW / 16 + r] = *(const f32x4*)src; }
        else if (r < 5120) { const int q = r - 4096, ji = q >> 6, k = 256 * (ji >> 2) + 4 * ln + (ji & 3); tab[TAB_RGW / 16 + q] = *(const f32x4*)(KIN(I_RGW) + (size_t)L * D * 4 + (size_t)k * 4); }
        else { const int q = r - 5120, half = (q >> 6) & 1, ji = (q >> 7) & 15, g = q >> 11, k = 256 * (ji >> 2) + 4 * ln + (ji & 3); tab[TAB_REW / 16 + q] = *(const f32x4*)(KIN(I_REW) + ((size_t)(L * 4 + g) * D + k) * 8 + 4 * half); } }
    bf16* HB = (bf16*)(kws() + WS_HB);
    __syncthreads();
    LAS f32x4* TBL = (LAS f32x4*)F.lds;
    for (int r = F.tid; r < 4096; r += 512) { const int ln = r & 63, ch = (r >> 6) & 3, ji = r >> 8, k = 256 * (ji >> 2) + 4 * ln + (ji & 3); TBL[r] = *(const f32x4*)(KIN(I_ABWIN) + (size_t)k * AB_IN + 4096 + 4 * ch); }
    __syncthreads();
#pragma unroll 1
    for (int m0 = F.gw; m0 < T; m0 += 2 * F.NGW) { const int m1 = m0 + F.NGW < T ? m0 + F.NGW : -1, m1c = m1 >= 0 ? m1 : m0; f32x4 v0[4], v1[4];
        row_load(KIN(I_X) + (size_t)m0 * D, F.lane, v0); row_load(KIN(I_X) + (size_t)m1c * D, F.lane, v1);
        row_store_bf16(HB + (size_t)m0 * D, F.lane, v0); if (m1 >= 0) row_store_bf16(HB + (size_t)m1 * D, F.lane, v1);
        row_gate_proj2_lds(F, v0, v1, TBL, m0, m1); }
}
__device__ __forceinline__ void e0_conv(Frame& F0, int j) {   Frame F = F0; asm volatile("" : "+v"(F.tid), "+v"(F.lane));
    const bf16* P = (const bf16*)(kws() + WS_R1); bf16* XBC = (bf16*)(kws() + WS_R3); bf16* MIX = (bf16*)(kws() + WS_MIX);
    const float* cw = KIN(I_CONVW) + (size_t)j * 4 * 1536; const float* cb = KIN(I_CONVB) + (size_t)j * 1536; const float* ca = KIN(I_CONVA) + (size_t)j * 3 * 512;
    constexpr int TT = 16;
    for (int it = F.gw; it < (T / TT) * 16; it += F.NGW) {
        const int tt = it >> 4, cg = it & 15, t0 = tt * TT, s0 = t0 & (SEQ - 1);
        if (cg < 12) {
            const int c = cg * 128 + 2 * F.lane;
            float w0[4], w1[4];
#pragma unroll
            for (int k = 0; k < 4; ++k) { w0[k] = cw[k * 1536 + c]; w1[k] = cw[k * 1536 + c + 1]; }
            const float b0 = cb[c], b1 = cb[c + 1];
            float xa[TT + 3], xb[TT + 3];
#pragma unroll
            for (int r = 0; r < TT + 3; ++r) { unsigned w = 0u; if (s0 - 3 + r >= 0) w = *(const unsigned*)(P + (size_t)(t0 - 3 + r) * NPE + 2560 + c); xa[r] = bflo(w); xb[r] = bfhi(w); }
#pragma unroll
            for (int o = 0; o < TT; ++o) { float a0 = b0, a1 = b1;
#pragma unroll
                for (int k = 0; k < 4; ++k) { a0 += w0[k] * xa[o + k]; a1 += w1[k] * xb[o + k]; }
                *(unsigned*)(XBC + (size_t)(t0 + o) * 1536 + c) = pk2(silu_f(a0), silu_f(a1)); }
        } else {
            const int c = (cg - 12) * 128 + 2 * F.lane;
            float w0[3], w1[3];
#pragma unroll
            for (int k = 0; k < 3; ++k) { w0[k] = ca[k * 512 + c]; w1[k] = ca[k * 512 + c + 1]; }
            float ua[TT + 2], ub[TT + 2]; unsigned bgw[TT];
#pragma unroll
            for (int o = 0; o < TT; ++o) bgw[o] = *(const unsigned*)(P + (size_t)(t0 + o) * NPE + c);
#pragma unroll
            for (int r = 0; r < TT + 2; ++r) { float a = 0.f, b = 0.f;
                if (s0 - 2 + r >= 0) { const bf16* pr = P + (size_t)(t0 - 2 + r) * NPE; const unsigned cgw = *(const unsigned*)(pr + 512 + c), xw = *(const unsigned*)(pr + 1024 + c); a = bflo(cgw) * bflo(xw); b = bfhi(cgw) * bfhi(xw); }
                ua[r] = a; ub[r] = b; }
#pragma unroll
            for (int o = 0; o < TT; ++o) { float a0 = 0.f, a1 = 0.f;
#pragma unroll
                for (int k = 0; k < 3; ++k) { a0 += w0[k] * ua[o + k]; a1 += w1[k] * ub[o + k]; }
                const unsigned bg = bgw[o];
                *(unsigned*)(MIX + (size_t)(t0 + o) * 1536 + c) = pk2(bflo(bg) * a0, bfhi(bg) * a1); }
        }
    }
}
__device__ __forceinline__ void ssd_gates(Frame& F, int j, int t0, int h, LAS float* dtl, LAS float* acs) {
    if (F.wave == 0) {
        const float* SG = (const float*)(kws() + WS_SG); const float dtb = KIN(I_DTB)[j * 16 + h], aneg = -expf(KIN(I_ALOG)[j * 16 + h]);
        const float d0 = softplus_f(SG[(size_t)(t0 + 2 * F.lane) * 16 + h] + dtb), d1 = softplus_f(SG[(size_t)(t0 + 2 * F.lane + 1) * 16 + h] + dtb);
        const float a0 = d0 * aneg, a1 = d1 * aneg; const float inc = wave_scan_sum(a0 + a1, F.lane);
        dtl[2 * F.lane] = d0; dtl[2 * F.lane + 1] = d1; acs[2 * F.lane] = inc - a1; acs[2 * F.lane + 1] = inc;
    }
}
__device__ __forceinline__ void e1_states(Frame& F0, int j) {   Frame F = F0; asm volatile("" : "+v"(F.tid), "+v"(F.lane));
    const bf16* XBC = (const bf16*)(kws() + WS_R3); float* ST = (float*)(kws() + WS_R4); float* DEC = (float*)(kws() + WS_DEC);
    LAS float* xw = (LAS float*)F.lds; LAS float* Bm = (LAS float*)(F.lds + 32768); LAS float* dtl = (LAS float*)(F.lds + SMALL_OFF); LAS float* acs = dtl + 128;
    for (int u = F.vcu; u < 2048; u += F.G) {
        const int b = u >> 8, c = (u >> 4) & 15, h = u & 15, g = h >> 2, t0 = b * SEQ + c * 128;
        __syncthreads();
        ssd_gates(F, j, t0, h, dtl, acs);
        __syncthreads();
        for (int i = F.tid; i < 128 * 32; i += 512) { const int l = i >> 5, pp = (i & 31) * 2; const float wgt = expf(acs[127] - acs[l]) * dtl[l];
            const unsigned xv = *(const unsigned*)(XBC + (size_t)(t0 + l) * 1536 + h * 64 + pp), bv = *(const unsigned*)(XBC + (size_t)(t0 + l) * 1536 + 1024 + g * 64 + pp);
            xw[l * 64 + pp] = bflo(xv) * wgt; xw[l * 64 + pp + 1] = bfhi(xv) * wgt; Bm[l * 64 + pp] = bflo(bv); Bm[l * 64 + pp + 1] = bfhi(bv); }
        __syncthreads();
        const int n = F.lane, p0 = 8 * F.wave; float acc[8];
#pragma unroll
        for (int i = 0; i < 8; ++i) acc[i] = 0.f;
#pragma unroll 2
        for (int l = 0; l < 128; ++l) { const float bm = Bm[l * 64 + n]; const f32x4 x0 = *(const LAS f32x4*)(xw + l * 64 + p0), x1 = *(const LAS f32x4*)(xw + l * 64 + p0 + 4);
#pragma unroll
            for (int i = 0; i < 4; ++i) { acc[i] += x0[i] * bm; acc[4 + i] += x1[i] * bm; } }
        float* dst = ST + (size_t)u * 4096;
#pragma unroll
        for (int i = 0; i < 8; ++i) dst[(p0 + i) * 64 + n] = acc[i];
        if (F.tid == 0) DEC[u] = expf(acs[127]);
    }
}
__device__ __forceinline__ void e2_scan(Frame& F0) {   Frame F = F0; asm volatile("" : "+v"(F.tid), "+v"(F.lane));
    float* ST = (float*)(kws() + WS_R4); const float* DEC = (const float*)(kws() + WS_DEC);
    for (int e = F.vcu * 512 + F.tid; e < NBATCH * 16 * 4096; e += F.G * 512) {
        const int b = e >> 16, h = (e >> 12) & 15, pn = e & 4095; float run = 0.f; float s[16], dc[16];
#pragma unroll
        for (int c = 0; c < 16; ++c) { const int u = (b * 16 + c) * 16 + h; s[c] = ST[(size_t)u * 4096 + pn]; dc[c] = DEC[u]; }
#pragma unroll
        for (int c = 0; c < 16; ++c) { const int u = (b * 16 + c) * 16 + h; ST[(size_t)u * 4096 + pn] = run; run = run * dc[c] + s[c]; }
    }
}
__device__ __forceinline__ void e3_output(Frame& F0, int j) {   Frame F = F0; asm volatile("" : "+v"(F.tid), "+v"(F.lane));
    const bf16* XBC = (const bf16*)(kws() + WS_R3); const float* ST = (const float*)(kws() + WS_R4); float* Y = (float*)(kws() + WS_R2);
    LAS float* R0 = (LAS float*)F.lds;
    LAS float* R1 = (LAS float*)(F.lds + 32768);
    LAS float* R2 = (LAS float*)(F.lds + 65536);
    LAS float* dtl = (LAS float*)(F.lds + SMALL_OFF); LAS float* acs = dtl + 128;
    for (int u = F.vcu; u < 2048; u += F.G) {
        const int b = u >> 8, c = (u >> 4) & 15, h = u & 15, g = h >> 2, t0 = b * SEQ + c * 128;
        __syncthreads();
        ssd_gates(F, j, t0, h, dtl, acs);
        for (int i = F.tid; i < 128 * 32; i += 512) { const int l = i >> 5, nn = (i & 31) * 2;
            const unsigned bv = *(const unsigned*)(XBC + (size_t)(t0 + l) * 1536 + 1024 + g * 64 + nn), cv = *(const unsigned*)(XBC + (size_t)(t0 + l) * 1536 + 1280 + g * 64 + nn);
            R0[l * 64 + nn] = bflo(cv); R0[l * 64 + nn + 1] = bfhi(cv); R1[nn * 128 + l] = bflo(bv); R1[(nn + 1) * 128 + l] = bfhi(bv); }
        { const float* hp = ST + (size_t)u * 4096; for (int i = F.tid; i < 4096; i += 512) { const int p = i >> 6, n = i & 63; R2[n * 64 + p] = hp[i]; } }
        __syncthreads();
        const int p = F.lane, l0 = 16 * F.wave; float acc[16];
#pragma unroll
        for (int i = 0; i < 16; ++i) acc[i] = 0.f;
#pragma unroll 1
        for (int n0 = 0; n0 < 64; n0 += 4) { float hp[4];
#pragma unroll
            for (int i = 0; i < 4; ++i) hp[i] = R2[(n0 + i) * 64 + p];
#pragma unroll
            for (int li = 0; li < 16; ++li) { const f32x4 c4 = *(const LAS f32x4*)(R0 + (l0 + li) * 64 + n0); acc[li] += (c4[0] * hp[0] + c4[1] * hp[1]) + (c4[2] * hp[2] + c4[3] * hp[3]); } }
#pragma unroll
        for (int li = 0; li < 16; ++li) acc[li] *= expf(acs[l0 + li]);
        __syncthreads();
#pragma unroll 1
        for (int half = 0; half < 2; ++half) { const int s = F.tid & 127, lg = 32 * (F.tid >> 7) + 16 * half; float gacc[16];
#pragma unroll
            for (int i = 0; i < 16; ++i) gacc[i] = 0.f;
#pragma unroll 1
            for (int n0 = 0; n0 < 64; n0 += 4) { float bb[4];
#pragma unroll
                for (int i = 0; i < 4; ++i) bb[i] = R1[(n0 + i) * 128 + s];
#pragma unroll
                for (int li = 0; li < 16; ++li) { const f32x4 c4 = *(const LAS f32x4*)(R0 + (lg + li) * 64 + n0); gacc[li] += (c4[0] * bb[0] + c4[1] * bb[1]) + (c4[2] * bb[2] + c4[3] * bb[3]); } }
            const float as = acs[s];
#pragma unroll
            for (int li = 0; li < 16; ++li) { const int l = lg + li; R2[l * 128 + s] = (s <= l) ? gacc[li] * expf(acs[l] - as) : 0.f; } }
        __syncthreads();
        for (int i = F.tid; i < 128 * 32; i += 512) { const int l = i >> 5, pp = (i & 31) * 2; const unsigned xv = *(const unsigned*)(XBC + (size_t)(t0 + l) * 1536 + h * 64 + pp);
            R0[l * 64 + pp] = bflo(xv); R0[l * 64 + pp + 1] = bfhi(xv); }
        __syncthreads();
#pragma unroll 1
        for (int s0 = 0; s0 < l0 + 16; s0 += 4) { float xv[4];
#pragma unroll
            for (int i = 0; i < 4; ++i) xv[i] = R0[(s0 + i) * 64 + p] * dtl[s0 + i];
#pragma unroll
            for (int li = 0; li < 16; ++li) { const f32x4 g4 = *(const LAS f32x4*)(R2 + (l0 + li) * 128 + s0); acc[li] += (g4[0] * xv[0] + g4[1] * xv[1]) + (g4[2] * xv[2] + g4[3] * xv[3]); } }
        const float dsk = KIN(I_DSKIP)[j * 16 + h];
#pragma unroll
        for (int li = 0; li < 16; ++li) Y[(size_t)(t0 + l0 + li) * D + h * 64 + p] = acc[li] + dsk * R0[(l0 + li) * 64 + p];
    }
}
__device__ __forceinline__ void e4_gnorm(Frame& F0) {   Frame F = F0; asm volatile("" : "+v"(F.tid), "+v"(F.lane));
    const float* Y = (const float*)(kws() + WS_R2); const bf16* P = (const bf16*)(kws() + WS_R1); bf16* MIX = (bf16*)(kws() + WS_MIX);
#pragma unroll 1
    for (int m0 = F.gw; m0 < T; m0 += 2 * F.NGW) { const int m1 = m0 + F.NGW < T ? m0 + F.NGW : m0; const int mm[2] = {m0, m1}; f32x4 y[2][4], z[2][4]; float rstd[2];
#pragma unroll
        for (int rr = 0; rr < 2; ++rr) { row_load(Y + (size_t)mm[rr] * D, F.lane, y[rr]); row_load_bf16(P + (size_t)mm[rr] * NPE + 1536, F.lane, z[rr]); }
#pragma unroll
        for (int rr = 0; rr < 2; ++rr) { float ss = 0.f;
#pragma unroll
            for (int jj = 0; jj < 4; ++jj)
#pragma unroll
                for (int i = 0; i < 4; ++i) { const float uu = y[rr][jj][i] * silu_f(z[rr][jj][i]); y[rr][jj][i] = uu; ss += uu * uu; }
            rstd[rr] = 1.0f / sqrtf(wave_sum(ss) * (1.f / D) + LN_EPS); }
#pragma unroll
        for (int rr = 0; rr < 2; ++rr) {
#pragma unroll
            for (int jj = 0; jj < 4; ++jj) y[rr][jj] = y[rr][jj] * rstd[rr];
            if (rr == 0 || m1 != m0) row_store_bf16(MIX + (size_t)mm[rr] * 1536 + 512, F.lane, y[rr]); } }
}
__device__ __forceinline__ void o_foxscan(Frame& F0, int j) {   Frame F = F0; asm volatile("" : "+v"(F.tid), "+v"(F.lane));
    const float* SG = (const float*)(kws() + WS_SG); float* FOXC = (float*)(kws() + WS_FOXC);
    for (int bh = F.gw; bh < 64; bh += F.NGW) { const int b = bh >> 3, h = bh & 7; const float bias = KIN(I_FOXB)[j * 8 + h];
        float v[32], run = 0.f;
#pragma unroll
        for (int i = 0; i < 32; ++i) { run += logsigmoid_f(SG[(size_t)(b * SEQ + 32 * F.lane + i) * 16 + 8 + h] + bias); v[i] = run; }
        const float off = wave_scan_sum(run, F.lane) - run;
#pragma unroll
        for (int i = 0; i < 32; ++i) FOXC[(size_t)bh * SEQ + 32 * F.lane + i] = (v[i] + off) * LOG2E; }
}
__device__ __forceinline__ void mlstm_gates(Frame& F, int j, int t0, int h, float& bcum, float& ib) {
    const float* SG = (const float*)(kws() + WS_SG);
    ib = SG[(size_t)(t0 + F.lane) * 16 + h] + KIN(I_IB)[j * 4 + h];
    bcum = wave_scan_sum(logsigmoid_f(SG[(size_t)(t0 + F.lane) * 16 + 4 + h] + KIN(I_FB)[j * 4 + h]), F.lane);
}
__device__ __forceinline__ void o1_local(Frame& F0, int j) {   Frame F = F0; asm volatile("" : "+v"(F.tid), "+v"(F.lane));
    const bf16* P = (const bf16*)(kws() + WS_R1); float* KLOC = (float*)(kws() + WS_R2); float* NLOC = (float*)(kws() + WS_NLOC); float* MLOC = (float*)(kws() + WS_MLOC); float* BLAST = (float*)(kws() + WS_BLAST);
    LAS float* kw = (LAS float*)F.lds; LAS float* Vs = (LAS float*)(F.lds + 32768); LAS float* wk = (LAS float*)(F.lds + SMALL_OFF);
    for (int u = F.vcu; u < 1024; u += F.G) {
        const int b = u >> 7, h = (u >> 5) & 3, c = u & 31, t0 = b * SEQ + c * 64;
        __syncthreads();
        if (F.wave == 0) { float bcum, ib; mlstm_gates(F, j, t0, h, bcum, ib); const float blast = __shfl(bcum, 63); const float gl = blast - bcum + ib; const float ml = wave_max(gl);
            wk[F.lane] = expf(gl - ml); if (F.lane == 0) { MLOC[u] = ml; BLAST[u] = blast; } }
        __syncthreads();
        for (int i = F.tid; i < 64 * 64; i += 512) { const int s = i >> 6, dd = (i & 63) * 2; const float w = wk[s];
            const unsigned kv = *(const unsigned*)(P + (size_t)(t0 + s) * NPO + 512 + h * 128 + dd), vv = *(const unsigned*)(P + (size_t)(t0 + s) * NPO + 1024 + h * 128 + dd);
            kw[s * 128 + dd] = bflo(kv) * w; kw[s * 128 + dd + 1] = bfhi(kv) * w; Vs[s * 128 + dd] = bflo(vv); Vs[s * 128 + dd + 1] = bfhi(vv); }
        __syncthreads();
        const int v = F.tid & 127, d0 = 32 * (F.tid >> 7); float acc[32];
#pragma unroll
        for (int i = 0; i < 32; ++i) acc[i] = 0.f;
#pragma unroll 1
        for (int s = 0; s < 64; ++s) { const float vv = Vs[s * 128 + v];
#pragma unroll
            for (int di = 0; di < 32; di += 4) { const f32x4 k4 = *(const LAS f32x4*)(kw + s * 128 + d0 + di);
#pragma unroll
                for (int i = 0; i < 4; ++i) acc[di + i] += k4[i] * vv; } }
        float* dst = KLOC + (size_t)u * 16384;
#pragma unroll
        for (int i = 0; i < 32; ++i) dst[(d0 + i) * 128 + v] = acc[i];
        if (F.tid < 128) { float a = 0.f; for (int s = 0; s < 64; ++s) a += kw[s * 128 + F.tid]; NLOC[(size_t)u * 128 + F.tid] = a; }
    }
}
__device__ __forceinline__ void o2_scan(Frame& F0) {   Frame F = F0; asm volatile("" : "+v"(F.tid), "+v"(F.lane));
    float* KLOC = (float*)(kws() + WS_R2); float* NLOC = (float*)(kws() + WS_NLOC); const float* MLOC = (const float*)(kws() + WS_MLOC); const float* BLAST = (const float*)(kws() + WS_BLAST); float* MPREV = (float*)(kws() + WS_MPREV);
    constexpr int PER = 16384 + 128;
    for (int e = F.vcu * 512 + F.tid; e < 32 * PER; e += F.G * 512) {
        const int bh = e / PER, r = e % PER; float run = 0.f, m = 0.f;
#pragma unroll 1
        for (int c0 = 0; c0 < 32; c0 += 16) { float loc[16], bl[16], ml[16];
#pragma unroll
            for (int i = 0; i < 16; ++i) { const int u = bh * 32 + c0 + i; const float* p = r < 16384 ? KLOC + (size_t)u * 16384 + r : NLOC + (size_t)u * 128 + (r - 16384); loc[i] = *p; bl[i] = BLAST[u]; ml[i] = MLOC[u]; }
#pragma unroll
            for (int i = 0; i < 16; ++i) { const int u = bh * 32 + c0 + i; float* p = r < 16384 ? KLOC + (size_t)u * 16384 + r : NLOC + (size_t)u * 128 + (r - 16384);
                *p = run; if (r == 0) MPREV[u] = m;
                const float mn = fmaxf(bl[i] + m, ml[i]);
                run = expf(bl[i] + m - mn) * run + expf(ml[i] - mn) * loc[i]; m = mn; } }
    }
}
__device__ __forceinline__ void o3_output(Frame& F0, int j) {   Frame F = F0; asm volatile("" : "+v"(F.tid), "+v"(F.lane));
    const bf16* P = (const bf16*)(kws() + WS_R1); const float* CPREV = (const float*)(kws() + WS_R2); const float* NPREV = (const float*)(kws() + WS_NLOC); const float* MPREV = (const float*)(kws() + WS_MPREV); bf16* MIX = (bf16*)(kws() + WS_MIX);
    LAS float* qT = (LAS float*)F.lds;
    LAS float* kT = (LAS float*)(F.lds + 32768);
    LAS float* Vs = (LAS float*)(F.lds + 65536);
    LAS float* WT = (LAS float*)(F.lds + 98304);
    LAS float* sm = (LAS float*)(F.lds + SMALL_OFF);
    for (int u = F.vcu; u < 1024; u += F.G) {
        const int b = u >> 7, h = (u >> 5) & 3, c = u & 31, t0 = b * SEQ + c * 64;
        __syncthreads();
        if (F.wave == 0) { float bcum, ib; mlstm_gates(F, j, t0, h, bcum, ib); const float mprev = MPREV[u];
            const float pm = wave_scan_max(ib - bcum, F.lane); const float inter = bcum + mprev; const float mt = fmaxf(bcum + pm, inter);
            sm[F.lane] = bcum; sm[64 + F.lane] = ib; sm[128 + F.lane] = mt; sm[192 + F.lane] = expf(inter - mt); }
        for (int i = F.tid; i < 64 * 64; i += 512) { const int s = i >> 6, dd = (i & 63) * 2; const bf16* pr = P + (size_t)(t0 + s) * NPO + h * 128 + dd;
            const unsigned qv = *(const unsigned*)pr, kv = *(const unsigned*)(pr + 512), vv = *(const unsigned*)(pr + 1024);
            qT[dd * 64 + s] = bflo(qv); qT[(dd + 1) * 64 + s] = bfhi(qv); kT[dd * 64 + s] = bflo(kv); kT[(dd + 1) * 64 + s] = bfhi(kv); Vs[s * 128 + dd] = bflo(vv); Vs[s * 128 + dd + 1] = bfhi(vv); }
        __syncthreads();
        { const int s = F.lane, l0 = 8 * F.wave; float acc[8];
#pragma unroll
            for (int i = 0; i < 8; ++i) acc[i] = 0.f;
#pragma unroll 2
            for (int d = 0; d < 128; ++d) { const float kk = kT[d * 64 + s]; const f32x4 q0 = *(const LAS f32x4*)(qT + d * 64 + l0), q1 = *(const LAS f32x4*)(qT + d * 64 + l0 + 4);
#pragma unroll
                for (int i = 0; i < 4; ++i) { acc[i] += q0[i] * kk; acc[4 + i] += q1[i] * kk; } }
            const float gs = sm[64 + s] - sm[s];
#pragma unroll
            for (int i = 0; i < 8; ++i) { const int l = l0 + i; const float w = (s <= l) ? acc[i] * expf(sm[l] + gs - sm[128 + l]) : 0.f; WT[s * 64 + l] = w; const float dsum = wave_sum(w); if (F.lane == 0) sm[256 + l] = dsum; } }
        __syncthreads();
        if (F.tid < 64) { const int l = F.tid; float qn = 0.f; const float* np = NPREV + (size_t)u * 128; for (int d = 0; d < 128; ++d) qn += qT[d * 64 + l] * np[d]; sm[256 + l] += sm[192 + l] * qn; }
        const int v = F.tid & 127, l0 = 16 * (F.tid >> 7); float acc[16];
#pragma unroll
        for (int i = 0; i < 16; ++i) acc[i] = 0.f;
        { const float* cp = CPREV + (size_t)u * 16384;
#pragma unroll 2
            for (int d = 0; d < 128; ++d) { const float cc = cp[d * 128 + v];
#pragma unroll
                for (int li = 0; li < 16; li += 4) { const f32x4 q4 = *(const LAS f32x4*)(qT + d * 64 + l0 + li);
#pragma unroll
                    for (int i = 0; i < 4; ++i) acc[li + i] += q4[i] * cc; } } }
#pragma unroll
        for (int i = 0; i < 16; ++i) acc[i] *= sm[192 + l0 + i];
#pragma unroll 2
        for (int s = 0; s < 64; ++s) { const float vv = Vs[s * 128 + v];
#pragma unroll
            for (int li = 0; li < 16; li += 4) { const f32x4 w4 = *(const LAS f32x4*)(WT + s * 64 + l0 + li);
#pragma unroll
                for (int i = 0; i < 4; ++i) acc[li + i] += w4[i] * vv; } }
        __syncthreads();
        LAS float* hb = kT;
#pragma unroll
        for (int i = 0; i < 16; ++i) { const int l = l0 + i; const float hv = acc[i] / fmaxf(fabsf(sm[256 + l]), expf(-sm[128 + l])); acc[i] = hv; hb[l * 128 + v] = hv; }
        __syncthreads();
        { const int lb = 8 * F.wave;
#pragma unroll
            for (int i = 0; i < 8; ++i) { const int l = lb + i; const float a = hb[l * 128 + F.lane], bq = hb[l * 128 + 64 + F.lane]; const float mu = wave_sum(a + bq) * (1.f / 128.f);
                const float da = a - mu, db = bq - mu; const float var = wave_sum(da * da + db * db) * (1.f / 128.f); if (F.lane == 0) { sm[320 + l] = mu; sm[384 + l] = 1.0f / sqrtf(var + LN_EPS); } } }
        __syncthreads();
        const float hw = KIN(I_HNW)[j * 512 + h * 128 + v];
#pragma unroll
        for (int i = 0; i < 16; ++i) { const int l = l0 + i; const float og = sigmoid_f(bf2f(P[(size_t)(t0 + l) * NPO + 1536 + h * 128 + v]));
            MIX[(size_t)(t0 + l) * D + h * 128 + v] = (bf16)f2bf(og * (acc[i] - sm[320 + l]) * sm[384 + l] * hw); }
    }
}
__device__ __forceinline__ void o4_fox(Frame& F0) {   Frame F = F0; asm volatile("" : "+v"(F.tid), "+v"(F.lane));
    const bf16* P = (const bf16*)(kws() + WS_R1); const float* FOXC = (const float*)(kws() + WS_FOXC); bf16* MIX = (bf16*)(kws() + WS_MIX);
    LAS float* QT = (LAS float*)F.lds;
    LAS float* KT = (LAS float*)(F.lds + 16384);
    LAS float* Vs = (LAS float*)(F.lds + 32768);
    LAS float* PT = (LAS float*)(F.lds + 49152) + F.wave * 512;
    LAS float* cq = (LAS float*)(F.lds + SMALL_OFF); LAS float* ck = cq + 64;
    for (int it = F.vcu; it < 2048; it += F.G) {
        const int qt = 31 - (it >> 6), bh = it & 63, b = bh >> 3, h = bh & 7, tq0 = b * SEQ + qt * 64;
        __syncthreads();
        for (int i = F.tid; i < 64 * 32; i += 512) { const int q = i >> 5, dd = (i & 31) * 2; const unsigned w = *(const unsigned*)(P + (size_t)(tq0 + q) * NPO + 2048 + h * 64 + dd); QT[dd * 64 + q] = bflo(w); QT[(dd + 1) * 64 + q] = bfhi(w); }
        if (F.tid < 64) cq[F.tid] = FOXC[(size_t)bh * SEQ + qt * 64 + F.tid];
        const int q0 = 8 * F.wave; float mrun[8], lrun[8], o[8];
#pragma unroll
        for (int i = 0; i < 8; ++i) { mrun[i] = -INFINITY; lrun[i] = 0.f; o[i] = 0.f; }
#pragma unroll 1
        for (int kt = 0; kt <= qt; ++kt) { const int tk0 = b * SEQ + kt * 64;
            __syncthreads();
            for (int i = F.tid; i < 64 * 32; i += 512) { const int k = i >> 5, dd = (i & 31) * 2; const bf16* pr = P + (size_t)(tk0 + k) * NPO + h * 64 + dd; const unsigned kw = *(const unsigned*)(pr + 2560), vw = *(const unsigned*)(pr + 3072);
                KT[dd * 64 + k] = bflo(kw); KT[(dd + 1) * 64 + k] = bfhi(kw); Vs[k * 64 + dd] = bflo(vw); Vs[k * 64 + dd + 1] = bfhi(vw); }
            if (F.tid < 64) ck[F.tid] = FOXC[(size_t)bh * SEQ + kt * 64 + F.tid];
            __syncthreads();
            float s[8];
#pragma unroll
            for (int i = 0; i < 8; ++i) s[i] = 0.f;
#pragma unroll 2
            for (int d = 0; d < 64; ++d) { const float kk = KT[d * 64 + F.lane]; const f32x4 qa = *(const LAS f32x4*)(QT + d * 64 + q0), qb = *(const LAS f32x4*)(QT + d * 64 + q0 + 4);
#pragma unroll
                for (int i = 0; i < 4; ++i) { s[i] += qa[i] * kk; s[4 + i] += qb[i] * kk; } }
            const float ckv = ck[F.lane];
#pragma unroll
            for (int i = 0; i < 8; ++i) { float sv = s[i] + cq[q0 + i] - ckv; if (kt == qt && F.lane > q0 + i) sv = -INFINITY;
                const float mn = fmaxf(mrun[i], wave_max(sv)); const float p = exp2f(sv - mn), al = exp2f(mrun[i] - mn);
                lrun[i] = lrun[i] * al + wave_sum(p); o[i] *= al; mrun[i] = mn; PT[F.lane * 8 + i] = p; }
            LDS_WAIT(); asm volatile("" ::: "memory");
#pragma unroll 2
            for (int k = 0; k < 64; ++k) { const float vv = Vs[k * 64 + F.lane]; const f32x4 pa = *(const LAS f32x4*)(PT + k * 8), pb = *(const LAS f32x4*)(PT + k * 8 + 4);
#pragma unroll
                for (int i = 0; i < 4; ++i) { o[i] += pa[i] * vv; o[4 + i] += pb[i] * vv; } }
        }
#pragma unroll
        for (int i = 0; i < 8; ++i) MIX[(size_t)(tq0 + q0 + i) * D + 512 + h * 64 + F.lane] = (bf16)f2bf(o[i] / lrun[i]);
    }
}
typedef short bf16x8 __attribute__((ext_vector_type(8)));
typedef float f32x16 __attribute__((ext_vector_type(16)));
#define MFMA32(a, b, c) __builtin_amdgcn_mfma_f32_32x32x16_bf16((a), (b), (c), 0, 0, 0)
__device__ __forceinline__ int crow(int r, int h) { return (r & 3) + 8 * (r >> 2) + 4 * h; }
__device__ __forceinline__ bf16x8 pack8(float a0, float a1, float a2, float a3, float a4, float a5, float a6, float a7) {
    v4u p; p.x = cvtpk(a0, a1); p.y = cvtpk(a2, a3); p.z = cvtpk(a4, a5); p.w = cvtpk(a6, a7); return __builtin_bit_cast(bf16x8, p); }
__device__ __forceinline__ bf16x8 pack_step(const f32x16& x, int s) { return pack8(x[8 * s], x[8 * s + 1], x[8 * s + 2], x[8 * s + 3], x[8 * s + 4], x[8 * s + 5], x[8 * s + 6], x[8 * s + 7]); }
__device__ __forceinline__ bf16x8 ldg8_f32(const float* p) { const f32x4 a = *(const f32x4*)p, b = *(const f32x4*)(p + 4); return pack8(a[0], a[1], a[2], a[3], b[0], b[1], b[2], b[3]); }
__device__ __forceinline__ bf16x8 lds_nat(const LAS bf16* row, int ks, int h) { return *(const LAS bf16x8*)(row + 16 * ks + 8 * h); }
__device__ __forceinline__ bf16x8 lds_krow(const LAS bf16* row, int k0, int h) { const v2u lo = *(const LAS v2u*)(row + k0 + 4 * h), hi = *(const LAS v2u*)(row + k0 + 8 + 4 * h);
    v4u p; p.x = lo.x; p.y = lo.y; p.z = hi.x; p.w = hi.y; return __builtin_bit_cast(bf16x8, p); }
__device__ __forceinline__ f32x16 zero16() { f32x16 z;
#pragma unroll
    for (int i = 0; i < 16; ++i) z[i] = 0.f;
    return z; }

__device__ __forceinline__ void ssd_gates4(Frame& F, int j, int t0, int g, LAS float* DT, LAS float* ACS) {
    if (F.wave < 4) { const int h = 4 * g + F.wave; const float* SG = (const float*)(kws() + WS_SG); const float dtb = KIN(I_DTB)[j * 16 + h], aneg = -expf(KIN(I_ALOG)[j * 16 + h]);
        const float d0 = softplus_f(SG[(size_t)(t0 + 2 * F.lane) * 16 + h] + dtb), d1 = softplus_f(SG[(size_t)(t0 + 2 * F.lane + 1) * 16 + h] + dtb);
        const float a0 = d0 * aneg, a1 = d1 * aneg; const float inc = wave_scan_sum(a0 + a1, F.lane);
        DT[F.wave * 128 + 2 * F.lane] = d0; DT[F.wave * 128 + 2 * F.lane + 1] = d1; ACS[F.wave * 128 + 2 * F.lane] = inc - a1; ACS[F.wave * 128 + 2 * F.lane + 1] = inc; }
}
__device__ __forceinline__ void ssd_stage_xt(Frame& F, const bf16* XBC, int t0, int g, LAS bf16* XT, const LAS float* WGT) {
    for (int i = F.tid; i < 2048; i += 512) { const int cp = i & 127, s0 = 8 * (i >> 7), hl = cp >> 5; float a[8], bq[8];
#pragma unroll
        for (int k = 0; k < 8; ++k) { const unsigned w = *(const unsigned*)(XBC + (size_t)(t0 + s0 + k) * 1536 + g * 256 + 2 * cp); const float wg = WGT[hl * 128 + s0 + k]; a[k] = bflo(w) * wg; bq[k] = bfhi(w) * wg; }
        *(LAS bf16x8*)(XT + (2 * cp) * 136 + s0) = pack8(a[0], a[1], a[2], a[3], a[4], a[5], a[6], a[7]);
        *(LAS bf16x8*)(XT + (2 * cp + 1) * 136 + s0) = pack8(bq[0], bq[1], bq[2], bq[3], bq[4], bq[5], bq[6], bq[7]); }
}
__device__ __forceinline__ void e1_states_mfma(Frame& F0, int j) {   Frame F = F0; asm volatile("" : "+v"(F.tid), "+v"(F.lane));
    const bf16* XBC = (const bf16*)(kws() + WS_R3); float* ST = (float*)(kws() + WS_R4); float* DEC = (float*)(kws() + WS_DEC);
    LAS bf16* XT = (LAS bf16*)F.lds; LAS bf16* BT = (LAS bf16*)(F.lds + 69632);
    LAS float* DT = (LAS float*)(F.lds + 98304); LAS float* ACS = DT + 512; LAS float* WGT = DT + 1024;
    for (int u = F.vcu; u < 512; u += F.G) {
        const int b = u >> 6, c = (u >> 2) & 15, g = u & 3, t0 = b * SEQ + c * 128;
        __syncthreads();
        ssd_gates4(F, j, t0, g, DT, ACS);
        { const int np = F.tid & 31, l0 = 8 * (F.tid >> 5); float a[8], bq[8];
#pragma unroll
            for (int k = 0; k < 8; ++k) { const unsigned w = *(const unsigned*)(XBC + (size_t)(t0 + l0 + k) * 1536 + 1024 + g * 64 + 2 * np); a[k] = bflo(w); bq[k] = bfhi(w); }
            *(LAS bf16x8*)(BT + (2 * np) * 136 + l0) = pack8(a[0], a[1], a[2], a[3], a[4], a[5], a[6], a[7]);
            *(LAS bf16x8*)(BT + (2 * np + 1) * 136 + l0) = pack8(bq[0], bq[1], bq[2], bq[3], bq[4], bq[5], bq[6], bq[7]); }
        __syncthreads();
        { const int hl = F.tid >> 7, l = F.tid & 127; WGT[F.tid] = expf(ACS[hl * 128 + 127] - ACS[F.tid]) * DT[F.tid]; if (l == 127) DEC[(b * 16 + c) * 16 + 4 * g + hl] = expf(ACS[F.tid]); }
        __syncthreads();
        ssd_stage_xt(F, XBC, t0, g, XT, WGT);
        __syncthreads();
        const int hl = F.wave >> 1, nt = F.wave & 1, li = F.lane & 31, hh = F.lane >> 5;
        f32x16 acc0 = zero16(), acc1 = zero16();
        const LAS bf16* ar0 = XT + (hl * 64 + li) * 136; const LAS bf16* ar1 = ar0 + 32 * 136; const LAS bf16* br = BT + (32 * nt + li) * 136;
#pragma unroll
        for (int ks = 0; ks < 8; ++ks) { const bf16x8 bf = lds_nat(br, ks, hh); acc0 = MFMA32(lds_nat(ar0, ks, hh), bf, acc0); acc1 = MFMA32(lds_nat(ar1, ks, hh), bf, acc1); }
        float* dst = ST + (size_t)((b * 16 + c) * 16 + 4 * g + hl) * 4096 + 32 * nt + li;
#pragma unroll
        for (int r = 0; r < 16; ++r) { dst[crow(r, hh) * 64] = acc0[r]; dst[(32 + crow(r, hh)) * 64] = acc1[r]; }
    }
}
__device__ __forceinline__ void e3_output_mfma(Frame& F0, int j) {   Frame F = F0; asm volatile("" : "+v"(F.tid), "+v"(F.lane));
    const bf16* XBC = (const bf16*)(kws() + WS_R3); const float* ST = (const float*)(kws() + WS_R4); float* Y = (float*)(kws() + WS_R2);
    LAS bf16* CR = (LAS bf16*)F.lds; LAS bf16* BR = (LAS bf16*)(F.lds + 18432); LAS bf16* XT = (LAS bf16*)(F.lds + 36864);
    LAS float* DT = (LAS float*)(F.lds + 106496); LAS float* ACS = DT + 512;
    for (int u = F.vcu; u < 512; u += F.G) {
        const int b = u >> 6, c = (u >> 2) & 15, g = u & 3, t0 = b * SEQ + c * 128;
        __syncthreads();
        ssd_gates4(F, j, t0, g, DT, ACS);
        for (int i = F.tid; i < 1024; i += 512) { const int l = i >> 3, ch = i & 7; const bf16* src = XBC + (size_t)(t0 + l) * 1536 + 1024 + g * 64 + 8 * ch;
            *(LAS v4u*)(BR + l * 72 + 8 * ch) = *(const v4u*)src; *(LAS v4u*)(CR + l * 72 + 8 * ch) = *(const v4u*)(src + 256); }
        __syncthreads();
        ssd_stage_xt(F, XBC, t0, g, XT, DT);
        __syncthreads();
        const int hl = F.wave >> 1, half = F.wave & 1, li = F.lane & 31, hh = F.lane >> 5, habs = 4 * g + hl;
        const LAS float* acs = ACS + hl * 128; const LAS float* dtl = DT + hl * 128;
        bf16x8 hp[2][4];
        { const float* hsrc = ST + (size_t)((b * 16 + c) * 16 + habs) * 4096;
#pragma unroll
            for (int pt = 0; pt < 2; ++pt)
#pragma unroll
                for (int ks = 0; ks < 4; ++ks) hp[pt][ks] = ldg8_f32(hsrc + (32 * pt + li) * 64 + 16 * ks + 8 * hh); }
        const float dsk = KIN(I_DSKIP)[j * 16 + habs];
#pragma unroll
        for (int q = 0; q < 2; ++q) { const int lt = half ? 1 + q : 3 * q;
            f32x16 acc[2]; acc[0] = zero16(); acc[1] = zero16();
            const LAS bf16* crl = CR + (32 * lt + li) * 72;
#pragma unroll
            for (int ks = 0; ks < 4; ++ks) { const bf16x8 cf = lds_nat(crl, ks, hh); acc[0] = MFMA32(cf, hp[0][ks], acc[0]); acc[1] = MFMA32(cf, hp[1][ks], acc[1]); }
#pragma unroll
            for (int a4 = 0; a4 < 4; ++a4) { const f32x4 av = *(const LAS f32x4*)(acs + 32 * lt + 8 * a4 + 4 * hh);
#pragma unroll
                for (int i = 0; i < 4; ++i) { const float e = expf(av[i]); acc[0][4 * a4 + i] *= e; acc[1][4 * a4 + i] *= e; } }
            const float acl = acs[32 * lt + li];
            for (int st = 0; st <= lt; ++st) {
                f32x16 gt = zero16(); const LAS bf16* brs = BR + (32 * st + li) * 72;
#pragma unroll
                for (int ks = 0; ks < 4; ++ks) gt = MFMA32(lds_nat(brs, ks, hh), lds_nat(crl, ks, hh), gt);
#pragma unroll
                for (int a4 = 0; a4 < 4; ++a4) { const f32x4 av = *(const LAS f32x4*)(acs + 32 * st + 8 * a4 + 4 * hh);
#pragma unroll
                    for (int i = 0; i < 4; ++i) { const int r = 4 * a4 + i; const float e = expf(acl - av[i]); gt[r] = (st < lt || crow(r, hh) <= li) ? gt[r] * e : 0.f; } }
                const bf16x8 g0 = pack_step(gt, 0), g1 = pack_step(gt, 1);
#pragma unroll
                for (int pt = 0; pt < 2; ++pt) { const LAS bf16* xr = XT + (hl * 64 + 32 * pt + li) * 136 + 32 * st;
                    acc[pt] = MFMA32(g0, lds_krow(xr, 0, hh), acc[pt]); acc[pt] = MFMA32(g1, lds_krow(xr, 16, hh), acc[pt]); } }
#pragma unroll
            for (int pt = 0; pt < 2; ++pt) { const LAS bf16* xr = XT + (hl * 64 + 32 * pt + li) * 136 + 32 * lt; float* yp = Y + (size_t)(t0 + 32 * lt) * D + habs * 64 + 32 * pt + li;
#pragma unroll
                for (int r = 0; r < 16; ++r) { const int l = crow(r, hh); yp[(size_t)l * D] = acc[pt][r] + dsk * bf2f(xr[l]) / dtl[32 * lt + l]; } }
        }
    }
}
__device__ __forceinline__ void mlstm_stage_t(Frame& F, const bf16* P, int t0, int col0, LAS bf16* DST, const LAS float* wk) {
    const int vp = F.tid & 63, s0 = 8 * (F.tid >> 6); float a[8], bq[8];
#pragma unroll
    for (int k = 0; k < 8; ++k) { const unsigned w = *(const unsigned*)(P + (size_t)(t0 + s0 + k) * NPO + col0 + 2 * vp); const float wg = wk ? wk[s0 + k] : 1.f; a[k] = bflo(w) * wg; bq[k] = bfhi(w) * wg; }
    *(LAS bf16x8*)(DST + (2 * vp) * 72 + s0) = pack8(a[0], a[1], a[2], a[3], a[4], a[5], a[6], a[7]);
    *(LAS bf16x8*)(DST + (2 * vp + 1) * 72 + s0) = pack8(bq[0], bq[1], bq[2], bq[3], bq[4], bq[5], bq[6], bq[7]);
}
__device__ __forceinline__ void o1_local_mfma(Frame& F0, int j) {   Frame F = F0; asm volatile("" : "+v"(F.tid), "+v"(F.lane));
    const bf16* P = (const bf16*)(kws() + WS_R1); float* KLOC = (float*)(kws() + WS_R2); float* NLOC = (float*)(kws() + WS_NLOC); float* MLOC = (float*)(kws() + WS_MLOC); float* BLAST = (float*)(kws() + WS_BLAST);
    LAS bf16* VT = (LAS bf16*)F.lds; LAS bf16* KWT = (LAS bf16*)(F.lds + 18432); LAS float* wk = (LAS float*)(F.lds + SMALL_OFF);
    for (int u = F.vcu; u < 1024; u += F.G) {
        const int b = u >> 7, h = (u >> 5) & 3, c = u & 31, t0 = b * SEQ + c * 64;
        __syncthreads();
        if (F.wave == 0) { float bcum, ib; mlstm_gates(F, j, t0, h, bcum, ib); const float blast = __shfl(bcum, 63); const float gl = blast - bcum + ib; const float ml = wave_max(gl);
            wk[F.lane] = expf(gl - ml); if (F.lane == 0) { MLOC[u] = ml; BLAST[u] = blast; } }
        mlstm_stage_t(F, P, t0, 1024 + h * 128, VT, nullptr);
        __syncthreads();
        mlstm_stage_t(F, P, t0, 512 + h * 128, KWT, wk);
        __syncthreads();
        const int vt = F.wave >> 1, dh = F.wave & 1, li = F.lane & 31, hh = F.lane >> 5;
        f32x16 acc0 = zero16(), acc1 = zero16();
        const LAS bf16* ar = VT + (32 * vt + li) * 72; const LAS bf16* b0 = KWT + (64 * dh + li) * 72; const LAS bf16* b1 = b0 + 32 * 72;
#pragma unroll
        for (int ks = 0; ks < 4; ++ks) { const bf16x8 af = lds_nat(ar, ks, hh); acc0 = MFMA32(af, lds_nat(b0, ks, hh), acc0); acc1 = MFMA32(af, lds_nat(b1, ks, hh), acc1); }
        float* dst = KLOC + (size_t)u * 16384 + (size_t)(32 * vt) * 128 + 64 * dh + li;
#pragma unroll
        for (int r = 0; r < 16; ++r) { dst[crow(r, hh) * 128] = acc0[r]; dst[crow(r, hh) * 128 + 32] = acc1[r]; }
        if (F.tid < 128) { float a = 0.f; const LAS bf16* kr = KWT + F.tid * 72;
#pragma unroll
            for (int s8 = 0; s8 < 8; ++s8) { const v4u w = *(const LAS v4u*)(kr + 8 * s8); a += (bflo(w.x) + bfhi(w.x)) + (bflo(w.y) + bfhi(w.y)) + (bflo(w.z) + bfhi(w.z)) + (bflo(w.w) + bfhi(w.w)); }
            NLOC[(size_t)u * 128 + F.tid] = a; }
    }
}
__device__ __forceinline__ void o3_output_mfma(Frame& F0, int j) {
    Frame F = F0; asm volatile("" : "+v"(F.tid), "+v"(F.lane));
    const bf16* P = (const bf16*)(kws() + WS_R1); const float* CPREV = (const float*)(kws() + WS_R2); const float* NPREV = (const float*)(kws() + WS_NLOC); const float* MPREV = (const float*)(kws() + WS_MPREV); bf16* MIX = (bf16*)(kws() + WS_MIX);
    LAS bf16* QR = (LAS bf16*)F.lds;
    LAS bf16* KR = (LAS bf16*)(F.lds + 17408);
    LAS bf16* VT = (LAS bf16*)(F.lds + 34816);
    LAS float* OST = (LAS float*)(F.lds + 53248);
    LAS float* sm = (LAS float*)(F.lds + 98304);
    for (int u = F.vcu; u < 1024; u += F.G) {
        const int b = u >> 7, h = (u >> 5) & 3, c = u & 31, t0 = b * SEQ + c * 64;
        __syncthreads();
        if (F.wave == 0) { float bcum, ib; mlstm_gates(F, j, t0, h, bcum, ib); const float mprev = MPREV[u];
            const float pm = wave_scan_max(ib - bcum, F.lane); const float inter = bcum + mprev; const float mt = fmaxf(bcum + pm, inter);
            sm[F.lane] = bcum; sm[64 + F.lane] = ib; sm[128 + F.lane] = mt; sm[192 + F.lane] = expf(inter - mt); }
        for (int i = F.tid; i < 1024; i += 512) { const int l = i >> 4, ch = i & 15; const bf16* src = P + (size_t)(t0 + l) * NPO + h * 128 + 8 * ch;
            *(LAS v4u*)(QR + l * 136 + 8 * ch) = *(const v4u*)src; *(LAS v4u*)(KR + l * 136 + 8 * ch) = *(const v4u*)(src + 512); }
        mlstm_stage_t(F, P, t0, 1024 + h * 128, VT, nullptr);
        __syncthreads();
        if (F.wave == 1) { const int l = F.lane; const float* np = NPREV + (size_t)u * 128; float qn = 0.f;
#pragma unroll 4
            for (int d8 = 0; d8 < 16; ++d8) { const v4u w = *(const LAS v4u*)(QR + l * 136 + 8 * d8); const f32x4 n0 = *(const f32x4*)(np + 8 * d8), n1 = *(const f32x4*)(np + 8 * d8 + 4);
                qn += (bflo(w.x) * n0[0] + bfhi(w.x) * n0[1]) + (bflo(w.y) * n0[2] + bfhi(w.y) * n0[3]) + (bflo(w.z) * n1[0] + bfhi(w.z) * n1[1]) + (bflo(w.w) * n1[2] + bfhi(w.w) * n1[3]); }
            sm[256 + l] = qn; }
        const int lt = F.wave >> 2, vt = F.wave & 3, li = F.lane & 31, hh = F.lane >> 5, l = 32 * lt + li;
        const float bcl = sm[l], mtl = sm[128 + l], sil = sm[192 + l];
        f32x16 acc = zero16();
        const LAS bf16* qrl = QR + l * 136;
        { const float* cp = CPREV + (size_t)u * 16384 + (size_t)(32 * vt + li) * 128;
#pragma unroll
            for (int ks = 0; ks < 8; ++ks) acc = MFMA32(ldg8_f32(cp + 16 * ks + 8 * hh), lds_nat(qrl, ks, hh), acc); }
#pragma unroll
        for (int r = 0; r < 16; ++r) acc[r] *= sil;
        float dsum = 0.f;
        for (int st = 0; st <= lt; ++st) {
            f32x16 wt = zero16(); const LAS bf16* krs = KR + (32 * st + li) * 136;
#pragma unroll
            for (int ks = 0; ks < 8; ++ks) wt = MFMA32(lds_nat(krs, ks, hh), lds_nat(qrl, ks, hh), wt);
#pragma unroll
            for (int a4 = 0; a4 < 4; ++a4) { const f32x4 bs = *(const LAS f32x4*)(sm + 32 * st + 8 * a4 + 4 * hh), is = *(const LAS f32x4*)(sm + 64 + 32 * st + 8 * a4 + 4 * hh);
#pragma unroll
                for (int i = 0; i < 4; ++i) { const int r = 4 * a4 + i; const float e = expf(bcl - bs[i] + is[i] - mtl); const float w = (st < lt || crow(r, hh) <= li) ? wt[r] * e : 0.f; wt[r] = w; dsum += w; } }
            const bf16x8 w0 = pack_step(wt, 0), w1 = pack_step(wt, 1); const LAS bf16* vr = VT + (32 * vt + li) * 72 + 32 * st;
            acc = MFMA32(lds_krow(vr, 0, hh), w0, acc); acc = MFMA32(lds_krow(vr, 16, hh), w1, acc); }
        __syncthreads();
        dsum += __shfl_xor(dsum, 32);
        const float den = dsum + sil * sm[256 + l]; const float rinv = 1.0f / fmaxf(fabsf(den), expf(-mtl));
        float s1 = 0.f, s2 = 0.f;
#pragma unroll
        for (int r = 0; r < 16; ++r) { acc[r] *= rinv; s1 += acc[r]; s2 += acc[r] * acc[r]; }
        s1 += __shfl_xor(s1, 32); s2 += __shfl_xor(s2, 32);
        if (hh == 0) { sm[320 + (vt * 64 + l) * 2] = s1; sm[320 + (vt * 64 + l) * 2 + 1] = s2; }
        __syncthreads();
        { float t1 = 0.f, t2 = 0.f;
#pragma unroll
            for (int q = 0; q < 4; ++q) { t1 += sm[320 + (q * 64 + l) * 2]; t2 += sm[320 + (q * 64 + l) * 2 + 1]; }
            const float mu = t1 * (1.f / 128.f), var = fmaxf(t2 * (1.f / 128.f) - mu * mu, 0.f), rstd = 1.0f / sqrtf(var + LN_EPS);
#pragma unroll
            for (int r = 0; r < 16; ++r) OST[l * 132 + 32 * vt + crow(r, hh)] = (acc[r] - mu) * rstd; }
        __syncthreads();
        for (int i = F.tid; i < 1024; i += 512) { const int ll = i >> 4, ch = i & 15; const LAS float* os = OST + ll * 132 + 8 * ch; const f32x4 o0 = *(const LAS f32x4*)os, o1 = *(const LAS f32x4*)(os + 4);
            const v4u ow = *(const v4u*)(P + (size_t)(t0 + ll) * NPO + 1536 + h * 128 + 8 * ch); const float* hw = KIN(I_HNW) + j * 512 + h * 128 + 8 * ch; const f32x4 h0 = *(const f32x4*)hw, h1 = *(const f32x4*)(hw + 4);
            v4u res; res.x = pk2(o0[0] * h0[0] * sigmoid_f(bflo(ow.x)), o0[1] * h0[1] * sigmoid_f(bfhi(ow.x))); res.y = pk2(o0[2] * h0[2] * sigmoid_f(bflo(ow.y)), o0[3] * h0[3] * sigmoid_f(bfhi(ow.y)));
            res.z = pk2(o1[0] * h1[0] * sigmoid_f(bflo(ow.z)), o1[1] * h1[1] * sigmoid_f(bfhi(ow.z))); res.w = pk2(o1[2] * h1[2] * sigmoid_f(bflo(ow.w)), o1[3] * h1[3] * sigmoid_f(bfhi(ow.w)));
            *(v4u*)(MIX + (size_t)(t0 + ll) * D + h * 128 + 8 * ch) = res; }
    }
}
template <bool XIN> __device__ __forceinline__ void p_ln1_route(Frame& F0, int layer) {   Frame F = F0; asm volatile("" : "+v"(F.tid), "+v"(F.lane));
    const bf16* OUTP = (const bf16*)(kws() + WS_R1); const bf16* HB = (const bf16*)(kws() + WS_HB); bf16* H1B = (bf16*)(kws() + WS_H1B);
    i32x4* ROUTE = (i32x4*)(kws() + WS_ROUTE); f32x2* GATE = (f32x2*)(kws() + WS_GATE); int* BCNT = (int*)(kws() + WS_BCNT);
    LAS int* cnt = (LAS int*)(F.lds + SMALL_OFF);
    const float* g1 = KIN(I_LN1G) + (size_t)layer * D; const float* b1 = KIN(I_LN1B) + (size_t)layer * D;
    const f32x4* rgw = (const f32x4*)(kws() + WS_TAB + (size_t)layer * TAB_LAYER + TAB_RGW); const float* rgb = KIN(I_RGB) + layer * 4; const f32x4* rew = (const f32x4*)(kws() + WS_TAB + (size_t)layer * TAB_LAYER + TAB_REW); const float* reb = KIN(I_REB) + layer * 32;
    __syncthreads();
    if (F.tid < 32) cnt[F.tid] = 0;
    __syncthreads();
    const LAS unsigned char* wl = F.lds + F.wave * 12288; const unsigned wla = (unsigned)(uintptr_t)(F.lds) + F.wave * 12288;
#define LN1_ISSUE(m0_) do { _Pragma("unroll") for (int rr = 0; rr < 2; ++rr) { const int m_ = (m0_) + rr * F.NGW < T ? (m0_) + rr * F.NGW : (m0_); \
        if constexpr (XIN) row_dma<4>(KIN(I_X) + (size_t)m_ * D, wla + rr * 6144, F.lane); else row_dma<2>(HB + (size_t)m_ * D, wla + rr * 6144, F.lane); \
        row_dma<2>(OUTP + (size_t)m_ * D, wla + rr * 6144 + 4096, F.lane); } } while (0)
    if (F.gw < T) LN1_ISSUE(F.gw);
#pragma unroll 1
    for (int m0 = F.gw; m0 < T; m0 += 2 * F.NGW) {
        const int m1 = m0 + F.NGW < T ? m0 + F.NGW : -1; const int mm[2] = {m0, m1 >= 0 ? m1 : m0};
        f32x4 v[2][4], a[2][4];
        DMA_WAIT_ALL();
#pragma unroll
        for (int rr = 0; rr < 2; ++rr) { if constexpr (XIN) row_load_f32_lds(wl + rr * 6144, F.lane, v[rr]); else row_load_bf16_lds(wl + rr * 6144, F.lane, v[rr]); row_load_bf16_lds(wl + rr * 6144 + 4096, F.lane, a[rr]); }
        LDS_WAIT();
        if (m0 + 2 * F.NGW < T) LN1_ISSUE(m0 + 2 * F.NGW);
#pragma unroll
        for (int rr = 0; rr < 2; ++rr) {
#pragma unroll
            for (int jj = 0; jj < 4; ++jj) v[rr][jj] = v[rr][jj] * ALPHA + a[rr][jj];
            row_layernorm(v[rr], g1, b1, F.lane); }
        row_store_bf16(H1B + (size_t)m0 * D, F.lane, v[0]); if (m1 >= 0) row_store_bf16(H1B + (size_t)m1 * D, F.lane, v[1]);
        float gl[2][4];
#pragma unroll
        for (int c = 0; c < 4; ++c) { gl[0][c] = 0.f; gl[1][c] = 0.f; }
#pragma unroll
        for (int jj = 0; jj < 4; ++jj)
#pragma unroll
            for (int i = 0; i < 4; ++i) { const f32x4 w = rgw[(jj * 4 + i) * 64 + F.lane];
#pragma unroll
                for (int c = 0; c < 4; ++c) { gl[0][c] += v[0][jj][i] * w[c]; gl[1][c] += v[1][jj][i] * w[c]; } }
        int gi[2]; float pg[2];
#pragma unroll
        for (int rr = 0; rr < 2; ++rr) { const float red = wave_reduce_multi<4>(gl[rr], F.lane); float l4[4];
#pragma unroll
            for (int c = 0; c < 4; ++c) l4[c] = __shfl(red, 16 * c) + rgb[c];
            int g = 0; float gm = l4[0];
#pragma unroll
            for (int c = 1; c < 4; ++c) if (l4[c] > gm) { gm = l4[c]; g = c; }
            float se = 0.f;
#pragma unroll
            for (int c = 0; c < 4; ++c) se += expf(l4[c] - gm);
            gi[rr] = g; pg[rr] = 1.0f / se; }
        float el[2][8];
#pragma unroll
        for (int rr = 0; rr < 2; ++rr) { const f32x4* rw = rew + (size_t)gi[rr] * 2048 + F.lane;
#pragma unroll
            for (int c = 0; c < 8; ++c) el[rr][c] = 0.f;
#pragma unroll
            for (int jj = 0; jj < 4; ++jj)
#pragma unroll
                for (int i = 0; i < 4; ++i) { const f32x4 w0 = rw[(jj * 4 + i) * 128], w1 = rw[(jj * 4 + i) * 128 + 64];
#pragma unroll
                    for (int c = 0; c < 4; ++c) { el[rr][c] += v[rr][jj][i] * w0[c]; el[rr][4 + c] += v[rr][jj][i] * w1[c]; } } }
#pragma unroll
        for (int rr = 0; rr < 2; ++rr) { const float red = wave_reduce_multi<8>(el[rr], F.lane); float e8[8];
#pragma unroll
            for (int c = 0; c < 8; ++c) e8[c] = __shfl(red, 8 * c) + reb[gi[rr] * 8 + c];
            int i0 = 0; float v0 = e8[0];
#pragma unroll
            for (int c = 1; c < 8; ++c) if (e8[c] > v0) { v0 = e8[c]; i0 = c; }
            int i1 = -1; float v1 = -INFINITY;
#pragma unroll
            for (int c = 0; c < 8; ++c) if (c != i0 && e8[c] > v1) { v1 = e8[c]; i1 = c; }
            if (i1 < 0) i1 = (i0 + 1) & 7;
            const float ee = expf(v1 - v0), g0 = pg[rr] / (1.0f + ee), g1v = pg[rr] * ee / (1.0f + ee);
            if (F.lane == 0 && (rr == 0 || m1 >= 0)) { const int e0 = gi[rr] * 8 + i0, e1 = gi[rr] * 8 + i1;
                const int r0 = __hip_atomic_fetch_add(cnt + e0, 1, __ATOMIC_RELAXED, __HIP_MEMORY_SCOPE_WORKGROUP), r1 = __hip_atomic_fetch_add(cnt + e1, 1, __ATOMIC_RELAXED, __HIP_MEMORY_SCOPE_WORKGROUP);
                ROUTE[mm[rr]] = (i32x4){e0, r0, e1, r1}; GATE[mm[rr]] = (f32x2){g0, g1v}; } }
    }
#undef LN1_ISSUE
    __syncthreads();
    if (F.tid < 32) BCNT[F.vcu * 32 + F.tid] = cnt[F.tid];
}
__device__ __forceinline__ void p_scatter(Frame& F0) {   Frame F = F0; asm volatile("" : "+v"(F.tid), "+v"(F.lane));
    const int* BCNT = (const int*)(kws() + WS_BCNT); int* PANEL = (int*)(kws() + WS_PANEL); const i32x4* ROUTE = (const i32x4*)(kws() + WS_ROUTE); i32x2* POS = (i32x2*)(kws() + WS_POS);
    const bf16* H1B = (const bf16*)(kws() + WS_H1B); bf16* XS = (bf16*)(kws() + WS_R1);
    LAS int* pa = (LAS int*)(F.lds + SMALL_OFF); LAS int* pb = pa + 512; LAS int* tot = pa + 1024; LAS int* bef = pa + 1056; LAS int* base = pa + 1088;
    __syncthreads();
    { const int e = F.tid & 31, part = F.tid >> 5; int sa = 0, sb = 0;
        for (int b = part; b < F.G; b += 16) { const int c = BCNT[b * 32 + e]; sa += c; if (b < F.vcu) sb += c; }
        pa[part * 32 + e] = sa; pb[part * 32 + e] = sb; }
    __syncthreads();
    if (F.tid < 32) { int sa = 0, sb = 0; for (int p = 0; p < 16; ++p) { sa += pa[p * 32 + F.tid]; sb += pb[p * 32 + F.tid]; } tot[F.tid] = sa; bef[F.tid] = sb; }
    __syncthreads();
    if (F.tid == 0) { int off = 0, np = 0;
        for (int e = 0; e < 32; ++e) { const int npan = (tot[e] + 255) >> 8; base[e] = off + bef[e];
            if (F.vcu == 0) for (int p = 0; p < npan; ++p) PANEL[1 + np + p] = e;
            np += npan; off += npan * 256; }
        if (F.vcu == 0) PANEL[0] = np; }
    __syncthreads();
#pragma unroll 1
    for (int m0 = F.gw; m0 < T; m0 += 4 * F.NGW) {
        i32x4 r[4]; v4u w[4][2];
#pragma unroll
        for (int rr = 0; rr < 4; ++rr) { const int m = m0 + rr * F.NGW < T ? m0 + rr * F.NGW : m0; r[rr] = ROUTE[m]; const v4u* src = (const v4u*)(H1B + (size_t)m * D); w[rr][0] = src[F.lane]; w[rr][1] = src[F.lane + 64]; }
#pragma unroll
        for (int rr = 0; rr < 4; ++rr) { const int m = m0 + rr * F.NGW; if (m < T) { const int p0 = base[r[rr].x] + r[rr].y, p1 = base[r[rr].z] + r[rr].w;
            if (F.lane == 0) POS[m] = (i32x2){p0, p1};
            v4u* d0 = (v4u*)(XS + (size_t)p0 * D); v4u* d1 = (v4u*)(XS + (size_t)p1 * D);
            d0[F.lane] = w[rr][0]; d0[F.lane + 64] = w[rr][1]; d1[F.lane] = w[rr][0]; d1[F.lane + 64] = w[rr][1]; } } }
}
__device__ __forceinline__ void p_combine(Frame& F0, int layer) {   Frame F = F0; asm volatile("" : "+v"(F.tid), "+v"(F.lane));
    const bf16* H1B = (const bf16*)(kws() + WS_H1B); const bf16* EOUT = (const bf16*)(kws() + WS_R1); const i32x2* POS = (const i32x2*)(kws() + WS_POS); const f32x2* GATE = (const f32x2*)(kws() + WS_GATE);
    bf16* HB = (bf16*)(kws() + WS_HB);
    const float* g2 = KIN(I_LN2G) + (size_t)layer * D; const float* b2 = KIN(I_LN2B) + (size_t)layer * D;
    const LAS unsigned char* wl = F.lds + F.wave * 12288; const unsigned wla = (unsigned)(uintptr_t)(F.lds) + F.wave * 12288;
    i32x2 myps = (i32x2){0, 0}; f32x2 mygt = (f32x2){0.f, 0.f};
    { const int mr = F.gw + F.lane * F.NGW; if (mr < T) { myps = POS[mr]; mygt = GATE[mr]; } }
#define CMB_ISSUE(m0_, i_) do { _Pragma("unroll") for (int rr = 0; rr < 2; ++rr) { const bool ok_ = (m0_) + rr * F.NGW < T; const int m_ = ok_ ? (m0_) + rr * F.NGW : (m0_); const int ri_ = ok_ ? (i_) + rr : (i_); \
        const int px_ = __shfl(myps.x, ri_), py_ = __shfl(myps.y, ri_); \
        row_dma<2>(H1B + (size_t)m_ * D, wla + rr * 6144, F.lane); row_dma<2>(EOUT + (size_t)px_ * D, wla + rr * 6144 + 2048, F.lane); row_dma<2>(EOUT + (size_t)py_ * D, wla + rr * 6144 + 4096, F.lane); } } while (0)
    if (F.gw < T) CMB_ISSUE(F.gw, 0);
    int ri = 0;
#pragma unroll 1
    for (int m0 = F.gw; m0 < T; m0 += 2 * F.NGW, ri += 2) {
        const int m1 = m0 + F.NGW < T ? m0 + F.NGW : -1;
        f32x4 v[2][4], ea[2][4], eb[2][4]; f32x2 gt[2];
        gt[0] = (f32x2){__shfl(mygt.x, ri), __shfl(mygt.y, ri)}; gt[1] = (f32x2){__shfl(mygt.x, ri + (m1 >= 0)), __shfl(mygt.y, ri + (m1 >= 0))};
        DMA_WAIT_ALL();
#pragma unroll
        for (int rr = 0; rr < 2; ++rr) { row_load_bf16_lds(wl + rr * 6144, F.lane, v[rr]); row_load_bf16_lds(wl + rr * 6144 + 2048, F.lane, ea[rr]); row_load_bf16_lds(wl + rr * 6144 + 4096, F.lane, eb[rr]); }
        LDS_WAIT();
        if (m0 + 2 * F.NGW < T) CMB_ISSUE(m0 + 2 * F.NGW, ri + 2);
#pragma unroll
        for (int rr = 0; rr < 2; ++rr) {
#pragma unroll
            for (int jj = 0; jj < 4; ++jj) v[rr][jj] = v[rr][jj] * ALPHA + (ea[rr][jj] * gt[rr].x + eb[rr][jj] * gt[rr].y);
            row_layernorm(v[rr], g2, b2, F.lane); }
        if (layer == DEPTH - 1) { row_store_f32(kout() + (size_t)m0 * D, F.lane, v[0]); if (m1 >= 0) row_store_f32(kout() + (size_t)m1 * D, F.lane, v[1]); }
        else { row_store_bf16(HB + (size_t)m0 * D, F.lane, v[0]); if (m1 >= 0) row_store_bf16(HB + (size_t)m1 * D, F.lane, v[1]); row_gate_proj2(F, v[0], v[1], layer + 1, m0, m1); } }
#undef CMB_ISSUE
}
#ifndef PHASE_MASK
#define PHASE_MASK 0x1fff
#endif
#define PH_EN(k) (((PHASE_MASK) >> (k)) & 1)
#ifndef PROBE_DUP
#define PROBE_DUP 0
#endif
#define TPROBE(k) ((((PROBE_DUP) >> (k)) & 1) != 0)
#define TWAIT(k) do { if constexpr (TPROBE(k)) { const unsigned long long t1_ = __builtin_amdgcn_s_memrealtime(); while (__builtin_amdgcn_s_memrealtime() - t1_ < (t1_ - tp0_)) __builtin_amdgcn_s_sleep(8); } } while (0)
#define IN(k) (lo <= (k) && (k) < hi)
#define SEAM(k) do { if ((k) + 1 < hi) xcd_barrier(bar); } while (0)
template <int LAYER> __device__ __forceinline__ void layer_body(Frame& F, const int lo, const int hi, const XcdBarrier& bar) {
        constexpr int layer = LAYER, pb = 1 + LAYER * NPH_LAYER, j = LAYER >> 1; constexpr bool odd = (LAYER & 1) != 0;
        bf16* HB = (bf16*)(kws() + WS_HB); bf16* MIX = (bf16*)(kws() + WS_MIX);
        if constexpr (PH_EN(0)) if (IN(pb + 0)) { const unsigned long long tp0_ = TPROBE(0) ? __builtin_amdgcn_s_memrealtime() : 0ull;
            const int N = odd ? NPO : NPE; const bf16* Bt = odd ? (const bf16*)(kws() + WS_WINO) + (size_t)j * NPO * D : (const bf16*)(kws() + WS_WINE) + (size_t)j * NPE * D;
            pg8::Gemm g{HB, Bt, T, N, D, 0}; pg8::StaticOrder S; S.init(T, N, F.G, (int)blockIdx.x);
            pg8::EpiStoreBf16 E{(bf16*)(kws() + WS_R1), N};
            pg8::gemm_phase<pg8::EpiStoreBf16, pg8::StaticOrder, true, true>(F.lds, g, S, E);
            SEAM(pb + 0); TWAIT(0); }
        if constexpr (!odd) {
            if constexpr (PH_EN(1)) if (IN(pb + 1)) { const unsigned long long tp0_ = TPROBE(1) ? __builtin_amdgcn_s_memrealtime() : 0ull; e0_conv(F, j); SEAM(pb + 1); TWAIT(1); }
            if constexpr (PH_EN(2)) if (IN(pb + 2)) { const unsigned long long tp0_ = TPROBE(2) ? __builtin_amdgcn_s_memrealtime() : 0ull; if constexpr (SSD_NAIVE) e1_states(F, j); else e1_states_mfma(F, j); SEAM(pb + 2); TWAIT(2); }
            if constexpr (PH_EN(3)) if (IN(pb + 3)) { const unsigned long long tp0_ = TPROBE(3) ? __builtin_amdgcn_s_memrealtime() : 0ull; e2_scan(F); SEAM(pb + 3); TWAIT(3); }
            if constexpr (PH_EN(4)) if (IN(pb + 4)) { const unsigned long long tp0_ = TPROBE(4) ? __builtin_amdgcn_s_memrealtime() : 0ull; if constexpr (SSD_NAIVE) e3_output(F, j); else e3_output_mfma(F, j); SEAM(pb + 4); TWAIT(4); }
            if constexpr (PH_EN(5)) if (IN(pb + 5)) { const unsigned long long tp0_ = TPROBE(5) ? __builtin_amdgcn_s_memrealtime() : 0ull; e4_gnorm(F); SEAM(pb + 5); TWAIT(5); }
        } else {
            if constexpr (PH_EN(1)) if (IN(pb + 1)) { const unsigned long long tp0_ = TPROBE(1) ? __builtin_amdgcn_s_memrealtime() : 0ull; o_foxscan(F, j); if constexpr (MLSTM_NAIVE) o1_local(F, j); else o1_local_mfma(F, j); SEAM(pb + 1); TWAIT(1); }
            if constexpr (PH_EN(2)) if (IN(pb + 2)) { const unsigned long long tp0_ = TPROBE(2) ? __builtin_amdgcn_s_memrealtime() : 0ull; o2_scan(F); SEAM(pb + 2); TWAIT(2); }
            if constexpr (PH_EN(3)) if (IN(pb + 3)) { const unsigned long long tp0_ = TPROBE(3) ? __builtin_amdgcn_s_memrealtime() : 0ull;
#if FOX_NAIVE
                o4_fox(F);
#else
                const attn_body::bf16* PR = (const attn_body::bf16*)(kws() + WS_R1);
                const attn_body::AttnTensors AT{PR + 2048, PR + 2560, PR + 3072, (attn_body::bf16*)(kws() + WS_MIX) + 512, (const float*)(kws() + WS_FOXC)};
                const attn_body::StaticOrder S((int)F.G, F.vcu);
                attn_body::attn_phase<attn_body::StaticOrder>((char*)F.lds, AT, S);
#endif
                __syncthreads();
                if constexpr (MLSTM_NAIVE) o3_output(F, j); else o3_output_mfma(F, j); SEAM(pb + 3); TWAIT(3); }
        }
        if constexpr (PH_EN(6)) if (IN(pb + 6)) { const unsigned long long tp0_ = TPROBE(6) ? __builtin_amdgcn_s_memrealtime() : 0ull;
            const int K = odd ? D : 1536; const bf16* Bt = odd ? (const bf16*)(kws() + WS_WOUTO) + (size_t)j * D * D : (const bf16*)(kws() + WS_WOUTE) + (size_t)j * D * 1536;
            pg8::Gemm g{MIX, Bt, T, D, K, 0}; pg8::StaticOrder S; S.init(T, D, F.G, (int)blockIdx.x);
            pg8::EpiStoreBf16 E{(bf16*)(kws() + WS_R1), D};
            pg8::gemm_phase<pg8::EpiStoreBf16, pg8::StaticOrder, false, true>(F.lds, g, S, E);
            SEAM(pb + 6); TWAIT(6); }
        if constexpr (PH_EN(7)) if (IN(pb + 7)) { const unsigned long long tp0_ = TPROBE(7) ? __builtin_amdgcn_s_memrealtime() : 0ull; p_ln1_route<LAYER == 0>(F, layer); SEAM(pb + 7); TWAIT(7); }
        if constexpr (PH_EN(8)) if (IN(pb + 8)) { const unsigned long long tp0_ = TPROBE(8) ? __builtin_amdgcn_s_memrealtime() : 0ull; p_scatter(F); SEAM(pb + 8); TWAIT(8); }
        if constexpr (PH_EN(9)) if (IN(pb + 9)) { const unsigned long long tp0_ = TPROBE(9) ? __builtin_amdgcn_s_memrealtime() : 0ull;
            pg8::Gemm g{(const bf16*)(kws() + WS_R1), (const bf16*)(kws() + WS_WGU) + (size_t)layer * 32 * D * D, RPAD, D, D, (size_t)D * D * 2};
            pg8::MoeOrder S; S.initm((const int*)(kws() + WS_PANEL), 4, F.G, (int)blockIdx.x);
            pg8::EpiSwiglu E{(bf16*)(kws() + WS_R3), 512};
            pg8::gemm_phase<pg8::EpiSwiglu, pg8::MoeOrder, true, true>(F.lds, g, S, E);
            SEAM(pb + 9); TWAIT(9); }
        if constexpr (PH_EN(10)) if (IN(pb + 10)) { const unsigned long long tp0_ = TPROBE(10) ? __builtin_amdgcn_s_memrealtime() : 0ull;
            pg8::Gemm g{(const bf16*)(kws() + WS_R3), (const bf16*)(kws() + WS_WD) + (size_t)layer * 32 * D * 512, RPAD, D, 512, (size_t)D * 512 * 2};
            pg8::MoeOrder S; S.initm((const int*)(kws() + WS_PANEL), 4, F.G, (int)blockIdx.x);
            pg8::EpiStoreBf16 E{(bf16*)(kws() + WS_R1), D};
            pg8::gemm_phase<pg8::EpiStoreBf16, pg8::MoeOrder, true, true>(F.lds, g, S, E);
            SEAM(pb + 10); TWAIT(10); }
        if constexpr (PH_EN(11)) if (IN(pb + 11)) { const unsigned long long tp0_ = TPROBE(11) ? __builtin_amdgcn_s_memrealtime() : 0ull; p_combine(F, layer); SEAM(pb + 11); TWAIT(11); }
}
struct Args { const float* in[27]; float* out; unsigned char* ws; int ph_lo, ph_hi; };
__global__ void __launch_bounds__(NWAVES * 64, 2) fwd_kernel(Args args) {
    extern __shared__ __attribute__((aligned(16))) unsigned char lds[];
    Frame F;
    F.lds = (LAS unsigned char*)lds;
    F.MISC = (volatile LAS unsigned*)(F.lds + MISC_OFF);
    F.tid = threadIdx.x; F.lane = F.tid & 63; F.wave = __builtin_amdgcn_readfirstlane(F.tid >> 6);
    F.G = gridDim.x; { const int bx = blockIdx.x; F.vcu = (F.G % 8 == 0) ? (bx % 8) * (F.G / 8) + bx / 8 : bx; }
    F.gw = F.vcu * NWAVES + F.wave; F.NGW = F.G * NWAVES;
    F.ctl = (unsigned*)(args.ws + WS_CTL);
    const int lo = args.ph_lo, hi = args.ph_hi;
    for (int u = F.tid; u < (LDS_BYTES - MISC_OFF) / 4; u += NWAVES * 64) ((LAS unsigned*)(F.lds + MISC_OFF))[u] = 0u;
    __syncthreads();
    XcdBarrier bar; bar.bar = F.ctl + CW_BAR; bar.x = 0; bar.st = nullptr;
    if (hi - lo > 1) bar = xcd_barrier_post(F.ctl + CW_BAR, F.MISC + 8);
    if constexpr (PH_EN(12)) if (IN(0)) { const unsigned long long tp0_ = TPROBE(12) ? __builtin_amdgcn_s_memrealtime() : 0ull; p_prologue(F); SEAM(0); TWAIT(12); }
    layer_body<0>(F, lo, hi, bar); layer_body<1>(F, lo, hi, bar); layer_body<2>(F, lo, hi, bar); layer_body<3>(F, lo, hi, bar);
#undef IN
#undef SEAM
}

extern "C" void kernel_launch(void* const* d_in, const int* in_sizes, int n_in, void* d_out, int out_size, void* d_ws, size_t ws_size, hipStream_t stream) {
    static int grid = 0;
    if (grid == 0) {
        if (n_in != 27 || in_sizes[0] != T * D || out_size != T * D || ws_size < WS_END) { fprintf(stderr, "kernel_launch: unexpected shapes (n_in %d, in0 %d, out %d, ws %zu); nothing launched\n", n_in, n_in > 0 ? in_sizes[0] : -1, out_size, ws_size); grid = -1; return; }
        int dev = 0, cus = 0, per_cu = 0;
        if (hipGetDevice(&dev) != hipSuccess || hipDeviceGetAttribute(&cus, hipDeviceAttributeMultiprocessorCount, dev) != hipSuccess) { grid = -1; return; }
        if (hipFuncSetAttribute((const void*)fwd_kernel, hipFuncAttributeMaxDynamicSharedMemorySize, LDS_BYTES) != hipSuccess) { fprintf(stderr, "kernel_launch: hipFuncSetAttribute failed\n"); grid = -1; return; }
        if (hipOccupancyMaxActiveBlocksPerMultiprocessor(&per_cu, (const void*)fwd_kernel, NWAVES * 64, LDS_BYTES) != hipSuccess || per_cu < 1) fprintf(stderr, "kernel_launch: note: occupancy query reports %d workgroups per CU\n", per_cu);
        (void)hipGetLastError();
        grid = cus;
    }
    if (grid < 0) return;
    if (hipMemsetAsync((char*)d_ws + WS_CTL, 0, CTL_ZERO_BYTES, stream) != hipSuccess) return;
    Args a{};
    for (int i = 0; i < 27; ++i) a.in[i] = (const float*)d_in[i];
    a.out = (float*)d_out; a.ws = (unsigned char*)d_ws;
#if MK_ONE_LAUNCH
    a.ph_lo = 0; a.ph_hi = NPHASES;
    hipLaunchKernelGGL(fwd_kernel, dim3(grid), dim3(NWAVES * 64), LDS_BYTES, stream, a);
#else
    for (int ph = 0; ph < NPHASES; ++ph) {
        if (ph > 0 && (((ph - 1) / NPH_LAYER) & 1) && ((ph - 1) % NPH_LAYER) == 5) continue;
        a.ph_lo = ph; a.ph_hi = ph + 1;
        hipLaunchKernelGGL(fwd_kernel, dim3(grid), dim3(NWAVES * 64), LDS_BYTES, stream, a);
    }
#endif
}
```

```cpp
#include <hip/hip_runtime.h>
#include <cstdio>
#include <cstdint>
__device__ __forceinline__ float silu_f(float x) { return x / (1.0f + __expf(-x)); }
namespace pg8 {
#define PG8_LAS __attribute__((address_space(3)))
typedef unsigned short bf16_t;
typedef short bf16x8 __attribute__((ext_vector_type(8)));
typedef float f32x4 __attribute__((ext_vector_type(4)));
typedef unsigned u32x4 __attribute__((ext_vector_type(4)));
constexpr int BM = 256, BK = 64, HALF = 128, HTB = HALF * BK * 2  , STAGE_BYTES = 8 * HTB, NXCD = 8, WGM = 8;

__host__ __device__ __forceinline__ int lds_byte(int r, int c) { const int st = (r >> 4) * 2 + (c >> 5), rr = r & 15, cc = c & 31, ob = rr * 64 + cc * 2; return st * 1024 + (ob ^ (((ob >> 9) & 1) << 5)); }
__host__ __device__ __forceinline__ void stage_rc(int b, int& R, int& C) { const int st = b / 1024, sb = b % 1024, swz = sb ^ (((sb >> 9) & 1) << 5); R = (st >> 1) * 16 + swz / 64; C = (st & 1) * 32 + (swz % 64) / 2; }
__host__ __device__ __forceinline__ int perm32(int rho) { const int n = rho >> 4, i = rho & 15; return 8 * (i >> 2) + 4 * n + (i & 3); }

struct Unit { int pm, pn, be; };
struct Gemm { const bf16_t* A; const bf16_t* Bt; int M, N, K; size_t bstride; };

struct StaticOrder {
    int nM, nN, nwg, G, c;
    __host__ __device__ void init(int M, int N, int G_, int c_) { nM = M / BM; nN = N / BM; nwg = nM * nN; G = G_; c = c_; }
    __host__ __device__ bool next(int i, Unit& u) const {
        const long L = (long)i * G + c; if (L >= nwg) return false;
        int wgid = (int)L; { const int q = nwg / NXCD, r = nwg % NXCD, xcd = wgid % NXCD, off = wgid / NXCD; wgid = (xcd < r ? xcd * (q + 1) : r * (q + 1) + (xcd - r) * q) + off; }
        const int nig = WGM * nN, gid = wgid / nig, fm = gid * WGM, gsz = (nM - fm) < WGM ? (nM - fm) : WGM;
        u.pm = fm + ((wgid % nig) % gsz); u.pn = (wgid % nig) / gsz; u.be = 0; return true;
    }
    __device__ __forceinline__ void a_ready(const Unit&) const {}
    __device__ __forceinline__ void done(const Unit&) const {}
};

__device__ __forceinline__ unsigned cvt_pk_bf16(float lo, float hi) { unsigned r; asm volatile("v_cvt_pk_bf16_f32 %0, %1, %2" : "=v"(r) : "v"(lo), "v"(hi)); return r; }
struct EpiStoreBf16 {
    static constexpr bool PERM = true, AFTER_DRAIN = false;
    bf16_t* O; int ldc;
    __device__ __forceinline__ void operator()(const f32x4 (&acc)[2][2][4][2], const Unit& u, int wr, int wc, int fr, int fq) const {
        const int row0 = u.pm * BM + wr * 64 + fr, col0 = u.pn * BM + wc * 32 + 8 * fq;
#pragma unroll
        for (int ai = 0; ai < 2; ++ai)
#pragma unroll
            for (int m = 0; m < 4; ++m) { bf16_t* rowp = O + (size_t)(row0 + ai * HALF + m * 16) * ldc + col0;
#pragma unroll
                for (int bj = 0; bj < 2; ++bj) { const f32x4 v0 = acc[ai][bj][m][0], v1 = acc[ai][bj][m][1];
                    u32x4 w; w.x = cvt_pk_bf16(v0[0], v0[1]); w.y = cvt_pk_bf16(v0[2], v0[3]); w.z = cvt_pk_bf16(v1[0], v1[1]); w.w = cvt_pk_bf16(v1[2], v1[3]);
                    *(u32x4*)(rowp + bj * HALF) = w; } }
    }
};
struct EpiStoreF32 {
    static constexpr bool PERM = false, AFTER_DRAIN = false;
    float* C; int ldc;
    __device__ __forceinline__ void operator()(const f32x4 (&acc)[2][2][4][2], const Unit& u, int wr, int wc, int fr, int fq) const {
        const int row0 = u.pm * BM + wr * 64 + fr, col0 = u.pn * BM + wc * 32 + 4 * fq;
#pragma unroll
        for (int ai = 0; ai < 2; ++ai)
#pragma unroll
            for (int m = 0; m < 4; ++m) { float* rowp = C + (size_t)(row0 + ai * HALF + m * 16) * ldc + col0;
#pragma unroll
                for (int bj = 0; bj < 2; ++bj)
#pragma unroll
                    for (int n = 0; n < 2; ++n) *(f32x4*)(rowp + bj * HALF + n * 16) = acc[ai][bj][m][n]; }
    }
};
struct EpiSwiglu {
    static constexpr bool PERM = true, AFTER_DRAIN = false;
    bf16_t* O; int ldc;
    __device__ __forceinline__ void operator()(const f32x4 (&acc)[2][2][4][2], const Unit& u, int wr, int wc, int fr, int fq) const {
        const int row0 = u.pm * BM + wr * 64 + fr, col0 = u.pn * HALF + wc * 32 + 8 * fq;
#pragma unroll
        for (int ai = 0; ai < 2; ++ai)
#pragma unroll
            for (int m = 0; m < 4; ++m) { bf16_t* rowp = O + (size_t)(row0 + ai * HALF + m * 16) * ldc + col0;
                const f32x4 g0 = acc[ai][0][m][0], g1 = acc[ai][0][m][1], u0 = acc[ai][1][m][0], u1 = acc[ai][1][m][1];
                float h[8];
#pragma unroll
                for (int i = 0; i < 4; ++i) { h[i] = silu_f(g0[i]) * u0[i]; h[4 + i] = silu_f(g1[i]) * u1[i]; }
                u32x4 w; w.x = cvt_pk_bf16(h[0], h[1]); w.y = cvt_pk_bf16(h[2], h[3]); w.z = cvt_pk_bf16(h[4], h[5]); w.w = cvt_pk_bf16(h[6], h[7]);
                *(u32x4*)rowp = w; }
    }
};
struct MoeOrder : StaticOrder {
    const int* tab;
    __device__ __forceinline__ void initm(const int* tab_, int nN_, int G_, int c_) { tab = tab_; nM = tab_[0]; nN = nN_; nwg = nM * nN; G = G_; c = c_; }
    __device__ __forceinline__ bool next(int i, Unit& u) const { if (!StaticOrder::next(i, u)) return false; u.be = tab[1 + u.pm]; return true; }
};
template <class Epi, class Sched, bool ALIGN_EPI = false, bool SP2 = false>
__device__ __forceinline__ void gemm_phase(PG8_LAS unsigned char* lds, const Gemm g, const Sched& S, const Epi& E) {
    const int tid = threadIdx.x, wid = __builtin_amdgcn_readfirstlane(tid >> 6), lane = tid & 63, wr = wid >> 2, wc = wid & 3, fr = lane & 15, fq = lane >> 4;
    const int K = g.K, nt = K / BK;
    unsigned voffA[2], voffB[2];
#pragma unroll
    for (int i = 0; i < 2; ++i) { int R, C; stage_rc(tid * 16 + i * 8192, R, C); const int Rb = Epi::PERM ? ((R & ~31) + perm32(R & 31)) : R;
        voffA[i] = (unsigned)(R * K + C) * 2u; voffB[i] = (unsigned)(Rb * K + C) * 2u; }
    const size_t kstep = (size_t)(BK * 2);
    const size_t hstep = (size_t)HALF * K * 2;
    const size_t tstep = 2 * hstep;
    const unsigned ldsw = (unsigned)wid * 1024u;
    const int aoff = lds_byte(wr * 64 + fr, fq * 8), boff = lds_byte(wc * 32 + fr, fq * 8);
#define PG8_SA(b, h) (((b) * 2 + (h)) * HTB)
#define PG8_SB(b, h) ((4 + (b) * 2 + (h)) * HTB)
#define PG8_STAGE(bufoff, gbase, voff) do { _Pragma("unroll") for (int _i = 0; _i < 2; ++_i) \
        __builtin_amdgcn_global_load_lds((const unsigned*)((const char*)(gbase) + (voff)[_i]), (PG8_LAS unsigned*)(lds + (bufoff) + ldsw + _i * 8192), 16, 0, 0); } while (0)
#define PG8_LDA(dst, b, h) do { _Pragma("unroll") for (int m = 0; m < 4; ++m) _Pragma("unroll") for (int k = 0; k < 2; ++k) dst[m][k] = *(const PG8_LAS bf16x8*)(lds + PG8_SA(b, h) + aoff + m * 2048 + k * 1024); } while (0)
#define PG8_LDB(dst, b, h) do { _Pragma("unroll") for (int n = 0; n < 2; ++n) _Pragma("unroll") for (int k = 0; k < 2; ++k) dst[n][k] = *(const PG8_LAS bf16x8*)(lds + PG8_SB(b, h) + boff + n * 2048 + k * 1024); } while (0)
#define PG8_MMA(ai, bj, At, Bt) do { __builtin_amdgcn_s_setprio(1); _Pragma("unroll") for (int m = 0; m < 4; ++m) _Pragma("unroll") for (int n = 0; n < 2; ++n) _Pragma("unroll") for (int k = 0; k < 2; ++k) \
        acc[ai][bj][m][n] = __builtin_amdgcn_mfma_f32_16x16x32_bf16(Bt[n][k], At[m][k], acc[ai][bj][m][n], 0, 0, 0); __builtin_amdgcn_s_setprio(0); } while (0)
#define PG8_WAIT_V(n) asm volatile("s_waitcnt vmcnt(" #n ")" ::: "memory")
#define PG8_WAIT_L(n) asm volatile("s_waitcnt lgkmcnt(" #n ")" ::: "memory")
#define PG8_BAR __builtin_amdgcn_s_barrier()
#define PG8_SCHED __builtin_amdgcn_sched_barrier(0)
    Unit cur, nxt; int ui = 0;
    if (!S.next(0, cur)) return;
    f32x4 acc[2][2][4][2];
#pragma unroll
    for (int a = 0; a < 2; ++a)
#pragma unroll
        for (int b = 0; b < 2; ++b)
#pragma unroll
            for (int m = 0; m < 4; ++m)
#pragma unroll
                for (int n = 0; n < 2; ++n) acc[a][b][m][n] = (f32x4){0.f, 0.f, 0.f, 0.f};
    bf16x8 At[4][2], B0[2][2], B1[2][2];
    const char* cA = (const char*)g.A + (size_t)cur.pm * tstep; const char* cB = (const char*)g.Bt + (size_t)cur.be * g.bstride + (size_t)cur.pn * tstep;
    S.a_ready(cur);
    if constexpr (SP2) {
        PG8_STAGE(PG8_SB(0, 0), cB, voffB); PG8_STAGE(PG8_SB(0, 1), cB + hstep, voffB); PG8_STAGE(PG8_SA(0, 0), cA, voffA); PG8_STAGE(PG8_SA(0, 1), cA + hstep, voffA);
        if (wr == 1) PG8_BAR;
        PG8_WAIT_V(2); PG8_BAR;
        PG8_STAGE(PG8_SB(1, 0), cB + kstep, voffB); PG8_STAGE(PG8_SA(1, 0), cA + kstep, voffA); PG8_STAGE(PG8_SB(1, 1), cB + hstep + kstep, voffB);
        PG8_WAIT_V(6); PG8_BAR;
    } else {
        PG8_STAGE(PG8_SB(0, 0), cB, voffB); PG8_STAGE(PG8_SA(0, 0), cA, voffA); PG8_STAGE(PG8_SB(0, 1), cB + hstep, voffB); PG8_STAGE(PG8_SA(0, 1), cA + hstep, voffA);
        if (wr == 1) PG8_BAR;
        PG8_WAIT_V(4); PG8_BAR;
        PG8_STAGE(PG8_SB(1, 0), cB + kstep, voffB); PG8_STAGE(PG8_SA(1, 0), cA + kstep, voffA); PG8_STAGE(PG8_SB(1, 1), cB + hstep + kstep, voffB);
        PG8_WAIT_V(6); PG8_BAR;
    }
    for (;;) {
        const bool has_next = S.next(ui + 1, nxt);
        const char* nA = has_next ? (const char*)g.A + (size_t)nxt.pm * tstep : cA; const char* nB = has_next ? (const char*)g.Bt + (size_t)nxt.be * g.bstride + (size_t)nxt.pn * tstep : cB;
        for (int t = 0; t < nt; t += 2) {
            const bool last = (t == nt - 2);
            const char* a1 = cA + (size_t)(t + 1) * kstep;
            const char* a2 = last ? nA : cA + (size_t)(t + 2) * kstep; const char* b2 = last ? nB : cB + (size_t)(t + 2) * kstep;
            const char* a3 = a2 + kstep; const char* b3 = b2 + kstep;
            if (last && has_next) S.a_ready(nxt);
            if constexpr (SP2) {
            PG8_LDB(B0, 0, 0); PG8_LDB(B1, 0, 1); PG8_SCHED; PG8_LDA(At, 0, 0); PG8_STAGE(PG8_SA(1, 1), a1 + hstep, voffA);
            PG8_WAIT_V(8); PG8_WAIT_L(0); PG8_BAR; PG8_MMA(0, 0, At, B0); PG8_MMA(0, 1, At, B1); PG8_BAR; PG8_SCHED;
            PG8_LDA(At, 0, 1); PG8_STAGE(PG8_SB(0, 0), b2, voffB); PG8_STAGE(PG8_SB(0, 1), b2 + hstep, voffB); PG8_STAGE(PG8_SA(0, 0), a2, voffA);
            PG8_WAIT_V(8); PG8_WAIT_L(0); PG8_BAR; PG8_MMA(1, 0, At, B0); PG8_MMA(1, 1, At, B1); PG8_BAR; PG8_SCHED;
            PG8_LDB(B0, 1, 0); PG8_LDB(B1, 1, 1); PG8_SCHED; PG8_LDA(At, 1, 0); PG8_STAGE(PG8_SA(0, 1), a2 + hstep, voffA);
            PG8_WAIT_V(8); PG8_WAIT_L(0); PG8_BAR; PG8_MMA(0, 0, At, B0); PG8_MMA(0, 1, At, B1); PG8_BAR; PG8_SCHED;
            PG8_LDA(At, 1, 1); PG8_STAGE(PG8_SB(1, 0), b3, voffB); PG8_STAGE(PG8_SB(1, 1), b3 + hstep, voffB); PG8_STAGE(PG8_SA(1, 0), a3, voffA);
            PG8_WAIT_V(8); PG8_WAIT_L(0); PG8_BAR; PG8_MMA(1, 0, At, B0); PG8_MMA(1, 1, At, B1); PG8_BAR; PG8_SCHED;
            } else {
            PG8_LDB(B0, 0, 0); PG8_SCHED; PG8_LDA(At, 0, 0); PG8_STAGE(PG8_SA(1, 1), a1 + hstep, voffA);
            PG8_WAIT_L(8); PG8_BAR; PG8_WAIT_L(0); PG8_MMA(0, 0, At, B0); PG8_BAR; PG8_SCHED;
            PG8_LDB(B1, 0, 1); PG8_STAGE(PG8_SB(0, 0), b2, voffB);
            PG8_BAR; PG8_WAIT_L(0); PG8_MMA(0, 1, At, B1); PG8_BAR;
            PG8_LDA(At, 0, 1); PG8_STAGE(PG8_SA(0, 0), a2, voffA);
            PG8_BAR; PG8_WAIT_L(0); PG8_MMA(1, 0, At, B0); PG8_BAR; PG8_SCHED;
            PG8_STAGE(PG8_SB(0, 1), b2 + hstep, voffB);
            PG8_WAIT_V(6); PG8_BAR; PG8_MMA(1, 1, At, B1); PG8_BAR;
            PG8_LDB(B0, 1, 0); PG8_SCHED; PG8_LDA(At, 1, 0); PG8_STAGE(PG8_SA(0, 1), a2 + hstep, voffA);
            PG8_WAIT_L(8); PG8_BAR; PG8_WAIT_L(0); PG8_MMA(0, 0, At, B0); PG8_BAR; PG8_SCHED;
            PG8_LDB(B1, 1, 1); PG8_STAGE(PG8_SB(1, 0), b3, voffB);
            PG8_BAR; PG8_WAIT_L(0); PG8_MMA(0, 1, At, B1); PG8_BAR;
            PG8_LDA(At, 1, 1); PG8_STAGE(PG8_SA(1, 0), a3, voffA);
            PG8_BAR; PG8_WAIT_L(0); PG8_MMA(1, 0, At, B0); PG8_BAR; PG8_SCHED;
            PG8_STAGE(PG8_SB(1, 1), b3 + hstep, voffB);
            PG8_WAIT_V(6); PG8_BAR; PG8_MMA(1, 1, At, B1); PG8_BAR;
            }
        }
        if constexpr (ALIGN_EPI) { if (wr == 0) PG8_BAR; }
        if constexpr (!Epi::AFTER_DRAIN) { E(acc, cur, wr, wc, fr, fq); S.done(cur); }
        if (!has_next) break;
#pragma unroll
        for (int a = 0; a < 2; ++a)
#pragma unroll
            for (int b = 0; b < 2; ++b)
#pragma unroll
                for (int m = 0; m < 4; ++m)
#pragma unroll
                    for (int n = 0; n < 2; ++n) acc[a][b][m][n] = (f32x4){0.f, 0.f, 0.f, 0.f};
        cur = nxt; cA = nA; cB = nB; ++ui;
        if constexpr (ALIGN_EPI) { if (wr == 1) PG8_BAR; }
    }
    PG8_WAIT_V(0);
    if constexpr (!ALIGN_EPI) { if (wr == 0) PG8_BAR; }
    PG8_BAR;
    if constexpr (Epi::AFTER_DRAIN) { E.fused(acc, cur, wr, wc, fr, fq, lds, wid, lane); S.done(cur); }
#undef PG8_SA
#undef PG8_SB
#undef PG8_STAGE
#undef PG8_LDA
#undef PG8_LDB
#undef PG8_MMA
#undef PG8_WAIT_V
#undef PG8_WAIT_L
#undef PG8_BAR
#undef PG8_SCHED
}
}
#ifndef SSD_NAIVE
#define SSD_NAIVE 0
#endif
#ifndef MLSTM_NAIVE
#define MLSTM_NAIVE 0
#endif
#ifndef FOX_NAIVE
#define FOX_NAIVE 0
#endif
#include <hip/hip_bf16.h>
#include <cmath>
namespace attn_body {
using bf16=__hip_bfloat16;
using bf16x8=__attribute__((ext_vector_type(8)))short;
using s16x4=__attribute__((ext_vector_type(4)))short;
using f32x16=__attribute__((ext_vector_type(16)))float;
using u32x4=__attribute__((ext_vector_type(4)))unsigned;
constexpr int BATCH=8,NHEAD=8,SEQ=2048,D=64,PQ=3584,PO=1024;
constexpr int NW=8,QBLK=32,QB=QBLK*NW,KVBLK=64,NQB=SEQ/QB;
constexpr int ATTN_UNIT_ROWS=QB;
__device__ __forceinline__ int crow(int r,int hi){return (r&3)+8*(r>>2)+4*hi;}
#define SBAR() __builtin_amdgcn_sched_barrier(0)
__device__ __forceinline__ void cmask(f32x16&p0,f32x16&p1,int jb,int qrel,int hi){
  const float NEG=-INFINITY; int kb=64*jb+4*hi;
  #pragma unroll
  for(int r=0;r<16;++r){int kv=kb+(r&3)+8*(r>>2); if(kv>qrel)p0[r]=NEG; if(kv+32>qrel)p1[r]=NEG;}
}

constexpr int NSLOT=3, SLOTB=8192;
constexpr int LDS_K=0, LDS_V=NSLOT*SLOTB, LDS_WS=2*NSLOT*SLOTB, LDS_OST=LDS_WS+NW*64*4, LDS_CK=LDS_OST+NW*4096, LDS_BYTES=LDS_CK+SEQ*4;
constexpr float C2=0.125f*1.4426950408889634f;
__device__ __forceinline__ void glds16(const void*gsrc,unsigned lds_dst){unsigned keep;
  asm volatile("s_mov_b32 %0, m0\n\ts_mov_b32 m0, %2\n\ts_nop 0\n\tglobal_load_lds_dwordx4 %1, off\n\ts_mov_b32 m0, %0":"=&s"(keep):"v"(gsrc),"s"(lds_dst):"memory");}
__device__ __forceinline__ float max3f(float a,float b,float c){float r;asm("v_max3_f32 %0, %1, %2, %3":"=v"(r):"v"(a),"v"(b),"v"(c));return r;}
__device__ __forceinline__ float max2f(float a,float b){float r;asm("v_max_f32_e32 %0, %1, %2":"=v"(r):"v"(a),"v"(b));return r;}
__device__ __forceinline__ float fadd_s(float a,float b){float r;asm("v_add_f32_e32 %0, %1, %2":"=v"(r):"v"(a),"v"(b));return r;}
__device__ __forceinline__ float fsub_s(float a,float b){float r;asm("v_sub_f32_e32 %0, %1, %2":"=v"(r):"v"(a),"v"(b));return r;}
typedef float f32x4_t __attribute__((ext_vector_type(4))); typedef float f32x2_t __attribute__((ext_vector_type(2))); typedef __bf16 bf16x2_t __attribute__((ext_vector_type(2)));
__device__ __forceinline__ unsigned cvtpk_s(float lo,float hi){f32x2_t v={lo,hi};bf16x2_t b=__builtin_convertvector(v,bf16x2_t);return __builtin_bit_cast(unsigned,b);}
#define WAIT_BAR(N) asm volatile("s_waitcnt vmcnt(" #N ") lgkmcnt(0)\n\ts_barrier":::"memory")

__device__ __forceinline__ void qkt(f32x16&p0,f32x16&p1,const char*Kslot,const bf16x8*qr,int r32,int hi){
  const char*kb=Kslot+hi*1024+r32*16;
  #pragma unroll
  for(int d0=0;d0<4;++d0){
    const bf16x8 b0=*reinterpret_cast<const bf16x8*>(kb+d0*2048);
    const bf16x8 b1=*reinterpret_cast<const bf16x8*>(kb+d0*2048+512);
    {p0=__builtin_amdgcn_mfma_f32_32x32x16_bf16(b0,qr[d0],p0,0,0,0);p1=__builtin_amdgcn_mfma_f32_32x32x16_bf16(b1,qr[d0],p1,0,0,0);}}
}
typedef __attribute__((address_space(3))) const char* lds_cptr;
typedef short v4i16_t __attribute__((ext_vector_type(4)));
__device__ __forceinline__ void kload8(bf16x8*kf,lds_cptr kp){
  kf[0]=*(const __attribute__((address_space(3))) bf16x8*)(kp);      kf[1]=*(const __attribute__((address_space(3))) bf16x8*)(kp+512);
  kf[2]=*(const __attribute__((address_space(3))) bf16x8*)(kp+2048); kf[3]=*(const __attribute__((address_space(3))) bf16x8*)(kp+2560);
  kf[4]=*(const __attribute__((address_space(3))) bf16x8*)(kp+4096); kf[5]=*(const __attribute__((address_space(3))) bf16x8*)(kp+4608);
  kf[6]=*(const __attribute__((address_space(3))) bf16x8*)(kp+6144); kf[7]=*(const __attribute__((address_space(3))) bf16x8*)(kp+6656);
}
__device__ __forceinline__ void kload2(bf16x8*kf,lds_cptr kp,int j){ kf[2*j]=*(const __attribute__((address_space(3))) bf16x8*)(kp+j*2048); kf[2*j+1]=*(const __attribute__((address_space(3))) bf16x8*)(kp+j*2048+512); }
__device__ __forceinline__ s16x4 vtr(lds_cptr p){ return __builtin_bit_cast(s16x4,__builtin_amdgcn_ds_read_tr16_b64_v4i16((__attribute__((address_space(3))) v4i16_t*)p)); }
__device__ __forceinline__ float rowmax(const f32x16&p0,const f32x16&p1){
  float a=max3f(p0[0],p0[1],p1[0]),b=max3f(p0[2],p0[3],p1[1]);a=max3f(a,p1[2],p1[3]);
  #pragma unroll
  for(int r=4;r<16;r+=4){a=max3f(a,p0[r],p0[r+1]);b=max3f(b,p0[r+2],p0[r+3]);a=max3f(a,p1[r],p1[r+1]);b=max3f(b,p1[r+2],p1[r+3]);}
  const float m=max2f(a,b);
  auto rr=__builtin_amdgcn_permlane32_swap(__float_as_uint(m),__float_as_uint(m),false,false);
  return max2f(__uint_as_float(rr[0]),__uint_as_float(rr[1]));
}
__device__ __forceinline__ void pv(f32x16*o,int vb,bf16x8 pa0,bf16x8 pa1,bf16x8 pa2,bf16x8 pa3){
  #pragma unroll
  for(int d0=0;d0<2;++d0){s16x4 lo[4],hi[4];
    #pragma unroll
    for(int ks=0;ks<4;++ks){
      asm volatile("ds_read_b64_tr_b16 %0,%1 offset:%c2":"=&v"(lo[ks]):"v"(vb),"i"(d0*4096+ks*1024):"memory");
      asm volatile("ds_read_b64_tr_b16 %0,%1 offset:%c2":"=&v"(hi[ks]):"v"(vb),"i"(d0*4096+ks*1024+512):"memory");}
    asm volatile("s_waitcnt lgkmcnt(0)":::"memory");SBAR();
    #define PK(k) (bf16x8){lo[k][0],lo[k][1],lo[k][2],lo[k][3],hi[k][0],hi[k][1],hi[k][2],hi[k][3]}
    o[d0]=__builtin_amdgcn_mfma_f32_32x32x16_bf16(pa0,PK(0),o[d0],0,0,0);
    o[d0]=__builtin_amdgcn_mfma_f32_32x32x16_bf16(pa1,PK(1),o[d0],0,0,0);
    o[d0]=__builtin_amdgcn_mfma_f32_32x32x16_bf16(pa2,PK(2),o[d0],0,0,0);
    o[d0]=__builtin_amdgcn_mfma_f32_32x32x16_bf16(pa3,PK(3),o[d0],0,0,0);
    #undef PK
  }
}

#ifndef ATTN_STORE16
#define ATTN_STORE16(p,v) (*(u32x4*)(p)=(v))
#endif
template<int THRL> __device__ __forceinline__ void attn_unit(int b,int h,int qb,const bf16*Q,const bf16*K,const bf16*V,bf16*O,const float*cum,char*shm){
  const int tid=threadIdx.x,lane=tid&63,r32=lane&31,hi=lane>>5; const int wid=__builtin_amdgcn_readfirstlane(tid>>6);
  const long rowbase=(long)b*SEQ; const int q0=qb*QB;
  const bf16*Qw=Q+(rowbase+q0+wid*QBLK)*PQ+h*D;
  const bf16*Kh=K+rowbase*PQ+h*D,*Vh=V+rowbase*PQ+h*D;
  const lds_cptr shm3_=(lds_cptr)shm;
  const unsigned lds0=(unsigned)(uintptr_t)shm;
  float*wsf=(float*)(shm+LDS_WS)+wid*64;
  const bf16*ksrc=Kh+(long)lane*PQ+wid*8;
  const bf16*vsrc=Vh+(long)(16*(wid&3)+(lane>>2))*PQ+(wid>>2)*32+(lane&3)*8;
  const unsigned kdst=lds0+LDS_K+wid*1024, vdst=lds0+LDS_V+wid*1024;
  #define DMA_K(t,slot) glds16(ksrc+(long)(t)*KVBLK*PQ,(unsigned)__builtin_amdgcn_readfirstlane(kdst+(slot)))
  #define DMA_V(t,slot) glds16(vsrc+(long)(t)*KVBLK*PQ,(unsigned)__builtin_amdgcn_readfirstlane(vdst+(slot)))
  const int vb0=(int)(lds0+LDS_V)+((lane>>4)&1)*32+(lane&3)*8+(4*hi+((lane&15)>>2))*64;
  const char*Kbase=shm+LDS_K; bf16x8 kf[8];
  const lds_cptr shm3=(lds_cptr)shm; const lds_cptr kp0=shm3+LDS_K+hi*1024+r32*16; const lds_cptr vp0=shm3+LDS_V+((lane>>4)&1)*32+(lane&3)*8+(4*hi+((lane&15)>>2))*64;
  const int NT=(q0+QB)/KVBLK;
  float cqm;
  { float*cks=(float*)(shm+LDS_CK); for(int i=tid;i<q0+QB;i+=NW*64)cks[i]=cum[i]; cqm=cum[q0+wid*QBLK+r32]; asm volatile("s_waitcnt vmcnt(0)":"+v"(cqm)::"memory"); }
  const __attribute__((address_space(3))) float*ckl=(const __attribute__((address_space(3))) float*)(shm3_+LDS_CK)+4*hi;
  #define BIASFILL(C0_,C1_,t_) do{ const __attribute__((address_space(3))) float*cp_=ckl+64*(t_); \
    _Pragma("unroll") for(int a_=0;a_<4;++a_){ const f32x4_t u_=*(const __attribute__((address_space(3))) f32x4_t*)(cp_+8*a_), w_=*(const __attribute__((address_space(3))) f32x4_t*)(cp_+32+8*a_); \
      _Pragma("unroll") for(int i_=0;i_<4;++i_){ C0_[4*a_+i_]=cqm-u_[i_]; C1_[4*a_+i_]=cqm-w_[i_]; } } }while(0)
  DMA_K(0,0);DMA_V(0,0);DMA_K(1,SLOTB);
  bf16x8 qr[4];
  #pragma unroll
  for(int d0=0;d0<4;++d0)qr[d0]=*reinterpret_cast<const bf16x8*>(&Qw[(long)r32*PQ+d0*16+hi*8]);
  float l_reg=0.f;f32x16 o[2];o[0]=f32x16{};o[1]=f32x16{};
  const int qrel=wid*QBLK+r32;
  #define CMASK(P0,P1,t) do{int jb_=(t)-(NT-4); if(jb_>=0)cmask(P0,P1,jb_,qrel,hi);}while(0)
  bool resc=false;
  #define START(P0,P1) do{ const float rm=rowmax(P0,P1); resc=false; \
    { const float dl=rm; cqm=fsub_s(cqm,dl); \
      _Pragma("unroll") for(int r=0;r<16;++r){P0[r]=fsub_s(P0[r],dl);P1[r]=fsub_s(P1[r],dl);} \
      } \
    _Pragma("unroll") for(int r=0;r<16;++r)P0[r]=__builtin_amdgcn_exp2f(P0[r]); }while(0)
  #define RESC() do{ if(resc){ asm volatile("s_waitcnt lgkmcnt(0)":::"memory"); \
      _Pragma("unroll") for(int d_=0;d_<2;++d_) _Pragma("unroll") for(int r=0;r<16;++r)o[d_][r]*=wsf[crow(r,hi)]; } }while(0)
  f32x16 pA0,pA1,pB0,pB1;
  int sl_prev=0,sl_cur=0,sl_next=SLOTB;
  #define ROT() do{sl_prev=sl_cur;sl_cur=sl_next;sl_next=(sl_next==(NSLOT-1)*SLOTB)?0:sl_next+SLOTB;}while(0)
  DMA_K(2,2*SLOTB);
  WAIT_BAR(3);
  BIASFILL(pA0,pA1,0); qkt(pA0,pA1,Kbase,qr,r32,hi);asm volatile("s_nop 15\n\ts_nop 7":"+v"(pA0),"+v"(pA1));CMASK(pA0,pA1,0);
  START(pA0,pA1);
  _Pragma("unroll") for(int r=0;r<16;++r)pA1[r]=__builtin_amdgcn_exp2f(pA1[r]);
  WAIT_BAR(0);
  DMA_K(3,0);DMA_V(1,SLOTB);
  ROT();
  kload8(kf,kp0+sl_cur);
  WAIT_BAR(2);
  s16x4 vlo[8],vhi[8]; u32x4 pw0,pw1,pw2,pw3;
  #define PKW(P,B) cvtpk_s(P[B],P[B+1])
  #define PAF(k) __builtin_bit_cast(bf16x8,pw##k)
  #define VFR(i) (bf16x8){vlo[i][0],vlo[i][1],vlo[i][2],vlo[i][3],vhi[i][0],vhi[i][1],vhi[i][2],vhi[i][3]}
  #define PIN(x) asm volatile("":"+v"(x))
  #define MX3(a,b,c) __builtin_fmaxf(__builtin_fmaxf((a),(b)),(c))
  #define GAPA(MF,A0,A1,A2,A3,W0,W1,PW) do{ MF; sacc+=A0; sacc+=A1; sacc+=A2; sacc+=A3; PIN(sacc); W0; W1; PIN(PW); SBAR(); }while(0)
  #define EX(v) __builtin_amdgcn_exp2f(v)
  #define GAPB(MF,X,B) do{ MF; X[B]=EX(X[B]); X[B+1]=EX(X[B+1]); X[B+2]=EX(X[B+2]); X[B+3]=EX(X[B+3]); PIN(X); SBAR(); }while(0)
  #define VRD(i) do{ vlo[i]=vtr(vp_+(((i)>>2)*4096+((i)&3)*1024)); vhi[i]=vtr(vp_+(((i)>>2)*4096+((i)&3)*1024+512)); }while(0)
  #define KRD(G,j) do{ if(G){ kload2(kf,kp0+sl_next,j); SBAR(); } }while(0)
  #define STEP(C0,C1,P0,P1,t,GK,GV,GL) do{ BIASFILL(C0,C1,t); SBAR(); \
    const lds_cptr vp_=vp0+sl_prev; \
    VRD(0); SBAR(); float sacc=(P0[0]+P0[1]); \
    GAPA(C0=__builtin_amdgcn_mfma_f32_32x32x16_bf16(kf[0],qr[0],C0,0,0,0), P0[2],P0[3],P0[4],P0[5],     pw0[0]=PKW(P0,0), pw0[1]=PKW(P0,2), pw0); \
    VRD(4); SBAR(); GAPA(C1=__builtin_amdgcn_mfma_f32_32x32x16_bf16(kf[1],qr[0],C1,0,0,0), P0[6],P0[7],P0[8],P0[9],     pw0[2]=PKW(P0,4), pw0[3]=PKW(P0,6), pw0); \
    VRD(1); SBAR(); GAPA(C0=__builtin_amdgcn_mfma_f32_32x32x16_bf16(kf[2],qr[1],C0,0,0,0),   P0[10],P0[11],P0[12],P0[13], pw1[0]=PKW(P0,8), pw1[1]=PKW(P0,10), pw1); \
    VRD(5); SBAR(); GAPA(C1=__builtin_amdgcn_mfma_f32_32x32x16_bf16(kf[3],qr[1],C1,0,0,0),   P0[14],P0[15],P1[0],P1[1],   pw1[2]=PKW(P0,12),pw1[3]=PKW(P0,14), pw1); \
    VRD(2); SBAR(); GAPA(C0=__builtin_amdgcn_mfma_f32_32x32x16_bf16(kf[4],qr[2],C0,0,0,0),   P1[2],P1[3],P1[4],P1[5],     pw2[0]=PKW(P1,0), pw2[1]=PKW(P1,2), pw2); \
    VRD(6); SBAR(); GAPA(C1=__builtin_amdgcn_mfma_f32_32x32x16_bf16(kf[5],qr[2],C1,0,0,0),   P1[6],P1[7],P1[8],P1[9],     pw2[2]=PKW(P1,4), pw2[3]=PKW(P1,6), pw2); \
    VRD(3); SBAR(); GAPA(C0=__builtin_amdgcn_mfma_f32_32x32x16_bf16(kf[6],qr[3],C0,0,0,0),   P1[10],P1[11],P1[12],P1[13], pw3[0]=PKW(P1,8), pw3[1]=PKW(P1,10), pw3); \
    VRD(7); SBAR(); GAPA(C1=__builtin_amdgcn_mfma_f32_32x32x16_bf16(kf[7],qr[3],C1,0,0,0),   P1[14],P1[15],0.f,0.f,       pw3[2]=PKW(P1,12),pw3[3]=PKW(P1,14), pw3); \
    l_reg+=sacc; \
    if(GK){DMA_K((t)+3,sl_cur);} if(GV){DMA_V((t)+1,sl_next);} \
    CMASK(C0,C1,t); \
    { float a=MX3(C0[0],C0[1],C1[0]),b=MX3(C0[2],C0[3],C1[1]); a=MX3(a,C1[2],C1[3]); \
      _Pragma("unroll") for(int r=4;r<16;r+=4){a=MX3(a,C0[r],C0[r+1]);b=MX3(b,C0[r+2],C0[r+3]);a=MX3(a,C1[r],C1[r+1]);b=MX3(b,C1[r+2],C1[r+3]);} \
      float rm=__builtin_fmaxf(a,b); { auto rr=__builtin_amdgcn_permlane32_swap(__float_as_uint(rm),__float_as_uint(rm),false,false); rm=__builtin_fmaxf(__uint_as_float(rr[0]),__uint_as_float(rr[1])); } \
      resc=false; \
      if(__builtin_expect(__any(rm>(float)THRL),0)){ const float dl=__builtin_fmaxf(rm,0.f); cqm-=dl; \
        _Pragma("unroll") for(int r=0;r<16;++r){C0[r]-=dl;C1[r]-=dl;} \
        const float f=__builtin_amdgcn_exp2f(-dl); l_reg*=f; if(hi==0)wsf[r32]=f; resc=true; } } \
    SBAR(); \
    GAPB(o[0]=__builtin_amdgcn_mfma_f32_32x32x16_bf16(PAF(0),VFR(0),o[0],0,0,0), C0,0); \
    GAPB(o[1]=__builtin_amdgcn_mfma_f32_32x32x16_bf16(PAF(0),VFR(4),o[1],0,0,0), C0,4); \
    KRD(GL,0); GAPB(o[0]=__builtin_amdgcn_mfma_f32_32x32x16_bf16(PAF(1),VFR(1),o[0],0,0,0), C0,8); \
    KRD(GL,1); GAPB(o[1]=__builtin_amdgcn_mfma_f32_32x32x16_bf16(PAF(1),VFR(5),o[1],0,0,0), C0,12); \
    KRD(GL,2); GAPB(o[0]=__builtin_amdgcn_mfma_f32_32x32x16_bf16(PAF(2),VFR(2),o[0],0,0,0), C1,0); \
    KRD(GL,3); GAPB(o[1]=__builtin_amdgcn_mfma_f32_32x32x16_bf16(PAF(2),VFR(6),o[1],0,0,0), C1,4); \
    GAPB(o[0]=__builtin_amdgcn_mfma_f32_32x32x16_bf16(PAF(3),VFR(3),o[0],0,0,0), C1,8); \
    GAPB(o[1]=__builtin_amdgcn_mfma_f32_32x32x16_bf16(PAF(3),VFR(7),o[1],0,0,0), C1,12); \
    }while(0)
  int t=1;
  #undef CMASK
  #define CMASK(P0,P1,t) do{}while(0)
  for(;t+5<NT;t+=2){
    STEP(pB0,pB1,pA0,pA1,t,true,true,true);     WAIT_BAR(2); RESC(); ROT();
    STEP(pA0,pA1,pB0,pB1,t+1,true,true,true);   WAIT_BAR(2); RESC(); ROT();
  }
  #undef CMASK
  #define CMASK(P0,P1,t) do{int jb_=(t)-(NT-4); if(jb_>=0)cmask(P0,P1,jb_,qrel,hi);}while(0)
  #define ENDW(tt) do{ if((tt)+3<NT){WAIT_BAR(2);} else if((tt)+2<NT){WAIT_BAR(1);} else {WAIT_BAR(0);} }while(0)
  for(;t+1<NT;t+=2){
    STEP(pB0,pB1,pA0,pA1,t,(t+3<NT),(t+1<NT),(t+1<NT));       ENDW(t);   RESC(); ROT();
    STEP(pA0,pA1,pB0,pB1,t+1,(t+4<NT),(t+2<NT),(t+2<NT));     ENDW(t+1); RESC(); ROT();
  }
  STEP(pB0,pB1,pA0,pA1,NT-1,false,false,false); RESC();
  { float sacc=pB0[0]+pB0[1]; _Pragma("unroll") for(int r=2;r<16;++r)sacc+=pB0[r]; _Pragma("unroll") for(int r=0;r<16;++r)sacc+=pB1[r]; l_reg+=sacc;
    pw0=(u32x4){PKW(pB0,0),PKW(pB0,2),PKW(pB0,4),PKW(pB0,6)};pw1=(u32x4){PKW(pB0,8),PKW(pB0,10),PKW(pB0,12),PKW(pB0,14)};pw2=(u32x4){PKW(pB1,0),PKW(pB1,2),PKW(pB1,4),PKW(pB1,6)};pw3=(u32x4){PKW(pB1,8),PKW(pB1,10),PKW(pB1,12),PKW(pB1,14)};
    SBAR(); pv(o,vb0+sl_cur,PAF(0),PAF(1),PAF(2),PAF(3)); }
  #undef PKW
  #undef PAF
  #undef VFR
  #undef PIN
  #undef MX3
  #undef GAPA
  #undef GAPB
  #undef EX
  #undef VRD
  #undef KRD
  #undef STEP
  #undef ENDW
  {auto rr=__builtin_amdgcn_permlane32_swap(__float_as_uint(l_reg),__float_as_uint(l_reg),false,false);l_reg=__uint_as_float(rr[0])+__uint_as_float(rr[1]);}
  if(hi==0)wsf[32+r32]=l_reg;asm volatile("s_waitcnt lgkmcnt(0)":::"memory");
  float rli[16];
  #pragma unroll
  for(int r=0;r<16;++r)rli[r]=__builtin_amdgcn_rcpf(wsf[32+crow(r,hi)]);
  bf16*Ow=O+(rowbase+q0+wid*QBLK)*PO+h*D;
  { bf16*stg=(bf16*)(shm+LDS_OST)+wid*2048;
    #pragma unroll
    for(int r=0;r<16;++r){const int orow=crow(r,hi);
      #pragma unroll
      for(int d0=0;d0<2;++d0)stg[orow*64+d0*32+r32]=__float2bfloat16(o[d0][r]*rli[r]);}
    asm volatile("s_waitcnt lgkmcnt(0)":::"memory");
    #pragma unroll
    for(int i=0;i<4;++i){const int row=i*8+(lane>>3),ch=lane&7; const u32x4 v=*(const u32x4*)(stg+row*64+ch*8); ATTN_STORE16(Ow+(long)row*PO+ch*8,v);} }
  asm volatile("s_waitcnt lgkmcnt(0)\n\ts_barrier":::"memory");
  #undef DMA_K
  #undef BIASFILL
  #undef DMA_V
  #undef CMASK
  #undef START
  #undef RESC
  #undef ROT
}
constexpr int ATTN_LDS_BYTES=LDS_BYTES;
struct AttnTensors { const bf16* Q; const bf16* K; const bf16* V; bf16* O; const float* cum; };
struct AttnUnit { int bh; int qb; };
struct StaticOrder {
  int vcu, G;
  __device__ __forceinline__ explicit StaticOrder(int grid,int v):vcu(v),G(grid){}
  __device__ __forceinline__ bool next(int i,AttnUnit&u)const{ const int pr=vcu+(i>>1)*G; if(pr>=256)return false; const int s=pr&3; u.bh=pr>>2; u.qb=(i&1)?7-s:s; return true; }
  __device__ __forceinline__ void a_ready(const AttnUnit&)const{}
  __device__ __forceinline__ void done(const AttnUnit&)const{}
};
template<class Sched,int THRL=8> __device__ __forceinline__ void attn_phase(char*lds,const AttnTensors&T,const Sched&S){
  AttnUnit u;
  for(int i=0;S.next(i,u);++i){ S.a_ready(u); attn_unit<THRL>(u.bh/NHEAD,u.bh%NHEAD,u.qb,T.Q,T.K,T.V,T.O,T.cum+(long)u.bh*SEQ,lds); S.done(u); }
}
#undef SBAR
#undef WAIT_BAR
}
constexpr int NWAVES = 8;
constexpr int T = 16384, D = 1024, SEQ = 2048, NBATCH = 8, DEPTH = 4;
constexpr float ALPHA = 1.6817928305074290f;
constexpr float LN_EPS = 1e-5f;
constexpr int AB_IN = 4112, CD_IN = 3600, NPE = 4096, NPO = 3584;
constexpr float LOG2E = 1.4426950408889634f;
constexpr float FOX_C2 = 0.125f * LOG2E;
constexpr float MLSTM_KSCALE = 0.08838834764831845f;
constexpr int RPAD = 40960;
constexpr int NPH_LAYER = 12, NPHASES = 1 + DEPTH * NPH_LAYER;
#ifndef MK_ONE_LAUNCH
#define MK_ONE_LAUNCH 1
#endif

constexpr size_t MiB = 1u << 20, KiB = 1u << 10;
constexpr size_t WS_CTL = 0, CTL_ZERO_BYTES = 1 * MiB;
constexpr size_t WS_BCNT = 1 * MiB, WS_PANEL = WS_BCNT + 64 * KiB, WS_ROUTE = WS_BCNT + 128 * KiB, WS_GATE = WS_BCNT + 384 * KiB, WS_POS = WS_BCNT + 512 * KiB,
                 WS_DEC = WS_BCNT + 640 * KiB, WS_MLOC = WS_BCNT + 704 * KiB, WS_BLAST = WS_BCNT + 712 * KiB, WS_MPREV = WS_BCNT + 720 * KiB,
                 WS_FOXC = 2 * MiB, WS_NLOC = 2 * MiB + 512 * KiB, WS_SG = 3 * MiB;
constexpr size_t WS_WINE = 4 * MiB, WS_WINO = 20 * MiB, WS_WOUTE = 34 * MiB, WS_WOUTO = 40 * MiB, WS_WGU = 44 * MiB, WS_WD = 300 * MiB;
constexpr size_t WS_HF = 428 * MiB, WS_HB = 492 * MiB, WS_H1F = 524 * MiB, WS_H1B = 588 * MiB;
constexpr size_t WS_R1 = 620 * MiB;
constexpr size_t WS_R2 = 748 * MiB;
constexpr size_t WS_R3 = 812 * MiB;
constexpr size_t WS_R4 = 860 * MiB;
constexpr size_t WS_MIX = 892 * MiB;
constexpr size_t WS_TAB = 940 * MiB, TAB_LAYER = 208 * KiB, TAB_GPW = 0, TAB_RGW = 64 * KiB, TAB_REW = 80 * KiB;
constexpr size_t WS_END = 941 * MiB;
constexpr int CW_BAR = 4096;

constexpr int RING_BYTES = 131072, SMALL_OFF = RING_BYTES, SMALL_BYTES = 8192, MISC_OFF = SMALL_OFF + SMALL_BYTES, LDS_BYTES = 147456;

#define GAS __attribute__((address_space(1)))
#define LAS __attribute__((address_space(3)))
typedef unsigned short bf16;
typedef unsigned v4u __attribute__((ext_vector_type(4)));
typedef unsigned v2u __attribute__((ext_vector_type(2)));
typedef float f32x4 __attribute__((ext_vector_type(4)));
typedef float f32x2 __attribute__((ext_vector_type(2)));
typedef int i32x4 __attribute__((ext_vector_type(4)));
typedef int i32x2 __attribute__((ext_vector_type(2)));
#define LDS_WAIT() asm volatile("s_waitcnt lgkmcnt(0)" ::: "memory")
__device__ __forceinline__ unsigned f2bf(float f) { unsigned u = __builtin_bit_cast(unsigned, f); return (u + 0x7fffu + ((u >> 16) & 1u)) >> 16; }
typedef __bf16 bf16x2_t __attribute__((ext_vector_type(2)));
__device__ __forceinline__ unsigned cvtpk(float lo, float hi) { const f32x2 v = {lo, hi}; const bf16x2_t b = __builtin_convertvector(v, bf16x2_t); return __builtin_bit_cast(unsigned, b); }
__device__ __forceinline__ unsigned pk2(float lo, float hi) { return cvtpk(lo, hi); }
__device__ __forceinline__ float bflo(unsigned w) { return __builtin_bit_cast(float, w << 16); }
__device__ __forceinline__ float bfhi(unsigned w) { return __builtin_bit_cast(float, w & 0xffff0000u); }
__device__ __forceinline__ float bf2f(bf16 b) { return __builtin_bit_cast(float, (unsigned)b << 16); }
__device__ __forceinline__ float wave_sum(float v) {
#pragma unroll
    for (int o = 1; o < 64; o <<= 1) v += __shfl_xor(v, o);
    return v;
}
__device__ __forceinline__ float wave_max(float v) {
#pragma unroll
    for (int o = 1; o < 64; o <<= 1) v = fmaxf(v, __shfl_xor(v, o));
    return v;
}
__device__ __forceinline__ float wave_scan_sum(float v, int lane) {
#pragma unroll
    for (int o = 1; o < 64; o <<= 1) { const float t = __shfl_up(v, o); if (lane >= o) v += t; }
    return v;
}
__device__ __forceinline__ float wave_scan_max(float v, int lane) {
#pragma unroll
    for (int o = 1; o < 64; o <<= 1) { const float t = __shfl_up(v, o); if (lane >= o) v = fmaxf(v, t); }
    return v;
}
__device__ __forceinline__ float softplus_f(float x) { return x > 20.f ? x : log1pf(expf(x)); }
__device__ __forceinline__ float logsigmoid_f(float x) { return fminf(x, 0.f) - log1pf(expf(-fabsf(x))); }
__device__ __forceinline__ float sigmoid_f(float x) { return 1.0f / (1.0f + expf(-x)); }
#define XB_TMO      128
#define XB_XCNT(j)  (256  + 64 * (j))
#define XB_XSUB(j)  (1280 + 64 * (j))
#define XB_XGEN(j)  (2304 + 64 * (j))
#define XB_TOP      3328
#define XB_TOPGEN   3392
#define XCD_BAR_WORDS 3456
#define XB_SPIN_CAP (1u << 18)

__device__ __forceinline__ unsigned xb_ld(unsigned* p)              { return __hip_atomic_load(p, __ATOMIC_RELAXED, __HIP_MEMORY_SCOPE_AGENT); }
__device__ __forceinline__ unsigned xb_add(unsigned* p, unsigned v) { return __hip_atomic_fetch_add(p, v, __ATOMIC_RELAXED, __HIP_MEMORY_SCOPE_AGENT); }
__device__ __forceinline__ unsigned xb_xcc_id() { return (unsigned)__builtin_amdgcn_s_getreg((3 << 11) | 20) & 0xFu; }
#define XB_SPIN(cond, bar) do { unsigned _sp = 0; while (cond) { __builtin_amdgcn_s_sleep(1); \
    if ((++_sp & 255u) == 0u) { if (xb_ld(&(bar)[XB_TMO])) break; if (_sp > XB_SPIN_CAP) { atomicAdd(&(bar)[XB_TMO], 1u); break; } } } } while (0)

struct XcdBarrier {
    unsigned* bar; unsigned x;
    volatile LAS unsigned* st;
};

__device__ __forceinline__ XcdBarrier xcd_barrier_post(unsigned* bar, volatile LAS unsigned* st) {
    XcdBarrier b; b.bar = bar; b.x = xb_xcc_id(); b.st = st;
    if (threadIdx.x == 0) (void)xb_add(&bar[XB_XCNT(b.x)], 1u);
    return b;
}
__device__ __forceinline__ void xcd_barrier_complete(unsigned* bar, unsigned x, unsigned& nloc, unsigned& nx) {
    const unsigned G = gridDim.x * gridDim.y * gridDim.z;
    unsigned sum, cnt, mine, sp = 0u;
    for (;;) {
        sum = 0u; cnt = 0u; mine = 0u;
#pragma unroll
        for (unsigned j = 0; j < 16; ++j) { const unsigned c = xb_ld(&bar[XB_XCNT(j)]); sum += c; cnt += (c > 0u) ? 1u : 0u; mine = (j == x) ? c : mine; }
        if (sum == G) break;
        __builtin_amdgcn_s_sleep(1);
        if ((++sp & 255u) == 0u) { if (xb_ld(&bar[XB_TMO])) break; if (sp > XB_SPIN_CAP) { atomicAdd(&bar[XB_TMO], 1u); break; } }
    }
    nloc = mine > 0u ? mine : 1u; nx = cnt > 0u ? cnt : 1u;
}

__device__ __forceinline__ void xcd_barrier(const XcdBarrier& b) {
    asm volatile("s_waitcnt vmcnt(0)" ::: "memory");
    __syncthreads();
    if (threadIdx.x == 0) {
        unsigned* bar = b.bar;
        __builtin_amdgcn_s_waitcnt(0);
        unsigned nloc = b.st[0], nx = b.st[1];
        if (nloc == 0u) { xcd_barrier_complete(bar, b.x, nloc, nx); b.st[0] = nloc; b.st[1] = nx; }
        const unsigned old = xb_add(&bar[XB_XSUB(b.x)], 1u);
        const unsigned gen = old / nloc;
        if (old + 1u == (gen + 1u) * nloc) {
            __builtin_amdgcn_fence(__ATOMIC_RELEASE, "agent");
            asm volatile("s_waitcnt vmcnt(0)" ::: "memory");
            const unsigned og = xb_add(&bar[XB_TOP], 1u);
            const unsigned tg = og / nx;
            if (og + 1u == (tg + 1u) * nx) xb_add(&bar[XB_TOPGEN], 1u);
            else XB_SPIN(xb_ld(&bar[XB_TOPGEN]) == tg, bar);
            __builtin_amdgcn_fence(__ATOMIC_ACQUIRE, "agent");
            xb_add(&bar[XB_XGEN(b.x)], 1u);
            asm volatile("s_waitcnt vmcnt(0)" ::: "memory");
        } else {
            XB_SPIN(xb_ld(&bar[XB_XGEN(b.x)]) == gen, bar);
            __builtin_amdgcn_fence(__ATOMIC_ACQUIRE, "agent");
            asm volatile("s_waitcnt vmcnt(0)" ::: "memory");
        }
    }
    __syncthreads();
}
struct Frame {
    LAS unsigned char* lds;
    volatile LAS unsigned* MISC;
    unsigned* ctl;
    int tid, lane, wave, vcu, G, gw, NGW;
};
typedef const float* const cfpc_t; typedef __attribute__((address_space(4))) cfpc_t* kargp_t;
__device__ __forceinline__ kargp_t kin() { kargp_t p = (kargp_t)__builtin_amdgcn_kernarg_segment_ptr(); asm volatile("" : "+s"(p)); return p; }
#define KIN(i) (kin()[i])
typedef unsigned char* const ucpc_t; typedef __attribute__((address_space(4))) ucpc_t* kargu_t;
__device__ __forceinline__ unsigned char* kws() { return ((kargu_t)kin())[28]; }
__device__ __forceinline__ float* kout() { return (float*)((kargu_t)kin())[27]; }
enum { I_X = 0, I_ABWIN, I_CONVA, I_CONVW, I_CONVB, I_DTB, I_ALOG, I_DSKIP, I_NORMW, I_ABWOUT, I_CDWIN, I_IB, I_FB, I_HNW, I_FOXB, I_CDWOUT, I_LN1G, I_LN1B, I_LN2G, I_LN2B,
       I_RGW, I_RGB, I_REW, I_REB, I_WG, I_WU, I_WDN };

__device__ __forceinline__ void row_load(const float* row, int lane, f32x4 (&v)[4]) {
#pragma unroll
    for (int j = 0; j < 4; ++j) v[j] = ((const f32x4*)row)[lane + 64 * j];
}
__device__ __forceinline__ void row_store_f32(float* row, int lane, const f32x4 (&v)[4]) {
#pragma unroll
    for (int j = 0; j < 4; ++j) ((f32x4*)row)[lane + 64 * j] = v[j];
}
__device__ __forceinline__ void row_store_bf16(bf16* row, int lane, const f32x4 (&v)[4]) {
#pragma unroll
    for (int j = 0; j < 4; ++j) { v2u w; w.x = pk2(v[j][0], v[j][1]); w.y = pk2(v[j][2], v[j][3]); ((v2u*)row)[lane + 64 * j] = w; }
}
__device__ __forceinline__ void row_load_bf16(const bf16* row, int lane, f32x4 (&v)[4]) {
#pragma unroll
    for (int j = 0; j < 4; ++j) { const v2u w = ((const v2u*)row)[lane + 64 * j]; v[j] = (f32x4){bflo(w.x), bfhi(w.x), bflo(w.y), bfhi(w.y)}; }
}
__device__ __forceinline__ void dma1k(const void* gsrc, unsigned lds_dst) { unsigned keep;
    asm volatile("s_mov_b32 %0, m0\n\ts_mov_b32 m0, %2\n\ts_nop 0\n\tglobal_load_lds_dwordx4 %1, off\n\ts_mov_b32 m0, %0" : "=&s"(keep) : "v"(gsrc), "s"(lds_dst) : "memory"); }
template <int KB> __device__ __forceinline__ void row_dma(const void* grow, unsigned lds_dst, int lane) {
#pragma unroll
    for (int i = 0; i < KB; ++i) dma1k((const char*)grow + 1024 * i + 16 * lane, (unsigned)__builtin_amdgcn_readfirstlane(lds_dst + 1024 * i));
}
#define DMA_WAIT_ALL() asm volatile("s_waitcnt vmcnt(0)" ::: "memory")
__device__ __forceinline__ void row_load_bf16_lds(const LAS unsigned char* row, int lane, f32x4 (&v)[4]) {
#pragma unroll
    for (int j = 0; j < 4; ++j) { const v2u w = ((const LAS v2u*)row)[lane + 64 * j]; v[j] = (f32x4){bflo(w.x), bfhi(w.x), bflo(w.y), bfhi(w.y)}; }
}
__device__ __forceinline__ void row_load_f32_lds(const LAS unsigned char* row, int lane, f32x4 (&v)[4]) {
#pragma unroll
    for (int j = 0; j < 4; ++j) v[j] = ((const LAS f32x4*)row)[lane + 64 * j];
}
__device__ __forceinline__ void row_layernorm(f32x4 (&v)[4], const float* g, const float* b, int lane) {
    float s = 0.f;
#pragma unroll
    for (int j = 0; j < 4; ++j) s += (v[j][0] + v[j][1]) + (v[j][2] + v[j][3]);
    const float mean = wave_sum(s) * (1.f / D); float s2 = 0.f;
#pragma unroll
    for (int j = 0; j < 4; ++j) { v[j] = v[j] - mean; s2 += (v[j][0] * v[j][0] + v[j][1] * v[j][1]) + (v[j][2] * v[j][2] + v[j][3] * v[j][3]); }
    const float rstd = 1.0f / sqrtf(wave_sum(s2) * (1.f / D) + LN_EPS);
#pragma unroll
    for (int j = 0; j < 4; ++j) { const f32x4 gg = ((const f32x4*)g)[lane + 64 * j], bb = ((const f32x4*)b)[lane + 64 * j]; v[j] = v[j] * rstd * gg + bb; }
}
template <int n, int o, int N> struct RedStep {
    static __device__ __forceinline__ void run(float (&a)[N], int lane) { const bool up = (lane & o) != 0;
#pragma unroll
        for (int i = 0; i < n / 2; ++i) { const float keep = up ? a[i + n / 2] : a[i], send = up ? a[i] : a[i + n / 2]; a[i] = keep + __shfl_xor(send, o); }
        RedStep<n / 2, o / 2, N>::run(a, lane); }
};
template <int o, int N> struct RedStep<1, o, N> {
    static __device__ __forceinline__ void run(float (&a)[N], int) { float r = a[0];
#pragma unroll
        for (int oo = o; oo >= 1; oo >>= 1) r += __shfl_xor(r, oo);
        a[0] = r; }
};
template <int N> __device__ __forceinline__ float wave_reduce_multi(float (&a)[N], int lane) { RedStep<N, 32, N>::run(a, lane); return a[0]; }
__device__ __forceinline__ void row_proj16x2(const f32x4 (&v0)[4], const f32x4 (&v1)[4], const f32x4* TB, float* sg0, float* sg1, int lane) {
    float a[16], b[16];
#pragma unroll
    for (int c = 0; c < 16; ++c) { a[c] = 0.f; b[c] = 0.f; }
#pragma unroll
    for (int j = 0; j < 4; ++j)
#pragma unroll
        for (int i = 0; i < 4; ++i) { const float x = v0[j][i], y = v1[j][i]; const f32x4* tb = TB + (size_t)((j * 4 + i) * 4) * 64 + lane;
            const f32x4 w0 = tb[0], w1 = tb[64], w2 = tb[128], w3 = tb[192];
#pragma unroll
            for (int c = 0; c < 4; ++c) { a[c] += x * w0[c]; a[4 + c] += x * w1[c]; a[8 + c] += x * w2[c]; a[12 + c] += x * w3[c]; b[c] += y * w0[c]; b[4 + c] += y * w1[c]; b[8 + c] += y * w2[c]; b[12 + c] += y * w3[c]; } }
    const float r0 = wave_reduce_multi<16>(a, lane), r1 = wave_reduce_multi<16>(b, lane);
    if ((lane & 3) == 0) { sg0[lane >> 2] = r0; if (sg1) sg1[lane >> 2] = r1; }
}
__device__ __forceinline__ void row_gate_proj2(Frame& F, const f32x4 (&v0)[4], const f32x4 (&v1)[4], int layer, int m0, int m1) {
    float* sg0 = (float*)(kws() + WS_SG) + (size_t)m0 * 16; float* sg1 = m1 >= 0 ? (float*)(kws() + WS_SG) + (size_t)m1 * 16 : nullptr;
    row_proj16x2(v0, v1, (const f32x4*)(kws() + WS_TAB + (size_t)layer * TAB_LAYER + TAB_GPW), sg0, sg1, F.lane);
}

__device__ __forceinline__ void row_gate_proj2_lds(Frame& F, const f32x4 (&v0)[4], const f32x4 (&v1)[4], const LAS f32x4* TB, int m0, int m1) {
    float* sg0 = (float*)(kws() + WS_SG) + (size_t)m0 * 16; float* sg1 = m1 >= 0 ? (float*)(kws() + WS_SG) + (size_t)m1 * 16 : nullptr;
    float a[16], b[16];
#pragma unroll
    for (int c = 0; c < 16; ++c) { a[c] = 0.f; b[c] = 0.f; }
#pragma unroll
    for (int j = 0; j < 4; ++j)
#pragma unroll
        for (int i = 0; i < 4; ++i) { const float x = v0[j][i], y = v1[j][i]; const LAS f32x4* tb = TB + ((j * 4 + i) * 4) * 64 + F.lane;
            const f32x4 w0 = tb[0], w1 = tb[64], w2 = tb[128], w3 = tb[192];
#pragma unroll
            for (int c = 0; c < 4; ++c) { a[c] += x * w0[c]; a[4 + c] += x * w1[c]; a[8 + c] += x * w2[c]; a[12 + c] += x * w3[c]; b[c] += y * w0[c]; b[4 + c] += y * w1[c]; b[8 + c] += y * w2[c]; b[12 + c] += y * w3[c]; } }
    const float r0 = wave_reduce_multi<16>(a, F.lane), r1 = wave_reduce_multi<16>(b, F.lane);
    if ((F.lane & 3) == 0) { sg0[F.lane >> 2] = r0; if (sg1) sg1[F.lane >> 2] = r1; }
}
struct TDesc { const float* src; bf16* dst; const float* ks; int ldw, ldt; float scale; };
__device__ __forceinline__ void tload(const TDesc& d, int lane, f32x4 (&v)[8]) { const int rs = lane >> 3, c4 = 4 * (lane & 7);
#pragma unroll
    for (int i = 0; i < 8; ++i) v[i] = *(const f32x4*)(d.src + (size_t)(8 * i + rs) * d.ldw + c4);
}
template <bool KS> __device__ __forceinline__ void tfinish(const TDesc& d, const f32x4 (&v)[8], LAS float* scr, int lane) { const int rs = lane >> 3, c4 = 4 * (lane & 7);
#pragma unroll
    for (int i = 0; i < 8; ++i) { const int kk = 8 * i + rs; float sc = d.scale; if constexpr (KS) { if (d.ks) sc *= d.ks[kk]; } LAS float* p = scr + kk * 33 + c4;
        p[0] = v[i][0] * sc; p[1] = v[i][1] * sc; p[2] = v[i][2] * sc; p[3] = v[i][3] * sc; }
    LDS_WAIT(); asm volatile("" ::: "memory");
    const int c = lane & 7;
#pragma unroll
    for (int j = 0; j < 4; ++j) { const int n = (lane >> 3) + 8 * j; const LAS float* s = scr + (8 * c) * 33 + n;
        v4u o; o.x = cvtpk(s[0 * 33], s[1 * 33]); o.y = cvtpk(s[2 * 33], s[3 * 33]); o.z = cvtpk(s[4 * 33], s[5 * 33]); o.w = cvtpk(s[6 * 33], s[7 * 33]);
        *(v4u*)(d.dst + (size_t)n * d.ldt + 8 * c) = o; }
    LDS_WAIT(); asm volatile("" ::: "memory");
}
constexpr int N_WINE = 2 * 2048, N_WINO = 2 * 1792, N_WOE = 2 * 768, N_WOO = 2 * 512, N_GU = 128 * 512, N_D = 128 * 256, N_TITEMS = N_WINE + N_WINO + N_WOE + N_WOO + N_GU + N_D;
__device__ __forceinline__ void tdecode(int it, TDesc& d) {
    bf16* WinE = (bf16*)(kws() + WS_WINE); bf16* WinO = (bf16*)(kws() + WS_WINO); bf16* WoutE = (bf16*)(kws() + WS_WOUTE); bf16* WoutO = (bf16*)(kws() + WS_WOUTO);
    bf16* Wgu = (bf16*)(kws() + WS_WGU); bf16* Wd = (bf16*)(kws() + WS_WD);
    int r = it; d.ks = nullptr; d.scale = 1.f;
    if (r < N_WINE) { const int j = r / 2048, q = r % 2048, kb = q / 128, nb = q % 128;
        d.src = KIN(I_ABWIN) + (size_t)j * D * AB_IN + (size_t)(64 * kb) * AB_IN + 32 * nb; d.ldw = AB_IN; d.dst = WinE + (size_t)j * NPE * D + (size_t)(32 * nb) * D + 64 * kb; d.ldt = D; return; } r -= N_WINE;
    if (r < N_WINO) { const int j = r / 1792, q = r % 1792, seg = q / 256, q2 = q % 256, kb = q2 / 16, nb = q2 % 16;
        const int scol = (seg < 3 ? 512 * seg : 1544 + 512 * (seg - 3)) + 32 * nb; d.scale = seg == 1 ? MLSTM_KSCALE : (seg == 4 ? FOX_C2 : 1.f);
        d.src = KIN(I_CDWIN) + (size_t)j * D * CD_IN + (size_t)(64 * kb) * CD_IN + scol; d.ldw = CD_IN; d.dst = WinO + (size_t)j * NPO * D + (size_t)(512 * seg + 32 * nb) * D + 64 * kb; d.ldt = D; return; } r -= N_WINO;
    if (r < N_WOE) { const int j = r / 768, q = r % 768, kb = q / 32, nb = q % 32;
        d.ks = kb >= 8 ? KIN(I_NORMW) + (size_t)j * 1024 + (64 * kb - 512) : nullptr;
        d.src = KIN(I_ABWOUT) + (size_t)j * 1536 * D + (size_t)(64 * kb) * D + 32 * nb; d.ldw = D; d.dst = WoutE + (size_t)j * D * 1536 + (size_t)(32 * nb) * 1536 + 64 * kb; d.ldt = 1536; return; } r -= N_WOE;
    if (r < N_WOO) { const int j = r / 512, q = r % 512, kb = q / 32, nb = q % 32;
        d.src = KIN(I_CDWOUT) + (size_t)j * D * D + (size_t)(64 * kb) * D + 32 * nb; d.ldw = D; d.dst = WoutO + (size_t)j * D * D + (size_t)(32 * nb) * D + 64 * kb; d.ldt = D; return; } r -= N_WOO;
    if (r < N_GU) { const int le = r / 512, q = r % 512, half = q / 256, q2 = q % 256, kb = q2 % 16, nb = q2 / 16, n0 = 32 * nb;
        d.src = (half ? KIN(I_WU) : KIN(I_WG)) + (size_t)le * D * 512 + (size_t)(64 * kb) * 512 + n0; d.ldw = 512;
        d.dst = Wgu + (size_t)le * D * D + (size_t)(256 * (n0 / 128) + 128 * half + (n0 % 128)) * D + 64 * kb; d.ldt = D; return; } r -= N_GU;
    { const int le = r / 256, q = r % 256, kb = q % 8, nb = q / 8;
        d.src = KIN(I_WDN) + (size_t)le * 512 * D + (size_t)(64 * kb) * D + 32 * nb; d.ldw = D; d.dst = Wd + (size_t)le * D * 512 + (size_t)(32 * nb) * 512 + 64 * kb; d.ldt = 512; }
}
__device__ __forceinline__ void p_prologue(Frame& F0) {   Frame F = F0; { int t_ = threadIdx.x; asm volatile("" : "+v"(t_)); F.tid = t_; F.lane = t_ & 63; }
    LAS float* scr = (LAS float*)(F.lds + F.wave * 16384);
    constexpr int KS_LO = N_WINE + N_WINO, KS_HI = KS_LO + N_WOE, N_PIPE = N_TITEMS - N_WOE;
#define PIPE_ITEM(q_) ((q_) < KS_LO ? (q_) : (q_) + N_WOE)
    { int q = F.gw; TDesc dA, dB; f32x4 vA[8], vB[8];
        { const int qc = q < N_PIPE ? q : N_PIPE - 1; tdecode(PIPE_ITEM(qc), dA); tload(dA, F.lane, vA); }
#pragma unroll 1
        while (q < N_PIPE) {
            const int qn = q + F.NGW; { const int qc = qn < N_PIPE ? qn : N_PIPE - 1; tdecode(PIPE_ITEM(qc), dB); tload(dB, F.lane, vB); }
            tfinish<false>(dA, vA, scr, F.lane);
            if (qn >= N_PIPE) break;
            q = qn + F.NGW; { const int qc = q < N_PIPE ? q : N_PIPE - 1; tdecode(PIPE_ITEM(qc), dA); tload(dA, F.lane, vA); }
            tfinish<false>(dB, vB, scr, F.lane); } }
#undef PIPE_ITEM
    asm volatile("s_waitcnt vmcnt(0)" ::: "memory");
    for (int it = KS_LO + F.gw; it < KS_HI; it += F.NGW) { TDesc d; f32x4 v[8]; tdecode(it, d); tload(d, F.lane, v); tfinish<true>(d, v, scr, F.lane); }
    for (int e = F.vcu * 512 + F.tid; e < DEPTH * 13312; e += F.G * 512) { const int L = e / 13312, r = e % 13312, ln = r & 63; f32x4* tab = (f32x4*)(kws() + WS_TAB + (size_t)L * TAB_LAYER);
        if (r < 4096) { const int ch = (r >> 6) & 3, ji = r >> 8, k = 256 * (ji >> 2) + 4 * ln + (ji & 3); const int jj = L >> 1;
            const float* src = (L & 1) ? KIN(I_CDWIN) + (size_t)jj * D * CD_IN + (size_t)k * CD_IN + (ch < 2 ? 1536 + 4 * ch : 3592 + 4 * (ch - 2)) : KIN(I_ABWIN) + (size_t)jj * D * AB_IN + (size_t)k * AB_IN + 4096 + 4 * ch;
            tab[TAB_GPW / 16 + r] = *(const f32x4*)src; }
        else if (r < 5120) { const int q = r - 4096, ji = q >> 6, k = 256 * (ji >> 2) + 4 * ln + (ji & 3); tab[TAB_RGW / 16 + q] = *(const f32x4*)(KIN(I_RGW) + (size_t)L * D * 4 + (size_t)k * 4); }
        else { const int q = r - 5120, half = (q >> 6) & 1, ji = (q >> 7) & 15, g = q >> 11, k = 256 * (ji >> 2) + 4 * ln + (ji & 3); tab[TAB_REW / 16 + q] = *(const f32x4*)(KIN(I_REW) + ((size_t)(L * 4 + g) * D + k) * 8 + 4 * half); } }
    bf16* HB = (bf16*)(kws() + WS_HB);
    __syncthreads();
    LAS f32x4* TBL = (LAS f32x4*)F.lds;
    for (int r = F.tid; r < 4096; r += 512) { const int ln = r & 63, ch = (r >> 6) & 3, ji = r >> 8, k = 256 * (ji >> 2) + 4 * ln + (ji & 3); TBL[r] = *(const f32x4*)(KIN(I_ABWIN) + (size_t)k * AB_IN + 4096 + 4 * ch); }
    __syncthreads();
#pragma unroll 1
    for (int m0 = F.gw; m0 < T; m0 += 2 * F.NGW) { const int m1 = m0 + F.NGW < T ? m0 + F.NGW : -1, m1c = m1 >= 0 ? m1 : m0; f32x4 v0[4], v1[4];
        row_load(KIN(I_X) + (size_t)m0 * D, F.lane, v0); row_load(KIN(I_X) + (size_t)m1c * D, F.lane, v1);
        row_store_bf16(HB + (size_t)m0 * D, F.lane, v0); if (m1 >= 0) row_store_bf16(HB + (size_t)m1 * D, F.lane, v1);
        row_gate_proj2_lds(F, v0, v1, TBL, m0, m1); }
}
__device__ __forceinline__ void e0_conv(Frame& F0, int j) {   Frame F = F0; { int t_ = threadIdx.x; asm volatile("" : "+v"(t_)); F.tid = t_; F.lane = t_ & 63; }
    const bf16* P = (const bf16*)(kws() + WS_R1); bf16* XBC = (bf16*)(kws() + WS_R3); bf16* MIX = (bf16*)(kws() + WS_MIX);
    const float* cw = KIN(I_CONVW) + (size_t)j * 4 * 1536; const float* cb = KIN(I_CONVB) + (size_t)j * 1536; const float* ca = KIN(I_CONVA) + (size_t)j * 3 * 512;
    constexpr int TT = 16;
    for (int it = F.gw; it < (T / TT) * 16; it += F.NGW) {
        const int tt = it >> 4, cg = it & 15, t0 = tt * TT, s0 = t0 & (SEQ - 1);
        if (cg < 12) {
            const int c = cg * 128 + 2 * F.lane;
            float w0[4], w1[4];
#pragma unroll
            for (int k = 0; k < 4; ++k) { w0[k] = cw[k * 1536 + c]; w1[k] = cw[k * 1536 + c + 1]; }
            const float b0 = cb[c], b1 = cb[c + 1];
            float xa[TT + 3], xb[TT + 3];
#pragma unroll
            for (int r = 0; r < TT + 3; ++r) { unsigned w = 0u; if (s0 - 3 + r >= 0) w = *(const unsigned*)(P + (size_t)(t0 - 3 + r) * NPE + 2560 + c); xa[r] = bflo(w); xb[r] = bfhi(w); }
#pragma unroll
            for (int o = 0; o < TT; ++o) { float a0 = b0, a1 = b1;
#pragma unroll
                for (int k = 0; k < 4; ++k) { a0 += w0[k] * xa[o + k]; a1 += w1[k] * xb[o + k]; }
                *(unsigned*)(XBC + (size_t)(t0 + o) * 1536 + c) = pk2(silu_f(a0), silu_f(a1)); }
        } else {
            const int c = (cg - 12) * 128 + 2 * F.lane;
            float w0[3], w1[3];
#pragma unroll
            for (int k = 0; k < 3; ++k) { w0[k] = ca[k * 512 + c]; w1[k] = ca[k * 512 + c + 1]; }
            float ua[TT + 2], ub[TT + 2]; unsigned bgw[TT];
#pragma unroll
            for (int o = 0; o < TT; ++o) bgw[o] = *(const unsigned*)(P + (size_t)(t0 + o) * NPE + c);
#pragma unroll
            for (int r = 0; r < TT + 2; ++r) { float a = 0.f, b = 0.f;
                if (s0 - 2 + r >= 0) { const bf16* pr = P + (size_t)(t0 - 2 + r) * NPE; const unsigned cgw = *(const unsigned*)(pr + 512 + c), xw = *(const unsigned*)(pr + 1024 + c); a = bflo(cgw) * bflo(xw); b = bfhi(cgw) * bfhi(xw); }
                ua[r] = a; ub[r] = b; }
#pragma unroll
            for (int o = 0; o < TT; ++o) { float a0 = 0.f, a1 = 0.f;
#pragma unroll
                for (int k = 0; k < 3; ++k) { a0 += w0[k] * ua[o + k]; a1 += w1[k] * ub[o + k]; }
                const unsigned bg = bgw[o];
                *(unsigned*)(MIX + (size_t)(t0 + o) * 1536 + c) = pk2(bflo(bg) * a0, bfhi(bg) * a1); }
        }
    }
}
__device__ __forceinline__ void ssd_gates(Frame& F, int j, int t0, int h, LAS float* dtl, LAS float* acs) {
    if (F.wave == 0) {
        const float* SG = (const float*)(kws() + WS_SG); const float dtb = KIN(I_DTB)[j * 16 + h], aneg = -expf(KIN(I_ALOG)[j * 16 + h]);
        const float d0 = softplus_f(SG[(size_t)(t0 + 2 * F.lane) * 16 + h] + dtb), d1 = softplus_f(SG[(size_t)(t0 + 2 * F.lane + 1) * 16 + h] + dtb);
        const float a0 = d0 * aneg, a1 = d1 * aneg; const float inc = wave_scan_sum(a0 + a1, F.lane);
        dtl[2 * F.lane] = d0; dtl[2 * F.lane + 1] = d1; acs[2 * F.lane] = inc - a1; acs[2 * F.lane + 1] = inc;
    }
}
__device__ __forceinline__ void e1_states(Frame& F0, int j) {   Frame F = F0; { int t_ = threadIdx.x; asm volatile("" : "+v"(t_)); F.tid = t_; F.lane = t_ & 63; }
    const bf16* XBC = (const bf16*)(kws() + WS_R3); float* ST = (float*)(kws() + WS_R4); float* DEC = (float*)(kws() + WS_DEC);
    LAS float* xw = (LAS float*)F.lds; LAS float* Bm = (LAS float*)(F.lds + 32768); LAS float* dtl = (LAS float*)(F.lds + SMALL_OFF); LAS float* acs = dtl + 128;
    for (int u = F.vcu; u < 2048; u += F.G) {
        const int b = u >> 8, c = (u >> 4) & 15, h = u & 15, g = h >> 2, t0 = b * SEQ + c * 128;
        __syncthreads();
        ssd_gates(F, j, t0, h, dtl, acs);
        __syncthreads();
        for (int i = F.tid; i < 128 * 32; i += 512) { const int l = i >> 5, pp = (i & 31) * 2; const float wgt = expf(acs[127] - acs[l]) * dtl[l];
            const unsigned xv = *(const unsigned*)(XBC + (size_t)(t0 + l) * 1536 + h * 64 + pp), bv = *(const unsigned*)(XBC + (size_t)(t0 + l) * 1536 + 1024 + g * 64 + pp);
            xw[l * 64 + pp] = bflo(xv) * wgt; xw[l * 64 + pp + 1] = bfhi(xv) * wgt; Bm[l * 64 + pp] = bflo(bv); Bm[l * 64 + pp + 1] = bfhi(bv); }
        __syncthreads();
        const int n = F.lane, p0 = 8 * F.wave; float acc[8];
#pragma unroll
        for (int i = 0; i < 8; ++i) acc[i] = 0.f;
#pragma unroll 2
        for (int l = 0; l < 128; ++l) { const float bm = Bm[l * 64 + n]; const f32x4 x0 = *(const LAS f32x4*)(xw + l * 64 + p0), x1 = *(const LAS f32x4*)(xw + l * 64 + p0 + 4);
#pragma unroll
            for (int i = 0; i < 4; ++i) { acc[i] += x0[i] * bm; acc[4 + i] += x1[i] * bm; } }
        float* dst = ST + (size_t)u * 4096;
#pragma unroll
        for (int i = 0; i < 8; ++i) dst[(p0 + i) * 64 + n] = acc[i];
        if (F.tid == 0) DEC[u] = expf(acs[127]);
    }
}
__device__ __forceinline__ void e2_scan(Frame& F0) {   Frame F = F0; { int t_ = threadIdx.x; asm volatile("" : "+v"(t_)); F.tid = t_; F.lane = t_ & 63; }
    float* ST = (float*)(kws() + WS_R4); const float* DEC = (const float*)(kws() + WS_DEC);
    for (int e = F.vcu * 512 + F.tid; e < NBATCH * 16 * 4096; e += F.G * 512) {
        const int b = e >> 16, h = (e >> 12) & 15, pn = e & 4095; float run = 0.f; float s[16], dc[16];
#pragma unroll
        for (int c = 0; c < 16; ++c) { const int u = (b * 16 + c) * 16 + h; s[c] = ST[(size_t)u * 4096 + pn]; dc[c] = DEC[u]; }
#pragma unroll
        for (int c = 0; c < 16; ++c) { const int u = (b * 16 + c) * 16 + h; ST[(size_t)u * 4096 + pn] = run; run = run * dc[c] + s[c]; }
    }
}
__device__ __forceinline__ void e3_output(Frame& F0, int j) {   Frame F = F0; { int t_ = threadIdx.x; asm volatile("" : "+v"(t_)); F.tid = t_; F.lane = t_ & 63; }
    const bf16* XBC = (const bf16*)(kws() + WS_R3); const float* ST = (const float*)(kws() + WS_R4); float* Y = (float*)(kws() + WS_R2);
    LAS float* R0 = (LAS float*)F.lds;
    LAS float* R1 = (LAS float*)(F.lds + 32768);
    LAS float* R2 = (LAS float*)(F.lds + 65536);
    LAS float* dtl = (LAS float*)(F.lds + SMALL_OFF); LAS float* acs = dtl + 128;
    for (int u = F.vcu; u < 2048; u += F.G) {
        const int b = u >> 8, c = (u >> 4) & 15, h = u & 15, g = h >> 2, t0 = b * SEQ + c * 128;
        __syncthreads();
        ssd_gates(F, j, t0, h, dtl, acs);
        for (int i = F.tid; i < 128 * 32; i += 512) { const int l = i >> 5, nn = (i & 31) * 2;
            const unsigned bv = *(const unsigned*)(XBC + (size_t)(t0 + l) * 1536 + 1024 + g * 64 + nn), cv = *(const unsigned*)(XBC + (size_t)(t0 + l) * 1536 + 1280 + g * 64 + nn);
            R0[l * 64 + nn] = bflo(cv); R0[l * 64 + nn + 1] = bfhi(cv); R1[nn * 128 + l] = bflo(bv); R1[(nn + 1) * 128 + l] = bfhi(bv); }
        { const float* hp = ST + (size_t)u * 4096; for (int i = F.tid; i < 4096; i += 512) { const int p = i >> 6, n = i & 63; R2[n * 64 + p] = hp[i]; } }
        __syncthreads();
        const int p = F.lane, l0 = 16 * F.wave; float acc[16];
#pragma unroll
        for (int i = 0; i < 16; ++i) acc[i] = 0.f;
#pragma unroll 1
        for (int n0 = 0; n0 < 64; n0 += 4) { float hp[4];
#pragma unroll
            for (int i = 0; i < 4; ++i) hp[i] = R2[(n0 + i) * 64 + p];
#pragma unroll
            for (int li = 0; li < 16; ++li) { const f32x4 c4 = *(const LAS f32x4*)(R0 + (l0 + li) * 64 + n0); acc[li] += (c4[0] * hp[0] + c4[1] * hp[1]) + (c4[2] * hp[2] + c4[3] * hp[3]); } }
#pragma unroll
        for (int li = 0; li < 16; ++li) acc[li] *= expf(acs[l0 + li]);
        __syncthreads();
#pragma unroll 1
        for (int half = 0; half < 2; ++half) { const int s = F.tid & 127, lg = 32 * (F.tid >> 7) + 16 * half; float gacc[16];
#pragma unroll
            for (int i = 0; i < 16; ++i) gacc[i] = 0.f;
#pragma unroll 1
            for (int n0 = 0; n0 < 64; n0 += 4) { float bb[4];
#pragma unroll
                for (int i = 0; i < 4; ++i) bb[i] = R1[(n0 + i) * 128 + s];
#pragma unroll
                for (int li = 0; li < 16; ++li) { const f32x4 c4 = *(const LAS f32x4*)(R0 + (lg + li) * 64 + n0); gacc[li] += (c4[0] * bb[0] + c4[1] * bb[1]) + (c4[2] * bb[2] + c4[3] * bb[3]); } }
            const float as = acs[s];
#pragma unroll
            for (int li = 0; li < 16; ++li) { const int l = lg + li; R2[l * 128 + s] = (s <= l) ? gacc[li] * expf(acs[l] - as) : 0.f; } }
        __syncthreads();
        for (int i = F.tid; i < 128 * 32; i += 512) { const int l = i >> 5, pp = (i & 31) * 2; const unsigned xv = *(const unsigned*)(XBC + (size_t)(t0 + l) * 1536 + h * 64 + pp);
            R0[l * 64 + pp] = bflo(xv); R0[l * 64 + pp + 1] = bfhi(xv); }
        __syncthreads();
#pragma unroll 1
        for (int s0 = 0; s0 < l0 + 16; s0 += 4) { float xv[4];
#pragma unroll
            for (int i = 0; i < 4; ++i) xv[i] = R0[(s0 + i) * 64 + p] * dtl[s0 + i];
#pragma unroll
            for (int li = 0; li < 16; ++li) { const f32x4 g4 = *(const LAS f32x4*)(R2 + (l0 + li) * 128 + s0); acc[li] += (g4[0] * xv[0] + g4[1] * xv[1]) + (g4[2] * xv[2] + g4[3] * xv[3]); } }
        const float dsk = KIN(I_DSKIP)[j * 16 + h];
#pragma unroll
        for (int li = 0; li < 16; ++li) Y[(size_t)(t0 + l0 + li) * D + h * 64 + p] = acc[li] + dsk * R0[(l0 + li) * 64 + p];
    }
}
__device__ __forceinline__ void e4_gnorm(Frame& F0) {   Frame F = F0; { int t_ = threadIdx.x; asm volatile("" : "+v"(t_)); F.tid = t_; F.lane = t_ & 63; }
    const float* Y = (const float*)(kws() + WS_R2); const bf16* P = (const bf16*)(kws() + WS_R1); bf16* MIX = (bf16*)(kws() + WS_MIX);
#pragma unroll 1
    for (int m0 = F.gw; m0 < T; m0 += 2 * F.NGW) { const int m1 = m0 + F.NGW < T ? m0 + F.NGW : m0; const int mm[2] = {m0, m1}; f32x4 y[2][4], z[2][4]; float rstd[2];
#pragma unroll
        for (int rr = 0; rr < 2; ++rr) { row_load(Y + (size_t)mm[rr] * D, F.lane, y[rr]); row_load_bf16(P + (size_t)mm[rr] * NPE + 1536, F.lane, z[rr]); }
#pragma unroll
        for (int rr = 0; rr < 2; ++rr) { float ss = 0.f;
#pragma unroll
            for (int jj = 0; jj < 4; ++jj)
#pragma unroll
                for (int i = 0; i < 4; ++i) { const float uu = y[rr][jj][i] * silu_f(z[rr][jj][i]); y[rr][jj][i] = uu; ss += uu * uu; }
            rstd[rr] = 1.0f / sqrtf(wave_sum(ss) * (1.f / D) + LN_EPS); }
#pragma unroll
        for (int rr = 0; rr < 2; ++rr) {
#pragma unroll
            for (int jj = 0; jj < 4; ++jj) y[rr][jj] = y[rr][jj] * rstd[rr];
            if (rr == 0 || m1 != m0) row_store_bf16(MIX + (size_t)mm[rr] * 1536 + 512, F.lane, y[rr]); } }
}
__device__ __forceinline__ void o_foxscan(Frame& F0, int j) {   Frame F = F0; { int t_ = threadIdx.x; asm volatile("" : "+v"(t_)); F.tid = t_; F.lane = t_ & 63; }
    const float* SG = (const float*)(kws() + WS_SG); float* FOXC = (float*)(kws() + WS_FOXC);
    for (int bh = F.gw; bh < 64; bh += F.NGW) { const int b = bh >> 3, h = bh & 7; const float bias = KIN(I_FOXB)[j * 8 + h];
        float v[32], run = 0.f;
#pragma unroll
        for (int i = 0; i < 32; ++i) { run += logsigmoid_f(SG[(size_t)(b * SEQ + 32 * F.lane + i) * 16 + 8 + h] + bias); v[i] = run; }
        const float off = wave_scan_sum(run, F.lane) - run;
#pragma unroll
        for (int i = 0; i < 32; ++i) FOXC[(size_t)bh * SEQ + 32 * F.lane + i] = (v[i] + off) * LOG2E; }
}
__device__ __forceinline__ void mlstm_gates(Frame& F, int j, int t0, int h, float& bcum, float& ib) {
    const float* SG = (const float*)(kws() + WS_SG);
    ib = SG[(size_t)(t0 + F.lane) * 16 + h] + KIN(I_IB)[j * 4 + h];
    bcum = wave_scan_sum(logsigmoid_f(SG[(size_t)(t0 + F.lane) * 16 + 4 + h] + KIN(I_FB)[j * 4 + h]), F.lane);
}
__device__ __forceinline__ void o1_local(Frame& F0, int j) {   Frame F = F0; { int t_ = threadIdx.x; asm volatile("" : "+v"(t_)); F.tid = t_; F.lane = t_ & 63; }
    const bf16* P = (const bf16*)(kws() + WS_R1); float* KLOC = (float*)(kws() + WS_R2); float* NLOC = (float*)(kws() + WS_NLOC); float* MLOC = (float*)(kws() + WS_MLOC); float* BLAST = (float*)(kws() + WS_BLAST);
    LAS float* kw = (LAS float*)F.lds; LAS float* Vs = (LAS float*)(F.lds + 32768); LAS float* wk = (LAS float*)(F.lds + SMALL_OFF);
    for (int u = F.vcu; u < 1024; u += F.G) {
        const int b = u >> 7, h = (u >> 5) & 3, c = u & 31, t0 = b * SEQ + c * 64;
        __syncthreads();
        if (F.wave == 0) { float bcum, ib; mlstm_gates(F, j, t0, h, bcum, ib); const float blast = __shfl(bcum, 63); const float gl = blast - bcum + ib; const float ml = wave_max(gl);
            wk[F.lane] = expf(gl - ml); if (F.lane == 0) { MLOC[u] = ml; BLAST[u] = blast; } }
        __syncthreads();
        for (int i = F.tid; i < 64 * 64; i += 512) { const int s = i >> 6, dd = (i & 63) * 2; const float w = wk[s];
            const unsigned kv = *(const unsigned*)(P + (size_t)(t0 + s) * NPO + 512 + h * 128 + dd), vv = *(const unsigned*)(P + (size_t)(t0 + s) * NPO + 1024 + h * 128 + dd);
            kw[s * 128 + dd] = bflo(kv) * w; kw[s * 128 + dd + 1] = bfhi(kv) * w; Vs[s * 128 + dd] = bflo(vv); Vs[s * 128 + dd + 1] = bfhi(vv); }
        __syncthreads();
        const int v = F.tid & 127, d0 = 32 * (F.tid >> 7); float acc[32];
#pragma unroll
        for (int i = 0; i < 32; ++i) acc[i] = 0.f;
#pragma unroll 1
        for (int s = 0; s < 64; ++s) { const float vv = Vs[s * 128 + v];
#pragma unroll
            for (int di = 0; di < 32; di += 4) { const f32x4 k4 = *(const LAS f32x4*)(kw + s * 128 + d0 + di);
#pragma unroll
                for (int i = 0; i < 4; ++i) acc[di + i] += k4[i] * vv; } }
        float* dst = KLOC + (size_t)u * 16384;
#pragma unroll
        for (int i = 0; i < 32; ++i) dst[(d0 + i) * 128 + v] = acc[i];
        if (F.tid < 128) { float a = 0.f; for (int s = 0; s < 64; ++s) a += kw[s * 128 + F.tid]; NLOC[(size_t)u * 128 + F.tid] = a; }
    }
}
__device__ __forceinline__ void o2_scan(Frame& F0) {   Frame F = F0; { int t_ = threadIdx.x; asm volatile("" : "+v"(t_)); F.tid = t_; F.lane = t_ & 63; }
    float* KLOC = (float*)(kws() + WS_R2); float* NLOC = (float*)(kws() + WS_NLOC); const float* MLOC = (const float*)(kws() + WS_MLOC); const float* BLAST = (const float*)(kws() + WS_BLAST); float* MPREV = (float*)(kws() + WS_MPREV);
    constexpr int PER = 16384 + 128;
    for (int e = F.vcu * 512 + F.tid; e < 32 * PER; e += F.G * 512) {
        const int bh = e / PER, r = e % PER; float run = 0.f, m = 0.f;
#pragma unroll 1
        for (int c0 = 0; c0 < 32; c0 += 16) { float loc[16], bl[16], ml[16];
#pragma unroll
            for (int i = 0; i < 16; ++i) { const int u = bh * 32 + c0 + i; const float* p = r < 16384 ? KLOC + (size_t)u * 16384 + r : NLOC + (size_t)u * 128 + (r - 16384); loc[i] = *p; bl[i] = BLAST[u]; ml[i] = MLOC[u]; }
#pragma unroll
            for (int i = 0; i < 16; ++i) { const int u = bh * 32 + c0 + i; float* p = r < 16384 ? KLOC + (size_t)u * 16384 + r : NLOC + (size_t)u * 128 + (r - 16384);
                *p = run; if (r == 0) MPREV[u] = m;
                const float mn = fmaxf(bl[i] + m, ml[i]);
                run = expf(bl[i] + m - mn) * run + expf(ml[i] - mn) * loc[i]; m = mn; } }
    }
}
__device__ __forceinline__ void o3_output(Frame& F0, int j) {   Frame F = F0; { int t_ = threadIdx.x; asm volatile("" : "+v"(t_)); F.tid = t_; F.lane = t_ & 63; }
    const bf16* P = (const bf16*)(kws() + WS_R1); const float* CPREV = (const float*)(kws() + WS_R2); const float* NPREV = (const float*)(kws() + WS_NLOC); const float* MPREV = (const float*)(kws() + WS_MPREV); bf16* MIX = (bf16*)(kws() + WS_MIX);
    LAS float* qT = (LAS float*)F.lds;
    LAS float* kT = (LAS float*)(F.lds + 32768);
    LAS float* Vs = (LAS float*)(F.lds + 65536);
    LAS float* WT = (LAS float*)(F.lds + 98304);
    LAS float* sm = (LAS float*)(F.lds + SMALL_OFF);
    for (int u = F.vcu; u < 1024; u += F.G) {
        const int b = u >> 7, h = (u >> 5) & 3, c = u & 31, t0 = b * SEQ + c * 64;
        __syncthreads();
        if (F.wave == 0) { float bcum, ib; mlstm_gates(F, j, t0, h, bcum, ib); const float mprev = MPREV[u];
            const float pm = wave_scan_max(ib - bcum, F.lane); const float inter = bcum + mprev; const float mt = fmaxf(bcum + pm, inter);
            sm[F.lane] = bcum; sm[64 + F.lane] = ib; sm[128 + F.lane] = mt; sm[192 + F.lane] = expf(inter - mt); }
        for (int i = F.tid; i < 64 * 64; i += 512) { const int s = i >> 6, dd = (i & 63) * 2; const bf16* pr = P + (size_t)(t0 + s) * NPO + h * 128 + dd;
            const unsigned qv = *(const unsigned*)pr, kv = *(const unsigned*)(pr + 512), vv = *(const unsigned*)(pr + 1024);
            qT[dd * 64 + s] = bflo(qv); qT[(dd + 1) * 64 + s] = bfhi(qv); kT[dd * 64 + s] = bflo(kv); kT[(dd + 1) * 64 + s] = bfhi(kv); Vs[s * 128 + dd] = bflo(vv); Vs[s * 128 + dd + 1] = bfhi(vv); }
        __syncthreads();
        { const int s = F.lane, l0 = 8 * F.wave; float acc[8];
#pragma unroll
            for (int i = 0; i < 8; ++i) acc[i] = 0.f;
#pragma unroll 2
            for (int d = 0; d < 128; ++d) { const float kk = kT[d * 64 + s]; const f32x4 q0 = *(const LAS f32x4*)(qT + d * 64 + l0), q1 = *(const LAS f32x4*)(qT + d * 64 + l0 + 4);
#pragma unroll
                for (int i = 0; i < 4; ++i) { acc[i] += q0[i] * kk; acc[4 + i] += q1[i] * kk; } }
            const float gs = sm[64 + s] - sm[s];
#pragma unroll
            for (int i = 0; i < 8; ++i) { const int l = l0 + i; const float w = (s <= l) ? acc[i] * expf(sm[l] + gs - sm[128 + l]) : 0.f; WT[s * 64 + l] = w; const float dsum = wave_sum(w); if (F.lane == 0) sm[256 + l] = dsum; } }
        __syncthreads();
        if (F.tid < 64) { const int l = F.tid; float qn = 0.f; const float* np = NPREV + (size_t)u * 128; for (int d = 0; d < 128; ++d) qn += qT[d * 64 + l] * np[d]; sm[256 + l] += sm[192 + l] * qn; }
        const int v = F.tid & 127, l0 = 16 * (F.tid >> 7); float acc[16];
#pragma unroll
        for (int i = 0; i < 16; ++i) acc[i] = 0.f;
        { const float* cp = CPREV + (size_t)u * 16384;
#pragma unroll 2
            for (int d = 0; d < 128; ++d) { const float cc = cp[d * 128 + v];
#pragma unroll
                for (int li = 0; li < 16; li += 4) { const f32x4 q4 = *(const LAS f32x4*)(qT + d * 64 + l0 + li);
#pragma unroll
                    for (int i = 0; i < 4; ++i) acc[li + i] += q4[i] * cc; } } }
#pragma unroll
        for (int i = 0; i < 16; ++i) acc[i] *= sm[192 + l0 + i];
#pragma unroll 2
        for (int s = 0; s < 64; ++s) { const float vv = Vs[s * 128 + v];
#pragma unroll
            for (int li = 0; li < 16; li += 4) { const f32x4 w4 = *(const LAS f32x4*)(WT + s * 64 + l0 + li);
#pragma unroll
                for (int i = 0; i < 4; ++i) acc[li + i] += w4[i] * vv; } }
        __syncthreads();
        LAS float* hb = kT;
#pragma unroll
        for (int i = 0; i < 16; ++i) { const int l = l0 + i; const float hv = acc[i] / fmaxf(fabsf(sm[256 + l]), expf(-sm[128 + l])); acc[i] = hv; hb[l * 128 + v] = hv; }
        __syncthreads();
        { const int lb = 8 * F.wave;
#pragma unroll
            for (int i = 0; i < 8; ++i) { const int l = lb + i; const float a = hb[l * 128 + F.lane], bq = hb[l * 128 + 64 + F.lane]; const float mu = wave_sum(a + bq) * (1.f / 128.f);
                const float da = a - mu, db = bq - mu; const float var = wave_sum(da * da + db * db) * (1.f / 128.f); if (F.lane == 0) { sm[320 + l] = mu; sm[384 + l] = 1.0f / sqrtf(var + LN_EPS); } } }
        __syncthreads();
        const float hw = KIN(I_HNW)[j * 512 + h * 128 + v];
#pragma unroll
        for (int i = 0; i < 16; ++i) { const int l = l0 + i; const float og = sigmoid_f(bf2f(P[(size_t)(t0 + l) * NPO + 1536 + h * 128 + v]));
            MIX[(size_t)(t0 + l) * D + h * 128 + v] = (bf16)f2bf(og * (acc[i] - sm[320 + l]) * sm[384 + l] * hw); }
    }
}
__device__ __forceinline__ void o4_fox(Frame& F0) {   Frame F = F0; { int t_ = threadIdx.x; asm volatile("" : "+v"(t_)); F.tid = t_; F.lane = t_ & 63; }
    const bf16* P = (const bf16*)(kws() + WS_R1); const float* FOXC = (const float*)(kws() + WS_FOXC); bf16* MIX = (bf16*)(kws() + WS_MIX);
    LAS float* QT = (LAS float*)F.lds;
    LAS float* KT = (LAS float*)(F.lds + 16384);
    LAS float* Vs = (LAS float*)(F.lds + 32768);
    LAS float* PT = (LAS float*)(F.lds + 49152) + F.wave * 512;
    LAS float* cq = (LAS float*)(F.lds + SMALL_OFF); LAS float* ck = cq + 64;
    for (int it = F.vcu; it < 2048; it += F.G) {
        const int qt = 31 - (it >> 6), bh = it & 63, b = bh >> 3, h = bh & 7, tq0 = b * SEQ + qt * 64;
        __syncthreads();
        for (int i = F.tid; i < 64 * 32; i += 512) { const int q = i >> 5, dd = (i & 31) * 2; const unsigned w = *(const unsigned*)(P + (size_t)(tq0 + q) * NPO + 2048 + h * 64 + dd); QT[dd * 64 + q] = bflo(w); QT[(dd + 1) * 64 + q] = bfhi(w); }
        if (F.tid < 64) cq[F.tid] = FOXC[(size_t)bh * SEQ + qt * 64 + F.tid];
        const int q0 = 8 * F.wave; float mrun[8], lrun[8], o[8];
#pragma unroll
        for (int i = 0; i < 8; ++i) { mrun[i] = -INFINITY; lrun[i] = 0.f; o[i] = 0.f; }
#pragma unroll 1
        for (int kt = 0; kt <= qt; ++kt) { const int tk0 = b * SEQ + kt * 64;
            __syncthreads();
            for (int i = F.tid; i < 64 * 32; i += 512) { const int k = i >> 5, dd = (i & 31) * 2; const bf16* pr = P + (size_t)(tk0 + k) * NPO + h * 64 + dd; const unsigned kw = *(const unsigned*)(pr + 2560), vw = *(const unsigned*)(pr + 3072);
                KT[dd * 64 + k] = bflo(kw); KT[(dd + 1) * 64 + k] = bfhi(kw); Vs[k * 64 + dd] = bflo(vw); Vs[k * 64 + dd + 1] = bfhi(vw); }
            if (F.tid < 64) ck[F.tid] = FOXC[(size_t)bh * SEQ + kt * 64 + F.tid];
            __syncthreads();
            float s[8];
#pragma unroll
            for (int i = 0; i < 8; ++i) s[i] = 0.f;
#pragma unroll 2
            for (int d = 0; d < 64; ++d) { const float kk = KT[d * 64 + F.lane]; const f32x4 qa = *(const LAS f32x4*)(QT + d * 64 + q0), qb = *(const LAS f32x4*)(QT + d * 64 + q0 + 4);
#pragma unroll
                for (int i = 0; i < 4; ++i) { s[i] += qa[i] * kk; s[4 + i] += qb[i] * kk; } }
            const float ckv = ck[F.lane];
#pragma unroll
            for (int i = 0; i < 8; ++i) { float sv = s[i] + cq[q0 + i] - ckv; if (kt == qt && F.lane > q0 + i) sv = -INFINITY;
                const float mn = fmaxf(mrun[i], wave_max(sv)); const float p = exp2f(sv - mn), al = exp2f(mrun[i] - mn);
                lrun[i] = lrun[i] * al + wave_sum(p); o[i] *= al; mrun[i] = mn; PT[F.lane * 8 + i] = p; }
            LDS_WAIT(); asm volatile("" ::: "memory");
#pragma unroll 2
            for (int k = 0; k < 64; ++k) { const float vv = Vs[k * 64 + F.lane]; const f32x4 pa = *(const LAS f32x4*)(PT + k * 8), pb = *(const LAS f32x4*)(PT + k * 8 + 4);
#pragma unroll
                for (int i = 0; i < 4; ++i) { o[i] += pa[i] * vv; o[4 + i] += pb[i] * vv; } }
        }
#pragma unroll
        for (int i = 0; i < 8; ++i) MIX[(size_t)(tq0 + q0 + i) * D + 512 + h * 64 + F.lane] = (bf16)f2bf(o[i] / lrun[i]);
    }
}
typedef short bf16x8 __attribute__((ext_vector_type(8)));
typedef float f32x16 __attribute__((ext_vector_type(16)));
#define MFMA32(a, b, c) __builtin_amdgcn_mfma_f32_32x32x16_bf16((a), (b), (c), 0, 0, 0)
__device__ __forceinline__ int crow(int r, int h) { return (r & 3) + 8 * (r >> 2) + 4 * h; }
__device__ __forceinline__ bf16x8 pack8(float a0, float a1, float a2, float a3, float a4, float a5, float a6, float a7) {
    v4u p; p.x = cvtpk(a0, a1); p.y = cvtpk(a2, a3); p.z = cvtpk(a4, a5); p.w = cvtpk(a6, a7); return __builtin_bit_cast(bf16x8, p); }
__device__ __forceinline__ bf16x8 pack_step(const f32x16& x, int s) { return pack8(x[8 * s], x[8 * s + 1], x[8 * s + 2], x[8 * s + 3], x[8 * s + 4], x[8 * s + 5], x[8 * s + 6], x[8 * s + 7]); }
__device__ __forceinline__ bf16x8 ldg8_f32(const float* p) { const f32x4 a = *(const f32x4*)p, b = *(const f32x4*)(p + 4); return pack8(a[0], a[1], a[2], a[3], b[0], b[1], b[2], b[3]); }
__device__ __forceinline__ bf16x8 lds_nat(const LAS bf16* row, int ks, int h) { return *(const LAS bf16x8*)(row + 16 * ks + 8 * h); }
__device__ __forceinline__ bf16x8 lds_krow(const LAS bf16* row, int k0, int h) { const v2u lo = *(const LAS v2u*)(row + k0 + 4 * h), hi = *(const LAS v2u*)(row + k0 + 8 + 4 * h);
    v4u p; p.x = lo.x; p.y = lo.y; p.z = hi.x; p.w = hi.y; return __builtin_bit_cast(bf16x8, p); }
__device__ __forceinline__ f32x16 zero16() { f32x16 z;
#pragma unroll
    for (int i = 0; i < 16; ++i) z[i] = 0.f;
    return z; }

__device__ __forceinline__ void ssd_gates4(Frame& F, int j, int t0, int g, LAS float* DT, LAS float* ACS) {
    if (F.wave < 4) { const int h = 4 * g + F.wave; const float* SG = (const float*)(kws() + WS_SG); const float dtb = KIN(I_DTB)[j * 16 + h], aneg = -expf(KIN(I_ALOG)[j * 16 + h]);
        const float d0 = softplus_f(SG[(size_t)(t0 + 2 * F.lane) * 16 + h] + dtb), d1 = softplus_f(SG[(size_t)(t0 + 2 * F.lane + 1) * 16 + h] + dtb);
        const float a0 = d0 * aneg, a1 = d1 * aneg; const float inc = wave_scan_sum(a0 + a1, F.lane);
        DT[F.wave * 128 + 2 * F.lane] = d0; DT[F.wave * 128 + 2 * F.lane + 1] = d1; ACS[F.wave * 128 + 2 * F.lane] = inc - a1; ACS[F.wave * 128 + 2 * F.lane + 1] = inc; }
}
__device__ __forceinline__ void ssd_stage_xt(Frame& F, const bf16* XBC, int t0, int g, LAS bf16* XT, const LAS float* WGT) {
    for (int i = F.tid; i < 2048; i += 512) { const int cp = i & 127, s0 = 8 * (i >> 7), hl = cp >> 5; float a[8], bq[8];
#pragma unroll
        for (int k = 0; k < 8; ++k) { const unsigned w = *(const unsigned*)(XBC + (size_t)(t0 + s0 + k) * 1536 + g * 256 + 2 * cp); const float wg = WGT[hl * 128 + s0 + k]; a[k] = bflo(w) * wg; bq[k] = bfhi(w) * wg; }
        *(LAS bf16x8*)(XT + (2 * cp) * 136 + s0) = pack8(a[0], a[1], a[2], a[3], a[4], a[5], a[6], a[7]);
        *(LAS bf16x8*)(XT + (2 * cp + 1) * 136 + s0) = pack8(bq[0], bq[1], bq[2], bq[3], bq[4], bq[5], bq[6], bq[7]); }
}
__device__ __forceinline__ void e1_states_mfma(Frame& F0, int j) {   Frame F = F0; { int t_ = threadIdx.x; asm volatile("" : "+v"(t_)); F.tid = t_; F.lane = t_ & 63; }
    const bf16* XBC = (const bf16*)(kws() + WS_R3); float* ST = (float*)(kws() + WS_R4); float* DEC = (float*)(kws() + WS_DEC);
    LAS bf16* XT = (LAS bf16*)F.lds; LAS bf16* BT = (LAS bf16*)(F.lds + 69632);
    LAS float* DT = (LAS float*)(F.lds + 98304); LAS float* ACS = DT + 512; LAS float* WGT = DT + 1024;
    for (int u = F.vcu; u < 512; u += F.G) {
        const int b = u >> 6, c = (u >> 2) & 15, g = u & 3, t0 = b * SEQ + c * 128;
        __syncthreads();
        ssd_gates4(F, j, t0, g, DT, ACS);
        { const int np = F.tid & 31, l0 = 8 * (F.tid >> 5); float a[8], bq[8];
#pragma unroll
            for (int k = 0; k < 8; ++k) { const unsigned w = *(const unsigned*)(XBC + (size_t)(t0 + l0 + k) * 1536 + 1024 + g * 64 + 2 * np); a[k] = bflo(w); bq[k] = bfhi(w); }
            *(LAS bf16x8*)(BT + (2 * np) * 136 + l0) = pack8(a[0], a[1], a[2], a[3], a[4], a[5], a[6], a[7]);
            *(LAS bf16x8*)(BT + (2 * np + 1) * 136 + l0) = pack8(bq[0], bq[1], bq[2], bq[3], bq[4], bq[5], bq[6], bq[7]); }
        __syncthreads();
        { const int hl = F.tid >> 7, l = F.tid & 127; WGT[F.tid] = expf(ACS[hl * 128 + 127] - ACS[F.tid]) * DT[F.tid]; if (l == 127) DEC[(b * 16 + c) * 16 + 4 * g + hl] = expf(ACS[F.tid]); }
        __syncthreads();
        ssd_stage_xt(F, XBC, t0, g, XT, WGT);
        __syncthreads();
        const int hl = F.wave >> 1, nt = F.wave & 1, li = F.lane & 31, hh = F.lane >> 5;
        f32x16 acc0 = zero16(), acc1 = zero16();
        const LAS bf16* ar0 = XT + (hl * 64 + li) * 136; const LAS bf16* ar1 = ar0 + 32 * 136; const LAS bf16* br = BT + (32 * nt + li) * 136;
#pragma unroll
        for (int ks = 0; ks < 8; ++ks) { const bf16x8 bf = lds_nat(br, ks, hh); acc0 = MFMA32(lds_nat(ar0, ks, hh), bf, acc0); acc1 = MFMA32(lds_nat(ar1, ks, hh), bf, acc1); }
        float* dst = ST + (size_t)((b * 16 + c) * 16 + 4 * g + hl) * 4096 + 32 * nt + li;
#pragma unroll
        for (int r = 0; r < 16; ++r) { dst[crow(r, hh) * 64] = acc0[r]; dst[(32 + crow(r, hh)) * 64] = acc1[r]; }
    }
}
__device__ __forceinline__ void e3_output_mfma(Frame& F0, int j) {   Frame F = F0; { int t_ = threadIdx.x; asm volatile("" : "+v"(t_)); F.tid = t_; F.lane = t_ & 63; }
    const bf16* XBC = (const bf16*)(kws() + WS_R3); const float* ST = (const float*)(kws() + WS_R4); float* Y = (float*)(kws() + WS_R2);
    LAS bf16* CR = (LAS bf16*)F.lds; LAS bf16* BR = (LAS bf16*)(F.lds + 18432); LAS bf16* XT = (LAS bf16*)(F.lds + 36864);
    LAS float* DT = (LAS float*)(F.lds + 106496); LAS float* ACS = DT + 512;
    for (int u = F.vcu; u < 512; u += F.G) {
        const int b = u >> 6, c = (u >> 2) & 15, g = u & 3, t0 = b * SEQ + c * 128;
        __syncthreads();
        ssd_gates4(F, j, t0, g, DT, ACS);
        for (int i = F.tid; i < 1024; i += 512) { const int l = i >> 3, ch = i & 7; const bf16* src = XBC + (size_t)(t0 + l) * 1536 + 1024 + g * 64 + 8 * ch;
            *(LAS v4u*)(BR + l * 72 + 8 * ch) = *(const v4u*)src; *(LAS v4u*)(CR + l * 72 + 8 * ch) = *(const v4u*)(src + 256); }
        __syncthreads();
        ssd_stage_xt(F, XBC, t0, g, XT, DT);
        __syncthreads();
        const int hl = F.wave >> 1, half = F.wave & 1, li = F.lane & 31, hh = F.lane >> 5, habs = 4 * g + hl;
        const LAS float* acs = ACS + hl * 128; const LAS float* dtl = DT + hl * 128;
        bf16x8 hp[2][4];
        { const float* hsrc = ST + (size_t)((b * 16 + c) * 16 + habs) * 4096;
#pragma unroll
            for (int pt = 0; pt < 2; ++pt)
#pragma unroll
                for (int ks = 0; ks < 4; ++ks) hp[pt][ks] = ldg8_f32(hsrc + (32 * pt + li) * 64 + 16 * ks + 8 * hh); }
        const float dsk = KIN(I_DSKIP)[j * 16 + habs];
#pragma unroll
        for (int q = 0; q < 2; ++q) { const int lt = half ? 1 + q : 3 * q;
            f32x16 acc[2]; acc[0] = zero16(); acc[1] = zero16();
            const LAS bf16* crl = CR + (32 * lt + li) * 72;
#pragma unroll
            for (int ks = 0; ks < 4; ++ks) { const bf16x8 cf = lds_nat(crl, ks, hh); acc[0] = MFMA32(cf, hp[0][ks], acc[0]); acc[1] = MFMA32(cf, hp[1][ks], acc[1]); }
#pragma unroll
            for (int a4 = 0; a4 < 4; ++a4) { const f32x4 av = *(const LAS f32x4*)(acs + 32 * lt + 8 * a4 + 4 * hh);
#pragma unroll
                for (int i = 0; i < 4; ++i) { const float e = expf(av[i]); acc[0][4 * a4 + i] *= e; acc[1][4 * a4 + i] *= e; } }
            const float acl = acs[32 * lt + li];
            for (int st = 0; st <= lt; ++st) {
                f32x16 gt = zero16(); const LAS bf16* brs = BR + (32 * st + li) * 72;
#pragma unroll
                for (int ks = 0; ks < 4; ++ks) gt = MFMA32(lds_nat(brs, ks, hh), lds_nat(crl, ks, hh), gt);
#pragma unroll
                for (int a4 = 0; a4 < 4; ++a4) { const f32x4 av = *(const LAS f32x4*)(acs + 32 * st + 8 * a4 + 4 * hh);
#pragma unroll
                    for (int i = 0; i < 4; ++i) { const int r = 4 * a4 + i; const float e = expf(acl - av[i]); gt[r] = (st < lt || crow(r, hh) <= li) ? gt[r] * e : 0.f; } }
                const bf16x8 g0 = pack_step(gt, 0), g1 = pack_step(gt, 1);
#pragma unroll
                for (int pt = 0; pt < 2; ++pt) { const LAS bf16* xr = XT + (hl * 64 + 32 * pt + li) * 136 + 32 * st;
                    acc[pt] = MFMA32(g0, lds_krow(xr, 0, hh), acc[pt]); acc[pt] = MFMA32(g1, lds_krow(xr, 16, hh), acc[pt]); } }
#pragma unroll
            for (int pt = 0; pt < 2; ++pt) { const LAS bf16* xr = XT + (hl * 64 + 32 * pt + li) * 136 + 32 * lt; float* yp = Y + (size_t)(t0 + 32 * lt) * D + habs * 64 + 32 * pt + li;
#pragma unroll
                for (int r = 0; r < 16; ++r) { const int l = crow(r, hh); yp[(size_t)l * D] = acc[pt][r] + dsk * bf2f(xr[l]) / dtl[32 * lt + l]; } }
        }
    }
}
__device__ __forceinline__ void mlstm_stage_t(Frame& F, const bf16* P, int t0, int col0, LAS bf16* DST, const LAS float* wk) {
    const int vp = F.tid & 63, s0 = 8 * (F.tid >> 6); float a[8], bq[8];
#pragma unroll
    for (int k = 0; k < 8; ++k) { const unsigned w = *(const unsigned*)(P + (size_t)(t0 + s0 + k) * NPO + col0 + 2 * vp); const float wg = wk ? wk[s0 + k] : 1.f; a[k] = bflo(w) * wg; bq[k] = bfhi(w) * wg; }
    *(LAS bf16x8*)(DST + (2 * vp) * 72 + s0) = pack8(a[0], a[1], a[2], a[3], a[4], a[5], a[6], a[7]);
    *(LAS bf16x8*)(DST + (2 * vp + 1) * 72 + s0) = pack8(bq[0], bq[1], bq[2], bq[3], bq[4], bq[5], bq[6], bq[7]);
}
__device__ __forceinline__ void o1_local_mfma(Frame& F0, int j) {   Frame F = F0; { int t_ = threadIdx.x; asm volatile("" : "+v"(t_)); F.tid = t_; F.lane = t_ & 63; }
    const bf16* P = (const bf16*)(kws() + WS_R1); float* KLOC = (float*)(kws() + WS_R2); float* NLOC = (float*)(kws() + WS_NLOC); float* MLOC = (float*)(kws() + WS_MLOC); float* BLAST = (float*)(kws() + WS_BLAST);
    LAS bf16* VT = (LAS bf16*)F.lds; LAS bf16* KWT = (LAS bf16*)(F.lds + 18432); LAS float* wk = (LAS float*)(F.lds + SMALL_OFF);
    for (int u = F.vcu; u < 1024; u += F.G) {
        const int b = u >> 7, h = (u >> 5) & 3, c = u & 31, t0 = b * SEQ + c * 64;
        __syncthreads();
        if (F.wave == 0) { float bcum, ib; mlstm_gates(F, j, t0, h, bcum, ib); const float blast = __shfl(bcum, 63); const float gl = blast - bcum + ib; const float ml = wave_max(gl);
            wk[F.lane] = expf(gl - ml); if (F.lane == 0) { MLOC[u] = ml; BLAST[u] = blast; } }
        mlstm_stage_t(F, P, t0, 1024 + h * 128, VT, nullptr);
        __syncthreads();
        mlstm_stage_t(F, P, t0, 512 + h * 128, KWT, wk);
        __syncthreads();
        const int vt = F.wave >> 1, dh = F.wave & 1, li = F.lane & 31, hh = F.lane >> 5;
        f32x16 acc0 = zero16(), acc1 = zero16();
        const LAS bf16* ar = VT + (32 * vt + li) * 72; const LAS bf16* b0 = KWT + (64 * dh + li) * 72; const LAS bf16* b1 = b0 + 32 * 72;
#pragma unroll
        for (int ks = 0; ks < 4; ++ks) { const bf16x8 af = lds_nat(ar, ks, hh); acc0 = MFMA32(af, lds_nat(b0, ks, hh), acc0); acc1 = MFMA32(af, lds_nat(b1, ks, hh), acc1); }
        float* dst = KLOC + (size_t)u * 16384 + (size_t)(32 * vt) * 128 + 64 * dh + li;
#pragma unroll
        for (int r = 0; r < 16; ++r) { dst[crow(r, hh) * 128] = acc0[r]; dst[crow(r, hh) * 128 + 32] = acc1[r]; }
        if (F.tid < 128) { float a = 0.f; const LAS bf16* kr = KWT + F.tid * 72;
#pragma unroll
            for (int s8 = 0; s8 < 8; ++s8) { const v4u w = *(const LAS v4u*)(kr + 8 * s8); a += (bflo(w.x) + bfhi(w.x)) + (bflo(w.y) + bfhi(w.y)) + (bflo(w.z) + bfhi(w.z)) + (bflo(w.w) + bfhi(w.w)); }
            NLOC[(size_t)u * 128 + F.tid] = a; }
    }
}
__device__ __forceinline__ void o3_output_mfma(Frame& F0, int j) {
    Frame F = F0; { int t_ = threadIdx.x; asm volatile("" : "+v"(t_)); F.tid = t_; F.lane = t_ & 63; }
    const bf16* P = (const bf16*)(kws() + WS_R1); const float* CPREV = (const float*)(kws() + WS_R2); const float* NPREV = (const float*)(kws() + WS_NLOC); const float* MPREV = (const float*)(kws() + WS_MPREV); bf16* MIX = (bf16*)(kws() + WS_MIX);
    LAS bf16* QR = (LAS bf16*)F.lds;
    LAS bf16* KR = (LAS bf16*)(F.lds + 17408);
    LAS bf16* VT = (LAS bf16*)(F.lds + 34816);
    LAS float* OST = (LAS float*)(F.lds + 53248);
    LAS float* sm = (LAS float*)(F.lds + 98304);
    for (int u = F.vcu; u < 1024; u += F.G) {
        const int b = u >> 7, h = (u >> 5) & 3, c = u & 31, t0 = b * SEQ + c * 64;
        __syncthreads();
        if (F.wave == 0) { float bcum, ib; mlstm_gates(F, j, t0, h, bcum, ib); const float mprev = MPREV[u];
            const float pm = wave_scan_max(ib - bcum, F.lane); const float inter = bcum + mprev; const float mt = fmaxf(bcum + pm, inter);
            sm[F.lane] = bcum; sm[64 + F.lane] = ib; sm[128 + F.lane] = mt; sm[192 + F.lane] = expf(inter - mt); }
        for (int i = F.tid; i < 1024; i += 512) { const int l = i >> 4, ch = i & 15; const bf16* src = P + (size_t)(t0 + l) * NPO + h * 128 + 8 * ch;
            *(LAS v4u*)(QR + l * 136 + 8 * ch) = *(const v4u*)src; *(LAS v4u*)(KR + l * 136 + 8 * ch) = *(const v4u*)(src + 512); }
        mlstm_stage_t(F, P, t0, 1024 + h * 128, VT, nullptr);
        __syncthreads();
        if (F.wave == 1) { const int l = F.lane; const float* np = NPREV + (size_t)u * 128; float qn = 0.f;
#pragma unroll 4
            for (int d8 = 0; d8 < 16; ++d8) { const v4u w = *(const LAS v4u*)(QR + l * 136 + 8 * d8); const f32x4 n0 = *(const f32x4*)(np + 8 * d8), n1 = *(const f32x4*)(np + 8 * d8 + 4);
                qn += (bflo(w.x) * n0[0] + bfhi(w.x) * n0[1]) + (bflo(w.y) * n0[2] + bfhi(w.y) * n0[3]) + (bflo(w.z) * n1[0] + bfhi(w.z) * n1[1]) + (bflo(w.w) * n1[2] + bfhi(w.w) * n1[3]); }
            sm[256 + l] = qn; }
        const int lt = F.wave >> 2, vt = F.wave & 3, li = F.lane & 31, hh = F.lane >> 5, l = 32 * lt + li;
        const float bcl = sm[l], mtl = sm[128 + l], sil = sm[192 + l];
        f32x16 acc = zero16();
        const LAS bf16* qrl = QR + l * 136;
        { const float* cp = CPREV + (size_t)u * 16384 + (size_t)(32 * vt + li) * 128;
#pragma unroll
            for (int ks = 0; ks < 8; ++ks) acc = MFMA32(ldg8_f32(cp + 16 * ks + 8 * hh), lds_nat(qrl, ks, hh), acc); }
#pragma unroll
        for (int r = 0; r < 16; ++r) acc[r] *= sil;
        float dsum = 0.f;
        for (int st = 0; st <= lt; ++st) {
            f32x16 wt = zero16(); const LAS bf16* krs = KR + (32 * st + li) * 136;
#pragma unroll
            for (int ks = 0; ks < 8; ++ks) wt = MFMA32(lds_nat(krs, ks, hh), lds_nat(qrl, ks, hh), wt);
#pragma unroll
            for (int a4 = 0; a4 < 4; ++a4) { const f32x4 bs = *(const LAS f32x4*)(sm + 32 * st + 8 * a4 + 4 * hh), is = *(const LAS f32x4*)(sm + 64 + 32 * st + 8 * a4 + 4 * hh);
#pragma unroll
                for (int i = 0; i < 4; ++i) { const int r = 4 * a4 + i; const float e = expf(bcl - bs[i] + is[i] - mtl); const float w = (st < lt || crow(r, hh) <= li) ? wt[r] * e : 0.f; wt[r] = w; dsum += w; } }
            const bf16x8 w0 = pack_step(wt, 0), w1 = pack_step(wt, 1); const LAS bf16* vr = VT + (32 * vt + li) * 72 + 32 * st;
            acc = MFMA32(lds_krow(vr, 0, hh), w0, acc); acc = MFMA32(lds_krow(vr, 16, hh), w1, acc); }
        __syncthreads();
        dsum += __shfl_xor(dsum, 32);
        const float den = dsum + sil * sm[256 + l]; const float rinv = 1.0f / fmaxf(fabsf(den), expf(-mtl));
        float s1 = 0.f, s2 = 0.f;
#pragma unroll
        for (int r = 0; r < 16; ++r) { acc[r] *= rinv; s1 += acc[r]; s2 += acc[r] * acc[r]; }
        s1 += __shfl_xor(s1, 32); s2 += __shfl_xor(s2, 32);
        if (hh == 0) { sm[320 + (vt * 64 + l) * 2] = s1; sm[320 + (vt * 64 + l) * 2 + 1] = s2; }
        __syncthreads();
        { float t1 = 0.f, t2 = 0.f;
#pragma unroll
            for (int q = 0; q < 4; ++q) { t1 += sm[320 + (q * 64 + l) * 2]; t2 += sm[320 + (q * 64 + l) * 2 + 1]; }
            const float mu = t1 * (1.f / 128.f), var = fmaxf(t2 * (1.f / 128.f) - mu * mu, 0.f), rstd = 1.0f / sqrtf(var + LN_EPS);
#pragma unroll
            for (int r = 0; r < 16; ++r) OST[l * 132 + 32 * vt + crow(r, hh)] = (acc[r] - mu) * rstd; }
        __syncthreads();
        for (int i = F.tid; i < 1024; i += 512) { const int ll = i >> 4, ch = i & 15; const LAS float* os = OST + ll * 132 + 8 * ch; const f32x4 o0 = *(const LAS f32x4*)os, o1 = *(const LAS f32x4*)(os + 4);
            const v4u ow = *(const v4u*)(P + (size_t)(t0 + ll) * NPO + 1536 + h * 128 + 8 * ch); const float* hw = KIN(I_HNW) + j * 512 + h * 128 + 8 * ch; const f32x4 h0 = *(const f32x4*)hw, h1 = *(const f32x4*)(hw + 4);
            v4u res; res.x = pk2(o0[0] * h0[0] * sigmoid_f(bflo(ow.x)), o0[1] * h0[1] * sigmoid_f(bfhi(ow.x))); res.y = pk2(o0[2] * h0[2] * sigmoid_f(bflo(ow.y)), o0[3] * h0[3] * sigmoid_f(bfhi(ow.y)));
            res.z = pk2(o1[0] * h1[0] * sigmoid_f(bflo(ow.z)), o1[1] * h1[1] * sigmoid_f(bfhi(ow.z))); res.w = pk2(o1[2] * h1[2] * sigmoid_f(bflo(ow.w)), o1[3] * h1[3] * sigmoid_f(bfhi(ow.w)));
            *(v4u*)(MIX + (size_t)(t0 + ll) * D + h * 128 + 8 * ch) = res; }
    }
}
template <bool XIN> __device__ __forceinline__ void p_ln1_route(Frame& F0, int layer) {   Frame F = F0; { int t_ = threadIdx.x; asm volatile("" : "+v"(t_)); F.tid = t_; F.lane = t_ & 63; }
    const bf16* OUTP = (const bf16*)(kws() + WS_R1); const bf16* HB = (const bf16*)(kws() + WS_HB); bf16* H1B = (bf16*)(kws() + WS_H1B);
    i32x4* ROUTE = (i32x4*)(kws() + WS_ROUTE); f32x2* GATE = (f32x2*)(kws() + WS_GATE); int* BCNT = (int*)(kws() + WS_BCNT);
    LAS int* cnt = (LAS int*)(F.lds + SMALL_OFF);
    const float* g1 = KIN(I_LN1G) + (size_t)layer * D; const float* b1 = KIN(I_LN1B) + (size_t)layer * D;
    const f32x4* rgw = (const f32x4*)(kws() + WS_TAB + (size_t)layer * TAB_LAYER + TAB_RGW); const float* rgb = KIN(I_RGB) + layer * 4; const f32x4* rew = (const f32x4*)(kws() + WS_TAB + (size_t)layer * TAB_LAYER + TAB_REW); const float* reb = KIN(I_REB) + layer * 32;
    __syncthreads();
    if (F.tid < 32) cnt[F.tid] = 0;
    __syncthreads();
    const LAS f32x4* rewl = (const LAS f32x4*)F.lds;
    for (int r = F.tid; r < 8192; r += 512) ((LAS f32x4*)F.lds)[r] = rew[r];
    __syncthreads();
#pragma unroll 1
    for (int m0 = F.gw; m0 < T; m0 += 2 * F.NGW) {
        const int m1 = m0 + F.NGW < T ? m0 + F.NGW : -1; const int mm[2] = {m0, m1 >= 0 ? m1 : m0};
        f32x4 v[2][4], a[2][4];
#pragma unroll
        for (int rr = 0; rr < 2; ++rr) { if constexpr (XIN) row_load(KIN(I_X) + (size_t)mm[rr] * D, F.lane, v[rr]); else row_load_bf16(HB + (size_t)mm[rr] * D, F.lane, v[rr]); row_load_bf16(OUTP + (size_t)mm[rr] * D, F.lane, a[rr]); }
#pragma unroll
        for (int rr = 0; rr < 2; ++rr) {
#pragma unroll
            for (int jj = 0; jj < 4; ++jj) v[rr][jj] = v[rr][jj] * ALPHA + a[rr][jj];
            row_layernorm(v[rr], g1, b1, F.lane); }
        row_store_bf16(H1B + (size_t)m0 * D, F.lane, v[0]); if (m1 >= 0) row_store_bf16(H1B + (size_t)m1 * D, F.lane, v[1]);
        float gl[2][4];
#pragma unroll
        for (int c = 0; c < 4; ++c) { gl[0][c] = 0.f; gl[1][c] = 0.f; }
#pragma unroll
        for (int jj = 0; jj < 4; ++jj)
#pragma unroll
            for (int i = 0; i < 4; ++i) { const f32x4 w = rgw[(jj * 4 + i) * 64 + F.lane];
#pragma unroll
                for (int c = 0; c < 4; ++c) { gl[0][c] += v[0][jj][i] * w[c]; gl[1][c] += v[1][jj][i] * w[c]; } }
        int gi[2]; float pg[2];
#pragma unroll
        for (int rr = 0; rr < 2; ++rr) { const float red = wave_reduce_multi<4>(gl[rr], F.lane); float l4[4];
#pragma unroll
            for (int c = 0; c < 4; ++c) l4[c] = __shfl(red, 16 * c) + rgb[c];
            int g = 0; float gm = l4[0];
#pragma unroll
            for (int c = 1; c < 4; ++c) if (l4[c] > gm) { gm = l4[c]; g = c; }
            float se = 0.f;
#pragma unroll
            for (int c = 0; c < 4; ++c) se += expf(l4[c] - gm);
            gi[rr] = g; pg[rr] = 1.0f / se; }
        float el[2][8];
#pragma unroll
        for (int rr = 0; rr < 2; ++rr) { const LAS f32x4* rw = rewl + gi[rr] * 2048 + F.lane;
#pragma unroll
            for (int c = 0; c < 8; ++c) el[rr][c] = 0.f;
#pragma unroll
            for (int jj = 0; jj < 4; ++jj)
#pragma unroll
                for (int i = 0; i < 4; ++i) { const f32x4 w0 = rw[(jj * 4 + i) * 128], w1 = rw[(jj * 4 + i) * 128 + 64];
#pragma unroll
                    for (int c = 0; c < 4; ++c) { el[rr][c] += v[rr][jj][i] * w0[c]; el[rr][4 + c] += v[rr][jj][i] * w1[c]; } } }
#pragma unroll
        for (int rr = 0; rr < 2; ++rr) { const float red = wave_reduce_multi<8>(el[rr], F.lane); float e8[8];
#pragma unroll
            for (int c = 0; c < 8; ++c) e8[c] = __shfl(red, 8 * c) + reb[gi[rr] * 8 + c];
            int i0 = 0; float v0 = e8[0];
#pragma unroll
            for (int c = 1; c < 8; ++c) if (e8[c] > v0) { v0 = e8[c]; i0 = c; }
            int i1 = -1; float v1 = -INFINITY;
#pragma unroll
            for (int c = 0; c < 8; ++c) if (c != i0 && e8[c] > v1) { v1 = e8[c]; i1 = c; }
            if (i1 < 0) i1 = (i0 + 1) & 7;
            const float ee = expf(v1 - v0), g0 = pg[rr] / (1.0f + ee), g1v = pg[rr] * ee / (1.0f + ee);
            if (F.lane == 0 && (rr == 0 || m1 >= 0)) { const int e0 = gi[rr] * 8 + i0, e1 = gi[rr] * 8 + i1;
                const int r0 = __hip_atomic_fetch_add(cnt + e0, 1, __ATOMIC_RELAXED, __HIP_MEMORY_SCOPE_WORKGROUP), r1 = __hip_atomic_fetch_add(cnt + e1, 1, __ATOMIC_RELAXED, __HIP_MEMORY_SCOPE_WORKGROUP);
                ROUTE[mm[rr]] = (i32x4){e0, r0, e1, r1}; GATE[mm[rr]] = (f32x2){g0, g1v}; } }
    }
    __syncthreads();
    if (F.tid < 32) BCNT[F.vcu * 32 + F.tid] = cnt[F.tid];
}
__device__ __forceinline__ void p_scatter(Frame& F0) {   Frame F = F0; { int t_ = threadIdx.x; asm volatile("" : "+v"(t_)); F.tid = t_; F.lane = t_ & 63; }
    const int* BCNT = (const int*)(kws() + WS_BCNT); int* PANEL = (int*)(kws() + WS_PANEL); const i32x4* ROUTE = (const i32x4*)(kws() + WS_ROUTE); i32x2* POS = (i32x2*)(kws() + WS_POS);
    const bf16* H1B = (const bf16*)(kws() + WS_H1B); bf16* XS = (bf16*)(kws() + WS_R1);
    LAS int* pa = (LAS int*)(F.lds + SMALL_OFF); LAS int* pb = pa + 512; LAS int* tot = pa + 1024; LAS int* bef = pa + 1056; LAS int* base = pa + 1088;
    __syncthreads();
    { const int e = F.tid & 31, part = F.tid >> 5; int sa = 0, sb = 0;
        for (int b = part; b < F.G; b += 16) { const int c = BCNT[b * 32 + e]; sa += c; if (b < F.vcu) sb += c; }
        pa[part * 32 + e] = sa; pb[part * 32 + e] = sb; }
    __syncthreads();
    if (F.tid < 32) { int sa = 0, sb = 0; for (int p = 0; p < 16; ++p) { sa += pa[p * 32 + F.tid]; sb += pb[p * 32 + F.tid]; } tot[F.tid] = sa; bef[F.tid] = sb; }
    __syncthreads();
    if (F.tid == 0) { int off = 0, np = 0;
        for (int e = 0; e < 32; ++e) { const int npan = (tot[e] + 255) >> 8; base[e] = off + bef[e];
            if (F.vcu == 0) for (int p = 0; p < npan; ++p) PANEL[1 + np + p] = e;
            np += npan; off += npan * 256; }
        if (F.vcu == 0) PANEL[0] = np; }
    __syncthreads();
#pragma unroll 1
    for (int m0 = F.gw; m0 < T; m0 += 4 * F.NGW) {
        i32x4 r[4]; v4u w[4][2];
#pragma unroll
        for (int rr = 0; rr < 4; ++rr) { const int m = m0 + rr * F.NGW < T ? m0 + rr * F.NGW : m0; r[rr] = ROUTE[m]; const v4u* src = (const v4u*)(H1B + (size_t)m * D); w[rr][0] = src[F.lane]; w[rr][1] = src[F.lane + 64]; }
#pragma unroll
        for (int rr = 0; rr < 4; ++rr) { const int m = m0 + rr * F.NGW; if (m < T) { const int p0 = base[r[rr].x] + r[rr].y, p1 = base[r[rr].z] + r[rr].w;
            if (F.lane == 0) POS[m] = (i32x2){p0, p1};
            v4u* d0 = (v4u*)(XS + (size_t)p0 * D); v4u* d1 = (v4u*)(XS + (size_t)p1 * D);
            d0[F.lane] = w[rr][0]; d0[F.lane + 64] = w[rr][1]; d1[F.lane] = w[rr][0]; d1[F.lane + 64] = w[rr][1]; } } }
}
__device__ __forceinline__ void p_combine(Frame& F0, int layer) {   Frame F = F0; { int t_ = threadIdx.x; asm volatile("" : "+v"(t_)); F.tid = t_; F.lane = t_ & 63; }
    const bf16* H1B = (const bf16*)(kws() + WS_H1B); const bf16* EOUT = (const bf16*)(kws() + WS_R1); const i32x2* POS = (const i32x2*)(kws() + WS_POS); const f32x2* GATE = (const f32x2*)(kws() + WS_GATE);
    bf16* HB = (bf16*)(kws() + WS_HB);
    const float* g2 = KIN(I_LN2G) + (size_t)layer * D; const float* b2 = KIN(I_LN2B) + (size_t)layer * D;
    const LAS f32x4* gpl = (const LAS f32x4*)F.lds;
    if (layer != DEPTH - 1) { const f32x4* src = (const f32x4*)(kws() + WS_TAB + (size_t)(layer + 1) * TAB_LAYER + TAB_GPW); for (int r = F.tid; r < 4096; r += 512) ((LAS f32x4*)F.lds)[r] = src[r]; }
    __syncthreads();
#pragma unroll 1
    for (int m0 = F.gw; m0 < T; m0 += 2 * F.NGW) {
        const int m1 = m0 + F.NGW < T ? m0 + F.NGW : -1; const int mm[2] = {m0, m1 >= 0 ? m1 : m0};
        f32x4 v[2][4], ea[2][4], eb[2][4]; i32x2 ps[2]; f32x2 gt[2];
#pragma unroll
        for (int rr = 0; rr < 2; ++rr) { ps[rr] = POS[mm[rr]]; gt[rr] = GATE[mm[rr]]; row_load_bf16(H1B + (size_t)mm[rr] * D, F.lane, v[rr]); }
#pragma unroll
        for (int rr = 0; rr < 2; ++rr) { row_load_bf16(EOUT + (size_t)ps[rr].x * D, F.lane, ea[rr]); row_load_bf16(EOUT + (size_t)ps[rr].y * D, F.lane, eb[rr]); }
#pragma unroll
        for (int rr = 0; rr < 2; ++rr) {
#pragma unroll
            for (int jj = 0; jj < 4; ++jj) v[rr][jj] = v[rr][jj] * ALPHA + (ea[rr][jj] * gt[rr].x + eb[rr][jj] * gt[rr].y);
            row_layernorm(v[rr], g2, b2, F.lane); }
        if (layer == DEPTH - 1) { row_store_f32(kout() + (size_t)m0 * D, F.lane, v[0]); if (m1 >= 0) row_store_f32(kout() + (size_t)m1 * D, F.lane, v[1]); }
        else { row_store_bf16(HB + (size_t)m0 * D, F.lane, v[0]); if (m1 >= 0) row_store_bf16(HB + (size_t)m1 * D, F.lane, v[1]); row_gate_proj2_lds(F, v[0], v[1], gpl, m0, m1); } }
}
#ifndef PHASE_MASK
#define PHASE_MASK 0x1fff
#endif
#define PH_EN(k) (((PHASE_MASK) >> (k)) & 1)
#ifndef PROBE_DUP
#define PROBE_DUP 0
#endif
#define TPROBE(k) ((((PROBE_DUP) >> (k)) & 1) != 0)
#define TWAIT(k) do { if constexpr (TPROBE(k)) { const unsigned long long t1_ = __builtin_amdgcn_s_memrealtime(); while (__builtin_amdgcn_s_memrealtime() - t1_ < (t1_ - tp0_)) __builtin_amdgcn_s_sleep(8); } } while (0)
#define IN(k) (lo <= (k) && (k) < hi)
#define SEAM(k) do { if ((k) + 1 < hi) xcd_barrier(bar); } while (0)
template <int LAYER> __device__ __forceinline__ void layer_body(Frame& F, const int lo, const int hi, const XcdBarrier& bar) {
        constexpr int layer = LAYER, pb = 1 + LAYER * NPH_LAYER, j = LAYER >> 1; constexpr bool odd = (LAYER & 1) != 0;
        bf16* HB = (bf16*)(kws() + WS_HB); bf16* MIX = (bf16*)(kws() + WS_MIX);
        if constexpr (PH_EN(0)) if (IN(pb + 0)) { const unsigned long long tp0_ = TPROBE(0) ? __builtin_amdgcn_s_memrealtime() : 0ull;
            const int N = odd ? NPO : NPE; const bf16* Bt = odd ? (const bf16*)(kws() + WS_WINO) + (size_t)j * NPO * D : (const bf16*)(kws() + WS_WINE) + (size_t)j * NPE * D;
            pg8::Gemm g{HB, Bt, T, N, D, 0}; pg8::StaticOrder S; S.init(T, N, F.G, (int)blockIdx.x);
            pg8::EpiStoreBf16 E{(bf16*)(kws() + WS_R1), N};
            pg8::gemm_phase<pg8::EpiStoreBf16, pg8::StaticOrder, true, true>(F.lds, g, S, E);
            SEAM(pb + 0); TWAIT(0); }
        if constexpr (!odd) {
            if constexpr (PH_EN(1)) if (IN(pb + 1)) { const unsigned long long tp0_ = TPROBE(1) ? __builtin_amdgcn_s_memrealtime() : 0ull; e0_conv(F, j); SEAM(pb + 1); TWAIT(1); }
            if constexpr (PH_EN(2)) if (IN(pb + 2)) { const unsigned long long tp0_ = TPROBE(2) ? __builtin_amdgcn_s_memrealtime() : 0ull; if constexpr (SSD_NAIVE) e1_states(F, j); else e1_states_mfma(F, j); SEAM(pb + 2); TWAIT(2); }
            if constexpr (PH_EN(3)) if (IN(pb + 3)) { const unsigned long long tp0_ = TPROBE(3) ? __builtin_amdgcn_s_memrealtime() : 0ull; e2_scan(F); SEAM(pb + 3); TWAIT(3); }
            if constexpr (PH_EN(4)) if (IN(pb + 4)) { const unsigned long long tp0_ = TPROBE(4) ? __builtin_amdgcn_s_memrealtime() : 0ull; if constexpr (SSD_NAIVE) e3_output(F, j); else e3_output_mfma(F, j); SEAM(pb + 4); TWAIT(4); }
            if constexpr (PH_EN(5)) if (IN(pb + 5)) { const unsigned long long tp0_ = TPROBE(5) ? __builtin_amdgcn_s_memrealtime() : 0ull; e4_gnorm(F); SEAM(pb + 5); TWAIT(5); }
        } else {
            if constexpr (PH_EN(1)) if (IN(pb + 1)) { const unsigned long long tp0_ = TPROBE(1) ? __builtin_amdgcn_s_memrealtime() : 0ull; o_foxscan(F, j); if constexpr (MLSTM_NAIVE) o1_local(F, j); else o1_local_mfma(F, j); SEAM(pb + 1); TWAIT(1); }
            if constexpr (PH_EN(2)) if (IN(pb + 2)) { const unsigned long long tp0_ = TPROBE(2) ? __builtin_amdgcn_s_memrealtime() : 0ull; o2_scan(F); SEAM(pb + 2); TWAIT(2); }
            if constexpr (PH_EN(3)) if (IN(pb + 3)) { const unsigned long long tp0_ = TPROBE(3) ? __builtin_amdgcn_s_memrealtime() : 0ull;
#if FOX_NAIVE
                o4_fox(F);
#else
                const attn_body::bf16* PR = (const attn_body::bf16*)(kws() + WS_R1);
                const attn_body::AttnTensors AT{PR + 2048, PR + 2560, PR + 3072, (attn_body::bf16*)(kws() + WS_MIX) + 512, (const float*)(kws() + WS_FOXC)};
                const attn_body::StaticOrder S((int)F.G, F.vcu);
                attn_body::attn_phase<attn_body::StaticOrder>((char*)F.lds, AT, S);
#endif
                __syncthreads();
                if constexpr (MLSTM_NAIVE) o3_output(F, j); else o3_output_mfma(F, j); SEAM(pb + 3); TWAIT(3); }
        }
        if constexpr (PH_EN(6)) if (IN(pb + 6)) { const unsigned long long tp0_ = TPROBE(6) ? __builtin_amdgcn_s_memrealtime() : 0ull;
            const int K = odd ? D : 1536; const bf16* Bt = odd ? (const bf16*)(kws() + WS_WOUTO) + (size_t)j * D * D : (const bf16*)(kws() + WS_WOUTE) + (size_t)j * D * 1536;
            pg8::Gemm g{MIX, Bt, T, D, K, 0}; pg8::StaticOrder S; S.init(T, D, F.G, (int)blockIdx.x);
            pg8::EpiStoreBf16 E{(bf16*)(kws() + WS_R1), D};
            pg8::gemm_phase<pg8::EpiStoreBf16, pg8::StaticOrder, false, true>(F.lds, g, S, E);
            SEAM(pb + 6); TWAIT(6); }
        if constexpr (PH_EN(7)) if (IN(pb + 7)) { const unsigned long long tp0_ = TPROBE(7) ? __builtin_amdgcn_s_memrealtime() : 0ull; p_ln1_route<LAYER == 0>(F, layer); SEAM(pb + 7); TWAIT(7); }
        if constexpr (PH_EN(8)) if (IN(pb + 8)) { const unsigned long long tp0_ = TPROBE(8) ? __builtin_amdgcn_s_memrealtime() : 0ull; p_scatter(F); SEAM(pb + 8); TWAIT(8); }
        if constexpr (PH_EN(9)) if (IN(pb + 9)) { const unsigned long long tp0_ = TPROBE(9) ? __builtin_amdgcn_s_memrealtime() : 0ull;
            pg8::Gemm g{(const bf16*)(kws() + WS_R1), (const bf16*)(kws() + WS_WGU) + (size_t)layer * 32 * D * D, RPAD, D, D, (size_t)D * D * 2};
            pg8::MoeOrder S; S.initm((const int*)(kws() + WS_PANEL), 4, F.G, (int)blockIdx.x);
            pg8::EpiSwiglu E{(bf16*)(kws() + WS_R3), 512};
            pg8::gemm_phase<pg8::EpiSwiglu, pg8::MoeOrder, true, true>(F.lds, g, S, E);
            SEAM(pb + 9); TWAIT(9); }
        if constexpr (PH_EN(10)) if (IN(pb + 10)) { const unsigned long long tp0_ = TPROBE(10) ? __builtin_amdgcn_s_memrealtime() : 0ull;
            pg8::Gemm g{(const bf16*)(kws() + WS_R3), (const bf16*)(kws() + WS_WD) + (size_t)layer * 32 * D * 512, RPAD, D, 512, (size_t)D * 512 * 2};
            pg8::MoeOrder S; S.initm((const int*)(kws() + WS_PANEL), 4, F.G, (int)blockIdx.x);
            pg8::EpiStoreBf16 E{(bf16*)(kws() + WS_R1), D};
            pg8::gemm_phase<pg8::EpiStoreBf16, pg8::MoeOrder, true, true>(F.lds, g, S, E);
            SEAM(pb + 10); TWAIT(10); }
        if constexpr (PH_EN(11)) if (IN(pb + 11)) { const unsigned long long tp0_ = TPROBE(11) ? __builtin_amdgcn_s_memrealtime() : 0ull; p_combine(F, layer); SEAM(pb + 11); TWAIT(11); }
}
struct Args { const float* in[27]; float* out; unsigned char* ws; int ph_lo, ph_hi; };
__global__ void __launch_bounds__(NWAVES * 64, 2) fwd_kernel(Args args) {
    extern __shared__ __attribute__((aligned(16))) unsigned char lds[];
    Frame F;
    F.lds = (LAS unsigned char*)lds;
    F.MISC = (volatile LAS unsigned*)(F.lds + MISC_OFF);
    F.tid = threadIdx.x; F.lane = F.tid & 63; F.wave = __builtin_amdgcn_readfirstlane(F.tid >> 6);
    F.G = gridDim.x; { const int bx = blockIdx.x; F.vcu = (F.G % 8 == 0) ? (bx % 8) * (F.G / 8) + bx / 8 : bx; }
    F.gw = F.vcu * NWAVES + F.wave; F.NGW = F.G * NWAVES;
    F.ctl = (unsigned*)(args.ws + WS_CTL);
    const int lo = args.ph_lo, hi = args.ph_hi;
    for (int u = F.tid; u < (LDS_BYTES - MISC_OFF) / 4; u += NWAVES * 64) ((LAS unsigned*)(F.lds + MISC_OFF))[u] = 0u;
    __syncthreads();
    XcdBarrier bar; bar.bar = F.ctl + CW_BAR; bar.x = 0; bar.st = nullptr;
    if (hi - lo > 1) bar = xcd_barrier_post(F.ctl + CW_BAR, F.MISC + 8);
    if constexpr (PH_EN(12)) if (IN(0)) { const unsigned long long tp0_ = TPROBE(12) ? __builtin_amdgcn_s_memrealtime() : 0ull; p_prologue(F); SEAM(0); TWAIT(12); }
    layer_body<0>(F, lo, hi, bar); layer_body<1>(F, lo, hi, bar); layer_body<2>(F, lo, hi, bar); layer_body<3>(F, lo, hi, bar);
#undef IN
#undef SEAM
}

extern "C" void kernel_launch(void* const* d_in, const int* in_sizes, int n_in, void* d_out, int out_size, void* d_ws, size_t ws_size, hipStream_t stream) {
    static int grid = 0;
    if (grid == 0) {
        if (n_in != 27 || in_sizes[0] != T * D || out_size != T * D || ws_size < WS_END) { fprintf(stderr, "kernel_launch: unexpected shapes (n_in %d, in0 %d, out %d, ws %zu); nothing launched\n", n_in, n_in > 0 ? in_sizes[0] : -1, out_size, ws_size); grid = -1; return; }
        int dev = 0, cus = 0, per_cu = 0;
        if (hipGetDevice(&dev) != hipSuccess || hipDeviceGetAttribute(&cus, hipDeviceAttributeMultiprocessorCount, dev) != hipSuccess) { grid = -1; return; }
        if (hipFuncSetAttribute((const void*)fwd_kernel, hipFuncAttributeMaxDynamicSharedMemorySize, LDS_BYTES) != hipSuccess) { fprintf(stderr, "kernel_launch: hipFuncSetAttribute failed\n"); grid = -1; return; }
        if (hipOccupancyMaxActiveBlocksPerMultiprocessor(&per_cu, (const void*)fwd_kernel, NWAVES * 64, LDS_BYTES) != hipSuccess || per_cu < 1) fprintf(stderr, "kernel_launch: note: occupancy query reports %d workgroups per CU\n", per_cu);
        (void)hipGetLastError();
        grid = cus;
    }
    if (grid < 0) return;
    if (hipMemsetAsync((char*)d_ws + WS_CTL, 0, CTL_ZERO_BYTES, stream) != hipSuccess) return;
    Args a{};
    for (int i = 0; i < 27; ++i) a.in[i] = (const float*)d_in[i];
    a.out = (float*)d_out; a.ws = (unsigned char*)d_ws;
#if MK_ONE_LAUNCH
    a.ph_lo = 0; a.ph_hi = NPHASES;
    hipLaunchKernelGGL(fwd_kernel, dim3(grid), dim3(NWAVES * 64), LDS_BYTES, stream, a);
#else
    for (int ph = 0; ph < NPHASES; ++ph) {
        if (ph > 0 && (((ph - 1) / NPH_LAYER) & 1) && ((ph - 1) % NPH_LAYER) == 5) continue;
        a.ph_lo = ph; a.ph_hi = ph + 1;
        hipLaunchKernelGGL(fwd_kernel, dim3(grid), dim3(NWAVES * 64), LDS_BYTES, stream, a);
    }
#endif
}
```

```cpp
#include <hip/hip_runtime.h>
#include <cstdio>
#include <cstdint>
__device__ __forceinline__ float silu_f(float x) { return x / (1.0f + __expf(-x)); }
namespace pg8 {
#define PG8_LAS __attribute__((address_space(3)))
typedef unsigned short bf16_t;
typedef short bf16x8 __attribute__((ext_vector_type(8)));
typedef float f32x4 __attribute__((ext_vector_type(4)));
typedef unsigned u32x4 __attribute__((ext_vector_type(4)));
constexpr int BM = 256, BK = 64, HALF = 128, HTB = HALF * BK * 2  , STAGE_BYTES = 8 * HTB, NXCD = 8, WGM = 8;

__host__ __device__ __forceinline__ int lds_byte(int r, int c) { const int st = (r >> 4) * 2 + (c >> 5), rr = r & 15, cc = c & 31, ob = rr * 64 + cc * 2; return st * 1024 + (ob ^ (((ob >> 9) & 1) << 5)); }
__host__ __device__ __forceinline__ void stage_rc(int b, int& R, int& C) { const int st = b / 1024, sb = b % 1024, swz = sb ^ (((sb >> 9) & 1) << 5); R = (st >> 1) * 16 + swz / 64; C = (st & 1) * 32 + (swz % 64) / 2; }
__host__ __device__ __forceinline__ int perm32(int rho) { const int n = rho >> 4, i = rho & 15; return 8 * (i >> 2) + 4 * n + (i & 3); }

struct Unit { int pm, pn, be; };
struct Gemm { const bf16_t* A; const bf16_t* Bt; int M, N, K; size_t bstride; };

struct StaticOrder {
    int nM, nN, nwg, G, c;
    __host__ __device__ void init(int M, int N, int G_, int c_) { nM = M / BM; nN = N / BM; nwg = nM * nN; G = G_; c = c_; }
    __host__ __device__ bool next(int i, Unit& u) const {
        const long L = (long)i * G + c; if (L >= nwg) return false;
        int wgid = (int)L; { const int q = nwg / NXCD, r = nwg % NXCD, xcd = wgid % NXCD, off = wgid / NXCD; wgid = (xcd < r ? xcd * (q + 1) : r * (q + 1) + (xcd - r) * q) + off; }
        const int nig = WGM * nN, gid = wgid / nig, fm = gid * WGM, gsz = (nM - fm) < WGM ? (nM - fm) : WGM;
        u.pm = fm + ((wgid % nig) % gsz); u.pn = (wgid % nig) / gsz; u.be = 0; return true;
    }
    __device__ __forceinline__ void a_ready(const Unit&) const {}
    __device__ __forceinline__ void done(const Unit&) const {}
};

__device__ __forceinline__ unsigned cvt_pk_bf16(float lo, float hi) { unsigned r; asm volatile("v_cvt_pk_bf16_f32 %0, %1, %2" : "=v"(r) : "v"(lo), "v"(hi)); return r; }
struct EpiStoreBf16 {
    static constexpr bool PERM = true, AFTER_DRAIN = false;
    bf16_t* O; int ldc;
    __device__ __forceinline__ void operator()(const f32x4 (&acc)[2][2][4][2], const Unit& u, int wr, int wc, int fr, int fq) const {
        const int row0 = u.pm * BM + wr * 64 + fr, col0 = u.pn * BM + wc * 32 + 8 * fq;
#pragma unroll
        for (int ai = 0; ai < 2; ++ai)
#pragma unroll
            for (int m = 0; m < 4; ++m) { bf16_t* rowp = O + (size_t)(row0 + ai * HALF + m * 16) * ldc + col0;
#pragma unroll
                for (int bj = 0; bj < 2; ++bj) { const f32x4 v0 = acc[ai][bj][m][0], v1 = acc[ai][bj][m][1];
                    u32x4 w; w.x = cvt_pk_bf16(v0[0], v0[1]); w.y = cvt_pk_bf16(v0[2], v0[3]); w.z = cvt_pk_bf16(v1[0], v1[1]); w.w = cvt_pk_bf16(v1[2], v1[3]);
                    *(u32x4*)(rowp + bj * HALF) = w; } }
    }
};
struct EpiStoreF32 {
    static constexpr bool PERM = false, AFTER_DRAIN = false;
    float* C; int ldc;
    __device__ __forceinline__ void operator()(const f32x4 (&acc)[2][2][4][2], const Unit& u, int wr, int wc, int fr, int fq) const {
        const int row0 = u.pm * BM + wr * 64 + fr, col0 = u.pn * BM + wc * 32 + 4 * fq;
#pragma unroll
        for (int ai = 0; ai < 2; ++ai)
#pragma unroll
            for (int m = 0; m < 4; ++m) { float* rowp = C + (size_t)(row0 + ai * HALF + m * 16) * ldc + col0;
#pragma unroll
                for (int bj = 0; bj < 2; ++bj)
#pragma unroll
                    for (int n = 0; n < 2; ++n) *(f32x4*)(rowp + bj * HALF + n * 16) = acc[ai][bj][m][n]; }
    }
};
struct EpiSwiglu {
    static constexpr bool PERM = true, AFTER_DRAIN = false;
    bf16_t* O; int ldc;
    __device__ __forceinline__ void operator()(const f32x4 (&acc)[2][2][4][2], const Unit& u, int wr, int wc, int fr, int fq) const {
        const int row0 = u.pm * BM + wr * 64 + fr, col0 = u.pn * HALF + wc * 32 + 8 * fq;
#pragma unroll
        for (int ai = 0; ai < 2; ++ai)
#pragma unroll
            for (int m = 0; m < 4; ++m) { bf16_t* rowp = O + (size_t)(row0 + ai * HALF + m * 16) * ldc + col0;
                const f32x4 g0 = acc[ai][0][m][0], g1 = acc[ai][0][m][1], u0 = acc[ai][1][m][0], u1 = acc[ai][1][m][1];
                float h[8];
#pragma unroll
                for (int i = 0; i < 4; ++i) { h[i] = silu_f(g0[i]) * u0[i]; h[4 + i] = silu_f(g1[i]) * u1[i]; }
                u32x4 w; w.x = cvt_pk_bf16(h[0], h[1]); w.y = cvt_pk_bf16(h[2], h[3]); w.z = cvt_pk_bf16(h[4], h[5]); w.w = cvt_pk_bf16(h[6], h[7]);
                *(u32x4*)rowp = w; }
    }
};
struct MoeOrder : StaticOrder {
    const int* tab;
    __device__ __forceinline__ void initm(const int* tab_, int nN_, int G_, int c_) { tab = tab_; nM = tab_[0]; nN = nN_; nwg = nM * nN; G = G_; c = c_; }
    __device__ __forceinline__ bool next(int i, Unit& u) const { if (!StaticOrder::next(i, u)) return false; u.be = tab[1 + u.pm]; return true; }
};
template <class Epi, class Sched, bool ALIGN_EPI = false, bool SP2 = false, int RSCALE_T = 0, bool GATHER = false>
__device__ __forceinline__ void gemm_phase(PG8_LAS unsigned char* lds, const Gemm g, const Sched& S, const Epi& E, const float* ssq = nullptr, float ms_inv = 0.f, float ms_eps = 0.f, const int* grow = nullptr) {
    static_assert(!GATHER || SP2, "GATHER is wired into the SP2 loop only");
    const int tid = threadIdx.x, wid = __builtin_amdgcn_readfirstlane(tid >> 6), lane = tid & 63, wr = wid >> 2, wc = wid & 3, fr = lane & 15, fq = lane >> 4;
    const int K = g.K, nt = K / BK;
    unsigned voffA[2], voffB[2];
#pragma unroll
    for (int i = 0; i < 2; ++i) { int R, C; stage_rc(tid * 16 + i * 8192, R, C); const int Rb = Epi::PERM ? ((R & ~31) + perm32(R & 31)) : R;
        voffA[i] = (unsigned)(R * K + C) * 2u; voffB[i] = (unsigned)(Rb * K + C) * 2u; }
    const size_t kstep = (size_t)(BK * 2);
    const size_t hstep = (size_t)HALF * K * 2;
    const size_t tstep = 2 * hstep;
    const unsigned ldsw = (unsigned)wid * 1024u;
    const int aoff = lds_byte(wr * 64 + fr, fq * 8), boff = lds_byte(wc * 32 + fr, fq * 8);
#define PG8_SA(b, h) (((b) * 2 + (h)) * HTB)
#define PG8_SB(b, h) ((4 + (b) * 2 + (h)) * HTB)
#define PG8_STAGE(bufoff, gbase, voff) do { _Pragma("unroll") for (int _i = 0; _i < 2; ++_i) \
        __builtin_amdgcn_global_load_lds((const unsigned*)((const char*)(gbase) + (voff)[_i]), (PG8_LAS unsigned*)(lds + (bufoff) + ldsw + _i * 8192), 16, 0, 0); } while (0)
#define PG8_LDA(dst, b, h) do { _Pragma("unroll") for (int m = 0; m < 4; ++m) _Pragma("unroll") for (int k = 0; k < 2; ++k) dst[m][k] = *(const PG8_LAS bf16x8*)(lds + PG8_SA(b, h) + aoff + m * 2048 + k * 1024); } while (0)
#define PG8_LDB(dst, b, h) do { _Pragma("unroll") for (int n = 0; n < 2; ++n) _Pragma("unroll") for (int k = 0; k < 2; ++k) dst[n][k] = *(const PG8_LAS bf16x8*)(lds + PG8_SB(b, h) + boff + n * 2048 + k * 1024); } while (0)
#define PG8_MMA(ai, bj, At, Bt) do { __builtin_amdgcn_s_setprio(1); _Pragma("unroll") for (int m = 0; m < 4; ++m) _Pragma("unroll") for (int n = 0; n < 2; ++n) _Pragma("unroll") for (int k = 0; k < 2; ++k) \
        acc[ai][bj][m][n] = __builtin_amdgcn_mfma_f32_16x16x32_bf16(Bt[n][k], At[m][k], acc[ai][bj][m][n], 0, 0, 0); __builtin_amdgcn_s_setprio(0); } while (0)
#define PG8_WAIT_V(n) asm volatile("s_waitcnt vmcnt(" #n ")" ::: "memory")
#define PG8_WAIT_L(n) asm volatile("s_waitcnt lgkmcnt(" #n ")" ::: "memory")
#define PG8_BAR __builtin_amdgcn_s_barrier()
#define PG8_SCHED __builtin_amdgcn_sched_barrier(0)
    unsigned vc[2][2], vn[2][2];
#define PG8_GROW(dst_, u_) do { _Pragma("unroll") for (int h_ = 0; h_ < 2; ++h_) _Pragma("unroll") for (int i_ = 0; i_ < 2; ++i_) { int R_, C_; stage_rc(tid * 16 + i_ * 8192, R_, C_); \
        dst_[h_][i_] = (unsigned)grow[(u_).pm * BM + h_ * HALF + R_] * (unsigned)(K * 2) + (unsigned)(C_ * 2); } } while (0)
#define PG8_STAGE_A(bufoff, gbase, h, NEXT) do { if constexpr (GATHER) { if (NEXT) PG8_STAGE(bufoff, gbase, vn[h]); else PG8_STAGE(bufoff, gbase, vc[h]); } \
        else PG8_STAGE(bufoff, (gbase) + (h) * hstep, voffA); } while (0)
    Unit cur, nxt; int ui = 0;
    if (!S.next(0, cur)) return;
    f32x4 acc[2][2][4][2];
#pragma unroll
    for (int a = 0; a < 2; ++a)
#pragma unroll
        for (int b = 0; b < 2; ++b)
#pragma unroll
            for (int m = 0; m < 4; ++m)
#pragma unroll
                for (int n = 0; n < 2; ++n) acc[a][b][m][n] = (f32x4){0.f, 0.f, 0.f, 0.f};
    bf16x8 At[4][2], B0[2][2], B1[2][2];
    const char* cA = (const char*)g.A + (GATHER ? (size_t)0 : (size_t)cur.pm * tstep); const char* cB = (const char*)g.Bt + (size_t)cur.be * g.bstride + (size_t)cur.pn * tstep;
    S.a_ready(cur);
    if constexpr (GATHER) PG8_GROW(vc, cur);
    if constexpr (SP2) {
        PG8_STAGE(PG8_SB(0, 0), cB, voffB); PG8_STAGE(PG8_SB(0, 1), cB + hstep, voffB); PG8_STAGE_A(PG8_SA(0, 0), cA, 0, false); PG8_STAGE_A(PG8_SA(0, 1), cA, 1, false);
        if (wr == 1) PG8_BAR;
        PG8_WAIT_V(2); PG8_BAR;
        PG8_STAGE(PG8_SB(1, 0), cB + kstep, voffB); PG8_STAGE_A(PG8_SA(1, 0), cA + kstep, 0, false); PG8_STAGE(PG8_SB(1, 1), cB + hstep + kstep, voffB);
        PG8_WAIT_V(6); PG8_BAR;
    } else {
        PG8_STAGE(PG8_SB(0, 0), cB, voffB); PG8_STAGE(PG8_SA(0, 0), cA, voffA); PG8_STAGE(PG8_SB(0, 1), cB + hstep, voffB); PG8_STAGE(PG8_SA(0, 1), cA + hstep, voffA);
        if (wr == 1) PG8_BAR;
        PG8_WAIT_V(4); PG8_BAR;
        PG8_STAGE(PG8_SB(1, 0), cB + kstep, voffB); PG8_STAGE(PG8_SA(1, 0), cA + kstep, voffA); PG8_STAGE(PG8_SB(1, 1), cB + hstep + kstep, voffB);
        PG8_WAIT_V(6); PG8_BAR;
    }
    for (;;) {
        const bool has_next = S.next(ui + 1, nxt);
        const char* nA = (has_next && !GATHER) ? (const char*)g.A + (size_t)nxt.pm * tstep : cA; const char* nB = has_next ? (const char*)g.Bt + (size_t)nxt.be * g.bstride + (size_t)nxt.pn * tstep : cB;
        for (int t = 0; t < nt; t += 2) {
            if constexpr (RSCALE_T > 0) { if (t == RSCALE_T) { int t2_ = threadIdx.x; asm volatile("" : "+v"(t2_)); const int rrow_ = cur.pm * BM + (t2_ >> 8) * 64 + (t2_ & 15);
#pragma unroll
                for (int ai_ = 0; ai_ < 2; ++ai_)
#pragma unroll
                    for (int m_ = 0; m_ < 4; ++m_) { asm volatile("" ::: "memory"); __builtin_amdgcn_sched_barrier(0); const f32x4 q_ = *(const f32x4*)(ssq + (size_t)(rrow_ + ai_ * HALF + m_ * 16) * 4);
                        const float rs_ = 1.0f / __builtin_sqrtf(((q_[0] + q_[1]) + (q_[2] + q_[3])) * ms_inv + ms_eps);
#pragma unroll
                        for (int bj_ = 0; bj_ < 2; ++bj_)
#pragma unroll
                            for (int n_ = 0; n_ < 2; ++n_) acc[ai_][bj_][m_][n_] *= rs_; } } }
            const bool last = (t == nt - 2);
            const char* a1 = cA + (size_t)(t + 1) * kstep;
            const char* a2 = last ? nA : cA + (size_t)(t + 2) * kstep; const char* b2 = last ? nB : cB + (size_t)(t + 2) * kstep;
            const char* a3 = a2 + kstep; const char* b3 = b2 + kstep;
            if (last && has_next) S.a_ready(nxt);
            if constexpr (GATHER) { if (has_next && t == nt - 4) PG8_GROW(vn, nxt); }
            const bool unx = GATHER && last && has_next;
            if constexpr (SP2) {
            PG8_LDB(B0, 0, 0); PG8_LDB(B1, 0, 1); PG8_SCHED; PG8_LDA(At, 0, 0); PG8_STAGE_A(PG8_SA(1, 1), a1, 1, false);
            PG8_WAIT_V(8); PG8_WAIT_L(0); PG8_BAR; PG8_MMA(0, 0, At, B0); PG8_MMA(0, 1, At, B1); PG8_BAR; PG8_SCHED;
            PG8_LDA(At, 0, 1); PG8_STAGE(PG8_SB(0, 0), b2, voffB); PG8_STAGE(PG8_SB(0, 1), b2 + hstep, voffB); PG8_STAGE_A(PG8_SA(0, 0), a2, 0, unx);
            PG8_WAIT_V(8); PG8_WAIT_L(0); PG8_BAR; PG8_MMA(1, 0, At, B0); PG8_MMA(1, 1, At, B1); PG8_BAR; PG8_SCHED;
            PG8_LDB(B0, 1, 0); PG8_LDB(B1, 1, 1); PG8_SCHED; PG8_LDA(At, 1, 0); PG8_STAGE_A(PG8_SA(0, 1), a2, 1, unx);
            PG8_WAIT_V(8); PG8_WAIT_L(0); PG8_BAR; PG8_MMA(0, 0, At, B0); PG8_MMA(0, 1, At, B1); PG8_BAR; PG8_SCHED;
            PG8_LDA(At, 1, 1); PG8_STAGE(PG8_SB(1, 0), b3, voffB); PG8_STAGE(PG8_SB(1, 1), b3 + hstep, voffB); PG8_STAGE_A(PG8_SA(1, 0), a3, 0, unx);
            PG8_WAIT_V(8); PG8_WAIT_L(0); PG8_BAR; PG8_MMA(1, 0, At, B0); PG8_MMA(1, 1, At, B1); PG8_BAR; PG8_SCHED;
            } else {
            PG8_LDB(B0, 0, 0); PG8_SCHED; PG8_LDA(At, 0, 0); PG8_STAGE(PG8_SA(1, 1), a1 + hstep, voffA);
            PG8_WAIT_L(8); PG8_BAR; PG8_WAIT_L(0); PG8_MMA(0, 0, At, B0); PG8_BAR; PG8_SCHED;
            PG8_LDB(B1, 0, 1); PG8_STAGE(PG8_SB(0, 0), b2, voffB);
            PG8_BAR; PG8_WAIT_L(0); PG8_MMA(0, 1, At, B1); PG8_BAR;
            PG8_LDA(At, 0, 1); PG8_STAGE(PG8_SA(0, 0), a2, voffA);
            PG8_BAR; PG8_WAIT_L(0); PG8_MMA(1, 0, At, B0); PG8_BAR; PG8_SCHED;
            PG8_STAGE(PG8_SB(0, 1), b2 + hstep, voffB);
            PG8_WAIT_V(6); PG8_BAR; PG8_MMA(1, 1, At, B1); PG8_BAR;
            PG8_LDB(B0, 1, 0); PG8_SCHED; PG8_LDA(At, 1, 0); PG8_STAGE(PG8_SA(0, 1), a2 + hstep, voffA);
            PG8_WAIT_L(8); PG8_BAR; PG8_WAIT_L(0); PG8_MMA(0, 0, At, B0); PG8_BAR; PG8_SCHED;
            PG8_LDB(B1, 1, 1); PG8_STAGE(PG8_SB(1, 0), b3, voffB);
            PG8_BAR; PG8_WAIT_L(0); PG8_MMA(0, 1, At, B1); PG8_BAR;
            PG8_LDA(At, 1, 1); PG8_STAGE(PG8_SA(1, 0), a3, voffA);
            PG8_BAR; PG8_WAIT_L(0); PG8_MMA(1, 0, At, B0); PG8_BAR; PG8_SCHED;
            PG8_STAGE(PG8_SB(1, 1), b3 + hstep, voffB);
            PG8_WAIT_V(6); PG8_BAR; PG8_MMA(1, 1, At, B1); PG8_BAR;
            }
        }
        if constexpr (ALIGN_EPI) { if (wr == 0) PG8_BAR; }
        if constexpr (!Epi::AFTER_DRAIN) { E(acc, cur, wr, wc, fr, fq); S.done(cur); }
        if (!has_next) break;
#pragma unroll
        for (int a = 0; a < 2; ++a)
#pragma unroll
            for (int b = 0; b < 2; ++b)
#pragma unroll
                for (int m = 0; m < 4; ++m)
#pragma unroll
                    for (int n = 0; n < 2; ++n) acc[a][b][m][n] = (f32x4){0.f, 0.f, 0.f, 0.f};
        cur = nxt; cA = nA; cB = nB; ++ui;
        if constexpr (GATHER) {
#pragma unroll
            for (int h_ = 0; h_ < 2; ++h_) { vc[h_][0] = vn[h_][0]; vc[h_][1] = vn[h_][1]; } }
        if constexpr (ALIGN_EPI) { if (wr == 1) PG8_BAR; }
    }
    PG8_WAIT_V(0);
    if constexpr (!ALIGN_EPI) { if (wr == 0) PG8_BAR; }
    PG8_BAR;
    if constexpr (Epi::AFTER_DRAIN) { E.fused(acc, cur, wr, wc, fr, fq, lds, wid, lane); S.done(cur); }
#undef PG8_GROW
#undef PG8_STAGE_A
#undef PG8_SA
#undef PG8_SB
#undef PG8_STAGE
#undef PG8_LDA
#undef PG8_LDB
#undef PG8_MMA
#undef PG8_WAIT_V
#undef PG8_WAIT_L
#undef PG8_BAR
#undef PG8_SCHED
}
}
#ifndef SSD_NAIVE
#define SSD_NAIVE 0
#endif
#ifndef MLSTM_NAIVE
#define MLSTM_NAIVE 0
#endif
#ifndef FOX_NAIVE
#define FOX_NAIVE 0
#endif
#include <hip/hip_bf16.h>
#include <cmath>
namespace attn_body {
using bf16=__hip_bfloat16;
using bf16x8=__attribute__((ext_vector_type(8)))short;
using s16x4=__attribute__((ext_vector_type(4)))short;
using f32x16=__attribute__((ext_vector_type(16)))float;
using u32x4=__attribute__((ext_vector_type(4)))unsigned;
constexpr int BATCH=8,NHEAD=8,SEQ=2048,D=64,PQ=3584,PO=1024;
constexpr int NW=8,QBLK=32,QB=QBLK*NW,KVBLK=64,NQB=SEQ/QB;
constexpr int ATTN_UNIT_ROWS=QB;
__device__ __forceinline__ int crow(int r,int hi){return (r&3)+8*(r>>2)+4*hi;}
#define SBAR() __builtin_amdgcn_sched_barrier(0)
__device__ __forceinline__ void cmask(f32x16&p0,f32x16&p1,int jb,int qrel,int hi){
  const float NEG=-INFINITY; int kb=64*jb+4*hi;
  #pragma unroll
  for(int r=0;r<16;++r){int kv=kb+(r&3)+8*(r>>2); if(kv>qrel)p0[r]=NEG; if(kv+32>qrel)p1[r]=NEG;}
}

constexpr int NSLOT=3, SLOTB=8192;
constexpr int LDS_K=0, LDS_V=NSLOT*SLOTB, LDS_WS=2*NSLOT*SLOTB, LDS_OST=LDS_WS+NW*64*4, LDS_CK=LDS_OST+NW*4096, LDS_BYTES=LDS_CK+SEQ*4;
constexpr float C2=0.125f*1.4426950408889634f;
__device__ __forceinline__ void glds16(const void*gsrc,unsigned lds_dst){unsigned keep;
  asm volatile("s_mov_b32 %0, m0\n\ts_mov_b32 m0, %2\n\ts_nop 0\n\tglobal_load_lds_dwordx4 %1, off\n\ts_mov_b32 m0, %0":"=&s"(keep):"v"(gsrc),"s"(lds_dst):"memory");}
__device__ __forceinline__ float max3f(float a,float b,float c){float r;asm("v_max3_f32 %0, %1, %2, %3":"=v"(r):"v"(a),"v"(b),"v"(c));return r;}
__device__ __forceinline__ float max2f(float a,float b){float r;asm("v_max_f32_e32 %0, %1, %2":"=v"(r):"v"(a),"v"(b));return r;}
__device__ __forceinline__ float fadd_s(float a,float b){float r;asm("v_add_f32_e32 %0, %1, %2":"=v"(r):"v"(a),"v"(b));return r;}
__device__ __forceinline__ float fsub_s(float a,float b){float r;asm("v_sub_f32_e32 %0, %1, %2":"=v"(r):"v"(a),"v"(b));return r;}
typedef float f32x4_t __attribute__((ext_vector_type(4))); typedef float f32x2_t __attribute__((ext_vector_type(2))); typedef __bf16 bf16x2_t __attribute__((ext_vector_type(2)));
__device__ __forceinline__ unsigned cvtpk_s(float lo,float hi){f32x2_t v={lo,hi};bf16x2_t b=__builtin_convertvector(v,bf16x2_t);return __builtin_bit_cast(unsigned,b);}
#define WAIT_BAR(N) asm volatile("s_waitcnt vmcnt(" #N ") lgkmcnt(0)\n\ts_barrier":::"memory")

__device__ __forceinline__ void qkt(f32x16&p0,f32x16&p1,const char*Kslot,const bf16x8*qr,int r32,int hi){
  const char*kb=Kslot+hi*1024+r32*16;
  #pragma unroll
  for(int d0=0;d0<4;++d0){
    const bf16x8 b0=*reinterpret_cast<const bf16x8*>(kb+d0*2048);
    const bf16x8 b1=*reinterpret_cast<const bf16x8*>(kb+d0*2048+512);
    {p0=__builtin_amdgcn_mfma_f32_32x32x16_bf16(b0,qr[d0],p0,0,0,0);p1=__builtin_amdgcn_mfma_f32_32x32x16_bf16(b1,qr[d0],p1,0,0,0);}}
}
typedef __attribute__((address_space(3))) const char* lds_cptr;
typedef short v4i16_t __attribute__((ext_vector_type(4)));
__device__ __forceinline__ void kload8(bf16x8*kf,lds_cptr kp){
  kf[0]=*(const __attribute__((address_space(3))) bf16x8*)(kp);      kf[1]=*(const __attribute__((address_space(3))) bf16x8*)(kp+512);
  kf[2]=*(const __attribute__((address_space(3))) bf16x8*)(kp+2048); kf[3]=*(const __attribute__((address_space(3))) bf16x8*)(kp+2560);
  kf[4]=*(const __attribute__((address_space(3))) bf16x8*)(kp+4096); kf[5]=*(const __attribute__((address_space(3))) bf16x8*)(kp+4608);
  kf[6]=*(const __attribute__((address_space(3))) bf16x8*)(kp+6144); kf[7]=*(const __attribute__((address_space(3))) bf16x8*)(kp+6656);
}
__device__ __forceinline__ void kload2(bf16x8*kf,lds_cptr kp,int j){ kf[2*j]=*(const __attribute__((address_space(3))) bf16x8*)(kp+j*2048); kf[2*j+1]=*(const __attribute__((address_space(3))) bf16x8*)(kp+j*2048+512); }
__device__ __forceinline__ s16x4 vtr(lds_cptr p){ return __builtin_bit_cast(s16x4,__builtin_amdgcn_ds_read_tr16_b64_v4i16((__attribute__((address_space(3))) v4i16_t*)p)); }
__device__ __forceinline__ float rowmax(const f32x16&p0,const f32x16&p1){
  float a=max3f(p0[0],p0[1],p1[0]),b=max3f(p0[2],p0[3],p1[1]);a=max3f(a,p1[2],p1[3]);
  #pragma unroll
  for(int r=4;r<16;r+=4){a=max3f(a,p0[r],p0[r+1]);b=max3f(b,p0[r+2],p0[r+3]);a=max3f(a,p1[r],p1[r+1]);b=max3f(b,p1[r+2],p1[r+3]);}
  const float m=max2f(a,b);
  auto rr=__builtin_amdgcn_permlane32_swap(__float_as_uint(m),__float_as_uint(m),false,false);
  return max2f(__uint_as_float(rr[0]),__uint_as_float(rr[1]));
}
__device__ __forceinline__ void pv(f32x16*o,int vb,bf16x8 pa0,bf16x8 pa1,bf16x8 pa2,bf16x8 pa3){
  #pragma unroll
  for(int d0=0;d0<2;++d0){s16x4 lo[4],hi[4];
    #pragma unroll
    for(int ks=0;ks<4;++ks){
      asm volatile("ds_read_b64_tr_b16 %0,%1 offset:%c2":"=&v"(lo[ks]):"v"(vb),"i"(d0*4096+ks*1024):"memory");
      asm volatile("ds_read_b64_tr_b16 %0,%1 offset:%c2":"=&v"(hi[ks]):"v"(vb),"i"(d0*4096+ks*1024+512):"memory");}
    asm volatile("s_waitcnt lgkmcnt(0)":::"memory");SBAR();
    #define PK(k) (bf16x8){lo[k][0],lo[k][1],lo[k][2],lo[k][3],hi[k][0],hi[k][1],hi[k][2],hi[k][3]}
    o[d0]=__builtin_amdgcn_mfma_f32_32x32x16_bf16(pa0,PK(0),o[d0],0,0,0);
    o[d0]=__builtin_amdgcn_mfma_f32_32x32x16_bf16(pa1,PK(1),o[d0],0,0,0);
    o[d0]=__builtin_amdgcn_mfma_f32_32x32x16_bf16(pa2,PK(2),o[d0],0,0,0);
    o[d0]=__builtin_amdgcn_mfma_f32_32x32x16_bf16(pa3,PK(3),o[d0],0,0,0);
    #undef PK
  }
}

#ifndef ATTN_STORE16
#define ATTN_STORE16(p,v) (*(u32x4*)(p)=(v))
#endif
template<int THRL> __device__ __forceinline__ void attn_unit(int b,int h,int qb,const bf16*Q,const bf16*K,const bf16*V,bf16*O,const float*cum,char*shm){
  const int tid=threadIdx.x,lane=tid&63,r32=lane&31,hi=lane>>5; const int wid=__builtin_amdgcn_readfirstlane(tid>>6);
  const long rowbase=(long)b*SEQ; const int q0=qb*QB;
  const bf16*Qw=Q+(rowbase+q0+wid*QBLK)*PQ+h*D;
  const bf16*Kh=K+rowbase*PQ+h*D,*Vh=V+rowbase*PQ+h*D;
  const lds_cptr shm3_=(lds_cptr)shm;
  const unsigned lds0=(unsigned)(uintptr_t)shm;
  float*wsf=(float*)(shm+LDS_WS)+wid*64;
  const bf16*ksrc=Kh+(long)lane*PQ+wid*8;
  const bf16*vsrc=Vh+(long)(16*(wid&3)+(lane>>2))*PQ+(wid>>2)*32+(lane&3)*8;
  const unsigned kdst=lds0+LDS_K+wid*1024, vdst=lds0+LDS_V+wid*1024;
  #define DMA_K(t,slot) glds16(ksrc+(long)(t)*KVBLK*PQ,(unsigned)__builtin_amdgcn_readfirstlane(kdst+(slot)))
  #define DMA_V(t,slot) glds16(vsrc+(long)(t)*KVBLK*PQ,(unsigned)__builtin_amdgcn_readfirstlane(vdst+(slot)))
  const int vb0=(int)(lds0+LDS_V)+((lane>>4)&1)*32+(lane&3)*8+(4*hi+((lane&15)>>2))*64;
  const char*Kbase=shm+LDS_K; bf16x8 kf[8];
  const lds_cptr shm3=(lds_cptr)shm; const lds_cptr kp0=shm3+LDS_K+hi*1024+r32*16; const lds_cptr vp0=shm3+LDS_V+((lane>>4)&1)*32+(lane&3)*8+(4*hi+((lane&15)>>2))*64;
  const int NT=(q0+QB)/KVBLK;
  float cqm;
  { float*cks=(float*)(shm+LDS_CK); for(int i=tid;i<q0+QB;i+=NW*64)cks[i]=cum[i]; cqm=cum[q0+wid*QBLK+r32]; asm volatile("s_waitcnt vmcnt(0)":"+v"(cqm)::"memory"); }
  const __attribute__((address_space(3))) float*ckl=(const __attribute__((address_space(3))) float*)(shm3_+LDS_CK)+4*hi;
  #define BIASFILL(C0_,C1_,t_) do{ const __attribute__((address_space(3))) float*cp_=ckl+64*(t_); \
    _Pragma("unroll") for(int a_=0;a_<4;++a_){ const f32x4_t u_=*(const __attribute__((address_space(3))) f32x4_t*)(cp_+8*a_), w_=*(const __attribute__((address_space(3))) f32x4_t*)(cp_+32+8*a_); \
      _Pragma("unroll") for(int i_=0;i_<4;++i_){ C0_[4*a_+i_]=cqm-u_[i_]; C1_[4*a_+i_]=cqm-w_[i_]; } } }while(0)
  DMA_K(0,0);DMA_V(0,0);DMA_K(1,SLOTB);
  bf16x8 qr[4];
  #pragma unroll
  for(int d0=0;d0<4;++d0)qr[d0]=*reinterpret_cast<const bf16x8*>(&Qw[(long)r32*PQ+d0*16+hi*8]);
  float l_reg=0.f;f32x16 o[2];o[0]=f32x16{};o[1]=f32x16{};
  const int qrel=wid*QBLK+r32;
  #define CMASK(P0,P1,t) do{int jb_=(t)-(NT-4); if(jb_>=0)cmask(P0,P1,jb_,qrel,hi);}while(0)
  bool resc=false;
  #define START(P0,P1) do{ const float rm=rowmax(P0,P1); resc=false; \
    { const float dl=rm; cqm=fsub_s(cqm,dl); \
      _Pragma("unroll") for(int r=0;r<16;++r){P0[r]=fsub_s(P0[r],dl);P1[r]=fsub_s(P1[r],dl);} \
      } \
    _Pragma("unroll") for(int r=0;r<16;++r)P0[r]=__builtin_amdgcn_exp2f(P0[r]); }while(0)
  #define RESC() do{ if(resc){ asm volatile("s_waitcnt lgkmcnt(0)":::"memory"); \
      _Pragma("unroll") for(int d_=0;d_<2;++d_) _Pragma("unroll") for(int r=0;r<16;++r)o[d_][r]*=wsf[crow(r,hi)]; } }while(0)
  f32x16 pA0,pA1,pB0,pB1;
  int sl_prev=0,sl_cur=0,sl_next=SLOTB;
  #define ROT() do{sl_prev=sl_cur;sl_cur=sl_next;sl_next=(sl_next==(NSLOT-1)*SLOTB)?0:sl_next+SLOTB;}while(0)
  DMA_K(2,2*SLOTB);
  WAIT_BAR(3);
  BIASFILL(pA0,pA1,0); qkt(pA0,pA1,Kbase,qr,r32,hi);asm volatile("s_nop 15\n\ts_nop 7":"+v"(pA0),"+v"(pA1));CMASK(pA0,pA1,0);
  START(pA0,pA1);
  _Pragma("unroll") for(int r=0;r<16;++r)pA1[r]=__builtin_amdgcn_exp2f(pA1[r]);
  WAIT_BAR(0);
  DMA_K(3,0);DMA_V(1,SLOTB);
  ROT();
  kload8(kf,kp0+sl_cur);
  WAIT_BAR(2);
  s16x4 vlo[8],vhi[8]; u32x4 pw0,pw1,pw2,pw3;
  #define PKW(P,B) cvtpk_s(P[B],P[B+1])
  #define PAF(k) __builtin_bit_cast(bf16x8,pw##k)
  #define VFR(i) (bf16x8){vlo[i][0],vlo[i][1],vlo[i][2],vlo[i][3],vhi[i][0],vhi[i][1],vhi[i][2],vhi[i][3]}
  #define PIN(x) asm volatile("":"+v"(x))
  #define MX3(a,b,c) __builtin_fmaxf(__builtin_fmaxf((a),(b)),(c))
  #define GAPA(MF,A0,A1,A2,A3,W0,W1,PW) do{ MF; sacc+=A0; sacc+=A1; sacc+=A2; sacc+=A3; PIN(sacc); W0; W1; PIN(PW); SBAR(); }while(0)
  #define EX(v) __builtin_amdgcn_exp2f(v)
  #define GAPB(MF,X,B) do{ MF; X[B]=EX(X[B]); X[B+1]=EX(X[B+1]); X[B+2]=EX(X[B+2]); X[B+3]=EX(X[B+3]); PIN(X); SBAR(); }while(0)
  #define VRD(i) do{ vlo[i]=vtr(vp_+(((i)>>2)*4096+((i)&3)*1024)); vhi[i]=vtr(vp_+(((i)>>2)*4096+((i)&3)*1024+512)); }while(0)
  #define KRD(G,j) do{ if(G){ kload2(kf,kp0+sl_next,j); SBAR(); } }while(0)
  #define STEP(C0,C1,P0,P1,t,GK,GV,GL) do{ BIASFILL(C0,C1,t); SBAR(); \
    const lds_cptr vp_=vp0+sl_prev; \
    VRD(0); SBAR(); float sacc=(P0[0]+P0[1]); \
    GAPA(C0=__builtin_amdgcn_mfma_f32_32x32x16_bf16(kf[0],qr[0],C0,0,0,0), P0[2],P0[3],P0[4],P0[5],     pw0[0]=PKW(P0,0), pw0[1]=PKW(P0,2), pw0); \
    VRD(4); SBAR(); GAPA(C1=__builtin_amdgcn_mfma_f32_32x32x16_bf16(kf[1],qr[0],C1,0,0,0), P0[6],P0[7],P0[8],P0[9],     pw0[2]=PKW(P0,4), pw0[3]=PKW(P0,6), pw0); \
    VRD(1); SBAR(); GAPA(C0=__builtin_amdgcn_mfma_f32_32x32x16_bf16(kf[2],qr[1],C0,0,0,0),   P0[10],P0[11],P0[12],P0[13], pw1[0]=PKW(P0,8), pw1[1]=PKW(P0,10), pw1); \
    VRD(5); SBAR(); GAPA(C1=__builtin_amdgcn_mfma_f32_32x32x16_bf16(kf[3],qr[1],C1,0,0,0),   P0[14],P0[15],P1[0],P1[1],   pw1[2]=PKW(P0,12),pw1[3]=PKW(P0,14), pw1); \
    VRD(2); SBAR(); GAPA(C0=__builtin_amdgcn_mfma_f32_32x32x16_bf16(kf[4],qr[2],C0,0,0,0),   P1[2],P1[3],P1[4],P1[5],     pw2[0]=PKW(P1,0), pw2[1]=PKW(P1,2), pw2); \
    VRD(6); SBAR(); GAPA(C1=__builtin_amdgcn_mfma_f32_32x32x16_bf16(kf[5],qr[2],C1,0,0,0),   P1[6],P1[7],P1[8],P1[9],     pw2[2]=PKW(P1,4), pw2[3]=PKW(P1,6), pw2); \
    VRD(3); SBAR(); GAPA(C0=__builtin_amdgcn_mfma_f32_32x32x16_bf16(kf[6],qr[3],C0,0,0,0),   P1[10],P1[11],P1[12],P1[13], pw3[0]=PKW(P1,8), pw3[1]=PKW(P1,10), pw3); \
    VRD(7); SBAR(); GAPA(C1=__builtin_amdgcn_mfma_f32_32x32x16_bf16(kf[7],qr[3],C1,0,0,0),   P1[14],P1[15],0.f,0.f,       pw3[2]=PKW(P1,12),pw3[3]=PKW(P1,14), pw3); \
    l_reg+=sacc; \
    if(GK){DMA_K((t)+3,sl_cur);} if(GV){DMA_V((t)+1,sl_next);} \
    CMASK(C0,C1,t); \
    { float a=MX3(C0[0],C0[1],C1[0]),b=MX3(C0[2],C0[3],C1[1]); a=MX3(a,C1[2],C1[3]); \
      _Pragma("unroll") for(int r=4;r<16;r+=4){a=MX3(a,C0[r],C0[r+1]);b=MX3(b,C0[r+2],C0[r+3]);a=MX3(a,C1[r],C1[r+1]);b=MX3(b,C1[r+2],C1[r+3]);} \
      float rm=__builtin_fmaxf(a,b); { auto rr=__builtin_amdgcn_permlane32_swap(__float_as_uint(rm),__float_as_uint(rm),false,false); rm=__builtin_fmaxf(__uint_as_float(rr[0]),__uint_as_float(rr[1])); } \
      resc=false; \
      if(__builtin_expect(__any(rm>(float)THRL),0)){ const float dl=__builtin_fmaxf(rm,0.f); cqm-=dl; \
        _Pragma("unroll") for(int r=0;r<16;++r){C0[r]-=dl;C1[r]-=dl;} \
        const float f=__builtin_amdgcn_exp2f(-dl); l_reg*=f; if(hi==0)wsf[r32]=f; resc=true; } } \
    SBAR(); \
    GAPB(o[0]=__builtin_amdgcn_mfma_f32_32x32x16_bf16(PAF(0),VFR(0),o[0],0,0,0), C0,0); \
    GAPB(o[1]=__builtin_amdgcn_mfma_f32_32x32x16_bf16(PAF(0),VFR(4),o[1],0,0,0), C0,4); \
    KRD(GL,0); GAPB(o[0]=__builtin_amdgcn_mfma_f32_32x32x16_bf16(PAF(1),VFR(1),o[0],0,0,0), C0,8); \
    KRD(GL,1); GAPB(o[1]=__builtin_amdgcn_mfma_f32_32x32x16_bf16(PAF(1),VFR(5),o[1],0,0,0), C0,12); \
    KRD(GL,2); GAPB(o[0]=__builtin_amdgcn_mfma_f32_32x32x16_bf16(PAF(2),VFR(2),o[0],0,0,0), C1,0); \
    KRD(GL,3); GAPB(o[1]=__builtin_amdgcn_mfma_f32_32x32x16_bf16(PAF(2),VFR(6),o[1],0,0,0), C1,4); \
    GAPB(o[0]=__builtin_amdgcn_mfma_f32_32x32x16_bf16(PAF(3),VFR(3),o[0],0,0,0), C1,8); \
    GAPB(o[1]=__builtin_amdgcn_mfma_f32_32x32x16_bf16(PAF(3),VFR(7),o[1],0,0,0), C1,12); \
    }while(0)
  int t=1;
  #undef CMASK
  #define CMASK(P0,P1,t) do{}while(0)
  for(;t+5<NT;t+=2){
    STEP(pB0,pB1,pA0,pA1,t,true,true,true);     WAIT_BAR(2); RESC(); ROT();
    STEP(pA0,pA1,pB0,pB1,t+1,true,true,true);   WAIT_BAR(2); RESC(); ROT();
  }
  #undef CMASK
  #define CMASK(P0,P1,t) do{int jb_=(t)-(NT-4); if(jb_>=0)cmask(P0,P1,jb_,qrel,hi);}while(0)
  #define ENDW(tt) do{ if((tt)+3<NT){WAIT_BAR(2);} else if((tt)+2<NT){WAIT_BAR(1);} else {WAIT_BAR(0);} }while(0)
  for(;t+1<NT;t+=2){
    STEP(pB0,pB1,pA0,pA1,t,(t+3<NT),(t+1<NT),(t+1<NT));       ENDW(t);   RESC(); ROT();
    STEP(pA0,pA1,pB0,pB1,t+1,(t+4<NT),(t+2<NT),(t+2<NT));     ENDW(t+1); RESC(); ROT();
  }
  STEP(pB0,pB1,pA0,pA1,NT-1,false,false,false); RESC();
  { float sacc=pB0[0]+pB0[1]; _Pragma("unroll") for(int r=2;r<16;++r)sacc+=pB0[r]; _Pragma("unroll") for(int r=0;r<16;++r)sacc+=pB1[r]; l_reg+=sacc;
    pw0=(u32x4){PKW(pB0,0),PKW(pB0,2),PKW(pB0,4),PKW(pB0,6)};pw1=(u32x4){PKW(pB0,8),PKW(pB0,10),PKW(pB0,12),PKW(pB0,14)};pw2=(u32x4){PKW(pB1,0),PKW(pB1,2),PKW(pB1,4),PKW(pB1,6)};pw3=(u32x4){PKW(pB1,8),PKW(pB1,10),PKW(pB1,12),PKW(pB1,14)};
    SBAR(); pv(o,vb0+sl_cur,PAF(0),PAF(1),PAF(2),PAF(3)); }
  #undef PKW
  #undef PAF
  #undef VFR
  #undef PIN
  #undef MX3
  #undef GAPA
  #undef GAPB
  #undef EX
  #undef VRD
  #undef KRD
  #undef STEP
  #undef ENDW
  {auto rr=__builtin_amdgcn_permlane32_swap(__float_as_uint(l_reg),__float_as_uint(l_reg),false,false);l_reg=__uint_as_float(rr[0])+__uint_as_float(rr[1]);}
  if(hi==0)wsf[32+r32]=l_reg;asm volatile("s_waitcnt lgkmcnt(0)":::"memory");
  float rli[16];
  #pragma unroll
  for(int r=0;r<16;++r)rli[r]=__builtin_amdgcn_rcpf(wsf[32+crow(r,hi)]);
  bf16*Ow=O+(rowbase+q0+wid*QBLK)*PO+h*D;
  { bf16*stg=(bf16*)(shm+LDS_OST)+wid*2048;
    #pragma unroll
    for(int r=0;r<16;++r){const int orow=crow(r,hi);
      #pragma unroll
      for(int d0=0;d0<2;++d0)stg[orow*64+d0*32+r32]=__float2bfloat16(o[d0][r]*rli[r]);}
    asm volatile("s_waitcnt lgkmcnt(0)":::"memory");
    #pragma unroll
    for(int i=0;i<4;++i){const int row=i*8+(lane>>3),ch=lane&7; const u32x4 v=*(const u32x4*)(stg+row*64+ch*8); ATTN_STORE16(Ow+(long)row*PO+ch*8,v);} }
  asm volatile("s_waitcnt lgkmcnt(0)\n\ts_barrier":::"memory");
  #undef DMA_K
  #undef BIASFILL
  #undef DMA_V
  #undef CMASK
  #undef START
  #undef RESC
  #undef ROT
}
constexpr int ATTN_LDS_BYTES=LDS_BYTES;
struct AttnTensors { const bf16* Q; const bf16* K; const bf16* V; bf16* O; const float* cum; };
struct AttnUnit { int bh; int qb; };
struct StaticOrder {
  int vcu, G;
  __device__ __forceinline__ explicit StaticOrder(int grid,int v):vcu(v),G(grid){}
  __device__ __forceinline__ bool next(int i,AttnUnit&u)const{ const int pr=vcu+(i>>1)*G; if(pr>=256)return false; const int s=pr&3; u.bh=pr>>2; u.qb=(i&1)?7-s:s; return true; }
  __device__ __forceinline__ void a_ready(const AttnUnit&)const{}
  __device__ __forceinline__ void done(const AttnUnit&)const{}
};
template<class Sched,int THRL=8> __device__ __forceinline__ void attn_phase(char*lds,const AttnTensors&T,const Sched&S){
  AttnUnit u;
  for(int i=0;S.next(i,u);++i){ S.a_ready(u); attn_unit<THRL>(u.bh/NHEAD,u.bh%NHEAD,u.qb,T.Q,T.K,T.V,T.O,T.cum+(long)u.bh*SEQ,lds); S.done(u); }
}
#undef SBAR
#undef WAIT_BAR
}
constexpr int NWAVES = 8;
constexpr int T = 16384, D = 1024, SEQ = 2048, NBATCH = 8, DEPTH = 4;
constexpr float ALPHA = 1.6817928305074290f;
constexpr float LN_EPS = 1e-5f;
constexpr int AB_IN = 4112, CD_IN = 3600, NPE = 4096, NPO = 3584;
constexpr float LOG2E = 1.4426950408889634f;
constexpr float FOX_C2 = 0.125f * LOG2E;
constexpr float MLSTM_KSCALE = 0.08838834764831845f;
constexpr int RPAD = 40960;
constexpr int NPH_LAYER = 12, NPHASES = 1 + DEPTH * NPH_LAYER;
#ifndef MK_ONE_LAUNCH
#define MK_ONE_LAUNCH 1
#endif

constexpr size_t MiB = 1u << 20, KiB = 1u << 10;
constexpr size_t WS_CTL = 0, CTL_ZERO_BYTES = 1 * MiB;
constexpr size_t WS_BCNT = 1 * MiB, WS_PANEL = WS_BCNT + 64 * KiB, WS_ROUTE = WS_BCNT + 128 * KiB, WS_GATE = WS_BCNT + 384 * KiB, WS_POS = WS_BCNT + 512 * KiB,
                 WS_DEC = WS_BCNT + 640 * KiB, WS_SSQ = WS_BCNT + 768 * KiB  , WS_MLOC = WS_BCNT + 704 * KiB, WS_BLAST = WS_BCNT + 712 * KiB, WS_MPREV = WS_BCNT + 720 * KiB,
                 WS_FOXC = 2 * MiB, WS_NLOC = 2 * MiB + 512 * KiB, WS_SG = 3 * MiB;
constexpr size_t WS_WINE = 4 * MiB, WS_WINO = 20 * MiB, WS_WOUTE = 34 * MiB, WS_WOUTO = 40 * MiB, WS_WGU = 44 * MiB, WS_WD = 300 * MiB;
constexpr size_t WS_HF = 428 * MiB, WS_HB = 492 * MiB, WS_H1F = 524 * MiB, WS_H1B = 588 * MiB;
constexpr size_t WS_R1 = 620 * MiB;
constexpr size_t WS_R2 = 748 * MiB;
constexpr size_t WS_R3 = 812 * MiB;
constexpr size_t WS_R4 = 860 * MiB;
constexpr size_t WS_MIX = 892 * MiB;
constexpr size_t WS_TAB = 940 * MiB, TAB_LAYER = 208 * KiB, TAB_GPW = 0, TAB_RGW = 64 * KiB, TAB_REW = 80 * KiB;
constexpr size_t WS_SROW = WS_TAB + 832 * KiB;
constexpr size_t WS_END = 941 * MiB;
constexpr int CW_BAR = 4096;

constexpr int RING_BYTES = 131072, SMALL_OFF = RING_BYTES, SMALL_BYTES = 8192, MISC_OFF = SMALL_OFF + SMALL_BYTES, LDS_BYTES = 147456;

#define GAS __attribute__((address_space(1)))
#define LAS __attribute__((address_space(3)))
typedef unsigned short bf16;
typedef unsigned v4u __attribute__((ext_vector_type(4)));
typedef unsigned v2u __attribute__((ext_vector_type(2)));
typedef float f32x4 __attribute__((ext_vector_type(4)));
typedef float f32x2 __attribute__((ext_vector_type(2)));
typedef int i32x4 __attribute__((ext_vector_type(4)));
typedef int i32x2 __attribute__((ext_vector_type(2)));
#define LDS_WAIT() asm volatile("s_waitcnt lgkmcnt(0)" ::: "memory")
__device__ __forceinline__ unsigned f2bf(float f) { unsigned u = __builtin_bit_cast(unsigned, f); return (u + 0x7fffu + ((u >> 16) & 1u)) >> 16; }
typedef __bf16 bf16x2_t __attribute__((ext_vector_type(2)));
__device__ __forceinline__ unsigned cvtpk(float lo, float hi) { const f32x2 v = {lo, hi}; const bf16x2_t b = __builtin_convertvector(v, bf16x2_t); return __builtin_bit_cast(unsigned, b); }
__device__ __forceinline__ unsigned pk2(float lo, float hi) { return cvtpk(lo, hi); }
__device__ __forceinline__ float bflo(unsigned w) { return __builtin_bit_cast(float, w << 16); }
__device__ __forceinline__ float bfhi(unsigned w) { return __builtin_bit_cast(float, w & 0xffff0000u); }
__device__ __forceinline__ float bf2f(bf16 b) { return __builtin_bit_cast(float, (unsigned)b << 16); }
__device__ __forceinline__ float wave_sum(float v) {
#pragma unroll
    for (int o = 1; o < 64; o <<= 1) v += __shfl_xor(v, o);
    return v;
}
__device__ __forceinline__ float wave_max(float v) {
#pragma unroll
    for (int o = 1; o < 64; o <<= 1) v = fmaxf(v, __shfl_xor(v, o));
    return v;
}
__device__ __forceinline__ float wave_scan_sum(float v, int lane) {
#pragma unroll
    for (int o = 1; o < 64; o <<= 1) { const float t = __shfl_up(v, o); if (lane >= o) v += t; }
    return v;
}
__device__ __forceinline__ float wave_scan_max(float v, int lane) {
#pragma unroll
    for (int o = 1; o < 64; o <<= 1) { const float t = __shfl_up(v, o); if (lane >= o) v = fmaxf(v, t); }
    return v;
}
__device__ __forceinline__ float softplus_f(float x) { return x > 20.f ? x : log1pf(expf(x)); }
__device__ __forceinline__ float logsigmoid_f(float x) { return fminf(x, 0.f) - log1pf(expf(-fabsf(x))); }
__device__ __forceinline__ float sigmoid_f(float x) { return 1.0f / (1.0f + expf(-x)); }
#define XB_TMO      128
#define XB_XCNT(j)  (256  + 64 * (j))
#define XB_XSUB(j)  (1280 + 64 * (j))
#define XB_XGEN(j)  (2304 + 64 * (j))
#define XB_TOP      3328
#define XB_TOPGEN   3392
#define XCD_BAR_WORDS 3456
#define XB_SPIN_CAP (1u << 18)

__device__ __forceinline__ unsigned xb_ld(unsigned* p)              { return __hip_atomic_load(p, __ATOMIC_RELAXED, __HIP_MEMORY_SCOPE_AGENT); }
__device__ __forceinline__ unsigned xb_add(unsigned* p, unsigned v) { return __hip_atomic_fetch_add(p, v, __ATOMIC_RELAXED, __HIP_MEMORY_SCOPE_AGENT); }
__device__ __forceinline__ unsigned xb_xcc_id() { return (unsigned)__builtin_amdgcn_s_getreg((3 << 11) | 20) & 0xFu; }
#define XB_SPIN(cond, bar) do { unsigned _sp = 0; while (cond) { __builtin_amdgcn_s_sleep(1); \
    if ((++_sp & 255u) == 0u) { if (xb_ld(&(bar)[XB_TMO])) break; if (_sp > XB_SPIN_CAP) { atomicAdd(&(bar)[XB_TMO], 1u); break; } } } } while (0)

struct XcdBarrier {
    unsigned* bar; unsigned x;
    volatile LAS unsigned* st;
};

__device__ __forceinline__ XcdBarrier xcd_barrier_post(unsigned* bar, volatile LAS unsigned* st) {
    XcdBarrier b; b.bar = bar; b.x = xb_xcc_id(); b.st = st;
    if (threadIdx.x == 0) (void)xb_add(&bar[XB_XCNT(b.x)], 1u);
    return b;
}
__device__ __forceinline__ void xcd_barrier_complete(unsigned* bar, unsigned x, unsigned& nloc, unsigned& nx) {
    const unsigned G = gridDim.x * gridDim.y * gridDim.z;
    unsigned sum, cnt, mine, sp = 0u;
    for (;;) {
        sum = 0u; cnt = 0u; mine = 0u;
#pragma unroll
        for (unsigned j = 0; j < 16; ++j) { const unsigned c = xb_ld(&bar[XB_XCNT(j)]); sum += c; cnt += (c > 0u) ? 1u : 0u; mine = (j == x) ? c : mine; }
        if (sum == G) break;
        __builtin_amdgcn_s_sleep(1);
        if ((++sp & 255u) == 0u) { if (xb_ld(&bar[XB_TMO])) break; if (sp > XB_SPIN_CAP) { atomicAdd(&bar[XB_TMO], 1u); break; } }
    }
    nloc = mine > 0u ? mine : 1u; nx = cnt > 0u ? cnt : 1u;
}

__device__ __forceinline__ void xcd_barrier(const XcdBarrier& b) {
    asm volatile("s_waitcnt vmcnt(0)" ::: "memory");
    __syncthreads();
    if (threadIdx.x == 0) {
        unsigned* bar = b.bar;
        __builtin_amdgcn_s_waitcnt(0);
        unsigned nloc = b.st[0], nx = b.st[1];
        if (nloc == 0u) { xcd_barrier_complete(bar, b.x, nloc, nx); b.st[0] = nloc; b.st[1] = nx; }
        const unsigned old = xb_add(&bar[XB_XSUB(b.x)], 1u);
        const unsigned gen = old / nloc;
        if (old + 1u == (gen + 1u) * nloc) {
            __builtin_amdgcn_fence(__ATOMIC_RELEASE, "agent");
            asm volatile("s_waitcnt vmcnt(0)" ::: "memory");
            const unsigned og = xb_add(&bar[XB_TOP], 1u);
            const unsigned tg = og / nx;
            if (og + 1u == (tg + 1u) * nx) xb_add(&bar[XB_TOPGEN], 1u);
            else XB_SPIN(xb_ld(&bar[XB_TOPGEN]) == tg, bar);
            __builtin_amdgcn_fence(__ATOMIC_ACQUIRE, "agent");
            xb_add(&bar[XB_XGEN(b.x)], 1u);
            asm volatile("s_waitcnt vmcnt(0)" ::: "memory");
        } else {
            XB_SPIN(xb_ld(&bar[XB_XGEN(b.x)]) == gen, bar);
            __builtin_amdgcn_fence(__ATOMIC_ACQUIRE, "agent");
            asm volatile("s_waitcnt vmcnt(0)" ::: "memory");
        }
    }
    __syncthreads();
}
struct Frame {
    LAS unsigned char* lds;
    volatile LAS unsigned* MISC;
    unsigned* ctl;
    int tid, lane, wave, vcu, G, gw, NGW;
};
typedef const float* const cfpc_t; typedef __attribute__((address_space(4))) cfpc_t* kargp_t;
__device__ __forceinline__ kargp_t kin() { kargp_t p = (kargp_t)__builtin_amdgcn_kernarg_segment_ptr(); asm volatile("" : "+s"(p)); return p; }
#define KIN(i) (kin()[i])
typedef unsigned char* const ucpc_t; typedef __attribute__((address_space(4))) ucpc_t* kargu_t;
__device__ __forceinline__ unsigned char* kws() { return ((kargu_t)kin())[28]; }
__device__ __forceinline__ float* kout() { return (float*)((kargu_t)kin())[27]; }
enum { I_X = 0, I_ABWIN, I_CONVA, I_CONVW, I_CONVB, I_DTB, I_ALOG, I_DSKIP, I_NORMW, I_ABWOUT, I_CDWIN, I_IB, I_FB, I_HNW, I_FOXB, I_CDWOUT, I_LN1G, I_LN1B, I_LN2G, I_LN2B,
       I_RGW, I_RGB, I_REW, I_REB, I_WG, I_WU, I_WDN };

__device__ __forceinline__ void row_load(const float* row, int lane, f32x4 (&v)[4]) {
#pragma unroll
    for (int j = 0; j < 4; ++j) v[j] = ((const f32x4*)row)[lane + 64 * j];
}
__device__ __forceinline__ void row_store_f32(float* row, int lane, const f32x4 (&v)[4]) {
#pragma unroll
    for (int j = 0; j < 4; ++j) ((f32x4*)row)[lane + 64 * j] = v[j];
}
__device__ __forceinline__ void row_store_bf16(bf16* row, int lane, const f32x4 (&v)[4]) {
#pragma unroll
    for (int j = 0; j < 4; ++j) { v2u w; w.x = pk2(v[j][0], v[j][1]); w.y = pk2(v[j][2], v[j][3]); ((v2u*)row)[lane + 64 * j] = w; }
}
__device__ __forceinline__ void row_load_bf16(const bf16* row, int lane, f32x4 (&v)[4]) {
#pragma unroll
    for (int j = 0; j < 4; ++j) { const v2u w = ((const v2u*)row)[lane + 64 * j]; v[j] = (f32x4){bflo(w.x), bfhi(w.x), bflo(w.y), bfhi(w.y)}; }
}
__device__ __forceinline__ void dma1k(const void* gsrc, unsigned lds_dst) { unsigned keep;
    asm volatile("s_mov_b32 %0, m0\n\ts_mov_b32 m0, %2\n\ts_nop 0\n\tglobal_load_lds_dwordx4 %1, off\n\ts_mov_b32 m0, %0" : "=&s"(keep) : "v"(gsrc), "s"(lds_dst) : "memory"); }
template <int KB> __device__ __forceinline__ void row_dma(const void* grow, unsigned lds_dst, int lane) {
#pragma unroll
    for (int i = 0; i < KB; ++i) dma1k((const char*)grow + 1024 * i + 16 * lane, (unsigned)__builtin_amdgcn_readfirstlane(lds_dst + 1024 * i));
}
#define DMA_WAIT_ALL() asm volatile("s_waitcnt vmcnt(0)" ::: "memory")
__device__ __forceinline__ void row_load_bf16_lds(const LAS unsigned char* row, int lane, f32x4 (&v)[4]) {
#pragma unroll
    for (int j = 0; j < 4; ++j) { const v2u w = ((const LAS v2u*)row)[lane + 64 * j]; v[j] = (f32x4){bflo(w.x), bfhi(w.x), bflo(w.y), bfhi(w.y)}; }
}
__device__ __forceinline__ void row_load_f32_lds(const LAS unsigned char* row, int lane, f32x4 (&v)[4]) {
#pragma unroll
    for (int j = 0; j < 4; ++j) v[j] = ((const LAS f32x4*)row)[lane + 64 * j];
}
__device__ __forceinline__ void row_layernorm(f32x4 (&v)[4], const float* g, const float* b, int lane) {
    float s = 0.f;
#pragma unroll
    for (int j = 0; j < 4; ++j) s += (v[j][0] + v[j][1]) + (v[j][2] + v[j][3]);
    const float mean = wave_sum(s) * (1.f / D); float s2 = 0.f;
#pragma unroll
    for (int j = 0; j < 4; ++j) { v[j] = v[j] - mean; s2 += (v[j][0] * v[j][0] + v[j][1] * v[j][1]) + (v[j][2] * v[j][2] + v[j][3] * v[j][3]); }
    const float rstd = 1.0f / sqrtf(wave_sum(s2) * (1.f / D) + LN_EPS);
#pragma unroll
    for (int j = 0; j < 4; ++j) { const f32x4 gg = ((const f32x4*)g)[lane + 64 * j], bb = ((const f32x4*)b)[lane + 64 * j]; v[j] = v[j] * rstd * gg + bb; }
}
template <int n, int o, int N> struct RedStep {
    static __device__ __forceinline__ void run(float (&a)[N], int lane) { const bool up = (lane & o) != 0;
#pragma unroll
        for (int i = 0; i < n / 2; ++i) { const float keep = up ? a[i + n / 2] : a[i], send = up ? a[i] : a[i + n / 2]; a[i] = keep + __shfl_xor(send, o); }
        RedStep<n / 2, o / 2, N>::run(a, lane); }
};
template <int o, int N> struct RedStep<1, o, N> {
    static __device__ __forceinline__ void run(float (&a)[N], int) { float r = a[0];
#pragma unroll
        for (int oo = o; oo >= 1; oo >>= 1) r += __shfl_xor(r, oo);
        a[0] = r; }
};
template <int N> __device__ __forceinline__ float wave_reduce_multi(float (&a)[N], int lane) { RedStep<N, 32, N>::run(a, lane); return a[0]; }
__device__ __forceinline__ void row_proj16x2(const f32x4 (&v0)[4], const f32x4 (&v1)[4], const f32x4* TB, float* sg0, float* sg1, int lane) {
    float a[16], b[16];
#pragma unroll
    for (int c = 0; c < 16; ++c) { a[c] = 0.f; b[c] = 0.f; }
#pragma unroll
    for (int j = 0; j < 4; ++j)
#pragma unroll
        for (int i = 0; i < 4; ++i) { const float x = v0[j][i], y = v1[j][i]; const f32x4* tb = TB + (size_t)((j * 4 + i) * 4) * 64 + lane;
            const f32x4 w0 = tb[0], w1 = tb[64], w2 = tb[128], w3 = tb[192];
#pragma unroll
            for (int c = 0; c < 4; ++c) { a[c] += x * w0[c]; a[4 + c] += x * w1[c]; a[8 + c] += x * w2[c]; a[12 + c] += x * w3[c]; b[c] += y * w0[c]; b[4 + c] += y * w1[c]; b[8 + c] += y * w2[c]; b[12 + c] += y * w3[c]; } }
    const float r0 = wave_reduce_multi<16>(a, lane), r1 = wave_reduce_multi<16>(b, lane);
    if ((lane & 3) == 0) { sg0[lane >> 2] = r0; if (sg1) sg1[lane >> 2] = r1; }
}
__device__ __forceinline__ void row_gate_proj2(Frame& F, const f32x4 (&v0)[4], const f32x4 (&v1)[4], int layer, int m0, int m1) {
    float* sg0 = (float*)(kws() + WS_SG) + (size_t)m0 * 16; float* sg1 = m1 >= 0 ? (float*)(kws() + WS_SG) + (size_t)m1 * 16 : nullptr;
    row_proj16x2(v0, v1, (const f32x4*)(kws() + WS_TAB + (size_t)layer * TAB_LAYER + TAB_GPW), sg0, sg1, F.lane);
}

__device__ __forceinline__ void row_gate_proj2_lds(Frame& F, const f32x4 (&v0)[4], const f32x4 (&v1)[4], const LAS f32x4* TB, int m0, int m1) {
    float* sg0 = (float*)(kws() + WS_SG) + (size_t)m0 * 16; float* sg1 = m1 >= 0 ? (float*)(kws() + WS_SG) + (size_t)m1 * 16 : nullptr;
    float a[16], b[16];
#pragma unroll
    for (int c = 0; c < 16; ++c) { a[c] = 0.f; b[c] = 0.f; }
#pragma unroll
    for (int j = 0; j < 4; ++j)
#pragma unroll
        for (int i = 0; i < 4; ++i) { const float x = v0[j][i], y = v1[j][i]; const LAS f32x4* tb = TB + ((j * 4 + i) * 4) * 64 + F.lane;
            const f32x4 w0 = tb[0], w1 = tb[64], w2 = tb[128], w3 = tb[192];
#pragma unroll
            for (int c = 0; c < 4; ++c) { a[c] += x * w0[c]; a[4 + c] += x * w1[c]; a[8 + c] += x * w2[c]; a[12 + c] += x * w3[c]; b[c] += y * w0[c]; b[4 + c] += y * w1[c]; b[8 + c] += y * w2[c]; b[12 + c] += y * w3[c]; } }
    const float r0 = wave_reduce_multi<16>(a, F.lane), r1 = wave_reduce_multi<16>(b, F.lane);
    if ((F.lane & 3) == 0) { sg0[F.lane >> 2] = r0; if (sg1) sg1[F.lane >> 2] = r1; }
}
struct TDesc { const float* src; bf16* dst; const float* ks; int ldw, ldt; float scale; };
__device__ __forceinline__ void tload(const TDesc& d, int lane, f32x4 (&v)[8]) { const int rs = lane >> 3, c4 = 4 * (lane & 7);
#pragma unroll
    for (int i = 0; i < 8; ++i) v[i] = *(const f32x4*)(d.src + (size_t)(8 * i + rs) * d.ldw + c4);
}
template <bool KS> __device__ __forceinline__ void tfinish(const TDesc& d, const f32x4 (&v)[8], LAS float* scr, int lane) { const int rs = lane >> 3, c4 = 4 * (lane & 7);
#pragma unroll
    for (int i = 0; i < 8; ++i) { const int kk = 8 * i + rs; float sc = d.scale; if constexpr (KS) { if (d.ks) sc *= d.ks[kk]; } LAS float* p = scr + kk * 33 + c4;
        p[0] = v[i][0] * sc; p[1] = v[i][1] * sc; p[2] = v[i][2] * sc; p[3] = v[i][3] * sc; }
    LDS_WAIT(); asm volatile("" ::: "memory");
    const int c = lane & 7;
#pragma unroll
    for (int j = 0; j < 4; ++j) { const int n = (lane >> 3) + 8 * j; const LAS float* s = scr + (8 * c) * 33 + n;
        v4u o; o.x = cvtpk(s[0 * 33], s[1 * 33]); o.y = cvtpk(s[2 * 33], s[3 * 33]); o.z = cvtpk(s[4 * 33], s[5 * 33]); o.w = cvtpk(s[6 * 33], s[7 * 33]);
        *(v4u*)(d.dst + (size_t)n * d.ldt + 8 * c) = o; }
    LDS_WAIT(); asm volatile("" ::: "memory");
}
constexpr int N_WINE = 2 * 2048, N_WINO = 2 * 1792, N_WOE = 2 * 768, N_WOO = 2 * 512, N_GU = 128 * 512, N_D = 128 * 256, N_TITEMS = N_WINE + N_WINO + N_WOE + N_WOO + N_GU + N_D;
__device__ __forceinline__ void tdecode(int it, TDesc& d) {
    bf16* WinE = (bf16*)(kws() + WS_WINE); bf16* WinO = (bf16*)(kws() + WS_WINO); bf16* WoutE = (bf16*)(kws() + WS_WOUTE); bf16* WoutO = (bf16*)(kws() + WS_WOUTO);
    bf16* Wgu = (bf16*)(kws() + WS_WGU); bf16* Wd = (bf16*)(kws() + WS_WD);
    int r = it; d.ks = nullptr; d.scale = 1.f;
    if (r < N_WINE) { const int j = r / 2048, q = r % 2048, kb = q / 128, nb = q % 128;
        d.src = KIN(I_ABWIN) + (size_t)j * D * AB_IN + (size_t)(64 * kb) * AB_IN + 32 * nb; d.ldw = AB_IN; d.dst = WinE + (size_t)j * NPE * D + (size_t)(32 * nb) * D + 64 * kb; d.ldt = D; return; } r -= N_WINE;
    if (r < N_WINO) { const int j = r / 1792, q = r % 1792, seg = q / 256, q2 = q % 256, kb = q2 / 16, nb = q2 % 16;
        const int scol = (seg < 3 ? 512 * seg : 1544 + 512 * (seg - 3)) + 32 * nb; d.scale = seg == 1 ? MLSTM_KSCALE : (seg == 4 ? FOX_C2 : 1.f);
        d.src = KIN(I_CDWIN) + (size_t)j * D * CD_IN + (size_t)(64 * kb) * CD_IN + scol; d.ldw = CD_IN; d.dst = WinO + (size_t)j * NPO * D + (size_t)(512 * seg + 32 * nb) * D + 64 * kb; d.ldt = D; return; } r -= N_WINO;
    if (r < N_WOE) { const int j = r / 768, q = r % 768, kb = q / 32, nb = q % 32;
        d.ks = kb >= 8 ? KIN(I_NORMW) + (size_t)j * 1024 + (64 * kb - 512) : nullptr;
        d.src = KIN(I_ABWOUT) + (size_t)j * 1536 * D + (size_t)(64 * kb) * D + 32 * nb; d.ldw = D; d.dst = WoutE + (size_t)j * D * 1536 + (size_t)(32 * nb) * 1536 + 64 * (kb < 8 ? kb + 16 : kb - 8); d.ldt = 1536; return; } r -= N_WOE;
    if (r < N_WOO) { const int j = r / 512, q = r % 512, kb = q / 32, nb = q % 32;
        d.src = KIN(I_CDWOUT) + (size_t)j * D * D + (size_t)(64 * kb) * D + 32 * nb; d.ldw = D; d.dst = WoutO + (size_t)j * D * D + (size_t)(32 * nb) * D + 64 * kb; d.ldt = D; return; } r -= N_WOO;
    if (r < N_GU) { const int le = r / 512, q = r % 512, half = q / 256, q2 = q % 256, kb = q2 % 16, nb = q2 / 16, n0 = 32 * nb;
        d.src = (half ? KIN(I_WU) : KIN(I_WG)) + (size_t)le * D * 512 + (size_t)(64 * kb) * 512 + n0; d.ldw = 512;
        d.dst = Wgu + (size_t)le * D * D + (size_t)(256 * (n0 / 128) + 128 * half + (n0 % 128)) * D + 64 * kb; d.ldt = D; return; } r -= N_GU;
    { const int le = r / 256, q = r % 256, kb = q % 8, nb = q / 8;
        d.src = KIN(I_WDN) + (size_t)le * 512 * D + (size_t)(64 * kb) * D + 32 * nb; d.ldw = D; d.dst = Wd + (size_t)le * D * 512 + (size_t)(32 * nb) * 512 + 64 * kb; d.ldt = 512; }
}
__device__ __forceinline__ void p_prologue(Frame& F0) {   Frame F = F0; { int t_ = threadIdx.x; asm volatile("" : "+v"(t_)); F.tid = t_; F.lane = t_ & 63; }
    LAS float* scr = (LAS float*)(F.lds + F.wave * 16384);
    constexpr int KS_LO = N_WINE + N_WINO, KS_HI = KS_LO + N_WOE, N_PIPE = N_TITEMS - N_WOE;
#define PIPE_ITEM(q_) ((q_) < KS_LO ? (q_) : (q_) + N_WOE)
    { int q = F.gw; TDesc dA, dB; f32x4 vA[8], vB[8];
        { const int qc = q < N_PIPE ? q : N_PIPE - 1; tdecode(PIPE_ITEM(qc), dA); tload(dA, F.lane, vA); }
#pragma unroll 1
        while (q < N_PIPE) {
            const int qn = q + F.NGW; { const int qc = qn < N_PIPE ? qn : N_PIPE - 1; tdecode(PIPE_ITEM(qc), dB); tload(dB, F.lane, vB); }
            tfinish<false>(dA, vA, scr, F.lane);
            if (qn >= N_PIPE) break;
            q = qn + F.NGW; { const int qc = q < N_PIPE ? q : N_PIPE - 1; tdecode(PIPE_ITEM(qc), dA); tload(dA, F.lane, vA); }
            tfinish<false>(dB, vB, scr, F.lane); } }
#undef PIPE_ITEM
    asm volatile("s_waitcnt vmcnt(0)" ::: "memory");
    for (int it = KS_LO + F.gw; it < KS_HI; it += F.NGW) { TDesc d; f32x4 v[8]; tdecode(it, d); tload(d, F.lane, v); tfinish<true>(d, v, scr, F.lane); }
    for (int e = F.vcu * 512 + F.tid; e < DEPTH * 13312; e += F.G * 512) { const int L = e / 13312, r = e % 13312, ln = r & 63; f32x4* tab = (f32x4*)(kws() + WS_TAB + (size_t)L * TAB_LAYER);
        if (r < 4096) { const int ch = (r >> 6) & 3, ji = r >> 8, k = 256 * (ji >> 2) + 4 * ln + (ji & 3); const int jj = L >> 1;
            const float* src = (L & 1) ? KIN(I_CDWIN) + (size_t)jj * D * CD_IN + (size_t)k * CD_IN + (ch < 2 ? 1536 + 4 * ch : 3592 + 4 * (ch - 2)) : KIN(I_ABWIN) + (size_t)jj * D * AB_IN + (size_t)k * AB_IN + 4096 + 4 * ch;
            tab[TAB_GPW / 16 + r] = *(const f32x4*)src; }
        else if (r < 5120) { const int q = r - 4096, ji = q >> 6, k = 256 * (ji >> 2) + 4 * ln + (ji & 3); tab[TAB_RGW / 16 + q] = *(const f32x4*)(KIN(I_RGW) + (size_t)L * D * 4 + (size_t)k * 4); }
        else { const int q = r - 5120, half = (q >> 6) & 1, ji = (q >> 7) & 15, g = q >> 11, k = 256 * (ji >> 2) + 4 * ln + (ji & 3); tab[TAB_REW / 16 + q] = *(const f32x4*)(KIN(I_REW) + ((size_t)(L * 4 + g) * D + k) * 8 + 4 * half); } }
    bf16* HB = (bf16*)(kws() + WS_HB);
    __syncthreads();
    LAS f32x4* TBL = (LAS f32x4*)F.lds;
    for (int r = F.tid; r < 4096; r += 512) { const int ln = r & 63, ch = (r >> 6) & 3, ji = r >> 8, k = 256 * (ji >> 2) + 4 * ln + (ji & 3); TBL[r] = *(const f32x4*)(KIN(I_ABWIN) + (size_t)k * AB_IN + 4096 + 4 * ch); }
    __syncthreads();
#pragma unroll 1
    for (int m0 = F.gw; m0 < T; m0 += 2 * F.NGW) { const int m1 = m0 + F.NGW < T ? m0 + F.NGW : -1, m1c = m1 >= 0 ? m1 : m0; f32x4 v0[4], v1[4];
        row_load(KIN(I_X) + (size_t)m0 * D, F.lane, v0); row_load(KIN(I_X) + (size_t)m1c * D, F.lane, v1);
        row_store_bf16(HB + (size_t)m0 * D, F.lane, v0); if (m1 >= 0) row_store_bf16(HB + (size_t)m1 * D, F.lane, v1);
        row_gate_proj2_lds(F, v0, v1, TBL, m0, m1); }
}
__device__ __forceinline__ void e0_conv(Frame& F0, int j) {   Frame F = F0; { int t_ = threadIdx.x; asm volatile("" : "+v"(t_)); F.tid = t_; F.lane = t_ & 63; }
    const bf16* P = (const bf16*)(kws() + WS_R1); bf16* XBC = (bf16*)(kws() + WS_R3); bf16* MIX = (bf16*)(kws() + WS_MIX);
    const float* cw = KIN(I_CONVW) + (size_t)j * 4 * 1536; const float* cb = KIN(I_CONVB) + (size_t)j * 1536; const float* ca = KIN(I_CONVA) + (size_t)j * 3 * 512;
    constexpr int TT = 16;
    for (int it = F.gw; it < (T / TT) * 16; it += F.NGW) {
        const int tt = it >> 4, cg = it & 15, t0 = tt * TT, s0 = t0 & (SEQ - 1);
        if (cg < 12) {
            const int c = cg * 128 + 2 * F.lane;
            float w0[4], w1[4];
#pragma unroll
            for (int k = 0; k < 4; ++k) { w0[k] = cw[k * 1536 + c]; w1[k] = cw[k * 1536 + c + 1]; }
            const float b0 = cb[c], b1 = cb[c + 1];
            float xa[TT + 3], xb[TT + 3];
#pragma unroll
            for (int r = 0; r < TT + 3; ++r) { unsigned w = 0u; if (s0 - 3 + r >= 0) w = *(const unsigned*)(P + (size_t)(t0 - 3 + r) * NPE + 2560 + c); xa[r] = bflo(w); xb[r] = bfhi(w); }
#pragma unroll
            for (int o = 0; o < TT; ++o) { float a0 = b0, a1 = b1;
#pragma unroll
                for (int k = 0; k < 4; ++k) { a0 += w0[k] * xa[o + k]; a1 += w1[k] * xb[o + k]; }
                *(unsigned*)(XBC + (size_t)(t0 + o) * 1536 + c) = pk2(silu_f(a0), silu_f(a1)); }
        } else {
            const int c = (cg - 12) * 128 + 2 * F.lane;
            float w0[3], w1[3];
#pragma unroll
            for (int k = 0; k < 3; ++k) { w0[k] = ca[k * 512 + c]; w1[k] = ca[k * 512 + c + 1]; }
            float ua[TT + 2], ub[TT + 2]; unsigned bgw[TT];
#pragma unroll
            for (int o = 0; o < TT; ++o) bgw[o] = *(const unsigned*)(P + (size_t)(t0 + o) * NPE + c);
#pragma unroll
            for (int r = 0; r < TT + 2; ++r) { float a = 0.f, b = 0.f;
                if (s0 - 2 + r >= 0) { const bf16* pr = P + (size_t)(t0 - 2 + r) * NPE; const unsigned cgw = *(const unsigned*)(pr + 512 + c), xw = *(const unsigned*)(pr + 1024 + c); a = bflo(cgw) * bflo(xw); b = bfhi(cgw) * bfhi(xw); }
                ua[r] = a; ub[r] = b; }
#pragma unroll
            for (int o = 0; o < TT; ++o) { float a0 = 0.f, a1 = 0.f;
#pragma unroll
                for (int k = 0; k < 3; ++k) { a0 += w0[k] * ua[o + k]; a1 += w1[k] * ub[o + k]; }
                const unsigned bg = bgw[o];
                *(unsigned*)(MIX + (size_t)(t0 + o) * 1536 + 1024 + c) = pk2(bflo(bg) * a0, bfhi(bg) * a1); }
        }
    }
}
__device__ __forceinline__ void ssd_gates(Frame& F, int j, int t0, int h, LAS float* dtl, LAS float* acs) {
    if (F.wave == 0) {
        const float* SG = (const float*)(kws() + WS_SG); const float dtb = KIN(I_DTB)[j * 16 + h], aneg = -expf(KIN(I_ALOG)[j * 16 + h]);
        const float d0 = softplus_f(SG[(size_t)(t0 + 2 * F.lane) * 16 + h] + dtb), d1 = softplus_f(SG[(size_t)(t0 + 2 * F.lane + 1) * 16 + h] + dtb);
        const float a0 = d0 * aneg, a1 = d1 * aneg; const float inc = wave_scan_sum(a0 + a1, F.lane);
        dtl[2 * F.lane] = d0; dtl[2 * F.lane + 1] = d1; acs[2 * F.lane] = inc - a1; acs[2 * F.lane + 1] = inc;
    }
}
__device__ __forceinline__ void e1_states(Frame& F0, int j) {   Frame F = F0; { int t_ = threadIdx.x; asm volatile("" : "+v"(t_)); F.tid = t_; F.lane = t_ & 63; }
    const bf16* XBC = (const bf16*)(kws() + WS_R3); float* ST = (float*)(kws() + WS_R4); float* DEC = (float*)(kws() + WS_DEC);
    LAS float* xw = (LAS float*)F.lds; LAS float* Bm = (LAS float*)(F.lds + 32768); LAS float* dtl = (LAS float*)(F.lds + SMALL_OFF); LAS float* acs = dtl + 128;
    for (int u = F.vcu; u < 2048; u += F.G) {
        const int b = u >> 8, c = (u >> 4) & 15, h = u & 15, g = h >> 2, t0 = b * SEQ + c * 128;
        __syncthreads();
        ssd_gates(F, j, t0, h, dtl, acs);
        __syncthreads();
        for (int i = F.tid; i < 128 * 32; i += 512) { const int l = i >> 5, pp = (i & 31) * 2; const float wgt = expf(acs[127] - acs[l]) * dtl[l];
            const unsigned xv = *(const unsigned*)(XBC + (size_t)(t0 + l) * 1536 + h * 64 + pp), bv = *(const unsigned*)(XBC + (size_t)(t0 + l) * 1536 + 1024 + g * 64 + pp);
            xw[l * 64 + pp] = bflo(xv) * wgt; xw[l * 64 + pp + 1] = bfhi(xv) * wgt; Bm[l * 64 + pp] = bflo(bv); Bm[l * 64 + pp + 1] = bfhi(bv); }
        __syncthreads();
        const int n = F.lane, p0 = 8 * F.wave; float acc[8];
#pragma unroll
        for (int i = 0; i < 8; ++i) acc[i] = 0.f;
#pragma unroll 2
        for (int l = 0; l < 128; ++l) { const float bm = Bm[l * 64 + n]; const f32x4 x0 = *(const LAS f32x4*)(xw + l * 64 + p0), x1 = *(const LAS f32x4*)(xw + l * 64 + p0 + 4);
#pragma unroll
            for (int i = 0; i < 4; ++i) { acc[i] += x0[i] * bm; acc[4 + i] += x1[i] * bm; } }
        float* dst = ST + (size_t)u * 4096;
#pragma unroll
        for (int i = 0; i < 8; ++i) dst[(p0 + i) * 64 + n] = acc[i];
        if (F.tid == 0) DEC[u] = expf(acs[127]);
    }
}
__device__ __forceinline__ void e2_scan(Frame& F0) {   Frame F = F0; { int t_ = threadIdx.x; asm volatile("" : "+v"(t_)); F.tid = t_; F.lane = t_ & 63; }
    float* ST = (float*)(kws() + WS_R4); const float* DEC = (const float*)(kws() + WS_DEC);
    for (int e = F.vcu * 512 + F.tid; e < NBATCH * 16 * 4096; e += F.G * 512) {
        const int b = e >> 16, h = (e >> 12) & 15, pn = e & 4095; float run = 0.f; float s[16], dc[16];
#pragma unroll
        for (int c = 0; c < 16; ++c) { const int u = (b * 16 + c) * 16 + h; s[c] = ST[(size_t)u * 4096 + pn]; dc[c] = DEC[u]; }
#pragma unroll
        for (int c = 0; c < 16; ++c) { const int u = (b * 16 + c) * 16 + h; ST[(size_t)u * 4096 + pn] = run; run = run * dc[c] + s[c]; }
    }
}
__device__ __forceinline__ void e3_output(Frame& F0, int j) {   Frame F = F0; { int t_ = threadIdx.x; asm volatile("" : "+v"(t_)); F.tid = t_; F.lane = t_ & 63; }
    const bf16* XBC = (const bf16*)(kws() + WS_R3); const float* ST = (const float*)(kws() + WS_R4); float* Y = (float*)(kws() + WS_R2);
    LAS float* R0 = (LAS float*)F.lds;
    LAS float* R1 = (LAS float*)(F.lds + 32768);
    LAS float* R2 = (LAS float*)(F.lds + 65536);
    LAS float* dtl = (LAS float*)(F.lds + SMALL_OFF); LAS float* acs = dtl + 128;
    for (int u = F.vcu; u < 2048; u += F.G) {
        const int b = u >> 8, c = (u >> 4) & 15, h = u & 15, g = h >> 2, t0 = b * SEQ + c * 128;
        __syncthreads();
        ssd_gates(F, j, t0, h, dtl, acs);
        for (int i = F.tid; i < 128 * 32; i += 512) { const int l = i >> 5, nn = (i & 31) * 2;
            const unsigned bv = *(const unsigned*)(XBC + (size_t)(t0 + l) * 1536 + 1024 + g * 64 + nn), cv = *(const unsigned*)(XBC + (size_t)(t0 + l) * 1536 + 1280 + g * 64 + nn);
            R0[l * 64 + nn] = bflo(cv); R0[l * 64 + nn + 1] = bfhi(cv); R1[nn * 128 + l] = bflo(bv); R1[(nn + 1) * 128 + l] = bfhi(bv); }
        { const float* hp = ST + (size_t)u * 4096; for (int i = F.tid; i < 4096; i += 512) { const int p = i >> 6, n = i & 63; R2[n * 64 + p] = hp[i]; } }
        __syncthreads();
        const int p = F.lane, l0 = 16 * F.wave; float acc[16];
#pragma unroll
        for (int i = 0; i < 16; ++i) acc[i] = 0.f;
#pragma unroll 1
        for (int n0 = 0; n0 < 64; n0 += 4) { float hp[4];
#pragma unroll
            for (int i = 0; i < 4; ++i) hp[i] = R2[(n0 + i) * 64 + p];
#pragma unroll
            for (int li = 0; li < 16; ++li) { const f32x4 c4 = *(const LAS f32x4*)(R0 + (l0 + li) * 64 + n0); acc[li] += (c4[0] * hp[0] + c4[1] * hp[1]) + (c4[2] * hp[2] + c4[3] * hp[3]); } }
#pragma unroll
        for (int li = 0; li < 16; ++li) acc[li] *= expf(acs[l0 + li]);
        __syncthreads();
#pragma unroll 1
        for (int half = 0; half < 2; ++half) { const int s = F.tid & 127, lg = 32 * (F.tid >> 7) + 16 * half; float gacc[16];
#pragma unroll
            for (int i = 0; i < 16; ++i) gacc[i] = 0.f;
#pragma unroll 1
            for (int n0 = 0; n0 < 64; n0 += 4) { float bb[4];
#pragma unroll
                for (int i = 0; i < 4; ++i) bb[i] = R1[(n0 + i) * 128 + s];
#pragma unroll
                for (int li = 0; li < 16; ++li) { const f32x4 c4 = *(const LAS f32x4*)(R0 + (lg + li) * 64 + n0); gacc[li] += (c4[0] * bb[0] + c4[1] * bb[1]) + (c4[2] * bb[2] + c4[3] * bb[3]); } }
            const float as = acs[s];
#pragma unroll
            for (int li = 0; li < 16; ++li) { const int l = lg + li; R2[l * 128 + s] = (s <= l) ? gacc[li] * expf(acs[l] - as) : 0.f; } }
        __syncthreads();
        for (int i = F.tid; i < 128 * 32; i += 512) { const int l = i >> 5, pp = (i & 31) * 2; const unsigned xv = *(const unsigned*)(XBC + (size_t)(t0 + l) * 1536 + h * 64 + pp);
            R0[l * 64 + pp] = bflo(xv); R0[l * 64 + pp + 1] = bfhi(xv); }
        __syncthreads();
#pragma unroll 1
        for (int s0 = 0; s0 < l0 + 16; s0 += 4) { float xv[4];
#pragma unroll
            for (int i = 0; i < 4; ++i) xv[i] = R0[(s0 + i) * 64 + p] * dtl[s0 + i];
#pragma unroll
            for (int li = 0; li < 16; ++li) { const f32x4 g4 = *(const LAS f32x4*)(R2 + (l0 + li) * 128 + s0); acc[li] += (g4[0] * xv[0] + g4[1] * xv[1]) + (g4[2] * xv[2] + g4[3] * xv[3]); } }
        const float dsk = KIN(I_DSKIP)[j * 16 + h];
#pragma unroll
        for (int li = 0; li < 16; ++li) Y[(size_t)(t0 + l0 + li) * D + h * 64 + p] = acc[li] + dsk * R0[(l0 + li) * 64 + p];
    }
}
__device__ __forceinline__ void e4_gnorm(Frame& F0) {   Frame F = F0; { int t_ = threadIdx.x; asm volatile("" : "+v"(t_)); F.tid = t_; F.lane = t_ & 63; }
    const float* Y = (const float*)(kws() + WS_R2); const bf16* P = (const bf16*)(kws() + WS_R1); bf16* MIX = (bf16*)(kws() + WS_MIX);
#pragma unroll 1
    for (int m0 = F.gw; m0 < T; m0 += 2 * F.NGW) { const int m1 = m0 + F.NGW < T ? m0 + F.NGW : m0; const int mm[2] = {m0, m1}; f32x4 y[2][4], z[2][4]; float rstd[2];
#pragma unroll
        for (int rr = 0; rr < 2; ++rr) { row_load(Y + (size_t)mm[rr] * D, F.lane, y[rr]); row_load_bf16(P + (size_t)mm[rr] * NPE + 1536, F.lane, z[rr]); }
#pragma unroll
        for (int rr = 0; rr < 2; ++rr) { float ss = 0.f;
#pragma unroll
            for (int jj = 0; jj < 4; ++jj)
#pragma unroll
                for (int i = 0; i < 4; ++i) { const float uu = y[rr][jj][i] * silu_f(z[rr][jj][i]); y[rr][jj][i] = uu; ss += uu * uu; }
            rstd[rr] = 1.0f / sqrtf(wave_sum(ss) * (1.f / D) + LN_EPS); }
#pragma unroll
        for (int rr = 0; rr < 2; ++rr) {
#pragma unroll
            for (int jj = 0; jj < 4; ++jj) y[rr][jj] = y[rr][jj] * rstd[rr];
            if (rr == 0 || m1 != m0) row_store_bf16(MIX + (size_t)mm[rr] * 1536 + 512, F.lane, y[rr]); } }
}
__device__ __forceinline__ void o_foxscan(Frame& F0, int j) {   Frame F = F0; { int t_ = threadIdx.x; asm volatile("" : "+v"(t_)); F.tid = t_; F.lane = t_ & 63; }
    const float* SG = (const float*)(kws() + WS_SG); float* FOXC = (float*)(kws() + WS_FOXC);
    for (int bh = F.gw; bh < 64; bh += F.NGW) { const int b = bh >> 3, h = bh & 7; const float bias = KIN(I_FOXB)[j * 8 + h];
        float v[32], run = 0.f;
#pragma unroll
        for (int i = 0; i < 32; ++i) { run += logsigmoid_f(SG[(size_t)(b * SEQ + 32 * F.lane + i) * 16 + 8 + h] + bias); v[i] = run; }
        const float off = wave_scan_sum(run, F.lane) - run;
#pragma unroll
        for (int i = 0; i < 32; ++i) FOXC[(size_t)bh * SEQ + 32 * F.lane + i] = (v[i] + off) * LOG2E; }
}
__device__ __forceinline__ void mlstm_gates(Frame& F, int j, int t0, int h, float& bcum, float& ib) {
    const float* SG = (const float*)(kws() + WS_SG);
    ib = SG[(size_t)(t0 + F.lane) * 16 + h] + KIN(I_IB)[j * 4 + h];
    bcum = wave_scan_sum(logsigmoid_f(SG[(size_t)(t0 + F.lane) * 16 + 4 + h] + KIN(I_FB)[j * 4 + h]), F.lane);
}
__device__ __forceinline__ void o1_local(Frame& F0, int j) {   Frame F = F0; { int t_ = threadIdx.x; asm volatile("" : "+v"(t_)); F.tid = t_; F.lane = t_ & 63; }
    const bf16* P = (const bf16*)(kws() + WS_R1); float* KLOC = (float*)(kws() + WS_R2); float* NLOC = (float*)(kws() + WS_NLOC); float* MLOC = (float*)(kws() + WS_MLOC); float* BLAST = (float*)(kws() + WS_BLAST);
    LAS float* kw = (LAS float*)F.lds; LAS float* Vs = (LAS float*)(F.lds + 32768); LAS float* wk = (LAS float*)(F.lds + SMALL_OFF);
    for (int u = F.vcu; u < 1024; u += F.G) {
        const int b = u >> 7, h = (u >> 5) & 3, c = u & 31, t0 = b * SEQ + c * 64;
        __syncthreads();
        if (F.wave == 0) { float bcum, ib; mlstm_gates(F, j, t0, h, bcum, ib); const float blast = __shfl(bcum, 63); const float gl = blast - bcum + ib; const float ml = wave_max(gl);
            wk[F.lane] = expf(gl - ml); if (F.lane == 0) { MLOC[u] = ml; BLAST[u] = blast; } }
        __syncthreads();
        for (int i = F.tid; i < 64 * 64; i += 512) { const int s = i >> 6, dd = (i & 63) * 2; const float w = wk[s];
            const unsigned kv = *(const unsigned*)(P + (size_t)(t0 + s) * NPO + 512 + h * 128 + dd), vv = *(const unsigned*)(P + (size_t)(t0 + s) * NPO + 1024 + h * 128 + dd);
            kw[s * 128 + dd] = bflo(kv) * w; kw[s * 128 + dd + 1] = bfhi(kv) * w; Vs[s * 128 + dd] = bflo(vv); Vs[s * 128 + dd + 1] = bfhi(vv); }
        __syncthreads();
        const int v = F.tid & 127, d0 = 32 * (F.tid >> 7); float acc[32];
#pragma unroll
        for (int i = 0; i < 32; ++i) acc[i] = 0.f;
#pragma unroll 1
        for (int s = 0; s < 64; ++s) { const float vv = Vs[s * 128 + v];
#pragma unroll
            for (int di = 0; di < 32; di += 4) { const f32x4 k4 = *(const LAS f32x4*)(kw + s * 128 + d0 + di);
#pragma unroll
                for (int i = 0; i < 4; ++i) acc[di + i] += k4[i] * vv; } }
        float* dst = KLOC + (size_t)u * 16384;
#pragma unroll
        for (int i = 0; i < 32; ++i) dst[(d0 + i) * 128 + v] = acc[i];
        if (F.tid < 128) { float a = 0.f; for (int s = 0; s < 64; ++s) a += kw[s * 128 + F.tid]; NLOC[(size_t)u * 128 + F.tid] = a; }
    }
}
__device__ __forceinline__ void o2_scan(Frame& F0) {   Frame F = F0; { int t_ = threadIdx.x; asm volatile("" : "+v"(t_)); F.tid = t_; F.lane = t_ & 63; }
    float* KLOC = (float*)(kws() + WS_R2); float* NLOC = (float*)(kws() + WS_NLOC); const float* MLOC = (const float*)(kws() + WS_MLOC); const float* BLAST = (const float*)(kws() + WS_BLAST); float* MPREV = (float*)(kws() + WS_MPREV);
    constexpr int PER = 16384 + 128;
    for (int e = F.vcu * 512 + F.tid; e < 32 * PER; e += F.G * 512) {
        const int bh = e / PER, r = e % PER; float run = 0.f, m = 0.f;
#pragma unroll 1
        for (int c0 = 0; c0 < 32; c0 += 16) { float loc[16], bl[16], ml[16];
#pragma unroll
            for (int i = 0; i < 16; ++i) { const int u = bh * 32 + c0 + i; const float* p = r < 16384 ? KLOC + (size_t)u * 16384 + r : NLOC + (size_t)u * 128 + (r - 16384); loc[i] = *p; bl[i] = BLAST[u]; ml[i] = MLOC[u]; }
#pragma unroll
            for (int i = 0; i < 16; ++i) { const int u = bh * 32 + c0 + i; float* p = r < 16384 ? KLOC + (size_t)u * 16384 + r : NLOC + (size_t)u * 128 + (r - 16384);
                *p = run; if (r == 0) MPREV[u] = m;
                const float mn = fmaxf(bl[i] + m, ml[i]);
                run = expf(bl[i] + m - mn) * run + expf(ml[i] - mn) * loc[i]; m = mn; } }
    }
}
__device__ __forceinline__ void o3_output(Frame& F0, int j) {   Frame F = F0; { int t_ = threadIdx.x; asm volatile("" : "+v"(t_)); F.tid = t_; F.lane = t_ & 63; }
    const bf16* P = (const bf16*)(kws() + WS_R1); const float* CPREV = (const float*)(kws() + WS_R2); const float* NPREV = (const float*)(kws() + WS_NLOC); const float* MPREV = (const float*)(kws() + WS_MPREV); bf16* MIX = (bf16*)(kws() + WS_MIX);
    LAS float* qT = (LAS float*)F.lds;
    LAS float* kT = (LAS float*)(F.lds + 32768);
    LAS float* Vs = (LAS float*)(F.lds + 65536);
    LAS float* WT = (LAS float*)(F.lds + 98304);
    LAS float* sm = (LAS float*)(F.lds + SMALL_OFF);
    for (int u = F.vcu; u < 1024; u += F.G) {
        const int b = u >> 7, h = (u >> 5) & 3, c = u & 31, t0 = b * SEQ + c * 64;
        __syncthreads();
        if (F.wave == 0) { float bcum, ib; mlstm_gates(F, j, t0, h, bcum, ib); const float mprev = MPREV[u];
            const float pm = wave_scan_max(ib - bcum, F.lane); const float inter = bcum + mprev; const float mt = fmaxf(bcum + pm, inter);
            sm[F.lane] = bcum; sm[64 + F.lane] = ib; sm[128 + F.lane] = mt; sm[192 + F.lane] = expf(inter - mt); }
        for (int i = F.tid; i < 64 * 64; i += 512) { const int s = i >> 6, dd = (i & 63) * 2; const bf16* pr = P + (size_t)(t0 + s) * NPO + h * 128 + dd;
            const unsigned qv = *(const unsigned*)pr, kv = *(const unsigned*)(pr + 512), vv = *(const unsigned*)(pr + 1024);
            qT[dd * 64 + s] = bflo(qv); qT[(dd + 1) * 64 + s] = bfhi(qv); kT[dd * 64 + s] = bflo(kv); kT[(dd + 1) * 64 + s] = bfhi(kv); Vs[s * 128 + dd] = bflo(vv); Vs[s * 128 + dd + 1] = bfhi(vv); }
        __syncthreads();
        { const int s = F.lane, l0 = 8 * F.wave; float acc[8];
#pragma unroll
            for (int i = 0; i < 8; ++i) acc[i] = 0.f;
#pragma unroll 2
            for (int d = 0; d < 128; ++d) { const float kk = kT[d * 64 + s]; const f32x4 q0 = *(const LAS f32x4*)(qT + d * 64 + l0), q1 = *(const LAS f32x4*)(qT + d * 64 + l0 + 4);
#pragma unroll
                for (int i = 0; i < 4; ++i) { acc[i] += q0[i] * kk; acc[4 + i] += q1[i] * kk; } }
            const float gs = sm[64 + s] - sm[s];
#pragma unroll
            for (int i = 0; i < 8; ++i) { const int l = l0 + i; const float w = (s <= l) ? acc[i] * expf(sm[l] + gs - sm[128 + l]) : 0.f; WT[s * 64 + l] = w; const float dsum = wave_sum(w); if (F.lane == 0) sm[256 + l] = dsum; } }
        __syncthreads();
        if (F.tid < 64) { const int l = F.tid; float qn = 0.f; const float* np = NPREV + (size_t)u * 128; for (int d = 0; d < 128; ++d) qn += qT[d * 64 + l] * np[d]; sm[256 + l] += sm[192 + l] * qn; }
        const int v = F.tid & 127, l0 = 16 * (F.tid >> 7); float acc[16];
#pragma unroll
        for (int i = 0; i < 16; ++i) acc[i] = 0.f;
        { const float* cp = CPREV + (size_t)u * 16384;
#pragma unroll 2
            for (int d = 0; d < 128; ++d) { const float cc = cp[d * 128 + v];
#pragma unroll
                for (int li = 0; li < 16; li += 4) { const f32x4 q4 = *(const LAS f32x4*)(qT + d * 64 + l0 + li);
#pragma unroll
                    for (int i = 0; i < 4; ++i) acc[li + i] += q4[i] * cc; } } }
#pragma unroll
        for (int i = 0; i < 16; ++i) acc[i] *= sm[192 + l0 + i];
#pragma unroll 2
        for (int s = 0; s < 64; ++s) { const float vv = Vs[s * 128 + v];
#pragma unroll
            for (int li = 0; li < 16; li += 4) { const f32x4 w4 = *(const LAS f32x4*)(WT + s * 64 + l0 + li);
#pragma unroll
                for (int i = 0; i < 4; ++i) acc[li + i] += w4[i] * vv; } }
        __syncthreads();
        LAS float* hb = kT;
#pragma unroll
        for (int i = 0; i < 16; ++i) { const int l = l0 + i; const float hv = acc[i] / fmaxf(fabsf(sm[256 + l]), expf(-sm[128 + l])); acc[i] = hv; hb[l * 128 + v] = hv; }
        __syncthreads();
        { const int lb = 8 * F.wave;
#pragma unroll
            for (int i = 0; i < 8; ++i) { const int l = lb + i; const float a = hb[l * 128 + F.lane], bq = hb[l * 128 + 64 + F.lane]; const float mu = wave_sum(a + bq) * (1.f / 128.f);
                const float da = a - mu, db = bq - mu; const float var = wave_sum(da * da + db * db) * (1.f / 128.f); if (F.lane == 0) { sm[320 + l] = mu; sm[384 + l] = 1.0f / sqrtf(var + LN_EPS); } } }
        __syncthreads();
        const float hw = KIN(I_HNW)[j * 512 + h * 128 + v];
#pragma unroll
        for (int i = 0; i < 16; ++i) { const int l = l0 + i; const float og = sigmoid_f(bf2f(P[(size_t)(t0 + l) * NPO + 1536 + h * 128 + v]));
            MIX[(size_t)(t0 + l) * D + h * 128 + v] = (bf16)f2bf(og * (acc[i] - sm[320 + l]) * sm[384 + l] * hw); }
    }
}
__device__ __forceinline__ void o4_fox(Frame& F0) {   Frame F = F0; { int t_ = threadIdx.x; asm volatile("" : "+v"(t_)); F.tid = t_; F.lane = t_ & 63; }
    const bf16* P = (const bf16*)(kws() + WS_R1); const float* FOXC = (const float*)(kws() + WS_FOXC); bf16* MIX = (bf16*)(kws() + WS_MIX);
    LAS float* QT = (LAS float*)F.lds;
    LAS float* KT = (LAS float*)(F.lds + 16384);
    LAS float* Vs = (LAS float*)(F.lds + 32768);
    LAS float* PT = (LAS float*)(F.lds + 49152) + F.wave * 512;
    LAS float* cq = (LAS float*)(F.lds + SMALL_OFF); LAS float* ck = cq + 64;
    for (int it = F.vcu; it < 2048; it += F.G) {
        const int qt = 31 - (it >> 6), bh = it & 63, b = bh >> 3, h = bh & 7, tq0 = b * SEQ + qt * 64;
        __syncthreads();
        for (int i = F.tid; i < 64 * 32; i += 512) { const int q = i >> 5, dd = (i & 31) * 2; const unsigned w = *(const unsigned*)(P + (size_t)(tq0 + q) * NPO + 2048 + h * 64 + dd); QT[dd * 64 + q] = bflo(w); QT[(dd + 1) * 64 + q] = bfhi(w); }
        if (F.tid < 64) cq[F.tid] = FOXC[(size_t)bh * SEQ + qt * 64 + F.tid];
        const int q0 = 8 * F.wave; float mrun[8], lrun[8], o[8];
#pragma unroll
        for (int i = 0; i < 8; ++i) { mrun[i] = -INFINITY; lrun[i] = 0.f; o[i] = 0.f; }
#pragma unroll 1
        for (int kt = 0; kt <= qt; ++kt) { const int tk0 = b * SEQ + kt * 64;
            __syncthreads();
            for (int i = F.tid; i < 64 * 32; i += 512) { const int k = i >> 5, dd = (i & 31) * 2; const bf16* pr = P + (size_t)(tk0 + k) * NPO + h * 64 + dd; const unsigned kw = *(const unsigned*)(pr + 2560), vw = *(const unsigned*)(pr + 3072);
                KT[dd * 64 + k] = bflo(kw); KT[(dd + 1) * 64 + k] = bfhi(kw); Vs[k * 64 + dd] = bflo(vw); Vs[k * 64 + dd + 1] = bfhi(vw); }
            if (F.tid < 64) ck[F.tid] = FOXC[(size_t)bh * SEQ + kt * 64 + F.tid];
            __syncthreads();
            float s[8];
#pragma unroll
            for (int i = 0; i < 8; ++i) s[i] = 0.f;
#pragma unroll 2
            for (int d = 0; d < 64; ++d) { const float kk = KT[d * 64 + F.lane]; const f32x4 qa = *(const LAS f32x4*)(QT + d * 64 + q0), qb = *(const LAS f32x4*)(QT + d * 64 + q0 + 4);
#pragma unroll
                for (int i = 0; i < 4; ++i) { s[i] += qa[i] * kk; s[4 + i] += qb[i] * kk; } }
            const float ckv = ck[F.lane];
#pragma unroll
            for (int i = 0; i < 8; ++i) { float sv = s[i] + cq[q0 + i] - ckv; if (kt == qt && F.lane > q0 + i) sv = -INFINITY;
                const float mn = fmaxf(mrun[i], wave_max(sv)); const float p = exp2f(sv - mn), al = exp2f(mrun[i] - mn);
                lrun[i] = lrun[i] * al + wave_sum(p); o[i] *= al; mrun[i] = mn; PT[F.lane * 8 + i] = p; }
            LDS_WAIT(); asm volatile("" ::: "memory");
#pragma unroll 2
            for (int k = 0; k < 64; ++k) { const float vv = Vs[k * 64 + F.lane]; const f32x4 pa = *(const LAS f32x4*)(PT + k * 8), pb = *(const LAS f32x4*)(PT + k * 8 + 4);
#pragma unroll
                for (int i = 0; i < 4; ++i) { o[i] += pa[i] * vv; o[4 + i] += pb[i] * vv; } }
        }
#pragma unroll
        for (int i = 0; i < 8; ++i) MIX[(size_t)(tq0 + q0 + i) * D + 512 + h * 64 + F.lane] = (bf16)f2bf(o[i] / lrun[i]);
    }
}
typedef short bf16x8 __attribute__((ext_vector_type(8)));
typedef float f32x16 __attribute__((ext_vector_type(16)));
#define MFMA32(a, b, c) __builtin_amdgcn_mfma_f32_32x32x16_bf16((a), (b), (c), 0, 0, 0)
__device__ __forceinline__ int crow(int r, int h) { return (r & 3) + 8 * (r >> 2) + 4 * h; }
__device__ __forceinline__ bf16x8 pack8(float a0, float a1, float a2, float a3, float a4, float a5, float a6, float a7) {
    v4u p; p.x = cvtpk(a0, a1); p.y = cvtpk(a2, a3); p.z = cvtpk(a4, a5); p.w = cvtpk(a6, a7); return __builtin_bit_cast(bf16x8, p); }
__device__ __forceinline__ bf16x8 pack_step(const f32x16& x, int s) { return pack8(x[8 * s], x[8 * s + 1], x[8 * s + 2], x[8 * s + 3], x[8 * s + 4], x[8 * s + 5], x[8 * s + 6], x[8 * s + 7]); }
__device__ __forceinline__ bf16x8 ldg8_f32(const float* p) { const f32x4 a = *(const f32x4*)p, b = *(const f32x4*)(p + 4); return pack8(a[0], a[1], a[2], a[3], b[0], b[1], b[2], b[3]); }
__device__ __forceinline__ bf16x8 lds_nat(const LAS bf16* row, int ks, int h) { return *(const LAS bf16x8*)(row + 16 * ks + 8 * h); }
__device__ __forceinline__ bf16x8 lds_krow(const LAS bf16* row, int k0, int h) { const v2u lo = *(const LAS v2u*)(row + k0 + 4 * h), hi = *(const LAS v2u*)(row + k0 + 8 + 4 * h);
    v4u p; p.x = lo.x; p.y = lo.y; p.z = hi.x; p.w = hi.y; return __builtin_bit_cast(bf16x8, p); }
__device__ __forceinline__ f32x16 zero16() { f32x16 z;
#pragma unroll
    for (int i = 0; i < 16; ++i) z[i] = 0.f;
    return z; }

__device__ __forceinline__ void ssd_gates4(Frame& F, int j, int t0, int g, LAS float* DT, LAS float* ACS) {
    if (F.wave < 4) { const int h = 4 * g + F.wave; const float* SG = (const float*)(kws() + WS_SG); const float dtb = KIN(I_DTB)[j * 16 + h], aneg = -expf(KIN(I_ALOG)[j * 16 + h]);
        const float d0 = softplus_f(SG[(size_t)(t0 + 2 * F.lane) * 16 + h] + dtb), d1 = softplus_f(SG[(size_t)(t0 + 2 * F.lane + 1) * 16 + h] + dtb);
        const float a0 = d0 * aneg, a1 = d1 * aneg; const float inc = wave_scan_sum(a0 + a1, F.lane);
        DT[F.wave * 128 + 2 * F.lane] = d0; DT[F.wave * 128 + 2 * F.lane + 1] = d1; ACS[F.wave * 128 + 2 * F.lane] = inc - a1; ACS[F.wave * 128 + 2 * F.lane + 1] = inc; }
}
__device__ __forceinline__ void ssd_stage_xt(Frame& F, const bf16* XBC, int t0, int g, LAS bf16* XT, const LAS float* WGT) {
    for (int i = F.tid; i < 2048; i += 512) { const int cp = i & 127, s0 = 8 * (i >> 7), hl = cp >> 5; float a[8], bq[8];
#pragma unroll
        for (int k = 0; k < 8; ++k) { const unsigned w = *(const unsigned*)(XBC + (size_t)(t0 + s0 + k) * 1536 + g * 256 + 2 * cp); const float wg = WGT[hl * 128 + s0 + k]; a[k] = bflo(w) * wg; bq[k] = bfhi(w) * wg; }
        *(LAS bf16x8*)(XT + (2 * cp) * 136 + s0) = pack8(a[0], a[1], a[2], a[3], a[4], a[5], a[6], a[7]);
        *(LAS bf16x8*)(XT + (2 * cp + 1) * 136 + s0) = pack8(bq[0], bq[1], bq[2], bq[3], bq[4], bq[5], bq[6], bq[7]); }
}
__device__ __forceinline__ void e1_states_mfma(Frame& F0, int j) {   Frame F = F0; { int t_ = threadIdx.x; asm volatile("" : "+v"(t_)); F.tid = t_; F.lane = t_ & 63; }
    const bf16* XBC = (const bf16*)(kws() + WS_R3); float* ST = (float*)(kws() + WS_R4); float* DEC = (float*)(kws() + WS_DEC);
    LAS bf16* XT = (LAS bf16*)F.lds; LAS bf16* BT = (LAS bf16*)(F.lds + 69632);
    LAS float* DT = (LAS float*)(F.lds + 98304); LAS float* ACS = DT + 512; LAS float* WGT = DT + 1024;
    for (int u = F.vcu; u < 512; u += F.G) {
        const int b = u >> 6, c = (u >> 2) & 15, g = u & 3, t0 = b * SEQ + c * 128;
        __syncthreads();
        ssd_gates4(F, j, t0, g, DT, ACS);
        { const int np = F.tid & 31, l0 = 8 * (F.tid >> 5); float a[8], bq[8];
#pragma unroll
            for (int k = 0; k < 8; ++k) { const unsigned w = *(const unsigned*)(XBC + (size_t)(t0 + l0 + k) * 1536 + 1024 + g * 64 + 2 * np); a[k] = bflo(w); bq[k] = bfhi(w); }
            *(LAS bf16x8*)(BT + (2 * np) * 136 + l0) = pack8(a[0], a[1], a[2], a[3], a[4], a[5], a[6], a[7]);
            *(LAS bf16x8*)(BT + (2 * np + 1) * 136 + l0) = pack8(bq[0], bq[1], bq[2], bq[3], bq[4], bq[5], bq[6], bq[7]); }
        __syncthreads();
        { const int hl = F.tid >> 7, l = F.tid & 127; WGT[F.tid] = expf(ACS[hl * 128 + 127] - ACS[F.tid]) * DT[F.tid]; if (l == 127) DEC[(b * 16 + c) * 16 + 4 * g + hl] = expf(ACS[F.tid]); }
        __syncthreads();
        ssd_stage_xt(F, XBC, t0, g, XT, WGT);
        __syncthreads();
        const int hl = F.wave >> 1, nt = F.wave & 1, li = F.lane & 31, hh = F.lane >> 5;
        f32x16 acc0 = zero16(), acc1 = zero16();
        const LAS bf16* ar0 = XT + (hl * 64 + li) * 136; const LAS bf16* ar1 = ar0 + 32 * 136; const LAS bf16* br = BT + (32 * nt + li) * 136;
#pragma unroll
        for (int ks = 0; ks < 8; ++ks) { const bf16x8 bf = lds_nat(br, ks, hh); acc0 = MFMA32(lds_nat(ar0, ks, hh), bf, acc0); acc1 = MFMA32(lds_nat(ar1, ks, hh), bf, acc1); }
        float* dst = ST + (size_t)((b * 16 + c) * 16 + 4 * g + hl) * 4096 + 32 * nt + li;
#pragma unroll
        for (int r = 0; r < 16; ++r) { dst[crow(r, hh) * 64] = acc0[r]; dst[(32 + crow(r, hh)) * 64] = acc1[r]; }
    }
}
__device__ __forceinline__ void e3_output_mfma(Frame& F0, int j) {   Frame F = F0; { int t_ = threadIdx.x; asm volatile("" : "+v"(t_)); F.tid = t_; F.lane = t_ & 63; }
    const bf16* XBC = (const bf16*)(kws() + WS_R3); const float* ST = (const float*)(kws() + WS_R4); const bf16* P = (const bf16*)(kws() + WS_R1); bf16* MIX = (bf16*)(kws() + WS_MIX); float* SSQ = (float*)(kws() + WS_SSQ);
    LAS float* SSQL = (LAS float*)(F.lds + 110592);
    LAS bf16* CR = (LAS bf16*)F.lds; LAS bf16* BR = (LAS bf16*)(F.lds + 18432); LAS bf16* XT = (LAS bf16*)(F.lds + 36864);
    LAS float* DT = (LAS float*)(F.lds + 106496); LAS float* ACS = DT + 512;
    for (int u = F.vcu; u < 512; u += F.G) {
        const int b = u >> 6, c = (u >> 2) & 15, g = u & 3, t0 = b * SEQ + c * 128;
        __syncthreads();
        ssd_gates4(F, j, t0, g, DT, ACS);
        for (int i = F.tid; i < 1024; i += 512) { const int l = i >> 3, ch = i & 7; const bf16* src = XBC + (size_t)(t0 + l) * 1536 + 1024 + g * 64 + 8 * ch;
            *(LAS v4u*)(BR + l * 72 + 8 * ch) = *(const v4u*)src; *(LAS v4u*)(CR + l * 72 + 8 * ch) = *(const v4u*)(src + 256); }
        __syncthreads();
        ssd_stage_xt(F, XBC, t0, g, XT, DT);
        __syncthreads();
        const int hl = F.wave >> 1, half = F.wave & 1, li = F.lane & 31, hh = F.lane >> 5, habs = 4 * g + hl;
        const LAS float* acs = ACS + hl * 128; const LAS float* dtl = DT + hl * 128;
        bf16x8 hp[2][4];
        { const float* hsrc = ST + (size_t)((b * 16 + c) * 16 + habs) * 4096;
#pragma unroll
            for (int pt = 0; pt < 2; ++pt)
#pragma unroll
                for (int ks = 0; ks < 4; ++ks) hp[pt][ks] = ldg8_f32(hsrc + (32 * pt + li) * 64 + 16 * ks + 8 * hh); }
        const float dsk = KIN(I_DSKIP)[j * 16 + habs];
        f32x16 yacc[2][2];
#pragma unroll
        for (int q = 0; q < 2; ++q) { const int lt = half ? 1 + q : 3 * q;
            f32x16 (&acc)[2] = yacc[q]; acc[0] = zero16(); acc[1] = zero16();
            const LAS bf16* crl = CR + (32 * lt + li) * 72;
#pragma unroll
            for (int ks = 0; ks < 4; ++ks) { const bf16x8 cf = lds_nat(crl, ks, hh); acc[0] = MFMA32(cf, hp[0][ks], acc[0]); acc[1] = MFMA32(cf, hp[1][ks], acc[1]); }
#pragma unroll
            for (int a4 = 0; a4 < 4; ++a4) { const f32x4 av = *(const LAS f32x4*)(acs + 32 * lt + 8 * a4 + 4 * hh);
#pragma unroll
                for (int i = 0; i < 4; ++i) { const float e = expf(av[i]); acc[0][4 * a4 + i] *= e; acc[1][4 * a4 + i] *= e; } }
            const float acl = acs[32 * lt + li];
            for (int st = 0; st <= lt; ++st) {
                f32x16 gt = zero16(); const LAS bf16* brs = BR + (32 * st + li) * 72;
#pragma unroll
                for (int ks = 0; ks < 4; ++ks) gt = MFMA32(lds_nat(brs, ks, hh), lds_nat(crl, ks, hh), gt);
#pragma unroll
                for (int a4 = 0; a4 < 4; ++a4) { const f32x4 av = *(const LAS f32x4*)(acs + 32 * st + 8 * a4 + 4 * hh);
#pragma unroll
                    for (int i = 0; i < 4; ++i) { const int r = 4 * a4 + i; const float e = expf(acl - av[i]); gt[r] = (st < lt || crow(r, hh) <= li) ? gt[r] * e : 0.f; } }
                const bf16x8 g0 = pack_step(gt, 0), g1 = pack_step(gt, 1);
#pragma unroll
                for (int pt = 0; pt < 2; ++pt) { const LAS bf16* xr = XT + (hl * 64 + 32 * pt + li) * 136 + 32 * st;
                    acc[pt] = MFMA32(g0, lds_krow(xr, 0, hh), acc[pt]); acc[pt] = MFMA32(g1, lds_krow(xr, 16, hh), acc[pt]); } }
#pragma unroll
            for (int pt = 0; pt < 2; ++pt) { const LAS bf16* xr = XT + (hl * 64 + 32 * pt + li) * 136 + 32 * lt;
#pragma unroll
                for (int r = 0; r < 16; ++r) { const int l = crow(r, hh); acc[pt][r] += dsk * bf2f(xr[l]) / dtl[32 * lt + l]; } }
        }
        __syncthreads();
        LAS bf16* YS = XT;
#pragma unroll
        for (int q = 0; q < 2; ++q) { const int lt = half ? 1 + q : 3 * q;
#pragma unroll
            for (int pt = 0; pt < 2; ++pt)
#pragma unroll
                for (int r = 0; r < 16; ++r) YS[(32 * lt + crow(r, hh)) * 264 + hl * 64 + 32 * pt + li] = (bf16)f2bf(yacc[q][pt][r]); }
        __syncthreads();
        for (int i = F.tid; i < 4096; i += 512) { const int l = i >> 5, ch = i & 31; const size_t tok = (size_t)(t0 + l);
            const v4u yw = *(const LAS v4u*)(YS + l * 264 + 8 * ch), zw = *(const v4u*)(P + tok * NPE + 1536 + g * 256 + 8 * ch);
            float u8[8]; u8[0] = bflo(yw.x) * silu_f(bflo(zw.x)); u8[1] = bfhi(yw.x) * silu_f(bfhi(zw.x)); u8[2] = bflo(yw.y) * silu_f(bflo(zw.y)); u8[3] = bfhi(yw.y) * silu_f(bfhi(zw.y));
            u8[4] = bflo(yw.z) * silu_f(bflo(zw.z)); u8[5] = bfhi(yw.z) * silu_f(bfhi(zw.z)); u8[6] = bflo(yw.w) * silu_f(bflo(zw.w)); u8[7] = bfhi(yw.w) * silu_f(bfhi(zw.w));
            v4u ow; ow.x = cvtpk(u8[0], u8[1]); ow.y = cvtpk(u8[2], u8[3]); ow.z = cvtpk(u8[4], u8[5]); ow.w = cvtpk(u8[6], u8[7]);
            *(v4u*)(MIX + tok * 1536 + g * 256 + 8 * ch) = ow;
            float s = ((u8[0] * u8[0] + u8[1] * u8[1]) + (u8[2] * u8[2] + u8[3] * u8[3])) + ((u8[4] * u8[4] + u8[5] * u8[5]) + (u8[6] * u8[6] + u8[7] * u8[7]));
#pragma unroll
            for (int o = 1; o < 32; o <<= 1) s += __shfl_xor(s, o);
            if (ch == 0) SSQ[tok * 4 + g] = s; }
    }
}
__device__ __forceinline__ void mlstm_stage_t(Frame& F, const bf16* P, int t0, int col0, LAS bf16* DST, const LAS float* wk) {
    const int vp = F.tid & 63, s0 = 8 * (F.tid >> 6); float a[8], bq[8];
#pragma unroll
    for (int k = 0; k < 8; ++k) { const unsigned w = *(const unsigned*)(P + (size_t)(t0 + s0 + k) * NPO + col0 + 2 * vp); const float wg = wk ? wk[s0 + k] : 1.f; a[k] = bflo(w) * wg; bq[k] = bfhi(w) * wg; }
    *(LAS bf16x8*)(DST + (2 * vp) * 72 + s0) = pack8(a[0], a[1], a[2], a[3], a[4], a[5], a[6], a[7]);
    *(LAS bf16x8*)(DST + (2 * vp + 1) * 72 + s0) = pack8(bq[0], bq[1], bq[2], bq[3], bq[4], bq[5], bq[6], bq[7]);
}
__device__ __forceinline__ void o1_local_mfma(Frame& F0, int j) {   Frame F = F0; { int t_ = threadIdx.x; asm volatile("" : "+v"(t_)); F.tid = t_; F.lane = t_ & 63; }
    const bf16* P = (const bf16*)(kws() + WS_R1); float* KLOC = (float*)(kws() + WS_R2); float* NLOC = (float*)(kws() + WS_NLOC); float* MLOC = (float*)(kws() + WS_MLOC); float* BLAST = (float*)(kws() + WS_BLAST);
    LAS bf16* VT = (LAS bf16*)F.lds; LAS bf16* KWT = (LAS bf16*)(F.lds + 18432); LAS float* wk = (LAS float*)(F.lds + SMALL_OFF);
    for (int u = F.vcu; u < 1024; u += F.G) {
        const int b = u >> 7, h = (u >> 5) & 3, c = u & 31, t0 = b * SEQ + c * 64;
        __syncthreads();
        if (F.wave == 0) { float bcum, ib; mlstm_gates(F, j, t0, h, bcum, ib); const float blast = __shfl(bcum, 63); const float gl = blast - bcum + ib; const float ml = wave_max(gl);
            wk[F.lane] = expf(gl - ml); if (F.lane == 0) { MLOC[u] = ml; BLAST[u] = blast; } }
        mlstm_stage_t(F, P, t0, 1024 + h * 128, VT, nullptr);
        __syncthreads();
        mlstm_stage_t(F, P, t0, 512 + h * 128, KWT, wk);
        __syncthreads();
        const int vt = F.wave >> 1, dh = F.wave & 1, li = F.lane & 31, hh = F.lane >> 5;
        f32x16 acc0 = zero16(), acc1 = zero16();
        const LAS bf16* ar = VT + (32 * vt + li) * 72; const LAS bf16* b0 = KWT + (64 * dh + li) * 72; const LAS bf16* b1 = b0 + 32 * 72;
#pragma unroll
        for (int ks = 0; ks < 4; ++ks) { const bf16x8 af = lds_nat(ar, ks, hh); acc0 = MFMA32(af, lds_nat(b0, ks, hh), acc0); acc1 = MFMA32(af, lds_nat(b1, ks, hh), acc1); }
        float* dst = KLOC + (size_t)u * 16384 + (size_t)(32 * vt) * 128 + 64 * dh + li;
#pragma unroll
        for (int r = 0; r < 16; ++r) { dst[crow(r, hh) * 128] = acc0[r]; dst[crow(r, hh) * 128 + 32] = acc1[r]; }
        if (F.tid < 128) { float a = 0.f; const LAS bf16* kr = KWT + F.tid * 72;
#pragma unroll
            for (int s8 = 0; s8 < 8; ++s8) { const v4u w = *(const LAS v4u*)(kr + 8 * s8); a += (bflo(w.x) + bfhi(w.x)) + (bflo(w.y) + bfhi(w.y)) + (bflo(w.z) + bfhi(w.z)) + (bflo(w.w) + bfhi(w.w)); }
            NLOC[(size_t)u * 128 + F.tid] = a; }
    }
}
__device__ __forceinline__ void o3_output_mfma(Frame& F0, int j) {
    Frame F = F0; { int t_ = threadIdx.x; asm volatile("" : "+v"(t_)); F.tid = t_; F.lane = t_ & 63; }
    const bf16* P = (const bf16*)(kws() + WS_R1); const float* CPREV = (const float*)(kws() + WS_R2); const float* NPREV = (const float*)(kws() + WS_NLOC); const float* MPREV = (const float*)(kws() + WS_MPREV); bf16* MIX = (bf16*)(kws() + WS_MIX);
    LAS bf16* QR = (LAS bf16*)F.lds;
    LAS bf16* KR = (LAS bf16*)(F.lds + 17408);
    LAS bf16* VT = (LAS bf16*)(F.lds + 34816);
    LAS float* OST = (LAS float*)(F.lds + 53248);
    LAS float* sm = (LAS float*)(F.lds + 98304);
    for (int u = F.vcu; u < 1024; u += F.G) {
        const int b = u >> 7, h = (u >> 5) & 3, c = u & 31, t0 = b * SEQ + c * 64;
        __syncthreads();
        if (F.wave == 0) { float bcum, ib; mlstm_gates(F, j, t0, h, bcum, ib); const float mprev = MPREV[u];
            const float pm = wave_scan_max(ib - bcum, F.lane); const float inter = bcum + mprev; const float mt = fmaxf(bcum + pm, inter);
            sm[F.lane] = bcum; sm[64 + F.lane] = ib; sm[128 + F.lane] = mt; sm[192 + F.lane] = expf(inter - mt); }
        for (int i = F.tid; i < 1024; i += 512) { const int l = i >> 4, ch = i & 15; const bf16* src = P + (size_t)(t0 + l) * NPO + h * 128 + 8 * ch;
            *(LAS v4u*)(QR + l * 136 + 8 * ch) = *(const v4u*)src; *(LAS v4u*)(KR + l * 136 + 8 * ch) = *(const v4u*)(src + 512); }
        mlstm_stage_t(F, P, t0, 1024 + h * 128, VT, nullptr);
        __syncthreads();
        if (F.wave == 1) { const int l = F.lane; const float* np = NPREV + (size_t)u * 128; float qn = 0.f;
#pragma unroll 4
            for (int d8 = 0; d8 < 16; ++d8) { const v4u w = *(const LAS v4u*)(QR + l * 136 + 8 * d8); const f32x4 n0 = *(const f32x4*)(np + 8 * d8), n1 = *(const f32x4*)(np + 8 * d8 + 4);
                qn += (bflo(w.x) * n0[0] + bfhi(w.x) * n0[1]) + (bflo(w.y) * n0[2] + bfhi(w.y) * n0[3]) + (bflo(w.z) * n1[0] + bfhi(w.z) * n1[1]) + (bflo(w.w) * n1[2] + bfhi(w.w) * n1[3]); }
            sm[256 + l] = qn; }
        const int lt = F.wave >> 2, vt = F.wave & 3, li = F.lane & 31, hh = F.lane >> 5, l = 32 * lt + li;
        const float bcl = sm[l], mtl = sm[128 + l], sil = sm[192 + l];
        f32x16 acc = zero16();
        const LAS bf16* qrl = QR + l * 136;
        { const float* cp = CPREV + (size_t)u * 16384 + (size_t)(32 * vt + li) * 128;
#pragma unroll
            for (int ks = 0; ks < 8; ++ks) acc = MFMA32(ldg8_f32(cp + 16 * ks + 8 * hh), lds_nat(qrl, ks, hh), acc); }
#pragma unroll
        for (int r = 0; r < 16; ++r) acc[r] *= sil;
        float dsum = 0.f;
        for (int st = 0; st <= lt; ++st) {
            f32x16 wt = zero16(); const LAS bf16* krs = KR + (32 * st + li) * 136;
#pragma unroll
            for (int ks = 0; ks < 8; ++ks) wt = MFMA32(lds_nat(krs, ks, hh), lds_nat(qrl, ks, hh), wt);
#pragma unroll
            for (int a4 = 0; a4 < 4; ++a4) { const f32x4 bs = *(const LAS f32x4*)(sm + 32 * st + 8 * a4 + 4 * hh), is = *(const LAS f32x4*)(sm + 64 + 32 * st + 8 * a4 + 4 * hh);
#pragma unroll
                for (int i = 0; i < 4; ++i) { const int r = 4 * a4 + i; const float e = expf(bcl - bs[i] + is[i] - mtl); const float w = (st < lt || crow(r, hh) <= li) ? wt[r] * e : 0.f; wt[r] = w; dsum += w; } }
            const bf16x8 w0 = pack_step(wt, 0), w1 = pack_step(wt, 1); const LAS bf16* vr = VT + (32 * vt + li) * 72 + 32 * st;
            acc = MFMA32(lds_krow(vr, 0, hh), w0, acc); acc = MFMA32(lds_krow(vr, 16, hh), w1, acc); }
        __syncthreads();
        dsum += __shfl_xor(dsum, 32);
        const float den = dsum + sil * sm[256 + l]; const float rinv = 1.0f / fmaxf(fabsf(den), expf(-mtl));
        float s1 = 0.f, s2 = 0.f;
#pragma unroll
        for (int r = 0; r < 16; ++r) { acc[r] *= rinv; s1 += acc[r]; s2 += acc[r] * acc[r]; }
        s1 += __shfl_xor(s1, 32); s2 += __shfl_xor(s2, 32);
        if (hh == 0) { sm[320 + (vt * 64 + l) * 2] = s1; sm[320 + (vt * 64 + l) * 2 + 1] = s2; }
        __syncthreads();
        { float t1 = 0.f, t2 = 0.f;
#pragma unroll
            for (int q = 0; q < 4; ++q) { t1 += sm[320 + (q * 64 + l) * 2]; t2 += sm[320 + (q * 64 + l) * 2 + 1]; }
            const float mu = t1 * (1.f / 128.f), var = fmaxf(t2 * (1.f / 128.f) - mu * mu, 0.f), rstd = 1.0f / sqrtf(var + LN_EPS);
#pragma unroll
            for (int r = 0; r < 16; ++r) OST[l * 132 + 32 * vt + crow(r, hh)] = (acc[r] - mu) * rstd; }
        __syncthreads();
        for (int i = F.tid; i < 1024; i += 512) { const int ll = i >> 4, ch = i & 15; const LAS float* os = OST + ll * 132 + 8 * ch; const f32x4 o0 = *(const LAS f32x4*)os, o1 = *(const LAS f32x4*)(os + 4);
            const v4u ow = *(const v4u*)(P + (size_t)(t0 + ll) * NPO + 1536 + h * 128 + 8 * ch); const float* hw = KIN(I_HNW) + j * 512 + h * 128 + 8 * ch; const f32x4 h0 = *(const f32x4*)hw, h1 = *(const f32x4*)(hw + 4);
            v4u res; res.x = pk2(o0[0] * h0[0] * sigmoid_f(bflo(ow.x)), o0[1] * h0[1] * sigmoid_f(bfhi(ow.x))); res.y = pk2(o0[2] * h0[2] * sigmoid_f(bflo(ow.y)), o0[3] * h0[3] * sigmoid_f(bfhi(ow.y)));
            res.z = pk2(o1[0] * h1[0] * sigmoid_f(bflo(ow.z)), o1[1] * h1[1] * sigmoid_f(bfhi(ow.z))); res.w = pk2(o1[2] * h1[2] * sigmoid_f(bflo(ow.w)), o1[3] * h1[3] * sigmoid_f(bfhi(ow.w)));
            *(v4u*)(MIX + (size_t)(t0 + ll) * D + h * 128 + 8 * ch) = res; }
    }
}
template <bool XIN> __device__ __forceinline__ void p_ln1_route(Frame& F0, int layer) {   Frame F = F0; { int t_ = threadIdx.x; asm volatile("" : "+v"(t_)); F.tid = t_; F.lane = t_ & 63; }
    const bf16* OUTP = (const bf16*)(kws() + WS_R1); const bf16* HB = (const bf16*)(kws() + WS_HB); bf16* H1B = (bf16*)(kws() + WS_H1B);
    i32x4* ROUTE = (i32x4*)(kws() + WS_ROUTE); f32x2* GATE = (f32x2*)(kws() + WS_GATE); int* BCNT = (int*)(kws() + WS_BCNT);
    LAS int* cnt = (LAS int*)(F.lds + SMALL_OFF);
    const float* g1 = KIN(I_LN1G) + (size_t)layer * D; const float* b1 = KIN(I_LN1B) + (size_t)layer * D;
    const f32x4* rgw = (const f32x4*)(kws() + WS_TAB + (size_t)layer * TAB_LAYER + TAB_RGW); const float* rgb = KIN(I_RGB) + layer * 4; const f32x4* rew = (const f32x4*)(kws() + WS_TAB + (size_t)layer * TAB_LAYER + TAB_REW); const float* reb = KIN(I_REB) + layer * 32;
    __syncthreads();
    if (F.tid < 32) cnt[F.tid] = 0;
    __syncthreads();
    const LAS f32x4* rewl = (const LAS f32x4*)F.lds;
    for (int r = F.tid; r < 8192; r += 512) ((LAS f32x4*)F.lds)[r] = rew[r];
    __syncthreads();
#pragma unroll 1
    for (int m0 = F.gw; m0 < T; m0 += 2 * F.NGW) {
        const int m1 = m0 + F.NGW < T ? m0 + F.NGW : -1; const int mm[2] = {m0, m1 >= 0 ? m1 : m0};
        f32x4 v[2][4], a[2][4];
#pragma unroll
        for (int rr = 0; rr < 2; ++rr) { if constexpr (XIN) row_load(KIN(I_X) + (size_t)mm[rr] * D, F.lane, v[rr]); else row_load_bf16(HB + (size_t)mm[rr] * D, F.lane, v[rr]); row_load_bf16(OUTP + (size_t)mm[rr] * D, F.lane, a[rr]); }
#pragma unroll
        for (int rr = 0; rr < 2; ++rr) {
#pragma unroll
            for (int jj = 0; jj < 4; ++jj) v[rr][jj] = v[rr][jj] * ALPHA + a[rr][jj];
            row_layernorm(v[rr], g1, b1, F.lane); }
        row_store_bf16(H1B + (size_t)m0 * D, F.lane, v[0]); if (m1 >= 0) row_store_bf16(H1B + (size_t)m1 * D, F.lane, v[1]);
        float gl[2][4];
#pragma unroll
        for (int c = 0; c < 4; ++c) { gl[0][c] = 0.f; gl[1][c] = 0.f; }
#pragma unroll
        for (int jj = 0; jj < 4; ++jj)
#pragma unroll
            for (int i = 0; i < 4; ++i) { const f32x4 w = rgw[(jj * 4 + i) * 64 + F.lane];
#pragma unroll
                for (int c = 0; c < 4; ++c) { gl[0][c] += v[0][jj][i] * w[c]; gl[1][c] += v[1][jj][i] * w[c]; } }
        int gi[2]; float pg[2];
#pragma unroll
        for (int rr = 0; rr < 2; ++rr) { const float red = wave_reduce_multi<4>(gl[rr], F.lane); float l4[4];
#pragma unroll
            for (int c = 0; c < 4; ++c) l4[c] = __shfl(red, 16 * c) + rgb[c];
            int g = 0; float gm = l4[0];
#pragma unroll
            for (int c = 1; c < 4; ++c) if (l4[c] > gm) { gm = l4[c]; g = c; }
            float se = 0.f;
#pragma unroll
            for (int c = 0; c < 4; ++c) se += expf(l4[c] - gm);
            gi[rr] = g; pg[rr] = 1.0f / se; }
        float el[2][8];
#pragma unroll
        for (int rr = 0; rr < 2; ++rr) { const LAS f32x4* rw = rewl + gi[rr] * 2048 + F.lane;
#pragma unroll
            for (int c = 0; c < 8; ++c) el[rr][c] = 0.f;
#pragma unroll
            for (int jj = 0; jj < 4; ++jj)
#pragma unroll
                for (int i = 0; i < 4; ++i) { const f32x4 w0 = rw[(jj * 4 + i) * 128], w1 = rw[(jj * 4 + i) * 128 + 64];
#pragma unroll
                    for (int c = 0; c < 4; ++c) { el[rr][c] += v[rr][jj][i] * w0[c]; el[rr][4 + c] += v[rr][jj][i] * w1[c]; } } }
#pragma unroll
        for (int rr = 0; rr < 2; ++rr) { const float red = wave_reduce_multi<8>(el[rr], F.lane); float e8[8];
#pragma unroll
            for (int c = 0; c < 8; ++c) e8[c] = __shfl(red, 8 * c) + reb[gi[rr] * 8 + c];
            int i0 = 0; float v0 = e8[0];
#pragma unroll
            for (int c = 1; c < 8; ++c) if (e8[c] > v0) { v0 = e8[c]; i0 = c; }
            int i1 = -1; float v1 = -INFINITY;
#pragma unroll
            for (int c = 0; c < 8; ++c) if (c != i0 && e8[c] > v1) { v1 = e8[c]; i1 = c; }
            if (i1 < 0) i1 = (i0 + 1) & 7;
            const float ee = expf(v1 - v0), g0 = pg[rr] / (1.0f + ee), g1v = pg[rr] * ee / (1.0f + ee);
            if (F.lane == 0 && (rr == 0 || m1 >= 0)) { const int e0 = gi[rr] * 8 + i0, e1 = gi[rr] * 8 + i1;
                const int r0 = __hip_atomic_fetch_add(cnt + e0, 1, __ATOMIC_RELAXED, __HIP_MEMORY_SCOPE_WORKGROUP), r1 = __hip_atomic_fetch_add(cnt + e1, 1, __ATOMIC_RELAXED, __HIP_MEMORY_SCOPE_WORKGROUP);
                ROUTE[mm[rr]] = (i32x4){e0, r0, e1, r1}; GATE[mm[rr]] = (f32x2){g0, g1v}; } }
    }
    __syncthreads();
    if (F.tid < 32) BCNT[F.vcu * 32 + F.tid] = cnt[F.tid];
}
__device__ __forceinline__ void p_scatter(Frame& F0) {   Frame F = F0; { int t_ = threadIdx.x; asm volatile("" : "+v"(t_)); F.tid = t_; F.lane = t_ & 63; }
    const int* BCNT = (const int*)(kws() + WS_BCNT); int* PANEL = (int*)(kws() + WS_PANEL); const i32x4* ROUTE = (const i32x4*)(kws() + WS_ROUTE); i32x2* POS = (i32x2*)(kws() + WS_POS);
    int* SROW = (int*)(kws() + WS_SROW);
    LAS int* pa = (LAS int*)(F.lds + SMALL_OFF); LAS int* pb = pa + 512; LAS int* tot = pa + 1024; LAS int* bef = pa + 1056; LAS int* base = pa + 1088;
    __syncthreads();
    { const int e = F.tid & 31, part = F.tid >> 5; int sa = 0, sb = 0;
        for (int b = part; b < F.G; b += 16) { const int c = BCNT[b * 32 + e]; sa += c; if (b < F.vcu) sb += c; }
        pa[part * 32 + e] = sa; pb[part * 32 + e] = sb; }
    __syncthreads();
    if (F.tid < 32) { int sa = 0, sb = 0; for (int p = 0; p < 16; ++p) { sa += pa[p * 32 + F.tid]; sb += pb[p * 32 + F.tid]; } tot[F.tid] = sa; bef[F.tid] = sb; }
    __syncthreads();
    if (F.tid == 0) { int off = 0, np = 0;
        for (int e = 0; e < 32; ++e) { const int npan = (tot[e] + 255) >> 8; base[e] = off + bef[e];
            if (F.vcu == 0) for (int p = 0; p < npan; ++p) PANEL[1 + np + p] = e;
            np += npan; off += npan * 256; }
        if (F.vcu == 0) PANEL[0] = np; }
    __syncthreads();
    for (int e = F.vcu; e < 32; e += F.G) { const int cnt = tot[e], st = base[e] - bef[e]; for (int p = cnt + F.tid; p < ((cnt + 255) & ~255); p += 512) SROW[st + p] = 0; }
    for (int q = F.tid; q < 8 * ((T + F.NGW - 1) / F.NGW); q += 512) { const int m = F.vcu * 8 + (q & 7) + (q >> 3) * F.NGW;
        if (m < T) { const i32x4 r = ROUTE[m]; const int p0 = base[r.x] + r.y, p1 = base[r.z] + r.w; POS[m] = (i32x2){p0, p1}; SROW[p0] = m; SROW[p1] = m; } }
}
__device__ __forceinline__ void p_combine(Frame& F0, int layer) {   Frame F = F0; { int t_ = threadIdx.x; asm volatile("" : "+v"(t_)); F.tid = t_; F.lane = t_ & 63; }
    const bf16* H1B = (const bf16*)(kws() + WS_H1B); const bf16* EOUT = (const bf16*)(kws() + WS_R1); const i32x2* POS = (const i32x2*)(kws() + WS_POS); const f32x2* GATE = (const f32x2*)(kws() + WS_GATE);
    bf16* HB = (bf16*)(kws() + WS_HB);
    const float* g2 = KIN(I_LN2G) + (size_t)layer * D; const float* b2 = KIN(I_LN2B) + (size_t)layer * D;
    const LAS f32x4* gpl = (const LAS f32x4*)F.lds;
    if (layer != DEPTH - 1) { const f32x4* src = (const f32x4*)(kws() + WS_TAB + (size_t)(layer + 1) * TAB_LAYER + TAB_GPW); for (int r = F.tid; r < 4096; r += 512) ((LAS f32x4*)F.lds)[r] = src[r]; }
    __syncthreads();
#pragma unroll 1
    for (int m0 = F.gw; m0 < T; m0 += 2 * F.NGW) {
        const int m1 = m0 + F.NGW < T ? m0 + F.NGW : -1; const int mm[2] = {m0, m1 >= 0 ? m1 : m0};
        f32x4 v[2][4], ea[2][4], eb[2][4]; i32x2 ps[2]; f32x2 gt[2];
#pragma unroll
        for (int rr = 0; rr < 2; ++rr) { ps[rr] = POS[mm[rr]]; gt[rr] = GATE[mm[rr]]; row_load_bf16(H1B + (size_t)mm[rr] * D, F.lane, v[rr]); }
#pragma unroll
        for (int rr = 0; rr < 2; ++rr) { row_load_bf16(EOUT + (size_t)ps[rr].x * D, F.lane, ea[rr]); row_load_bf16(EOUT + (size_t)ps[rr].y * D, F.lane, eb[rr]); }
#pragma unroll
        for (int rr = 0; rr < 2; ++rr) {
#pragma unroll
            for (int jj = 0; jj < 4; ++jj) v[rr][jj] = v[rr][jj] * ALPHA + (ea[rr][jj] * gt[rr].x + eb[rr][jj] * gt[rr].y);
            row_layernorm(v[rr], g2, b2, F.lane); }
        if (layer == DEPTH - 1) { row_store_f32(kout() + (size_t)m0 * D, F.lane, v[0]); if (m1 >= 0) row_store_f32(kout() + (size_t)m1 * D, F.lane, v[1]); }
        else { row_store_bf16(HB + (size_t)m0 * D, F.lane, v[0]); if (m1 >= 0) row_store_bf16(HB + (size_t)m1 * D, F.lane, v[1]); row_gate_proj2_lds(F, v[0], v[1], gpl, m0, m1); } }
}
#ifndef PHASE_MASK
#define PHASE_MASK 0x1fff
#endif
#define PH_EN(k) (((PHASE_MASK) >> (k)) & 1)
#ifndef PROBE_DUP
#define PROBE_DUP 0
#endif
#define TPROBE(k) ((((PROBE_DUP) >> (k)) & 1) != 0)
#define TWAIT(k) do { if constexpr (TPROBE(k)) { const unsigned long long t1_ = __builtin_amdgcn_s_memrealtime(); while (__builtin_amdgcn_s_memrealtime() - t1_ < (t1_ - tp0_)) __builtin_amdgcn_s_sleep(8); } } while (0)
#define IN(k) (lo <= (k) && (k) < hi)
#define SEAM(k) do { if ((k) + 1 < hi) xcd_barrier(bar); } while (0)
template <int LAYER> __device__ __forceinline__ void layer_body(Frame& F, const int lo, const int hi, const XcdBarrier& bar) {
        constexpr int layer = LAYER, pb = 1 + LAYER * NPH_LAYER, j = LAYER >> 1; constexpr bool odd = (LAYER & 1) != 0;
        bf16* HB = (bf16*)(kws() + WS_HB); bf16* MIX = (bf16*)(kws() + WS_MIX);
        if constexpr (PH_EN(0)) if (IN(pb + 0)) { const unsigned long long tp0_ = TPROBE(0) ? __builtin_amdgcn_s_memrealtime() : 0ull;
            const int N = odd ? NPO : NPE; const bf16* Bt = odd ? (const bf16*)(kws() + WS_WINO) + (size_t)j * NPO * D : (const bf16*)(kws() + WS_WINE) + (size_t)j * NPE * D;
            pg8::Gemm g{HB, Bt, T, N, D, 0}; pg8::StaticOrder S; S.init(T, N, F.G, (int)blockIdx.x);
            pg8::EpiStoreBf16 E{(bf16*)(kws() + WS_R1), N};
            pg8::gemm_phase<pg8::EpiStoreBf16, pg8::StaticOrder, true, true>(F.lds, g, S, E);
            SEAM(pb + 0); TWAIT(0); }
        if constexpr (!odd) {
            if constexpr (PH_EN(1)) if (IN(pb + 1)) { const unsigned long long tp0_ = TPROBE(1) ? __builtin_amdgcn_s_memrealtime() : 0ull; e0_conv(F, j); SEAM(pb + 1); TWAIT(1); }
            if constexpr (PH_EN(2)) if (IN(pb + 2)) { const unsigned long long tp0_ = TPROBE(2) ? __builtin_amdgcn_s_memrealtime() : 0ull; if constexpr (SSD_NAIVE) e1_states(F, j); else e1_states_mfma(F, j); SEAM(pb + 2); TWAIT(2); }
            if constexpr (PH_EN(3)) if (IN(pb + 3)) { const unsigned long long tp0_ = TPROBE(3) ? __builtin_amdgcn_s_memrealtime() : 0ull; e2_scan(F); SEAM(pb + 3); TWAIT(3); }
            if constexpr (PH_EN(4)) if (IN(pb + 4)) { const unsigned long long tp0_ = TPROBE(4) ? __builtin_amdgcn_s_memrealtime() : 0ull; e3_output_mfma(F, j); SEAM(pb + 4); TWAIT(4); }
        } else {
            if constexpr (PH_EN(1)) if (IN(pb + 1)) { const unsigned long long tp0_ = TPROBE(1) ? __builtin_amdgcn_s_memrealtime() : 0ull; o_foxscan(F, j); if constexpr (MLSTM_NAIVE) o1_local(F, j); else o1_local_mfma(F, j); SEAM(pb + 1); TWAIT(1); }
            if constexpr (PH_EN(2)) if (IN(pb + 2)) { const unsigned long long tp0_ = TPROBE(2) ? __builtin_amdgcn_s_memrealtime() : 0ull; o2_scan(F); SEAM(pb + 2); TWAIT(2); }
            if constexpr (PH_EN(3)) if (IN(pb + 3)) { const unsigned long long tp0_ = TPROBE(3) ? __builtin_amdgcn_s_memrealtime() : 0ull;
#if FOX_NAIVE
                o4_fox(F);
#else
                const attn_body::bf16* PR = (const attn_body::bf16*)(kws() + WS_R1);
                const attn_body::AttnTensors AT{PR + 2048, PR + 2560, PR + 3072, (attn_body::bf16*)(kws() + WS_MIX) + 512, (const float*)(kws() + WS_FOXC)};
                const attn_body::StaticOrder S((int)F.G, F.vcu);
                attn_body::attn_phase<attn_body::StaticOrder>((char*)F.lds, AT, S);
#endif
                __syncthreads();
                if constexpr (MLSTM_NAIVE) o3_output(F, j); else o3_output_mfma(F, j); SEAM(pb + 3); TWAIT(3); }
        }
        if constexpr (PH_EN(6)) if (IN(pb + 6)) { const unsigned long long tp0_ = TPROBE(6) ? __builtin_amdgcn_s_memrealtime() : 0ull;
            const int K = odd ? D : 1536; const bf16* Bt = odd ? (const bf16*)(kws() + WS_WOUTO) + (size_t)j * D * D : (const bf16*)(kws() + WS_WOUTE) + (size_t)j * D * 1536;
            pg8::Gemm g{MIX, Bt, T, D, K, 0}; pg8::StaticOrder S; S.init(T, D, F.G, (int)blockIdx.x);
            pg8::EpiStoreBf16 E{(bf16*)(kws() + WS_R1), D};
            if constexpr (odd) pg8::gemm_phase<pg8::EpiStoreBf16, pg8::StaticOrder, false, true>(F.lds, g, S, E);
            else pg8::gemm_phase<pg8::EpiStoreBf16, pg8::StaticOrder, false, true, 16>(F.lds, g, S, E, (const float*)(kws() + WS_SSQ), 1.0f / 1024.0f, LN_EPS);
            SEAM(pb + 6); TWAIT(6); }
        if constexpr (PH_EN(7)) if (IN(pb + 7)) { const unsigned long long tp0_ = TPROBE(7) ? __builtin_amdgcn_s_memrealtime() : 0ull; p_ln1_route<LAYER == 0>(F, layer); SEAM(pb + 7); TWAIT(7); }
        if constexpr (PH_EN(8)) if (IN(pb + 8)) { const unsigned long long tp0_ = TPROBE(8) ? __builtin_amdgcn_s_memrealtime() : 0ull; p_scatter(F); SEAM(pb + 8); TWAIT(8); }
        if constexpr (PH_EN(9)) if (IN(pb + 9)) { const unsigned long long tp0_ = TPROBE(9) ? __builtin_amdgcn_s_memrealtime() : 0ull;
            pg8::Gemm g{(const bf16*)(kws() + WS_H1B), (const bf16*)(kws() + WS_WGU) + (size_t)layer * 32 * D * D, RPAD, D, D, (size_t)D * D * 2};
            pg8::MoeOrder S; S.initm((const int*)(kws() + WS_PANEL), 4, F.G, (int)blockIdx.x);
            pg8::EpiSwiglu E{(bf16*)(kws() + WS_R3), 512};
            pg8::gemm_phase<pg8::EpiSwiglu, pg8::MoeOrder, true, true, 0, true>(F.lds, g, S, E, nullptr, 0.f, 0.f, (const int*)(kws() + WS_SROW));
            SEAM(pb + 9); TWAIT(9); }
        if constexpr (PH_EN(10)) if (IN(pb + 10)) { const unsigned long long tp0_ = TPROBE(10) ? __builtin_amdgcn_s_memrealtime() : 0ull;
            pg8::Gemm g{(const bf16*)(kws() + WS_R3), (const bf16*)(kws() + WS_WD) + (size_t)layer * 32 * D * 512, RPAD, D, 512, (size_t)D * 512 * 2};
            pg8::MoeOrder S; S.initm((const int*)(kws() + WS_PANEL), 4, F.G, (int)blockIdx.x);
            pg8::EpiStoreBf16 E{(bf16*)(kws() + WS_R1), D};
            pg8::gemm_phase<pg8::EpiStoreBf16, pg8::MoeOrder, true, true>(F.lds, g, S, E);
            SEAM(pb + 10); TWAIT(10); }
        if constexpr (PH_EN(11)) if (IN(pb + 11)) { const unsigned long long tp0_ = TPROBE(11) ? __builtin_amdgcn_s_memrealtime() : 0ull; p_combine(F, layer); SEAM(pb + 11); TWAIT(11); }
}
struct Args { const float* in[27]; float* out; unsigned char* ws; int ph_lo, ph_hi; };
__global__ void __launch_bounds__(NWAVES * 64, 2) fwd_kernel(Args args) {
    extern __shared__ __attribute__((aligned(16))) unsigned char lds[];
    Frame F;
    F.lds = (LAS unsigned char*)lds;
    F.MISC = (volatile LAS unsigned*)(F.lds + MISC_OFF);
    F.tid = threadIdx.x; F.lane = F.tid & 63; F.wave = __builtin_amdgcn_readfirstlane(F.tid >> 6);
    F.G = gridDim.x; { const int bx = blockIdx.x; F.vcu = (F.G % 8 == 0) ? (bx % 8) * (F.G / 8) + bx / 8 : bx; }
    F.gw = F.vcu * NWAVES + F.wave; F.NGW = F.G * NWAVES;
    F.ctl = (unsigned*)(args.ws + WS_CTL);
    const int lo = args.ph_lo, hi = args.ph_hi;
    for (int u = F.tid; u < (LDS_BYTES - MISC_OFF) / 4; u += NWAVES * 64) ((LAS unsigned*)(F.lds + MISC_OFF))[u] = 0u;
    __syncthreads();
    XcdBarrier bar; bar.bar = F.ctl + CW_BAR; bar.x = 0; bar.st = nullptr;
    if (hi - lo > 1) bar = xcd_barrier_post(F.ctl + CW_BAR, F.MISC + 8);
    if constexpr (PH_EN(12)) if (IN(0)) { const unsigned long long tp0_ = TPROBE(12) ? __builtin_amdgcn_s_memrealtime() : 0ull; p_prologue(F); SEAM(0); TWAIT(12); }
    layer_body<0>(F, lo, hi, bar); layer_body<1>(F, lo, hi, bar); layer_body<2>(F, lo, hi, bar); layer_body<3>(F, lo, hi, bar);
#undef IN
#undef SEAM
}

extern "C" void kernel_launch(void* const* d_in, const int* in_sizes, int n_in, void* d_out, int out_size, void* d_ws, size_t ws_size, hipStream_t stream) {
    static int grid = 0;
    if (grid == 0) {
        if (n_in != 27 || in_sizes[0] != T * D || out_size != T * D || ws_size < WS_END) { fprintf(stderr, "kernel_launch: unexpected shapes (n_in %d, in0 %d, out %d, ws %zu); nothing launched\n", n_in, n_in > 0 ? in_sizes[0] : -1, out_size, ws_size); grid = -1; return; }
        int dev = 0, cus = 0, per_cu = 0;
        if (hipGetDevice(&dev) != hipSuccess || hipDeviceGetAttribute(&cus, hipDeviceAttributeMultiprocessorCount, dev) != hipSuccess) { grid = -1; return; }
        if (hipFuncSetAttribute((const void*)fwd_kernel, hipFuncAttributeMaxDynamicSharedMemorySize, LDS_BYTES) != hipSuccess) { fprintf(stderr, "kernel_launch: hipFuncSetAttribute failed\n"); grid = -1; return; }
        if (hipOccupancyMaxActiveBlocksPerMultiprocessor(&per_cu, (const void*)fwd_kernel, NWAVES * 64, LDS_BYTES) != hipSuccess || per_cu < 1) fprintf(stderr, "kernel_launch: note: occupancy query reports %d workgroups per CU\n", per_cu);
        (void)hipGetLastError();
        grid = cus;
    }
    if (grid < 0) return;
    if (hipMemsetAsync((char*)d_ws + WS_CTL, 0, CTL_ZERO_BYTES, stream) != hipSuccess) return;
    Args a{};
    for (int i = 0; i < 27; ++i) a.in[i] = (const float*)d_in[i];
    a.out = (float*)d_out; a.ws = (unsigned char*)d_ws;
#if MK_ONE_LAUNCH
    a.ph_lo = 0; a.ph_hi = NPHASES;
    hipLaunchKernelGGL(fwd_kernel, dim3(grid), dim3(NWAVES * 64), LDS_BYTES, stream, a);
#else
    for (int ph = 0; ph < NPHASES; ++ph) {
        if (ph > 0 && (((ph - 1) / NPH_LAYER) & 1) && ((ph - 1) % NPH_LAYER) == 5) continue;
        a.ph_lo = ph; a.ph_hi = ph + 1;
        hipLaunchKernelGGL(fwd_kernel, dim3(grid), dim3(NWAVES * 64), LDS_BYTES, stream, a);
    }
#endif
}
```
